# Optimizing an MI355X kernel written in HIP

```python
import math
import jax
import jax.numpy as jnp
from jax import lax
import numpy as np

D_MODEL = 1024
BATCH = 4
SEQ = 4096
DEPTH = 4

GRID_W = 64
CTX_LEN = 256
EPS = 1e-6
N_MOD = 6

HY_WIDTH = 512
HY_ORDER = 2
HY_BANDS = 16
HY_EMB = 1 + 2 * HY_BANDS
HY_FFN = 64
SHORT_K = 3
HY_FAST_DECAY = 0.3
HY_SLOW_DECAY = 1.5
HY_TARGET = 1e-2

MLA_HEADS = 8
QK_NOPE = 64
QK_ROPE = 32
V_DIM = 64
Q_LORA = 384
KV_LORA = 256
ROPE_PAIRS = QK_ROPE // 4
ROPE_BASE = 10000.0
ATTN_SCALE = (QK_NOPE + QK_ROPE) ** -0.5
Q_BLOCK = 128

N_GROUPS = 8
EXP_PER_GROUP = 8
N_EXPERTS = N_GROUPS * EXP_PER_GROUP
TOP_K = 2
D_EXPERT = 256
MOE_BLOCK = 128

HY_COLS = (HY_ORDER + 1) * HY_WIDTH
MLA_END = HY_COLS + Q_LORA + KV_LORA + QK_ROPE
IN_COLS = MLA_END + 2 * D_MODEL

kernel_name = "hyena_mla_hier_moe_dit_trunk"


def rmsnorm(x, g):
    xf = x.astype(jnp.float32)
    y = xf * lax.rsqrt(jnp.mean(xf * xf, axis=-1, keepdims=True) + EPS)
    return (y * g.astype(jnp.float32)).astype(x.dtype)


def modulate(h, g, shift, scale):
    return rmsnorm(h, g) * (1 + scale) + shift


def axial_rope_tables(L):
    rows = L // GRID_W
    r, col = jnp.meshgrid(jnp.arange(rows), jnp.arange(GRID_W), indexing="ij")
    pos = jnp.stack([r.reshape(-1), col.reshape(-1)], axis=-1).astype(jnp.float32)
    inv = ROPE_BASE ** (-jnp.arange(ROPE_PAIRS, dtype=jnp.float32) / ROPE_PAIRS)
    ang = pos[:, :, None] * inv
    return jnp.cos(ang), jnp.sin(ang)


def apply_axial_rope(x, cos, sin):
    shp = x.shape
    xa = x.reshape(shp[:-1] + (2, 2, ROPE_PAIRS))
    x1, x2 = xa[..., 0, :], xa[..., 1, :]
    bshape = (shp[1],) + (1,) * (x.ndim - 3) + (2, ROPE_PAIRS)
    cs = cos.reshape(bshape).astype(x.dtype)
    sn = sin.reshape(bshape).astype(x.dtype)
    return jnp.stack([x1 * cs - x2 * sn, x1 * sn + x2 * cs], axis=-2).reshape(shp)


def short_conv(z, w, b):
    L = z.shape[1]
    pad = SHORT_K // 2
    zp = jnp.pad(z, ((0, 0), (pad, pad), (0, 0)))
    out = b + zp[:, 0:L] * w[0]
    for k in range(1, SHORT_K):
        out = out + zp[:, k:k + L] * w[k]
    return out


def hyena_filters(L, w1, b1, freq, w2, b2, w3):
    f32 = jnp.float32
    t = jnp.linspace(0.0, 1.0, L, dtype=f32)[:, None]
    w = 2.0 * math.pi * jnp.arange(L, dtype=f32)[:, None] / L
    bands = jnp.linspace(1e-4, HY_BANDS - 1, HY_BANDS, dtype=f32)[None, :]
    z = jnp.concatenate([t, jnp.cos(bands * w), -jnp.sin(bands * w)], axis=-1)
    fr = freq.astype(f32)
    h = jnp.sin(fr * (z @ w1.astype(f32) + b1.astype(f32)))
    h = jnp.sin(fr * (h @ w2.astype(f32) + b2.astype(f32)))
    h = (h @ w3.astype(f32)).reshape(L, HY_ORDER, 2, HY_WIDTH)
    deltas = jnp.linspace(math.log(HY_TARGET) / HY_FAST_DECAY, math.log(HY_TARGET) / HY_SLOW_DECAY,
                          HY_WIDTH, dtype=f32)
    h = h * jnp.exp(-t[:, :, None, None] * jnp.abs(deltas))
    h = h * lax.rsqrt(jnp.sum(h * h, axis=0, keepdims=True) + EPS)
    h_fwd, h_bwd = h[:, :, 0], h[:, :, 1]
    circ = jnp.concatenate([h_fwd, jnp.zeros_like(h_fwd[:1]), h_bwd[1:][::-1]], axis=0)
    return jnp.fft.rfft(circ, axis=0)


def long_conv(z, h_freq):
    L = z.shape[1]
    zf = jnp.fft.rfft(z.astype(jnp.float32), n=2 * L, axis=1)
    return jnp.fft.irfft(zf * h_freq, n=2 * L, axis=1)[:, :L].astype(z.dtype)


def hyena_branch(p_hy, sc_w, sc_b, flt, flt_bias):
    L = p_hy.shape[1]
    u = short_conv(p_hy, sc_w, sc_b)
    v, x1, x2 = jnp.split(u, 3, axis=-1)
    h_freq = hyena_filters(L, *flt)
    z = v
    for o, gate in enumerate((x1, x2)):
        z = gate * (long_conv(z, h_freq[:, o]) + flt_bias[o] * z)
    return z


def mla_queries(p_q, q_norm_g, w_uq):
    B, L, _ = p_q.shape
    q = (rmsnorm(p_q, q_norm_g) @ w_uq).reshape(B, L, MLA_HEADS, QK_NOPE + QK_ROPE)
    return q[..., :QK_NOPE], q[..., QK_NOPE:]


def mla_keys_values(p_kv, kv_norm_g, w_ukv):
    B, L, _ = p_kv.shape
    c_kv, k_rope = p_kv[..., :KV_LORA], p_kv[..., KV_LORA:]
    kv = (rmsnorm(c_kv, kv_norm_g) @ w_ukv).reshape(B, L, MLA_HEADS, QK_NOPE + V_DIM)
    return kv[..., :QK_NOPE], kv[..., QK_NOPE:], k_rope


def ctx_attention(qn, qr, kn, kr, v):
    s = jnp.einsum("bqhd,bkhd->bhqk", qn, kn) + jnp.einsum("bqhr,bkr->bhqk", qr, kr)
    p = jax.nn.softmax(s.astype(jnp.float32) * ATTN_SCALE, axis=-1).astype(v.dtype)
    B, C = qn.shape[:2]
    return jnp.einsum("bhqk,bkhd->bqhd", p, v).reshape(B, C, MLA_HEADS * V_DIM)


def latent_attention(qn, qr_rot, qr_raw, kn, kr_rot, v, kn_c, kr_c, v_c):
    B, L = qn.shape[:2]
    nb = L // Q_BLOCK

    def blockify(t):
        return jnp.moveaxis(t.reshape((B, nb, Q_BLOCK) + t.shape[2:]), 1, 0)

    def one_block(args):
        bqn, bqr, bqr0 = args
        s_lat = jnp.einsum("bqhd,bkhd->bhqk", bqn, kn) + jnp.einsum("bqhr,bkr->bhqk", bqr, kr_rot)
        s_ctx = jnp.einsum("bqhd,bkhd->bhqk", bqn, kn_c) + jnp.einsum("bqhr,bkr->bhqk", bqr0, kr_c)
        s = jnp.concatenate([s_lat, s_ctx], axis=-1).astype(jnp.float32) * ATTN_SCALE
        p = jax.nn.softmax(s, axis=-1).astype(v.dtype)
        return (jnp.einsum("bhqk,bkhd->bqhd", p[..., :L], v)
                + jnp.einsum("bhqk,bkhd->bqhd", p[..., L:], v_c))

    out = lax.map(one_block, (blockify(qn), blockify(qr_rot), blockify(qr_raw)))
    return jnp.moveaxis(out, 0, 1).reshape(B, L, MLA_HEADS * V_DIM)


def merge_branches(p_gate, y_hy, y_att, w_hy_o, w_mla_o, w_out):
    g = jax.nn.sigmoid(p_gate)
    return (g[..., :D_MODEL] * (y_hy @ w_hy_o) + g[..., D_MODEL:] * (y_att @ w_mla_o)) @ w_out


def grouped_experts(t, expert, weight, w_gate, w_up, w_down):
    T = t.shape[0]
    A = expert.shape[0]
    token = jnp.repeat(jnp.arange(T, dtype=jnp.int32), TOP_K)
    order = jnp.argsort(expert)
    e_sorted = expert[order]
    counts = jnp.zeros((N_EXPERTS,), jnp.int32).at[expert].add(1)
    padded = (counts + MOE_BLOCK - 1) // MOE_BLOCK * MOE_BLOCK
    start = jnp.cumsum(counts) - counts
    p_end = jnp.cumsum(padded)
    p_start = p_end - padded
    dest = p_start[e_sorted] + jnp.arange(A, dtype=jnp.int32) - start[e_sorted]
    n_blocks = -(-A // MOE_BLOCK) + N_EXPERTS
    slots = n_blocks * MOE_BLOCK
    slot_token = jnp.full((slots,), T, jnp.int32).at[dest].set(token[order])
    slot_weight = jnp.zeros((slots,), weight.dtype).at[dest].set(weight[order])
    block_expert = jnp.minimum(
        jnp.searchsorted(p_end, jnp.arange(n_blocks, dtype=jnp.int32) * MOE_BLOCK, side="right"),
        N_EXPERTS - 1)
    t_pad = jnp.concatenate([t, jnp.zeros((1, t.shape[1]), t.dtype)], axis=0)

    def run_block(args):
        e, tok, wt = args
        xb = t_pad[tok]
        hb = jax.nn.silu(xb @ w_gate[e]) * (xb @ w_up[e])
        return (hb @ w_down[e]) * wt[:, None].astype(t.dtype)

    yb = lax.map(run_block, (block_expert, slot_token.reshape(n_blocks, MOE_BLOCK),
                             slot_weight.reshape(n_blocks, MOE_BLOCK)))
    y = jnp.zeros_like(t_pad).at[slot_token].add(yb.reshape(slots, t.shape[1]))
    return y[:T]


def hier_moe(u, w_rg, b_rg, w_re, b_re, w_gate, w_up, w_down):
    shp = u.shape
    t = u.reshape(-1, D_MODEL)
    T = t.shape[0]
    lg = (t @ w_rg).astype(jnp.float32)
    g_sel = jnp.argmax(lg + b_rg.astype(jnp.float32), axis=-1)
    p_g = jnp.take_along_axis(jax.nn.softmax(lg, axis=-1), g_sel[:, None], axis=-1)
    le = (t @ w_re).astype(jnp.float32).reshape(T, N_GROUPS, EXP_PER_GROUP)
    le_g = jnp.take_along_axis(le, g_sel[:, None, None], axis=1)[:, 0]
    be_g = b_re.astype(jnp.float32).reshape(N_GROUPS, EXP_PER_GROUP)[g_sel]
    _, local = lax.top_k(le_g + be_g, TOP_K)
    w_local = jax.nn.softmax(jnp.take_along_axis(le_g, local, axis=-1), axis=-1)
    expert = (g_sel[:, None] * EXP_PER_GROUP + local).astype(jnp.int32)
    weight = p_g * w_local
    y = grouped_experts(t, expert.reshape(-1), weight.reshape(-1), w_gate, w_up, w_down)
    return y.reshape(shp)


def setup_inputs(seed: int = 0) -> dict:
    key = jax.random.key(seed)
    ks = iter(jax.random.split(key, 40))

    def nrm(shape, scale):
        return jax.random.normal(next(ks), shape, jnp.float32) * scale

    def gain(shape):
        return 1.0 + nrm(shape, 0.05)

    return {
        "x": nrm((BATCH, SEQ, D_MODEL), 1.0),
        "c": nrm((BATCH, D_MODEL), 1.0),
        "ctx": nrm((BATCH, CTX_LEN, D_MODEL), 1.0),
        "c_ctx": nrm((D_MODEL,), 1.0),
        "w_ada": nrm((DEPTH, D_MODEL, N_MOD * D_MODEL), 0.5 * D_MODEL ** -0.5),
        "b_ada": nrm((DEPTH, N_MOD * D_MODEL), 0.02),
        "norm1_g": gain((DEPTH, D_MODEL)),
        "w_in": nrm((DEPTH, D_MODEL, IN_COLS), D_MODEL ** -0.5),
        "q_norm_g": gain((DEPTH, Q_LORA)),
        "kv_norm_g": gain((DEPTH, KV_LORA)),
        "w_uq": nrm((DEPTH, Q_LORA, MLA_HEADS * (QK_NOPE + QK_ROPE)), Q_LORA ** -0.5),
        "w_ukv": nrm((DEPTH, KV_LORA, MLA_HEADS * (QK_NOPE + V_DIM)), KV_LORA ** -0.5),
        "sc_w": nrm((DEPTH, SHORT_K, HY_COLS), SHORT_K ** -0.5),
        "sc_b": nrm((DEPTH, HY_COLS), 0.02),
        "flt_w1": nrm((DEPTH, HY_EMB, HY_FFN), HY_EMB ** -0.5),
        "flt_b1": nrm((DEPTH, HY_FFN), 0.1),
        "flt_freq": gain((DEPTH, HY_FFN)),
        "flt_w2": nrm((DEPTH, HY_FFN, HY_FFN), HY_FFN ** -0.5),
        "flt_b2": nrm((DEPTH, HY_FFN), 0.1),
        "flt_w3": nrm((DEPTH, HY_FFN, HY_ORDER * 2 * HY_WIDTH), HY_FFN ** -0.5),
        "flt_bias": nrm((DEPTH, HY_ORDER, HY_WIDTH), 0.5),
        "w_hy_o": nrm((DEPTH, HY_WIDTH, D_MODEL), HY_WIDTH ** -0.5),
        "w_mla_o": nrm((DEPTH, MLA_HEADS * V_DIM, D_MODEL), (MLA_HEADS * V_DIM) ** -0.5),
        "w_out": nrm((DEPTH, D_MODEL, D_MODEL), D_MODEL ** -0.5),
        "norm2_g": gain((DEPTH, D_MODEL)),
        "w_router_g": nrm((DEPTH, D_MODEL, N_GROUPS), D_MODEL ** -0.5),
        "b_router_g": nrm((DEPTH, N_GROUPS), 0.01),
        "w_router_e": nrm((DEPTH, D_MODEL, N_EXPERTS), D_MODEL ** -0.5),
        "b_router_e": nrm((DEPTH, N_EXPERTS), 0.01),
        "w_gate_e": nrm((DEPTH, N_EXPERTS, D_MODEL, D_EXPERT), D_MODEL ** -0.5),
        "w_up_e": nrm((DEPTH, N_EXPERTS, D_MODEL, D_EXPERT), D_MODEL ** -0.5),
        "w_down_e": nrm((DEPTH, N_EXPERTS, D_EXPERT, D_MODEL), D_EXPERT ** -0.5),
        "final_g": gain((D_MODEL,)),
    }


def reference(x, c, ctx, c_ctx, w_ada, b_ada, norm1_g, w_in, q_norm_g, kv_norm_g, w_uq, w_ukv,
              sc_w, sc_b, flt_w1, flt_b1, flt_freq, flt_w2, flt_b2, flt_w3, flt_bias,
              w_hy_o, w_mla_o, w_out, norm2_g, w_router_g, b_router_g, w_router_e, b_router_e,
              w_gate_e, w_up_e, w_down_e, final_g):
    L = x.shape[1]
    cos, sin = axial_rope_tables(L)
    s_x = jax.nn.silu(c)
    s_c = jax.nn.silu(c_ctx)
    hx, hc = x, ctx
    for l in range(DEPTH):
        last = l == DEPTH - 1
        mx = (s_x @ w_ada[l] + b_ada[l])[:, None, :]
        mc = s_c @ w_ada[l] + b_ada[l]
        sh1x, sc1x, g1x, sh2x, sc2x, g2x = jnp.split(mx, N_MOD, axis=-1)
        sh1c, sc1c, g1c, sh2c, sc2c, g2c = jnp.split(mc, N_MOD, axis=-1)
        flt = (flt_w1[l], flt_b1[l], flt_freq[l], flt_w2[l], flt_b2[l], flt_w3[l])

        ux = modulate(hx, norm1_g[l], sh1x, sc1x)
        uc = modulate(hc, norm1_g[l], sh1c, sc1c)
        px = ux @ w_in[l]
        pc = None if last else uc @ w_in[l]
        pc_mla = uc @ w_in[l][:, HY_COLS:MLA_END] if last else pc[..., HY_COLS:MLA_END]
        kn_c, v_c, kr_c = mla_keys_values(pc_mla[..., Q_LORA:], kv_norm_g[l], w_ukv[l])

        qn_x, qr_x = mla_queries(px[..., HY_COLS:HY_COLS + Q_LORA], q_norm_g[l], w_uq[l])
        kn_x, v_x, kr_x = mla_keys_values(px[..., HY_COLS + Q_LORA:MLA_END], kv_norm_g[l], w_ukv[l])
        att_x = latent_attention(qn_x, apply_axial_rope(qr_x, cos, sin), qr_x,
                                 kn_x, apply_axial_rope(kr_x, cos, sin), v_x, kn_c, kr_c, v_c)
        hy_x = hyena_branch(px[..., :HY_COLS], sc_w[l], sc_b[l], flt, flt_bias[l])
        hx = hx + g1x * merge_branches(px[..., MLA_END:], hy_x, att_x, w_hy_o[l], w_mla_o[l], w_out[l])
        if not last:
            qn_c, qr_c = mla_queries(pc[..., HY_COLS:HY_COLS + Q_LORA], q_norm_g[l], w_uq[l])
            att_c = ctx_attention(qn_c, qr_c, kn_c, kr_c, v_c)
            hy_c = hyena_branch(pc[..., :HY_COLS], sc_w[l], sc_b[l], flt, flt_bias[l])
            hc = hc + g1c * merge_branches(pc[..., MLA_END:], hy_c, att_c, w_hy_o[l], w_mla_o[l], w_out[l])

        moe_w = (w_router_g[l], b_router_g[l], w_router_e[l], b_router_e[l],
                 w_gate_e[l], w_up_e[l], w_down_e[l])
        hx = hx + g2x * hier_moe(modulate(hx, norm2_g[l], sh2x, sc2x), *moe_w)
        if not last:
            hc = hc + g2c * hier_moe(modulate(hc, norm2_g[l], sh2c, sc2c), *moe_w)
    return rmsnorm(hx, final_g)
```

```cpp
#include <hip/hip_runtime.h>
#include <stdint.h>
#include <stdio.h>

typedef unsigned short bf16_t;
typedef short bf16x8 __attribute__((ext_vector_type(8)));
typedef float f32x4 __attribute__((ext_vector_type(4)));
typedef unsigned u32x4 __attribute__((ext_vector_type(4)));
typedef unsigned u32x2 __attribute__((ext_vector_type(2)));

#define NT 512
constexpr int DM = 1024, NB = 4, SEQ = 4096, DEPTH = 4, CTXL = 256;
constexpr int TL = NB * SEQ, TC = NB * CTXL, TT = TL + TC;
constexpr int HYW = 512, HYC = 1536, QL = 384, KVL = 256, QKR = 32;
constexpr int MLAW = QL + KVL + QKR, MLA_END = HYC + MLAW, INC = MLA_END + 2 * DM;
constexpr int NH = 8, DQK = 96, DV = 64, NKEY = SEQ + CTXL;
constexpr int NE = 64, DE = 256, CAP = TT;
constexpr int NMOD = 6 * DM;
constexpr float EPSF = 1e-6f;
constexpr float QSCALE = 0.10206207261596577f * 1.4426950408889634f;

__device__ __forceinline__ bf16_t f2bf(float f) { unsigned u = __float_as_uint(f); u += 0x7FFFu + ((u >> 16) & 1u); return (bf16_t)(u >> 16); }
__device__ __forceinline__ float bf2f(bf16_t b) { return __uint_as_float(((unsigned)b) << 16); }
__device__ __forceinline__ unsigned pack2(float lo, float hi) { return (unsigned)f2bf(lo) | ((unsigned)f2bf(hi) << 16); }
__device__ __forceinline__ float wave_sum(float v) {
#pragma unroll
    for (int o = 32; o > 0; o >>= 1) v += __shfl_xor(v, o);
    return v;
}

struct P {
    const float *x, *c, *ctx, *c_ctx, *w_ada, *b_ada, *norm1_g, *w_in, *q_norm_g, *kv_norm_g, *w_uq, *w_ukv, *sc_w, *sc_b;
    const float *flt_w1, *flt_b1, *flt_freq, *flt_w2, *flt_b2, *flt_w3, *flt_bias, *w_hy_o, *w_mla_o, *w_out, *norm2_g;
    const float *w_rg, *b_rg, *w_re, *b_re, *w_gate, *w_up, *w_down, *final_g;
    float* out;
    int* cnt;
    int* off;
    float* modp;
    float* mod;
    float* H2a;
    float* H2b;
    float* HT0;
    float* HT1;
    float* SSQ0;
    float* SSQ1;
    float* SCL0;
    float* SCL1;
    float* hx;
    bf16_t* U;
    bf16_t* PT;
    bf16_t* PTc;
    float* PMLA;
    bf16_t* G;
    bf16_t* CQ;
    bf16_t* CKV;
    float* QRAW;
    bf16_t* Q;
    bf16_t* Qc;
    bf16_t* K;
    bf16_t* V;
    bf16_t* Yatt;
    bf16_t* Yhy;
    float* M1F;
    bf16_t* M1;
    int* list;
    float* wl;
    int* asg;
    float* HG;
    bf16_t* Hb;
    bf16_t* Y;
};

__device__ void ph_copy_h(const P& p) {
    const size_t n4 = (size_t)TT * DM / 4, nl4 = (size_t)TL * DM / 4;
    for (size_t i = (size_t)blockIdx.x * NT + threadIdx.x; i < n4; i += (size_t)gridDim.x * NT) {
        float4 v = (i < nl4) ? ((const float4*)p.x)[i] : ((const float4*)p.ctx)[i - nl4];
        ((float4*)p.hx)[i] = v;
    }
}

__device__ void ph_mod_partial(const P& p, char* smem) {
    float* s = (float*)smem;
    const int tid = threadIdx.x;
    for (int it = blockIdx.x; it < DEPTH * 8 * 12; it += gridDim.x) {
        const int l = it / 96, kc = (it / 12) % 8, jb = it % 12;
        __syncthreads();
        for (int i = tid; i < 5 * 128; i += NT) {
            const int r = i / 128, kk = i % 128, k = kc * 128 + kk;
            const float cv = (r < 4) ? p.c[r * DM + k] : p.c_ctx[k];
            s[i] = cv / (1.0f + expf(-cv));
        }
        __syncthreads();
        const int j = jb * 512 + tid;
        float a0 = 0, a1 = 0, a2 = 0, a3 = 0, a4 = 0;
        const float* w = p.w_ada + ((size_t)l * DM + kc * 128) * NMOD + j;
#pragma unroll 8
        for (int kk = 0; kk < 128; ++kk) {
            const float wv = w[(size_t)kk * NMOD];
            a0 += s[kk] * wv; a1 += s[128 + kk] * wv; a2 += s[256 + kk] * wv; a3 += s[384 + kk] * wv; a4 += s[512 + kk] * wv;
        }
        float* o = p.modp + ((size_t)(l * 8 + kc) * 5) * NMOD + j;
        o[0] = a0; o[NMOD] = a1; o[2 * NMOD] = a2; o[3 * NMOD] = a3; o[4 * NMOD] = a4;
    }
}

__device__ void ph_filter_a(const P& p, char* smem) {
    float* zs = (float*)smem;
    float* h1s = zs + 8 * 36;
    const int tid = threadIdx.x, tt = tid >> 6, j = tid & 63;
    const int n0 = DEPTH * 512, n1 = DEPTH * 32;
    for (int it = blockIdx.x; it < n0 + n1; it += gridDim.x) {
        int l, ls, tg;
        if (it < n0) { ls = 0; l = it / 512; tg = it % 512; } else { ls = 1; l = (it - n0) / 32; tg = (it - n0) % 32; }
        const int L = ls ? CTXL : SEQ;
        const int t = tg * 8 + tt;
        __syncthreads();
        if (j < 33) {
            float f;
            if (j == 0) f = (float)t / (float)(L - 1);
            else {
                const int k = (j - 1) & 15;
                const float band = 1e-4f + (float)k * ((15.0f - 1e-4f) / 15.0f);
                const float w = 6.283185307179586f * (float)t / (float)L;
                const double ang = (double)band * (double)w;
                f = (j <= 16) ? (float)cos(ang) : (float)(-sin(ang));
            }
            zs[tt * 36 + j] = f;
        }
        __syncthreads();
        const float fr = p.flt_freq[l * 64 + j];
        float a = p.flt_b1[l * 64 + j];
        for (int i = 0; i < 33; ++i) a += zs[tt * 36 + i] * p.flt_w1[((size_t)l * 33 + i) * 64 + j];
        h1s[tt * 64 + j] = sinf(fr * a);
        __syncthreads();
        float a2 = p.flt_b2[l * 64 + j];
        for (int i = 0; i < 64; ++i) a2 += h1s[tt * 64 + i] * p.flt_w2[((size_t)l * 64 + i) * 64 + j];
        const float h2 = sinf(fr * a2);
        if (ls == 0) p.H2a[((size_t)l * SEQ + t) * 64 + j] = h2; else p.H2b[((size_t)l * CTXL + t) * 64 + j] = h2;
    }
}

__device__ void ph_filter_b(const P& p, char* smem) {
    float* w3s = (float*)smem;
    const int tid = threadIdx.x, lane = tid & 63, wv = tid >> 6;
    const int n0 = DEPTH * 8 * 16, n1 = DEPTH * 16;
    const float DA = -15.350567286626973f, DB = -3.0701134573253946f;
    for (int it = blockIdx.x; it < n0 + n1; it += gridDim.x) {
        int l, ls, tc, cc;
        if (it < n0) { ls = 0; l = it / 128; tc = (it / 16) % 8; cc = it % 16; } else { ls = 1; l = (it - n0) / 16; tc = 0; cc = (it - n0) % 16; }
        const int L = ls ? CTXL : SEQ;
        __syncthreads();
        for (int i = tid; i < 64 * 128; i += NT) { const int jj = i >> 7, c = i & 127; w3s[i] = p.flt_w3[((size_t)l * 64 + jj) * 2048 + cc * 128 + c]; }
        __syncthreads();
        int t, cbeg, cend;
        if (ls == 0) { t = tc * 512 + tid; cbeg = 0; cend = 128; } else { t = tid & 255; cbeg = (tid >> 8) * 64; cend = cbeg + 64; }
        const float* h2 = ls ? p.H2b + ((size_t)l * CTXL + t) * 64 : p.H2a + ((size_t)l * SEQ + t) * 64;
        float h[64];
#pragma unroll
        for (int jj = 0; jj < 64; jj += 4) { const float4 v = *(const float4*)(h2 + jj); h[jj] = v.x; h[jj + 1] = v.y; h[jj + 2] = v.z; h[jj + 3] = v.w; }
        const float tl = (float)t / (float)(L - 1);
        for (int c = cbeg; c < cend; ++c) {
            float acc = 0.f;
#pragma unroll
            for (int jj = 0; jj < 64; ++jj) acc += h[jj] * w3s[jj * 128 + c];
            const int col = cc * 128 + c, ch = col & 511;
            const float delta = fabsf(DA + (float)ch * ((DB - DA) / 511.0f));
            const float v = acc * expf(-tl * delta);
            if (ls == 0) p.HT0[((size_t)l * 2048 + col) * SEQ + t] = v; else p.HT1[((size_t)l * 2048 + col) * CTXL + t] = v;
            const float q = wave_sum(v * v);
            if (lane == 0) { if (ls == 0) p.SSQ0[((size_t)l * 2048 + col) * 64 + tc * 8 + wv] = q; else p.SSQ1[((size_t)l * 2048 + col) * 4 + (wv & 3)] = q; }
        }
    }
}

__device__ void ph_finalize(const P& p) {
    const int n_mod = DEPTH * 5 * NMOD, n_s = DEPTH * 2048;
    for (int i = blockIdx.x * NT + threadIdx.x; i < n_mod + 2 * n_s; i += gridDim.x * NT) {
        if (i < n_mod) {
            const int l = i / (5 * NMOD), r = (i / NMOD) % 5, j = i % NMOD;
            float a = p.b_ada[l * NMOD + j];
            for (int kc = 0; kc < 8; ++kc) a += p.modp[((size_t)(l * 8 + kc) * 5 + r) * NMOD + j];
            p.mod[i] = a;
        } else if (i < n_mod + n_s) {
            const int k = i - n_mod; float a = 0.f;
            for (int q = 0; q < 64; ++q) a += p.SSQ0[(size_t)k * 64 + q];
            p.SCL0[k] = rsqrtf(a + EPSF);
        } else {
            const int k = i - n_mod - n_s; float a = 0.f;
            for (int q = 0; q < 4; ++q) a += p.SSQ1[(size_t)k * 4 + q];
            p.SCL1[k] = rsqrtf(a + EPSF);
        }
    }
}

template <int WHICH>
__device__ void ph_norm(const P& p, int l, char* smem) {
    float* rowbuf = (float*)smem;
    float* lgs = rowbuf + 8 * 1024;
    const int tid = threadIdx.x, lane = tid & 63, wv = tid >> 6;
    const float* ng = (WHICH == 1 ? p.norm1_g : p.norm2_g) + l * DM;
    for (int rb = blockIdx.x * 8; rb < TT; rb += gridDim.x * 8) {
        const int row = rb + wv;
        const int b = row < TL ? (row >> 12) : 4;
        const float* hp = p.hx + (size_t)row * DM;
        const float* md = p.mod + ((size_t)l * 5 + b) * NMOD + (WHICH == 1 ? 0 : 3 * DM);
        float4 xv[4]; float ss = 0.f;
#pragma unroll
        for (int i = 0; i < 4; ++i) { xv[i] = *(const float4*)(hp + i * 256 + lane * 4); ss += xv[i].x * xv[i].x + xv[i].y * xv[i].y + xv[i].z * xv[i].z + xv[i].w * xv[i].w; }
        ss = wave_sum(ss);
        const float rs = rsqrtf(ss * (1.0f / DM) + EPSF);
#pragma unroll
        for (int i = 0; i < 4; ++i) {
            const int j = i * 256 + lane * 4;
            const float4 g = *(const float4*)(ng + j), sh = *(const float4*)(md + j), sc = *(const float4*)(md + DM + j);
            float4 y;
            y.x = (xv[i].x * rs * g.x) * (1.f + sc.x) + sh.x; y.y = (xv[i].y * rs * g.y) * (1.f + sc.y) + sh.y;
            y.z = (xv[i].z * rs * g.z) * (1.f + sc.z) + sh.z; y.w = (xv[i].w * rs * g.w) * (1.f + sc.w) + sh.w;
            u32x2 o; o.x = pack2(y.x, y.y); o.y = pack2(y.z, y.w);
            *(u32x2*)(p.U + (size_t)row * DM + j) = o;
            if (WHICH == 2) *(float4*)(rowbuf + wv * 1024 + j) = y;
        }
        if (WHICH == 2) {
            __syncthreads();
            const float* wre = p.w_re + (size_t)l * DM * NE + lane;
            const float* wrg = p.w_rg + (size_t)l * DM * 8 + (lane & 7);
            float ae = 0.f, ag = 0.f;
            const float* rbp = rowbuf + wv * 1024;
#pragma unroll 8
            for (int k = 0; k < DM; ++k) { const float tv = rbp[k]; ae += tv * wre[(size_t)k * NE]; ag += tv * wrg[(size_t)k * 8]; }
            lgs[wv * 72 + 8 + lane] = ae;
            if (lane < 8) lgs[wv * 72 + lane] = ag;
            __syncthreads();
            if (lane == 0) {
                const float* lg = lgs + wv * 72; const float* le = lg + 8;
                int gs = 0; float best = lg[0] + p.b_rg[l * 8], mx = lg[0];
                for (int i = 1; i < 8; ++i) { const float v = lg[i] + p.b_rg[l * 8 + i]; if (v > best) { best = v; gs = i; } mx = fmaxf(mx, lg[i]); }
                float den = 0.f;
                for (int i = 0; i < 8; ++i) den += expf(lg[i] - mx);
                const float pg = expf(lg[gs] - mx) / den;
                int i0 = 0; float k0 = le[gs * 8] + p.b_re[l * NE + gs * 8];
                for (int i = 1; i < 8; ++i) { const float v = le[gs * 8 + i] + p.b_re[l * NE + gs * 8 + i]; if (v > k0) { k0 = v; i0 = i; } }
                int i1 = -1; float k1 = 0.f;
                for (int i = 0; i < 8; ++i) { if (i == i0) continue; const float v = le[gs * 8 + i] + p.b_re[l * NE + gs * 8 + i]; if (i1 < 0 || v > k1) { k1 = v; i1 = i; } }
                const float w0 = 1.0f / (1.0f + expf(le[gs * 8 + i1] - le[gs * 8 + i0])), w1 = 1.0f - w0;
                const int e0 = gs * 8 + i0, e1 = gs * 8 + i1;
                const int r0 = atomicAdd(p.cnt + l * NE + e0, 1), r1 = atomicAdd(p.cnt + l * NE + e1, 1);
                p.list[(size_t)e0 * CAP + r0] = row; p.wl[(size_t)e0 * CAP + r0] = pg * w0;
                p.list[(size_t)e1 * CAP + r1] = row; p.wl[(size_t)e1 * CAP + r1] = pg * w1;
                *(int4*)(p.asg + (size_t)row * 4) = make_int4(e0, r0, e1, r1);
            }
            __syncthreads();
        }
    }
}

template <bool A_F32, class Epi>
__device__ __forceinline__ void gemm_tiles(char* smem, const void* Av, int lda, const int* arow, int M, const float* B, int ldb, int N, int K, const Epi& epi) {
    bf16_t* sA = (bf16_t*)smem;
    bf16_t* sB = sA + 128 * 40;
    const int tid = threadIdx.x, lane = tid & 63, wv = tid >> 6, wm = wv >> 1, wn = wv & 1, fr = lane & 15, fq = lane >> 4;
    const int tm = (M + 127) / 128, tn = (N + 63) / 64;
    for (int u = blockIdx.x; u < tm * tn; u += gridDim.x) {
        const int m0 = (u / tn) * 128, n0 = (u % tn) * 64;
        f32x4 acc[2][2];
#pragma unroll
        for (int a = 0; a < 2; ++a)
#pragma unroll
            for (int b = 0; b < 2; ++b) acc[a][b] = (f32x4){0.f, 0.f, 0.f, 0.f};
        const int ar = tid >> 2, ak = (tid & 3) * 8, gr = m0 + ar;
        long asrc = -1; if (gr < M) asrc = arow ? (long)arow[gr] : (long)gr;
        const int bk = tid >> 4, bn = (tid & 15) * 4, gcol = n0 + bn;
        for (int k0 = 0; k0 < K; k0 += 32) {
            u32x4 av = (u32x4){0u, 0u, 0u, 0u};
            if (asrc >= 0) {
                if (A_F32) {
                    const float* ap = (const float*)Av + asrc * lda + k0 + ak;
                    const float4 x0 = *(const float4*)ap, x1 = *(const float4*)(ap + 4);
                    av.x = pack2(x0.x, x0.y); av.y = pack2(x0.z, x0.w); av.z = pack2(x1.x, x1.y); av.w = pack2(x1.z, x1.w);
                } else av = *(const u32x4*)((const bf16_t*)Av + asrc * lda + k0 + ak);
            }
            float4 bv = make_float4(0.f, 0.f, 0.f, 0.f);
            if (gcol < N) bv = *(const float4*)(B + (size_t)(k0 + bk) * ldb + gcol);
            __syncthreads();
            *(u32x4*)(sA + ar * 40 + ak) = av;
            sB[(bn + 0) * 40 + bk] = f2bf(bv.x); sB[(bn + 1) * 40 + bk] = f2bf(bv.y); sB[(bn + 2) * 40 + bk] = f2bf(bv.z); sB[(bn + 3) * 40 + bk] = f2bf(bv.w);
            __syncthreads();
            bf16x8 a[2], b[2];
#pragma unroll
            for (int i = 0; i < 2; ++i) { a[i] = *(const bf16x8*)(sA + (wm * 32 + i * 16 + fr) * 40 + fq * 8); b[i] = *(const bf16x8*)(sB + (wn * 32 + i * 16 + fr) * 40 + fq * 8); }
#pragma unroll
            for (int mi = 0; mi < 2; ++mi)
#pragma unroll
                for (int ni = 0; ni < 2; ++ni) acc[mi][ni] = __builtin_amdgcn_mfma_f32_16x16x32_bf16(a[mi], b[ni], acc[mi][ni], 0, 0, 0);
        }
#pragma unroll
        for (int mi = 0; mi < 2; ++mi)
#pragma unroll
            for (int ni = 0; ni < 2; ++ni)
#pragma unroll
                for (int j = 0; j < 4; ++j) {
                    const int row = m0 + wm * 32 + mi * 16 + fq * 4 + j, col = n0 + wn * 32 + ni * 16 + fr;
                    if (row < M && col < N) epi(row, col, acc[mi][ni][j]);
                }
    }
}

__device__ void ph_inproj(const P& p, int l, char* smem) {
    auto epi = [&](int row, int col, float v) {
        if (col < HYC) {
            if (row < TL) p.PT[((size_t)(row >> 12) * HYC + col) * SEQ + (row & 4095)] = f2bf(v);
            else { const int r = row - TL; p.PTc[((size_t)(r >> 8) * HYC + col) * CTXL + (r & 255)] = f2bf(v); }
        } else if (col < MLA_END) p.PMLA[(size_t)row * MLAW + col - HYC] = v;
        else p.G[(size_t)row * 2048 + col - MLA_END] = f2bf(1.0f / (1.0f + expf(-v)));
    };
    gemm_tiles<false>(smem, p.U, DM, nullptr, TT, p.w_in + (size_t)l * DM * INC, INC, INC, DM, epi);
}

__device__ __forceinline__ float rope_apply(float self, float partner, int d, int t) {
    const int a = d >> 4, s = (d >> 3) & 1, i = d & 7;
    const float pos = (float)(a == 0 ? (t >> 6) : (t & 63));
    const float inv = powf(10000.0f, -(float)i / 8.0f);
    const float ang = pos * inv;
    const float cs = cosf(ang), sn = sinf(ang);
    return s == 0 ? self * cs - partner * sn : partner * sn + self * cs;
}

__device__ void ph_mla_prep(const P& p, int l) {
    const int tid = threadIdx.x, lane = tid & 63, wv = tid >> 6;
    for (int rb = blockIdx.x * 8; rb < TT; rb += gridDim.x * 8) {
        const int row = rb + wv;
        const float* pm = p.PMLA + (size_t)row * MLAW;
        float q[6], ss = 0.f;
#pragma unroll
        for (int i = 0; i < 6; ++i) { q[i] = pm[lane + 64 * i]; ss += q[i] * q[i]; }
        ss = wave_sum(ss);
        float rs = rsqrtf(ss * (1.0f / QL) + EPSF);
#pragma unroll
        for (int i = 0; i < 6; ++i) p.CQ[(size_t)row * QL + lane + 64 * i] = f2bf(q[i] * rs * p.q_norm_g[l * QL + lane + 64 * i]);
        float kv[4]; ss = 0.f;
#pragma unroll
        for (int i = 0; i < 4; ++i) { kv[i] = pm[QL + lane + 64 * i]; ss += kv[i] * kv[i]; }
        ss = wave_sum(ss);
        rs = rsqrtf(ss * (1.0f / KVL) + EPSF);
#pragma unroll
        for (int i = 0; i < 4; ++i) p.CKV[(size_t)row * KVL + lane + 64 * i] = f2bf(kv[i] * rs * p.kv_norm_g[l * KVL + lane + 64 * i]);
        const int d = lane & 31;
        const float self = pm[QL + KVL + d];
        const float partner = __shfl_xor(self, 8);
        int b, key; float val;
        if (row < TL) { b = row >> 12; const int t = row & 4095; key = t; val = rope_apply(self, partner, d, t); }
        else { const int r = row - TL; b = r >> 8; key = SEQ + (r & 255); val = self; }
        if (lane < 32) {
            const bf16_t o = f2bf(val);
#pragma unroll
            for (int h = 0; h < NH; ++h) p.K[((size_t)(b * NH + h) * NKEY + key) * DQK + 64 + d] = o;
        }
    }
}

__device__ void ph_qgemm(const P& p, int l, char* smem) {
    auto epi = [&](int row, int col, float v) { p.QRAW[(size_t)row * 768 + col] = v; };
    gemm_tiles<false>(smem, p.CQ, QL, nullptr, TT, p.w_uq + (size_t)l * QL * 768, 768, 768, QL, epi);
}
__device__ void ph_kvgemm(const P& p, int l, char* smem) {
    auto epi = [&](int row, int col, float v) {
        const int h = col >> 7, d = col & 127;
        int b, key;
        if (row < TL) { b = row >> 12; key = row & 4095; } else { const int r = row - TL; b = r >> 8; key = SEQ + (r & 255); }
        if (d < 64) p.K[((size_t)(b * NH + h) * NKEY + key) * DQK + d] = f2bf(v);
        else p.V[((size_t)(b * NH + h) * NKEY + key) * DV + d - 64] = f2bf(v);
    };
    gemm_tiles<false>(smem, p.CKV, KVL, nullptr, TT, p.w_ukv + (size_t)l * KVL * 1024, 1024, 1024, KVL, epi);
}
__device__ void ph_qpack(const P& p) {
    const size_t n = (size_t)TT * NH * 128;
    for (size_t i = (size_t)blockIdx.x * NT + threadIdx.x; i < n; i += (size_t)gridDim.x * NT) {
        const int dd = (int)(i & 127), h = (int)((i >> 7) & 7), row = (int)(i >> 10);
        const float* qr = p.QRAW + (size_t)row * 768 + h * 96;
        float v;
        if (dd < 64) v = qr[dd];
        else if (dd < 96) { const int d = dd - 64; v = (row < TL) ? rope_apply(qr[64 + d], qr[64 + (d ^ 8)], d, row & 4095) : qr[64 + d]; }
        else v = qr[64 + dd - 96];
        v *= QSCALE;
        if (row < TL) p.Q[((size_t)((row >> 12) * NH + h) * SEQ + (row & 4095)) * 128 + dd] = f2bf(v);
        else { const int r = row - TL; p.Qc[((size_t)((r >> 8) * NH + h) * CTXL + (r & 255)) * 128 + dd] = f2bf(v); }
    }
}

__device__ void ph_attn(const P& p, char* smem) {
    bf16_t* sK = (bf16_t*)smem;
    bf16_t* sVt = sK + 64 * 104;
    bf16_t* sP = sVt + 64 * 72;
    const int tid = threadIdx.x, lane = tid & 63, wv = tid >> 6, fr = lane & 15, fq = lane >> 4;
    bf16_t* sPw = sP + wv * 16 * 72;
    const int NUL = NB * NH * 32, NUC = NB * NH * 2;
    for (int u = blockIdx.x; u < NUL + NUC; u += gridDim.x) {
        const bool isctx = u >= NUL;
        int b, h, q0;
        if (!isctx) { b = u / (NH * 32); h = (u / 32) % NH; q0 = (u % 32) * 128; } else { const int v = u - NUL; b = v / (NH * 2); h = (v / 2) % NH; q0 = (v % 2) * 128; }
        const bf16_t* Qp = isctx ? p.Qc + ((size_t)(b * NH + h) * CTXL + q0) * 128 : p.Q + ((size_t)(b * NH + h) * SEQ + q0) * 128;
        bf16x8 qa[4];
#pragma unroll
        for (int ks = 0; ks < 4; ++ks) qa[ks] = *(const bf16x8*)(Qp + (size_t)(wv * 16 + fr) * 128 + ks * 32 + fq * 8);
        const bf16_t* Kp = p.K + (size_t)(b * NH + h) * NKEY * DQK;
        const bf16_t* Vp = p.V + (size_t)(b * NH + h) * NKEY * DV;
        f32x4 o[4]; float m[4], lsum[4];
#pragma unroll
        for (int i = 0; i < 4; ++i) { o[i] = (f32x4){0.f, 0.f, 0.f, 0.f}; m[i] = -INFINITY; lsum[i] = 0.f; }
        for (int kt = isctx ? 64 : 0; kt < 68; ++kt) {
            __syncthreads();
            for (int i = tid; i < 768; i += NT) { const int key = i / 12, part = i % 12; *(u32x4*)(sK + key * 104 + part * 8) = *(const u32x4*)(Kp + (size_t)(kt * 64 + key) * DQK + part * 8); }
            {
                const int key = tid >> 3, d0 = (tid & 7) * 8;
                const bf16x8 vv = *(const bf16x8*)(Vp + (size_t)(kt * 64 + key) * DV + d0);
#pragma unroll
                for (int i = 0; i < 8; ++i) sVt[(d0 + i) * 72 + key] = (bf16_t)vv[i];
            }
            __syncthreads();
            f32x4 s[4];
#pragma unroll
            for (int nt = 0; nt < 4; ++nt) {
                s[nt] = (f32x4){0.f, 0.f, 0.f, 0.f};
#pragma unroll
                for (int ks = 0; ks < 3; ++ks) {
                    const bf16x8 a = (ks < 2) ? qa[ks] : (kt >= 64 ? qa[3] : qa[2]);
                    const bf16x8 bb = *(const bf16x8*)(sK + (nt * 16 + fr) * 104 + ks * 32 + fq * 8);
                    s[nt] = __builtin_amdgcn_mfma_f32_16x16x32_bf16(a, bb, s[nt], 0, 0, 0);
                }
            }
#pragma unroll
            for (int j = 0; j < 4; ++j) {
                float mx = fmaxf(fmaxf(s[0][j], s[1][j]), fmaxf(s[2][j], s[3][j]));
                mx = fmaxf(mx, __shfl_xor(mx, 1)); mx = fmaxf(mx, __shfl_xor(mx, 2)); mx = fmaxf(mx, __shfl_xor(mx, 4)); mx = fmaxf(mx, __shfl_xor(mx, 8));
                const float mn = fmaxf(m[j], mx);
                const float alpha = exp2f(m[j] - mn);
                m[j] = mn;
                float rsum = 0.f;
#pragma unroll
                for (int nt = 0; nt < 4; ++nt) { const float pv = exp2f(s[nt][j] - mn); rsum += pv; sPw[(fq * 4 + j) * 72 + nt * 16 + fr] = f2bf(pv); }
                rsum += __shfl_xor(rsum, 1); rsum += __shfl_xor(rsum, 2); rsum += __shfl_xor(rsum, 4); rsum += __shfl_xor(rsum, 8);
                lsum[j] = lsum[j] * alpha + rsum;
#pragma unroll
                for (int nt = 0; nt < 4; ++nt) o[nt][j] *= alpha;
            }
            __syncthreads();
#pragma unroll
            for (int ks = 0; ks < 2; ++ks) {
                const bf16x8 a = *(const bf16x8*)(sPw + fr * 72 + ks * 32 + fq * 8);
#pragma unroll
                for (int nt = 0; nt < 4; ++nt) {
                    const bf16x8 bb = *(const bf16x8*)(sVt + (nt * 16 + fr) * 72 + ks * 32 + fq * 8);
                    o[nt] = __builtin_amdgcn_mfma_f32_16x16x32_bf16(a, bb, o[nt], 0, 0, 0);
                }
            }
        }
        const size_t rbase = (isctx ? (size_t)TL + b * CTXL : (size_t)b * SEQ) + q0 + wv * 16 + fq * 4;
#pragma unroll
        for (int j = 0; j < 4; ++j) {
            const float inv = 1.0f / lsum[j];
#pragma unroll
            for (int nt = 0; nt < 4; ++nt) p.Yatt[(rbase + j) * 512 + h * 64 + nt * 16 + fr] = f2bf(o[nt][j] * inv);
        }
    }
}

template <int L>
__device__ void ph_hyena(const P& p, int l, char* smem) {
    constexpr int NOUT = (L >= NT) ? L / NT : 1;
    float* kern0 = (float*)smem;
    float* kern1 = kern0 + 2 * L;
    float* zb = kern1 + 2 * L;
    const int tid = threadIdx.x;
    const bool active = tid < L;
    const int tb = active ? tid : 0;
    const bf16_t* PTb = (L == SEQ) ? p.PT : p.PTc;
    const float* HT = (L == SEQ) ? p.HT0 + (size_t)l * 2048 * SEQ : p.HT1 + (size_t)l * 2048 * CTXL;
    const float* SCL = ((L == SEQ) ? p.SCL0 : p.SCL1) + l * 2048;
    for (int u = blockIdx.x; u < NB * HYW; u += gridDim.x) {
        const int b = u / HYW, c = u % HYW;
        __syncthreads();
        for (int i = tid; i < 2 * L; i += NT) {
            const int d = i - L;
            float k0, k1;
            if (d >= 0) { k0 = HT[(size_t)(0 * 1024 + c) * L + d] * SCL[c]; k1 = HT[(size_t)(1 * 1024 + c) * L + d] * SCL[1024 + c]; }
            else if (d > -L) { k0 = HT[(size_t)(0 * 1024 + 512 + c) * L + (size_t)(-d)] * SCL[512 + c]; k1 = HT[(size_t)(1 * 1024 + 512 + c) * L + (size_t)(-d)] * SCL[1536 + c]; }
            else { k0 = 0.f; k1 = 0.f; }
            kern0[i] = k0; kern1[i] = k1;
        }
        float uv[3][NOUT];
#pragma unroll
        for (int w = 0; w < 3; ++w) {
            const int col = w * HYW + c;
            const bf16_t* pr = PTb + ((size_t)b * HYC + col) * L;
            const float w0 = p.sc_w[(size_t)(l * 3 + 0) * HYC + col], w1 = p.sc_w[(size_t)(l * 3 + 1) * HYC + col], w2 = p.sc_w[(size_t)(l * 3 + 2) * HYC + col], bb = p.sc_b[l * HYC + col];
#pragma unroll
            for (int i = 0; i < NOUT; ++i) {
                const int t = tb + i * NT;
                const float pm1 = t > 0 ? bf2f(pr[t - 1]) : 0.f, p0 = bf2f(pr[t]), pp1 = t < L - 1 ? bf2f(pr[t + 1]) : 0.f;
                uv[w][i] = bb + w0 * pm1 + w1 * p0 + w2 * pp1;
            }
        }
        if (active) {
#pragma unroll
            for (int i = 0; i < NOUT; ++i) zb[tb + i * NT] = uv[0][i];
        }
        __syncthreads();
        float acc[NOUT];
#pragma unroll
        for (int i = 0; i < NOUT; ++i) acc[i] = 0.f;
        for (int s = 0; s < L; ++s) {
            const float zs = zb[s];
#pragma unroll
            for (int i = 0; i < NOUT; ++i) acc[i] += zs * kern0[tb + i * NT - s + L];
        }
        const float bias0 = p.flt_bias[(l * 2 + 0) * HYW + c], bias1 = p.flt_bias[(l * 2 + 1) * HYW + c];
        float z1[NOUT];
#pragma unroll
        for (int i = 0; i < NOUT; ++i) z1[i] = uv[1][i] * (acc[i] + bias0 * uv[0][i]);
        __syncthreads();
        if (active) {
#pragma unroll
            for (int i = 0; i < NOUT; ++i) zb[tb + i * NT] = z1[i];
        }
        __syncthreads();
#pragma unroll
        for (int i = 0; i < NOUT; ++i) acc[i] = 0.f;
        for (int s = 0; s < L; ++s) {
            const float zs = zb[s];
#pragma unroll
            for (int i = 0; i < NOUT; ++i) acc[i] += zs * kern1[tb + i * NT - s + L];
        }
        if (active) {
            const size_t rbase = (L == SEQ) ? (size_t)b * SEQ : (size_t)TL + b * CTXL;
#pragma unroll
            for (int i = 0; i < NOUT; ++i) p.Yhy[(rbase + tb + i * NT) * HYW + c] = f2bf(uv[2][i] * (acc[i] + bias1 * z1[i]));
        }
    }
}

__device__ void ph_merge_a(const P& p, int l, char* smem) {
    auto epi = [&](int row, int col, float v) { p.M1F[(size_t)row * DM + col] = bf2f(p.G[(size_t)row * 2048 + col]) * v; };
    gemm_tiles<false>(smem, p.Yhy, HYW, nullptr, TT, p.w_hy_o + (size_t)l * HYW * DM, DM, DM, HYW, epi);
}
__device__ void ph_merge_b(const P& p, int l, char* smem) {
    auto epi = [&](int row, int col, float v) { p.M1[(size_t)row * DM + col] = f2bf(p.M1F[(size_t)row * DM + col] + bf2f(p.G[(size_t)row * 2048 + DM + col]) * v); };
    gemm_tiles<false>(smem, p.Yatt, 512, nullptr, TT, p.w_mla_o + (size_t)l * 512 * DM, DM, DM, 512, epi);
}
__device__ void ph_outproj(const P& p, int l, char* smem) {
    auto epi = [&](int row, int col, float v) {
        const int b = row < TL ? (row >> 12) : 4;
        p.hx[(size_t)row * DM + col] += p.mod[((size_t)l * 5 + b) * NMOD + 2 * DM + col] * v;
    };
    gemm_tiles<false>(smem, p.M1, DM, nullptr, TT, p.w_out + (size_t)l * DM * DM, DM, DM, DM, epi);
}
__device__ void ph_moe_off(const P& p, int l) {
    if (blockIdx.x == 0 && threadIdx.x == 0) { int a = 0; for (int e = 0; e < NE; ++e) { p.off[l * 65 + e] = a; a += p.cnt[l * NE + e]; } p.off[l * 65 + 64] = a; }
}
__device__ void ph_moe_gate(const P& p, int l, char* smem) {
    for (int e = 0; e < NE; ++e) {
        const int M = p.cnt[l * NE + e], o = p.off[l * 65 + e];
        auto epi = [&](int row, int col, float v) { p.HG[(size_t)(o + row) * DE + col] = v; };
        gemm_tiles<false>(smem, p.U, DM, p.list + (size_t)e * CAP, M, p.w_gate + (size_t)(l * NE + e) * DM * DE, DE, DE, DM, epi);
    }
}
__device__ void ph_moe_up(const P& p, int l, char* smem) {
    for (int e = 0; e < NE; ++e) {
        const int M = p.cnt[l * NE + e], o = p.off[l * 65 + e];
        auto epi = [&](int row, int col, float v) { const float g = p.HG[(size_t)(o + row) * DE + col]; p.Hb[(size_t)(o + row) * DE + col] = f2bf(g / (1.0f + expf(-g)) * v); };
        gemm_tiles<false>(smem, p.U, DM, p.list + (size_t)e * CAP, M, p.w_up + (size_t)(l * NE + e) * DM * DE, DE, DE, DM, epi);
    }
}
__device__ void ph_moe_down(const P& p, int l, char* smem) {
    for (int e = 0; e < NE; ++e) {
        const int M = p.cnt[l * NE + e], o = p.off[l * 65 + e];
        auto epi = [&](int row, int col, float v) { p.Y[(size_t)(o + row) * DM + col] = f2bf(v * p.wl[(size_t)e * CAP + row]); };
        gemm_tiles<false>(smem, p.Hb + (size_t)o * DE, DE, nullptr, M, p.w_down + (size_t)(l * NE + e) * DE * DM, DM, DM, DE, epi);
    }
}
__device__ void ph_combine(const P& p, int l) {
    const int tid = threadIdx.x, lane = tid & 63, wv = tid >> 6;
    for (int rb = blockIdx.x * 8; rb < TT; rb += gridDim.x * 8) {
        const int row = rb + wv;
        const int b = row < TL ? (row >> 12) : 4;
        const int4 a = *(const int4*)(p.asg + (size_t)row * 4);
        const size_t s0 = (size_t)p.off[l * 65 + a.x] + a.y, s1 = (size_t)p.off[l * 65 + a.z] + a.w;
        const float* g2 = p.mod + ((size_t)l * 5 + b) * NMOD + 5 * DM;
#pragma unroll
        for (int i = 0; i < 4; ++i) {
            const int j = i * 256 + lane * 4;
            float4 hv = *(float4*)(p.hx + (size_t)row * DM + j);
            const u32x2 y0 = *(const u32x2*)(p.Y + s0 * DM + j), y1 = *(const u32x2*)(p.Y + s1 * DM + j);
            const float4 g = *(const float4*)(g2 + j);
            hv.x += g.x * (__uint_as_float(y0.x << 16) + __uint_as_float(y1.x << 16));
            hv.y += g.y * (__uint_as_float(y0.x & 0xFFFF0000u) + __uint_as_float(y1.x & 0xFFFF0000u));
            hv.z += g.z * (__uint_as_float(y0.y << 16) + __uint_as_float(y1.y << 16));
            hv.w += g.w * (__uint_as_float(y0.y & 0xFFFF0000u) + __uint_as_float(y1.y & 0xFFFF0000u));
            *(float4*)(p.hx + (size_t)row * DM + j) = hv;
        }
    }
}
__device__ void ph_final(const P& p) {
    const int tid = threadIdx.x, lane = tid & 63, wv = tid >> 6;
    for (int rb = blockIdx.x * 8; rb < TL; rb += gridDim.x * 8) {
        const int row = rb + wv;
        const float* hp = p.hx + (size_t)row * DM;
        float4 xv[4]; float ss = 0.f;
#pragma unroll
        for (int i = 0; i < 4; ++i) { xv[i] = *(const float4*)(hp + i * 256 + lane * 4); ss += xv[i].x * xv[i].x + xv[i].y * xv[i].y + xv[i].z * xv[i].z + xv[i].w * xv[i].w; }
        ss = wave_sum(ss);
        const float rs = rsqrtf(ss * (1.0f / DM) + EPSF);
#pragma unroll
        for (int i = 0; i < 4; ++i) {
            const int j = i * 256 + lane * 4;
            const float4 g = *(const float4*)(p.final_g + j);
            float4 y; y.x = xv[i].x * rs * g.x; y.y = xv[i].y * rs * g.y; y.z = xv[i].z * rs * g.z; y.w = xv[i].w * rs * g.w;
            *(float4*)(p.out + (size_t)row * DM + j) = y;
        }
    }
}

#define KW(name, body) __global__ __launch_bounds__(NT) void name(P p, int l) { extern __shared__ __attribute__((aligned(16))) char smem[]; (void)smem; (void)l; body; }
KW(k_copy_h, ph_copy_h(p))
KW(k_mod_partial, ph_mod_partial(p, smem))
KW(k_filter_a, ph_filter_a(p, smem))
KW(k_filter_b, ph_filter_b(p, smem))
KW(k_finalize, ph_finalize(p))
KW(k_norm1, ph_norm<1>(p, l, smem))
KW(k_norm2, ph_norm<2>(p, l, smem))
KW(k_inproj, ph_inproj(p, l, smem))
KW(k_mla_prep, ph_mla_prep(p, l))
KW(k_qgemm, ph_qgemm(p, l, smem))
KW(k_kvgemm, ph_kvgemm(p, l, smem))
KW(k_qpack, ph_qpack(p))
KW(k_attn, ph_attn(p, smem))
KW(k_hyena_l, ph_hyena<SEQ>(p, l, smem))
KW(k_hyena_c, ph_hyena<CTXL>(p, l, smem))
KW(k_merge_a, ph_merge_a(p, l, smem))
KW(k_merge_b, ph_merge_b(p, l, smem))
KW(k_outproj, ph_outproj(p, l, smem))
KW(k_moe_off, ph_moe_off(p, l))
KW(k_moe_gate, ph_moe_gate(p, l, smem))
KW(k_moe_up, ph_moe_up(p, l, smem))
KW(k_moe_down, ph_moe_down(p, l, smem))
KW(k_combine, ph_combine(p, l))
KW(k_final, ph_final(p))

extern "C" void kernel_launch(void* const* d_in, const int* in_sizes, int n_in, void* d_out, int out_size, void* d_ws, size_t ws_size, hipStream_t stream) {
    (void)in_sizes; (void)n_in; (void)out_size;
    P p{};
    const float* const* in = (const float* const*)d_in;
    p.x = in[0]; p.c = in[1]; p.ctx = in[2]; p.c_ctx = in[3]; p.w_ada = in[4]; p.b_ada = in[5]; p.norm1_g = in[6]; p.w_in = in[7];
    p.q_norm_g = in[8]; p.kv_norm_g = in[9]; p.w_uq = in[10]; p.w_ukv = in[11]; p.sc_w = in[12]; p.sc_b = in[13];
    p.flt_w1 = in[14]; p.flt_b1 = in[15]; p.flt_freq = in[16]; p.flt_w2 = in[17]; p.flt_b2 = in[18]; p.flt_w3 = in[19]; p.flt_bias = in[20];
    p.w_hy_o = in[21]; p.w_mla_o = in[22]; p.w_out = in[23]; p.norm2_g = in[24]; p.w_rg = in[25]; p.b_rg = in[26]; p.w_re = in[27]; p.b_re = in[28];
    p.w_gate = in[29]; p.w_up = in[30]; p.w_down = in[31]; p.final_g = in[32];
    p.out = (float*)d_out;
    size_t off = 0;
    auto alloc = [&](size_t bytes) { char* r = (char*)d_ws + off; off += (bytes + 255) & ~(size_t)255; return r; };
    p.cnt = (int*)alloc(DEPTH * 64 * 4);
    p.off = (int*)alloc(DEPTH * 65 * 4);
    const size_t zero_bytes = off;
    p.modp = (float*)alloc((size_t)DEPTH * 8 * 5 * NMOD * 4);
    p.mod = (float*)alloc((size_t)DEPTH * 5 * NMOD * 4);
    p.H2a = (float*)alloc((size_t)DEPTH * SEQ * 64 * 4);
    p.H2b = (float*)alloc((size_t)DEPTH * CTXL * 64 * 4);
    p.HT0 = (float*)alloc((size_t)DEPTH * 2048 * SEQ * 4);
    p.HT1 = (float*)alloc((size_t)DEPTH * 2048 * CTXL * 4);
    p.SSQ0 = (float*)alloc((size_t)DEPTH * 2048 * 64 * 4);
    p.SSQ1 = (float*)alloc((size_t)DEPTH * 2048 * 4 * 4);
    p.SCL0 = (float*)alloc((size_t)DEPTH * 2048 * 4);
    p.SCL1 = (float*)alloc((size_t)DEPTH * 2048 * 4);
    p.hx = (float*)alloc((size_t)TT * DM * 4);
    p.U = (bf16_t*)alloc((size_t)TT * DM * 2);
    p.PT = (bf16_t*)alloc((size_t)NB * HYC * SEQ * 2);
    p.PTc = (bf16_t*)alloc((size_t)NB * HYC * CTXL * 2);
    p.PMLA = (float*)alloc((size_t)TT * MLAW * 4);
    p.G = (bf16_t*)alloc((size_t)TT * 2048 * 2);
    p.CQ = (bf16_t*)alloc((size_t)TT * QL * 2);
    p.CKV = (bf16_t*)alloc((size_t)TT * KVL * 2);
    p.QRAW = (float*)alloc((size_t)TT * 768 * 4);
    p.Q = (bf16_t*)alloc((size_t)NB * NH * SEQ * 128 * 2);
    p.Qc = (bf16_t*)alloc((size_t)NB * NH * CTXL * 128 * 2);
    p.K = (bf16_t*)alloc((size_t)NB * NH * NKEY * DQK * 2);
    p.V = (bf16_t*)alloc((size_t)NB * NH * NKEY * DV * 2);
    p.Yatt = (bf16_t*)alloc((size_t)TT * 512 * 2);
    p.Yhy = (bf16_t*)alloc((size_t)TT * 512 * 2);
    p.M1F = (float*)alloc((size_t)TT * DM * 4);
    p.M1 = (bf16_t*)alloc((size_t)TT * DM * 2);
    p.list = (int*)alloc((size_t)NE * CAP * 4);
    p.wl = (float*)alloc((size_t)NE * CAP * 4);
    p.asg = (int*)alloc((size_t)TT * 4 * 4);
    p.HG = (float*)alloc((size_t)2 * TT * DE * 4);
    p.Hb = (bf16_t*)alloc((size_t)2 * TT * DE * 2);
    p.Y = (bf16_t*)alloc((size_t)2 * TT * DM * 2);
    if (off > ws_size) { fprintf(stderr, "kernel_launch: workspace too small: need %zu have %zu\n", off, ws_size); return; }
    static bool attr_done = false;
    if (!attr_done) {
        hipFuncSetAttribute((const void*)k_hyena_l, hipFuncAttributeMaxDynamicSharedMemorySize, 5 * SEQ * 4);
        attr_done = true;
    }
    hipMemsetAsync(d_ws, 0, zero_bytes, stream);
    const int GB = 1024;
#define L1(k, lds, l) hipLaunchKernelGGL(k, dim3(GB), dim3(NT), lds, stream, p, l)
    L1(k_copy_h, 0, 0);
    L1(k_mod_partial, 5 * 128 * 4, 0);
    L1(k_filter_a, (8 * 36 + 8 * 64) * 4, 0);
    L1(k_filter_b, 64 * 128 * 4, 0);
    L1(k_finalize, 0, 0);
    const int GEMM_LDS = (128 * 40 + 64 * 40) * 2;
    for (int l = 0; l < DEPTH; ++l) {
        L1(k_norm1, 0, l);
        L1(k_inproj, GEMM_LDS, l);
        L1(k_mla_prep, 0, l);
        L1(k_qgemm, GEMM_LDS, l);
        L1(k_kvgemm, GEMM_LDS, l);
        L1(k_qpack, 0, l);
        L1(k_attn, (64 * 104 + 64 * 72 + 8 * 16 * 72) * 2, l);
        L1(k_hyena_l, 5 * SEQ * 4, l);
        L1(k_hyena_c, 5 * CTXL * 4, l);
        L1(k_merge_a, GEMM_LDS, l);
        L1(k_merge_b, GEMM_LDS, l);
        L1(k_outproj, GEMM_LDS, l);
        L1(k_norm2, (8 * 1024 + 8 * 72) * 4, l);
        L1(k_moe_off, 0, l);
        L1(k_moe_gate, GEMM_LDS, l);
        L1(k_moe_up, GEMM_LDS, l);
        L1(k_moe_down, GEMM_LDS, l);
        L1(k_combine, 0, l);
    }
    L1(k_final, 0, 0);
}
```

```cpp
#include <hip/hip_runtime.h>
#include <stdint.h>
#include <stdio.h>

typedef unsigned short bf16_t;
typedef short bf16x8 __attribute__((ext_vector_type(8)));
typedef float f32x4 __attribute__((ext_vector_type(4)));
typedef unsigned u32x4 __attribute__((ext_vector_type(4)));
typedef unsigned u32x2 __attribute__((ext_vector_type(2)));

#define NT 512
constexpr int DM = 1024, NB = 4, SEQ = 4096, DEPTH = 4, CTXL = 256;
constexpr int TL = NB * SEQ, TC = NB * CTXL, TT = TL + TC;
constexpr int HYW = 512, HYC = 1536, QL = 384, KVL = 256, QKR = 32;
constexpr int MLAW = QL + KVL + QKR, MLA_END = HYC + MLAW, INC = MLA_END + 2 * DM;
constexpr int NH = 8, DQK = 96, DV = 64, NKEY = SEQ + CTXL;
constexpr int NE = 64, DE = 256, CAP = TT;
constexpr int NMOD = 6 * DM;
constexpr float EPSF = 1e-6f;
constexpr float QSCALE = 0.10206207261596577f * 1.4426950408889634f;

__device__ __forceinline__ bf16_t f2bf(float f) { unsigned u = __float_as_uint(f); u += 0x7FFFu + ((u >> 16) & 1u); return (bf16_t)(u >> 16); }
__device__ __forceinline__ float bf2f(bf16_t b) { return __uint_as_float(((unsigned)b) << 16); }
__device__ __forceinline__ unsigned pack2(float lo, float hi) { return (unsigned)f2bf(lo) | ((unsigned)f2bf(hi) << 16); }
__device__ __forceinline__ float wave_sum(float v) {
#pragma unroll
    for (int o = 32; o > 0; o >>= 1) v += __shfl_xor(v, o);
    return v;
}


#define XB_TMO      128
#define XB_XCNT(j)  (256  + 64 * (j))
#define XB_XSUB(j)  (1280 + 64 * (j))
#define XB_XGEN(j)  (2304 + 64 * (j))
#define XB_TOP      3328
#define XB_TOPGEN   3392
#define XCD_BAR_WORDS 3456
#define XB_SPIN_CAP (1u << 22)
#define LAS __attribute__((address_space(3)))
__device__ __forceinline__ unsigned xb_ld(unsigned* p)              { return __hip_atomic_load(p, __ATOMIC_RELAXED, __HIP_MEMORY_SCOPE_AGENT); }
__device__ __forceinline__ unsigned xb_add(unsigned* p, unsigned v) { return __hip_atomic_fetch_add(p, v, __ATOMIC_RELAXED, __HIP_MEMORY_SCOPE_AGENT); }
__device__ __forceinline__ unsigned xb_xcc_id() { return (unsigned)__builtin_amdgcn_s_getreg((3 << 11) | 20) & 0xFu; }
#define XB_SPIN(cond, bar) do { unsigned _sp = 0; while (cond) { __builtin_amdgcn_s_sleep(1); \
    if ((++_sp & 255u) == 0u) { if (xb_ld(&(bar)[XB_TMO])) break; if (_sp > XB_SPIN_CAP) { atomicAdd(&(bar)[XB_TMO], 1u); break; } } } } while (0)
struct XcdBarrier { unsigned* bar; unsigned x; volatile LAS unsigned* st; };
__device__ __forceinline__ XcdBarrier xcd_barrier_post(unsigned* bar, volatile LAS unsigned* st) {
    XcdBarrier b; b.bar = bar; b.x = xb_xcc_id(); b.st = st;
    if (threadIdx.x == 0) (void)xb_add(&bar[XB_XCNT(b.x)], 1u);
    return b;
}
__device__ __forceinline__ void xcd_barrier_complete(unsigned* bar, unsigned x, unsigned& nloc, unsigned& nx) {
    const unsigned G = gridDim.x * gridDim.y * gridDim.z;
    unsigned sum, cnt, mine, sp = 0u;
    for (;;) {
        sum = 0u; cnt = 0u; mine = 0u;
#pragma unroll
        for (unsigned j = 0; j < 16; ++j) { const unsigned c = xb_ld(&bar[XB_XCNT(j)]); sum += c; cnt += (c > 0u) ? 1u : 0u; mine = (j == x) ? c : mine; }
        if (sum == G) break;
        __builtin_amdgcn_s_sleep(1);
        if ((++sp & 255u) == 0u) { if (xb_ld(&bar[XB_TMO])) break; if (sp > XB_SPIN_CAP) { atomicAdd(&bar[XB_TMO], 1u); break; } }
    }
    nloc = mine > 0u ? mine : 1u; nx = cnt > 0u ? cnt : 1u;
}
__device__ __forceinline__ void xcd_barrier(const XcdBarrier& b) {
    asm volatile("s_waitcnt vmcnt(0)" ::: "memory");
    __syncthreads();
    if (threadIdx.x == 0) {
        unsigned* bar = b.bar;
        __builtin_amdgcn_s_waitcnt(0);
        unsigned nloc = b.st[0], nx = b.st[1];
        if (nloc == 0u) { xcd_barrier_complete(bar, b.x, nloc, nx); b.st[0] = nloc; b.st[1] = nx; }
        const unsigned old = xb_add(&bar[XB_XSUB(b.x)], 1u);
        const unsigned gen = old / nloc;
        if (old + 1u == (gen + 1u) * nloc) {
            __builtin_amdgcn_fence(__ATOMIC_RELEASE, "agent");
            asm volatile("s_waitcnt vmcnt(0)" ::: "memory");
            const unsigned og = xb_add(&bar[XB_TOP], 1u);
            const unsigned tg = og / nx;
            if (og + 1u == (tg + 1u) * nx) xb_add(&bar[XB_TOPGEN], 1u);
            else XB_SPIN(xb_ld(&bar[XB_TOPGEN]) == tg, bar);
            __builtin_amdgcn_fence(__ATOMIC_ACQUIRE, "agent");
            xb_add(&bar[XB_XGEN(b.x)], 1u);
            asm volatile("s_waitcnt vmcnt(0)" ::: "memory");
        } else {
            XB_SPIN(xb_ld(&bar[XB_XGEN(b.x)]) == gen, bar);
            __builtin_amdgcn_fence(__ATOMIC_ACQUIRE, "agent");
            asm volatile("s_waitcnt vmcnt(0)" ::: "memory");
        }
    }
    __syncthreads();
}

struct P {
    const float *x, *c, *ctx, *c_ctx, *w_ada, *b_ada, *norm1_g, *w_in, *q_norm_g, *kv_norm_g, *w_uq, *w_ukv, *sc_w, *sc_b;
    const float *flt_w1, *flt_b1, *flt_freq, *flt_w2, *flt_b2, *flt_w3, *flt_bias, *w_hy_o, *w_mla_o, *w_out, *norm2_g;
    const float *w_rg, *b_rg, *w_re, *b_re, *w_gate, *w_up, *w_down, *final_g;
    float* out;
    unsigned* bar;
    int* cnt;
    int* off;
    float* modp;
    float* mod;
    float* H2a;
    float* H2b;
    float* HT0;
    float* HT1;
    float* SSQ0;
    float* SSQ1;
    float* SCL0;
    float* SCL1;
    float* hx;
    bf16_t* U;
    bf16_t* PT;
    bf16_t* PTc;
    float* PMLA;
    bf16_t* G;
    bf16_t* CQ;
    bf16_t* CKV;
    float* QRAW;
    bf16_t* Q;
    bf16_t* Qc;
    bf16_t* K;
    bf16_t* V;
    bf16_t* Yatt;
    bf16_t* Yhy;
    float* M1F;
    bf16_t* M1;
    int* list;
    float* wl;
    int* asg;
    float* HG;
    bf16_t* Hb;
    bf16_t* Y;
};

__device__ __forceinline__ void ph_copy_h(const P& p) {
    const size_t n4 = (size_t)TT * DM / 4, nl4 = (size_t)TL * DM / 4;
    for (size_t i = (size_t)blockIdx.x * NT + threadIdx.x; i < n4; i += (size_t)gridDim.x * NT) {
        float4 v = (i < nl4) ? ((const float4*)p.x)[i] : ((const float4*)p.ctx)[i - nl4];
        ((float4*)p.hx)[i] = v;
    }
}

__device__ __forceinline__ void ph_mod_partial(const P& p, char* smem) {
    float* s = (float*)smem;
    const int tid = threadIdx.x;
    for (int it = blockIdx.x; it < DEPTH * 8 * 12; it += gridDim.x) {
        const int l = it / 96, kc = (it / 12) % 8, jb = it % 12;
        __syncthreads();
        for (int i = tid; i < 5 * 128; i += NT) {
            const int r = i / 128, kk = i % 128, k = kc * 128 + kk;
            const float cv = (r < 4) ? p.c[r * DM + k] : p.c_ctx[k];
            s[i] = cv / (1.0f + expf(-cv));
        }
        __syncthreads();
        const int j = jb * 512 + tid;
        float a0 = 0, a1 = 0, a2 = 0, a3 = 0, a4 = 0;
        const float* w = p.w_ada + ((size_t)l * DM + kc * 128) * NMOD + j;
#pragma unroll 8
        for (int kk = 0; kk < 128; ++kk) {
            const float wv = w[(size_t)kk * NMOD];
            a0 += s[kk] * wv; a1 += s[128 + kk] * wv; a2 += s[256 + kk] * wv; a3 += s[384 + kk] * wv; a4 += s[512 + kk] * wv;
        }
        float* o = p.modp + ((size_t)(l * 8 + kc) * 5) * NMOD + j;
        o[0] = a0; o[NMOD] = a1; o[2 * NMOD] = a2; o[3 * NMOD] = a3; o[4 * NMOD] = a4;
    }
}

__device__ __forceinline__ void ph_filter_a(const P& p, char* smem) {
    float* zs = (float*)smem;
    float* h1s = zs + 8 * 36;
    const int tid = threadIdx.x, tt = tid >> 6, j = tid & 63;
    const int n0 = DEPTH * 512, n1 = DEPTH * 32;
    for (int it = blockIdx.x; it < n0 + n1; it += gridDim.x) {
        int l, ls, tg;
        if (it < n0) { ls = 0; l = it / 512; tg = it % 512; } else { ls = 1; l = (it - n0) / 32; tg = (it - n0) % 32; }
        const int L = ls ? CTXL : SEQ;
        const int t = tg * 8 + tt;
        __syncthreads();
        if (j < 33) {
            float f;
            if (j == 0) f = (float)t / (float)(L - 1);
            else {
                const int k = (j - 1) & 15;
                const float band = 1e-4f + (float)k * ((15.0f - 1e-4f) / 15.0f);
                const float w = 6.283185307179586f * (float)t / (float)L;
                const double ang = (double)band * (double)w;
                f = (j <= 16) ? (float)cos(ang) : (float)(-sin(ang));
            }
            zs[tt * 36 + j] = f;
        }
        __syncthreads();
        const float fr = p.flt_freq[l * 64 + j];
        float a = p.flt_b1[l * 64 + j];
        for (int i = 0; i < 33; ++i) a += zs[tt * 36 + i] * p.flt_w1[((size_t)l * 33 + i) * 64 + j];
        h1s[tt * 64 + j] = sinf(fr * a);
        __syncthreads();
        float a2 = p.flt_b2[l * 64 + j];
        for (int i = 0; i < 64; ++i) a2 += h1s[tt * 64 + i] * p.flt_w2[((size_t)l * 64 + i) * 64 + j];
        const float h2 = sinf(fr * a2);
        if (ls == 0) p.H2a[((size_t)l * SEQ + t) * 64 + j] = h2; else p.H2b[((size_t)l * CTXL + t) * 64 + j] = h2;
    }
}

__device__ __forceinline__ void ph_filter_b(const P& p, char* smem) {
    float* w3s = (float*)smem;
    const int tid = threadIdx.x, lane = tid & 63, wv = tid >> 6;
    const int n0 = DEPTH * 8 * 16, n1 = DEPTH * 16;
    const float DA = -15.350567286626973f, DB = -3.0701134573253946f;
    for (int it = blockIdx.x; it < n0 + n1; it += gridDim.x) {
        int l, ls, tc, cc;
        if (it < n0) { ls = 0; l = it / 128; tc = (it / 16) % 8; cc = it % 16; } else { ls = 1; l = (it - n0) / 16; tc = 0; cc = (it - n0) % 16; }
        const int L = ls ? CTXL : SEQ;
        __syncthreads();
        for (int i = tid; i < 64 * 128; i += NT) { const int jj = i >> 7, c = i & 127; w3s[i] = p.flt_w3[((size_t)l * 64 + jj) * 2048 + cc * 128 + c]; }
        __syncthreads();
        int t, cbeg, cend;
        if (ls == 0) { t = tc * 512 + tid; cbeg = 0; cend = 128; } else { t = tid & 255; cbeg = (tid >> 8) * 64; cend = cbeg + 64; }
        const float* h2 = ls ? p.H2b + ((size_t)l * CTXL + t) * 64 : p.H2a + ((size_t)l * SEQ + t) * 64;
        float h[64];
#pragma unroll
        for (int jj = 0; jj < 64; jj += 4) { const float4 v = *(const float4*)(h2 + jj); h[jj] = v.x; h[jj + 1] = v.y; h[jj + 2] = v.z; h[jj + 3] = v.w; }
        const float tl = (float)t / (float)(L - 1);
        for (int c = cbeg; c < cend; ++c) {
            float acc = 0.f;
#pragma unroll
            for (int jj = 0; jj < 64; ++jj) acc += h[jj] * w3s[jj * 128 + c];
            const int col = cc * 128 + c, ch = col & 511;
            const float delta = fabsf(DA + (float)ch * ((DB - DA) / 511.0f));
            const float v = acc * expf(-tl * delta);
            if (ls == 0) p.HT0[((size_t)l * 2048 + col) * SEQ + t] = v; else p.HT1[((size_t)l * 2048 + col) * CTXL + t] = v;
            const float q = wave_sum(v * v);
            if (lane == 0) { if (ls == 0) p.SSQ0[((size_t)l * 2048 + col) * 64 + tc * 8 + wv] = q; else p.SSQ1[((size_t)l * 2048 + col) * 4 + (wv & 3)] = q; }
        }
    }
}

__device__ __forceinline__ void ph_finalize(const P& p) {
    const int n_mod = DEPTH * 5 * NMOD, n_s = DEPTH * 2048;
    for (int i = blockIdx.x * NT + threadIdx.x; i < n_mod + 2 * n_s; i += gridDim.x * NT) {
        if (i < n_mod) {
            const int l = i / (5 * NMOD), r = (i / NMOD) % 5, j = i % NMOD;
            float a = p.b_ada[l * NMOD + j];
            for (int kc = 0; kc < 8; ++kc) a += p.modp[((size_t)(l * 8 + kc) * 5 + r) * NMOD + j];
            p.mod[i] = a;
        } else if (i < n_mod + n_s) {
            const int k = i - n_mod; float a = 0.f;
            for (int q = 0; q < 64; ++q) a += p.SSQ0[(size_t)k * 64 + q];
            p.SCL0[k] = rsqrtf(a + EPSF);
        } else {
            const int k = i - n_mod - n_s; float a = 0.f;
            for (int q = 0; q < 4; ++q) a += p.SSQ1[(size_t)k * 4 + q];
            p.SCL1[k] = rsqrtf(a + EPSF);
        }
    }
}

template <int WHICH>
__device__ __forceinline__ void ph_norm(const P& p, int l, char* smem) {
    float* rowbuf = (float*)smem;
    float* lgs = rowbuf + 8 * 1024;
    const int tid = threadIdx.x, lane = tid & 63, wv = tid >> 6;
    const float* ng = (WHICH == 1 ? p.norm1_g : p.norm2_g) + l * DM;
    for (int rb = blockIdx.x * 8; rb < TT; rb += gridDim.x * 8) {
        const int row = rb + wv;
        const int b = row < TL ? (row >> 12) : 4;
        const float* hp = p.hx + (size_t)row * DM;
        const float* md = p.mod + ((size_t)l * 5 + b) * NMOD + (WHICH == 1 ? 0 : 3 * DM);
        float4 xv[4]; float ss = 0.f;
#pragma unroll
        for (int i = 0; i < 4; ++i) { xv[i] = *(const float4*)(hp + i * 256 + lane * 4); ss += xv[i].x * xv[i].x + xv[i].y * xv[i].y + xv[i].z * xv[i].z + xv[i].w * xv[i].w; }
        ss = wave_sum(ss);
        const float rs = rsqrtf(ss * (1.0f / DM) + EPSF);
#pragma unroll
        for (int i = 0; i < 4; ++i) {
            const int j = i * 256 + lane * 4;
            const float4 g = *(const float4*)(ng + j), sh = *(const float4*)(md + j), sc = *(const float4*)(md + DM + j);
            float4 y;
            y.x = (xv[i].x * rs * g.x) * (1.f + sc.x) + sh.x; y.y = (xv[i].y * rs * g.y) * (1.f + sc.y) + sh.y;
            y.z = (xv[i].z * rs * g.z) * (1.f + sc.z) + sh.z; y.w = (xv[i].w * rs * g.w) * (1.f + sc.w) + sh.w;
            u32x2 o; o.x = pack2(y.x, y.y); o.y = pack2(y.z, y.w);
            *(u32x2*)(p.U + (size_t)row * DM + j) = o;
            if (WHICH == 2) *(float4*)(rowbuf + wv * 1024 + j) = y;
        }
        if (WHICH == 2) {
            __syncthreads();
            const float* wre = p.w_re + (size_t)l * DM * NE + lane;
            const float* wrg = p.w_rg + (size_t)l * DM * 8 + (lane & 7);
            float ae = 0.f, ag = 0.f;
            const float* rbp = rowbuf + wv * 1024;
#pragma unroll 8
            for (int k = 0; k < DM; ++k) { const float tv = rbp[k]; ae += tv * wre[(size_t)k * NE]; ag += tv * wrg[(size_t)k * 8]; }
            lgs[wv * 72 + 8 + lane] = ae;
            if (lane < 8) lgs[wv * 72 + lane] = ag;
            __syncthreads();
            if (lane == 0) {
                const float* lg = lgs + wv * 72; const float* le = lg + 8;
                int gs = 0; float best = lg[0] + p.b_rg[l * 8], mx = lg[0];
                for (int i = 1; i < 8; ++i) { const float v = lg[i] + p.b_rg[l * 8 + i]; if (v > best) { best = v; gs = i; } mx = fmaxf(mx, lg[i]); }
                float den = 0.f;
                for (int i = 0; i < 8; ++i) den += expf(lg[i] - mx);
                const float pg = expf(lg[gs] - mx) / den;
                int i0 = 0; float k0 = le[gs * 8] + p.b_re[l * NE + gs * 8];
                for (int i = 1; i < 8; ++i) { const float v = le[gs * 8 + i] + p.b_re[l * NE + gs * 8 + i]; if (v > k0) { k0 = v; i0 = i; } }
                int i1 = -1; float k1 = 0.f;
                for (int i = 0; i < 8; ++i) { if (i == i0) continue; const float v = le[gs * 8 + i] + p.b_re[l * NE + gs * 8 + i]; if (i1 < 0 || v > k1) { k1 = v; i1 = i; } }
                const float w0 = 1.0f / (1.0f + expf(le[gs * 8 + i1] - le[gs * 8 + i0])), w1 = 1.0f - w0;
                const int e0 = gs * 8 + i0, e1 = gs * 8 + i1;
                const int r0 = atomicAdd(p.cnt + l * NE + e0, 1), r1 = atomicAdd(p.cnt + l * NE + e1, 1);
                p.list[(size_t)e0 * CAP + r0] = row; p.wl[(size_t)e0 * CAP + r0] = pg * w0;
                p.list[(size_t)e1 * CAP + r1] = row; p.wl[(size_t)e1 * CAP + r1] = pg * w1;
                *(int4*)(p.asg + (size_t)row * 4) = make_int4(e0, r0, e1, r1);
            }
            __syncthreads();
        }
    }
}

template <bool A_F32, class Epi>
__device__ __forceinline__ void gemm_tiles(char* smem, const void* Av, int lda, const int* arow, int M, const float* B, int ldb, int N, int K, const Epi& epi) {
    bf16_t* sA = (bf16_t*)smem;
    bf16_t* sB = sA + 128 * 40;
    const int tid = threadIdx.x, lane = tid & 63, wv = tid >> 6, wm = wv >> 1, wn = wv & 1, fr = lane & 15, fq = lane >> 4;
    const int tm = (M + 127) / 128, tn = (N + 63) / 64;
    for (int u = blockIdx.x; u < tm * tn; u += gridDim.x) {
        const int m0 = (u / tn) * 128, n0 = (u % tn) * 64;
        f32x4 acc[2][2];
#pragma unroll
        for (int a = 0; a < 2; ++a)
#pragma unroll
            for (int b = 0; b < 2; ++b) acc[a][b] = (f32x4){0.f, 0.f, 0.f, 0.f};
        const int ar = tid >> 2, ak = (tid & 3) * 8, gr = m0 + ar;
        long asrc = -1; if (gr < M) asrc = arow ? (long)arow[gr] : (long)gr;
        const int bk = tid >> 4, bn = (tid & 15) * 4, gcol = n0 + bn;
        for (int k0 = 0; k0 < K; k0 += 32) {
            u32x4 av = (u32x4){0u, 0u, 0u, 0u};
            if (asrc >= 0) {
                if (A_F32) {
                    const float* ap = (const float*)Av + asrc * lda + k0 + ak;
                    const float4 x0 = *(const float4*)ap, x1 = *(const float4*)(ap + 4);
                    av.x = pack2(x0.x, x0.y); av.y = pack2(x0.z, x0.w); av.z = pack2(x1.x, x1.y); av.w = pack2(x1.z, x1.w);
                } else av = *(const u32x4*)((const bf16_t*)Av + asrc * lda + k0 + ak);
            }
            float4 bv = make_float4(0.f, 0.f, 0.f, 0.f);
            if (gcol < N) bv = *(const float4*)(B + (size_t)(k0 + bk) * ldb + gcol);
            __syncthreads();
            *(u32x4*)(sA + ar * 40 + ak) = av;
            sB[(bn + 0) * 40 + bk] = f2bf(bv.x); sB[(bn + 1) * 40 + bk] = f2bf(bv.y); sB[(bn + 2) * 40 + bk] = f2bf(bv.z); sB[(bn + 3) * 40 + bk] = f2bf(bv.w);
            __syncthreads();
            bf16x8 a[2], b[2];
#pragma unroll
            for (int i = 0; i < 2; ++i) { a[i] = *(const bf16x8*)(sA + (wm * 32 + i * 16 + fr) * 40 + fq * 8); b[i] = *(const bf16x8*)(sB + (wn * 32 + i * 16 + fr) * 40 + fq * 8); }
#pragma unroll
            for (int mi = 0; mi < 2; ++mi)
#pragma unroll
                for (int ni = 0; ni < 2; ++ni) acc[mi][ni] = __builtin_amdgcn_mfma_f32_16x16x32_bf16(a[mi], b[ni], acc[mi][ni], 0, 0, 0);
        }
#pragma unroll
        for (int mi = 0; mi < 2; ++mi)
#pragma unroll
            for (int ni = 0; ni < 2; ++ni)
#pragma unroll
                for (int j = 0; j < 4; ++j) {
                    const int row = m0 + wm * 32 + mi * 16 + fq * 4 + j, col = n0 + wn * 32 + ni * 16 + fr;
                    if (row < M && col < N) epi(row, col, acc[mi][ni][j]);
                }
    }
}

__device__ __forceinline__ void ph_inproj(const P& p, int l, char* smem) {
    auto epi = [&](int row, int col, float v) {
        if (col < HYC) {
            if (row < TL) p.PT[((size_t)(row >> 12) * HYC + col) * SEQ + (row & 4095)] = f2bf(v);
            else { const int r = row - TL; p.PTc[((size_t)(r >> 8) * HYC + col) * CTXL + (r & 255)] = f2bf(v); }
        } else if (col < MLA_END) p.PMLA[(size_t)row * MLAW + col - HYC] = v;
        else p.G[(size_t)row * 2048 + col - MLA_END] = f2bf(1.0f / (1.0f + expf(-v)));
    };
    gemm_tiles<false>(smem, p.U, DM, nullptr, TT, p.w_in + (size_t)l * DM * INC, INC, INC, DM, epi);
}

__device__ __forceinline__ float rope_apply(float self, float partner, int d, int t) {
    const int a = d >> 4, s = (d >> 3) & 1, i = d & 7;
    const float pos = (float)(a == 0 ? (t >> 6) : (t & 63));
    const float inv = powf(10000.0f, -(float)i / 8.0f);
    const float ang = pos * inv;
    const float cs = cosf(ang), sn = sinf(ang);
    return s == 0 ? self * cs - partner * sn : partner * sn + self * cs;
}

__device__ __forceinline__ void ph_mla_prep(const P& p, int l) {
    const int tid = threadIdx.x, lane = tid & 63, wv = tid >> 6;
    for (int rb = blockIdx.x * 8; rb < TT; rb += gridDim.x * 8) {
        const int row = rb + wv;
        const float* pm = p.PMLA + (size_t)row * MLAW;
        float q[6], ss = 0.f;
#pragma unroll
        for (int i = 0; i < 6; ++i) { q[i] = pm[lane + 64 * i]; ss += q[i] * q[i]; }
        ss = wave_sum(ss);
        float rs = rsqrtf(ss * (1.0f / QL) + EPSF);
#pragma unroll
        for (int i = 0; i < 6; ++i) p.CQ[(size_t)row * QL + lane + 64 * i] = f2bf(q[i] * rs * p.q_norm_g[l * QL + lane + 64 * i]);
        float kv[4]; ss = 0.f;
#pragma unroll
        for (int i = 0; i < 4; ++i) { kv[i] = pm[QL + lane + 64 * i]; ss += kv[i] * kv[i]; }
        ss = wave_sum(ss);
        rs = rsqrtf(ss * (1.0f / KVL) + EPSF);
#pragma unroll
        for (int i = 0; i < 4; ++i) p.CKV[(size_t)row * KVL + lane + 64 * i] = f2bf(kv[i] * rs * p.kv_norm_g[l * KVL + lane + 64 * i]);
        const int d = lane & 31;
        const float self = pm[QL + KVL + d];
        const float partner = __shfl_xor(self, 8);
        int b, key; float val;
        if (row < TL) { b = row >> 12; const int t = row & 4095; key = t; val = rope_apply(self, partner, d, t); }
        else { const int r = row - TL; b = r >> 8; key = SEQ + (r & 255); val = self; }
        if (lane < 32) {
            const bf16_t o = f2bf(val);
#pragma unroll
            for (int h = 0; h < NH; ++h) p.K[((size_t)(b * NH + h) * NKEY + key) * DQK + 64 + d] = o;
        }
    }
}

__device__ __forceinline__ void ph_qgemm(const P& p, int l, char* smem) {
    auto epi = [&](int row, int col, float v) { p.QRAW[(size_t)row * 768 + col] = v; };
    gemm_tiles<false>(smem, p.CQ, QL, nullptr, TT, p.w_uq + (size_t)l * QL * 768, 768, 768, QL, epi);
}
__device__ __forceinline__ void ph_kvgemm(const P& p, int l, char* smem) {
    auto epi = [&](int row, int col, float v) {
        const int h = col >> 7, d = col & 127;
        int b, key;
        if (row < TL) { b = row >> 12; key = row & 4095; } else { const int r = row - TL; b = r >> 8; key = SEQ + (r & 255); }
        if (d < 64) p.K[((size_t)(b * NH + h) * NKEY + key) * DQK + d] = f2bf(v);
        else p.V[((size_t)(b * NH + h) * NKEY + key) * DV + d - 64] = f2bf(v);
    };
    gemm_tiles<false>(smem, p.CKV, KVL, nullptr, TT, p.w_ukv + (size_t)l * KVL * 1024, 1024, 1024, KVL, epi);
}
__device__ __forceinline__ void ph_qpack(const P& p) {
    const size_t n = (size_t)TT * NH * 128;
    for (size_t i = (size_t)blockIdx.x * NT + threadIdx.x; i < n; i += (size_t)gridDim.x * NT) {
        const int dd = (int)(i & 127), h = (int)((i >> 7) & 7), row = (int)(i >> 10);
        const float* qr = p.QRAW + (size_t)row * 768 + h * 96;
        float v;
        if (dd < 64) v = qr[dd];
        else if (dd < 96) { const int d = dd - 64; v = (row < TL) ? rope_apply(qr[64 + d], qr[64 + (d ^ 8)], d, row & 4095) : qr[64 + d]; }
        else v = qr[64 + dd - 96];
        v *= QSCALE;
        if (row < TL) p.Q[((size_t)((row >> 12) * NH + h) * SEQ + (row & 4095)) * 128 + dd] = f2bf(v);
        else { const int r = row - TL; p.Qc[((size_t)((r >> 8) * NH + h) * CTXL + (r & 255)) * 128 + dd] = f2bf(v); }
    }
}

__device__ __forceinline__ void ph_attn(const P& p, char* smem) {
    bf16_t* sK = (bf16_t*)smem;
    bf16_t* sVt = sK + 64 * 104;
    bf16_t* sP = sVt + 64 * 72;
    const int tid = threadIdx.x, lane = tid & 63, wv = tid >> 6, fr = lane & 15, fq = lane >> 4;
    bf16_t* sPw = sP + wv * 16 * 72;
    const int NUL = NB * NH * 32, NUC = NB * NH * 2;
    for (int u = blockIdx.x; u < NUL + NUC; u += gridDim.x) {
        const bool isctx = u >= NUL;
        int b, h, q0;
        if (!isctx) { b = u / (NH * 32); h = (u / 32) % NH; q0 = (u % 32) * 128; } else { const int v = u - NUL; b = v / (NH * 2); h = (v / 2) % NH; q0 = (v % 2) * 128; }
        const bf16_t* Qp = isctx ? p.Qc + ((size_t)(b * NH + h) * CTXL + q0) * 128 : p.Q + ((size_t)(b * NH + h) * SEQ + q0) * 128;
        bf16x8 qa[4];
#pragma unroll
        for (int ks = 0; ks < 4; ++ks) qa[ks] = *(const bf16x8*)(Qp + (size_t)(wv * 16 + fr) * 128 + ks * 32 + fq * 8);
        const bf16_t* Kp = p.K + (size_t)(b * NH + h) * NKEY * DQK;
        const bf16_t* Vp = p.V + (size_t)(b * NH + h) * NKEY * DV;
        f32x4 o[4]; float m[4], lsum[4];
#pragma unroll
        for (int i = 0; i < 4; ++i) { o[i] = (f32x4){0.f, 0.f, 0.f, 0.f}; m[i] = -INFINITY; lsum[i] = 0.f; }
        for (int kt = isctx ? 64 : 0; kt < 68; ++kt) {
            __syncthreads();
            for (int i = tid; i < 768; i += NT) { const int key = i / 12, part = i % 12; *(u32x4*)(sK + key * 104 + part * 8) = *(const u32x4*)(Kp + (size_t)(kt * 64 + key) * DQK + part * 8); }
            {
                const int key = tid >> 3, d0 = (tid & 7) * 8;
                const bf16x8 vv = *(const bf16x8*)(Vp + (size_t)(kt * 64 + key) * DV + d0);
#pragma unroll
                for (int i = 0; i < 8; ++i) sVt[(d0 + i) * 72 + key] = (bf16_t)vv[i];
            }
            __syncthreads();
            f32x4 s[4];
#pragma unroll
            for (int nt = 0; nt < 4; ++nt) {
                s[nt] = (f32x4){0.f, 0.f, 0.f, 0.f};
#pragma unroll
                for (int ks = 0; ks < 3; ++ks) {
                    const bf16x8 a = (ks < 2) ? qa[ks] : (kt >= 64 ? qa[3] : qa[2]);
                    const bf16x8 bb = *(const bf16x8*)(sK + (nt * 16 + fr) * 104 + ks * 32 + fq * 8);
                    s[nt] = __builtin_amdgcn_mfma_f32_16x16x32_bf16(a, bb, s[nt], 0, 0, 0);
                }
            }
#pragma unroll
            for (int j = 0; j < 4; ++j) {
                float mx = fmaxf(fmaxf(s[0][j], s[1][j]), fmaxf(s[2][j], s[3][j]));
                mx = fmaxf(mx, __shfl_xor(mx, 1)); mx = fmaxf(mx, __shfl_xor(mx, 2)); mx = fmaxf(mx, __shfl_xor(mx, 4)); mx = fmaxf(mx, __shfl_xor(mx, 8));
                const float mn = fmaxf(m[j], mx);
                const float alpha = exp2f(m[j] - mn);
                m[j] = mn;
                float rsum = 0.f;
#pragma unroll
                for (int nt = 0; nt < 4; ++nt) { const float pv = exp2f(s[nt][j] - mn); rsum += pv; sPw[(fq * 4 + j) * 72 + nt * 16 + fr] = f2bf(pv); }
                rsum += __shfl_xor(rsum, 1); rsum += __shfl_xor(rsum, 2); rsum += __shfl_xor(rsum, 4); rsum += __shfl_xor(rsum, 8);
                lsum[j] = lsum[j] * alpha + rsum;
#pragma unroll
                for (int nt = 0; nt < 4; ++nt) o[nt][j] *= alpha;
            }
            __syncthreads();
#pragma unroll
            for (int ks = 0; ks < 2; ++ks) {
                const bf16x8 a = *(const bf16x8*)(sPw + fr * 72 + ks * 32 + fq * 8);
#pragma unroll
                for (int nt = 0; nt < 4; ++nt) {
                    const bf16x8 bb = *(const bf16x8*)(sVt + (nt * 16 + fr) * 72 + ks * 32 + fq * 8);
                    o[nt] = __builtin_amdgcn_mfma_f32_16x16x32_bf16(a, bb, o[nt], 0, 0, 0);
                }
            }
        }
        const size_t rbase = (isctx ? (size_t)TL + b * CTXL : (size_t)b * SEQ) + q0 + wv * 16 + fq * 4;
#pragma unroll
        for (int j = 0; j < 4; ++j) {
            const float inv = 1.0f / lsum[j];
#pragma unroll
            for (int nt = 0; nt < 4; ++nt) p.Yatt[(rbase + j) * 512 + h * 64 + nt * 16 + fr] = f2bf(o[nt][j] * inv);
        }
    }
}

template <int L>
__device__ __forceinline__ void ph_hyena(const P& p, int l, char* smem) {
    constexpr int NOUT = (L >= NT) ? L / NT : 1;
    float* kern0 = (float*)smem;
    float* kern1 = kern0 + 2 * L;
    float* zb = kern1 + 2 * L;
    const int tid = threadIdx.x;
    const bool active = tid < L;
    const int tb = active ? tid : 0;
    const bf16_t* PTb = (L == SEQ) ? p.PT : p.PTc;
    const float* HT = (L == SEQ) ? p.HT0 + (size_t)l * 2048 * SEQ : p.HT1 + (size_t)l * 2048 * CTXL;
    const float* SCL = ((L == SEQ) ? p.SCL0 : p.SCL1) + l * 2048;
    for (int u = blockIdx.x; u < NB * HYW; u += gridDim.x) {
        const int b = u / HYW, c = u % HYW;
        __syncthreads();
        for (int i = tid; i < 2 * L; i += NT) {
            const int d = i - L;
            float k0, k1;
            if (d >= 0) { k0 = HT[(size_t)(0 * 1024 + c) * L + d] * SCL[c]; k1 = HT[(size_t)(1 * 1024 + c) * L + d] * SCL[1024 + c]; }
            else if (d > -L) { k0 = HT[(size_t)(0 * 1024 + 512 + c) * L + (size_t)(-d)] * SCL[512 + c]; k1 = HT[(size_t)(1 * 1024 + 512 + c) * L + (size_t)(-d)] * SCL[1536 + c]; }
            else { k0 = 0.f; k1 = 0.f; }
            kern0[i] = k0; kern1[i] = k1;
        }
        float uv[3][NOUT];
#pragma unroll
        for (int w = 0; w < 3; ++w) {
            const int col = w * HYW + c;
            const bf16_t* pr = PTb + ((size_t)b * HYC + col) * L;
            const float w0 = p.sc_w[(size_t)(l * 3 + 0) * HYC + col], w1 = p.sc_w[(size_t)(l * 3 + 1) * HYC + col], w2 = p.sc_w[(size_t)(l * 3 + 2) * HYC + col], bb = p.sc_b[l * HYC + col];
#pragma unroll
            for (int i = 0; i < NOUT; ++i) {
                const int t = tb + i * NT;
                const float pm1 = t > 0 ? bf2f(pr[t - 1]) : 0.f, p0 = bf2f(pr[t]), pp1 = t < L - 1 ? bf2f(pr[t + 1]) : 0.f;
                uv[w][i] = bb + w0 * pm1 + w1 * p0 + w2 * pp1;
            }
        }
        if (active) {
#pragma unroll
            for (int i = 0; i < NOUT; ++i) zb[tb + i * NT] = uv[0][i];
        }
        __syncthreads();
        float acc[NOUT];
#pragma unroll
        for (int i = 0; i < NOUT; ++i) acc[i] = 0.f;
        for (int s = 0; s < L; ++s) {
            const float zs = zb[s];
#pragma unroll
            for (int i = 0; i < NOUT; ++i) acc[i] += zs * kern0[tb + i * NT - s + L];
        }
        const float bias0 = p.flt_bias[(l * 2 + 0) * HYW + c], bias1 = p.flt_bias[(l * 2 + 1) * HYW + c];
        float z1[NOUT];
#pragma unroll
        for (int i = 0; i < NOUT; ++i) z1[i] = uv[1][i] * (acc[i] + bias0 * uv[0][i]);
        __syncthreads();
        if (active) {
#pragma unroll
            for (int i = 0; i < NOUT; ++i) zb[tb + i * NT] = z1[i];
        }
        __syncthreads();
#pragma unroll
        for (int i = 0; i < NOUT; ++i) acc[i] = 0.f;
        for (int s = 0; s < L; ++s) {
            const float zs = zb[s];
#pragma unroll
            for (int i = 0; i < NOUT; ++i) acc[i] += zs * kern1[tb + i * NT - s + L];
        }
        if (active) {
            const size_t rbase = (L == SEQ) ? (size_t)b * SEQ : (size_t)TL + b * CTXL;
#pragma unroll
            for (int i = 0; i < NOUT; ++i) p.Yhy[(rbase + tb + i * NT) * HYW + c] = f2bf(uv[2][i] * (acc[i] + bias1 * z1[i]));
        }
    }
}

__device__ __forceinline__ void ph_merge_a(const P& p, int l, char* smem) {
    auto epi = [&](int row, int col, float v) { p.M1F[(size_t)row * DM + col] = bf2f(p.G[(size_t)row * 2048 + col]) * v; };
    gemm_tiles<false>(smem, p.Yhy, HYW, nullptr, TT, p.w_hy_o + (size_t)l * HYW * DM, DM, DM, HYW, epi);
}
__device__ __forceinline__ void ph_merge_b(const P& p, int l, char* smem) {
    auto epi = [&](int row, int col, float v) { p.M1[(size_t)row * DM + col] = f2bf(p.M1F[(size_t)row * DM + col] + bf2f(p.G[(size_t)row * 2048 + DM + col]) * v); };
    gemm_tiles<false>(smem, p.Yatt, 512, nullptr, TT, p.w_mla_o + (size_t)l * 512 * DM, DM, DM, 512, epi);
}
__device__ __forceinline__ void ph_outproj(const P& p, int l, char* smem) {
    auto epi = [&](int row, int col, float v) {
        const int b = row < TL ? (row >> 12) : 4;
        p.hx[(size_t)row * DM + col] += p.mod[((size_t)l * 5 + b) * NMOD + 2 * DM + col] * v;
    };
    gemm_tiles<false>(smem, p.M1, DM, nullptr, TT, p.w_out + (size_t)l * DM * DM, DM, DM, DM, epi);
}
__device__ __forceinline__ void ph_moe_off(const P& p, int l) {
    if (blockIdx.x == 0 && threadIdx.x == 0) { int a = 0; for (int e = 0; e < NE; ++e) { p.off[l * 65 + e] = a; a += p.cnt[l * NE + e]; } p.off[l * 65 + 64] = a; }
}
__device__ __forceinline__ void ph_moe_gate(const P& p, int l, char* smem, const int* offs) {
    for (int e = 0; e < NE; ++e) {
        const int M = p.cnt[l * NE + e], o = offs[e];
        auto epi = [&](int row, int col, float v) { p.HG[(size_t)(o + row) * DE + col] = v; };
        gemm_tiles<false>(smem, p.U, DM, p.list + (size_t)e * CAP, M, p.w_gate + (size_t)(l * NE + e) * DM * DE, DE, DE, DM, epi);
    }
}
__device__ __forceinline__ void ph_moe_up(const P& p, int l, char* smem, const int* offs) {
    for (int e = 0; e < NE; ++e) {
        const int M = p.cnt[l * NE + e], o = offs[e];
        auto epi = [&](int row, int col, float v) { const float g = p.HG[(size_t)(o + row) * DE + col]; p.Hb[(size_t)(o + row) * DE + col] = f2bf(g / (1.0f + expf(-g)) * v); };
        gemm_tiles<false>(smem, p.U, DM, p.list + (size_t)e * CAP, M, p.w_up + (size_t)(l * NE + e) * DM * DE, DE, DE, DM, epi);
    }
}
__device__ __forceinline__ void ph_moe_down(const P& p, int l, char* smem, const int* offs) {
    for (int e = 0; e < NE; ++e) {
        const int M = p.cnt[l * NE + e], o = offs[e];
        auto epi = [&](int row, int col, float v) { p.Y[(size_t)(o + row) * DM + col] = f2bf(v * p.wl[(size_t)e * CAP + row]); };
        gemm_tiles<false>(smem, p.Hb + (size_t)o * DE, DE, nullptr, M, p.w_down + (size_t)(l * NE + e) * DE * DM, DM, DM, DE, epi);
    }
}
__device__ __forceinline__ void ph_combine(const P& p, int l, const int* offs) {
    const int tid = threadIdx.x, lane = tid & 63, wv = tid >> 6;
    for (int rb = blockIdx.x * 8; rb < TT; rb += gridDim.x * 8) {
        const int row = rb + wv;
        const int b = row < TL ? (row >> 12) : 4;
        const int4 a = *(const int4*)(p.asg + (size_t)row * 4);
        const size_t s0 = (size_t)offs[a.x] + a.y, s1 = (size_t)offs[a.z] + a.w;
        const float* g2 = p.mod + ((size_t)l * 5 + b) * NMOD + 5 * DM;
#pragma unroll
        for (int i = 0; i < 4; ++i) {
            const int j = i * 256 + lane * 4;
            float4 hv = *(float4*)(p.hx + (size_t)row * DM + j);
            const u32x2 y0 = *(const u32x2*)(p.Y + s0 * DM + j), y1 = *(const u32x2*)(p.Y + s1 * DM + j);
            const float4 g = *(const float4*)(g2 + j);
            hv.x += g.x * (__uint_as_float(y0.x << 16) + __uint_as_float(y1.x << 16));
            hv.y += g.y * (__uint_as_float(y0.x & 0xFFFF0000u) + __uint_as_float(y1.x & 0xFFFF0000u));
            hv.z += g.z * (__uint_as_float(y0.y << 16) + __uint_as_float(y1.y << 16));
            hv.w += g.w * (__uint_as_float(y0.y & 0xFFFF0000u) + __uint_as_float(y1.y & 0xFFFF0000u));
            *(float4*)(p.hx + (size_t)row * DM + j) = hv;
        }
    }
}
__device__ __forceinline__ void ph_final(const P& p) {
    const int tid = threadIdx.x, lane = tid & 63, wv = tid >> 6;
    for (int rb = blockIdx.x * 8; rb < TL; rb += gridDim.x * 8) {
        const int row = rb + wv;
        const float* hp = p.hx + (size_t)row * DM;
        float4 xv[4]; float ss = 0.f;
#pragma unroll
        for (int i = 0; i < 4; ++i) { xv[i] = *(const float4*)(hp + i * 256 + lane * 4); ss += xv[i].x * xv[i].x + xv[i].y * xv[i].y + xv[i].z * xv[i].z + xv[i].w * xv[i].w; }
        ss = wave_sum(ss);
        const float rs = rsqrtf(ss * (1.0f / DM) + EPSF);
#pragma unroll
        for (int i = 0; i < 4; ++i) {
            const int j = i * 256 + lane * 4;
            const float4 g = *(const float4*)(p.final_g + j);
            float4 y; y.x = xv[i].x * rs * g.x; y.y = xv[i].y * rs * g.y; y.z = xv[i].z * rs * g.z; y.w = xv[i].w * rs * g.w;
            *(float4*)(p.out + (size_t)row * DM + j) = y;
        }
    }
}

#if defined(MK_MULTI)
#define KW(name, body) __global__ __launch_bounds__(NT) void name(P p, int l) { extern __shared__ __attribute__((aligned(16))) char smem[]; (void)smem; (void)l; body; }
KW(k_copy_h, ph_copy_h(p))
KW(k_mod_partial, ph_mod_partial(p, smem))
KW(k_filter_a, ph_filter_a(p, smem))
KW(k_filter_b, ph_filter_b(p, smem))
KW(k_finalize, ph_finalize(p))
KW(k_norm1, ph_norm<1>(p, l, smem))
KW(k_norm2, ph_norm<2>(p, l, smem))
KW(k_inproj, ph_inproj(p, l, smem))
KW(k_mla_prep, ph_mla_prep(p, l))
KW(k_qgemm, ph_qgemm(p, l, smem))
KW(k_kvgemm, ph_kvgemm(p, l, smem))
KW(k_qpack, ph_qpack(p))
KW(k_attn, ph_attn(p, smem))
KW(k_hyena_l, ph_hyena<SEQ>(p, l, smem))
KW(k_hyena_c, ph_hyena<CTXL>(p, l, smem))
KW(k_merge_a, ph_merge_a(p, l, smem))
KW(k_merge_b, ph_merge_b(p, l, smem))
KW(k_outproj, ph_outproj(p, l, smem))
KW(k_moe_off, ph_moe_off(p, l))
KW(k_moe_gate, ph_moe_gate(p, l, smem, p.off + l * 65))
KW(k_moe_up, ph_moe_up(p, l, smem, p.off + l * 65))
KW(k_moe_down, ph_moe_down(p, l, smem, p.off + l * 65))
KW(k_combine, ph_combine(p, l, p.off + l * 65))
KW(k_final, ph_final(p))

#endif

constexpr int LDS_TOTAL = 96 * 1024;
constexpr int LDS_OFFS = 32 * 1024;
__global__ __launch_bounds__(NT, 2) void mega(P p) {
    extern __shared__ __attribute__((aligned(16))) char smem[];
    volatile LAS unsigned* xbw = (volatile LAS unsigned*)(smem + LDS_TOTAL - 16);
    if (threadIdx.x == 0) { xbw[0] = 0u; xbw[1] = 0u; xbw[2] = 0u; xbw[3] = 0u; }
    __syncthreads();
    const XcdBarrier bar = xcd_barrier_post(p.bar, xbw);
    int* offs = (int*)(smem + LDS_OFFS);
    ph_copy_h(p); ph_mod_partial(p, smem); ph_filter_a(p, smem);
    xcd_barrier(bar);
    ph_filter_b(p, smem);
    xcd_barrier(bar);
    ph_finalize(p);
    xcd_barrier(bar);
    for (int l = 0; l < DEPTH; ++l) {
        ph_norm<1>(p, l, smem);
        xcd_barrier(bar);
        ph_inproj(p, l, smem);
        xcd_barrier(bar);
        ph_mla_prep(p, l);
        xcd_barrier(bar);
        ph_qgemm(p, l, smem); ph_kvgemm(p, l, smem);
        xcd_barrier(bar);
        ph_qpack(p);
        xcd_barrier(bar);
        ph_attn(p, smem); ph_hyena<SEQ>(p, l, smem); ph_hyena<CTXL>(p, l, smem);
        xcd_barrier(bar);
        ph_merge_a(p, l, smem);
        xcd_barrier(bar);
        ph_merge_b(p, l, smem);
        xcd_barrier(bar);
        ph_outproj(p, l, smem);
        xcd_barrier(bar);
        ph_norm<2>(p, l, smem);
        xcd_barrier(bar);
        if (threadIdx.x == 0) { int a = 0; for (int e = 0; e < NE; ++e) { offs[e] = a; a += p.cnt[l * NE + e]; } offs[64] = a; }
        __syncthreads();
        ph_moe_gate(p, l, smem, offs);
        xcd_barrier(bar);
        ph_moe_up(p, l, smem, offs);
        xcd_barrier(bar);
        ph_moe_down(p, l, smem, offs);
        xcd_barrier(bar);
        ph_combine(p, l, offs);
        xcd_barrier(bar);
    }
    ph_final(p);
}

extern "C" void kernel_launch(void* const* d_in, const int* in_sizes, int n_in, void* d_out, int out_size, void* d_ws, size_t ws_size, hipStream_t stream) {
    (void)in_sizes; (void)n_in; (void)out_size;
    P p{};
    const float* const* in = (const float* const*)d_in;
    p.x = in[0]; p.c = in[1]; p.ctx = in[2]; p.c_ctx = in[3]; p.w_ada = in[4]; p.b_ada = in[5]; p.norm1_g = in[6]; p.w_in = in[7];
    p.q_norm_g = in[8]; p.kv_norm_g = in[9]; p.w_uq = in[10]; p.w_ukv = in[11]; p.sc_w = in[12]; p.sc_b = in[13];
    p.flt_w1 = in[14]; p.flt_b1 = in[15]; p.flt_freq = in[16]; p.flt_w2 = in[17]; p.flt_b2 = in[18]; p.flt_w3 = in[19]; p.flt_bias = in[20];
    p.w_hy_o = in[21]; p.w_mla_o = in[22]; p.w_out = in[23]; p.norm2_g = in[24]; p.w_rg = in[25]; p.b_rg = in[26]; p.w_re = in[27]; p.b_re = in[28];
    p.w_gate = in[29]; p.w_up = in[30]; p.w_down = in[31]; p.final_g = in[32];
    p.out = (float*)d_out;
    size_t off = 0;
    auto alloc = [&](size_t bytes) { char* r = (char*)d_ws + off; off += (bytes + 255) & ~(size_t)255; return r; };
    p.bar = (unsigned*)alloc(XCD_BAR_WORDS * 4);
    p.cnt = (int*)alloc(DEPTH * 64 * 4);
    p.off = (int*)alloc(DEPTH * 65 * 4);
    const size_t zero_bytes = off;
    p.modp = (float*)alloc((size_t)DEPTH * 8 * 5 * NMOD * 4);
    p.mod = (float*)alloc((size_t)DEPTH * 5 * NMOD * 4);
    p.H2a = (float*)alloc((size_t)DEPTH * SEQ * 64 * 4);
    p.H2b = (float*)alloc((size_t)DEPTH * CTXL * 64 * 4);
    p.HT0 = (float*)alloc((size_t)DEPTH * 2048 * SEQ * 4);
    p.HT1 = (float*)alloc((size_t)DEPTH * 2048 * CTXL * 4);
    p.SSQ0 = (float*)alloc((size_t)DEPTH * 2048 * 64 * 4);
    p.SSQ1 = (float*)alloc((size_t)DEPTH * 2048 * 4 * 4);
    p.SCL0 = (float*)alloc((size_t)DEPTH * 2048 * 4);
    p.SCL1 = (float*)alloc((size_t)DEPTH * 2048 * 4);
    p.hx = (float*)alloc((size_t)TT * DM * 4);
    p.U = (bf16_t*)alloc((size_t)TT * DM * 2);
    p.PT = (bf16_t*)alloc((size_t)NB * HYC * SEQ * 2);
    p.PTc = (bf16_t*)alloc((size_t)NB * HYC * CTXL * 2);
    p.PMLA = (float*)alloc((size_t)TT * MLAW * 4);
    p.G = (bf16_t*)alloc((size_t)TT * 2048 * 2);
    p.CQ = (bf16_t*)alloc((size_t)TT * QL * 2);
    p.CKV = (bf16_t*)alloc((size_t)TT * KVL * 2);
    p.QRAW = (float*)alloc((size_t)TT * 768 * 4);
    p.Q = (bf16_t*)alloc((size_t)NB * NH * SEQ * 128 * 2);
    p.Qc = (bf16_t*)alloc((size_t)NB * NH * CTXL * 128 * 2);
    p.K = (bf16_t*)alloc((size_t)NB * NH * NKEY * DQK * 2);
    p.V = (bf16_t*)alloc((size_t)NB * NH * NKEY * DV * 2);
    p.Yatt = (bf16_t*)alloc((size_t)TT * 512 * 2);
    p.Yhy = (bf16_t*)alloc((size_t)TT * 512 * 2);
    p.M1F = (float*)alloc((size_t)TT * DM * 4);
    p.M1 = (bf16_t*)alloc((size_t)TT * DM * 2);
    p.list = (int*)alloc((size_t)NE * CAP * 4);
    p.wl = (float*)alloc((size_t)NE * CAP * 4);
    p.asg = (int*)alloc((size_t)TT * 4 * 4);
    p.HG = (float*)alloc((size_t)2 * TT * DE * 4);
    p.Hb = (bf16_t*)alloc((size_t)2 * TT * DE * 2);
    p.Y = (bf16_t*)alloc((size_t)2 * TT * DM * 2);
    if (off > ws_size) { fprintf(stderr, "kernel_launch: workspace too small: need %zu have %zu\n", off, ws_size); return; }
    (void)hipMemsetAsync(d_ws, 0, zero_bytes, stream);
#if defined(MK_MULTI)
    static bool attr_done = false;
    if (!attr_done) { (void)hipFuncSetAttribute((const void*)k_hyena_l, hipFuncAttributeMaxDynamicSharedMemorySize, 5 * SEQ * 4); attr_done = true; }
    const int GB = 1024;
#define L1(k, lds, l) hipLaunchKernelGGL(k, dim3(GB), dim3(NT), lds, stream, p, l)
    L1(k_copy_h, 0, 0);
    L1(k_mod_partial, 5 * 128 * 4, 0);
    L1(k_filter_a, (8 * 36 + 8 * 64) * 4, 0);
    L1(k_filter_b, 64 * 128 * 4, 0);
    L1(k_finalize, 0, 0);
    const int GEMM_LDS = (128 * 40 + 64 * 40) * 2;
    for (int l = 0; l < DEPTH; ++l) {
        L1(k_norm1, 0, l);
        L1(k_inproj, GEMM_LDS, l);
        L1(k_mla_prep, 0, l);
        L1(k_qgemm, GEMM_LDS, l);
        L1(k_kvgemm, GEMM_LDS, l);
        L1(k_qpack, 0, l);
        L1(k_attn, (64 * 104 + 64 * 72 + 8 * 16 * 72) * 2, l);
        L1(k_hyena_l, 5 * SEQ * 4, l);
        L1(k_hyena_c, 5 * CTXL * 4, l);
        L1(k_merge_a, GEMM_LDS, l);
        L1(k_merge_b, GEMM_LDS, l);
        L1(k_outproj, GEMM_LDS, l);
        L1(k_norm2, (8 * 1024 + 8 * 72) * 4, l);
        L1(k_moe_off, 0, l);
        L1(k_moe_gate, GEMM_LDS, l);
        L1(k_moe_up, GEMM_LDS, l);
        L1(k_moe_down, GEMM_LDS, l);
        L1(k_combine, 0, l);
    }
    L1(k_final, 0, 0);
#else
    static int grid = 0;
    if (!grid) {
        int dev = 0, cus = 0, per_cu = 0;
        (void)hipGetDevice(&dev);
        (void)hipDeviceGetAttribute(&cus, hipDeviceAttributeMultiprocessorCount, dev);
        (void)hipFuncSetAttribute((const void*)mega, hipFuncAttributeMaxDynamicSharedMemorySize, LDS_TOTAL);
        (void)hipOccupancyMaxActiveBlocksPerMultiprocessor(&per_cu, (const void*)mega, NT, LDS_TOTAL);
        if (per_cu < 1) fprintf(stderr, "kernel_launch: occupancy query reports %d blocks per CU\n", per_cu);
        grid = cus > 0 ? cus : 256;
    }
    hipLaunchKernelGGL(mega, dim3(grid), dim3(NT), LDS_TOTAL, stream, p);
#endif
}
```

```cpp
#include <hip/hip_runtime.h>
#include <stdint.h>
#include <stdio.h>

typedef unsigned short bf16_t;
typedef short bf16x8 __attribute__((ext_vector_type(8)));
typedef float f32x4 __attribute__((ext_vector_type(4)));
typedef unsigned u32x4 __attribute__((ext_vector_type(4)));
typedef unsigned u32x2 __attribute__((ext_vector_type(2)));

#define NT 512
constexpr int DM = 1024, NB = 4, SEQ = 4096, DEPTH = 4, CTXL = 256;
constexpr int TL = NB * SEQ, TC = NB * CTXL, TT = TL + TC;
constexpr int HYW = 512, HYC = 1536, QL = 384, KVL = 256, QKR = 32;
constexpr int MLAW = QL + KVL + QKR, MLA_END = HYC + MLAW, INC = MLA_END + 2 * DM;
constexpr int NH = 8, DQK = 96, DV = 64, NKEY = SEQ + CTXL;
constexpr int NE = 64, DE = 256, CAP = TT;
constexpr int NMOD = 6 * DM;
constexpr float EPSF = 1e-6f;
constexpr float QSCALE = 0.10206207261596577f * 1.4426950408889634f;

__device__ __forceinline__ bf16_t f2bf(float f) { unsigned u = __float_as_uint(f); u += 0x7FFFu + ((u >> 16) & 1u); return (bf16_t)(u >> 16); }
__device__ __forceinline__ float bf2f(bf16_t b) { return __uint_as_float(((unsigned)b) << 16); }
__device__ __forceinline__ unsigned pack2(float lo, float hi) { return (unsigned)f2bf(lo) | ((unsigned)f2bf(hi) << 16); }
__device__ __forceinline__ int tid_opaque() { int t = threadIdx.x; asm volatile("" : "+v"(t)); return t; }
__device__ __forceinline__ float wave_sum(float v) {
#pragma unroll
    for (int o = 32; o > 0; o >>= 1) v += __shfl_xor(v, o);
    return v;
}


#define XB_TMO      128
#define XB_XCNT(j)  (256  + 64 * (j))
#define XB_XSUB(j)  (1280 + 64 * (j))
#define XB_XGEN(j)  (2304 + 64 * (j))
#define XB_TOP      3328
#define XB_TOPGEN   3392
#define XCD_BAR_WORDS 3456
#define XB_SPIN_CAP (1u << 22)
#define LAS __attribute__((address_space(3)))
__device__ __forceinline__ unsigned xb_ld(unsigned* p)              { return __hip_atomic_load(p, __ATOMIC_RELAXED, __HIP_MEMORY_SCOPE_AGENT); }
__device__ __forceinline__ unsigned xb_add(unsigned* p, unsigned v) { return __hip_atomic_fetch_add(p, v, __ATOMIC_RELAXED, __HIP_MEMORY_SCOPE_AGENT); }
__device__ __forceinline__ unsigned xb_xcc_id() { return (unsigned)__builtin_amdgcn_s_getreg((3 << 11) | 20) & 0xFu; }
#define XB_SPIN(cond, bar) do { unsigned _sp = 0; while (cond) { __builtin_amdgcn_s_sleep(1); \
    if ((++_sp & 255u) == 0u) { if (xb_ld(&(bar)[XB_TMO])) break; if (_sp > XB_SPIN_CAP) { atomicAdd(&(bar)[XB_TMO], 1u); break; } } } } while (0)
struct XcdBarrier { unsigned* bar; unsigned x; volatile LAS unsigned* st; };
__device__ __forceinline__ XcdBarrier xcd_barrier_post(unsigned* bar, volatile LAS unsigned* st) {
    XcdBarrier b; b.bar = bar; b.x = xb_xcc_id(); b.st = st;
    if (threadIdx.x == 0) (void)xb_add(&bar[XB_XCNT(b.x)], 1u);
    return b;
}
__device__ __forceinline__ void xcd_barrier_complete(unsigned* bar, unsigned x, unsigned& nloc, unsigned& nx) {
    const unsigned G = gridDim.x * gridDim.y * gridDim.z;
    unsigned sum, cnt, mine, sp = 0u;
    for (;;) {
        sum = 0u; cnt = 0u; mine = 0u;
#pragma unroll
        for (unsigned j = 0; j < 16; ++j) { const unsigned c = xb_ld(&bar[XB_XCNT(j)]); sum += c; cnt += (c > 0u) ? 1u : 0u; mine = (j == x) ? c : mine; }
        if (sum == G) break;
        __builtin_amdgcn_s_sleep(1);
        if ((++sp & 255u) == 0u) { if (xb_ld(&bar[XB_TMO])) break; if (sp > XB_SPIN_CAP) { atomicAdd(&bar[XB_TMO], 1u); break; } }
    }
    nloc = mine > 0u ? mine : 1u; nx = cnt > 0u ? cnt : 1u;
}
__device__ __forceinline__ void xcd_barrier(const XcdBarrier& b) {
    asm volatile("s_waitcnt vmcnt(0)" ::: "memory");
    __syncthreads();
    if (threadIdx.x == 0) {
        unsigned* bar = b.bar;
        __builtin_amdgcn_s_waitcnt(0);
        unsigned nloc = b.st[0], nx = b.st[1];
        if (nloc == 0u) { xcd_barrier_complete(bar, b.x, nloc, nx); b.st[0] = nloc; b.st[1] = nx; }
        const unsigned old = xb_add(&bar[XB_XSUB(b.x)], 1u);
        const unsigned gen = old / nloc;
        if (old + 1u == (gen + 1u) * nloc) {
            __builtin_amdgcn_fence(__ATOMIC_RELEASE, "agent");
            asm volatile("s_waitcnt vmcnt(0)" ::: "memory");
            const unsigned og = xb_add(&bar[XB_TOP], 1u);
            const unsigned tg = og / nx;
            if (og + 1u == (tg + 1u) * nx) xb_add(&bar[XB_TOPGEN], 1u);
            else XB_SPIN(xb_ld(&bar[XB_TOPGEN]) == tg, bar);
            __builtin_amdgcn_fence(__ATOMIC_ACQUIRE, "agent");
            xb_add(&bar[XB_XGEN(b.x)], 1u);
            asm volatile("s_waitcnt vmcnt(0)" ::: "memory");
        } else {
            XB_SPIN(xb_ld(&bar[XB_XGEN(b.x)]) == gen, bar);
            __builtin_amdgcn_fence(__ATOMIC_ACQUIRE, "agent");
            asm volatile("s_waitcnt vmcnt(0)" ::: "memory");
        }
    }
    __syncthreads();
}

#define WS_LIST(X) \
    X(unsigned, bar, XCD_BAR_WORDS * 4)                         \
    X(int, cnt, DEPTH * 64 * 4)                                 \
    X(float, modp, (size_t)DEPTH * 8 * 5 * NMOD * 4)            \
    X(float, mod, (size_t)DEPTH * 5 * NMOD * 4)                 \
    X(float, H2a, (size_t)DEPTH * SEQ * 64 * 4) \
    X(float, H2b, (size_t)DEPTH * CTXL * 64 * 4) \
    X(float, HT0, (size_t)DEPTH * 2048 * SEQ * 4)               \
    X(float, HT1, (size_t)DEPTH * 2048 * CTXL * 4) \
    X(float, SSQ0, (size_t)DEPTH * 2048 * 64 * 4) \
    X(float, SSQ1, (size_t)DEPTH * 2048 * 4 * 4) \
    X(float, SCL0, (size_t)DEPTH * 2048 * 4) \
    X(float, SCL1, (size_t)DEPTH * 2048 * 4) \
    X(float, hx, (size_t)TT * DM * 4)                           \
    X(bf16_t, U, (size_t)TT * DM * 2)                           \
    X(bf16_t, PT, (size_t)NB * HYC * SEQ * 2)                   \
    X(bf16_t, PTc, (size_t)NB * HYC * CTXL * 2) \
    X(float, PMLA, (size_t)TT * MLAW * 4)                       \
    X(bf16_t, G, (size_t)TT * 2048 * 2)                         \
    X(bf16_t, CQ, (size_t)TT * QL * 2) \
    X(bf16_t, CKV, (size_t)TT * KVL * 2) \
    X(bf16_t, Q, (size_t)NB * NH * SEQ * 128 * 2)               \
    X(bf16_t, Qc, (size_t)NB * NH * CTXL * 128 * 2) \
    X(bf16_t, K, (size_t)NB * NH * NKEY * DQK * 2)              \
    X(bf16_t, V, (size_t)NB * NH * NKEY * DV * 2)               \
    X(bf16_t, Yatt, (size_t)TT * 512 * 2) \
    X(bf16_t, Yhy, (size_t)TT * 512 * 2) \
    X(bf16_t, M1, (size_t)TT * DM * 2) \
    X(int, list, (size_t)NE * CAP * 4) \
    X(float, wl, (size_t)NE * CAP * 4) \
    X(int, asg, (size_t)TT * 4 * 4) \
    X(bf16_t, Hb, (size_t)(2 * TT + 256) * DE * 2) \
    X(bf16_t, Y, (size_t)2 * TT * DM * 2) \
    X(bf16_t, WtHy, (size_t)DEPTH * HYC * DM * 2)               \
    X(bf16_t, WtRest, (size_t)DEPTH * 2816 * DM * 2) \
    X(bf16_t, WtUq, (size_t)DEPTH * 768 * QL * 2) \
    X(bf16_t, WtUkv, (size_t)DEPTH * 1024 * KVL * 2) \
    X(bf16_t, WtHyo, (size_t)DEPTH * DM * HYW * 2) \
    X(bf16_t, WtMlao, (size_t)DEPTH * DM * 512 * 2) \
    X(bf16_t, WtOut, (size_t)DEPTH * DM * DM * 2) \
    X(bf16_t, WtG, (size_t)NE * DE * DM * 2)                    \
    X(bf16_t, WtU, (size_t)NE * DE * DM * 2) \
    X(bf16_t, WtD, (size_t)NE * DM * DE * 2) \
    X(float2, rope, (size_t)SEQ * 16 * 8)
struct WsOff {
#define X(t, n, b) size_t n;
    WS_LIST(X)
#undef X
    size_t total;
};
constexpr WsOff ws_layout() {
    WsOff o{}; size_t a = 0;
#define X(t, n, b) o.n = a; a += (((size_t)(b)) + 255) & ~(size_t)255;
    WS_LIST(X)
#undef X
    o.total = a; return o;
}
constexpr WsOff WSO = ws_layout();
constexpr size_t WS_ZERO_BYTES = WSO.modp;

struct PK { const float* in[33]; float* out; char* ws; };
struct P {
    const float *x, *c, *ctx, *c_ctx, *w_ada, *b_ada, *norm1_g, *w_in, *q_norm_g, *kv_norm_g, *w_uq, *w_ukv, *sc_w, *sc_b;
    const float *flt_w1, *flt_b1, *flt_freq, *flt_w2, *flt_b2, *flt_w3, *flt_bias, *w_hy_o, *w_mla_o, *w_out, *norm2_g;
    const float *w_rg, *b_rg, *w_re, *b_re, *w_gate, *w_up, *w_down, *final_g;
    float* out;
#define X(t, n, b) t* n;
    WS_LIST(X)
#undef X
};
typedef const __attribute__((address_space(4))) PK* KArgP;
__device__ __forceinline__ P make_p(KArgP kp) {
    P p; const KArgP& kk = kp; char* ws = kk->ws;
    p.x = kk->in[0]; p.c = kk->in[1]; p.ctx = kk->in[2]; p.c_ctx = kk->in[3]; p.w_ada = kk->in[4]; p.b_ada = kk->in[5]; p.norm1_g = kk->in[6]; p.w_in = kk->in[7];
    p.q_norm_g = kk->in[8]; p.kv_norm_g = kk->in[9]; p.w_uq = kk->in[10]; p.w_ukv = kk->in[11]; p.sc_w = kk->in[12]; p.sc_b = kk->in[13];
    p.flt_w1 = kk->in[14]; p.flt_b1 = kk->in[15]; p.flt_freq = kk->in[16]; p.flt_w2 = kk->in[17]; p.flt_b2 = kk->in[18]; p.flt_w3 = kk->in[19]; p.flt_bias = kk->in[20];
    p.w_hy_o = kk->in[21]; p.w_mla_o = kk->in[22]; p.w_out = kk->in[23]; p.norm2_g = kk->in[24]; p.w_rg = kk->in[25]; p.b_rg = kk->in[26]; p.w_re = kk->in[27]; p.b_re = kk->in[28];
    p.w_gate = kk->in[29]; p.w_up = kk->in[30]; p.w_down = kk->in[31]; p.final_g = kk->in[32];
    p.out = kk->out;
#define X(t, n, b) p.n = (t*)(ws + WSO.n);
    WS_LIST(X)
#undef X
    return p;
}

__device__ __forceinline__ void ph_copy_h(const P& p) {
    const size_t n4 = (size_t)TT * DM / 4, nl4 = (size_t)TL * DM / 4;
    for (size_t i = (size_t)blockIdx.x * NT + threadIdx.x; i < n4; i += (size_t)gridDim.x * NT) {
        float4 v = (i < nl4) ? ((const float4*)p.x)[i] : ((const float4*)p.ctx)[i - nl4];
        ((float4*)p.hx)[i] = v;
    }
}

__device__ __forceinline__ void ph_mod_partial(const P& p, char* smem) {
    float* s = (float*)smem;
    const int tid = tid_opaque();
    for (int it = blockIdx.x; it < DEPTH * 8 * 12; it += gridDim.x) {
        const int l = it / 96, kc = (it / 12) % 8, jb = it % 12;
        __syncthreads();
        for (int i = tid; i < 5 * 128; i += NT) {
            const int r = i / 128, kk = i % 128, k = kc * 128 + kk;
            const float cv = (r < 4) ? p.c[r * DM + k] : p.c_ctx[k];
            s[i] = cv / (1.0f + expf(-cv));
        }
        __syncthreads();
        const int j = jb * 512 + tid;
        float a0 = 0, a1 = 0, a2 = 0, a3 = 0, a4 = 0;
        const float* w = p.w_ada + ((size_t)l * DM + kc * 128) * NMOD + j;
#pragma unroll 8
        for (int kk = 0; kk < 128; ++kk) {
            const float wv = w[(size_t)kk * NMOD];
            a0 += s[kk] * wv; a1 += s[128 + kk] * wv; a2 += s[256 + kk] * wv; a3 += s[384 + kk] * wv; a4 += s[512 + kk] * wv;
        }
        float* o = p.modp + ((size_t)(l * 8 + kc) * 5) * NMOD + j;
        o[0] = a0; o[NMOD] = a1; o[2 * NMOD] = a2; o[3 * NMOD] = a3; o[4 * NMOD] = a4;
    }
}

__device__ __forceinline__ void ph_filter_a(const P& p, char* smem) {
    float* zs = (float*)smem;
    float* h1s = zs + 8 * 36;
    const int tid = tid_opaque(), tt = tid >> 6, j = tid & 63;
    const int n0 = DEPTH * 512, n1 = DEPTH * 32;
    for (int it = blockIdx.x; it < n0 + n1; it += gridDim.x) {
        int l, ls, tg;
        if (it < n0) { ls = 0; l = it / 512; tg = it % 512; } else { ls = 1; l = (it - n0) / 32; tg = (it - n0) % 32; }
        const int L = ls ? CTXL : SEQ;
        const int t = tg * 8 + tt;
        __syncthreads();
        if (j < 33) {
            float f;
            if (j == 0) f = (float)t / (float)(L - 1);
            else {
                const int k = (j - 1) & 15;
                const float band = 1e-4f + (float)k * ((15.0f - 1e-4f) / 15.0f);
                const float w = 6.283185307179586f * (float)t / (float)L;
                const double ang = (double)band * (double)w;
                f = (j <= 16) ? (float)cos(ang) : (float)(-sin(ang));
            }
            zs[tt * 36 + j] = f;
        }
        __syncthreads();
        const float fr = p.flt_freq[l * 64 + j];
        float a = p.flt_b1[l * 64 + j];
        for (int i = 0; i < 33; ++i) a += zs[tt * 36 + i] * p.flt_w1[((size_t)l * 33 + i) * 64 + j];
        h1s[tt * 64 + j] = sinf(fr * a);
        __syncthreads();
        float a2 = p.flt_b2[l * 64 + j];
        for (int i = 0; i < 64; ++i) a2 += h1s[tt * 64 + i] * p.flt_w2[((size_t)l * 64 + i) * 64 + j];
        const float h2 = sinf(fr * a2);
        if (ls == 0) p.H2a[((size_t)l * SEQ + t) * 64 + j] = h2; else p.H2b[((size_t)l * CTXL + t) * 64 + j] = h2;
    }
}

__device__ __forceinline__ void ph_filter_b(const P& p, char* smem) {
    float* w3s = (float*)smem;
    const int tid = tid_opaque(), lane = tid & 63, wv = tid >> 6;
    const int n0 = DEPTH * 8 * 16, n1 = DEPTH * 16;
    const float DA = -15.350567286626973f, DB = -3.0701134573253946f;
    for (int it = blockIdx.x; it < n0 + n1; it += gridDim.x) {
        int l, ls, tc, cc;
        if (it < n0) { ls = 0; l = it / 128; tc = (it / 16) % 8; cc = it % 16; } else { ls = 1; l = (it - n0) / 16; tc = 0; cc = (it - n0) % 16; }
        const int L = ls ? CTXL : SEQ;
        __syncthreads();
        for (int i = tid; i < 64 * 128; i += NT) { const int jj = i >> 7, c = i & 127; w3s[i] = p.flt_w3[((size_t)l * 64 + jj) * 2048 + cc * 128 + c]; }
        __syncthreads();
        int t, cbeg, cend;
        if (ls == 0) { t = tc * 512 + tid; cbeg = 0; cend = 128; } else { t = tid & 255; cbeg = (tid >> 8) * 64; cend = cbeg + 64; }
        const float* h2 = ls ? p.H2b + ((size_t)l * CTXL + t) * 64 : p.H2a + ((size_t)l * SEQ + t) * 64;
        float h[64];
#pragma unroll
        for (int jj = 0; jj < 64; jj += 4) { const float4 v = *(const float4*)(h2 + jj); h[jj] = v.x; h[jj + 1] = v.y; h[jj + 2] = v.z; h[jj + 3] = v.w; }
        const float tl = (float)t / (float)(L - 1);
        for (int c = cbeg; c < cend; ++c) {
            float acc = 0.f;
#pragma unroll
            for (int jj = 0; jj < 64; ++jj) acc += h[jj] * w3s[jj * 128 + c];
            const int col = cc * 128 + c, ch = col & 511;
            const float delta = fabsf(DA + (float)ch * ((DB - DA) / 511.0f));
            const float v = acc * expf(-tl * delta);
            if (ls == 0) p.HT0[((size_t)l * 2048 + col) * SEQ + t] = v; else p.HT1[((size_t)l * 2048 + col) * CTXL + t] = v;
            const float q = wave_sum(v * v);
            if (lane == 0) { if (ls == 0) p.SSQ0[((size_t)l * 2048 + col) * 64 + tc * 8 + wv] = q; else p.SSQ1[((size_t)l * 2048 + col) * 4 + (wv & 3)] = q; }
        }
    }
}

__device__ __forceinline__ void ph_finalize(const P& p) {
    const int n_mod = DEPTH * 5 * NMOD, n_s = DEPTH * 2048;
    for (int i = blockIdx.x * NT + threadIdx.x; i < n_mod + 2 * n_s; i += gridDim.x * NT) {
        if (i < n_mod) {
            const int l = i / (5 * NMOD), r = (i / NMOD) % 5, j = i % NMOD;
            float a = p.b_ada[l * NMOD + j];
            for (int kc = 0; kc < 8; ++kc) a += p.modp[((size_t)(l * 8 + kc) * 5 + r) * NMOD + j];
            p.mod[i] = a;
        } else if (i < n_mod + n_s) {
            const int k = i - n_mod; float a = 0.f;
            for (int q = 0; q < 64; ++q) a += p.SSQ0[(size_t)k * 64 + q];
            p.SCL0[k] = rsqrtf(a + EPSF);
        } else {
            const int k = i - n_mod - n_s; float a = 0.f;
            for (int q = 0; q < 4; ++q) a += p.SSQ1[(size_t)k * 4 + q];
            p.SCL1[k] = rsqrtf(a + EPSF);
        }
    }
}

template <int WHICH>
__device__ __forceinline__ void ph_norm(const P& p, int l, char* smem) {
    float* rowbuf = (float*)smem;
    float* lgs = rowbuf + 8 * 1024;
    const int tid = tid_opaque(), lane = tid & 63, wv = tid >> 6;
    const float* ng = (WHICH == 1 ? p.norm1_g : p.norm2_g) + l * DM;
    for (int rb = blockIdx.x * 8; rb < TT; rb += gridDim.x * 8) {
        const int row = rb + wv;
        const int b = row < TL ? (row >> 12) : 4;
        const float* hp = p.hx + (size_t)row * DM;
        const float* md = p.mod + ((size_t)l * 5 + b) * NMOD + (WHICH == 1 ? 0 : 3 * DM);
        float4 xv[4]; float ss = 0.f;
#pragma unroll
        for (int i = 0; i < 4; ++i) { xv[i] = *(const float4*)(hp + i * 256 + lane * 4); ss += xv[i].x * xv[i].x + xv[i].y * xv[i].y + xv[i].z * xv[i].z + xv[i].w * xv[i].w; }
        ss = wave_sum(ss);
        const float rs = rsqrtf(ss * (1.0f / DM) + EPSF);
#pragma unroll
        for (int i = 0; i < 4; ++i) {
            const int j = i * 256 + lane * 4;
            const float4 g = *(const float4*)(ng + j), sh = *(const float4*)(md + j), sc = *(const float4*)(md + DM + j);
            float4 y;
            y.x = (xv[i].x * rs * g.x) * (1.f + sc.x) + sh.x; y.y = (xv[i].y * rs * g.y) * (1.f + sc.y) + sh.y;
            y.z = (xv[i].z * rs * g.z) * (1.f + sc.z) + sh.z; y.w = (xv[i].w * rs * g.w) * (1.f + sc.w) + sh.w;
            u32x2 o; o.x = pack2(y.x, y.y); o.y = pack2(y.z, y.w);
            *(u32x2*)(p.U + (size_t)row * DM + j) = o;
            if (WHICH == 2) *(float4*)(rowbuf + wv * 1024 + j) = y;
        }
        if (WHICH == 2) {
            __syncthreads();
            const float* wre = p.w_re + (size_t)l * DM * NE + lane;
            const float* wrg = p.w_rg + (size_t)l * DM * 8 + (lane & 7);
            float ae = 0.f, ag = 0.f;
            const float* rbp = rowbuf + wv * 1024;
#pragma unroll 8
            for (int k = 0; k < DM; ++k) { const float tv = rbp[k]; ae += tv * wre[(size_t)k * NE]; ag += tv * wrg[(size_t)k * 8]; }
            lgs[wv * 72 + 8 + lane] = ae;
            if (lane < 8) lgs[wv * 72 + lane] = ag;
            __syncthreads();
            if (lane == 0) {
                const float* lg = lgs + wv * 72; const float* le = lg + 8;
                int gs = 0; float best = lg[0] + p.b_rg[l * 8], mx = lg[0];
                for (int i = 1; i < 8; ++i) { const float v = lg[i] + p.b_rg[l * 8 + i]; if (v > best) { best = v; gs = i; } mx = fmaxf(mx, lg[i]); }
                float den = 0.f;
                for (int i = 0; i < 8; ++i) den += expf(lg[i] - mx);
                const float pg = expf(lg[gs] - mx) / den;
                int i0 = 0; float k0 = le[gs * 8] + p.b_re[l * NE + gs * 8];
                for (int i = 1; i < 8; ++i) { const float v = le[gs * 8 + i] + p.b_re[l * NE + gs * 8 + i]; if (v > k0) { k0 = v; i0 = i; } }
                int i1 = -1; float k1 = 0.f;
                for (int i = 0; i < 8; ++i) { if (i == i0) continue; const float v = le[gs * 8 + i] + p.b_re[l * NE + gs * 8 + i]; if (i1 < 0 || v > k1) { k1 = v; i1 = i; } }
                const float w0 = 1.0f / (1.0f + expf(le[gs * 8 + i1] - le[gs * 8 + i0])), w1 = 1.0f - w0;
                const int e0 = gs * 8 + i0, e1 = gs * 8 + i1;
                const int r0 = atomicAdd(p.cnt + l * NE + e0, 1), r1 = atomicAdd(p.cnt + l * NE + e1, 1);
                p.list[(size_t)e0 * CAP + r0] = row; p.wl[(size_t)e0 * CAP + r0] = pg * w0;
                p.list[(size_t)e1 * CAP + r1] = row; p.wl[(size_t)e1 * CAP + r1] = pg * w1;
                *(int4*)(p.asg + (size_t)row * 4) = make_int4(e0, r0, e1, r1);
            }
            __syncthreads();
        }
    }
}

__device__ __forceinline__ float rope_apply(float self, float partner, int d, int t) {
    const int a = d >> 4, s = (d >> 3) & 1, i = d & 7;
    const float pos = (float)(a == 0 ? (t >> 6) : (t & 63));
    const float inv = powf(10000.0f, -(float)i / 8.0f);
    const float ang = pos * inv;
    const float cs = cosf(ang), sn = sinf(ang);
    return s == 0 ? self * cs - partner * sn : partner * sn + self * cs;
}

__device__ __forceinline__ void ph_mla_prep(const P& p, int l) {
    const int tid = tid_opaque(), lane = tid & 63, wv = tid >> 6;
    for (int rb = blockIdx.x * 8; rb < TT; rb += gridDim.x * 8) {
        const int row = rb + wv;
        const float* pm = p.PMLA + (size_t)row * MLAW;
        float q[6], ss = 0.f;
#pragma unroll
        for (int i = 0; i < 6; ++i) { q[i] = pm[lane + 64 * i]; ss += q[i] * q[i]; }
        ss = wave_sum(ss);
        float rs = rsqrtf(ss * (1.0f / QL) + EPSF);
#pragma unroll
        for (int i = 0; i < 6; ++i) p.CQ[(size_t)row * QL + lane + 64 * i] = f2bf(q[i] * rs * p.q_norm_g[l * QL + lane + 64 * i]);
        float kv[4]; ss = 0.f;
#pragma unroll
        for (int i = 0; i < 4; ++i) { kv[i] = pm[QL + lane + 64 * i]; ss += kv[i] * kv[i]; }
        ss = wave_sum(ss);
        rs = rsqrtf(ss * (1.0f / KVL) + EPSF);
#pragma unroll
        for (int i = 0; i < 4; ++i) p.CKV[(size_t)row * KVL + lane + 64 * i] = f2bf(kv[i] * rs * p.kv_norm_g[l * KVL + lane + 64 * i]);
        const int d = lane & 31;
        const float self = pm[QL + KVL + d];
        const float partner = __shfl_xor(self, 8);
        int b, key; float val;
        if (row < TL) { b = row >> 12; const int t = row & 4095; key = t; val = rope_apply(self, partner, d, t); }
        else { const int r = row - TL; b = r >> 8; key = SEQ + (r & 255); val = self; }
        if (lane < 32) {
            const bf16_t o = f2bf(val);
#pragma unroll
            for (int h = 0; h < NH; ++h) p.K[((size_t)(b * NH + h) * NKEY + key) * DQK + 64 + d] = o;
        }
    }
}

__device__ __forceinline__ void ph_attn(const P& p, char* smem) {
    bf16_t* sK = (bf16_t*)smem;
    bf16_t* sVt = sK + 64 * 104;
    bf16_t* sP = sVt + 64 * 72;
    const int tid = tid_opaque(), lane = tid & 63, wv = tid >> 6, fr = lane & 15, fq = lane >> 4;
    bf16_t* sPw = sP + wv * 16 * 72;
    const int NUL = NB * NH * 32, NUC = NB * NH * 2;
    for (int u = blockIdx.x; u < NUL + NUC; u += gridDim.x) {
        const bool isctx = u >= NUL;
        int b, h, q0;
        if (!isctx) { b = u / (NH * 32); h = (u / 32) % NH; q0 = (u % 32) * 128; } else { const int v = u - NUL; b = v / (NH * 2); h = (v / 2) % NH; q0 = (v % 2) * 128; }
        const bf16_t* Qp = isctx ? p.Qc + ((size_t)(b * NH + h) * CTXL + q0) * 128 : p.Q + ((size_t)(b * NH + h) * SEQ + q0) * 128;
        bf16x8 qa[4];
#pragma unroll
        for (int ks = 0; ks < 4; ++ks) qa[ks] = *(const bf16x8*)(Qp + (size_t)(wv * 16 + fr) * 128 + ks * 32 + fq * 8);
        const bf16_t* Kp = p.K + (size_t)(b * NH + h) * NKEY * DQK;
        const bf16_t* Vp = p.V + (size_t)(b * NH + h) * NKEY * DV;
        f32x4 o[4]; float m[4], lsum[4];
#pragma unroll
        for (int i = 0; i < 4; ++i) { o[i] = (f32x4){0.f, 0.f, 0.f, 0.f}; m[i] = -INFINITY; lsum[i] = 0.f; }
        for (int kt = isctx ? 64 : 0; kt < 68; ++kt) {
            __syncthreads();
            for (int i = tid; i < 768; i += NT) { const int key = i / 12, part = i % 12; *(u32x4*)(sK + key * 104 + part * 8) = *(const u32x4*)(Kp + (size_t)(kt * 64 + key) * DQK + part * 8); }
            {
                const int key = tid >> 3, d0 = (tid & 7) * 8;
                const bf16x8 vv = *(const bf16x8*)(Vp + (size_t)(kt * 64 + key) * DV + d0);
#pragma unroll
                for (int i = 0; i < 8; ++i) sVt[(d0 + i) * 72 + key] = (bf16_t)vv[i];
            }
            __syncthreads();
            f32x4 s[4];
#pragma unroll
            for (int nt = 0; nt < 4; ++nt) {
                s[nt] = (f32x4){0.f, 0.f, 0.f, 0.f};
#pragma unroll
                for (int ks = 0; ks < 3; ++ks) {
                    const bf16x8 a = (ks < 2) ? qa[ks] : (kt >= 64 ? qa[3] : qa[2]);
                    const bf16x8 bb = *(const bf16x8*)(sK + (nt * 16 + fr) * 104 + ks * 32 + fq * 8);
                    s[nt] = __builtin_amdgcn_mfma_f32_16x16x32_bf16(a, bb, s[nt], 0, 0, 0);
                }
            }
#pragma unroll
            for (int j = 0; j < 4; ++j) {
                float mx = fmaxf(fmaxf(s[0][j], s[1][j]), fmaxf(s[2][j], s[3][j]));
                mx = fmaxf(mx, __shfl_xor(mx, 1)); mx = fmaxf(mx, __shfl_xor(mx, 2)); mx = fmaxf(mx, __shfl_xor(mx, 4)); mx = fmaxf(mx, __shfl_xor(mx, 8));
                const float mn = fmaxf(m[j], mx);
                const float alpha = exp2f(m[j] - mn);
                m[j] = mn;
                float rsum = 0.f;
#pragma unroll
                for (int nt = 0; nt < 4; ++nt) { const float pv = exp2f(s[nt][j] - mn); rsum += pv; sPw[(fq * 4 + j) * 72 + nt * 16 + fr] = f2bf(pv); }
                rsum += __shfl_xor(rsum, 1); rsum += __shfl_xor(rsum, 2); rsum += __shfl_xor(rsum, 4); rsum += __shfl_xor(rsum, 8);
                lsum[j] = lsum[j] * alpha + rsum;
#pragma unroll
                for (int nt = 0; nt < 4; ++nt) o[nt][j] *= alpha;
            }
            __syncthreads();
#pragma unroll
            for (int ks = 0; ks < 2; ++ks) {
                const bf16x8 a = *(const bf16x8*)(sPw + fr * 72 + ks * 32 + fq * 8);
#pragma unroll
                for (int nt = 0; nt < 4; ++nt) {
                    const bf16x8 bb = *(const bf16x8*)(sVt + (nt * 16 + fr) * 72 + ks * 32 + fq * 8);
                    o[nt] = __builtin_amdgcn_mfma_f32_16x16x32_bf16(a, bb, o[nt], 0, 0, 0);
                }
            }
        }
        const size_t rbase = (isctx ? (size_t)TL + b * CTXL : (size_t)b * SEQ) + q0 + wv * 16 + fq * 4;
#pragma unroll
        for (int j = 0; j < 4; ++j) {
            const float inv = 1.0f / lsum[j];
#pragma unroll
            for (int nt = 0; nt < 4; ++nt) p.Yatt[(rbase + j) * 512 + h * 64 + nt * 16 + fr] = f2bf(o[nt][j] * inv);
        }
    }
}

template <int L>
__device__ __forceinline__ void ph_hyena(const P& p, int l, char* smem) {
    constexpr int NOUT = (L >= NT) ? L / NT : 1;
    float* kern0 = (float*)smem;
    float* kern1 = kern0 + 2 * L;
    float* zb = kern1 + 2 * L;
    const int tid = tid_opaque();
    const bool active = tid < L;
    const int tb = active ? tid : 0;
    const bf16_t* PTb = (L == SEQ) ? p.PT : p.PTc;
    const float* HT = (L == SEQ) ? p.HT0 + (size_t)l * 2048 * SEQ : p.HT1 + (size_t)l * 2048 * CTXL;
    const float* SCL = ((L == SEQ) ? p.SCL0 : p.SCL1) + l * 2048;
    for (int u = blockIdx.x; u < NB * HYW; u += gridDim.x) {
        const int b = u / HYW, c = u % HYW;
        __syncthreads();
        for (int i = tid; i < 2 * L; i += NT) {
            const int d = i - L;
            float k0, k1;
            if (d >= 0) { k0 = HT[(size_t)(0 * 1024 + c) * L + d] * SCL[c]; k1 = HT[(size_t)(1 * 1024 + c) * L + d] * SCL[1024 + c]; }
            else if (d > -L) { k0 = HT[(size_t)(0 * 1024 + 512 + c) * L + (size_t)(-d)] * SCL[512 + c]; k1 = HT[(size_t)(1 * 1024 + 512 + c) * L + (size_t)(-d)] * SCL[1536 + c]; }
            else { k0 = 0.f; k1 = 0.f; }
            kern0[i] = k0; kern1[i] = k1;
        }
        float uv[3][NOUT];
#pragma unroll
        for (int w = 0; w < 3; ++w) {
            const int col = w * HYW + c;
            const bf16_t* pr = PTb + ((size_t)b * HYC + col) * L;
            const float w0 = p.sc_w[(size_t)(l * 3 + 0) * HYC + col], w1 = p.sc_w[(size_t)(l * 3 + 1) * HYC + col], w2 = p.sc_w[(size_t)(l * 3 + 2) * HYC + col], bb = p.sc_b[l * HYC + col];
#pragma unroll
            for (int i = 0; i < NOUT; ++i) {
                const int t = tb + i * NT;
                const float pm1 = t > 0 ? bf2f(pr[t - 1]) : 0.f, p0 = bf2f(pr[t]), pp1 = t < L - 1 ? bf2f(pr[t + 1]) : 0.f;
                uv[w][i] = bb + w0 * pm1 + w1 * p0 + w2 * pp1;
            }
        }
        if (active) {
#pragma unroll
            for (int i = 0; i < NOUT; ++i) zb[tb + i * NT] = uv[0][i];
        }
        __syncthreads();
        float acc[NOUT];
#pragma unroll
        for (int i = 0; i < NOUT; ++i) acc[i] = 0.f;
        for (int s = 0; s < L; ++s) {
            const float zs = zb[s];
#pragma unroll
            for (int i = 0; i < NOUT; ++i) acc[i] += zs * kern0[tb + i * NT - s + L];
        }
        const float bias0 = p.flt_bias[(l * 2 + 0) * HYW + c], bias1 = p.flt_bias[(l * 2 + 1) * HYW + c];
        float z1[NOUT];
#pragma unroll
        for (int i = 0; i < NOUT; ++i) z1[i] = uv[1][i] * (acc[i] + bias0 * uv[0][i]);
        __syncthreads();
        if (active) {
#pragma unroll
            for (int i = 0; i < NOUT; ++i) zb[tb + i * NT] = z1[i];
        }
        __syncthreads();
#pragma unroll
        for (int i = 0; i < NOUT; ++i) acc[i] = 0.f;
        for (int s = 0; s < L; ++s) {
            const float zs = zb[s];
#pragma unroll
            for (int i = 0; i < NOUT; ++i) acc[i] += zs * kern1[tb + i * NT - s + L];
        }
        if (active) {
            const size_t rbase = (L == SEQ) ? (size_t)b * SEQ : (size_t)TL + b * CTXL;
#pragma unroll
            for (int i = 0; i < NOUT; ++i) p.Yhy[(rbase + tb + i * NT) * HYW + c] = f2bf(uv[2][i] * (acc[i] + bias1 * z1[i]));
        }
    }
}

__device__ __forceinline__ void ph_combine(const P& p, int l, const int* offs) {
    const int tid = tid_opaque(), lane = tid & 63, wv = tid >> 6;
    for (int rb = blockIdx.x * 8; rb < TT; rb += gridDim.x * 8) {
        const int row = rb + wv;
        const int b = row < TL ? (row >> 12) : 4;
        const int4 a = *(const int4*)(p.asg + (size_t)row * 4);
        const size_t s0 = (size_t)offs[a.x] + a.y, s1 = (size_t)offs[a.z] + a.w;
        const float* g2 = p.mod + ((size_t)l * 5 + b) * NMOD + 5 * DM;
#pragma unroll
        for (int i = 0; i < 4; ++i) {
            const int j = i * 256 + lane * 4;
            float4 hv = *(float4*)(p.hx + (size_t)row * DM + j);
            const u32x2 y0 = *(const u32x2*)(p.Y + s0 * DM + j), y1 = *(const u32x2*)(p.Y + s1 * DM + j);
            const float4 g = *(const float4*)(g2 + j);
            hv.x += g.x * (__uint_as_float(y0.x << 16) + __uint_as_float(y1.x << 16));
            hv.y += g.y * (__uint_as_float(y0.x & 0xFFFF0000u) + __uint_as_float(y1.x & 0xFFFF0000u));
            hv.z += g.z * (__uint_as_float(y0.y << 16) + __uint_as_float(y1.y << 16));
            hv.w += g.w * (__uint_as_float(y0.y & 0xFFFF0000u) + __uint_as_float(y1.y & 0xFFFF0000u));
            *(float4*)(p.hx + (size_t)row * DM + j) = hv;
        }
    }
}
__device__ __forceinline__ void ph_final(const P& p) {
    const int tid = tid_opaque(), lane = tid & 63, wv = tid >> 6;
    for (int rb = blockIdx.x * 8; rb < TL; rb += gridDim.x * 8) {
        const int row = rb + wv;
        const float* hp = p.hx + (size_t)row * DM;
        float4 xv[4]; float ss = 0.f;
#pragma unroll
        for (int i = 0; i < 4; ++i) { xv[i] = *(const float4*)(hp + i * 256 + lane * 4); ss += xv[i].x * xv[i].x + xv[i].y * xv[i].y + xv[i].z * xv[i].z + xv[i].w * xv[i].w; }
        ss = wave_sum(ss);
        const float rs = rsqrtf(ss * (1.0f / DM) + EPSF);
#pragma unroll
        for (int i = 0; i < 4; ++i) {
            const int j = i * 256 + lane * 4;
            const float4 g = *(const float4*)(p.final_g + j);
            float4 y; y.x = xv[i].x * rs * g.x; y.y = xv[i].y * rs * g.y; y.z = xv[i].z * rs * g.z; y.w = xv[i].w * rs * g.w;
            *(float4*)(p.out + (size_t)row * DM + j) = y;
        }
    }
}

namespace ge {
constexpr int BM = 256, BK = 64, HALF = 128, HTB = HALF * BK * 2, STAGE_BYTES = 8 * HTB, NXCD = 8, WGM = 8;
__device__ __forceinline__ int lds_byte(int r, int c) { const int st = (r >> 4) * 2 + (c >> 5), rr = r & 15, cc = c & 31, ob = rr * 64 + cc * 2; return st * 1024 + (ob ^ (((ob >> 9) & 1) << 5)); }
__device__ __forceinline__ void stage_rc(int b, int& R, int& C) { const int st = b / 1024, sb = b % 1024, swz = sb ^ (((sb >> 9) & 1) << 5); R = (st >> 1) * 16 + swz / 64; C = (st & 1) * 32 + (swz % 64) / 2; }
__device__ __forceinline__ int perm32(int rho) { const int n = rho >> 4, i = rho & 15; return 8 * (i >> 2) + 4 * n + (i & 3); }
__device__ __forceinline__ void tile_order(int L, int nM, int nN, int& pm, int& pn) {
    const int nwg = nM * nN; int wgid = L;
    { const int q = nwg / NXCD, r = nwg % NXCD, xcd = wgid % NXCD, off = wgid / NXCD; wgid = (xcd < r ? xcd * (q + 1) : r * (q + 1) + (xcd - r) * q) + off; }
    const int nig = WGM * nN, gid = wgid / nig, fm = gid * WGM, gsz = (nM - fm) < WGM ? (nM - fm) : WGM;
    pm = fm + ((wgid % nig) % gsz); pn = (wgid % nig) / gsz;
}
struct Unit { const char* a; const char* b0; const char* b1; const int* rows; int nrows; int pm, pn, kind; };
typedef f32x4 Acc[2][2][4][2];

template <bool GATHER, class Sched, class Epi>
__device__ __forceinline__ void gemm_engine(LAS unsigned char* lds, const int lda, const int ldb, const int K, const Sched& S, const Epi& E) {
    const int tid = tid_opaque(), wid = __builtin_amdgcn_readfirstlane(tid >> 6), lane = tid & 63, wr = wid >> 2, wc = wid & 3, fr = lane & 15, fq = lane >> 4;
    const int nt = K / BK;
    int sR[2], sC[2];
    unsigned voffA[2], voffB[2];
#pragma unroll
    for (int i = 0; i < 2; ++i) { stage_rc(tid * 16 + i * 8192, sR[i], sC[i]); const int Rb = (sR[i] & ~31) + perm32(sR[i] & 31);
        voffA[i] = (unsigned)(sR[i] * lda + sC[i]) * 2u; voffB[i] = (unsigned)(Rb * ldb + sC[i]) * 2u; }
    const size_t kstep = (size_t)(BK * 2);
    const size_t hstepA = (size_t)HALF * lda * 2;
    const unsigned ldsw = (unsigned)wid * 1024u;
    const int aoff = lds_byte(wr * 64 + fr, fq * 8), boff = lds_byte(wc * 32 + fr, fq * 8);
    unsigned gvc[2][2], gvn[2][2];
#define GE_SA(b, h) (((b) * 2 + (h)) * HTB)
#define GE_SB(b, h) ((4 + (b) * 2 + (h)) * HTB)
#define GE_GLDS(src, bufoff, i) __builtin_amdgcn_global_load_lds((const unsigned*)(src), (LAS unsigned*)(lds + (bufoff) + ldsw + (i) * 8192), 16, 0, 0)
#define GE_STAGE_B(bufoff, bp) do { _Pragma("unroll") for (int _i = 0; _i < 2; ++_i) GE_GLDS((bp) + voffB[_i], bufoff, _i); } while (0)
#define GE_STAGE_A(bufoff, ap, h, gv) do { _Pragma("unroll") for (int _i = 0; _i < 2; ++_i) { \
        if constexpr (GATHER) GE_GLDS((ap) + (gv)[h][_i], bufoff, _i); else GE_GLDS((ap) + (size_t)(h) * hstepA + voffA[_i], bufoff, _i); } } while (0)
#define GE_LDA(dst, b, h) do { _Pragma("unroll") for (int m = 0; m < 4; ++m) _Pragma("unroll") for (int k = 0; k < 2; ++k) dst[m][k] = *(const LAS bf16x8*)(lds + GE_SA(b, h) + aoff + m * 2048 + k * 1024); } while (0)
#define GE_LDB(dst, b, h) do { _Pragma("unroll") for (int n = 0; n < 2; ++n) _Pragma("unroll") for (int k = 0; k < 2; ++k) dst[n][k] = *(const LAS bf16x8*)(lds + GE_SB(b, h) + boff + n * 2048 + k * 1024); } while (0)
#define GE_MMA(ai, bj, At, Bt) do { __builtin_amdgcn_s_setprio(1); _Pragma("unroll") for (int m = 0; m < 4; ++m) _Pragma("unroll") for (int n = 0; n < 2; ++n) _Pragma("unroll") for (int k = 0; k < 2; ++k) \
        acc[ai][bj][m][n] = __builtin_amdgcn_mfma_f32_16x16x32_bf16(Bt[n][k], At[m][k], acc[ai][bj][m][n], 0, 0, 0); __builtin_amdgcn_s_setprio(0); } while (0)
#define GE_WAIT_V(n) asm volatile("s_waitcnt vmcnt(" #n ")" ::: "memory")
#define GE_WAIT_L(n) asm volatile("s_waitcnt lgkmcnt(" #n ")" ::: "memory")
#define GE_BAR __builtin_amdgcn_s_barrier()
#define GE_SCHED __builtin_amdgcn_sched_barrier(0)
#define GE_GATHER_OFFS(gv, u) do { if constexpr (GATHER) { _Pragma("unroll") for (int _h = 0; _h < 2; ++_h) _Pragma("unroll") for (int _i = 0; _i < 2; ++_i) { \
        int _r = (u).pm * BM + _h * HALF + sR[_i]; _r = _r < (u).nrows ? _r : (u).nrows - 1; (gv)[_h][_i] = (unsigned)((u).rows[_r] * lda + sC[_i]) * 2u; } } } while (0)
    Unit cur, nxt; int ui = 0;
    if (!S.next(0, cur)) return;
    Acc acc;
#pragma unroll
    for (int a = 0; a < 2; ++a)
#pragma unroll
        for (int b = 0; b < 2; ++b)
#pragma unroll
            for (int m = 0; m < 4; ++m)
#pragma unroll
                for (int n = 0; n < 2; ++n) acc[a][b][m][n] = (f32x4){0.f, 0.f, 0.f, 0.f};
    bf16x8 At[4][2], B0[2][2], B1[2][2];
    GE_GATHER_OFFS(gvc, cur);
    GE_STAGE_B(GE_SB(0, 0), cur.b0); GE_STAGE_A(GE_SA(0, 0), cur.a, 0, gvc); GE_STAGE_B(GE_SB(0, 1), cur.b1); GE_STAGE_A(GE_SA(0, 1), cur.a, 1, gvc);
    if (wr == 1) GE_BAR;
    GE_WAIT_V(4); GE_BAR;
    GE_STAGE_B(GE_SB(1, 0), cur.b0 + kstep); GE_STAGE_A(GE_SA(1, 0), cur.a + kstep, 0, gvc); GE_STAGE_B(GE_SB(1, 1), cur.b1 + kstep);
    GE_WAIT_V(6); GE_BAR;
    for (;;) {
        const bool has_next = S.next(ui + 1, nxt);
        if (!has_next) nxt = cur;
        if constexpr (GATHER) { if (has_next) { GE_GATHER_OFFS(gvn, nxt); } else {
#pragma unroll
            for (int h = 0; h < 2; ++h)
#pragma unroll
                for (int i = 0; i < 2; ++i) gvn[h][i] = gvc[h][i]; } }
#pragma unroll 1
        for (int t = 0; t < nt; t += 2) {
            const bool last = (t == nt - 2);
            const char* a1 = cur.a + (size_t)(t + 1) * kstep;
            const char* a2 = last ? nxt.a : cur.a + (size_t)(t + 2) * kstep;
            const char* b20 = last ? nxt.b0 : cur.b0 + (size_t)(t + 2) * kstep;
            const char* b21 = last ? nxt.b1 : cur.b1 + (size_t)(t + 2) * kstep;
            const char* a3 = a2 + kstep; const char* b30 = b20 + kstep; const char* b31 = b21 + kstep;
            unsigned gv2[2][2];
            if constexpr (GATHER) {
#pragma unroll
                for (int h = 0; h < 2; ++h)
#pragma unroll
                    for (int i = 0; i < 2; ++i) gv2[h][i] = last ? gvn[h][i] : gvc[h][i]; }
            GE_LDB(B0, 0, 0); GE_SCHED; GE_LDA(At, 0, 0); GE_STAGE_A(GE_SA(1, 1), a1, 1, gvc);
            GE_WAIT_L(8); GE_BAR; GE_WAIT_L(0); GE_MMA(0, 0, At, B0); GE_BAR; GE_SCHED;
            GE_LDB(B1, 0, 1); GE_STAGE_B(GE_SB(0, 0), b20);
            GE_BAR; GE_WAIT_L(0); GE_MMA(0, 1, At, B1); GE_BAR;
            GE_LDA(At, 0, 1); GE_STAGE_A(GE_SA(0, 0), a2, 0, gv2);
            GE_BAR; GE_WAIT_L(0); GE_MMA(1, 0, At, B0); GE_BAR; GE_SCHED;
            GE_STAGE_B(GE_SB(0, 1), b21);
            GE_WAIT_V(6); GE_BAR; GE_MMA(1, 1, At, B1); GE_BAR;
            GE_LDB(B0, 1, 0); GE_SCHED; GE_LDA(At, 1, 0); GE_STAGE_A(GE_SA(0, 1), a2, 1, gv2);
            GE_WAIT_L(8); GE_BAR; GE_WAIT_L(0); GE_MMA(0, 0, At, B0); GE_BAR; GE_SCHED;
            GE_LDB(B1, 1, 1); GE_STAGE_B(GE_SB(1, 0), b30);
            GE_BAR; GE_WAIT_L(0); GE_MMA(0, 1, At, B1); GE_BAR;
            GE_LDA(At, 1, 1); GE_STAGE_A(GE_SA(1, 0), a3, 0, gv2);
            GE_BAR; GE_WAIT_L(0); GE_MMA(1, 0, At, B0); GE_BAR; GE_SCHED;
            GE_STAGE_B(GE_SB(1, 1), b31);
            GE_WAIT_V(6); GE_BAR; GE_MMA(1, 1, At, B1); GE_BAR;
        }
        E(acc, cur, wr, wc, fr, fq);
        if (!has_next) break;
#pragma unroll
        for (int a = 0; a < 2; ++a)
#pragma unroll
            for (int b = 0; b < 2; ++b)
#pragma unroll
                for (int m = 0; m < 4; ++m)
#pragma unroll
                    for (int n = 0; n < 2; ++n) acc[a][b][m][n] = (f32x4){0.f, 0.f, 0.f, 0.f};
        cur = nxt; ++ui;
        if constexpr (GATHER) {
#pragma unroll
            for (int h = 0; h < 2; ++h)
#pragma unroll
                for (int i = 0; i < 2; ++i) gvc[h][i] = gvn[h][i]; }
    }
    GE_WAIT_V(0);
    if (wr == 0) GE_BAR;
    GE_BAR;
#undef GE_SA
#undef GE_SB
#undef GE_GLDS
#undef GE_STAGE_A
#undef GE_STAGE_B
#undef GE_LDA
#undef GE_LDB
#undef GE_MMA
#undef GE_WAIT_V
#undef GE_WAIT_L
#undef GE_BAR
#undef GE_SCHED
#undef GE_GATHER_OFFS
}
}
__device__ __forceinline__ unsigned cvt_pk_bf16(float lo, float hi) { unsigned r; asm volatile("v_cvt_pk_bf16_f32 %0, %1, %2" : "=v"(r) : "v"(lo), "v"(hi)); return r; }
__device__ __forceinline__ u32x4 pack8(const f32x4 a, const f32x4 b) { u32x4 w; w.x = cvt_pk_bf16(a[0], a[1]); w.y = cvt_pk_bf16(a[2], a[3]); w.z = cvt_pk_bf16(b[0], b[1]); w.w = cvt_pk_bf16(b[2], b[3]); return w; }
__device__ __forceinline__ void unpack8(const u32x4 w, f32x4& a, f32x4& b) {
    a[0] = __uint_as_float(w.x << 16); a[1] = __uint_as_float(w.x & 0xFFFF0000u); a[2] = __uint_as_float(w.y << 16); a[3] = __uint_as_float(w.y & 0xFFFF0000u);
    b[0] = __uint_as_float(w.z << 16); b[1] = __uint_as_float(w.z & 0xFFFF0000u); b[2] = __uint_as_float(w.w << 16); b[3] = __uint_as_float(w.w & 0xFFFF0000u); }
__device__ __forceinline__ float sigmoidf_fast(float v) { return 1.0f / (1.0f + __expf(-v)); }

struct SchedDense {
    const char* A; const char* B; size_t arb, brb; int nM, nN, G, c;
    __device__ __forceinline__ bool next(int i, ge::Unit& u) const {
        const int L = i * G + c; if (L >= nM * nN) return false;
        int pm, pn; ge::tile_order(L, nM, nN, pm, pn);
        u.pm = pm; u.pn = pn; u.kind = 0; u.rows = nullptr; u.nrows = 0;
        u.a = A + (size_t)pm * 256 * arb; u.b0 = B + (size_t)pn * 256 * brb; u.b1 = u.b0 + 128 * brb; return true;
    }
};
struct SchedInproj {
    const char* WtHy; const char* WtRest; const char* U; int G, c;
    __device__ __forceinline__ bool next(int i, ge::Unit& u) const {
        const int L = i * G + c; if (L >= 408 + 748) return false;
        int pm, pn; u.rows = nullptr; u.nrows = 0;
        if (L < 408) { ge::tile_order(L, 6, 68, pm, pn); u.kind = 0; u.a = WtHy + (size_t)pm * 256 * 2048; u.b0 = U + (size_t)pn * 256 * 2048; }
        else { ge::tile_order(L - 408, 68, 11, pm, pn); u.kind = 1; u.a = U + (size_t)pm * 256 * 2048; u.b0 = WtRest + (size_t)pn * 256 * 2048; }
        u.b1 = u.b0 + 128 * 2048; u.pm = pm; u.pn = pn; return true;
    }
};
struct EpiInproj {
    bf16_t* PT; bf16_t* PTc; float* PMLA; bf16_t* G;
    __device__ __forceinline__ void operator()(const ge::Acc& acc, const ge::Unit& u, int wr, int wc, int fr, int fq) const {
#pragma unroll
        for (int ai = 0; ai < 2; ++ai)
#pragma unroll
            for (int m = 0; m < 4; ++m) {
                const int r = u.pm * 256 + ai * 128 + wr * 64 + m * 16 + fr;
#pragma unroll
                for (int bj = 0; bj < 2; ++bj) {
                    const int c0 = bj * 128 + wc * 32 + fq * 8;
                    if (u.kind == 0) {
                        bf16_t* dst = (u.pn < 64) ? PT + ((size_t)((u.pn >> 4) * HYC + r)) * SEQ + (u.pn & 15) * 256 + c0
                                                  : PTc + ((size_t)((u.pn - 64) * HYC + r)) * CTXL + c0;
                        *(u32x4*)dst = pack8(acc[ai][bj][m][0], acc[ai][bj][m][1]);
                    } else if (u.pn < 3) {
                        const int c = u.pn * 256 + c0;
                        if (c < MLAW) { float* dst = PMLA + (size_t)r * MLAW + c; *(f32x4*)dst = acc[ai][bj][m][0]; *(f32x4*)(dst + 4) = acc[ai][bj][m][1]; }
                    } else {
                        const int c = (u.pn - 3) * 256 + c0;
                        f32x4 a = acc[ai][bj][m][0], b = acc[ai][bj][m][1];
#pragma unroll
                        for (int j = 0; j < 4; ++j) { a[j] = sigmoidf_fast(a[j]); b[j] = sigmoidf_fast(b[j]); }
                        *(u32x4*)(G + (size_t)r * 2048 + c) = pack8(a, b);
                    }
                }
            }
    }
};
struct EpiQ {
    bf16_t* Q; bf16_t* Qc; const float2* rope;
    __device__ __forceinline__ void operator()(const ge::Acc& acc, const ge::Unit& u, int wr, int wc, int fr, int fq) const {
#pragma unroll
        for (int ai = 0; ai < 2; ++ai)
#pragma unroll
            for (int m = 0; m < 4; ++m) {
                const int r = u.pm * 256 + ai * 128 + wr * 64 + m * 16 + fr;
                const bool lat = r < TL;
                const int t = lat ? (r & 4095) : ((r - TL) & 255);
                const int b = lat ? (r >> 12) : ((r - TL) >> 8);
#pragma unroll
                for (int bj = 0; bj < 2; ++bj) {
                    const int c = u.pn * 256 + bj * 128 + wc * 32 + fq * 8;
                    const int h = c / 96, dd = c - h * 96;
                    f32x4 v0 = acc[ai][bj][m][0] * QSCALE, v1 = acc[ai][bj][m][1] * QSCALE;
                    f32x4 p0, p1;
#pragma unroll
                    for (int j = 0; j < 4; ++j) { p0[j] = __shfl_xor(v0[j], 16); p1[j] = __shfl_xor(v1[j], 16); }
                    bf16_t* qrow = lat ? Q + ((size_t)(b * NH + h) * SEQ + t) * 128 : Qc + ((size_t)(b * NH + h) * CTXL + t) * 128;
                    if (dd < 64) *(u32x4*)(qrow + dd) = pack8(v0, v1);
                    else {
                        const int d0 = dd - 64;
                        f32x4 o0 = v0, o1 = v1;
                        if (lat) {
                            const float2* rp = rope + (size_t)t * 16 + (d0 >> 4) * 8;
                            const bool s1 = (d0 >> 3) & 1;
#pragma unroll
                            for (int j = 0; j < 4; ++j) {
                                const float2 ca = rp[j], cb = rp[4 + j];
                                o0[j] = s1 ? p0[j] * ca.y + v0[j] * ca.x : v0[j] * ca.x - p0[j] * ca.y;
                                o1[j] = s1 ? p1[j] * cb.y + v1[j] * cb.x : v1[j] * cb.x - p1[j] * cb.y;
                            }
                        }
                        *(u32x4*)(qrow + 64 + d0) = pack8(o0, o1);
                        *(u32x4*)(qrow + 96 + d0) = pack8(v0, v1);
                    }
                }
            }
    }
};
struct EpiKV {
    bf16_t* K; bf16_t* V;
    __device__ __forceinline__ void operator()(const ge::Acc& acc, const ge::Unit& u, int wr, int wc, int fr, int fq) const {
#pragma unroll
        for (int ai = 0; ai < 2; ++ai)
#pragma unroll
            for (int m = 0; m < 4; ++m) {
                const int r = u.pm * 256 + ai * 128 + wr * 64 + m * 16 + fr;
                int b, key;
                if (r < TL) { b = r >> 12; key = r & 4095; } else { b = (r - TL) >> 8; key = SEQ + ((r - TL) & 255); }
#pragma unroll
                for (int bj = 0; bj < 2; ++bj) {
                    const int c = u.pn * 256 + bj * 128 + wc * 32 + fq * 8;
                    const int h = c >> 7, d = c & 127;
                    const size_t kb = (size_t)(b * NH + h) * NKEY + key;
                    bf16_t* dst = (d < 64) ? K + kb * DQK + d : V + kb * DV + (d - 64);
                    *(u32x4*)dst = pack8(acc[ai][bj][m][0], acc[ai][bj][m][1]);
                }
            }
    }
};
struct SchedMerge {
    const char* Yhy; const char* Yatt; const char* Whyo; const char* Wmlao; int G, c;
    __device__ __forceinline__ bool next(int i, ge::Unit& u) const {
        const int T = (i >> 1) * G + c; if (T >= 272) return false;
        const int seg = i & 1; int pm, pn; ge::tile_order(T, 68, 4, pm, pn);
        u.pm = pm; u.pn = pn; u.kind = seg; u.rows = nullptr; u.nrows = 0;
        u.a = (seg ? Yatt : Yhy) + (size_t)pm * 256 * 1024; u.b0 = (seg ? Wmlao : Whyo) + (size_t)pn * 256 * 1024; u.b1 = u.b0 + 128 * 1024; return true;
    }
};
struct EpiMerge {
    const bf16_t* G; bf16_t* M1;
    __device__ __forceinline__ void operator()(const ge::Acc& acc, const ge::Unit& u, int wr, int wc, int fr, int fq) const {
#pragma unroll
        for (int ai = 0; ai < 2; ++ai)
#pragma unroll
            for (int m = 0; m < 4; ++m) {
                const int r = u.pm * 256 + ai * 128 + wr * 64 + m * 16 + fr;
#pragma unroll
                for (int bj = 0; bj < 2; ++bj) {
                    const int c = u.pn * 256 + bj * 128 + wc * 32 + fq * 8;
                    f32x4 g0, g1; unpack8(*(const u32x4*)(G + (size_t)r * 2048 + u.kind * DM + c), g0, g1);
                    f32x4 o0 = g0 * acc[ai][bj][m][0], o1 = g1 * acc[ai][bj][m][1];
                    bf16_t* dst = M1 + (size_t)r * DM + c;
                    if (u.kind) { f32x4 q0, q1; unpack8(*(const u32x4*)dst, q0, q1); o0 += q0; o1 += q1; }
                    *(u32x4*)dst = pack8(o0, o1);
                }
            }
    }
};
struct EpiOut {
    float* hx; const float* mod;
    __device__ __forceinline__ void operator()(const ge::Acc& acc, const ge::Unit& u, int wr, int wc, int fr, int fq) const {
#pragma unroll
        for (int ai = 0; ai < 2; ++ai)
#pragma unroll
            for (int m = 0; m < 4; ++m) {
                const int r = u.pm * 256 + ai * 128 + wr * 64 + m * 16 + fr;
                const int b = r < TL ? (r >> 12) : 4;
#pragma unroll
                for (int bj = 0; bj < 2; ++bj) {
                    const int c = u.pn * 256 + bj * 128 + wc * 32 + fq * 8;
                    const float* g = mod + (size_t)b * NMOD + 2 * DM + c;
                    float* dst = hx + (size_t)r * DM + c;
                    *(f32x4*)dst = *(const f32x4*)dst + *(const f32x4*)g * acc[ai][bj][m][0];
                    *(f32x4*)(dst + 4) = *(const f32x4*)(dst + 4) + *(const f32x4*)(g + 4) * acc[ai][bj][m][1];
                }
            }
    }
};
struct SchedGU {
    const char* U; const char* WtG; const char* WtU; const int* list; const LAS int* tpre; const LAS int* cntl; int G, c;
    __device__ __forceinline__ bool next(int i, ge::Unit& u) const {
        const int L = i * G + c; if (L >= 2 * tpre[64]) return false;
        const int rt = L >> 1, half = L & 1; int e = 0; while (tpre[e + 1] <= rt) ++e;
        u.kind = e; u.pm = rt - tpre[e]; u.pn = half; u.rows = list + (size_t)e * CAP; u.nrows = cntl[e];
        u.a = U; u.b0 = WtG + ((size_t)e * DE + half * 128) * 2048; u.b1 = WtU + ((size_t)e * DE + half * 128) * 2048; return true;
    }
};
struct EpiGU {
    bf16_t* H; const LAS int* offs;
    __device__ __forceinline__ void operator()(const ge::Acc& acc, const ge::Unit& u, int wr, int wc, int fr, int fq) const {
        const int o = offs[u.kind];
#pragma unroll
        for (int ai = 0; ai < 2; ++ai)
#pragma unroll
            for (int m = 0; m < 4; ++m) {
                const int r = u.pm * 256 + ai * 128 + wr * 64 + m * 16 + fr;
                if (r < u.nrows) {
                    const int c = u.pn * 128 + wc * 32 + fq * 8;
                    f32x4 g0 = acc[ai][0][m][0], g1 = acc[ai][0][m][1];
#pragma unroll
                    for (int j = 0; j < 4; ++j) { g0[j] = g0[j] * sigmoidf_fast(g0[j]) * acc[ai][1][m][0][j]; g1[j] = g1[j] * sigmoidf_fast(g1[j]) * acc[ai][1][m][1][j]; }
                    *(u32x4*)(H + (size_t)(o + r) * DE + c) = pack8(g0, g1);
                }
            }
    }
};
struct SchedDown {
    const char* H; const char* WtD; const LAS int* tpre; const LAS int* cntl; const LAS int* offs; int G, c;
    __device__ __forceinline__ bool next(int i, ge::Unit& u) const {
        const int L = i * G + c; if (L >= 4 * tpre[64]) return false;
        const int rt = L >> 2, pn = L & 3; int e = 0; while (tpre[e + 1] <= rt) ++e;
        u.kind = e; u.pm = rt - tpre[e]; u.pn = pn; u.rows = nullptr; u.nrows = cntl[e];
        u.a = H + ((size_t)offs[e] + (size_t)u.pm * 256) * 512; u.b0 = WtD + ((size_t)e * DM + pn * 256) * 512; u.b1 = u.b0 + 128 * 512; return true;
    }
};
struct EpiDown {
    bf16_t* Y; const float* wl; const LAS int* offs;
    __device__ __forceinline__ void operator()(const ge::Acc& acc, const ge::Unit& u, int wr, int wc, int fr, int fq) const {
        const int o = offs[u.kind];
#pragma unroll
        for (int ai = 0; ai < 2; ++ai)
#pragma unroll
            for (int m = 0; m < 4; ++m) {
                const int r = u.pm * 256 + ai * 128 + wr * 64 + m * 16 + fr;
                if (r < u.nrows) {
                    const float w = wl[(size_t)u.kind * CAP + r];
#pragma unroll
                    for (int bj = 0; bj < 2; ++bj) {
                        const int c = u.pn * 256 + bj * 128 + wc * 32 + fq * 8;
                        *(u32x4*)(Y + (size_t)(o + r) * DM + c) = pack8(acc[ai][bj][m][0] * w, acc[ai][bj][m][1] * w);
                    }
                }
            }
    }
};

__device__ __forceinline__ void conv_tile(bf16_t* tile, const float* src, int ld, int c0, int ncols, int K, bf16_t* dst, int kt, int ntile) {
    const int tid = tid_opaque();
    const int k = tid >> 3, n8 = (tid & 7) * 8, nbase = ntile * 64;
    float4 x0 = make_float4(0.f, 0.f, 0.f, 0.f), x1 = x0;
    if (nbase + n8 < ncols) { const float* sp = src + (size_t)(kt * 64 + k) * ld + c0 + nbase + n8; x0 = *(const float4*)sp; x1 = *(const float4*)(sp + 4); }
    __syncthreads();
    tile[(n8 + 0) * 72 + k] = f2bf(x0.x); tile[(n8 + 1) * 72 + k] = f2bf(x0.y); tile[(n8 + 2) * 72 + k] = f2bf(x0.z); tile[(n8 + 3) * 72 + k] = f2bf(x0.w);
    tile[(n8 + 4) * 72 + k] = f2bf(x1.x); tile[(n8 + 5) * 72 + k] = f2bf(x1.y); tile[(n8 + 6) * 72 + k] = f2bf(x1.z); tile[(n8 + 7) * 72 + k] = f2bf(x1.w);
    __syncthreads();
    const int n = tid >> 3, k8 = (tid & 7) * 8;
    if (nbase + n < ncols) *(u32x4*)(dst + (size_t)(nbase + n) * K + kt * 64 + k8) = *(const u32x4*)(tile + n * 72 + k8);
}
constexpr int DENSE_TILES = 1720;
__device__ __forceinline__ void ph_conv_dense(const P& p, char* smem) {
    bf16_t* tile = (bf16_t*)smem;
    for (int id = blockIdx.x; id < DEPTH * DENSE_TILES; id += gridDim.x) {
        const int l = id / DENSE_TILES; int r = id % DENSE_TILES;
        const float* win = p.w_in + (size_t)l * DM * INC;
        if (r < 384) conv_tile(tile, win, INC, 0, HYC, DM, p.WtHy + (size_t)l * HYC * DM, r / 24, r % 24);
        else if ((r -= 384) < 176) conv_tile(tile, win, INC, HYC, MLAW, DM, p.WtRest + (size_t)l * 2816 * DM, r / 11, r % 11);
        else if ((r -= 176) < 512) conv_tile(tile, win, INC, MLA_END, 2048, DM, p.WtRest + ((size_t)l * 2816 + 768) * DM, r / 32, r % 32);
        else if ((r -= 512) < 72) conv_tile(tile, p.w_uq + (size_t)l * QL * 768, 768, 0, 768, QL, p.WtUq + (size_t)l * 768 * QL, r / 12, r % 12);
        else if ((r -= 72) < 64) conv_tile(tile, p.w_ukv + (size_t)l * KVL * 1024, 1024, 0, 1024, KVL, p.WtUkv + (size_t)l * 1024 * KVL, r / 16, r % 16);
        else if ((r -= 64) < 128) conv_tile(tile, p.w_hy_o + (size_t)l * HYW * DM, DM, 0, DM, HYW, p.WtHyo + (size_t)l * DM * HYW, r / 16, r % 16);
        else if ((r -= 128) < 128) conv_tile(tile, p.w_mla_o + (size_t)l * 512 * DM, DM, 0, DM, 512, p.WtMlao + (size_t)l * DM * 512, r / 16, r % 16);
        else { r -= 128; conv_tile(tile, p.w_out + (size_t)l * DM * DM, DM, 0, DM, DM, p.WtOut + (size_t)l * DM * DM, r / 16, r % 16); }
    }
    const int nz = DEPTH * 96 * DM / 8;
    for (int i = blockIdx.x * NT + threadIdx.x; i < nz + SEQ * 16; i += gridDim.x * NT) {
        if (i < nz) { const int l = i / (96 * DM / 8), o = i % (96 * DM / 8); *(u32x4*)(p.WtRest + ((size_t)l * 2816 + MLAW) * DM + (size_t)o * 8) = (u32x4){0u, 0u, 0u, 0u}; }
        else { const int k = i - nz, t = k >> 4, a = (k >> 3) & 1, ii = k & 7; const float ang = (float)(a == 0 ? (t >> 6) : (t & 63)) * powf(10000.0f, -(float)ii / 8.0f); p.rope[k] = make_float2(cosf(ang), sinf(ang)); }
    }
}
__device__ __forceinline__ void ph_conv_experts(const P& p, int l, char* smem) {
    bf16_t* tile = (bf16_t*)smem;
    for (int id = blockIdx.x; id < NE * 192; id += gridDim.x) {
        const int e = id / 192; int r = id % 192;
        const size_t le = (size_t)l * NE + e;
        if (r < 64) conv_tile(tile, p.w_gate + le * DM * DE, DE, 0, DE, DM, p.WtG + (size_t)e * DE * DM, r / 4, r % 4);
        else if (r < 128) { r -= 64; conv_tile(tile, p.w_up + le * DM * DE, DE, 0, DE, DM, p.WtU + (size_t)e * DE * DM, r / 4, r % 4); }
        else { r -= 128; conv_tile(tile, p.w_down + le * DE * DM, DM, 0, DM, DE, p.WtD + (size_t)e * DM * DE, r / 16, r % 16); }
    }
    __syncthreads();
}

constexpr int LDS_TAB = ge::STAGE_BYTES;
constexpr int LDS_TOTAL = ge::STAGE_BYTES + 2048;
#define PH_P KArgP kp_ = (KArgP)__builtin_amdgcn_kernarg_segment_ptr(); asm volatile("" : "+s"(kp_)); const P p = make_p(kp_); int G = gridDim.x, c = blockIdx.x; asm volatile("" : "+s"(G), "+s"(c)); (void)G; (void)c;
#define GRID_BAR() do { XcdBarrier b_; b_.bar = (unsigned*)k.ws; b_.x = xb_xcc_id(); b_.st = xbw; xcd_barrier(b_); } while (0)
__global__ __launch_bounds__(NT, 2) void mega(PK k) {
    extern __shared__ __attribute__((aligned(16))) char smem[];
    LAS unsigned char* lds = (LAS unsigned char*)smem;
    volatile LAS unsigned* xbw = (volatile LAS unsigned*)(smem + LDS_TOTAL - 16);
    if (threadIdx.x == 0) { xbw[0] = 0u; xbw[1] = 0u; xbw[2] = 0u; xbw[3] = 0u; }
    __syncthreads();
    (void)xcd_barrier_post((unsigned*)k.ws, xbw);
    int* offs = (int*)(smem + LDS_TAB); int* tpre = offs + 65; int* cntl = tpre + 65;
    const LAS int* offs_l = (const LAS int*)(lds + LDS_TAB); const LAS int* tpre_l = offs_l + 65; const LAS int* cntl_l = tpre_l + 65;
    { PH_P ph_copy_h(p); ph_mod_partial(p, smem); ph_filter_a(p, smem); ph_conv_dense(p, smem); }
    GRID_BAR();
    { PH_P ph_filter_b(p, smem); }
    GRID_BAR();
    { PH_P ph_finalize(p); }
    GRID_BAR();
    for (int l = 0; l < DEPTH; ++l) {
        { PH_P ph_norm<1>(p, l, smem); }
        GRID_BAR();
        { PH_P
            SchedInproj S{(const char*)(p.WtHy + (size_t)l * HYC * DM), (const char*)(p.WtRest + (size_t)l * 2816 * DM), (const char*)p.U, G, c};
            EpiInproj E{p.PT, p.PTc, p.PMLA, p.G};
            ge::gemm_engine<false>(lds, DM, DM, DM, S, E);
        }
        GRID_BAR();
        { PH_P ph_mla_prep(p, l); }
        GRID_BAR();
        { PH_P
            SchedDense S{(const char*)p.CQ, (const char*)(p.WtUq + (size_t)l * 768 * QL), (size_t)QL * 2, (size_t)QL * 2, 68, 3, G, c};
            EpiQ E{p.Q, p.Qc, p.rope};
            ge::gemm_engine<false>(lds, QL, QL, QL, S, E);
        }
        { PH_P
            SchedDense S2{(const char*)p.CKV, (const char*)(p.WtUkv + (size_t)l * 1024 * KVL), (size_t)KVL * 2, (size_t)KVL * 2, 68, 4, G, (c + G - (204 % G)) % G};
            EpiKV E2{p.K, p.V};
            ge::gemm_engine<false>(lds, KVL, KVL, KVL, S2, E2);
        }
        GRID_BAR();
        { PH_P ph_conv_experts(p, l, smem); }
        { PH_P ph_attn(p, smem); }
        { PH_P ph_hyena<SEQ>(p, l, smem); }
        { PH_P ph_hyena<CTXL>(p, l, smem); }
        GRID_BAR();
        { PH_P
            SchedMerge S{(const char*)p.Yhy, (const char*)p.Yatt, (const char*)(p.WtHyo + (size_t)l * DM * HYW), (const char*)(p.WtMlao + (size_t)l * DM * 512), G, c};
            EpiMerge E{p.G, p.M1};
            ge::gemm_engine<false>(lds, 512, 512, 512, S, E);
        }
        GRID_BAR();
        { PH_P
            SchedDense S{(const char*)p.M1, (const char*)(p.WtOut + (size_t)l * DM * DM), (size_t)DM * 2, (size_t)DM * 2, 68, 4, G, c};
            EpiOut E{p.hx, p.mod + (size_t)l * 5 * NMOD};
            ge::gemm_engine<false>(lds, DM, DM, DM, S, E);
        }
        GRID_BAR();
        { PH_P ph_norm<2>(p, l, smem); }
        GRID_BAR();
        { PH_P
            if (threadIdx.x == 0) { int a = 0, t = 0; for (int e = 0; e < NE; ++e) { const int n = p.cnt[l * NE + e]; offs[e] = a; tpre[e] = t; cntl[e] = n; a += n; t += (n + 255) >> 8; } offs[64] = a; tpre[64] = t; }
            __syncthreads();
            SchedGU S{(const char*)p.U, (const char*)p.WtG, (const char*)p.WtU, p.list, tpre_l, cntl_l, G, c};
            EpiGU E{p.Hb, offs_l};
            ge::gemm_engine<true>(lds, DM, DM, DM, S, E);
        }
        GRID_BAR();
        { PH_P
            SchedDown S{(const char*)p.Hb, (const char*)p.WtD, tpre_l, cntl_l, offs_l, G, c};
            EpiDown E{p.Y, p.wl, offs_l};
            ge::gemm_engine<false>(lds, DE, DE, DE, S, E);
        }
        GRID_BAR();
        { PH_P ph_combine(p, l, offs); }
        GRID_BAR();
    }
    { PH_P ph_final(p); }
}

extern "C" void kernel_launch(void* const* d_in, const int* in_sizes, int n_in, void* d_out, int out_size, void* d_ws, size_t ws_size, hipStream_t stream) {
    (void)in_sizes; (void)out_size;
    if (n_in < 33 || WSO.total > ws_size) { fprintf(stderr, "kernel_launch: need 33 inputs and %zu bytes of workspace; got %d, %zu\n", (size_t)WSO.total, n_in, ws_size); return; }
    PK k{};
    for (int i = 0; i < 33; ++i) k.in[i] = (const float*)d_in[i];
    k.out = (float*)d_out; k.ws = (char*)d_ws;
    (void)hipMemsetAsync(d_ws, 0, WS_ZERO_BYTES, stream);
    static int grid = 0;
    if (!grid) {
        int dev = 0, cus = 0, per_cu = 0;
        (void)hipGetDevice(&dev);
        (void)hipDeviceGetAttribute(&cus, hipDeviceAttributeMultiprocessorCount, dev);
        (void)hipFuncSetAttribute((const void*)mega, hipFuncAttributeMaxDynamicSharedMemorySize, LDS_TOTAL);
        (void)hipOccupancyMaxActiveBlocksPerMultiprocessor(&per_cu, (const void*)mega, NT, LDS_TOTAL);
        if (per_cu < 1) fprintf(stderr, "kernel_launch: occupancy query reports %d blocks per CU\n", per_cu);
        grid = cus > 0 ? cus : 256;
    }
    hipLaunchKernelGGL(mega, dim3(grid), dim3(NT), LDS_TOTAL, stream, k);
}
```

```cpp
#include <hip/hip_runtime.h>
#include <stdint.h>
#include <stdio.h>

typedef unsigned short bf16_t;
typedef short bf16x8 __attribute__((ext_vector_type(8)));
typedef float f32x4 __attribute__((ext_vector_type(4)));
typedef unsigned u32x4 __attribute__((ext_vector_type(4)));
typedef unsigned u32x2 __attribute__((ext_vector_type(2)));

#define NT 512
constexpr int DM = 1024, NB = 4, SEQ = 4096, DEPTH = 4, CTXL = 256;
constexpr int TL = NB * SEQ, TC = NB * CTXL, TT = TL + TC;
constexpr int HYW = 512, HYC = 1536, QL = 384, KVL = 256, QKR = 32;
constexpr int MLAW = QL + KVL + QKR, MLA_END = HYC + MLAW, INC = MLA_END + 2 * DM;
constexpr int NH = 8, DQK = 96, DV = 64, NKEY = SEQ + CTXL;
constexpr int NE = 64, DE = 256, CAP = TT;
constexpr int NMOD = 6 * DM;
constexpr float EPSF = 1e-6f;
constexpr float QSCALE = 0.10206207261596577f * 1.4426950408889634f;

__device__ __forceinline__ bf16_t f2bf(float f) { unsigned u = __float_as_uint(f); u += 0x7FFFu + ((u >> 16) & 1u); return (bf16_t)(u >> 16); }
__device__ __forceinline__ float bf2f(bf16_t b) { return __uint_as_float(((unsigned)b) << 16); }
__device__ __forceinline__ unsigned pack2(float lo, float hi) { return (unsigned)f2bf(lo) | ((unsigned)f2bf(hi) << 16); }
__device__ __forceinline__ int tid_opaque() { int t = threadIdx.x; asm volatile("" : "+v"(t)); return t; }
__device__ __forceinline__ float wave_sum(float v) {
#pragma unroll
    for (int o = 32; o > 0; o >>= 1) v += __shfl_xor(v, o);
    return v;
}


#define XB_TMO      128
#define XB_XCNT(j)  (256  + 64 * (j))
#define XB_XSUB(j)  (1280 + 64 * (j))
#define XB_XGEN(j)  (2304 + 64 * (j))
#define XB_TOP      3328
#define XB_TOPGEN   3392
#define XCD_BAR_WORDS 3456
#define XB_SPIN_CAP (1u << 22)
#define LAS __attribute__((address_space(3)))
__device__ __forceinline__ unsigned xb_ld(unsigned* p)              { return __hip_atomic_load(p, __ATOMIC_RELAXED, __HIP_MEMORY_SCOPE_AGENT); }
__device__ __forceinline__ unsigned xb_add(unsigned* p, unsigned v) { return __hip_atomic_fetch_add(p, v, __ATOMIC_RELAXED, __HIP_MEMORY_SCOPE_AGENT); }
__device__ __forceinline__ unsigned xb_xcc_id() { return (unsigned)__builtin_amdgcn_s_getreg((3 << 11) | 20) & 0xFu; }
#define XB_SPIN(cond, bar) do { unsigned _sp = 0; while (cond) { __builtin_amdgcn_s_sleep(1); \
    if ((++_sp & 255u) == 0u) { if (xb_ld(&(bar)[XB_TMO])) break; if (_sp > XB_SPIN_CAP) { atomicAdd(&(bar)[XB_TMO], 1u); break; } } } } while (0)
struct XcdBarrier { unsigned* bar; unsigned x; volatile LAS unsigned* st; };
__device__ __forceinline__ XcdBarrier xcd_barrier_post(unsigned* bar, volatile LAS unsigned* st) {
    XcdBarrier b; b.bar = bar; b.x = xb_xcc_id(); b.st = st;
    if (threadIdx.x == 0) (void)xb_add(&bar[XB_XCNT(b.x)], 1u);
    return b;
}
__device__ __forceinline__ void xcd_barrier_complete(unsigned* bar, unsigned x, unsigned& nloc, unsigned& nx) {
    const unsigned G = gridDim.x * gridDim.y * gridDim.z;
    unsigned sum, cnt, mine, sp = 0u;
    for (;;) {
        sum = 0u; cnt = 0u; mine = 0u;
#pragma unroll
        for (unsigned j = 0; j < 16; ++j) { const unsigned c = xb_ld(&bar[XB_XCNT(j)]); sum += c; cnt += (c > 0u) ? 1u : 0u; mine = (j == x) ? c : mine; }
        if (sum == G) break;
        __builtin_amdgcn_s_sleep(1);
        if ((++sp & 255u) == 0u) { if (xb_ld(&bar[XB_TMO])) break; if (sp > XB_SPIN_CAP) { atomicAdd(&bar[XB_TMO], 1u); break; } }
    }
    nloc = mine > 0u ? mine : 1u; nx = cnt > 0u ? cnt : 1u;
}
__device__ __forceinline__ void xcd_barrier(const XcdBarrier& b) {
    asm volatile("s_waitcnt vmcnt(0)" ::: "memory");
    __syncthreads();
    if (threadIdx.x == 0) {
        unsigned* bar = b.bar;
        __builtin_amdgcn_s_waitcnt(0);
        unsigned nloc = b.st[0], nx = b.st[1];
        if (nloc == 0u) { xcd_barrier_complete(bar, b.x, nloc, nx); b.st[0] = nloc; b.st[1] = nx; }
        const unsigned old = xb_add(&bar[XB_XSUB(b.x)], 1u);
        const unsigned gen = old / nloc;
        if (old + 1u == (gen + 1u) * nloc) {
            __builtin_amdgcn_fence(__ATOMIC_RELEASE, "agent");
            asm volatile("s_waitcnt vmcnt(0)" ::: "memory");
            const unsigned og = xb_add(&bar[XB_TOP], 1u);
            const unsigned tg = og / nx;
            if (og + 1u == (tg + 1u) * nx) xb_add(&bar[XB_TOPGEN], 1u);
            else XB_SPIN(xb_ld(&bar[XB_TOPGEN]) == tg, bar);
            __builtin_amdgcn_fence(__ATOMIC_ACQUIRE, "agent");
            xb_add(&bar[XB_XGEN(b.x)], 1u);
            asm volatile("s_waitcnt vmcnt(0)" ::: "memory");
        } else {
            XB_SPIN(xb_ld(&bar[XB_XGEN(b.x)]) == gen, bar);
            __builtin_amdgcn_fence(__ATOMIC_ACQUIRE, "agent");
            asm volatile("s_waitcnt vmcnt(0)" ::: "memory");
        }
    }
    __syncthreads();
}

#define WS_LIST(X) \
    X(unsigned, bar, XCD_BAR_WORDS * 4)                         \
    X(int, cnt, DEPTH * 64 * 4)                                 \
    X(float, modp, (size_t)DEPTH * 8 * 5 * NMOD * 4)            \
    X(float, mod, (size_t)DEPTH * 5 * NMOD * 4)                 \
    X(float, H2a, (size_t)DEPTH * SEQ * 64 * 4) \
    X(float, H2b, (size_t)DEPTH * CTXL * 64 * 4) \
    X(float, HT1, (size_t)DEPTH * 2048 * CTXL * 4) \
    X(float, SSQ0, (size_t)DEPTH * 2048 * 64 * 4) \
    X(float, SSQ1, (size_t)DEPTH * 2048 * 4 * 4) \
    X(float, SCL0, (size_t)DEPTH * 2048 * 4) \
    X(float, SCL1, (size_t)DEPTH * 2048 * 4) \
    X(float, hx, (size_t)TT * DM * 4)                           \
    X(bf16_t, U, (size_t)TT * DM * 2)                           \
    X(bf16_t, PT, (size_t)NB * HYC * SEQ * 2)                   \
    X(bf16_t, PTc, (size_t)NB * HYC * CTXL * 2) \
    X(float, PMLA, (size_t)TT * MLAW * 4)                       \
    X(bf16_t, G, (size_t)TT * 2048 * 2)                         \
    X(bf16_t, CQ, (size_t)TT * QL * 2) \
    X(bf16_t, CKV, (size_t)TT * KVL * 2) \
    X(bf16_t, Q, (size_t)NB * NH * SEQ * 128 * 2)               \
    X(bf16_t, Qc, (size_t)NB * NH * CTXL * 128 * 2) \
    X(bf16_t, K, (size_t)NB * NH * NKEY * DQK * 2)              \
    X(bf16_t, V, (size_t)NB * NH * NKEY * DV * 2)               \
    X(bf16_t, Yatt, (size_t)TT * 512 * 2) \
    X(bf16_t, Yhy, (size_t)TT * 512 * 2) \
    X(bf16_t, M1, (size_t)TT * DM * 2) \
    X(int, list, (size_t)NE * CAP * 4) \
    X(float, wl, (size_t)NE * CAP * 4) \
    X(int, asg, (size_t)TT * 4 * 4) \
    X(bf16_t, Hb, (size_t)(2 * TT + 256) * DE * 2) \
    X(bf16_t, Y, (size_t)2 * TT * DM * 2) \
    X(bf16_t, WtHy, (size_t)DEPTH * HYC * DM * 2)               \
    X(bf16_t, WtRest, (size_t)DEPTH * 2816 * DM * 2) \
    X(bf16_t, WtUq, (size_t)DEPTH * 768 * QL * 2) \
    X(bf16_t, WtUkv, (size_t)DEPTH * 1024 * KVL * 2) \
    X(bf16_t, WtHyo, (size_t)DEPTH * DM * HYW * 2) \
    X(bf16_t, WtMlao, (size_t)DEPTH * DM * 512 * 2) \
    X(bf16_t, WtOut, (size_t)DEPTH * DM * DM * 2) \
    X(bf16_t, WtG, (size_t)NE * DE * DM * 2)                    \
    X(bf16_t, WtU, (size_t)NE * DE * DM * 2) \
    X(bf16_t, WtD, (size_t)NE * DM * DE * 2) \
    X(float2, rope, (size_t)SEQ * 16 * 8)                       \
    X(bf16_t, UT, (size_t)NB * HYC * SEQ * 2)                   \
    X(float2, Hs, (size_t)DEPTH * HYW * 4 * 4096 * 8)           \
    X(float2, Wtab, 4096 * 8) \
    X(float2, W2tab, 4096 * 8)
struct WsOff {
#define X(t, n, b) size_t n;
    WS_LIST(X)
#undef X
    size_t total;
};
constexpr WsOff ws_layout() {
    WsOff o{}; size_t a = 0;
#define X(t, n, b) o.n = a; a += (((size_t)(b)) + 255) & ~(size_t)255;
    WS_LIST(X)
#undef X
    o.total = a; return o;
}
constexpr WsOff WSO = ws_layout();
constexpr size_t WS_ZERO_BYTES = WSO.modp;
static_assert(WSO.V - WSO.G >= (size_t)DEPTH * 2048 * SEQ * 4, "HT0 alias region too small");

struct PK { const float* in[33]; float* out; char* ws; };
struct P {
    const float *x, *c, *ctx, *c_ctx, *w_ada, *b_ada, *norm1_g, *w_in, *q_norm_g, *kv_norm_g, *w_uq, *w_ukv, *sc_w, *sc_b;
    const float *flt_w1, *flt_b1, *flt_freq, *flt_w2, *flt_b2, *flt_w3, *flt_bias, *w_hy_o, *w_mla_o, *w_out, *norm2_g;
    const float *w_rg, *b_rg, *w_re, *b_re, *w_gate, *w_up, *w_down, *final_g;
    float* out;
#define X(t, n, b) t* n;
    WS_LIST(X)
#undef X
    float* HT0;
};
typedef const __attribute__((address_space(4))) PK* KArgP;
__device__ __forceinline__ P make_p(KArgP kp) {
    P p; const KArgP& kk = kp; char* ws = kk->ws;
    p.x = kk->in[0]; p.c = kk->in[1]; p.ctx = kk->in[2]; p.c_ctx = kk->in[3]; p.w_ada = kk->in[4]; p.b_ada = kk->in[5]; p.norm1_g = kk->in[6]; p.w_in = kk->in[7];
    p.q_norm_g = kk->in[8]; p.kv_norm_g = kk->in[9]; p.w_uq = kk->in[10]; p.w_ukv = kk->in[11]; p.sc_w = kk->in[12]; p.sc_b = kk->in[13];
    p.flt_w1 = kk->in[14]; p.flt_b1 = kk->in[15]; p.flt_freq = kk->in[16]; p.flt_w2 = kk->in[17]; p.flt_b2 = kk->in[18]; p.flt_w3 = kk->in[19]; p.flt_bias = kk->in[20];
    p.w_hy_o = kk->in[21]; p.w_mla_o = kk->in[22]; p.w_out = kk->in[23]; p.norm2_g = kk->in[24]; p.w_rg = kk->in[25]; p.b_rg = kk->in[26]; p.w_re = kk->in[27]; p.b_re = kk->in[28];
    p.w_gate = kk->in[29]; p.w_up = kk->in[30]; p.w_down = kk->in[31]; p.final_g = kk->in[32];
    p.out = kk->out;
#define X(t, n, b) p.n = (t*)(ws + WSO.n);
    WS_LIST(X)
#undef X
    p.HT0 = (float*)(ws + WSO.G);
    return p;
}

__device__ __forceinline__ void ph_copy_h(const P& p) {
    const size_t n4 = (size_t)TT * DM / 4, nl4 = (size_t)TL * DM / 4;
    for (size_t i = (size_t)blockIdx.x * NT + threadIdx.x; i < n4; i += (size_t)gridDim.x * NT) {
        float4 v = (i < nl4) ? ((const float4*)p.x)[i] : ((const float4*)p.ctx)[i - nl4];
        ((float4*)p.hx)[i] = v;
    }
}

__device__ __forceinline__ void ph_mod_partial(const P& p, char* smem) {
    float* s = (float*)smem;
    const int tid = tid_opaque();
    for (int it = blockIdx.x; it < DEPTH * 8 * 12; it += gridDim.x) {
        const int l = it / 96, kc = (it / 12) % 8, jb = it % 12;
        __syncthreads();
        for (int i = tid; i < 5 * 128; i += NT) {
            const int r = i / 128, kk = i % 128, k = kc * 128 + kk;
            const float cv = (r < 4) ? p.c[r * DM + k] : p.c_ctx[k];
            s[i] = cv / (1.0f + expf(-cv));
        }
        __syncthreads();
        const int j = jb * 512 + tid;
        float a0 = 0, a1 = 0, a2 = 0, a3 = 0, a4 = 0;
        const float* w = p.w_ada + ((size_t)l * DM + kc * 128) * NMOD + j;
#pragma unroll 8
        for (int kk = 0; kk < 128; ++kk) {
            const float wv = w[(size_t)kk * NMOD];
            a0 += s[kk] * wv; a1 += s[128 + kk] * wv; a2 += s[256 + kk] * wv; a3 += s[384 + kk] * wv; a4 += s[512 + kk] * wv;
        }
        float* o = p.modp + ((size_t)(l * 8 + kc) * 5) * NMOD + j;
        o[0] = a0; o[NMOD] = a1; o[2 * NMOD] = a2; o[3 * NMOD] = a3; o[4 * NMOD] = a4;
    }
}

__device__ __forceinline__ void ph_filter_a(const P& p, char* smem) {
    float* zs = (float*)smem;
    float* h1s = zs + 8 * 36;
    const int tid = tid_opaque(), tt = tid >> 6, j = tid & 63;
    const int n0 = DEPTH * 512, n1 = DEPTH * 32;
    for (int it = blockIdx.x; it < n0 + n1; it += gridDim.x) {
        int l, ls, tg;
        if (it < n0) { ls = 0; l = it / 512; tg = it % 512; } else { ls = 1; l = (it - n0) / 32; tg = (it - n0) % 32; }
        const int L = ls ? CTXL : SEQ;
        const int t = tg * 8 + tt;
        __syncthreads();
        if (j < 33) {
            float f;
            if (j == 0) f = (float)t / (float)(L - 1);
            else {
                const int k = (j - 1) & 15;
                const float band = 1e-4f + (float)k * ((15.0f - 1e-4f) / 15.0f);
                const float w = 6.283185307179586f * (float)t / (float)L;
                const double ang = (double)band * (double)w;
                f = (j <= 16) ? (float)cos(ang) : (float)(-sin(ang));
            }
            zs[tt * 36 + j] = f;
        }
        __syncthreads();
        const float fr = p.flt_freq[l * 64 + j];
        float a = p.flt_b1[l * 64 + j];
        for (int i = 0; i < 33; ++i) a += zs[tt * 36 + i] * p.flt_w1[((size_t)l * 33 + i) * 64 + j];
        h1s[tt * 64 + j] = sinf(fr * a);
        __syncthreads();
        float a2 = p.flt_b2[l * 64 + j];
        for (int i = 0; i < 64; ++i) a2 += h1s[tt * 64 + i] * p.flt_w2[((size_t)l * 64 + i) * 64 + j];
        const float h2 = sinf(fr * a2);
        if (ls == 0) p.H2a[((size_t)l * SEQ + t) * 64 + j] = h2; else p.H2b[((size_t)l * CTXL + t) * 64 + j] = h2;
    }
}

__device__ __forceinline__ void ph_filter_b(const P& p, char* smem) {
    float* w3s = (float*)smem;
    const int tid = tid_opaque(), lane = tid & 63, wv = tid >> 6;
    const int n0 = DEPTH * 8 * 16, n1 = DEPTH * 16;
    const float DA = -15.350567286626973f, DB = -3.0701134573253946f;
    for (int it = blockIdx.x; it < n0 + n1; it += gridDim.x) {
        int l, ls, tc, cc;
        if (it < n0) { ls = 0; l = it / 128; tc = (it / 16) % 8; cc = it % 16; } else { ls = 1; l = (it - n0) / 16; tc = 0; cc = (it - n0) % 16; }
        const int L = ls ? CTXL : SEQ;
        __syncthreads();
        for (int i = tid; i < 64 * 128; i += NT) { const int jj = i >> 7, c = i & 127; w3s[i] = p.flt_w3[((size_t)l * 64 + jj) * 2048 + cc * 128 + c]; }
        __syncthreads();
        int t, cbeg, cend;
        if (ls == 0) { t = tc * 512 + tid; cbeg = 0; cend = 128; } else { t = tid & 255; cbeg = (tid >> 8) * 64; cend = cbeg + 64; }
        const float* h2 = ls ? p.H2b + ((size_t)l * CTXL + t) * 64 : p.H2a + ((size_t)l * SEQ + t) * 64;
        float h[64];
#pragma unroll
        for (int jj = 0; jj < 64; jj += 4) { const float4 v = *(const float4*)(h2 + jj); h[jj] = v.x; h[jj + 1] = v.y; h[jj + 2] = v.z; h[jj + 3] = v.w; }
        const float tl = (float)t / (float)(L - 1);
        for (int c = cbeg; c < cend; ++c) {
            float acc = 0.f;
#pragma unroll
            for (int jj = 0; jj < 64; ++jj) acc += h[jj] * w3s[jj * 128 + c];
            const int col = cc * 128 + c, ch = col & 511;
            const float delta = fabsf(DA + (float)ch * ((DB - DA) / 511.0f));
            const float v = acc * expf(-tl * delta);
            if (ls == 0) p.HT0[((size_t)l * 2048 + col) * SEQ + t] = v; else p.HT1[((size_t)l * 2048 + col) * CTXL + t] = v;
            const float q = wave_sum(v * v);
            if (lane == 0) { if (ls == 0) p.SSQ0[((size_t)l * 2048 + col) * 64 + tc * 8 + wv] = q; else p.SSQ1[((size_t)l * 2048 + col) * 4 + (wv & 3)] = q; }
        }
    }
}

__device__ __forceinline__ void ph_finalize(const P& p) {
    const int n_mod = DEPTH * 5 * NMOD, n_s = DEPTH * 2048;
    for (int i = blockIdx.x * NT + threadIdx.x; i < n_mod + 2 * n_s; i += gridDim.x * NT) {
        if (i < n_mod) {
            const int l = i / (5 * NMOD), r = (i / NMOD) % 5, j = i % NMOD;
            float a = p.b_ada[l * NMOD + j];
            for (int kc = 0; kc < 8; ++kc) a += p.modp[((size_t)(l * 8 + kc) * 5 + r) * NMOD + j];
            p.mod[i] = a;
        } else if (i < n_mod + n_s) {
            const int k = i - n_mod; float a = 0.f;
            for (int q = 0; q < 64; ++q) a += p.SSQ0[(size_t)k * 64 + q];
            p.SCL0[k] = rsqrtf(a + EPSF);
        } else {
            const int k = i - n_mod - n_s; float a = 0.f;
            for (int q = 0; q < 4; ++q) a += p.SSQ1[(size_t)k * 4 + q];
            p.SCL1[k] = rsqrtf(a + EPSF);
        }
    }
}

template <int WHICH>
__device__ __forceinline__ void ph_norm(const P& p, int l, char* smem) {
    float* rowbuf = (float*)smem;
    float* lgs = rowbuf + 8 * 1024;
    const int tid = tid_opaque(), lane = tid & 63, wv = tid >> 6;
    const float* ng = (WHICH == 1 ? p.norm1_g : p.norm2_g) + l * DM;
    for (int rb = blockIdx.x * 8; rb < TT; rb += gridDim.x * 8) {
        const int row = rb + wv;
        const int b = row < TL ? (row >> 12) : 4;
        const float* hp = p.hx + (size_t)row * DM;
        const float* md = p.mod + ((size_t)l * 5 + b) * NMOD + (WHICH == 1 ? 0 : 3 * DM);
        float4 xv[4]; float ss = 0.f;
#pragma unroll
        for (int i = 0; i < 4; ++i) { xv[i] = *(const float4*)(hp + i * 256 + lane * 4); ss += xv[i].x * xv[i].x + xv[i].y * xv[i].y + xv[i].z * xv[i].z + xv[i].w * xv[i].w; }
        ss = wave_sum(ss);
        const float rs = rsqrtf(ss * (1.0f / DM) + EPSF);
#pragma unroll
        for (int i = 0; i < 4; ++i) {
            const int j = i * 256 + lane * 4;
            const float4 g = *(const float4*)(ng + j), sh = *(const float4*)(md + j), sc = *(const float4*)(md + DM + j);
            float4 y;
            y.x = (xv[i].x * rs * g.x) * (1.f + sc.x) + sh.x; y.y = (xv[i].y * rs * g.y) * (1.f + sc.y) + sh.y;
            y.z = (xv[i].z * rs * g.z) * (1.f + sc.z) + sh.z; y.w = (xv[i].w * rs * g.w) * (1.f + sc.w) + sh.w;
            u32x2 o; o.x = pack2(y.x, y.y); o.y = pack2(y.z, y.w);
            *(u32x2*)(p.U + (size_t)row * DM + j) = o;
            if (WHICH == 2) *(float4*)(rowbuf + wv * 1024 + j) = y;
        }
        if (WHICH == 2) {
            __syncthreads();
            const float* wre = p.w_re + (size_t)l * DM * NE + lane;
            const float* wrg = p.w_rg + (size_t)l * DM * 8 + (lane & 7);
            float ae = 0.f, ag = 0.f;
            const float* rbp = rowbuf + wv * 1024;
#pragma unroll 8
            for (int k = 0; k < DM; ++k) { const float tv = rbp[k]; ae += tv * wre[(size_t)k * NE]; ag += tv * wrg[(size_t)k * 8]; }
            lgs[wv * 72 + 8 + lane] = ae;
            if (lane < 8) lgs[wv * 72 + lane] = ag;
            __syncthreads();
            if (lane == 0) {
                const float* lg = lgs + wv * 72; const float* le = lg + 8;
                int gs = 0; float best = lg[0] + p.b_rg[l * 8], mx = lg[0];
                for (int i = 1; i < 8; ++i) { const float v = lg[i] + p.b_rg[l * 8 + i]; if (v > best) { best = v; gs = i; } mx = fmaxf(mx, lg[i]); }
                float den = 0.f;
                for (int i = 0; i < 8; ++i) den += expf(lg[i] - mx);
                const float pg = expf(lg[gs] - mx) / den;
                int i0 = 0; float k0 = le[gs * 8] + p.b_re[l * NE + gs * 8];
                for (int i = 1; i < 8; ++i) { const float v = le[gs * 8 + i] + p.b_re[l * NE + gs * 8 + i]; if (v > k0) { k0 = v; i0 = i; } }
                int i1 = -1; float k1 = 0.f;
                for (int i = 0; i < 8; ++i) { if (i == i0) continue; const float v = le[gs * 8 + i] + p.b_re[l * NE + gs * 8 + i]; if (i1 < 0 || v > k1) { k1 = v; i1 = i; } }
                const float w0 = 1.0f / (1.0f + expf(le[gs * 8 + i1] - le[gs * 8 + i0])), w1 = 1.0f - w0;
                const int e0 = gs * 8 + i0, e1 = gs * 8 + i1;
                const int r0 = atomicAdd(p.cnt + l * NE + e0, 1), r1 = atomicAdd(p.cnt + l * NE + e1, 1);
                p.list[(size_t)e0 * CAP + r0] = row; p.wl[(size_t)e0 * CAP + r0] = pg * w0;
                p.list[(size_t)e1 * CAP + r1] = row; p.wl[(size_t)e1 * CAP + r1] = pg * w1;
                *(int4*)(p.asg + (size_t)row * 4) = make_int4(e0, r0, e1, r1);
            }
            __syncthreads();
        }
    }
}

__device__ __forceinline__ float rope_apply(float self, float partner, int d, int t) {
    const int a = d >> 4, s = (d >> 3) & 1, i = d & 7;
    const float pos = (float)(a == 0 ? (t >> 6) : (t & 63));
    const float inv = powf(10000.0f, -(float)i / 8.0f);
    const float ang = pos * inv;
    const float cs = cosf(ang), sn = sinf(ang);
    return s == 0 ? self * cs - partner * sn : partner * sn + self * cs;
}

__device__ __forceinline__ void ph_mla_prep(const P& p, int l) {
    const int tid = tid_opaque(), lane = tid & 63, wv = tid >> 6;
    for (int rb = blockIdx.x * 8; rb < TT; rb += gridDim.x * 8) {
        const int row = rb + wv;
        const float* pm = p.PMLA + (size_t)row * MLAW;
        float q[6], ss = 0.f;
#pragma unroll
        for (int i = 0; i < 6; ++i) { q[i] = pm[lane + 64 * i]; ss += q[i] * q[i]; }
        ss = wave_sum(ss);
        float rs = rsqrtf(ss * (1.0f / QL) + EPSF);
#pragma unroll
        for (int i = 0; i < 6; ++i) p.CQ[(size_t)row * QL + lane + 64 * i] = f2bf(q[i] * rs * p.q_norm_g[l * QL + lane + 64 * i]);
        float kv[4]; ss = 0.f;
#pragma unroll
        for (int i = 0; i < 4; ++i) { kv[i] = pm[QL + lane + 64 * i]; ss += kv[i] * kv[i]; }
        ss = wave_sum(ss);
        rs = rsqrtf(ss * (1.0f / KVL) + EPSF);
#pragma unroll
        for (int i = 0; i < 4; ++i) p.CKV[(size_t)row * KVL + lane + 64 * i] = f2bf(kv[i] * rs * p.kv_norm_g[l * KVL + lane + 64 * i]);
        const int d = lane & 31;
        const float self = pm[QL + KVL + d];
        const float partner = __shfl_xor(self, 8);
        int b, key; float val;
        if (row < TL) { b = row >> 12; const int t = row & 4095; key = t; val = rope_apply(self, partner, d, t); }
        else { const int r = row - TL; b = r >> 8; key = SEQ + (r & 255); val = self; }
        if (lane < 32) {
            const bf16_t o = f2bf(val);
#pragma unroll
            for (int h = 0; h < NH; ++h) p.K[((size_t)(b * NH + h) * NKEY + key) * DQK + 64 + d] = o;
        }
    }
}

__device__ __forceinline__ void ph_attn(const P& p, char* smem) {
    bf16_t* sK = (bf16_t*)smem;
    bf16_t* sVt = sK + 64 * 104;
    bf16_t* sP = sVt + 64 * 72;
    const int tid = tid_opaque(), lane = tid & 63, wv = tid >> 6, fr = lane & 15, fq = lane >> 4;
    bf16_t* sPw = sP + wv * 16 * 72;
    const int NUL = NB * NH * 32, NUC = NB * NH * 2;
    for (int u = blockIdx.x; u < NUL + NUC; u += gridDim.x) {
        const bool isctx = u >= NUL;
        int b, h, q0;
        if (!isctx) { b = u / (NH * 32); h = (u / 32) % NH; q0 = (u % 32) * 128; } else { const int v = u - NUL; b = v / (NH * 2); h = (v / 2) % NH; q0 = (v % 2) * 128; }
        const bf16_t* Qp = isctx ? p.Qc + ((size_t)(b * NH + h) * CTXL + q0) * 128 : p.Q + ((size_t)(b * NH + h) * SEQ + q0) * 128;
        bf16x8 qa[4];
#pragma unroll
        for (int ks = 0; ks < 4; ++ks) qa[ks] = *(const bf16x8*)(Qp + (size_t)(wv * 16 + fr) * 128 + ks * 32 + fq * 8);
        const bf16_t* Kp = p.K + (size_t)(b * NH + h) * NKEY * DQK;
        const bf16_t* Vp = p.V + (size_t)(b * NH + h) * NKEY * DV;
        f32x4 o[4]; float m[4], lsum[4];
#pragma unroll
        for (int i = 0; i < 4; ++i) { o[i] = (f32x4){0.f, 0.f, 0.f, 0.f}; m[i] = -INFINITY; lsum[i] = 0.f; }
        for (int kt = isctx ? 64 : 0; kt < 68; ++kt) {
            __syncthreads();
            for (int i = tid; i < 768; i += NT) { const int key = i / 12, part = i % 12; *(u32x4*)(sK + key * 104 + part * 8) = *(const u32x4*)(Kp + (size_t)(kt * 64 + key) * DQK + part * 8); }
            {
                const int key = tid >> 3, d0 = (tid & 7) * 8;
                const bf16x8 vv = *(const bf16x8*)(Vp + (size_t)(kt * 64 + key) * DV + d0);
#pragma unroll
                for (int i = 0; i < 8; ++i) sVt[(d0 + i) * 72 + key] = (bf16_t)vv[i];
            }
            __syncthreads();
            f32x4 s[4];
#pragma unroll
            for (int nt = 0; nt < 4; ++nt) {
                s[nt] = (f32x4){0.f, 0.f, 0.f, 0.f};
#pragma unroll
                for (int ks = 0; ks < 3; ++ks) {
                    const bf16x8 a = (ks < 2) ? qa[ks] : (kt >= 64 ? qa[3] : qa[2]);
                    const bf16x8 bb = *(const bf16x8*)(sK + (nt * 16 + fr) * 104 + ks * 32 + fq * 8);
                    s[nt] = __builtin_amdgcn_mfma_f32_16x16x32_bf16(a, bb, s[nt], 0, 0, 0);
                }
            }
#pragma unroll
            for (int j = 0; j < 4; ++j) {
                float mx = fmaxf(fmaxf(s[0][j], s[1][j]), fmaxf(s[2][j], s[3][j]));
                mx = fmaxf(mx, __shfl_xor(mx, 1)); mx = fmaxf(mx, __shfl_xor(mx, 2)); mx = fmaxf(mx, __shfl_xor(mx, 4)); mx = fmaxf(mx, __shfl_xor(mx, 8));
                const float mn = fmaxf(m[j], mx);
                const float alpha = exp2f(m[j] - mn);
                m[j] = mn;
                float rsum = 0.f;
#pragma unroll
                for (int nt = 0; nt < 4; ++nt) { const float pv = exp2f(s[nt][j] - mn); rsum += pv; sPw[(fq * 4 + j) * 72 + nt * 16 + fr] = f2bf(pv); }
                rsum += __shfl_xor(rsum, 1); rsum += __shfl_xor(rsum, 2); rsum += __shfl_xor(rsum, 4); rsum += __shfl_xor(rsum, 8);
                lsum[j] = lsum[j] * alpha + rsum;
#pragma unroll
                for (int nt = 0; nt < 4; ++nt) o[nt][j] *= alpha;
            }
            __syncthreads();
#pragma unroll
            for (int ks = 0; ks < 2; ++ks) {
                const bf16x8 a = *(const bf16x8*)(sPw + fr * 72 + ks * 32 + fq * 8);
#pragma unroll
                for (int nt = 0; nt < 4; ++nt) {
                    const bf16x8 bb = *(const bf16x8*)(sVt + (nt * 16 + fr) * 72 + ks * 32 + fq * 8);
                    o[nt] = __builtin_amdgcn_mfma_f32_16x16x32_bf16(a, bb, o[nt], 0, 0, 0);
                }
            }
        }
        const size_t rbase = (isctx ? (size_t)TL + b * CTXL : (size_t)b * SEQ) + q0 + wv * 16 + fq * 4;
#pragma unroll
        for (int j = 0; j < 4; ++j) {
            const float inv = 1.0f / lsum[j];
#pragma unroll
            for (int nt = 0; nt < 4; ++nt) p.Yatt[(rbase + j) * 512 + h * 64 + nt * 16 + fr] = f2bf(o[nt][j] * inv);
        }
    }
}

template <int L>
__device__ __forceinline__ void ph_hyena(const P& p, int l, char* smem) {
    constexpr int NOUT = (L >= NT) ? L / NT : 1;
    float* kern0 = (float*)smem;
    float* kern1 = kern0 + 2 * L;
    float* zb = kern1 + 2 * L;
    const int tid = tid_opaque();
    const bool active = tid < L;
    const int tb = active ? tid : 0;
    const bf16_t* PTb = (L == SEQ) ? p.PT : p.PTc;
    const float* HT = (L == SEQ) ? p.HT0 + (size_t)l * 2048 * SEQ : p.HT1 + (size_t)l * 2048 * CTXL;
    const float* SCL = ((L == SEQ) ? p.SCL0 : p.SCL1) + l * 2048;
    for (int u = blockIdx.x; u < NB * HYW; u += gridDim.x) {
        const int b = u / HYW, c = u % HYW;
        __syncthreads();
        for (int i = tid; i < 2 * L; i += NT) {
            const int d = i - L;
            float k0, k1;
            if (d >= 0) { k0 = HT[(size_t)(0 * 1024 + c) * L + d] * SCL[c]; k1 = HT[(size_t)(1 * 1024 + c) * L + d] * SCL[1024 + c]; }
            else if (d > -L) { k0 = HT[(size_t)(0 * 1024 + 512 + c) * L + (size_t)(-d)] * SCL[512 + c]; k1 = HT[(size_t)(1 * 1024 + 512 + c) * L + (size_t)(-d)] * SCL[1536 + c]; }
            else { k0 = 0.f; k1 = 0.f; }
            kern0[i] = k0; kern1[i] = k1;
        }
        float uv[3][NOUT];
#pragma unroll
        for (int w = 0; w < 3; ++w) {
            const int col = w * HYW + c;
            const bf16_t* pr = PTb + ((size_t)b * HYC + col) * L;
            const float w0 = p.sc_w[(size_t)(l * 3 + 0) * HYC + col], w1 = p.sc_w[(size_t)(l * 3 + 1) * HYC + col], w2 = p.sc_w[(size_t)(l * 3 + 2) * HYC + col], bb = p.sc_b[l * HYC + col];
#pragma unroll
            for (int i = 0; i < NOUT; ++i) {
                const int t = tb + i * NT;
                const float pm1 = t > 0 ? bf2f(pr[t - 1]) : 0.f, p0 = bf2f(pr[t]), pp1 = t < L - 1 ? bf2f(pr[t + 1]) : 0.f;
                uv[w][i] = bb + w0 * pm1 + w1 * p0 + w2 * pp1;
            }
        }
        if (active) {
#pragma unroll
            for (int i = 0; i < NOUT; ++i) zb[tb + i * NT] = uv[0][i];
        }
        __syncthreads();
        float acc[NOUT];
#pragma unroll
        for (int i = 0; i < NOUT; ++i) acc[i] = 0.f;
        for (int s = 0; s < L; ++s) {
            const float zs = zb[s];
#pragma unroll
            for (int i = 0; i < NOUT; ++i) acc[i] += zs * kern0[tb + i * NT - s + L];
        }
        const float bias0 = p.flt_bias[(l * 2 + 0) * HYW + c], bias1 = p.flt_bias[(l * 2 + 1) * HYW + c];
        float z1[NOUT];
#pragma unroll
        for (int i = 0; i < NOUT; ++i) z1[i] = uv[1][i] * (acc[i] + bias0 * uv[0][i]);
        __syncthreads();
        if (active) {
#pragma unroll
            for (int i = 0; i < NOUT; ++i) zb[tb + i * NT] = z1[i];
        }
        __syncthreads();
#pragma unroll
        for (int i = 0; i < NOUT; ++i) acc[i] = 0.f;
        for (int s = 0; s < L; ++s) {
            const float zs = zb[s];
#pragma unroll
            for (int i = 0; i < NOUT; ++i) acc[i] += zs * kern1[tb + i * NT - s + L];
        }
        if (active) {
            const size_t rbase = (L == SEQ) ? (size_t)b * SEQ : (size_t)TL + b * CTXL;
#pragma unroll
            for (int i = 0; i < NOUT; ++i) p.Yhy[(rbase + tb + i * NT) * HYW + c] = f2bf(uv[2][i] * (acc[i] + bias1 * z1[i]));
        }
    }
}

__device__ __forceinline__ void ph_combine(const P& p, int l, const int* offs) {
    const int tid = tid_opaque(), lane = tid & 63, wv = tid >> 6;
    for (int rb = blockIdx.x * 8; rb < TT; rb += gridDim.x * 8) {
        const int row = rb + wv;
        const int b = row < TL ? (row >> 12) : 4;
        const int4 a = *(const int4*)(p.asg + (size_t)row * 4);
        const size_t s0 = (size_t)offs[a.x] + a.y, s1 = (size_t)offs[a.z] + a.w;
        const float* g2 = p.mod + ((size_t)l * 5 + b) * NMOD + 5 * DM;
#pragma unroll
        for (int i = 0; i < 4; ++i) {
            const int j = i * 256 + lane * 4;
            float4 hv = *(float4*)(p.hx + (size_t)row * DM + j);
            const u32x2 y0 = *(const u32x2*)(p.Y + s0 * DM + j), y1 = *(const u32x2*)(p.Y + s1 * DM + j);
            const float4 g = *(const float4*)(g2 + j);
            hv.x += g.x * (__uint_as_float(y0.x << 16) + __uint_as_float(y1.x << 16));
            hv.y += g.y * (__uint_as_float(y0.x & 0xFFFF0000u) + __uint_as_float(y1.x & 0xFFFF0000u));
            hv.z += g.z * (__uint_as_float(y0.y << 16) + __uint_as_float(y1.y << 16));
            hv.w += g.w * (__uint_as_float(y0.y & 0xFFFF0000u) + __uint_as_float(y1.y & 0xFFFF0000u));
            *(float4*)(p.hx + (size_t)row * DM + j) = hv;
        }
    }
}
__device__ __forceinline__ void ph_final(const P& p) {
    const int tid = tid_opaque(), lane = tid & 63, wv = tid >> 6;
    for (int rb = blockIdx.x * 8; rb < TL; rb += gridDim.x * 8) {
        const int row = rb + wv;
        const float* hp = p.hx + (size_t)row * DM;
        float4 xv[4]; float ss = 0.f;
#pragma unroll
        for (int i = 0; i < 4; ++i) { xv[i] = *(const float4*)(hp + i * 256 + lane * 4); ss += xv[i].x * xv[i].x + xv[i].y * xv[i].y + xv[i].z * xv[i].z + xv[i].w * xv[i].w; }
        ss = wave_sum(ss);
        const float rs = rsqrtf(ss * (1.0f / DM) + EPSF);
#pragma unroll
        for (int i = 0; i < 4; ++i) {
            const int j = i * 256 + lane * 4;
            const float4 g = *(const float4*)(p.final_g + j);
            float4 y; y.x = xv[i].x * rs * g.x; y.y = xv[i].y * rs * g.y; y.z = xv[i].z * rs * g.z; y.w = xv[i].w * rs * g.w;
            *(float4*)(p.out + (size_t)row * DM + j) = y;
        }
    }
}

namespace ge {
constexpr int BM = 256, BK = 64, HALF = 128, HTB = HALF * BK * 2, STAGE_BYTES = 8 * HTB, NXCD = 8, WGM = 8;
__device__ __forceinline__ int lds_byte(int r, int c) { const int st = (r >> 4) * 2 + (c >> 5), rr = r & 15, cc = c & 31, ob = rr * 64 + cc * 2; return st * 1024 + (ob ^ (((ob >> 9) & 1) << 5)); }
__device__ __forceinline__ void stage_rc(int b, int& R, int& C) { const int st = b / 1024, sb = b % 1024, swz = sb ^ (((sb >> 9) & 1) << 5); R = (st >> 1) * 16 + swz / 64; C = (st & 1) * 32 + (swz % 64) / 2; }
__device__ __forceinline__ int perm32(int rho) { const int n = rho >> 4, i = rho & 15; return 8 * (i >> 2) + 4 * n + (i & 3); }
__device__ __forceinline__ void tile_order(int L, int nM, int nN, int& pm, int& pn) {
    const int nwg = nM * nN; int wgid = L;
    { const int q = nwg / NXCD, r = nwg % NXCD, xcd = wgid % NXCD, off = wgid / NXCD; wgid = (xcd < r ? xcd * (q + 1) : r * (q + 1) + (xcd - r) * q) + off; }
    const int nig = WGM * nN, gid = wgid / nig, fm = gid * WGM, gsz = (nM - fm) < WGM ? (nM - fm) : WGM;
    pm = fm + ((wgid % nig) % gsz); pn = (wgid % nig) / gsz;
}
struct Unit { const char* a; const char* b0; const char* b1; const int* rows; int nrows; int pm, pn, kind; };
typedef f32x4 Acc[2][2][4][2];

template <bool GATHER, class Sched, class Epi>
__device__ __forceinline__ void gemm_engine(LAS unsigned char* lds, const int lda, const int ldb, const int K, const Sched& S, const Epi& E) {
    const int tid = tid_opaque(), wid = __builtin_amdgcn_readfirstlane(tid >> 6), lane = tid & 63, wr = wid >> 2, wc = wid & 3, fr = lane & 15, fq = lane >> 4;
    const int nt = K / BK;
    int sR[2], sC[2];
    unsigned voffA[2], voffB[2];
#pragma unroll
    for (int i = 0; i < 2; ++i) { stage_rc(tid * 16 + i * 8192, sR[i], sC[i]); const int Rb = (sR[i] & ~31) + perm32(sR[i] & 31);
        voffA[i] = (unsigned)(sR[i] * lda + sC[i]) * 2u; voffB[i] = (unsigned)(Rb * ldb + sC[i]) * 2u; }
    const size_t kstep = (size_t)(BK * 2);
    const size_t hstepA = (size_t)HALF * lda * 2;
    const unsigned ldsw = (unsigned)wid * 1024u;
    const int aoff = lds_byte(wr * 64 + fr, fq * 8), boff = lds_byte(wc * 32 + fr, fq * 8);
    unsigned gvc[2][2], gvn[2][2];
#define GE_SA(b, h) (((b) * 2 + (h)) * HTB)
#define GE_SB(b, h) ((4 + (b) * 2 + (h)) * HTB)
#define GE_GLDS(src, bufoff, i) __builtin_amdgcn_global_load_lds((const unsigned*)(src), (LAS unsigned*)(lds + (bufoff) + ldsw + (i) * 8192), 16, 0, 0)
#define GE_STAGE_B(bufoff, bp) do { _Pragma("unroll") for (int _i = 0; _i < 2; ++_i) GE_GLDS((bp) + voffB[_i], bufoff, _i); } while (0)
#define GE_STAGE_A(bufoff, ap, h, gv) do { _Pragma("unroll") for (int _i = 0; _i < 2; ++_i) { \
        if constexpr (GATHER) GE_GLDS((ap) + (gv)[h][_i], bufoff, _i); else GE_GLDS((ap) + (size_t)(h) * hstepA + voffA[_i], bufoff, _i); } } while (0)
#define GE_LDA(dst, b, h) do { _Pragma("unroll") for (int m = 0; m < 4; ++m) _Pragma("unroll") for (int k = 0; k < 2; ++k) dst[m][k] = *(const LAS bf16x8*)(lds + GE_SA(b, h) + aoff + m * 2048 + k * 1024); } while (0)
#define GE_LDB(dst, b, h) do { _Pragma("unroll") for (int n = 0; n < 2; ++n) _Pragma("unroll") for (int k = 0; k < 2; ++k) dst[n][k] = *(const LAS bf16x8*)(lds + GE_SB(b, h) + boff + n * 2048 + k * 1024); } while (0)
#define GE_MMA(ai, bj, At, Bt) do { __builtin_amdgcn_s_setprio(1); _Pragma("unroll") for (int m = 0; m < 4; ++m) _Pragma("unroll") for (int n = 0; n < 2; ++n) _Pragma("unroll") for (int k = 0; k < 2; ++k) \
        acc[ai][bj][m][n] = __builtin_amdgcn_mfma_f32_16x16x32_bf16(Bt[n][k], At[m][k], acc[ai][bj][m][n], 0, 0, 0); __builtin_amdgcn_s_setprio(0); } while (0)
#define GE_WAIT_V(n) asm volatile("s_waitcnt vmcnt(" #n ")" ::: "memory")
#define GE_WAIT_L(n) asm volatile("s_waitcnt lgkmcnt(" #n ")" ::: "memory")
#define GE_BAR __builtin_amdgcn_s_barrier()
#define GE_SCHED __builtin_amdgcn_sched_barrier(0)
#define GE_GATHER_OFFS(gv, u) do { if constexpr (GATHER) { _Pragma("unroll") for (int _h = 0; _h < 2; ++_h) _Pragma("unroll") for (int _i = 0; _i < 2; ++_i) { \
        int _r = (u).pm * BM + _h * HALF + sR[_i]; _r = _r < (u).nrows ? _r : (u).nrows - 1; (gv)[_h][_i] = (unsigned)((u).rows[_r] * lda + sC[_i]) * 2u; } } } while (0)
    Unit cur, nxt; int ui = 0;
    if (!S.next(0, cur)) return;
    Acc acc;
#pragma unroll
    for (int a = 0; a < 2; ++a)
#pragma unroll
        for (int b = 0; b < 2; ++b)
#pragma unroll
            for (int m = 0; m < 4; ++m)
#pragma unroll
                for (int n = 0; n < 2; ++n) acc[a][b][m][n] = (f32x4){0.f, 0.f, 0.f, 0.f};
    bf16x8 At[4][2], B0[2][2], B1[2][2];
    GE_GATHER_OFFS(gvc, cur);
    GE_STAGE_B(GE_SB(0, 0), cur.b0); GE_STAGE_A(GE_SA(0, 0), cur.a, 0, gvc); GE_STAGE_B(GE_SB(0, 1), cur.b1); GE_STAGE_A(GE_SA(0, 1), cur.a, 1, gvc);
    if (wr == 1) GE_BAR;
    GE_WAIT_V(4); GE_BAR;
    GE_STAGE_B(GE_SB(1, 0), cur.b0 + kstep); GE_STAGE_A(GE_SA(1, 0), cur.a + kstep, 0, gvc); GE_STAGE_B(GE_SB(1, 1), cur.b1 + kstep);
    GE_WAIT_V(6); GE_BAR;
    for (;;) {
        const bool has_next = S.next(ui + 1, nxt);
        if (!has_next) nxt = cur;
        if constexpr (GATHER) { if (has_next) { GE_GATHER_OFFS(gvn, nxt); } else {
#pragma unroll
            for (int h = 0; h < 2; ++h)
#pragma unroll
                for (int i = 0; i < 2; ++i) gvn[h][i] = gvc[h][i]; } }
#pragma unroll 1
        for (int t = 0; t < nt; t += 2) {
            const bool last = (t == nt - 2);
            const char* a1 = cur.a + (size_t)(t + 1) * kstep;
            const char* a2 = last ? nxt.a : cur.a + (size_t)(t + 2) * kstep;
            const char* b20 = last ? nxt.b0 : cur.b0 + (size_t)(t + 2) * kstep;
            const char* b21 = last ? nxt.b1 : cur.b1 + (size_t)(t + 2) * kstep;
            const char* a3 = a2 + kstep; const char* b30 = b20 + kstep; const char* b31 = b21 + kstep;
            unsigned gv2[2][2];
            if constexpr (GATHER) {
#pragma unroll
                for (int h = 0; h < 2; ++h)
#pragma unroll
                    for (int i = 0; i < 2; ++i) gv2[h][i] = last ? gvn[h][i] : gvc[h][i]; }
            GE_LDB(B0, 0, 0); GE_SCHED; GE_LDA(At, 0, 0); GE_STAGE_A(GE_SA(1, 1), a1, 1, gvc);
            GE_WAIT_L(8); GE_BAR; GE_WAIT_L(0); GE_MMA(0, 0, At, B0); GE_BAR; GE_SCHED;
            GE_LDB(B1, 0, 1); GE_STAGE_B(GE_SB(0, 0), b20);
            GE_BAR; GE_WAIT_L(0); GE_MMA(0, 1, At, B1); GE_BAR;
            GE_LDA(At, 0, 1); GE_STAGE_A(GE_SA(0, 0), a2, 0, gv2);
            GE_BAR; GE_WAIT_L(0); GE_MMA(1, 0, At, B0); GE_BAR; GE_SCHED;
            GE_STAGE_B(GE_SB(0, 1), b21);
            GE_WAIT_V(6); GE_BAR; GE_MMA(1, 1, At, B1); GE_BAR;
            GE_LDB(B0, 1, 0); GE_SCHED; GE_LDA(At, 1, 0); GE_STAGE_A(GE_SA(0, 1), a2, 1, gv2);
            GE_WAIT_L(8); GE_BAR; GE_WAIT_L(0); GE_MMA(0, 0, At, B0); GE_BAR; GE_SCHED;
            GE_LDB(B1, 1, 1); GE_STAGE_B(GE_SB(1, 0), b30);
            GE_BAR; GE_WAIT_L(0); GE_MMA(0, 1, At, B1); GE_BAR;
            GE_LDA(At, 1, 1); GE_STAGE_A(GE_SA(1, 0), a3, 0, gv2);
            GE_BAR; GE_WAIT_L(0); GE_MMA(1, 0, At, B0); GE_BAR; GE_SCHED;
            GE_STAGE_B(GE_SB(1, 1), b31);
            GE_WAIT_V(6); GE_BAR; GE_MMA(1, 1, At, B1); GE_BAR;
        }
        E(acc, cur, wr, wc, fr, fq);
        if (!has_next) break;
#pragma unroll
        for (int a = 0; a < 2; ++a)
#pragma unroll
            for (int b = 0; b < 2; ++b)
#pragma unroll
                for (int m = 0; m < 4; ++m)
#pragma unroll
                    for (int n = 0; n < 2; ++n) acc[a][b][m][n] = (f32x4){0.f, 0.f, 0.f, 0.f};
        cur = nxt; ++ui;
        if constexpr (GATHER) {
#pragma unroll
            for (int h = 0; h < 2; ++h)
#pragma unroll
                for (int i = 0; i < 2; ++i) gvc[h][i] = gvn[h][i]; }
    }
    GE_WAIT_V(0);
    if (wr == 0) GE_BAR;
    GE_BAR;
#undef GE_SA
#undef GE_SB
#undef GE_GLDS
#undef GE_STAGE_A
#undef GE_STAGE_B
#undef GE_LDA
#undef GE_LDB
#undef GE_MMA
#undef GE_WAIT_V
#undef GE_WAIT_L
#undef GE_BAR
#undef GE_SCHED
#undef GE_GATHER_OFFS
}
}
__device__ __forceinline__ unsigned cvt_pk_bf16(float lo, float hi) { unsigned r; asm volatile("v_cvt_pk_bf16_f32 %0, %1, %2" : "=v"(r) : "v"(lo), "v"(hi)); return r; }
__device__ __forceinline__ u32x4 pack8(const f32x4 a, const f32x4 b) { u32x4 w; w.x = cvt_pk_bf16(a[0], a[1]); w.y = cvt_pk_bf16(a[2], a[3]); w.z = cvt_pk_bf16(b[0], b[1]); w.w = cvt_pk_bf16(b[2], b[3]); return w; }
__device__ __forceinline__ void unpack8(const u32x4 w, f32x4& a, f32x4& b) {
    a[0] = __uint_as_float(w.x << 16); a[1] = __uint_as_float(w.x & 0xFFFF0000u); a[2] = __uint_as_float(w.y << 16); a[3] = __uint_as_float(w.y & 0xFFFF0000u);
    b[0] = __uint_as_float(w.z << 16); b[1] = __uint_as_float(w.z & 0xFFFF0000u); b[2] = __uint_as_float(w.w << 16); b[3] = __uint_as_float(w.w & 0xFFFF0000u); }
__device__ __forceinline__ float sigmoidf_fast(float v) { return 1.0f / (1.0f + __expf(-v)); }

struct SchedDense {
    const char* A; const char* B; size_t arb, brb; int nM, nN, G, c;
    __device__ __forceinline__ bool next(int i, ge::Unit& u) const {
        const int L = i * G + c; if (L >= nM * nN) return false;
        int pm, pn; ge::tile_order(L, nM, nN, pm, pn);
        u.pm = pm; u.pn = pn; u.kind = 0; u.rows = nullptr; u.nrows = 0;
        u.a = A + (size_t)pm * 256 * arb; u.b0 = B + (size_t)pn * 256 * brb; u.b1 = u.b0 + 128 * brb; return true;
    }
};
struct SchedInproj {
    const char* WtHy; const char* WtRest; const char* U; int G, c;
    __device__ __forceinline__ bool next(int i, ge::Unit& u) const {
        const int L = i * G + c; if (L >= 408 + 748) return false;
        int pm, pn; u.rows = nullptr; u.nrows = 0;
        if (L < 408) { ge::tile_order(L, 6, 68, pm, pn); u.kind = 0; u.a = WtHy + (size_t)pm * 256 * 2048; u.b0 = U + (size_t)pn * 256 * 2048; }
        else { ge::tile_order(L - 408, 68, 11, pm, pn); u.kind = 1; u.a = U + (size_t)pm * 256 * 2048; u.b0 = WtRest + (size_t)pn * 256 * 2048; }
        u.b1 = u.b0 + 128 * 2048; u.pm = pm; u.pn = pn; return true;
    }
};
struct EpiInproj {
    bf16_t* PT; bf16_t* PTc; float* PMLA; bf16_t* G;
    __device__ __forceinline__ void operator()(const ge::Acc& acc, const ge::Unit& u, int wr, int wc, int fr, int fq) const {
#pragma unroll
        for (int ai = 0; ai < 2; ++ai)
#pragma unroll
            for (int m = 0; m < 4; ++m) {
                const int r = u.pm * 256 + ai * 128 + wr * 64 + m * 16 + fr;
#pragma unroll
                for (int bj = 0; bj < 2; ++bj) {
                    const int c0 = bj * 128 + wc * 32 + fq * 8;
                    if (u.kind == 0) {
                        bf16_t* dst = (u.pn < 64) ? PT + ((size_t)((u.pn >> 4) * HYC + r)) * SEQ + (u.pn & 15) * 256 + c0
                                                  : PTc + ((size_t)((u.pn - 64) * HYC + r)) * CTXL + c0;
                        *(u32x4*)dst = pack8(acc[ai][bj][m][0], acc[ai][bj][m][1]);
                    } else if (u.pn < 3) {
                        const int c = u.pn * 256 + c0;
                        if (c < MLAW) { float* dst = PMLA + (size_t)r * MLAW + c; *(f32x4*)dst = acc[ai][bj][m][0]; *(f32x4*)(dst + 4) = acc[ai][bj][m][1]; }
                    } else {
                        const int c = (u.pn - 3) * 256 + c0;
                        f32x4 a = acc[ai][bj][m][0], b = acc[ai][bj][m][1];
#pragma unroll
                        for (int j = 0; j < 4; ++j) { a[j] = sigmoidf_fast(a[j]); b[j] = sigmoidf_fast(b[j]); }
                        *(u32x4*)(G + (size_t)r * 2048 + c) = pack8(a, b);
                    }
                }
            }
    }
};
struct EpiQ {
    bf16_t* Q; bf16_t* Qc; const float2* rope;
    __device__ __forceinline__ void operator()(const ge::Acc& acc, const ge::Unit& u, int wr, int wc, int fr, int fq) const {
#pragma unroll
        for (int ai = 0; ai < 2; ++ai)
#pragma unroll
            for (int m = 0; m < 4; ++m) {
                const int r = u.pm * 256 + ai * 128 + wr * 64 + m * 16 + fr;
                const bool lat = r < TL;
                const int t = lat ? (r & 4095) : ((r - TL) & 255);
                const int b = lat ? (r >> 12) : ((r - TL) >> 8);
#pragma unroll
                for (int bj = 0; bj < 2; ++bj) {
                    const int c = u.pn * 256 + bj * 128 + wc * 32 + fq * 8;
                    const int h = c / 96, dd = c - h * 96;
                    f32x4 v0 = acc[ai][bj][m][0] * QSCALE, v1 = acc[ai][bj][m][1] * QSCALE;
                    f32x4 p0, p1;
#pragma unroll
                    for (int j = 0; j < 4; ++j) { p0[j] = __shfl_xor(v0[j], 16); p1[j] = __shfl_xor(v1[j], 16); }
                    bf16_t* qrow = lat ? Q + ((size_t)(b * NH + h) * SEQ + t) * 128 : Qc + ((size_t)(b * NH + h) * CTXL + t) * 128;
                    if (dd < 64) *(u32x4*)(qrow + dd) = pack8(v0, v1);
                    else {
                        const int d0 = dd - 64;
                        f32x4 o0 = v0, o1 = v1;
                        if (lat) {
                            const float2* rp = rope + (size_t)t * 16 + (d0 >> 4) * 8;
                            const bool s1 = (d0 >> 3) & 1;
#pragma unroll
                            for (int j = 0; j < 4; ++j) {
                                const float2 ca = rp[j], cb = rp[4 + j];
                                o0[j] = s1 ? p0[j] * ca.y + v0[j] * ca.x : v0[j] * ca.x - p0[j] * ca.y;
                                o1[j] = s1 ? p1[j] * cb.y + v1[j] * cb.x : v1[j] * cb.x - p1[j] * cb.y;
                            }
                        }
                        *(u32x4*)(qrow + 64 + d0) = pack8(o0, o1);
                        *(u32x4*)(qrow + 96 + d0) = pack8(v0, v1);
                    }
                }
            }
    }
};
struct EpiKV {
    bf16_t* K; bf16_t* V;
    __device__ __forceinline__ void operator()(const ge::Acc& acc, const ge::Unit& u, int wr, int wc, int fr, int fq) const {
#pragma unroll
        for (int ai = 0; ai < 2; ++ai)
#pragma unroll
            for (int m = 0; m < 4; ++m) {
                const int r = u.pm * 256 + ai * 128 + wr * 64 + m * 16 + fr;
                int b, key;
                if (r < TL) { b = r >> 12; key = r & 4095; } else { b = (r - TL) >> 8; key = SEQ + ((r - TL) & 255); }
#pragma unroll
                for (int bj = 0; bj < 2; ++bj) {
                    const int c = u.pn * 256 + bj * 128 + wc * 32 + fq * 8;
                    const int h = c >> 7, d = c & 127;
                    const size_t kb = (size_t)(b * NH + h) * NKEY + key;
                    bf16_t* dst = (d < 64) ? K + kb * DQK + d : V + kb * DV + (d - 64);
                    *(u32x4*)dst = pack8(acc[ai][bj][m][0], acc[ai][bj][m][1]);
                }
            }
    }
};
struct SchedMerge {
    const char* Yhy; const char* Yatt; const char* Whyo; const char* Wmlao; int G, c;
    __device__ __forceinline__ bool next(int i, ge::Unit& u) const {
        const int T = (i >> 1) * G + c; if (T >= 272) return false;
        const int seg = i & 1; int pm, pn; ge::tile_order(T, 68, 4, pm, pn);
        u.pm = pm; u.pn = pn; u.kind = seg; u.rows = nullptr; u.nrows = 0;
        u.a = (seg ? Yatt : Yhy) + (size_t)pm * 256 * 1024; u.b0 = (seg ? Wmlao : Whyo) + (size_t)pn * 256 * 1024; u.b1 = u.b0 + 128 * 1024; return true;
    }
};
struct EpiMerge {
    const bf16_t* G; bf16_t* M1;
    __device__ __forceinline__ void operator()(const ge::Acc& acc, const ge::Unit& u, int wr, int wc, int fr, int fq) const {
#pragma unroll
        for (int ai = 0; ai < 2; ++ai)
#pragma unroll
            for (int m = 0; m < 4; ++m) {
                const int r = u.pm * 256 + ai * 128 + wr * 64 + m * 16 + fr;
#pragma unroll
                for (int bj = 0; bj < 2; ++bj) {
                    const int c = u.pn * 256 + bj * 128 + wc * 32 + fq * 8;
                    f32x4 g0, g1; unpack8(*(const u32x4*)(G + (size_t)r * 2048 + u.kind * DM + c), g0, g1);
                    f32x4 o0 = g0 * acc[ai][bj][m][0], o1 = g1 * acc[ai][bj][m][1];
                    bf16_t* dst = M1 + (size_t)r * DM + c;
                    if (u.kind) { f32x4 q0, q1; unpack8(*(const u32x4*)dst, q0, q1); o0 += q0; o1 += q1; }
                    *(u32x4*)dst = pack8(o0, o1);
                }
            }
    }
};
struct EpiOut {
    float* hx; const float* mod;
    __device__ __forceinline__ void operator()(const ge::Acc& acc, const ge::Unit& u, int wr, int wc, int fr, int fq) const {
#pragma unroll
        for (int ai = 0; ai < 2; ++ai)
#pragma unroll
            for (int m = 0; m < 4; ++m) {
                const int r = u.pm * 256 + ai * 128 + wr * 64 + m * 16 + fr;
                const int b = r < TL ? (r >> 12) : 4;
#pragma unroll
                for (int bj = 0; bj < 2; ++bj) {
                    const int c = u.pn * 256 + bj * 128 + wc * 32 + fq * 8;
                    const float* g = mod + (size_t)b * NMOD + 2 * DM + c;
                    float* dst = hx + (size_t)r * DM + c;
                    *(f32x4*)dst = *(const f32x4*)dst + *(const f32x4*)g * acc[ai][bj][m][0];
                    *(f32x4*)(dst + 4) = *(const f32x4*)(dst + 4) + *(const f32x4*)(g + 4) * acc[ai][bj][m][1];
                }
            }
    }
};
struct SchedGU {
    const char* U; const char* WtG; const char* WtU; const int* list; const LAS int* tpre; const LAS int* cntl; int G, c;
    __device__ __forceinline__ bool next(int i, ge::Unit& u) const {
        const int L = i * G + c; if (L >= 2 * tpre[64]) return false;
        const int rt = L >> 1, half = L & 1; int e = 0; while (tpre[e + 1] <= rt) ++e;
        u.kind = e; u.pm = rt - tpre[e]; u.pn = half; u.rows = list + (size_t)e * CAP; u.nrows = cntl[e];
        u.a = U; u.b0 = WtG + ((size_t)e * DE + half * 128) * 2048; u.b1 = WtU + ((size_t)e * DE + half * 128) * 2048; return true;
    }
};
struct EpiGU {
    bf16_t* H; const LAS int* offs;
    __device__ __forceinline__ void operator()(const ge::Acc& acc, const ge::Unit& u, int wr, int wc, int fr, int fq) const {
        const int o = offs[u.kind];
#pragma unroll
        for (int ai = 0; ai < 2; ++ai)
#pragma unroll
            for (int m = 0; m < 4; ++m) {
                const int r = u.pm * 256 + ai * 128 + wr * 64 + m * 16 + fr;
                if (r < u.nrows) {
                    const int c = u.pn * 128 + wc * 32 + fq * 8;
                    f32x4 g0 = acc[ai][0][m][0], g1 = acc[ai][0][m][1];
#pragma unroll
                    for (int j = 0; j < 4; ++j) { g0[j] = g0[j] * sigmoidf_fast(g0[j]) * acc[ai][1][m][0][j]; g1[j] = g1[j] * sigmoidf_fast(g1[j]) * acc[ai][1][m][1][j]; }
                    *(u32x4*)(H + (size_t)(o + r) * DE + c) = pack8(g0, g1);
                }
            }
    }
};
struct SchedDown {
    const char* H; const char* WtD; const LAS int* tpre; const LAS int* cntl; const LAS int* offs; int G, c;
    __device__ __forceinline__ bool next(int i, ge::Unit& u) const {
        const int L = i * G + c; if (L >= 4 * tpre[64]) return false;
        const int rt = L >> 2, pn = L & 3; int e = 0; while (tpre[e + 1] <= rt) ++e;
        u.kind = e; u.pm = rt - tpre[e]; u.pn = pn; u.rows = nullptr; u.nrows = cntl[e];
        u.a = H + ((size_t)offs[e] + (size_t)u.pm * 256) * 512; u.b0 = WtD + ((size_t)e * DM + pn * 256) * 512; u.b1 = u.b0 + 128 * 512; return true;
    }
};
struct EpiDown {
    bf16_t* Y; const float* wl; const LAS int* offs;
    __device__ __forceinline__ void operator()(const ge::Acc& acc, const ge::Unit& u, int wr, int wc, int fr, int fq) const {
        const int o = offs[u.kind];
#pragma unroll
        for (int ai = 0; ai < 2; ++ai)
#pragma unroll
            for (int m = 0; m < 4; ++m) {
                const int r = u.pm * 256 + ai * 128 + wr * 64 + m * 16 + fr;
                if (r < u.nrows) {
                    const float w = wl[(size_t)u.kind * CAP + r];
#pragma unroll
                    for (int bj = 0; bj < 2; ++bj) {
                        const int c = u.pn * 256 + bj * 128 + wc * 32 + fq * 8;
                        *(u32x4*)(Y + (size_t)(o + r) * DM + c) = pack8(acc[ai][bj][m][0] * w, acc[ai][bj][m][1] * w);
                    }
                }
            }
    }
};


typedef short s16x4 __attribute__((ext_vector_type(4)));
__device__ __forceinline__ void ph_attn2(const P& p, char* smem) {
    constexpr int KS = 112, VS = 80;
    bf16_t* sK = (bf16_t*)smem;
    bf16_t* sV = sK + 2 * 64 * KS;
    const int tid = tid_opaque(), lane = tid & 63, wv = tid >> 6, fr = lane & 15, g = lane >> 4;
    const int NUL = NB * NH * 16, NUC = NB * NH;
    const int kc0 = tid / 12, kp0 = tid % 12, kc1 = (512 + tid) / 12, kp1 = (512 + tid) % 12;
    const int vk = tid >> 3, vp = tid & 7;
    for (int u = blockIdx.x; u < NUL + NUC; u += gridDim.x) {
        const bool isctx = u >= NUL;
        int b, h, q0;
        if (!isctx) { b = u / (NH * 16); h = (u / 16) % NH; q0 = (u % 16) * 256; } else { const int v = u - NUL; b = v / NH; h = v % NH; q0 = 0; }
        const bf16_t* Qp = (isctx ? p.Qc + ((size_t)(b * NH + h) * CTXL + q0) * 128 : p.Q + ((size_t)(b * NH + h) * SEQ + q0) * 128) + (size_t)(wv * 32) * 128;
        bf16x8 qf[2][4];
#pragma unroll
        for (int nq = 0; nq < 2; ++nq)
#pragma unroll
            for (int ks = 0; ks < 4; ++ks) qf[nq][ks] = *(const bf16x8*)(Qp + (size_t)(nq * 16 + fr) * 128 + ks * 32 + g * 8);
        const bf16_t* Kp = p.K + (size_t)(b * NH + h) * NKEY * DQK;
        const bf16_t* Vp = p.V + (size_t)(b * NH + h) * NKEY * DV;
        f32x4 oT[4][2]; float m[2], lsum[2];
#pragma unroll
        for (int nq = 0; nq < 2; ++nq) { m[nq] = -INFINITY; lsum[nq] = 0.f;
#pragma unroll
            for (int md = 0; md < 4; ++md) oT[md][nq] = (f32x4){0.f, 0.f, 0.f, 0.f}; }
        const int kt0 = isctx ? 64 : 0, ntiles = 68 - kt0;
        u32x4 kr0, kr1 = (u32x4){0u, 0u, 0u, 0u}, vr0;
        {
            const bf16_t* kb = Kp + (size_t)(kt0 * 64) * DQK; const bf16_t* vb = Vp + (size_t)(kt0 * 64) * DV;
            kr0 = *(const u32x4*)(kb + kc0 * DQK + kp0 * 8); if (tid < 256) kr1 = *(const u32x4*)(kb + kc1 * DQK + kp1 * 8);
            vr0 = *(const u32x4*)(vb + vk * DV + vp * 8);
            __syncthreads();
            *(u32x4*)(sK + kc0 * KS + kp0 * 8) = kr0; if (tid < 256) *(u32x4*)(sK + kc1 * KS + kp1 * 8) = kr1;
            *(u32x4*)(sV + vk * VS + vp * 8) = vr0;
            __syncthreads();
        }
        for (int it = 0; it < ntiles; ++it) {
            const int buf = it & 1, kt = kt0 + it;
            const bool more = it + 1 < ntiles;
            if (more) {
                const bf16_t* kb = Kp + (size_t)((kt + 1) * 64) * DQK; const bf16_t* vb = Vp + (size_t)((kt + 1) * 64) * DV;
                kr0 = *(const u32x4*)(kb + kc0 * DQK + kp0 * 8); if (tid < 256) kr1 = *(const u32x4*)(kb + kc1 * DQK + kp1 * 8);
                vr0 = *(const u32x4*)(vb + vk * DV + vp * 8);
            }
            const bf16_t* sKb = sK + buf * 64 * KS; const bf16_t* sVb = sV + buf * 64 * VS;
            f32x4 sT[4][2];
#pragma unroll
            for (int mk = 0; mk < 4; ++mk) {
                sT[mk][0] = (f32x4){0.f, 0.f, 0.f, 0.f}; sT[mk][1] = (f32x4){0.f, 0.f, 0.f, 0.f};
#pragma unroll
                for (int ks = 0; ks < 3; ++ks) {
                    const bf16x8 a = *(const bf16x8*)(sKb + (mk * 16 + fr) * KS + ks * 32 + g * 8);
#pragma unroll
                    for (int nq = 0; nq < 2; ++nq) {
                        const bf16x8 bq = (ks < 2) ? qf[nq][ks] : (kt >= 64 ? qf[nq][3] : qf[nq][2]);
                        sT[mk][nq] = __builtin_amdgcn_mfma_f32_16x16x32_bf16(a, bq, sT[mk][nq], 0, 0, 0);
                    }
                }
            }
            bf16x8 pf[2][2];
#pragma unroll
            for (int nq = 0; nq < 2; ++nq) {
                float mx = sT[0][nq][0];
#pragma unroll
                for (int mk = 0; mk < 4; ++mk)
#pragma unroll
                    for (int r = 0; r < 4; ++r) mx = fmaxf(mx, sT[mk][nq][r]);
                mx = fmaxf(mx, __shfl_xor(mx, 16)); mx = fmaxf(mx, __shfl_xor(mx, 32));
                const float mn = fmaxf(m[nq], mx);
                const float alpha = __builtin_amdgcn_exp2f(m[nq] - mn);
                m[nq] = mn;
                float rs = 0.f;
#pragma unroll
                for (int mk = 0; mk < 4; ++mk)
#pragma unroll
                    for (int r = 0; r < 4; ++r) { const float pv = __builtin_amdgcn_exp2f(sT[mk][nq][r] - mn); rs += pv; sT[mk][nq][r] = pv; }
                lsum[nq] = lsum[nq] * alpha + rs;
#pragma unroll
                for (int md = 0; md < 4; ++md) oT[md][nq] *= alpha;
#pragma unroll
                for (int kp = 0; kp < 2; ++kp) {
                    const u32x4 w = pack8(sT[2 * kp][nq], sT[2 * kp + 1][nq]);
                    pf[kp][nq] = __builtin_bit_cast(bf16x8, w);
                }
            }
#pragma unroll
            for (int kp = 0; kp < 2; ++kp)
#pragma unroll
                for (int md = 0; md < 4; ++md) {
                    const bf16_t* a0 = sVb + (32 * kp + 4 * g + (fr >> 2)) * VS + 16 * md + 4 * (fr & 3);
                    const s16x4 lo = __builtin_amdgcn_ds_read_tr16_b64_v4i16((LAS s16x4*)a0);
                    const s16x4 hi = __builtin_amdgcn_ds_read_tr16_b64_v4i16((LAS s16x4*)(a0 + 16 * VS));
                    const bf16x8 vf = __builtin_shufflevector(lo, hi, 0, 1, 2, 3, 4, 5, 6, 7);
#pragma unroll
                    for (int nq = 0; nq < 2; ++nq) oT[md][nq] = __builtin_amdgcn_mfma_f32_16x16x32_bf16(vf, pf[kp][nq], oT[md][nq], 0, 0, 0);
                }
            if (more) {
                bf16_t* dK = sK + (buf ^ 1) * 64 * KS; bf16_t* dV = sV + (buf ^ 1) * 64 * VS;
                *(u32x4*)(dK + kc0 * KS + kp0 * 8) = kr0; if (tid < 256) *(u32x4*)(dK + kc1 * KS + kp1 * 8) = kr1;
                *(u32x4*)(dV + vk * VS + vp * 8) = vr0;
            }
            __syncthreads();
        }
        const size_t rbase = (isctx ? (size_t)TL + b * CTXL : (size_t)b * SEQ) + q0 + wv * 32;
#pragma unroll
        for (int nq = 0; nq < 2; ++nq) {
            float l = lsum[nq]; l += __shfl_xor(l, 16); l += __shfl_xor(l, 32);
            const float inv = 1.0f / l;
#pragma unroll
            for (int md = 0; md < 4; ++md) {
                u32x2 o; o.x = cvt_pk_bf16(oT[md][nq][0] * inv, oT[md][nq][1] * inv); o.y = cvt_pk_bf16(oT[md][nq][2] * inv, oT[md][nq][3] * inv);
                *(u32x2*)(p.Yatt + (rbase + nq * 16 + fr) * 512 + h * 64 + md * 16 + 4 * g) = o;
            }
        }
    }
}


#define HD __device__ __forceinline__
HD float2 cmul(float2 a, float2 b) { return make_float2(a.x * b.x - a.y * b.y, a.x * b.y + a.y * b.x); }
HD float2 cmulc(float2 a, float2 b) { return make_float2(a.x * b.x + a.y * b.y, a.y * b.x - a.x * b.y); }
HD float2 cadd(float2 a, float2 b) { return make_float2(a.x + b.x, a.y + b.y); }
HD float2 csub(float2 a, float2 b) { return make_float2(a.x - b.x, a.y - b.y); }
HD int fphys(int i) { return (i >> 8) * 272 + ((i >> 4) & 15) * 17 + (i & 15); }
constexpr int FBUF = 4352;
template <bool INV> HD void dft4(float2& x0, float2& x1, float2& x2, float2& x3) {
    const float2 s02 = cadd(x0, x2), d02 = csub(x0, x2), s13 = cadd(x1, x3), d13 = csub(x1, x3);
    const float2 jd = INV ? make_float2(-d13.y, d13.x) : make_float2(d13.y, -d13.x);
    x0 = cadd(s02, s13); x2 = csub(s02, s13); x1 = cadd(d02, jd); x3 = csub(d02, jd);
}
template <bool INV> HD void dft16(float2 (&v)[16]) {
#pragma unroll
    for (int b = 0; b < 4; ++b) dft4<INV>(v[b], v[4 + b], v[8 + b], v[12 + b]);
    const float C1 = 0.92387953251128674f, S1 = 0.38268343236508977f, C2 = 0.70710678118654752f;
#define TW(idx, cr, ci) v[idx] = INV ? cmulc(v[idx], make_float2(cr, ci)) : cmul(v[idx], make_float2(cr, ci))
    TW(4 * 1 + 1, C1, -S1);
    TW(4 * 1 + 2, C2, -C2);
    TW(4 * 1 + 3, S1, -C1);
    TW(4 * 2 + 1, C2, -C2);
    TW(4 * 2 + 2, 0.f, -1.f);
    TW(4 * 2 + 3, -C2, -C2);
    TW(4 * 3 + 1, S1, -C1);
    TW(4 * 3 + 2, -C2, -C2);
    TW(4 * 3 + 3, -C1, S1);
#undef TW
#pragma unroll
    for (int c = 0; c < 4; ++c) dft4<INV>(v[4 * c], v[4 * c + 1], v[4 * c + 2], v[4 * c + 3]);
#define SW(i, j) { const float2 t_ = v[i]; v[i] = v[j]; v[j] = t_; }
    SW(1, 4) SW(2, 8) SW(3, 12) SW(6, 9) SW(7, 13) SW(11, 14)
#undef SW
}
template <class BUF, class TW> HD void fwd_pass0(int u, float2 (&v)[16], BUF buf, TW W) {
    dft16<false>(v);
#pragma unroll
    for (int r = 0; r < 16; ++r) { if (r) v[r] = cmul(v[r], W[(u * r) & 4095]); buf[fphys(u) + 272 * r] = v[r]; }
}
template <class BUF, class TW> HD void fwd_pass1(int u, float2 (&v)[16], BUF buf, TW W) {
    const int j = u & 15, pb = (u >> 4) * 272 + j;
#pragma unroll
    for (int q = 0; q < 16; ++q) v[q] = buf[pb + 17 * q];
    dft16<false>(v);
#pragma unroll
    for (int r = 0; r < 16; ++r) { if (r) v[r] = cmul(v[r], W[(16 * j * r) & 4095]); buf[pb + 17 * r] = v[r]; }
}
template <class BUF> HD void fwd_pass2(int u, float2 (&v)[16], BUF buf) {
    const int pb = (u >> 4) * 272 + (u & 15) * 17;
#pragma unroll
    for (int q = 0; q < 16; ++q) v[q] = buf[pb + q];
    dft16<false>(v);
}
template <class BUF> HD void inv_passA(int u, float2 (&v)[16], BUF buf) {
    dft16<true>(v);
    const int pb = (u >> 4) * 272 + (u & 15) * 17;
#pragma unroll
    for (int r = 0; r < 16; ++r) buf[pb + r] = v[r];
}
template <class BUF, class TW> HD void inv_passB(int u, float2 (&v)[16], BUF buf, TW W) {
    const int j = u & 15, pb = (u >> 4) * 272 + j;
#pragma unroll
    for (int q = 0; q < 16; ++q) { v[q] = buf[pb + 17 * q]; if (q) v[q] = cmulc(v[q], W[(16 * j * q) & 4095]); }
    dft16<true>(v);
#pragma unroll
    for (int r = 0; r < 16; ++r) buf[pb + 17 * r] = v[r];
}
template <class BUF, class TW> HD void inv_passC(int u, float2 (&v)[16], BUF buf, TW W) {
#pragma unroll
    for (int q = 0; q < 16; ++q) { v[q] = buf[fphys(u) + 272 * q]; if (q) v[q] = cmulc(v[q], W[(u * q) & 4095]); }
    dft16<true>(v);
}
HD int digitrev(int i) { return ((i & 15) << 8) | (i & 0xF0) | (i >> 8); }

#undef HD
constexpr int FFT_LDS_W = 2 * FBUF * 8;
__device__ __forceinline__ void fft_load_w(const P& p, char* smem) {
    float2* Wl = (float2*)(smem + FFT_LDS_W);
    __syncthreads();
    for (int i = tid_opaque(); i < 4096; i += NT) Wl[i] = p.Wtab[i];
    __syncthreads();
}
__device__ __forceinline__ void ph_tables(const P& p) {
    for (int i = blockIdx.x * NT + tid_opaque(); i < 8192; i += gridDim.x * NT) {
        float sn, cs;
        if (i < 4096) { sincospif((float)i * (1.0f / 2048.0f), &sn, &cs); p.Wtab[i] = make_float2(cs, -sn); }
        else { sincospif((float)(i - 4096) * (1.0f / 4096.0f), &sn, &cs); p.W2tab[i - 4096] = make_float2(cs, -sn); }
    }
}
__device__ __forceinline__ void ph_spectra(const P& p, char* smem) {
    float2* bufE = (float2*)smem; float2* bufO = bufE + FBUF; const float2* Wl = (const float2*)(smem + FFT_LDS_W);
    const int tid = tid_opaque(), half = tid >> 8, u = tid & 255;
    float2* buf = half ? bufO : bufE;
    fft_load_w(p, smem);
    for (int un = blockIdx.x; un < DEPTH * HYW; un += gridDim.x) {
        const int l = un / HYW, c = un % HYW;
        const float* hf0 = p.HT0 + ((size_t)l * 2048 + c) * SEQ;        const float s_f0 = p.SCL0[l * 2048 + c];
        const float* hb0 = p.HT0 + ((size_t)l * 2048 + 512 + c) * SEQ;  const float s_b0 = p.SCL0[l * 2048 + 512 + c];
        const float* hf1 = p.HT0 + ((size_t)l * 2048 + 1024 + c) * SEQ; const float s_f1 = p.SCL0[l * 2048 + 1024 + c];
        const float* hb1 = p.HT0 + ((size_t)l * 2048 + 1536 + c) * SEQ; const float s_b1 = p.SCL0[l * 2048 + 1536 + c];
        float2 v[16];
#pragma unroll
        for (int q = 0; q < 16; ++q) {
            const int j = 2 * (u + 256 * q) + half;
            float a, b;
            if (j < SEQ) { a = hf0[j] * s_f0; b = hf1[j] * s_f1; } else if (j == SEQ) { a = 0.f; b = 0.f; } else { a = hb0[2 * SEQ - j] * s_b0; b = hb1[2 * SEQ - j] * s_b1; }
            v[q] = make_float2(a, b);
        }
        __syncthreads();
        fwd_pass0(u, v, buf, Wl); __syncthreads();
        fwd_pass1(u, v, buf, Wl); __syncthreads();
        fwd_pass2(u, v, buf);
#pragma unroll
        for (int r = 0; r < 16; ++r) buf[fphys(16 * u + r)] = v[r];
        __syncthreads();
        float2* out = p.Hs + (size_t)(l * HYW + c) * 4 * 4096;
        for (int idx = tid; idx < 8192; idx += NT) {
            const int par = idx >> 12, pi = idx & 4095, kp = 2 * digitrev(pi) + par, kpp = (8192 - kp) & 8191;
            const int k1 = kp & 4095, k2 = kpp & 4095;
            float2 t1 = cmul(p.W2tab[k1], bufO[fphys(digitrev(k1))]); if (kp >= 4096) { t1.x = -t1.x; t1.y = -t1.y; }
            float2 t2 = cmul(p.W2tab[k2], bufO[fphys(digitrev(k2))]); if (kpp >= 4096) { t2.x = -t2.x; t2.y = -t2.y; }
            const float2 F = cadd(bufE[fphys(digitrev(k1))], t1), Gq = cadd(bufE[fphys(digitrev(k2))], t2);
            const float sc = 0.5f / 8192.0f;
            out[(0 * 2 + par) * 4096 + pi] = make_float2((F.x + Gq.x) * sc, (F.y - Gq.y) * sc);
            out[(1 * 2 + par) * 4096 + pi] = make_float2((F.y + Gq.y) * sc, -(F.x - Gq.x) * sc);
        }
    }
    __syncthreads();
}
__device__ __forceinline__ void ph_shortconv(const P& p, int l) {
    const int n = NB * HYC * (SEQ / 8);
    for (int i = blockIdx.x * NT + tid_opaque(); i < n; i += gridDim.x * NT) {
        const int t0 = (i & (SEQ / 8 - 1)) * 8, rc = i / (SEQ / 8), col = rc % HYC;
        const bf16_t* pr = p.PT + (size_t)rc * SEQ;
        const float w0 = p.sc_w[(size_t)(l * 3 + 0) * HYC + col], w1 = p.sc_w[(size_t)(l * 3 + 1) * HYC + col], w2 = p.sc_w[(size_t)(l * 3 + 2) * HYC + col], bb = p.sc_b[l * HYC + col];
        f32x4 a, b; unpack8(*(const u32x4*)(pr + t0), a, b);
        const float left = t0 > 0 ? bf2f(pr[t0 - 1]) : 0.f, right = t0 + 8 < SEQ ? bf2f(pr[t0 + 8]) : 0.f;
        f32x4 o0, o1;
        o0[0] = bb + w0 * left + w1 * a[0] + w2 * a[1]; o0[1] = bb + w0 * a[0] + w1 * a[1] + w2 * a[2]; o0[2] = bb + w0 * a[1] + w1 * a[2] + w2 * a[3]; o0[3] = bb + w0 * a[2] + w1 * a[3] + w2 * b[0];
        o1[0] = bb + w0 * a[3] + w1 * b[0] + w2 * b[1]; o1[1] = bb + w0 * b[0] + w1 * b[1] + w2 * b[2]; o1[2] = bb + w0 * b[1] + w1 * b[2] + w2 * b[3]; o1[3] = bb + w0 * b[2] + w1 * b[3] + w2 * right;
        *(u32x4*)(p.UT + (size_t)rc * SEQ + t0) = pack8(o0, o1);
    }
}
__device__ __forceinline__ void fft_conv(int half, int u, float2 (&v)[16], const float2* W2g, const float2* Hso, float2* buf, const float2* Wl) {
    if (half) {
#pragma unroll
        for (int q = 0; q < 16; ++q) v[q] = cmul(v[q], W2g[u + 256 * q]);
    }
    fwd_pass0(u, v, buf, Wl); __syncthreads();
    fwd_pass1(u, v, buf, Wl); __syncthreads();
    fwd_pass2(u, v, buf);
    const float4* hp = (const float4*)(Hso + (size_t)half * 4096 + 16 * u);
#pragma unroll
    for (int r2 = 0; r2 < 8; ++r2) { const float4 h = hp[r2]; v[2 * r2] = cmul(v[2 * r2], make_float2(h.x, h.y)); v[2 * r2 + 1] = cmul(v[2 * r2 + 1], make_float2(h.z, h.w)); }
    inv_passA(u, v, buf); __syncthreads();
    inv_passB(u, v, buf, Wl); __syncthreads();
    inv_passC(u, v, buf, Wl);
    if (half) {
#pragma unroll
        for (int r = 0; r < 16; ++r) v[r] = cmulc(v[r], W2g[u + 256 * r]);
    }
}
constexpr int FFT_LDS_B2 = FFT_LDS_W + 4096 * 8;
__device__ __forceinline__ void ph_hyena_fft(const P& p, int l, char* smem) {
    float2* buf0 = (float2*)smem; float2* buf1 = buf0 + FBUF; const float2* Wl = (const float2*)(smem + FFT_LDS_W); float2* buf2 = (float2*)(smem + FFT_LDS_B2);
    const int tid = tid_opaque(), half = tid >> 8, u = tid & 255;
    float2* buf = half ? buf1 : buf0;
    const int pu = fphys(u);
    fft_load_w(p, smem);
    for (int c = blockIdx.x; c < HYW; c += gridDim.x) {
        const float bias0 = p.flt_bias[(l * 2 + 0) * HYW + c], bias1 = p.flt_bias[(l * 2 + 1) * HYW + c];
        const float2* Hs0 = p.Hs + (size_t)(l * HYW + c) * 4 * 4096; const float2* Hs1 = Hs0 + 2 * 4096;
        for (int pr = 0; pr < 2; ++pr) {
            const bf16_t* vA = p.UT + ((size_t)(2 * pr) * HYC + c) * SEQ + u; const bf16_t* vB = vA + (size_t)HYC * SEQ;
            float2 v[16];
#pragma unroll
            for (int q = 0; q < 16; ++q) v[q] = make_float2(bf2f(vA[256 * q]), bf2f(vB[256 * q]));
            __syncthreads();
            fft_conv(half, u, v, p.W2tab, Hs0, buf, Wl);
            if (half) {
#pragma unroll
                for (int r = 0; r < 16; ++r) buf1[pu + 272 * r] = v[r];
            }
            __syncthreads();
            if (!half) {
                const bf16_t* xA = vA + (size_t)HYW * SEQ; const bf16_t* xB = vB + (size_t)HYW * SEQ;
#pragma unroll
                for (int r = 0; r < 16; ++r) {
                    const float2 y = cadd(v[r], buf1[pu + 272 * r]);
                    const float2 z1 = make_float2(bf2f(xA[256 * r]) * (y.x + bias0 * bf2f(vA[256 * r])), bf2f(xB[256 * r]) * (y.y + bias0 * bf2f(vB[256 * r])));
                    v[r] = z1; buf1[pu + 272 * r] = z1; buf2[pu + 272 * r] = z1;
                }
            }
            __syncthreads();
            if (half) {
#pragma unroll
                for (int r = 0; r < 16; ++r) v[r] = buf1[pu + 272 * r];
            }
            fft_conv(half, u, v, p.W2tab, Hs1, buf, Wl);
            if (half) {
#pragma unroll
                for (int r = 0; r < 16; ++r) buf1[pu + 272 * r] = v[r];
            }
            __syncthreads();
            if (!half) {
                const bf16_t* xA = vA + (size_t)2 * HYW * SEQ; const bf16_t* xB = vB + (size_t)2 * HYW * SEQ;
                bf16_t* oA = p.Yhy + ((size_t)(2 * pr) * SEQ + u) * HYW + c; bf16_t* oB = oA + (size_t)SEQ * HYW;
#pragma unroll
                for (int r = 0; r < 16; ++r) {
                    const float2 y = cadd(v[r], buf1[pu + 272 * r]), z1 = buf2[pu + 272 * r];
                    oA[(size_t)(256 * r) * HYW] = f2bf(bf2f(xA[256 * r]) * (y.x + bias1 * z1.x));
                    oB[(size_t)(256 * r) * HYW] = f2bf(bf2f(xB[256 * r]) * (y.y + bias1 * z1.y));
                }
            }
        }
    }
    __syncthreads();
}

__device__ __forceinline__ void conv_tile(bf16_t* tile, const float* src, int ld, int c0, int ncols, int K, bf16_t* dst, int kt, int ntile) {
    const int tid = tid_opaque();
    const int k = tid >> 3, n8 = (tid & 7) * 8, nbase = ntile * 64;
    float4 x0 = make_float4(0.f, 0.f, 0.f, 0.f), x1 = x0;
    if (nbase + n8 < ncols) { const float* sp = src + (size_t)(kt * 64 + k) * ld + c0 + nbase + n8; x0 = *(const float4*)sp; x1 = *(const float4*)(sp + 4); }
    __syncthreads();
    tile[(n8 + 0) * 72 + k] = f2bf(x0.x); tile[(n8 + 1) * 72 + k] = f2bf(x0.y); tile[(n8 + 2) * 72 + k] = f2bf(x0.z); tile[(n8 + 3) * 72 + k] = f2bf(x0.w);
    tile[(n8 + 4) * 72 + k] = f2bf(x1.x); tile[(n8 + 5) * 72 + k] = f2bf(x1.y); tile[(n8 + 6) * 72 + k] = f2bf(x1.z); tile[(n8 + 7) * 72 + k] = f2bf(x1.w);
    __syncthreads();
    const int n = tid >> 3, k8 = (tid & 7) * 8;
    if (nbase + n < ncols) *(u32x4*)(dst + (size_t)(nbase + n) * K + kt * 64 + k8) = *(const u32x4*)(tile + n * 72 + k8);
}
constexpr int DENSE_TILES = 1720;
__device__ __forceinline__ void ph_conv_dense(const P& p, char* smem) {
    bf16_t* tile = (bf16_t*)smem;
    for (int id = blockIdx.x; id < DEPTH * DENSE_TILES; id += gridDim.x) {
        const int l = id / DENSE_TILES; int r = id % DENSE_TILES;
        const float* win = p.w_in + (size_t)l * DM * INC;
        if (r < 384) conv_tile(tile, win, INC, 0, HYC, DM, p.WtHy + (size_t)l * HYC * DM, r / 24, r % 24);
        else if ((r -= 384) < 176) conv_tile(tile, win, INC, HYC, MLAW, DM, p.WtRest + (size_t)l * 2816 * DM, r / 11, r % 11);
        else if ((r -= 176) < 512) conv_tile(tile, win, INC, MLA_END, 2048, DM, p.WtRest + ((size_t)l * 2816 + 768) * DM, r / 32, r % 32);
        else if ((r -= 512) < 72) conv_tile(tile, p.w_uq + (size_t)l * QL * 768, 768, 0, 768, QL, p.WtUq + (size_t)l * 768 * QL, r / 12, r % 12);
        else if ((r -= 72) < 64) conv_tile(tile, p.w_ukv + (size_t)l * KVL * 1024, 1024, 0, 1024, KVL, p.WtUkv + (size_t)l * 1024 * KVL, r / 16, r % 16);
        else if ((r -= 64) < 128) conv_tile(tile, p.w_hy_o + (size_t)l * HYW * DM, DM, 0, DM, HYW, p.WtHyo + (size_t)l * DM * HYW, r / 16, r % 16);
        else if ((r -= 128) < 128) conv_tile(tile, p.w_mla_o + (size_t)l * 512 * DM, DM, 0, DM, 512, p.WtMlao + (size_t)l * DM * 512, r / 16, r % 16);
        else { r -= 128; conv_tile(tile, p.w_out + (size_t)l * DM * DM, DM, 0, DM, DM, p.WtOut + (size_t)l * DM * DM, r / 16, r % 16); }
    }
    const int nz = DEPTH * 96 * DM / 8;
    for (int i = blockIdx.x * NT + threadIdx.x; i < nz + SEQ * 16; i += gridDim.x * NT) {
        if (i < nz) { const int l = i / (96 * DM / 8), o = i % (96 * DM / 8); *(u32x4*)(p.WtRest + ((size_t)l * 2816 + MLAW) * DM + (size_t)o * 8) = (u32x4){0u, 0u, 0u, 0u}; }
        else { const int k = i - nz, t = k >> 4, a = (k >> 3) & 1, ii = k & 7; const float ang = (float)(a == 0 ? (t >> 6) : (t & 63)) * powf(10000.0f, -(float)ii / 8.0f); p.rope[k] = make_float2(cosf(ang), sinf(ang)); }
    }
}
__device__ __forceinline__ void ph_conv_experts(const P& p, int l, char* smem) {
    bf16_t* tile = (bf16_t*)smem;
    for (int id = blockIdx.x; id < NE * 192; id += gridDim.x) {
        const int e = id / 192; int r = id % 192;
        const size_t le = (size_t)l * NE + e;
        if (r < 64) conv_tile(tile, p.w_gate + le * DM * DE, DE, 0, DE, DM, p.WtG + (size_t)e * DE * DM, r / 4, r % 4);
        else if (r < 128) { r -= 64; conv_tile(tile, p.w_up + le * DM * DE, DE, 0, DE, DM, p.WtU + (size_t)e * DE * DM, r / 4, r % 4); }
        else { r -= 128; conv_tile(tile, p.w_down + le * DE * DM, DM, 0, DM, DE, p.WtD + (size_t)e * DM * DE, r / 16, r % 16); }
    }
    __syncthreads();
}

constexpr int LDS_TAB = ge::STAGE_BYTES;
static_assert(FFT_LDS_B2 + FBUF * 8 <= 140 * 1024 - 16, "FFT LDS image");
constexpr int LDS_TOTAL = 140 * 1024;
#define PH_P KArgP kp_ = (KArgP)__builtin_amdgcn_kernarg_segment_ptr(); asm volatile("" : "+s"(kp_)); const P p = make_p(kp_); int G = gridDim.x, c = blockIdx.x; asm volatile("" : "+s"(G), "+s"(c)); (void)G; (void)c;
#define GRID_BAR() do { XcdBarrier b_; b_.bar = (unsigned*)k.ws; b_.x = xb_xcc_id(); b_.st = xbw; xcd_barrier(b_); } while (0)
__global__ __launch_bounds__(NT, 2) void mega(PK k) {
    extern __shared__ __attribute__((aligned(16))) char smem[];
    LAS unsigned char* lds = (LAS unsigned char*)smem;
    volatile LAS unsigned* xbw = (volatile LAS unsigned*)(smem + LDS_TOTAL - 16);
    if (threadIdx.x == 0) { xbw[0] = 0u; xbw[1] = 0u; xbw[2] = 0u; xbw[3] = 0u; }
    __syncthreads();
    (void)xcd_barrier_post((unsigned*)k.ws, xbw);
    int* offs = (int*)(smem + LDS_TAB); int* tpre = offs + 65; int* cntl = tpre + 65;
    const LAS int* offs_l = (const LAS int*)(lds + LDS_TAB); const LAS int* tpre_l = offs_l + 65; const LAS int* cntl_l = tpre_l + 65;
    { PH_P ph_copy_h(p); ph_mod_partial(p, smem); ph_filter_a(p, smem); ph_conv_dense(p, smem); ph_tables(p); }
    GRID_BAR();
    { PH_P ph_filter_b(p, smem); }
    GRID_BAR();
    { PH_P ph_finalize(p); }
    GRID_BAR();
    { PH_P ph_spectra(p, smem); }
    GRID_BAR();
    for (int l = 0; l < DEPTH; ++l) {
        { PH_P ph_norm<1>(p, l, smem); }
        GRID_BAR();
        { PH_P
            SchedInproj S{(const char*)(p.WtHy + (size_t)l * HYC * DM), (const char*)(p.WtRest + (size_t)l * 2816 * DM), (const char*)p.U, G, c};
            EpiInproj E{p.PT, p.PTc, p.PMLA, p.G};
            ge::gemm_engine<false>(lds, DM, DM, DM, S, E);
        }
        GRID_BAR();
        { PH_P ph_mla_prep(p, l); }
        { PH_P ph_shortconv(p, l); }
        GRID_BAR();
        { PH_P
            SchedDense S{(const char*)p.CQ, (const char*)(p.WtUq + (size_t)l * 768 * QL), (size_t)QL * 2, (size_t)QL * 2, 68, 3, G, c};
            EpiQ E{p.Q, p.Qc, p.rope};
            ge::gemm_engine<false>(lds, QL, QL, QL, S, E);
        }
        { PH_P
            SchedDense S2{(const char*)p.CKV, (const char*)(p.WtUkv + (size_t)l * 1024 * KVL), (size_t)KVL * 2, (size_t)KVL * 2, 68, 4, G, (c + G - (204 % G)) % G};
            EpiKV E2{p.K, p.V};
            ge::gemm_engine<false>(lds, KVL, KVL, KVL, S2, E2);
        }
        GRID_BAR();
        { PH_P ph_conv_experts(p, l, smem); }
        { PH_P ph_attn2(p, smem); }
        { PH_P ph_hyena_fft(p, l, smem); }
        { PH_P ph_hyena<CTXL>(p, l, smem); }
        GRID_BAR();
        { PH_P
            SchedMerge S{(const char*)p.Yhy, (const char*)p.Yatt, (const char*)(p.WtHyo + (size_t)l * DM * HYW), (const char*)(p.WtMlao + (size_t)l * DM * 512), G, c};
            EpiMerge E{p.G, p.M1};
            ge::gemm_engine<false>(lds, 512, 512, 512, S, E);
        }
        GRID_BAR();
        { PH_P
            SchedDense S{(const char*)p.M1, (const char*)(p.WtOut + (size_t)l * DM * DM), (size_t)DM * 2, (size_t)DM * 2, 68, 4, G, c};
            EpiOut E{p.hx, p.mod + (size_t)l * 5 * NMOD};
            ge::gemm_engine<false>(lds, DM, DM, DM, S, E);
        }
        GRID_BAR();
        { PH_P ph_norm<2>(p, l, smem); }
        GRID_BAR();
        { PH_P
            if (threadIdx.x == 0) { int a = 0, t = 0; for (int e = 0; e < NE; ++e) { const int n = p.cnt[l * NE + e]; offs[e] = a; tpre[e] = t; cntl[e] = n; a += n; t += (n + 255) >> 8; } offs[64] = a; tpre[64] = t; }
            __syncthreads();
            SchedGU S{(const char*)p.U, (const char*)p.WtG, (const char*)p.WtU, p.list, tpre_l, cntl_l, G, c};
            EpiGU E{p.Hb, offs_l};
            ge::gemm_engine<true>(lds, DM, DM, DM, S, E);
        }
        GRID_BAR();
        { PH_P
            SchedDown S{(const char*)p.Hb, (const char*)p.WtD, tpre_l, cntl_l, offs_l, G, c};
            EpiDown E{p.Y, p.wl, offs_l};
            ge::gemm_engine<false>(lds, DE, DE, DE, S, E);
        }
        GRID_BAR();
        { PH_P ph_combine(p, l, offs); }
        GRID_BAR();
    }
    { PH_P ph_final(p); }
}

extern "C" void kernel_launch(void* const* d_in, const int* in_sizes, int n_in, void* d_out, int out_size, void* d_ws, size_t ws_size, hipStream_t stream) {
    (void)in_sizes; (void)out_size;
    if (n_in < 33 || WSO.total > ws_size) { fprintf(stderr, "kernel_launch: need 33 inputs and %zu bytes of workspace; got %d, %zu\n", (size_t)WSO.total, n_in, ws_size); return; }
    PK k{};
    for (int i = 0; i < 33; ++i) k.in[i] = (const float*)d_in[i];
    k.out = (float*)d_out; k.ws = (char*)d_ws;
    (void)hipMemsetAsync(d_ws, 0, WS_ZERO_BYTES, stream);
    static int grid = 0;
    if (!grid) {
        int dev = 0, cus = 0, per_cu = 0;
        (void)hipGetDevice(&dev);
        (void)hipDeviceGetAttribute(&cus, hipDeviceAttributeMultiprocessorCount, dev);
        (void)hipFuncSetAttribute((const void*)mega, hipFuncAttributeMaxDynamicSharedMemorySize, LDS_TOTAL);
        (void)hipOccupancyMaxActiveBlocksPerMultiprocessor(&per_cu, (const void*)mega, NT, LDS_TOTAL);
        if (per_cu < 1) fprintf(stderr, "kernel_launch: occupancy query reports %d blocks per CU\n", per_cu);
        grid = cus > 0 ? cus : 256;
    }
    hipLaunchKernelGGL(mega, dim3(grid), dim3(NT), LDS_TOTAL, stream, k);
}
```

```cpp
#include <hip/hip_runtime.h>
#include <stdint.h>
#include <stdio.h>

typedef unsigned short bf16_t;
typedef short bf16x8 __attribute__((ext_vector_type(8)));
typedef float f32x4 __attribute__((ext_vector_type(4)));
typedef unsigned u32x4 __attribute__((ext_vector_type(4)));
typedef unsigned u32x2 __attribute__((ext_vector_type(2)));

#define NT 512
#ifndef REP_PRO
#define REP_PRO 1
#endif
#ifndef REP_DENSE
#define REP_DENSE 1
#endif
#ifndef REP_MOE
#define REP_MOE 1
#endif
#ifndef REP_MIX
#define REP_MIX 1
#endif
#ifndef REP_MISC
#define REP_MISC 1
#endif
constexpr int DM = 1024, NB = 4, SEQ = 4096, DEPTH = 4, CTXL = 256;
constexpr int TL = NB * SEQ, TC = NB * CTXL, TT = TL + TC;
constexpr int HYW = 512, HYC = 1536, QL = 384, KVL = 256, QKR = 32;
constexpr int MLAW = QL + KVL + QKR, MLA_END = HYC + MLAW, INC = MLA_END + 2 * DM;
constexpr int NH = 8, DQK = 96, DV = 64, NKEY = SEQ + CTXL;
constexpr int NE = 64, DE = 256, CAP = TT;
constexpr int NMOD = 6 * DM;
constexpr float EPSF = 1e-6f;
constexpr float QSCALE = 0.10206207261596577f * 1.4426950408889634f;

__device__ __forceinline__ bf16_t f2bf(float f) { unsigned u = __float_as_uint(f); u += 0x7FFFu + ((u >> 16) & 1u); return (bf16_t)(u >> 16); }
__device__ __forceinline__ float bf2f(bf16_t b) { return __uint_as_float(((unsigned)b) << 16); }
__device__ __forceinline__ unsigned pack2(float lo, float hi) { return (unsigned)f2bf(lo) | ((unsigned)f2bf(hi) << 16); }
__device__ __forceinline__ int tid_opaque() { int t = threadIdx.x; asm volatile("" : "+v"(t)); return t; }
__device__ __forceinline__ float wave_sum(float v) {
#pragma unroll
    for (int o = 32; o > 0; o >>= 1) v += __shfl_xor(v, o);
    return v;
}


#define XB_TMO      128
#define XB_XCNT(j)  (256  + 64 * (j))
#define XB_XSUB(j)  (1280 + 64 * (j))
#define XB_XGEN(j)  (2304 + 64 * (j))
#define XB_TOP      3328
#define XB_TOPGEN   3392
#define XCD_BAR_WORDS 3456
#define XB_SPIN_CAP (1u << 22)
#define LAS __attribute__((address_space(3)))
__device__ __forceinline__ unsigned xb_ld(unsigned* p)              { return __hip_atomic_load(p, __ATOMIC_RELAXED, __HIP_MEMORY_SCOPE_AGENT); }
__device__ __forceinline__ unsigned xb_add(unsigned* p, unsigned v) { return __hip_atomic_fetch_add(p, v, __ATOMIC_RELAXED, __HIP_MEMORY_SCOPE_AGENT); }
__device__ __forceinline__ unsigned xb_xcc_id() { return (unsigned)__builtin_amdgcn_s_getreg((3 << 11) | 20) & 0xFu; }
#define XB_SPIN(cond, bar) do { unsigned _sp = 0; while (cond) { __builtin_amdgcn_s_sleep(1); \
    if ((++_sp & 255u) == 0u) { if (xb_ld(&(bar)[XB_TMO])) break; if (_sp > XB_SPIN_CAP) { atomicAdd(&(bar)[XB_TMO], 1u); break; } } } } while (0)
struct XcdBarrier { unsigned* bar; unsigned x; volatile LAS unsigned* st; };
__device__ __forceinline__ XcdBarrier xcd_barrier_post(unsigned* bar, volatile LAS unsigned* st) {
    XcdBarrier b; b.bar = bar; b.x = xb_xcc_id(); b.st = st;
    if (threadIdx.x == 0) (void)xb_add(&bar[XB_XCNT(b.x)], 1u);
    return b;
}
__device__ __forceinline__ void xcd_barrier_complete(unsigned* bar, unsigned x, unsigned& nloc, unsigned& nx) {
    const unsigned G = gridDim.x * gridDim.y * gridDim.z;
    unsigned sum, cnt, mine, sp = 0u;
    for (;;) {
        sum = 0u; cnt = 0u; mine = 0u;
#pragma unroll
        for (unsigned j = 0; j < 16; ++j) { const unsigned c = xb_ld(&bar[XB_XCNT(j)]); sum += c; cnt += (c > 0u) ? 1u : 0u; mine = (j == x) ? c : mine; }
        if (sum == G) break;
        __builtin_amdgcn_s_sleep(1);
        if ((++sp & 255u) == 0u) { if (xb_ld(&bar[XB_TMO])) break; if (sp > XB_SPIN_CAP) { atomicAdd(&bar[XB_TMO], 1u); break; } }
    }
    nloc = mine > 0u ? mine : 1u; nx = cnt > 0u ? cnt : 1u;
}
__device__ __forceinline__ void xcd_barrier(const XcdBarrier& b) {
    asm volatile("s_waitcnt vmcnt(0)" ::: "memory");
    __syncthreads();
    if (threadIdx.x == 0) {
        unsigned* bar = b.bar;
        __builtin_amdgcn_s_waitcnt(0);
        unsigned nloc = b.st[0], nx = b.st[1];
        if (nloc == 0u) { xcd_barrier_complete(bar, b.x, nloc, nx); b.st[0] = nloc; b.st[1] = nx; }
        const unsigned old = xb_add(&bar[XB_XSUB(b.x)], 1u);
        const unsigned gen = old / nloc;
        if (old + 1u == (gen + 1u) * nloc) {
            __builtin_amdgcn_fence(__ATOMIC_RELEASE, "agent");
            asm volatile("s_waitcnt vmcnt(0)" ::: "memory");
            const unsigned og = xb_add(&bar[XB_TOP], 1u);
            const unsigned tg = og / nx;
            if (og + 1u == (tg + 1u) * nx) xb_add(&bar[XB_TOPGEN], 1u);
            else XB_SPIN(xb_ld(&bar[XB_TOPGEN]) == tg, bar);
            __builtin_amdgcn_fence(__ATOMIC_ACQUIRE, "agent");
            xb_add(&bar[XB_XGEN(b.x)], 1u);
            asm volatile("s_waitcnt vmcnt(0)" ::: "memory");
        } else {
            XB_SPIN(xb_ld(&bar[XB_XGEN(b.x)]) == gen, bar);
            __builtin_amdgcn_fence(__ATOMIC_ACQUIRE, "agent");
            asm volatile("s_waitcnt vmcnt(0)" ::: "memory");
        }
    }
    __syncthreads();
}

#define WS_LIST(X) \
    X(unsigned, bar, XCD_BAR_WORDS * 4)                         \
    X(int, cnt, DEPTH * 64 * 4)                                 \
    X(float, modp, (size_t)DEPTH * 8 * 5 * NMOD * 4)            \
    X(float, mod, (size_t)DEPTH * 5 * NMOD * 4)                 \
    X(float, H2a, (size_t)DEPTH * SEQ * 64 * 4) \
    X(float, H2b, (size_t)DEPTH * CTXL * 64 * 4) \
    X(float, HT1, (size_t)DEPTH * 2048 * CTXL * 4) \
    X(float, SSQ0, (size_t)DEPTH * 2048 * 64 * 4) \
    X(float, SSQ1, (size_t)DEPTH * 2048 * 4 * 4) \
    X(float, SCL0, (size_t)DEPTH * 2048 * 4) \
    X(float, SCL1, (size_t)DEPTH * 2048 * 4) \
    X(float, hx, (size_t)TT * DM * 4)                           \
    X(bf16_t, U, (size_t)TT * DM * 2)                           \
    X(bf16_t, PT, (size_t)NB * HYC * SEQ * 2)                   \
    X(bf16_t, PTc, (size_t)NB * HYC * CTXL * 2) \
    X(float, PMLA, (size_t)TT * MLAW * 4)                       \
    X(bf16_t, G, (size_t)TT * 2048 * 2)                         \
    X(bf16_t, CQ, (size_t)TT * QL * 2) \
    X(bf16_t, CKV, (size_t)TT * KVL * 2) \
    X(bf16_t, Q, (size_t)NB * NH * SEQ * 128 * 2)               \
    X(bf16_t, Qc, (size_t)NB * NH * CTXL * 128 * 2) \
    X(bf16_t, K, (size_t)NB * NH * NKEY * DQK * 2)              \
    X(bf16_t, V, (size_t)NB * NH * NKEY * DV * 2)               \
    X(bf16_t, Yatt, (size_t)TT * 512 * 2) \
    X(bf16_t, Yhy, (size_t)TT * 512 * 2) \
    X(bf16_t, M1, (size_t)TT * DM * 2) \
    X(int, list, (size_t)NE * CAP * 4) \
    X(float, wl, (size_t)NE * CAP * 4) \
    X(int, asg, (size_t)TT * 4 * 4) \
    X(bf16_t, Hb, (size_t)(2 * TT + 256) * DE * 2) \
    X(bf16_t, Y, (size_t)2 * TT * DM * 2) \
    X(bf16_t, WtHy, (size_t)DEPTH * HYC * DM * 2)               \
    X(bf16_t, WtRest, (size_t)DEPTH * 2816 * DM * 2) \
    X(bf16_t, WtUq, (size_t)DEPTH * 768 * QL * 2) \
    X(bf16_t, WtUkv, (size_t)DEPTH * 1024 * KVL * 2) \
    X(bf16_t, WtHyo, (size_t)DEPTH * DM * HYW * 2) \
    X(bf16_t, WtMlao, (size_t)DEPTH * DM * 512 * 2) \
    X(bf16_t, WtOut, (size_t)DEPTH * DM * DM * 2) \
    X(bf16_t, WtG, (size_t)NE * DE * DM * 2)                    \
    X(bf16_t, WtU, (size_t)NE * DE * DM * 2) \
    X(bf16_t, WtD, (size_t)NE * DM * DE * 2) \
    X(float2, rope, (size_t)SEQ * 16 * 8)                       \
    X(bf16_t, UT, (size_t)NB * HYC * SEQ * 2)                   \
    X(float2, Hs, (size_t)DEPTH * HYW * 4 * 4096 * 8)           \
    X(float2, Wtab, 4096 * 8) \
    X(bf16_t, WrT, (size_t)DEPTH * 2 * 80 * DM * 2)             \
    X(float2, W2tab, 4096 * 8)
struct WsOff {
#define X(t, n, b) size_t n;
    WS_LIST(X)
#undef X
    size_t total;
};
constexpr WsOff ws_layout() {
    WsOff o{}; size_t a = 0;
#define X(t, n, b) o.n = a; a += (((size_t)(b)) + 255) & ~(size_t)255;
    WS_LIST(X)
#undef X
    o.total = a; return o;
}
constexpr WsOff WSO = ws_layout();
constexpr size_t WS_ZERO_BYTES = WSO.modp;
static_assert(WSO.V - WSO.G >= (size_t)DEPTH * 2048 * SEQ * 4, "HT0 alias region too small");

struct PK { const float* in[33]; float* out; char* ws; };
struct P {
    const float *x, *c, *ctx, *c_ctx, *w_ada, *b_ada, *norm1_g, *w_in, *q_norm_g, *kv_norm_g, *w_uq, *w_ukv, *sc_w, *sc_b;
    const float *flt_w1, *flt_b1, *flt_freq, *flt_w2, *flt_b2, *flt_w3, *flt_bias, *w_hy_o, *w_mla_o, *w_out, *norm2_g;
    const float *w_rg, *b_rg, *w_re, *b_re, *w_gate, *w_up, *w_down, *final_g;
    float* out;
#define X(t, n, b) t* n;
    WS_LIST(X)
#undef X
    float* HT0;
};
typedef const __attribute__((address_space(4))) PK* KArgP;
__device__ __forceinline__ P make_p(KArgP kp) {
    P p; const KArgP& kk = kp; char* ws = kk->ws;
    p.x = kk->in[0]; p.c = kk->in[1]; p.ctx = kk->in[2]; p.c_ctx = kk->in[3]; p.w_ada = kk->in[4]; p.b_ada = kk->in[5]; p.norm1_g = kk->in[6]; p.w_in = kk->in[7];
    p.q_norm_g = kk->in[8]; p.kv_norm_g = kk->in[9]; p.w_uq = kk->in[10]; p.w_ukv = kk->in[11]; p.sc_w = kk->in[12]; p.sc_b = kk->in[13];
    p.flt_w1 = kk->in[14]; p.flt_b1 = kk->in[15]; p.flt_freq = kk->in[16]; p.flt_w2 = kk->in[17]; p.flt_b2 = kk->in[18]; p.flt_w3 = kk->in[19]; p.flt_bias = kk->in[20];
    p.w_hy_o = kk->in[21]; p.w_mla_o = kk->in[22]; p.w_out = kk->in[23]; p.norm2_g = kk->in[24]; p.w_rg = kk->in[25]; p.b_rg = kk->in[26]; p.w_re = kk->in[27]; p.b_re = kk->in[28];
    p.w_gate = kk->in[29]; p.w_up = kk->in[30]; p.w_down = kk->in[31]; p.final_g = kk->in[32];
    p.out = kk->out;
#define X(t, n, b) p.n = (t*)(ws + WSO.n);
    WS_LIST(X)
#undef X
    p.HT0 = (float*)(ws + WSO.G);
    return p;
}

__device__ __forceinline__ void ph_copy_h(const P& p) {
    const size_t n4 = (size_t)TT * DM / 4, nl4 = (size_t)TL * DM / 4;
    for (size_t i = (size_t)blockIdx.x * NT + threadIdx.x; i < n4; i += (size_t)gridDim.x * NT) {
        float4 v = (i < nl4) ? ((const float4*)p.x)[i] : ((const float4*)p.ctx)[i - nl4];
        ((float4*)p.hx)[i] = v;
    }
}

__device__ __forceinline__ void ph_mod_partial(const P& p, char* smem) {
    float* s = (float*)smem;
    const int tid = tid_opaque();
    for (int it = blockIdx.x; it < DEPTH * 8 * 12; it += gridDim.x) {
        const int l = it / 96, kc = (it / 12) % 8, jb = it % 12;
        __syncthreads();
        for (int i = tid; i < 5 * 128; i += NT) {
            const int r = i / 128, kk = i % 128, k = kc * 128 + kk;
            const float cv = (r < 4) ? p.c[r * DM + k] : p.c_ctx[k];
            s[i] = cv / (1.0f + expf(-cv));
        }
        __syncthreads();
        const int j = jb * 512 + tid;
        float a0 = 0, a1 = 0, a2 = 0, a3 = 0, a4 = 0;
        const float* w = p.w_ada + ((size_t)l * DM + kc * 128) * NMOD + j;
#pragma unroll 8
        for (int kk = 0; kk < 128; ++kk) {
            const float wv = w[(size_t)kk * NMOD];
            a0 += s[kk] * wv; a1 += s[128 + kk] * wv; a2 += s[256 + kk] * wv; a3 += s[384 + kk] * wv; a4 += s[512 + kk] * wv;
        }
        float* o = p.modp + ((size_t)(l * 8 + kc) * 5) * NMOD + j;
        o[0] = a0; o[NMOD] = a1; o[2 * NMOD] = a2; o[3 * NMOD] = a3; o[4 * NMOD] = a4;
    }
}

__device__ __forceinline__ void ph_filter_a(const P& p, char* smem) {
    float* zs = (float*)smem;
    float* h1s = zs + 8 * 36;
    const int tid = tid_opaque(), tt = tid >> 6, j = tid & 63;
    const int n0 = DEPTH * 512, n1 = DEPTH * 32;
    for (int it = blockIdx.x; it < n0 + n1; it += gridDim.x) {
        int l, ls, tg;
        if (it < n0) { ls = 0; l = it / 512; tg = it % 512; } else { ls = 1; l = (it - n0) / 32; tg = (it - n0) % 32; }
        const int L = ls ? CTXL : SEQ;
        const int t = tg * 8 + tt;
        __syncthreads();
        if (j < 33) {
            float f;
            if (j == 0) f = (float)t / (float)(L - 1);
            else {
                const int k = (j - 1) & 15;
                const float band = 1e-4f + (float)k * ((15.0f - 1e-4f) / 15.0f);
                const float w = 6.283185307179586f * (float)t / (float)L;
                const double ang = (double)band * (double)w;
                f = (j <= 16) ? (float)cos(ang) : (float)(-sin(ang));
            }
            zs[tt * 36 + j] = f;
        }
        __syncthreads();
        const float fr = p.flt_freq[l * 64 + j];
        float a = p.flt_b1[l * 64 + j];
        for (int i = 0; i < 33; ++i) a += zs[tt * 36 + i] * p.flt_w1[((size_t)l * 33 + i) * 64 + j];
        h1s[tt * 64 + j] = sinf(fr * a);
        __syncthreads();
        float a2 = p.flt_b2[l * 64 + j];
        for (int i = 0; i < 64; ++i) a2 += h1s[tt * 64 + i] * p.flt_w2[((size_t)l * 64 + i) * 64 + j];
        const float h2 = sinf(fr * a2);
        if (ls == 0) p.H2a[((size_t)l * SEQ + t) * 64 + j] = h2; else p.H2b[((size_t)l * CTXL + t) * 64 + j] = h2;
    }
}

__device__ __forceinline__ void ph_filter_b(const P& p, char* smem) {
    float* w3s = (float*)smem;
    const int tid = tid_opaque(), lane = tid & 63, wv = tid >> 6;
    const int n0 = DEPTH * 8 * 16, n1 = DEPTH * 16;
    const float DA = -15.350567286626973f, DB = -3.0701134573253946f;
    for (int it = blockIdx.x; it < n0 + n1; it += gridDim.x) {
        int l, ls, tc, cc;
        if (it < n0) { ls = 0; l = it / 128; tc = (it / 16) % 8; cc = it % 16; } else { ls = 1; l = (it - n0) / 16; tc = 0; cc = (it - n0) % 16; }
        const int L = ls ? CTXL : SEQ;
        __syncthreads();
        for (int i = tid; i < 64 * 128; i += NT) { const int jj = i >> 7, c = i & 127; w3s[i] = p.flt_w3[((size_t)l * 64 + jj) * 2048 + cc * 128 + c]; }
        __syncthreads();
        int t, cbeg, cend;
        if (ls == 0) { t = tc * 512 + tid; cbeg = 0; cend = 128; } else { t = tid & 255; cbeg = (tid >> 8) * 64; cend = cbeg + 64; }
        const float* h2 = ls ? p.H2b + ((size_t)l * CTXL + t) * 64 : p.H2a + ((size_t)l * SEQ + t) * 64;
        float h[64];
#pragma unroll
        for (int jj = 0; jj < 64; jj += 4) { const float4 v = *(const float4*)(h2 + jj); h[jj] = v.x; h[jj + 1] = v.y; h[jj + 2] = v.z; h[jj + 3] = v.w; }
        const float tl = (float)t / (float)(L - 1);
        for (int c = cbeg; c < cend; ++c) {
            float acc = 0.f;
#pragma unroll
            for (int jj = 0; jj < 64; ++jj) acc += h[jj] * w3s[jj * 128 + c];
            const int col = cc * 128 + c, ch = col & 511;
            const float delta = fabsf(DA + (float)ch * ((DB - DA) / 511.0f));
            const float v = acc * expf(-tl * delta);
            if (ls == 0) p.HT0[((size_t)l * 2048 + col) * SEQ + t] = v; else p.HT1[((size_t)l * 2048 + col) * CTXL + t] = v;
            const float q = wave_sum(v * v);
            if (lane == 0) { if (ls == 0) p.SSQ0[((size_t)l * 2048 + col) * 64 + tc * 8 + wv] = q; else p.SSQ1[((size_t)l * 2048 + col) * 4 + (wv & 3)] = q; }
        }
    }
}

__device__ __forceinline__ void ph_finalize(const P& p) {
    const int n_mod = DEPTH * 5 * NMOD, n_s = DEPTH * 2048;
    for (int i = blockIdx.x * NT + threadIdx.x; i < n_mod + 2 * n_s; i += gridDim.x * NT) {
        if (i < n_mod) {
            const int l = i / (5 * NMOD), r = (i / NMOD) % 5, j = i % NMOD;
            float a = p.b_ada[l * NMOD + j];
            for (int kc = 0; kc < 8; ++kc) a += p.modp[((size_t)(l * 8 + kc) * 5 + r) * NMOD + j];
            p.mod[i] = a;
        } else if (i < n_mod + n_s) {
            const int k = i - n_mod; float a = 0.f;
            for (int q = 0; q < 64; ++q) a += p.SSQ0[(size_t)k * 64 + q];
            p.SCL0[k] = rsqrtf(a + EPSF);
        } else {
            const int k = i - n_mod - n_s; float a = 0.f;
            for (int q = 0; q < 4; ++q) a += p.SSQ1[(size_t)k * 4 + q];
            p.SCL1[k] = rsqrtf(a + EPSF);
        }
    }
}

template <int WHICH>
__device__ __forceinline__ void ph_norm(const P& p, int l, char* smem) {
    float* rowbuf = (float*)smem;
    float* lgs = rowbuf + 8 * 1024;
    const int tid = tid_opaque(), lane = tid & 63, wv = tid >> 6;
    const float* ng = (WHICH == 1 ? p.norm1_g : p.norm2_g) + l * DM;
    for (int rb = blockIdx.x * 8; rb < TT; rb += gridDim.x * 8) {
        const int row = rb + wv;
        const int b = row < TL ? (row >> 12) : 4;
        const float* hp = p.hx + (size_t)row * DM;
        const float* md = p.mod + ((size_t)l * 5 + b) * NMOD + (WHICH == 1 ? 0 : 3 * DM);
        float4 xv[4]; float ss = 0.f;
#pragma unroll
        for (int i = 0; i < 4; ++i) { xv[i] = *(const float4*)(hp + i * 256 + lane * 4); ss += xv[i].x * xv[i].x + xv[i].y * xv[i].y + xv[i].z * xv[i].z + xv[i].w * xv[i].w; }
        ss = wave_sum(ss);
        const float rs = rsqrtf(ss * (1.0f / DM) + EPSF);
#pragma unroll
        for (int i = 0; i < 4; ++i) {
            const int j = i * 256 + lane * 4;
            const float4 g = *(const float4*)(ng + j), sh = *(const float4*)(md + j), sc = *(const float4*)(md + DM + j);
            float4 y;
            y.x = (xv[i].x * rs * g.x) * (1.f + sc.x) + sh.x; y.y = (xv[i].y * rs * g.y) * (1.f + sc.y) + sh.y;
            y.z = (xv[i].z * rs * g.z) * (1.f + sc.z) + sh.z; y.w = (xv[i].w * rs * g.w) * (1.f + sc.w) + sh.w;
            u32x2 o; o.x = pack2(y.x, y.y); o.y = pack2(y.z, y.w);
            *(u32x2*)(p.U + (size_t)row * DM + j) = o;
            if (WHICH == 2) *(float4*)(rowbuf + wv * 1024 + j) = y;
        }
        if (WHICH == 2) {
            __syncthreads();
            const float* wre = p.w_re + (size_t)l * DM * NE + lane;
            const float* wrg = p.w_rg + (size_t)l * DM * 8 + (lane & 7);
            float ae = 0.f, ag = 0.f;
            const float* rbp = rowbuf + wv * 1024;
#pragma unroll 8
            for (int k = 0; k < DM; ++k) { const float tv = rbp[k]; ae += tv * wre[(size_t)k * NE]; ag += tv * wrg[(size_t)k * 8]; }
            lgs[wv * 72 + 8 + lane] = ae;
            if (lane < 8) lgs[wv * 72 + lane] = ag;
            __syncthreads();
            if (lane == 0) {
                const float* lg = lgs + wv * 72; const float* le = lg + 8;
                int gs = 0; float best = lg[0] + p.b_rg[l * 8], mx = lg[0];
                for (int i = 1; i < 8; ++i) { const float v = lg[i] + p.b_rg[l * 8 + i]; if (v > best) { best = v; gs = i; } mx = fmaxf(mx, lg[i]); }
                float den = 0.f;
                for (int i = 0; i < 8; ++i) den += expf(lg[i] - mx);
                const float pg = expf(lg[gs] - mx) / den;
                int i0 = 0; float k0 = le[gs * 8] + p.b_re[l * NE + gs * 8];
                for (int i = 1; i < 8; ++i) { const float v = le[gs * 8 + i] + p.b_re[l * NE + gs * 8 + i]; if (v > k0) { k0 = v; i0 = i; } }
                int i1 = -1; float k1 = 0.f;
                for (int i = 0; i < 8; ++i) { if (i == i0) continue; const float v = le[gs * 8 + i] + p.b_re[l * NE + gs * 8 + i]; if (i1 < 0 || v > k1) { k1 = v; i1 = i; } }
                const float w0 = 1.0f / (1.0f + expf(le[gs * 8 + i1] - le[gs * 8 + i0])), w1 = 1.0f - w0;
                const int e0 = gs * 8 + i0, e1 = gs * 8 + i1;
                const int r0 = atomicAdd(p.cnt + l * NE + e0, 1), r1 = atomicAdd(p.cnt + l * NE + e1, 1);
                p.list[(size_t)e0 * CAP + r0] = row; p.wl[(size_t)e0 * CAP + r0] = pg * w0;
                p.list[(size_t)e1 * CAP + r1] = row; p.wl[(size_t)e1 * CAP + r1] = pg * w1;
                *(int4*)(p.asg + (size_t)row * 4) = make_int4(e0, r0, e1, r1);
            }
            __syncthreads();
        }
    }
}

__device__ __forceinline__ float rope_apply(float self, float partner, int d, int t) {
    const int a = d >> 4, s = (d >> 3) & 1, i = d & 7;
    const float pos = (float)(a == 0 ? (t >> 6) : (t & 63));
    const float inv = powf(10000.0f, -(float)i / 8.0f);
    const float ang = pos * inv;
    const float cs = cosf(ang), sn = sinf(ang);
    return s == 0 ? self * cs - partner * sn : partner * sn + self * cs;
}

__device__ __forceinline__ void ph_mla_prep(const P& p, int l) {
    const int tid = tid_opaque(), lane = tid & 63, wv = tid >> 6;
    for (int rb = blockIdx.x * 8; rb < TT; rb += gridDim.x * 8) {
        const int row = rb + wv;
        const float* pm = p.PMLA + (size_t)row * MLAW;
        float q[6], ss = 0.f;
#pragma unroll
        for (int i = 0; i < 6; ++i) { q[i] = pm[lane + 64 * i]; ss += q[i] * q[i]; }
        ss = wave_sum(ss);
        float rs = rsqrtf(ss * (1.0f / QL) + EPSF);
#pragma unroll
        for (int i = 0; i < 6; ++i) p.CQ[(size_t)row * QL + lane + 64 * i] = f2bf(q[i] * rs * p.q_norm_g[l * QL + lane + 64 * i]);
        float kv[4]; ss = 0.f;
#pragma unroll
        for (int i = 0; i < 4; ++i) { kv[i] = pm[QL + lane + 64 * i]; ss += kv[i] * kv[i]; }
        ss = wave_sum(ss);
        rs = rsqrtf(ss * (1.0f / KVL) + EPSF);
#pragma unroll
        for (int i = 0; i < 4; ++i) p.CKV[(size_t)row * KVL + lane + 64 * i] = f2bf(kv[i] * rs * p.kv_norm_g[l * KVL + lane + 64 * i]);
        const int d = lane & 31;
        const float self = pm[QL + KVL + d];
        const float partner = __shfl_xor(self, 8);
        int b, key; float val;
        if (row < TL) { b = row >> 12; const int t = row & 4095; key = t; val = rope_apply(self, partner, d, t); }
        else { const int r = row - TL; b = r >> 8; key = SEQ + (r & 255); val = self; }
        if (lane < 32) {
            const bf16_t o = f2bf(val);
#pragma unroll
            for (int h = 0; h < NH; ++h) p.K[((size_t)(b * NH + h) * NKEY + key) * DQK + 64 + d] = o;
        }
    }
}

__device__ __forceinline__ void ph_attn(const P& p, char* smem) {
    bf16_t* sK = (bf16_t*)smem;
    bf16_t* sVt = sK + 64 * 104;
    bf16_t* sP = sVt + 64 * 72;
    const int tid = tid_opaque(), lane = tid & 63, wv = tid >> 6, fr = lane & 15, fq = lane >> 4;
    bf16_t* sPw = sP + wv * 16 * 72;
    const int NUL = NB * NH * 32, NUC = NB * NH * 2;
    for (int u = blockIdx.x; u < NUL + NUC; u += gridDim.x) {
        const bool isctx = u >= NUL;
        int b, h, q0;
        if (!isctx) { b = u / (NH * 32); h = (u / 32) % NH; q0 = (u % 32) * 128; } else { const int v = u - NUL; b = v / (NH * 2); h = (v / 2) % NH; q0 = (v % 2) * 128; }
        const bf16_t* Qp = isctx ? p.Qc + ((size_t)(b * NH + h) * CTXL + q0) * 128 : p.Q + ((size_t)(b * NH + h) * SEQ + q0) * 128;
        bf16x8 qa[4];
#pragma unroll
        for (int ks = 0; ks < 4; ++ks) qa[ks] = *(const bf16x8*)(Qp + (size_t)(wv * 16 + fr) * 128 + ks * 32 + fq * 8);
        const bf16_t* Kp = p.K + (size_t)(b * NH + h) * NKEY * DQK;
        const bf16_t* Vp = p.V + (size_t)(b * NH + h) * NKEY * DV;
        f32x4 o[4]; float m[4], lsum[4];
#pragma unroll
        for (int i = 0; i < 4; ++i) { o[i] = (f32x4){0.f, 0.f, 0.f, 0.f}; m[i] = -INFINITY; lsum[i] = 0.f; }
        for (int kt = isctx ? 64 : 0; kt < 68; ++kt) {
            __syncthreads();
            for (int i = tid; i < 768; i += NT) { const int key = i / 12, part = i % 12; *(u32x4*)(sK + key * 104 + part * 8) = *(const u32x4*)(Kp + (size_t)(kt * 64 + key) * DQK + part * 8); }
            {
                const int key = tid >> 3, d0 = (tid & 7) * 8;
                const bf16x8 vv = *(const bf16x8*)(Vp + (size_t)(kt * 64 + key) * DV + d0);
#pragma unroll
                for (int i = 0; i < 8; ++i) sVt[(d0 + i) * 72 + key] = (bf16_t)vv[i];
            }
            __syncthreads();
            f32x4 s[4];
#pragma unroll
            for (int nt = 0; nt < 4; ++nt) {
                s[nt] = (f32x4){0.f, 0.f, 0.f, 0.f};
#pragma unroll
                for (int ks = 0; ks < 3; ++ks) {
                    const bf16x8 a = (ks < 2) ? qa[ks] : (kt >= 64 ? qa[3] : qa[2]);
                    const bf16x8 bb = *(const bf16x8*)(sK + (nt * 16 + fr) * 104 + ks * 32 + fq * 8);
                    s[nt] = __builtin_amdgcn_mfma_f32_16x16x32_bf16(a, bb, s[nt], 0, 0, 0);
                }
            }
#pragma unroll
            for (int j = 0; j < 4; ++j) {
                float mx = fmaxf(fmaxf(s[0][j], s[1][j]), fmaxf(s[2][j], s[3][j]));
                mx = fmaxf(mx, __shfl_xor(mx, 1)); mx = fmaxf(mx, __shfl_xor(mx, 2)); mx = fmaxf(mx, __shfl_xor(mx, 4)); mx = fmaxf(mx, __shfl_xor(mx, 8));
                const float mn = fmaxf(m[j], mx);
                const float alpha = exp2f(m[j] - mn);
                m[j] = mn;
                float rsum = 0.f;
#pragma unroll
                for (int nt = 0; nt < 4; ++nt) { const float pv = exp2f(s[nt][j] - mn); rsum += pv; sPw[(fq * 4 + j) * 72 + nt * 16 + fr] = f2bf(pv); }
                rsum += __shfl_xor(rsum, 1); rsum += __shfl_xor(rsum, 2); rsum += __shfl_xor(rsum, 4); rsum += __shfl_xor(rsum, 8);
                lsum[j] = lsum[j] * alpha + rsum;
#pragma unroll
                for (int nt = 0; nt < 4; ++nt) o[nt][j] *= alpha;
            }
            __syncthreads();
#pragma unroll
            for (int ks = 0; ks < 2; ++ks) {
                const bf16x8 a = *(const bf16x8*)(sPw + fr * 72 + ks * 32 + fq * 8);
#pragma unroll
                for (int nt = 0; nt < 4; ++nt) {
                    const bf16x8 bb = *(const bf16x8*)(sVt + (nt * 16 + fr) * 72 + ks * 32 + fq * 8);
                    o[nt] = __builtin_amdgcn_mfma_f32_16x16x32_bf16(a, bb, o[nt], 0, 0, 0);
                }
            }
        }
        const size_t rbase = (isctx ? (size_t)TL + b * CTXL : (size_t)b * SEQ) + q0 + wv * 16 + fq * 4;
#pragma unroll
        for (int j = 0; j < 4; ++j) {
            const float inv = 1.0f / lsum[j];
#pragma unroll
            for (int nt = 0; nt < 4; ++nt) p.Yatt[(rbase + j) * 512 + h * 64 + nt * 16 + fr] = f2bf(o[nt][j] * inv);
        }
    }
}

template <int L>
__device__ __forceinline__ void ph_hyena(const P& p, int l, char* smem) {
    constexpr int NOUT = (L >= NT) ? L / NT : 1;
    float* kern0 = (float*)smem;
    float* kern1 = kern0 + 2 * L;
    float* zb = kern1 + 2 * L;
    const int tid = tid_opaque();
    const bool active = tid < L;
    const int tb = active ? tid : 0;
    const bf16_t* PTb = (L == SEQ) ? p.PT : p.PTc;
    const float* HT = (L == SEQ) ? p.HT0 + (size_t)l * 2048 * SEQ : p.HT1 + (size_t)l * 2048 * CTXL;
    const float* SCL = ((L == SEQ) ? p.SCL0 : p.SCL1) + l * 2048;
    for (int u = blockIdx.x; u < NB * HYW; u += gridDim.x) {
        const int b = u / HYW, c = u % HYW;
        __syncthreads();
        for (int i = tid; i < 2 * L; i += NT) {
            const int d = i - L;
            float k0, k1;
            if (d >= 0) { k0 = HT[(size_t)(0 * 1024 + c) * L + d] * SCL[c]; k1 = HT[(size_t)(1 * 1024 + c) * L + d] * SCL[1024 + c]; }
            else if (d > -L) { k0 = HT[(size_t)(0 * 1024 + 512 + c) * L + (size_t)(-d)] * SCL[512 + c]; k1 = HT[(size_t)(1 * 1024 + 512 + c) * L + (size_t)(-d)] * SCL[1536 + c]; }
            else { k0 = 0.f; k1 = 0.f; }
            kern0[i] = k0; kern1[i] = k1;
        }
        float uv[3][NOUT];
#pragma unroll
        for (int w = 0; w < 3; ++w) {
            const int col = w * HYW + c;
            const bf16_t* pr = PTb + ((size_t)b * HYC + col) * L;
            const float w0 = p.sc_w[(size_t)(l * 3 + 0) * HYC + col], w1 = p.sc_w[(size_t)(l * 3 + 1) * HYC + col], w2 = p.sc_w[(size_t)(l * 3 + 2) * HYC + col], bb = p.sc_b[l * HYC + col];
#pragma unroll
            for (int i = 0; i < NOUT; ++i) {
                const int t = tb + i * NT;
                const float pm1 = t > 0 ? bf2f(pr[t - 1]) : 0.f, p0 = bf2f(pr[t]), pp1 = t < L - 1 ? bf2f(pr[t + 1]) : 0.f;
                uv[w][i] = bb + w0 * pm1 + w1 * p0 + w2 * pp1;
            }
        }
        if (active) {
#pragma unroll
            for (int i = 0; i < NOUT; ++i) zb[tb + i * NT] = uv[0][i];
        }
        __syncthreads();
        float acc[NOUT];
#pragma unroll
        for (int i = 0; i < NOUT; ++i) acc[i] = 0.f;
        for (int s = 0; s < L; ++s) {
            const float zs = zb[s];
#pragma unroll
            for (int i = 0; i < NOUT; ++i) acc[i] += zs * kern0[tb + i * NT - s + L];
        }
        const float bias0 = p.flt_bias[(l * 2 + 0) * HYW + c], bias1 = p.flt_bias[(l * 2 + 1) * HYW + c];
        float z1[NOUT];
#pragma unroll
        for (int i = 0; i < NOUT; ++i) z1[i] = uv[1][i] * (acc[i] + bias0 * uv[0][i]);
        __syncthreads();
        if (active) {
#pragma unroll
            for (int i = 0; i < NOUT; ++i) zb[tb + i * NT] = z1[i];
        }
        __syncthreads();
#pragma unroll
        for (int i = 0; i < NOUT; ++i) acc[i] = 0.f;
        for (int s = 0; s < L; ++s) {
            const float zs = zb[s];
#pragma unroll
            for (int i = 0; i < NOUT; ++i) acc[i] += zs * kern1[tb + i * NT - s + L];
        }
        if (active) {
            const size_t rbase = (L == SEQ) ? (size_t)b * SEQ : (size_t)TL + b * CTXL;
#pragma unroll
            for (int i = 0; i < NOUT; ++i) p.Yhy[(rbase + tb + i * NT) * HYW + c] = f2bf(uv[2][i] * (acc[i] + bias1 * z1[i]));
        }
    }
}

__device__ __forceinline__ void ph_combine(const P& p, int l, const int* offs) {
    const int tid = tid_opaque(), lane = tid & 63, wv = tid >> 6;
    for (int rb = blockIdx.x * 8; rb < TT; rb += gridDim.x * 8) {
        const int row = rb + wv;
        const int b = row < TL ? (row >> 12) : 4;
        const int4 a = *(const int4*)(p.asg + (size_t)row * 4);
        const size_t s0 = (size_t)offs[a.x] + a.y, s1 = (size_t)offs[a.z] + a.w;
        const float* g2 = p.mod + ((size_t)l * 5 + b) * NMOD + 5 * DM;
#pragma unroll
        for (int i = 0; i < 4; ++i) {
            const int j = i * 256 + lane * 4;
            float4 hv = *(float4*)(p.hx + (size_t)row * DM + j);
            const u32x2 y0 = *(const u32x2*)(p.Y + s0 * DM + j), y1 = *(const u32x2*)(p.Y + s1 * DM + j);
            const float4 g = *(const float4*)(g2 + j);
            hv.x += g.x * (__uint_as_float(y0.x << 16) + __uint_as_float(y1.x << 16));
            hv.y += g.y * (__uint_as_float(y0.x & 0xFFFF0000u) + __uint_as_float(y1.x & 0xFFFF0000u));
            hv.z += g.z * (__uint_as_float(y0.y << 16) + __uint_as_float(y1.y << 16));
            hv.w += g.w * (__uint_as_float(y0.y & 0xFFFF0000u) + __uint_as_float(y1.y & 0xFFFF0000u));
            *(float4*)(p.hx + (size_t)row * DM + j) = hv;
        }
    }
}
__device__ __forceinline__ void ph_final(const P& p) {
    const int tid = tid_opaque(), lane = tid & 63, wv = tid >> 6;
    for (int rb = blockIdx.x * 8; rb < TL; rb += gridDim.x * 8) {
        const int row = rb + wv;
        const float* hp = p.hx + (size_t)row * DM;
        float4 xv[4]; float ss = 0.f;
#pragma unroll
        for (int i = 0; i < 4; ++i) { xv[i] = *(const float4*)(hp + i * 256 + lane * 4); ss += xv[i].x * xv[i].x + xv[i].y * xv[i].y + xv[i].z * xv[i].z + xv[i].w * xv[i].w; }
        ss = wave_sum(ss);
        const float rs = rsqrtf(ss * (1.0f / DM) + EPSF);
#pragma unroll
        for (int i = 0; i < 4; ++i) {
            const int j = i * 256 + lane * 4;
            const float4 g = *(const float4*)(p.final_g + j);
            float4 y; y.x = xv[i].x * rs * g.x; y.y = xv[i].y * rs * g.y; y.z = xv[i].z * rs * g.z; y.w = xv[i].w * rs * g.w;
            *(float4*)(p.out + (size_t)row * DM + j) = y;
        }
    }
}

namespace ge {
constexpr int BM = 256, BK = 64, HALF = 128, HTB = HALF * BK * 2, STAGE_BYTES = 8 * HTB, NXCD = 8, WGM = 8;
__device__ __forceinline__ int lds_byte(int r, int c) { const int st = (r >> 4) * 2 + (c >> 5), rr = r & 15, cc = c & 31, ob = rr * 64 + cc * 2; return st * 1024 + (ob ^ (((ob >> 9) & 1) << 5)); }
__device__ __forceinline__ void stage_rc(int b, int& R, int& C) { const int st = b / 1024, sb = b % 1024, swz = sb ^ (((sb >> 9) & 1) << 5); R = (st >> 1) * 16 + swz / 64; C = (st & 1) * 32 + (swz % 64) / 2; }
__device__ __forceinline__ int perm32(int rho) { const int n = rho >> 4, i = rho & 15; return 8 * (i >> 2) + 4 * n + (i & 3); }
__device__ __forceinline__ void tile_order(int L, int nM, int nN, int& pm, int& pn) {
    const int nwg = nM * nN; int wgid = L;
    { const int q = nwg / NXCD, r = nwg % NXCD, xcd = wgid % NXCD, off = wgid / NXCD; wgid = (xcd < r ? xcd * (q + 1) : r * (q + 1) + (xcd - r) * q) + off; }
    const int nig = WGM * nN, gid = wgid / nig, fm = gid * WGM, gsz = (nM - fm) < WGM ? (nM - fm) : WGM;
    pm = fm + ((wgid % nig) % gsz); pn = (wgid % nig) / gsz;
}
struct Unit { const char* a; const char* b0; const char* b1; const int* rows; int nrows; int pm, pn, kind; };
typedef f32x4 Acc[2][2][4][2];

template <bool GATHER, class Sched, class Epi>
__device__ __forceinline__ void gemm_engine(LAS unsigned char* lds, const int lda, const int ldb, const int K, const Sched& S, const Epi& E) {
    const int tid = tid_opaque(), wid = __builtin_amdgcn_readfirstlane(tid >> 6), lane = tid & 63, wr = wid >> 2, wc = wid & 3, fr = lane & 15, fq = lane >> 4;
    const int nt = K / BK;
    int sR[2], sC[2];
    unsigned voffA[2], voffB[2];
#pragma unroll
    for (int i = 0; i < 2; ++i) { stage_rc(tid * 16 + i * 8192, sR[i], sC[i]); const int Rb = (sR[i] & ~31) + perm32(sR[i] & 31);
        voffA[i] = (unsigned)(sR[i] * lda + sC[i]) * 2u; voffB[i] = (unsigned)(Rb * ldb + sC[i]) * 2u; }
    const size_t kstep = (size_t)(BK * 2);
    const size_t hstepA = (size_t)HALF * lda * 2;
    const unsigned ldsw = (unsigned)wid * 1024u;
    const int aoff = lds_byte(wr * 64 + fr, fq * 8), boff = lds_byte(wc * 32 + fr, fq * 8);
    unsigned gvc[2][2], gvn[2][2];
#define GE_SA(b, h) (((b) * 2 + (h)) * HTB)
#define GE_SB(b, h) ((4 + (b) * 2 + (h)) * HTB)
#define GE_GLDS(src, bufoff, i) __builtin_amdgcn_global_load_lds((const unsigned*)(src), (LAS unsigned*)(lds + (bufoff) + ldsw + (i) * 8192), 16, 0, 0)
#define GE_STAGE_B(bufoff, bp) do { _Pragma("unroll") for (int _i = 0; _i < 2; ++_i) GE_GLDS((bp) + voffB[_i], bufoff, _i); } while (0)
#define GE_STAGE_A(bufoff, ap, h, gv) do { _Pragma("unroll") for (int _i = 0; _i < 2; ++_i) { \
        if constexpr (GATHER) GE_GLDS((ap) + (gv)[h][_i], bufoff, _i); else GE_GLDS((ap) + (size_t)(h) * hstepA + voffA[_i], bufoff, _i); } } while (0)
#define GE_LDA(dst, b, h) do { _Pragma("unroll") for (int m = 0; m < 4; ++m) _Pragma("unroll") for (int k = 0; k < 2; ++k) dst[m][k] = *(const LAS bf16x8*)(lds + GE_SA(b, h) + aoff + m * 2048 + k * 1024); } while (0)
#define GE_LDB(dst, b, h) do { _Pragma("unroll") for (int n = 0; n < 2; ++n) _Pragma("unroll") for (int k = 0; k < 2; ++k) dst[n][k] = *(const LAS bf16x8*)(lds + GE_SB(b, h) + boff + n * 2048 + k * 1024); } while (0)
#define GE_MMA(ai, bj, At, Bt) do { __builtin_amdgcn_s_setprio(1); _Pragma("unroll") for (int m = 0; m < 4; ++m) _Pragma("unroll") for (int n = 0; n < 2; ++n) _Pragma("unroll") for (int k = 0; k < 2; ++k) \
        acc[ai][bj][m][n] = __builtin_amdgcn_mfma_f32_16x16x32_bf16(Bt[n][k], At[m][k], acc[ai][bj][m][n], 0, 0, 0); __builtin_amdgcn_s_setprio(0); } while (0)
#define GE_WAIT_V(n) asm volatile("s_waitcnt vmcnt(" #n ")" ::: "memory")
#define GE_WAIT_L(n) asm volatile("s_waitcnt lgkmcnt(" #n ")" ::: "memory")
#define GE_BAR __builtin_amdgcn_s_barrier()
#define GE_SCHED __builtin_amdgcn_sched_barrier(0)
#define GE_GATHER_OFFS(gv, u) do { if constexpr (GATHER) { _Pragma("unroll") for (int _h = 0; _h < 2; ++_h) _Pragma("unroll") for (int _i = 0; _i < 2; ++_i) { \
        int _r = (u).pm * BM + _h * HALF + sR[_i]; _r = _r < (u).nrows ? _r : (u).nrows - 1; (gv)[_h][_i] = (unsigned)((u).rows[_r] * lda + sC[_i]) * 2u; } } } while (0)
    Unit cur, nxt; int ui = 0;
    if (!S.next(0, cur)) return;
    Acc acc;
#pragma unroll
    for (int a = 0; a < 2; ++a)
#pragma unroll
        for (int b = 0; b < 2; ++b)
#pragma unroll
            for (int m = 0; m < 4; ++m)
#pragma unroll
                for (int n = 0; n < 2; ++n) acc[a][b][m][n] = (f32x4){0.f, 0.f, 0.f, 0.f};
    bf16x8 At[4][2], B0[2][2], B1[2][2];
    GE_GATHER_OFFS(gvc, cur);
    GE_STAGE_B(GE_SB(0, 0), cur.b0); GE_STAGE_A(GE_SA(0, 0), cur.a, 0, gvc); GE_STAGE_B(GE_SB(0, 1), cur.b1); GE_STAGE_A(GE_SA(0, 1), cur.a, 1, gvc);
    if (wr == 1) GE_BAR;
    GE_WAIT_V(4); GE_BAR;
    GE_STAGE_B(GE_SB(1, 0), cur.b0 + kstep); GE_STAGE_A(GE_SA(1, 0), cur.a + kstep, 0, gvc); GE_STAGE_B(GE_SB(1, 1), cur.b1 + kstep);
    GE_WAIT_V(6); GE_BAR;
    for (;;) {
        const bool has_next = S.next(ui + 1, nxt);
        if (!has_next) nxt = cur;
        if constexpr (GATHER) { if (has_next) { GE_GATHER_OFFS(gvn, nxt); } else {
#pragma unroll
            for (int h = 0; h < 2; ++h)
#pragma unroll
                for (int i = 0; i < 2; ++i) gvn[h][i] = gvc[h][i]; } }
#pragma unroll 1
        for (int t = 0; t < nt; t += 2) {
            const bool last = (t == nt - 2);
            const char* a1 = cur.a + (size_t)(t + 1) * kstep;
            const char* a2 = last ? nxt.a : cur.a + (size_t)(t + 2) * kstep;
            const char* b20 = last ? nxt.b0 : cur.b0 + (size_t)(t + 2) * kstep;
            const char* b21 = last ? nxt.b1 : cur.b1 + (size_t)(t + 2) * kstep;
            const char* a3 = a2 + kstep; const char* b30 = b20 + kstep; const char* b31 = b21 + kstep;
            unsigned gv2[2][2];
            if constexpr (GATHER) {
#pragma unroll
                for (int h = 0; h < 2; ++h)
#pragma unroll
                    for (int i = 0; i < 2; ++i) gv2[h][i] = last ? gvn[h][i] : gvc[h][i]; }
            GE_LDB(B0, 0, 0); GE_SCHED; GE_LDA(At, 0, 0); GE_STAGE_A(GE_SA(1, 1), a1, 1, gvc);
            GE_WAIT_L(8); GE_BAR; GE_WAIT_L(0); GE_MMA(0, 0, At, B0); GE_BAR; GE_SCHED;
            GE_LDB(B1, 0, 1); GE_STAGE_B(GE_SB(0, 0), b20);
            GE_BAR; GE_WAIT_L(0); GE_MMA(0, 1, At, B1); GE_BAR;
            GE_LDA(At, 0, 1); GE_STAGE_A(GE_SA(0, 0), a2, 0, gv2);
            GE_BAR; GE_WAIT_L(0); GE_MMA(1, 0, At, B0); GE_BAR; GE_SCHED;
            GE_STAGE_B(GE_SB(0, 1), b21);
            GE_WAIT_V(6); GE_BAR; GE_MMA(1, 1, At, B1); GE_BAR;
            GE_LDB(B0, 1, 0); GE_SCHED; GE_LDA(At, 1, 0); GE_STAGE_A(GE_SA(0, 1), a2, 1, gv2);
            GE_WAIT_L(8); GE_BAR; GE_WAIT_L(0); GE_MMA(0, 0, At, B0); GE_BAR; GE_SCHED;
            GE_LDB(B1, 1, 1); GE_STAGE_B(GE_SB(1, 0), b30);
            GE_BAR; GE_WAIT_L(0); GE_MMA(0, 1, At, B1); GE_BAR;
            GE_LDA(At, 1, 1); GE_STAGE_A(GE_SA(1, 0), a3, 0, gv2);
            GE_BAR; GE_WAIT_L(0); GE_MMA(1, 0, At, B0); GE_BAR; GE_SCHED;
            GE_STAGE_B(GE_SB(1, 1), b31);
            GE_WAIT_V(6); GE_BAR; GE_MMA(1, 1, At, B1); GE_BAR;
        }
        E(acc, cur, wr, wc, fr, fq);
        if (!has_next) break;
#pragma unroll
        for (int a = 0; a < 2; ++a)
#pragma unroll
            for (int b = 0; b < 2; ++b)
#pragma unroll
                for (int m = 0; m < 4; ++m)
#pragma unroll
                    for (int n = 0; n < 2; ++n) acc[a][b][m][n] = (f32x4){0.f, 0.f, 0.f, 0.f};
        cur = nxt; ++ui;
        if constexpr (GATHER) {
#pragma unroll
            for (int h = 0; h < 2; ++h)
#pragma unroll
                for (int i = 0; i < 2; ++i) gvc[h][i] = gvn[h][i]; }
    }
    GE_WAIT_V(0);
    if (wr == 0) GE_BAR;
    GE_BAR;
#undef GE_SA
#undef GE_SB
#undef GE_GLDS
#undef GE_STAGE_A
#undef GE_STAGE_B
#undef GE_LDA
#undef GE_LDB
#undef GE_MMA
#undef GE_WAIT_V
#undef GE_WAIT_L
#undef GE_BAR
#undef GE_SCHED
#undef GE_GATHER_OFFS
}
}
__device__ __forceinline__ unsigned cvt_pk_bf16(float lo, float hi) { unsigned r; asm volatile("v_cvt_pk_bf16_f32 %0, %1, %2" : "=v"(r) : "v"(lo), "v"(hi)); return r; }
__device__ __forceinline__ u32x4 pack8(const f32x4 a, const f32x4 b) { u32x4 w; w.x = cvt_pk_bf16(a[0], a[1]); w.y = cvt_pk_bf16(a[2], a[3]); w.z = cvt_pk_bf16(b[0], b[1]); w.w = cvt_pk_bf16(b[2], b[3]); return w; }
__device__ __forceinline__ void unpack8(const u32x4 w, f32x4& a, f32x4& b) {
    a[0] = __uint_as_float(w.x << 16); a[1] = __uint_as_float(w.x & 0xFFFF0000u); a[2] = __uint_as_float(w.y << 16); a[3] = __uint_as_float(w.y & 0xFFFF0000u);
    b[0] = __uint_as_float(w.z << 16); b[1] = __uint_as_float(w.z & 0xFFFF0000u); b[2] = __uint_as_float(w.w << 16); b[3] = __uint_as_float(w.w & 0xFFFF0000u); }
__device__ __forceinline__ float sigmoidf_fast(float v) { return 1.0f / (1.0f + __expf(-v)); }

struct SchedDense {
    const char* A; const char* B; size_t arb, brb; int nM, nN, G, c;
    __device__ __forceinline__ bool next(int i, ge::Unit& u) const {
        const int L = i * G + c; if (L >= nM * nN) return false;
        int pm, pn; ge::tile_order(L, nM, nN, pm, pn);
        u.pm = pm; u.pn = pn; u.kind = 0; u.rows = nullptr; u.nrows = 0;
        u.a = A + (size_t)pm * 256 * arb; u.b0 = B + (size_t)pn * 256 * brb; u.b1 = u.b0 + 128 * brb; return true;
    }
};
struct SchedInproj {
    const char* WtHy; const char* WtRest; const char* U; int G, c;
    __device__ __forceinline__ bool next(int i, ge::Unit& u) const {
        const int L = i * G + c; if (L >= 408 + 748) return false;
        int pm, pn; u.rows = nullptr; u.nrows = 0;
        if (L < 408) { ge::tile_order(L, 6, 68, pm, pn); u.kind = 0; u.a = WtHy + (size_t)pm * 256 * 2048; u.b0 = U + (size_t)pn * 256 * 2048; }
        else { ge::tile_order(L - 408, 68, 11, pm, pn); u.kind = 1; u.a = U + (size_t)pm * 256 * 2048; u.b0 = WtRest + (size_t)pn * 256 * 2048; }
        u.b1 = u.b0 + 128 * 2048; u.pm = pm; u.pn = pn; return true;
    }
};
struct EpiInproj {
    bf16_t* PT; bf16_t* PTc; float* PMLA; bf16_t* G;
    __device__ __forceinline__ void operator()(const ge::Acc& acc, const ge::Unit& u, int wr, int wc, int fr, int fq) const {
#pragma unroll
        for (int ai = 0; ai < 2; ++ai)
#pragma unroll
            for (int m = 0; m < 4; ++m) {
                const int r = u.pm * 256 + ai * 128 + wr * 64 + m * 16 + fr;
#pragma unroll
                for (int bj = 0; bj < 2; ++bj) {
                    const int c0 = bj * 128 + wc * 32 + fq * 8;
                    if (u.kind == 0) {
                        bf16_t* dst = (u.pn < 64) ? PT + ((size_t)((u.pn >> 4) * HYC + r)) * SEQ + (u.pn & 15) * 256 + c0
                                                  : PTc + ((size_t)((u.pn - 64) * HYC + r)) * CTXL + c0;
                        *(u32x4*)dst = pack8(acc[ai][bj][m][0], acc[ai][bj][m][1]);
                    } else if (u.pn < 3) {
                        const int c = u.pn * 256 + c0;
                        if (c < MLAW) { float* dst = PMLA + (size_t)r * MLAW + c; *(f32x4*)dst = acc[ai][bj][m][0]; *(f32x4*)(dst + 4) = acc[ai][bj][m][1]; }
                    } else {
                        const int c = (u.pn - 3) * 256 + c0;
                        f32x4 a = acc[ai][bj][m][0], b = acc[ai][bj][m][1];
#pragma unroll
                        for (int j = 0; j < 4; ++j) { a[j] = sigmoidf_fast(a[j]); b[j] = sigmoidf_fast(b[j]); }
                        *(u32x4*)(G + (size_t)r * 2048 + c) = pack8(a, b);
                    }
                }
            }
    }
};
struct EpiQ {
    bf16_t* Q; bf16_t* Qc; const float2* rope;
    __device__ __forceinline__ void operator()(const ge::Acc& acc, const ge::Unit& u, int wr, int wc, int fr, int fq) const {
#pragma unroll
        for (int ai = 0; ai < 2; ++ai)
#pragma unroll
            for (int m = 0; m < 4; ++m) {
                const int r = u.pm * 256 + ai * 128 + wr * 64 + m * 16 + fr;
                const bool lat = r < TL;
                const int t = lat ? (r & 4095) : ((r - TL) & 255);
                const int b = lat ? (r >> 12) : ((r - TL) >> 8);
#pragma unroll
                for (int bj = 0; bj < 2; ++bj) {
                    const int c = u.pn * 256 + bj * 128 + wc * 32 + fq * 8;
                    const int h = c / 96, dd = c - h * 96;
                    f32x4 v0 = acc[ai][bj][m][0] * QSCALE, v1 = acc[ai][bj][m][1] * QSCALE;
                    f32x4 p0, p1;
#pragma unroll
                    for (int j = 0; j < 4; ++j) { p0[j] = __shfl_xor(v0[j], 16); p1[j] = __shfl_xor(v1[j], 16); }
                    bf16_t* qrow = lat ? Q + ((size_t)(b * NH + h) * SEQ + t) * 128 : Qc + ((size_t)(b * NH + h) * CTXL + t) * 128;
                    if (dd < 64) *(u32x4*)(qrow + dd) = pack8(v0, v1);
                    else {
                        const int d0 = dd - 64;
                        f32x4 o0 = v0, o1 = v1;
                        if (lat) {
                            const float2* rp = rope + (size_t)t * 16 + (d0 >> 4) * 8;
                            const bool s1 = (d0 >> 3) & 1;
#pragma unroll
                            for (int j = 0; j < 4; ++j) {
                                const float2 ca = rp[j], cb = rp[4 + j];
                                o0[j] = s1 ? p0[j] * ca.y + v0[j] * ca.x : v0[j] * ca.x - p0[j] * ca.y;
                                o1[j] = s1 ? p1[j] * cb.y + v1[j] * cb.x : v1[j] * cb.x - p1[j] * cb.y;
                            }
                        }
                        *(u32x4*)(qrow + 64 + d0) = pack8(o0, o1);
                        *(u32x4*)(qrow + 96 + d0) = pack8(v0, v1);
                    }
                }
            }
    }
};
struct EpiKV {
    bf16_t* K; bf16_t* V;
    __device__ __forceinline__ void operator()(const ge::Acc& acc, const ge::Unit& u, int wr, int wc, int fr, int fq) const {
#pragma unroll
        for (int ai = 0; ai < 2; ++ai)
#pragma unroll
            for (int m = 0; m < 4; ++m) {
                const int r = u.pm * 256 + ai * 128 + wr * 64 + m * 16 + fr;
                int b, key;
                if (r < TL) { b = r >> 12; key = r & 4095; } else { b = (r - TL) >> 8; key = SEQ + ((r - TL) & 255); }
#pragma unroll
                for (int bj = 0; bj < 2; ++bj) {
                    const int c = u.pn * 256 + bj * 128 + wc * 32 + fq * 8;
                    const int h = c >> 7, d = c & 127;
                    const size_t kb = (size_t)(b * NH + h) * NKEY + key;
                    bf16_t* dst = (d < 64) ? K + kb * DQK + d : V + kb * DV + (d - 64);
                    *(u32x4*)dst = pack8(acc[ai][bj][m][0], acc[ai][bj][m][1]);
                }
            }
    }
};
struct SchedMerge {
    const char* Yhy; const char* Yatt; const char* Whyo; const char* Wmlao; int G, c;
    __device__ __forceinline__ bool next(int i, ge::Unit& u) const {
        const int T = (i >> 1) * G + c; if (T >= 272) return false;
        const int seg = i & 1; int pm, pn; ge::tile_order(T, 68, 4, pm, pn);
        u.pm = pm; u.pn = pn; u.kind = seg; u.rows = nullptr; u.nrows = 0;
        u.a = (seg ? Yatt : Yhy) + (size_t)pm * 256 * 1024; u.b0 = (seg ? Wmlao : Whyo) + (size_t)pn * 256 * 1024; u.b1 = u.b0 + 128 * 1024; return true;
    }
};
struct EpiMerge {
    const bf16_t* G; bf16_t* M1;
    __device__ __forceinline__ void operator()(const ge::Acc& acc, const ge::Unit& u, int wr, int wc, int fr, int fq) const {
#pragma unroll
        for (int ai = 0; ai < 2; ++ai)
#pragma unroll
            for (int m = 0; m < 4; ++m) {
                const int r = u.pm * 256 + ai * 128 + wr * 64 + m * 16 + fr;
#pragma unroll
                for (int bj = 0; bj < 2; ++bj) {
                    const int c = u.pn * 256 + bj * 128 + wc * 32 + fq * 8;
                    f32x4 g0, g1; unpack8(*(const u32x4*)(G + (size_t)r * 2048 + u.kind * DM + c), g0, g1);
                    f32x4 o0 = g0 * acc[ai][bj][m][0], o1 = g1 * acc[ai][bj][m][1];
                    bf16_t* dst = M1 + (size_t)r * DM + c;
                    if (u.kind) { f32x4 q0, q1; unpack8(*(const u32x4*)dst, q0, q1); o0 += q0; o1 += q1; }
                    *(u32x4*)dst = pack8(o0, o1);
                }
            }
    }
};
struct EpiOut {
    float* hx; const float* mod;
    __device__ __forceinline__ void operator()(const ge::Acc& acc, const ge::Unit& u, int wr, int wc, int fr, int fq) const {
#pragma unroll
        for (int ai = 0; ai < 2; ++ai)
#pragma unroll
            for (int m = 0; m < 4; ++m) {
                const int r = u.pm * 256 + ai * 128 + wr * 64 + m * 16 + fr;
                const int b = r < TL ? (r >> 12) : 4;
#pragma unroll
                for (int bj = 0; bj < 2; ++bj) {
                    const int c = u.pn * 256 + bj * 128 + wc * 32 + fq * 8;
                    const float* g = mod + (size_t)b * NMOD + 2 * DM + c;
                    float* dst = hx + (size_t)r * DM + c;
                    *(f32x4*)dst = *(const f32x4*)dst + *(const f32x4*)g * acc[ai][bj][m][0];
                    *(f32x4*)(dst + 4) = *(const f32x4*)(dst + 4) + *(const f32x4*)(g + 4) * acc[ai][bj][m][1];
                }
            }
    }
};
struct SchedGU {
    const char* U; const char* WtG; const char* WtU; const int* list; const LAS int* tpre; const LAS int* cntl; int G, c;
    __device__ __forceinline__ bool next(int i, ge::Unit& u) const {
        const int L = i * G + c; if (L >= 2 * tpre[64]) return false;
        const int rt = L >> 1, half = L & 1; int e = 0; while (tpre[e + 1] <= rt) ++e;
        u.kind = e; u.pm = rt - tpre[e]; u.pn = half; u.rows = list + (size_t)e * CAP; u.nrows = cntl[e];
        u.a = U; u.b0 = WtG + ((size_t)e * DE + half * 128) * 2048; u.b1 = WtU + ((size_t)e * DE + half * 128) * 2048; return true;
    }
};
struct EpiGU {
    bf16_t* H; const LAS int* offs;
    __device__ __forceinline__ void operator()(const ge::Acc& acc, const ge::Unit& u, int wr, int wc, int fr, int fq) const {
        const int o = offs[u.kind];
#pragma unroll
        for (int ai = 0; ai < 2; ++ai)
#pragma unroll
            for (int m = 0; m < 4; ++m) {
                const int r = u.pm * 256 + ai * 128 + wr * 64 + m * 16 + fr;
                if (r < u.nrows) {
                    const int c = u.pn * 128 + wc * 32 + fq * 8;
                    f32x4 g0 = acc[ai][0][m][0], g1 = acc[ai][0][m][1];
#pragma unroll
                    for (int j = 0; j < 4; ++j) { g0[j] = g0[j] * sigmoidf_fast(g0[j]) * acc[ai][1][m][0][j]; g1[j] = g1[j] * sigmoidf_fast(g1[j]) * acc[ai][1][m][1][j]; }
                    *(u32x4*)(H + (size_t)(o + r) * DE + c) = pack8(g0, g1);
                }
            }
    }
};
struct SchedDown {
    const char* H; const char* WtD; const LAS int* tpre; const LAS int* cntl; const LAS int* offs; int G, c;
    __device__ __forceinline__ bool next(int i, ge::Unit& u) const {
        const int L = i * G + c; if (L >= 4 * tpre[64]) return false;
        const int rt = L >> 2, pn = L & 3; int e = 0; while (tpre[e + 1] <= rt) ++e;
        u.kind = e; u.pm = rt - tpre[e]; u.pn = pn; u.rows = nullptr; u.nrows = cntl[e];
        u.a = H + ((size_t)offs[e] + (size_t)u.pm * 256) * 512; u.b0 = WtD + ((size_t)e * DM + pn * 256) * 512; u.b1 = u.b0 + 128 * 512; return true;
    }
};
struct EpiDown {
    bf16_t* Y; const float* wl; const LAS int* offs;
    __device__ __forceinline__ void operator()(const ge::Acc& acc, const ge::Unit& u, int wr, int wc, int fr, int fq) const {
        const int o = offs[u.kind];
#pragma unroll
        for (int ai = 0; ai < 2; ++ai)
#pragma unroll
            for (int m = 0; m < 4; ++m) {
                const int r = u.pm * 256 + ai * 128 + wr * 64 + m * 16 + fr;
                if (r < u.nrows) {
                    const float w = wl[(size_t)u.kind * CAP + r];
#pragma unroll
                    for (int bj = 0; bj < 2; ++bj) {
                        const int c = u.pn * 256 + bj * 128 + wc * 32 + fq * 8;
                        *(u32x4*)(Y + (size_t)(o + r) * DM + c) = pack8(acc[ai][bj][m][0] * w, acc[ai][bj][m][1] * w);
                    }
                }
            }
    }
};


typedef short s16x4 __attribute__((ext_vector_type(4)));
__device__ __forceinline__ void ph_attn2(const P& p, char* smem) {
    constexpr int KS = 112, VS = 80;
    bf16_t* sK = (bf16_t*)smem;
    bf16_t* sV = sK + 2 * 64 * KS;
    const int tid = tid_opaque(), lane = tid & 63, wv = tid >> 6, fr = lane & 15, g = lane >> 4;
    const int NUL = NB * NH * 16, NUC = NB * NH;
    const int kc0 = tid / 12, kp0 = tid % 12, kc1 = (512 + tid) / 12, kp1 = (512 + tid) % 12;
    const int vk = tid >> 3, vp = tid & 7;
    for (int u = blockIdx.x; u < NUL + NUC; u += gridDim.x) {
        const bool isctx = u >= NUL;
        int b, h, q0;
        if (!isctx) { b = u / (NH * 16); h = (u / 16) % NH; q0 = (u % 16) * 256; } else { const int v = u - NUL; b = v / NH; h = v % NH; q0 = 0; }
        const bf16_t* Qp = (isctx ? p.Qc + ((size_t)(b * NH + h) * CTXL + q0) * 128 : p.Q + ((size_t)(b * NH + h) * SEQ + q0) * 128) + (size_t)(wv * 32) * 128;
        bf16x8 qf[2][4];
#pragma unroll
        for (int nq = 0; nq < 2; ++nq)
#pragma unroll
            for (int ks = 0; ks < 4; ++ks) qf[nq][ks] = *(const bf16x8*)(Qp + (size_t)(nq * 16 + fr) * 128 + ks * 32 + g * 8);
        const bf16_t* Kp = p.K + (size_t)(b * NH + h) * NKEY * DQK;
        const bf16_t* Vp = p.V + (size_t)(b * NH + h) * NKEY * DV;
        f32x4 oT[4][2]; float m[2], lsum[2];
#pragma unroll
        for (int nq = 0; nq < 2; ++nq) { m[nq] = -INFINITY; lsum[nq] = 0.f;
#pragma unroll
            for (int md = 0; md < 4; ++md) oT[md][nq] = (f32x4){0.f, 0.f, 0.f, 0.f}; }
        const int kt0 = isctx ? 64 : 0, ntiles = 68 - kt0;
        u32x4 kr0, kr1 = (u32x4){0u, 0u, 0u, 0u}, vr0;
        {
            const bf16_t* kb = Kp + (size_t)(kt0 * 64) * DQK; const bf16_t* vb = Vp + (size_t)(kt0 * 64) * DV;
            kr0 = *(const u32x4*)(kb + kc0 * DQK + kp0 * 8); if (tid < 256) kr1 = *(const u32x4*)(kb + kc1 * DQK + kp1 * 8);
            vr0 = *(const u32x4*)(vb + vk * DV + vp * 8);
            __syncthreads();
            *(u32x4*)(sK + kc0 * KS + kp0 * 8) = kr0; if (tid < 256) *(u32x4*)(sK + kc1 * KS + kp1 * 8) = kr1;
            *(u32x4*)(sV + vk * VS + vp * 8) = vr0;
            __syncthreads();
        }
        for (int it = 0; it < ntiles; ++it) {
            const int buf = it & 1, kt = kt0 + it;
            const bool more = it + 1 < ntiles;
            if (more) {
                const bf16_t* kb = Kp + (size_t)((kt + 1) * 64) * DQK; const bf16_t* vb = Vp + (size_t)((kt + 1) * 64) * DV;
                kr0 = *(const u32x4*)(kb + kc0 * DQK + kp0 * 8); if (tid < 256) kr1 = *(const u32x4*)(kb + kc1 * DQK + kp1 * 8);
                vr0 = *(const u32x4*)(vb + vk * DV + vp * 8);
            }
            const bf16_t* sKb = sK + buf * 64 * KS; const bf16_t* sVb = sV + buf * 64 * VS;
            f32x4 sT[4][2];
#pragma unroll
            for (int mk = 0; mk < 4; ++mk) {
                sT[mk][0] = (f32x4){0.f, 0.f, 0.f, 0.f}; sT[mk][1] = (f32x4){0.f, 0.f, 0.f, 0.f};
#pragma unroll
                for (int ks = 0; ks < 3; ++ks) {
                    const bf16x8 a = *(const bf16x8*)(sKb + (mk * 16 + fr) * KS + ks * 32 + g * 8);
#pragma unroll
                    for (int nq = 0; nq < 2; ++nq) {
                        const bf16x8 bq = (ks < 2) ? qf[nq][ks] : (kt >= 64 ? qf[nq][3] : qf[nq][2]);
                        sT[mk][nq] = __builtin_amdgcn_mfma_f32_16x16x32_bf16(a, bq, sT[mk][nq], 0, 0, 0);
                    }
                }
            }
            bf16x8 pf[2][2];
#pragma unroll
            for (int nq = 0; nq < 2; ++nq) {
                float mx = sT[0][nq][0];
#pragma unroll
                for (int mk = 0; mk < 4; ++mk)
#pragma unroll
                    for (int r = 0; r < 4; ++r) mx = fmaxf(mx, sT[mk][nq][r]);
                mx = fmaxf(mx, __shfl_xor(mx, 16)); mx = fmaxf(mx, __shfl_xor(mx, 32));
                const float mn = fmaxf(m[nq], mx);
                const float alpha = __builtin_amdgcn_exp2f(m[nq] - mn);
                m[nq] = mn;
                float rs = 0.f;
#pragma unroll
                for (int mk = 0; mk < 4; ++mk)
#pragma unroll
                    for (int r = 0; r < 4; ++r) { const float pv = __builtin_amdgcn_exp2f(sT[mk][nq][r] - mn); rs += pv; sT[mk][nq][r] = pv; }
                lsum[nq] = lsum[nq] * alpha + rs;
#pragma unroll
                for (int md = 0; md < 4; ++md) oT[md][nq] *= alpha;
#pragma unroll
                for (int kp = 0; kp < 2; ++kp) {
                    const u32x4 w = pack8(sT[2 * kp][nq], sT[2 * kp + 1][nq]);
                    pf[kp][nq] = __builtin_bit_cast(bf16x8, w);
                }
            }
#pragma unroll
            for (int kp = 0; kp < 2; ++kp)
#pragma unroll
                for (int md = 0; md < 4; ++md) {
                    const bf16_t* a0 = sVb + (32 * kp + 4 * g + (fr >> 2)) * VS + 16 * md + 4 * (fr & 3);
                    const s16x4 lo = __builtin_amdgcn_ds_read_tr16_b64_v4i16((LAS s16x4*)a0);
                    const s16x4 hi = __builtin_amdgcn_ds_read_tr16_b64_v4i16((LAS s16x4*)(a0 + 16 * VS));
                    const bf16x8 vf = __builtin_shufflevector(lo, hi, 0, 1, 2, 3, 4, 5, 6, 7);
#pragma unroll
                    for (int nq = 0; nq < 2; ++nq) oT[md][nq] = __builtin_amdgcn_mfma_f32_16x16x32_bf16(vf, pf[kp][nq], oT[md][nq], 0, 0, 0);
                }
            if (more) {
                bf16_t* dK = sK + (buf ^ 1) * 64 * KS; bf16_t* dV = sV + (buf ^ 1) * 64 * VS;
                *(u32x4*)(dK + kc0 * KS + kp0 * 8) = kr0; if (tid < 256) *(u32x4*)(dK + kc1 * KS + kp1 * 8) = kr1;
                *(u32x4*)(dV + vk * VS + vp * 8) = vr0;
            }
            __syncthreads();
        }
        const size_t rbase = (isctx ? (size_t)TL + b * CTXL : (size_t)b * SEQ) + q0 + wv * 32;
#pragma unroll
        for (int nq = 0; nq < 2; ++nq) {
            float l = lsum[nq]; l += __shfl_xor(l, 16); l += __shfl_xor(l, 32);
            const float inv = 1.0f / l;
#pragma unroll
            for (int md = 0; md < 4; ++md) {
                u32x2 o; o.x = cvt_pk_bf16(oT[md][nq][0] * inv, oT[md][nq][1] * inv); o.y = cvt_pk_bf16(oT[md][nq][2] * inv, oT[md][nq][3] * inv);
                *(u32x2*)(p.Yatt + (rbase + nq * 16 + fr) * 512 + h * 64 + md * 16 + 4 * g) = o;
            }
        }
    }
}


constexpr int RT_PITCH = 1024 + 8;
__device__ __forceinline__ void ph_norm2_router(const P& p, int l, char* smem) {
    bf16_t* thi = (bf16_t*)smem;
    bf16_t* tlo = thi + 16 * RT_PITCH;
    float* part = (float*)(tlo + 16 * RT_PITCH);
    float* lgs = part + 8 * 16 * 80;
    const int tid = tid_opaque(), lane = tid & 63, wv = tid >> 6, fr = lane & 15, g = lane >> 4;
    const float* ng = p.norm2_g + l * DM;
    const bf16_t* whi = p.WrT + (size_t)(l * 2 + 0) * 80 * DM; const bf16_t* wlo = p.WrT + (size_t)(l * 2 + 1) * 80 * DM;
    for (int rb = blockIdx.x * 16; rb < TT; rb += gridDim.x * 16) {
        __syncthreads();
#pragma unroll
        for (int rr = 0; rr < 2; ++rr) {
            const int lr = wv * 2 + rr, row = rb + lr;
            const int b = row < TL ? (row >> 12) : 4;
            const float* hp = p.hx + (size_t)row * DM;
            const float* md = p.mod + ((size_t)l * 5 + b) * NMOD + 3 * DM;
            float4 xv[4]; float ss = 0.f;
#pragma unroll
            for (int i = 0; i < 4; ++i) { xv[i] = *(const float4*)(hp + i * 256 + lane * 4); ss += xv[i].x * xv[i].x + xv[i].y * xv[i].y + xv[i].z * xv[i].z + xv[i].w * xv[i].w; }
            ss = wave_sum(ss);
            const float rs = rsqrtf(ss * (1.0f / DM) + EPSF);
#pragma unroll
            for (int i = 0; i < 4; ++i) {
                const int j = i * 256 + lane * 4;
                const float4 gg = *(const float4*)(ng + j), sh = *(const float4*)(md + j), sc = *(const float4*)(md + DM + j);
                float y[4];
                y[0] = (xv[i].x * rs * gg.x) * (1.f + sc.x) + sh.x; y[1] = (xv[i].y * rs * gg.y) * (1.f + sc.y) + sh.y;
                y[2] = (xv[i].z * rs * gg.z) * (1.f + sc.z) + sh.z; y[3] = (xv[i].w * rs * gg.w) * (1.f + sc.w) + sh.w;
                bf16_t h[4], lo[4];
#pragma unroll
                for (int e = 0; e < 4; ++e) { h[e] = f2bf(y[e]); lo[e] = f2bf(y[e] - bf2f(h[e])); }
                u32x2 oh; oh.x = (unsigned)h[0] | ((unsigned)h[1] << 16); oh.y = (unsigned)h[2] | ((unsigned)h[3] << 16);
                u32x2 ol; ol.x = (unsigned)lo[0] | ((unsigned)lo[1] << 16); ol.y = (unsigned)lo[2] | ((unsigned)lo[3] << 16);
                *(u32x2*)(p.U + (size_t)row * DM + j) = oh;
                *(u32x2*)(thi + lr * RT_PITCH + j) = oh; *(u32x2*)(tlo + lr * RT_PITCH + j) = ol;
            }
        }
        __syncthreads();
        f32x4 acc[5];
#pragma unroll
        for (int nt = 0; nt < 5; ++nt) acc[nt] = (f32x4){0.f, 0.f, 0.f, 0.f};
#pragma unroll
        for (int ks = 0; ks < 4; ++ks) {
            const int k0 = wv * 128 + ks * 32 + g * 8;
            const bf16x8 ah = *(const bf16x8*)(thi + fr * RT_PITCH + k0), al = *(const bf16x8*)(tlo + fr * RT_PITCH + k0);
#pragma unroll
            for (int nt = 0; nt < 5; ++nt) {
                const bf16x8 bh = *(const bf16x8*)(whi + (size_t)(nt * 16 + fr) * DM + k0), bl = *(const bf16x8*)(wlo + (size_t)(nt * 16 + fr) * DM + k0);
                acc[nt] = __builtin_amdgcn_mfma_f32_16x16x32_bf16(ah, bh, acc[nt], 0, 0, 0);
                acc[nt] = __builtin_amdgcn_mfma_f32_16x16x32_bf16(al, bh, acc[nt], 0, 0, 0);
                acc[nt] = __builtin_amdgcn_mfma_f32_16x16x32_bf16(ah, bl, acc[nt], 0, 0, 0);
            }
        }
#pragma unroll
        for (int nt = 0; nt < 5; ++nt)
#pragma unroll
            for (int r = 0; r < 4; ++r) part[(wv * 16 + g * 4 + r) * 80 + nt * 16 + fr] = acc[nt][r];
        __syncthreads();
        for (int i = tid; i < 16 * 80; i += NT) { float a = 0.f;
#pragma unroll
            for (int w = 0; w < 8; ++w) a += part[w * 16 * 80 + i];
            lgs[i] = a; }
        __syncthreads();
        if (tid < 16) {
            const int row = rb + tid;
            const float* le = lgs + tid * 80; const float* lg = le + 64;
            int gs = 0; float best = lg[0] + p.b_rg[l * 8], mx = lg[0];
            for (int i = 1; i < 8; ++i) { const float v = lg[i] + p.b_rg[l * 8 + i]; if (v > best) { best = v; gs = i; } mx = fmaxf(mx, lg[i]); }
            float den = 0.f;
            for (int i = 0; i < 8; ++i) den += expf(lg[i] - mx);
            const float pg = expf(lg[gs] - mx) / den;
            int i0 = 0; float k0 = le[gs * 8] + p.b_re[l * NE + gs * 8];
            for (int i = 1; i < 8; ++i) { const float v = le[gs * 8 + i] + p.b_re[l * NE + gs * 8 + i]; if (v > k0) { k0 = v; i0 = i; } }
            int i1 = -1; float k1 = 0.f;
            for (int i = 0; i < 8; ++i) { if (i == i0) continue; const float v = le[gs * 8 + i] + p.b_re[l * NE + gs * 8 + i]; if (i1 < 0 || v > k1) { k1 = v; i1 = i; } }
            const float w0 = 1.0f / (1.0f + expf(le[gs * 8 + i1] - le[gs * 8 + i0])), w1 = 1.0f - w0;
            const int e0 = gs * 8 + i0, e1 = gs * 8 + i1;
            const int r0 = atomicAdd(p.cnt + l * NE + e0, 1), r1 = atomicAdd(p.cnt + l * NE + e1, 1);
            p.list[(size_t)e0 * CAP + r0] = row; p.wl[(size_t)e0 * CAP + r0] = pg * w0;
            p.list[(size_t)e1 * CAP + r1] = row; p.wl[(size_t)e1 * CAP + r1] = pg * w1;
            *(int4*)(p.asg + (size_t)row * 4) = make_int4(e0, r0, e1, r1);
        }
    }
    __syncthreads();
}

#define HD __device__ __forceinline__
HD float2 cmul(float2 a, float2 b) { return make_float2(a.x * b.x - a.y * b.y, a.x * b.y + a.y * b.x); }
HD float2 cmulc(float2 a, float2 b) { return make_float2(a.x * b.x + a.y * b.y, a.y * b.x - a.x * b.y); }
HD float2 cadd(float2 a, float2 b) { return make_float2(a.x + b.x, a.y + b.y); }
HD float2 csub(float2 a, float2 b) { return make_float2(a.x - b.x, a.y - b.y); }
HD int fphys(int i) { return (i >> 8) * 272 + ((i >> 4) & 15) * 17 + (i & 15); }
constexpr int FBUF = 4352;
template <bool INV> HD void dft4(float2& x0, float2& x1, float2& x2, float2& x3) {
    const float2 s02 = cadd(x0, x2), d02 = csub(x0, x2), s13 = cadd(x1, x3), d13 = csub(x1, x3);
    const float2 jd = INV ? make_float2(-d13.y, d13.x) : make_float2(d13.y, -d13.x);
    x0 = cadd(s02, s13); x2 = csub(s02, s13); x1 = cadd(d02, jd); x3 = csub(d02, jd);
}
template <bool INV> HD void dft16(float2 (&v)[16]) {
#pragma unroll
    for (int b = 0; b < 4; ++b) dft4<INV>(v[b], v[4 + b], v[8 + b], v[12 + b]);
    const float C1 = 0.92387953251128674f, S1 = 0.38268343236508977f, C2 = 0.70710678118654752f;
#define TW(idx, cr, ci) v[idx] = INV ? cmulc(v[idx], make_float2(cr, ci)) : cmul(v[idx], make_float2(cr, ci))
    TW(4 * 1 + 1, C1, -S1);
    TW(4 * 1 + 2, C2, -C2);
    TW(4 * 1 + 3, S1, -C1);
    TW(4 * 2 + 1, C2, -C2);
    TW(4 * 2 + 2, 0.f, -1.f);
    TW(4 * 2 + 3, -C2, -C2);
    TW(4 * 3 + 1, S1, -C1);
    TW(4 * 3 + 2, -C2, -C2);
    TW(4 * 3 + 3, -C1, S1);
#undef TW
#pragma unroll
    for (int c = 0; c < 4; ++c) dft4<INV>(v[4 * c], v[4 * c + 1], v[4 * c + 2], v[4 * c + 3]);
#define SW(i, j) { const float2 t_ = v[i]; v[i] = v[j]; v[j] = t_; }
    SW(1, 4) SW(2, 8) SW(3, 12) SW(6, 9) SW(7, 13) SW(11, 14)
#undef SW
}
template <class BUF, class TW> HD void fwd_pass0(int u, float2 (&v)[16], BUF buf, TW W) {
    dft16<false>(v);
#pragma unroll
    for (int r = 0; r < 16; ++r) { if (r) v[r] = cmul(v[r], W[(u * r) & 4095]); buf[fphys(u) + 272 * r] = v[r]; }
}
template <class BUF, class TW> HD void fwd_pass1(int u, float2 (&v)[16], BUF buf, TW W) {
    const int j = u & 15, pb = (u >> 4) * 272 + j;
#pragma unroll
    for (int q = 0; q < 16; ++q) v[q] = buf[pb + 17 * q];
    dft16<false>(v);
#pragma unroll
    for (int r = 0; r < 16; ++r) { if (r) v[r] = cmul(v[r], W[(16 * j * r) & 4095]); buf[pb + 17 * r] = v[r]; }
}
template <class BUF> HD void fwd_pass2(int u, float2 (&v)[16], BUF buf) {
    const int pb = (u >> 4) * 272 + (u & 15) * 17;
#pragma unroll
    for (int q = 0; q < 16; ++q) v[q] = buf[pb + q];
    dft16<false>(v);
}
template <class BUF> HD void inv_passA(int u, float2 (&v)[16], BUF buf) {
    dft16<true>(v);
    const int pb = (u >> 4) * 272 + (u & 15) * 17;
#pragma unroll
    for (int r = 0; r < 16; ++r) buf[pb + r] = v[r];
}
template <class BUF, class TW> HD void inv_passB(int u, float2 (&v)[16], BUF buf, TW W) {
    const int j = u & 15, pb = (u >> 4) * 272 + j;
#pragma unroll
    for (int q = 0; q < 16; ++q) { v[q] = buf[pb + 17 * q]; if (q) v[q] = cmulc(v[q], W[(16 * j * q) & 4095]); }
    dft16<true>(v);
#pragma unroll
    for (int r = 0; r < 16; ++r) buf[pb + 17 * r] = v[r];
}
template <class BUF, class TW> HD void inv_passC(int u, float2 (&v)[16], BUF buf, TW W) {
#pragma unroll
    for (int q = 0; q < 16; ++q) { v[q] = buf[fphys(u) + 272 * q]; if (q) v[q] = cmulc(v[q], W[(u * q) & 4095]); }
    dft16<true>(v);
}
HD int digitrev(int i) { return ((i & 15) << 8) | (i & 0xF0) | (i >> 8); }

#undef HD
constexpr int FFT_LDS_W = 2 * FBUF * 8;
__device__ __forceinline__ void fft_load_w(const P& p, char* smem) {
    float2* Wl = (float2*)(smem + FFT_LDS_W);
    __syncthreads();
    for (int i = tid_opaque(); i < 4096; i += NT) Wl[i] = p.Wtab[i];
    __syncthreads();
}
__device__ __forceinline__ void ph_tables(const P& p) {
    for (int i = blockIdx.x * NT + tid_opaque(); i < 8192; i += gridDim.x * NT) {
        float sn, cs;
        if (i < 4096) { sincospif((float)i * (1.0f / 2048.0f), &sn, &cs); p.Wtab[i] = make_float2(cs, -sn); }
        else { sincospif((float)(i - 4096) * (1.0f / 4096.0f), &sn, &cs); p.W2tab[i - 4096] = make_float2(cs, -sn); }
    }
    for (int i = blockIdx.x * NT + tid_opaque(); i < DEPTH * 80 * DM; i += gridDim.x * NT) {
        const int l = i / (80 * DM), n = (i / DM) % 80, kk = i % DM;
        const float v = n < 64 ? p.w_re[((size_t)l * DM + kk) * NE + n] : (n < 72 ? p.w_rg[((size_t)l * DM + kk) * 8 + (n - 64)] : 0.f);
        const bf16_t h = f2bf(v);
        p.WrT[((size_t)(l * 2 + 0) * 80 + n) * DM + kk] = h; p.WrT[((size_t)(l * 2 + 1) * 80 + n) * DM + kk] = f2bf(v - bf2f(h));
    }
}
__device__ __forceinline__ void ph_spectra(const P& p, char* smem) {
    float2* bufE = (float2*)smem; float2* bufO = bufE + FBUF; const float2* Wl = (const float2*)(smem + FFT_LDS_W);
    const int tid = tid_opaque(), half = tid >> 8, u = tid & 255;
    float2* buf = half ? bufO : bufE;
    fft_load_w(p, smem);
    for (int un = blockIdx.x; un < DEPTH * HYW; un += gridDim.x) {
        const int l = un / HYW, c = un % HYW;
        const float* hf0 = p.HT0 + ((size_t)l * 2048 + c) * SEQ;        const float s_f0 = p.SCL0[l * 2048 + c];
        const float* hb0 = p.HT0 + ((size_t)l * 2048 + 512 + c) * SEQ;  const float s_b0 = p.SCL0[l * 2048 + 512 + c];
        const float* hf1 = p.HT0 + ((size_t)l * 2048 + 1024 + c) * SEQ; const float s_f1 = p.SCL0[l * 2048 + 1024 + c];
        const float* hb1 = p.HT0 + ((size_t)l * 2048 + 1536 + c) * SEQ; const float s_b1 = p.SCL0[l * 2048 + 1536 + c];
        float2 v[16];
#pragma unroll
        for (int q = 0; q < 16; ++q) {
            const int j = 2 * (u + 256 * q) + half;
            float a, b;
            if (j < SEQ) { a = hf0[j] * s_f0; b = hf1[j] * s_f1; } else if (j == SEQ) { a = 0.f; b = 0.f; } else { a = hb0[2 * SEQ - j] * s_b0; b = hb1[2 * SEQ - j] * s_b1; }
            v[q] = make_float2(a, b);
        }
        __syncthreads();
        fwd_pass0(u, v, buf, Wl); __syncthreads();
        fwd_pass1(u, v, buf, Wl); __syncthreads();
        fwd_pass2(u, v, buf);
#pragma unroll
        for (int r = 0; r < 16; ++r) buf[fphys(16 * u + r)] = v[r];
        __syncthreads();
        float2* out = p.Hs + (size_t)(l * HYW + c) * 4 * 4096;
        for (int idx = tid; idx < 8192; idx += NT) {
            const int par = idx >> 12, pi = idx & 4095, kp = 2 * digitrev(pi) + par, kpp = (8192 - kp) & 8191;
            const int k1 = kp & 4095, k2 = kpp & 4095;
            float2 t1 = cmul(p.W2tab[k1], bufO[fphys(digitrev(k1))]); if (kp >= 4096) { t1.x = -t1.x; t1.y = -t1.y; }
            float2 t2 = cmul(p.W2tab[k2], bufO[fphys(digitrev(k2))]); if (kpp >= 4096) { t2.x = -t2.x; t2.y = -t2.y; }
            const float2 F = cadd(bufE[fphys(digitrev(k1))], t1), Gq = cadd(bufE[fphys(digitrev(k2))], t2);
            const float sc = 0.5f / 8192.0f;
            out[(0 * 2 + par) * 4096 + pi] = make_float2((F.x + Gq.x) * sc, (F.y - Gq.y) * sc);
            out[(1 * 2 + par) * 4096 + pi] = make_float2((F.y + Gq.y) * sc, -(F.x - Gq.x) * sc);
        }
    }
    __syncthreads();
}
__device__ __forceinline__ void ph_shortconv(const P& p, int l) {
    const int n = NB * HYC * (SEQ / 8);
    for (int i = blockIdx.x * NT + tid_opaque(); i < n; i += gridDim.x * NT) {
        const int t0 = (i & (SEQ / 8 - 1)) * 8, rc = i / (SEQ / 8), col = rc % HYC;
        const bf16_t* pr = p.PT + (size_t)rc * SEQ;
        const float w0 = p.sc_w[(size_t)(l * 3 + 0) * HYC + col], w1 = p.sc_w[(size_t)(l * 3 + 1) * HYC + col], w2 = p.sc_w[(size_t)(l * 3 + 2) * HYC + col], bb = p.sc_b[l * HYC + col];
        f32x4 a, b; unpack8(*(const u32x4*)(pr + t0), a, b);
        const float left = t0 > 0 ? bf2f(pr[t0 - 1]) : 0.f, right = t0 + 8 < SEQ ? bf2f(pr[t0 + 8]) : 0.f;
        f32x4 o0, o1;
        o0[0] = bb + w0 * left + w1 * a[0] + w2 * a[1]; o0[1] = bb + w0 * a[0] + w1 * a[1] + w2 * a[2]; o0[2] = bb + w0 * a[1] + w1 * a[2] + w2 * a[3]; o0[3] = bb + w0 * a[2] + w1 * a[3] + w2 * b[0];
        o1[0] = bb + w0 * a[3] + w1 * b[0] + w2 * b[1]; o1[1] = bb + w0 * b[0] + w1 * b[1] + w2 * b[2]; o1[2] = bb + w0 * b[1] + w1 * b[2] + w2 * b[3]; o1[3] = bb + w0 * b[2] + w1 * b[3] + w2 * right;
        *(u32x4*)(p.UT + (size_t)rc * SEQ + t0) = pack8(o0, o1);
    }
}
__device__ __forceinline__ void fft_conv(int half, int u, float2 (&v)[16], const float2* W2g, const float2* Hso, float2* buf, const float2* Wl) {
    if (half) {
#pragma unroll
        for (int q = 0; q < 16; ++q) v[q] = cmul(v[q], W2g[u + 256 * q]);
    }
    fwd_pass0(u, v, buf, Wl); __syncthreads();
    fwd_pass1(u, v, buf, Wl); __syncthreads();
    fwd_pass2(u, v, buf);
    const float4* hp = (const float4*)(Hso + (size_t)half * 4096 + 16 * u);
#pragma unroll
    for (int r2 = 0; r2 < 8; ++r2) { const float4 h = hp[r2]; v[2 * r2] = cmul(v[2 * r2], make_float2(h.x, h.y)); v[2 * r2 + 1] = cmul(v[2 * r2 + 1], make_float2(h.z, h.w)); }
    inv_passA(u, v, buf); __syncthreads();
    inv_passB(u, v, buf, Wl); __syncthreads();
    inv_passC(u, v, buf, Wl);
    if (half) {
#pragma unroll
        for (int r = 0; r < 16; ++r) v[r] = cmulc(v[r], W2g[u + 256 * r]);
    }
}
constexpr int FFT_LDS_B2 = FFT_LDS_W + 4096 * 8;
__device__ __forceinline__ void ph_hyena_fft(const P& p, int l, char* smem) {
    float2* buf0 = (float2*)smem; float2* buf1 = buf0 + FBUF; const float2* Wl = (const float2*)(smem + FFT_LDS_W); float2* buf2 = (float2*)(smem + FFT_LDS_B2);
    const int tid = tid_opaque(), half = tid >> 8, u = tid & 255;
    float2* buf = half ? buf1 : buf0;
    const int pu = fphys(u);
    fft_load_w(p, smem);
    for (int c = blockIdx.x; c < HYW; c += gridDim.x) {
        const float bias0 = p.flt_bias[(l * 2 + 0) * HYW + c], bias1 = p.flt_bias[(l * 2 + 1) * HYW + c];
        const float2* Hs0 = p.Hs + (size_t)(l * HYW + c) * 4 * 4096; const float2* Hs1 = Hs0 + 2 * 4096;
        for (int pr = 0; pr < 2; ++pr) {
            const bf16_t* vA = p.UT + ((size_t)(2 * pr) * HYC + c) * SEQ + u; const bf16_t* vB = vA + (size_t)HYC * SEQ;
            float2 v[16];
#pragma unroll
            for (int q = 0; q < 16; ++q) v[q] = make_float2(bf2f(vA[256 * q]), bf2f(vB[256 * q]));
            __syncthreads();
            fft_conv(half, u, v, p.W2tab, Hs0, buf, Wl);
            if (half) {
#pragma unroll
                for (int r = 0; r < 16; ++r) buf1[pu + 272 * r] = v[r];
            }
            __syncthreads();
            if (!half) {
                const bf16_t* xA = vA + (size_t)HYW * SEQ; const bf16_t* xB = vB + (size_t)HYW * SEQ;
#pragma unroll
                for (int r = 0; r < 16; ++r) {
                    const float2 y = cadd(v[r], buf1[pu + 272 * r]);
                    const float2 z1 = make_float2(bf2f(xA[256 * r]) * (y.x + bias0 * bf2f(vA[256 * r])), bf2f(xB[256 * r]) * (y.y + bias0 * bf2f(vB[256 * r])));
                    v[r] = z1; buf1[pu + 272 * r] = z1; buf2[pu + 272 * r] = z1;
                }
            }
            __syncthreads();
            if (half) {
#pragma unroll
                for (int r = 0; r < 16; ++r) v[r] = buf1[pu + 272 * r];
            }
            fft_conv(half, u, v, p.W2tab, Hs1, buf, Wl);
            if (half) {
#pragma unroll
                for (int r = 0; r < 16; ++r) buf1[pu + 272 * r] = v[r];
            }
            __syncthreads();
            if (!half) {
                const bf16_t* xA = vA + (size_t)2 * HYW * SEQ; const bf16_t* xB = vB + (size_t)2 * HYW * SEQ;
                bf16_t* oA = p.Yhy + ((size_t)(2 * pr) * SEQ + u) * HYW + c; bf16_t* oB = oA + (size_t)SEQ * HYW;
#pragma unroll
                for (int r = 0; r < 16; ++r) {
                    const float2 y = cadd(v[r], buf1[pu + 272 * r]), z1 = buf2[pu + 272 * r];
                    oA[(size_t)(256 * r) * HYW] = f2bf(bf2f(xA[256 * r]) * (y.x + bias1 * z1.x));
                    oB[(size_t)(256 * r) * HYW] = f2bf(bf2f(xB[256 * r]) * (y.y + bias1 * z1.y));
                }
            }
        }
    }
    __syncthreads();
}

__device__ __forceinline__ void conv_tile(bf16_t* tile, const float* src, int ld, int c0, int ncols, int K, bf16_t* dst, int kt, int ntile) {
    const int tid = tid_opaque();
    const int k = tid >> 3, n8 = (tid & 7) * 8, nbase = ntile * 64;
    float4 x0 = make_float4(0.f, 0.f, 0.f, 0.f), x1 = x0;
    if (nbase + n8 < ncols) { const float* sp = src + (size_t)(kt * 64 + k) * ld + c0 + nbase + n8; x0 = *(const float4*)sp; x1 = *(const float4*)(sp + 4); }
    __syncthreads();
    tile[(n8 + 0) * 72 + k] = f2bf(x0.x); tile[(n8 + 1) * 72 + k] = f2bf(x0.y); tile[(n8 + 2) * 72 + k] = f2bf(x0.z); tile[(n8 + 3) * 72 + k] = f2bf(x0.w);
    tile[(n8 + 4) * 72 + k] = f2bf(x1.x); tile[(n8 + 5) * 72 + k] = f2bf(x1.y); tile[(n8 + 6) * 72 + k] = f2bf(x1.z); tile[(n8 + 7) * 72 + k] = f2bf(x1.w);
    __syncthreads();
    const int n = tid >> 3, k8 = (tid & 7) * 8;
    if (nbase + n < ncols) *(u32x4*)(dst + (size_t)(nbase + n) * K + kt * 64 + k8) = *(const u32x4*)(tile + n * 72 + k8);
}
constexpr int DENSE_TILES = 1720;
__device__ __forceinline__ void ph_conv_dense(const P& p, char* smem) {
    bf16_t* tile = (bf16_t*)smem;
    for (int id = blockIdx.x; id < DEPTH * DENSE_TILES; id += gridDim.x) {
        const int l = id / DENSE_TILES; int r = id % DENSE_TILES;
        const float* win = p.w_in + (size_t)l * DM * INC;
        if (r < 384) conv_tile(tile, win, INC, 0, HYC, DM, p.WtHy + (size_t)l * HYC * DM, r / 24, r % 24);
        else if ((r -= 384) < 176) conv_tile(tile, win, INC, HYC, MLAW, DM, p.WtRest + (size_t)l * 2816 * DM, r / 11, r % 11);
        else if ((r -= 176) < 512) conv_tile(tile, win, INC, MLA_END, 2048, DM, p.WtRest + ((size_t)l * 2816 + 768) * DM, r / 32, r % 32);
        else if ((r -= 512) < 72) conv_tile(tile, p.w_uq + (size_t)l * QL * 768, 768, 0, 768, QL, p.WtUq + (size_t)l * 768 * QL, r / 12, r % 12);
        else if ((r -= 72) < 64) conv_tile(tile, p.w_ukv + (size_t)l * KVL * 1024, 1024, 0, 1024, KVL, p.WtUkv + (size_t)l * 1024 * KVL, r / 16, r % 16);
        else if ((r -= 64) < 128) conv_tile(tile, p.w_hy_o + (size_t)l * HYW * DM, DM, 0, DM, HYW, p.WtHyo + (size_t)l * DM * HYW, r / 16, r % 16);
        else if ((r -= 128) < 128) conv_tile(tile, p.w_mla_o + (size_t)l * 512 * DM, DM, 0, DM, 512, p.WtMlao + (size_t)l * DM * 512, r / 16, r % 16);
        else { r -= 128; conv_tile(tile, p.w_out + (size_t)l * DM * DM, DM, 0, DM, DM, p.WtOut + (size_t)l * DM * DM, r / 16, r % 16); }
    }
    const int nz = DEPTH * 96 * DM / 8;
    for (int i = blockIdx.x * NT + threadIdx.x; i < nz + SEQ * 16; i += gridDim.x * NT) {
        if (i < nz) { const int l = i / (96 * DM / 8), o = i % (96 * DM / 8); *(u32x4*)(p.WtRest + ((size_t)l * 2816 + MLAW) * DM + (size_t)o * 8) = (u32x4){0u, 0u, 0u, 0u}; }
        else { const int k = i - nz, t = k >> 4, a = (k >> 3) & 1, ii = k & 7; const float ang = (float)(a == 0 ? (t >> 6) : (t & 63)) * powf(10000.0f, -(float)ii / 8.0f); p.rope[k] = make_float2(cosf(ang), sinf(ang)); }
    }
}
__device__ __forceinline__ void ph_conv_experts(const P& p, int l, char* smem) {
    bf16_t* tile = (bf16_t*)smem;
    for (int id = blockIdx.x; id < NE * 192; id += gridDim.x) {
        const int e = id / 192; int r = id % 192;
        const size_t le = (size_t)l * NE + e;
        if (r < 64) conv_tile(tile, p.w_gate + le * DM * DE, DE, 0, DE, DM, p.WtG + (size_t)e * DE * DM, r / 4, r % 4);
        else if (r < 128) { r -= 64; conv_tile(tile, p.w_up + le * DM * DE, DE, 0, DE, DM, p.WtU + (size_t)e * DE * DM, r / 4, r % 4); }
        else { r -= 128; conv_tile(tile, p.w_down + le * DE * DM, DM, 0, DM, DE, p.WtD + (size_t)e * DM * DE, r / 16, r % 16); }
    }
    __syncthreads();
}

constexpr int LDS_TAB = ge::STAGE_BYTES;
static_assert(FFT_LDS_B2 + FBUF * 8 <= 140 * 1024 - 16, "FFT LDS image");
constexpr int LDS_TOTAL = 140 * 1024;
#define PH_P KArgP kp_ = (KArgP)__builtin_amdgcn_kernarg_segment_ptr(); asm volatile("" : "+s"(kp_)); const P p = make_p(kp_); int G = gridDim.x, c = blockIdx.x; asm volatile("" : "+s"(G), "+s"(c)); (void)G; (void)c;
#define GRID_BAR() do { XcdBarrier b_; b_.bar = (unsigned*)k.ws; b_.x = xb_xcc_id(); b_.st = xbw; xcd_barrier(b_); } while (0)
__global__ __launch_bounds__(NT, 2) void mega(PK k) {
    extern __shared__ __attribute__((aligned(16))) char smem[];
    LAS unsigned char* lds = (LAS unsigned char*)smem;
    volatile LAS unsigned* xbw = (volatile LAS unsigned*)(smem + LDS_TOTAL - 16);
    if (threadIdx.x == 0) { xbw[0] = 0u; xbw[1] = 0u; xbw[2] = 0u; xbw[3] = 0u; }
    __syncthreads();
    (void)xcd_barrier_post((unsigned*)k.ws, xbw);
    int* offs = (int*)(smem + LDS_TAB); int* tpre = offs + 65; int* cntl = tpre + 65;
    const LAS int* offs_l = (const LAS int*)(lds + LDS_TAB); const LAS int* tpre_l = offs_l + 65; const LAS int* cntl_l = tpre_l + 65;
    for (int rep = 0; rep < REP_PRO; ++rep) {
    { PH_P ph_copy_h(p); ph_mod_partial(p, smem); ph_filter_a(p, smem); ph_conv_dense(p, smem); ph_tables(p); }
    GRID_BAR();
    { PH_P ph_filter_b(p, smem); }
    GRID_BAR();
    { PH_P ph_finalize(p); }
    GRID_BAR();
    { PH_P ph_spectra(p, smem); }
    GRID_BAR();
    }
    for (int l = 0; l < DEPTH; ++l) {
        for (int rep = 0; rep < REP_MISC; ++rep) { PH_P ph_norm<1>(p, l, smem); }
        GRID_BAR();
        for (int rep = 0; rep < REP_DENSE; ++rep) { PH_P
            SchedInproj S{(const char*)(p.WtHy + (size_t)l * HYC * DM), (const char*)(p.WtRest + (size_t)l * 2816 * DM), (const char*)p.U, G, c};
            EpiInproj E{p.PT, p.PTc, p.PMLA, p.G};
            ge::gemm_engine<false>(lds, DM, DM, DM, S, E);
        }
        GRID_BAR();
        for (int rep = 0; rep < REP_MISC; ++rep) { { PH_P ph_mla_prep(p, l); }
        { PH_P ph_shortconv(p, l); } }
        GRID_BAR();
        for (int rep = 0; rep < REP_DENSE; ++rep) {
        { PH_P
            SchedDense S{(const char*)p.CQ, (const char*)(p.WtUq + (size_t)l * 768 * QL), (size_t)QL * 2, (size_t)QL * 2, 68, 3, G, c};
            EpiQ E{p.Q, p.Qc, p.rope};
            ge::gemm_engine<false>(lds, QL, QL, QL, S, E);
        }
        { PH_P
            SchedDense S2{(const char*)p.CKV, (const char*)(p.WtUkv + (size_t)l * 1024 * KVL), (size_t)KVL * 2, (size_t)KVL * 2, 68, 4, G, (c + G - (204 % G)) % G};
            EpiKV E2{p.K, p.V};
            ge::gemm_engine<false>(lds, KVL, KVL, KVL, S2, E2);
        } }
        GRID_BAR();
        for (int rep = 0; rep < REP_MIX; ++rep) {
        { PH_P ph_conv_experts(p, l, smem); }
        { PH_P ph_attn2(p, smem); }
        { PH_P ph_hyena_fft(p, l, smem); }
        { PH_P ph_hyena<CTXL>(p, l, smem); } }
        GRID_BAR();
        for (int rep = 0; rep < REP_DENSE; ++rep) { PH_P
            SchedMerge S{(const char*)p.Yhy, (const char*)p.Yatt, (const char*)(p.WtHyo + (size_t)l * DM * HYW), (const char*)(p.WtMlao + (size_t)l * DM * 512), G, c};
            EpiMerge E{p.G, p.M1};
            ge::gemm_engine<false>(lds, 512, 512, 512, S, E);
        }
        GRID_BAR();
        { PH_P
            SchedDense S{(const char*)p.M1, (const char*)(p.WtOut + (size_t)l * DM * DM), (size_t)DM * 2, (size_t)DM * 2, 68, 4, G, c};
            EpiOut E{p.hx, p.mod + (size_t)l * 5 * NMOD};
            ge::gemm_engine<false>(lds, DM, DM, DM, S, E);
        }
        GRID_BAR();
        { PH_P ph_norm2_router(p, l, smem); }
        GRID_BAR();
        for (int rep = 0; rep < REP_MOE; ++rep) { PH_P
            if (threadIdx.x == 0) { int a = 0, t = 0; for (int e = 0; e < NE; ++e) { const int n = p.cnt[l * NE + e]; offs[e] = a; tpre[e] = t; cntl[e] = n; a += n; t += (n + 255) >> 8; } offs[64] = a; tpre[64] = t; }
            __syncthreads();
            SchedGU S{(const char*)p.U, (const char*)p.WtG, (const char*)p.WtU, p.list, tpre_l, cntl_l, G, c};
            EpiGU E{p.Hb, offs_l};
            ge::gemm_engine<true>(lds, DM, DM, DM, S, E);
        }
        GRID_BAR();
        for (int rep = 0; rep < REP_MOE; ++rep) { PH_P
            SchedDown S{(const char*)p.Hb, (const char*)p.WtD, tpre_l, cntl_l, offs_l, G, c};
            EpiDown E{p.Y, p.wl, offs_l};
            ge::gemm_engine<false>(lds, DE, DE, DE, S, E);
        }
        GRID_BAR();
        { PH_P ph_combine(p, l, offs); }
        GRID_BAR();
    }
    { PH_P ph_final(p); }
}

extern "C" void kernel_launch(void* const* d_in, const int* in_sizes, int n_in, void* d_out, int out_size, void* d_ws, size_t ws_size, hipStream_t stream) {
    (void)in_sizes; (void)out_size;
    if (n_in < 33 || WSO.total > ws_size) { fprintf(stderr, "kernel_launch: need 33 inputs and %zu bytes of workspace; got %d, %zu\n", (size_t)WSO.total, n_in, ws_size); return; }
    PK k{};
    for (int i = 0; i < 33; ++i) k.in[i] = (const float*)d_in[i];
    k.out = (float*)d_out; k.ws = (char*)d_ws;
    (void)hipMemsetAsync(d_ws, 0, WS_ZERO_BYTES, stream);
    static int grid = 0;
    if (!grid) {
        int dev = 0, cus = 0, per_cu = 0;
        (void)hipGetDevice(&dev);
        (void)hipDeviceGetAttribute(&cus, hipDeviceAttributeMultiprocessorCount, dev);
        (void)hipFuncSetAttribute((const void*)mega, hipFuncAttributeMaxDynamicSharedMemorySize, LDS_TOTAL);
        (void)hipOccupancyMaxActiveBlocksPerMultiprocessor(&per_cu, (const void*)mega, NT, LDS_TOTAL);
        if (per_cu < 1) fprintf(stderr, "kernel_launch: occupancy query reports %d blocks per CU\n", per_cu);
        grid = cus > 0 ? cus : 256;
    }
    hipLaunchKernelGGL(mega, dim3(grid), dim3(NT), LDS_TOTAL, stream, k);
}
```

```cpp
#include <hip/hip_runtime.h>
#include <stdint.h>
#include <stdio.h>

typedef unsigned short bf16_t;
typedef short bf16x8 __attribute__((ext_vector_type(8)));
typedef float f32x4 __attribute__((ext_vector_type(4)));
typedef unsigned u32x4 __attribute__((ext_vector_type(4)));
typedef unsigned u32x2 __attribute__((ext_vector_type(2)));

#define NT 512
#ifndef PROBE_ID
#define PROBE_ID (-1)
#endif
#define PROBE_K 8
#ifndef REP_PRO
#define REP_PRO 1
#endif
#ifndef REP_DENSE
#define REP_DENSE 1
#endif
#ifndef REP_MOE
#define REP_MOE 1
#endif
#ifndef REP_MIX
#define REP_MIX 1
#endif
#ifndef REP_MISC
#define REP_MISC 1
#endif
constexpr int DM = 1024, NB = 4, SEQ = 4096, DEPTH = 4, CTXL = 256;
constexpr int TL = NB * SEQ, TC = NB * CTXL, TT = TL + TC;
constexpr int HYW = 512, HYC = 1536, QL = 384, KVL = 256, QKR = 32;
constexpr int MLAW = QL + KVL + QKR, MLA_END = HYC + MLAW, INC = MLA_END + 2 * DM;
constexpr int NH = 8, DQK = 96, DV = 64, NKEY = SEQ + CTXL;
constexpr int NE = 64, DE = 256, CAP = TT;
constexpr int NMOD = 6 * DM;
constexpr float EPSF = 1e-6f;
constexpr float QSCALE = 0.10206207261596577f * 1.4426950408889634f;

__device__ __forceinline__ bf16_t f2bf(float f) { unsigned u = __float_as_uint(f); u += 0x7FFFu + ((u >> 16) & 1u); return (bf16_t)(u >> 16); }
__device__ __forceinline__ float bf2f(bf16_t b) { return __uint_as_float(((unsigned)b) << 16); }
__device__ __forceinline__ unsigned pack2(float lo, float hi) { return (unsigned)f2bf(lo) | ((unsigned)f2bf(hi) << 16); }
__device__ __forceinline__ float epsf() { float e = EPSF; asm volatile("" : "+v"(e)); return e; }
__device__ __forceinline__ int tid_opaque() { int t = threadIdx.x; asm volatile("" : "+v"(t)); return t; }
__device__ __forceinline__ int shx_i(int v, int mask) {
    switch (mask) {
        case 1: return __builtin_amdgcn_ds_swizzle(v, (1 << 10) | 0x1F);
        case 2: return __builtin_amdgcn_ds_swizzle(v, (2 << 10) | 0x1F);
        case 4: return __builtin_amdgcn_ds_swizzle(v, (4 << 10) | 0x1F);
        case 8: return __builtin_amdgcn_ds_swizzle(v, (8 << 10) | 0x1F);
        case 16: return __builtin_amdgcn_ds_swizzle(v, (16 << 10) | 0x1F);
        default: {
            typedef unsigned u32x2s_t __attribute__((ext_vector_type(2)));
            const u32x2s_t r = __builtin_amdgcn_permlane32_swap((unsigned)v, (unsigned)v, false, false);
            return (int)(((threadIdx.x & 32u) == 0u) ? r.y : r.x); }
    }
}
__device__ __forceinline__ float shx(float v, int mask) { return __int_as_float(shx_i(__float_as_int(v), mask)); }
__device__ __forceinline__ int shx(int v, int mask) { return shx_i(v, mask); }
typedef unsigned u32x2_t __attribute__((ext_vector_type(2)));
__device__ __forceinline__ float rowmax4(float v) {
    u32x2_t r = __builtin_amdgcn_permlane16_swap(__float_as_uint(v), __float_as_uint(v), false, false);
    v = fmaxf(__uint_as_float(r.x), __uint_as_float(r.y));
    r = __builtin_amdgcn_permlane32_swap(__float_as_uint(v), __float_as_uint(v), false, false);
    return fmaxf(__uint_as_float(r.x), __uint_as_float(r.y));
}
__device__ __forceinline__ float rowsum4(float v) {
    u32x2_t r = __builtin_amdgcn_permlane16_swap(__float_as_uint(v), __float_as_uint(v), false, false);
    v = __uint_as_float(r.x) + __uint_as_float(r.y);
    r = __builtin_amdgcn_permlane32_swap(__float_as_uint(v), __float_as_uint(v), false, false);
    return __uint_as_float(r.x) + __uint_as_float(r.y);
}
__device__ __forceinline__ float wave_sum(float v) {
#pragma unroll
    for (int o = 32; o > 0; o >>= 1) v += shx(v, o);
    return v;
}


#define XB_TMO      128
#define XB_XCNT(j)  (256  + 64 * (j))
#define XB_XSUB(j)  (1280 + 64 * (j))
#define XB_XGEN(j)  (2304 + 64 * (j))
#define XB_TOP      3328
#define XB_TOPGEN   3392
#define XCD_BAR_WORDS 3456
#define XB_SPIN_CAP (1u << 22)
#define LAS __attribute__((address_space(3)))
__device__ __forceinline__ unsigned xb_ld(unsigned* p)              { return __hip_atomic_load(p, __ATOMIC_RELAXED, __HIP_MEMORY_SCOPE_AGENT); }
__device__ __forceinline__ unsigned xb_add(unsigned* p, unsigned v) { return __hip_atomic_fetch_add(p, v, __ATOMIC_RELAXED, __HIP_MEMORY_SCOPE_AGENT); }
__device__ __forceinline__ unsigned xb_xcc_id() { return (unsigned)__builtin_amdgcn_s_getreg((3 << 11) | 20) & 0xFu; }
#define XB_SPIN(cond, bar) do { unsigned _sp = 0; while (cond) { __builtin_amdgcn_s_sleep(1); \
    if ((++_sp & 255u) == 0u) { if (xb_ld(&(bar)[XB_TMO])) break; if (_sp > XB_SPIN_CAP) { atomicAdd(&(bar)[XB_TMO], 1u); break; } } } } while (0)
struct XcdBarrier { unsigned* bar; unsigned x; volatile LAS unsigned* st; };
__device__ __forceinline__ XcdBarrier xcd_barrier_post(unsigned* bar, volatile LAS unsigned* st) {
    XcdBarrier b; b.bar = bar; b.x = xb_xcc_id(); b.st = st;
    if (threadIdx.x == 0) (void)xb_add(&bar[XB_XCNT(b.x)], 1u);
    return b;
}
__device__ __forceinline__ void xcd_barrier_complete(unsigned* bar, unsigned x, unsigned& nloc, unsigned& nx) {
    const unsigned G = gridDim.x * gridDim.y * gridDim.z;
    unsigned sum, cnt, mine, sp = 0u;
    for (;;) {
        sum = 0u; cnt = 0u; mine = 0u;
#pragma unroll
        for (unsigned j = 0; j < 16; ++j) { const unsigned c = xb_ld(&bar[XB_XCNT(j)]); sum += c; cnt += (c > 0u) ? 1u : 0u; mine = (j == x) ? c : mine; }
        if (sum == G) break;
        __builtin_amdgcn_s_sleep(1);
        if ((++sp & 255u) == 0u) { if (xb_ld(&bar[XB_TMO])) break; if (sp > XB_SPIN_CAP) { atomicAdd(&bar[XB_TMO], 1u); break; } }
    }
    nloc = mine > 0u ? mine : 1u; nx = cnt > 0u ? cnt : 1u;
}
__device__ __forceinline__ void xcd_barrier(const XcdBarrier& b) {
    asm volatile("s_waitcnt vmcnt(0)" ::: "memory");
    __syncthreads();
    if (threadIdx.x == 0) {
        unsigned* bar = b.bar;
        __builtin_amdgcn_s_waitcnt(0);
        unsigned nloc = b.st[0], nx = b.st[1];
        if (nloc == 0u) { xcd_barrier_complete(bar, b.x, nloc, nx); b.st[0] = nloc; b.st[1] = nx; }
        const unsigned old = xb_add(&bar[XB_XSUB(b.x)], 1u);
        const unsigned gen = old / nloc;
        if (old + 1u == (gen + 1u) * nloc) {
            __builtin_amdgcn_fence(__ATOMIC_RELEASE, "agent");
            asm volatile("s_waitcnt vmcnt(0)" ::: "memory");
            const unsigned og = xb_add(&bar[XB_TOP], 1u);
            const unsigned tg = og / nx;
            if (og + 1u == (tg + 1u) * nx) xb_add(&bar[XB_TOPGEN], 1u);
            else XB_SPIN(xb_ld(&bar[XB_TOPGEN]) == tg, bar);
            __builtin_amdgcn_fence(__ATOMIC_ACQUIRE, "agent");
            xb_add(&bar[XB_XGEN(b.x)], 1u);
            asm volatile("s_waitcnt vmcnt(0)" ::: "memory");
        } else {
            XB_SPIN(xb_ld(&bar[XB_XGEN(b.x)]) == gen, bar);
            __builtin_amdgcn_fence(__ATOMIC_ACQUIRE, "agent");
            asm volatile("s_waitcnt vmcnt(0)" ::: "memory");
        }
    }
    __syncthreads();
}

#define WS_LIST(X) \
    X(unsigned, bar, XCD_BAR_WORDS * 4)                         \
    X(int, cnt, DEPTH * 64 * 256)                               \
    X(float, modp, (size_t)DEPTH * 32 * 5 * NMOD * 4)           \
    X(float, mod, (size_t)DEPTH * 5 * NMOD * 4)                 \
    X(float, H2a, (size_t)DEPTH * SEQ * 64 * 4) \
    X(float, H2b, (size_t)DEPTH * CTXL * 64 * 4) \
    X(float, HT1, (size_t)DEPTH * 2048 * CTXL * 4) \
    X(float, SSQ0, (size_t)DEPTH * 2048 * 128 * 4) \
    X(float, SSQ1, (size_t)DEPTH * 2048 * 8 * 4) \
    X(float, SCL0, (size_t)DEPTH * 2048 * 4) \
    X(float, SCL1, (size_t)DEPTH * 2048 * 4) \
    X(float, hx, (size_t)TT * DM * 4)                           \
    X(bf16_t, U, (size_t)TT * DM * 2)                           \
    X(bf16_t, PT, (size_t)NB * HYC * SEQ * 2)                   \
    X(bf16_t, PTc, (size_t)NB * HYC * CTXL * 2) \
    X(bf16_t, PMLAb, (size_t)TT * 640 * 2)                      \
    X(bf16_t, G, (size_t)TT * 2048 * 2)                         \
    X(bf16_t, Q, (size_t)NB * NH * SEQ * 128 * 2)               \
    X(bf16_t, Qc, (size_t)NB * NH * CTXL * 128 * 2) \
    X(bf16_t, K, (size_t)NB * NH * NKEY * DQK * 2)              \
    X(bf16_t, V, (size_t)NB * NH * NKEY * DV * 2)               \
    X(bf16_t, Yatt, (size_t)TT * 512 * 2) \
    X(bf16_t, Yhy, (size_t)TT * 512 * 2) \
    X(bf16_t, M1, (size_t)TT * DM * 2) \
    X(int, list, (size_t)NE * CAP * 4) \
    X(float, wl, (size_t)NE * CAP * 4) \
    X(int, asg, (size_t)TT * 4 * 4) \
    X(bf16_t, Hb, (size_t)(2 * TT + 256) * DE * 2) \
    X(bf16_t, Y, (size_t)2 * TT * DM * 2) \
    X(bf16_t, WtHy, (size_t)DEPTH * HYC * DM * 2)               \
    X(bf16_t, WtRest, (size_t)DEPTH * 2816 * DM * 2) \
    X(bf16_t, WtUq, (size_t)DEPTH * 768 * QL * 2) \
    X(bf16_t, WtUkv, (size_t)DEPTH * 1024 * KVL * 2) \
    X(bf16_t, WtHyo, (size_t)DEPTH * DM * HYW * 2) \
    X(bf16_t, WtMlao, (size_t)DEPTH * DM * 512 * 2) \
    X(bf16_t, WtOut, (size_t)DEPTH * DM * DM * 2) \
    X(bf16_t, WtG, (size_t)NE * DE * DM * 2)                    \
    X(bf16_t, WtU, (size_t)NE * DE * DM * 2) \
    X(bf16_t, WtD, (size_t)NE * DM * DE * 2) \
    X(float2, rope, (size_t)SEQ * 16 * 8)                       \
    X(float2, Hs, (size_t)DEPTH * HYW * 4 * 4096 * 8)           \
    X(float2, Wtab, 4096 * 8) \
    X(bf16_t, WrT, (size_t)DEPTH * 2 * 80 * DM * 2)             \
    X(float2, W2tab, 4096 * 8)
struct WsOff {
#define X(t, n, b) size_t n;
    WS_LIST(X)
#undef X
    size_t total;
};
constexpr WsOff ws_layout() {
    WsOff o{}; size_t a = 0;
#define X(t, n, b) o.n = a; a += (((size_t)(b)) + 255) & ~(size_t)255;
    WS_LIST(X)
#undef X
    o.total = a; return o;
}
constexpr WsOff WSO = ws_layout();
constexpr size_t WS_ZERO_BYTES = WSO.modp;
static_assert(WSO.Yatt - WSO.G >= (size_t)DEPTH * 2048 * SEQ * 4, "HT0 alias region too small");

struct PK { const float* in[33]; float* out; char* ws; };
struct P {
    const float *x, *c, *ctx, *c_ctx, *w_ada, *b_ada, *norm1_g, *w_in, *q_norm_g, *kv_norm_g, *w_uq, *w_ukv, *sc_w, *sc_b;
    const float *flt_w1, *flt_b1, *flt_freq, *flt_w2, *flt_b2, *flt_w3, *flt_bias, *w_hy_o, *w_mla_o, *w_out, *norm2_g;
    const float *w_rg, *b_rg, *w_re, *b_re, *w_gate, *w_up, *w_down, *final_g;
    float* out;
#define X(t, n, b) t* n;
    WS_LIST(X)
#undef X
    float* HT0;
};
typedef const __attribute__((address_space(4))) PK* KArgP;
__device__ __forceinline__ P make_p(KArgP kp) {
    P p; const KArgP& kk = kp; char* ws = kk->ws;
    p.x = kk->in[0]; p.c = kk->in[1]; p.ctx = kk->in[2]; p.c_ctx = kk->in[3]; p.w_ada = kk->in[4]; p.b_ada = kk->in[5]; p.norm1_g = kk->in[6]; p.w_in = kk->in[7];
    p.q_norm_g = kk->in[8]; p.kv_norm_g = kk->in[9]; p.w_uq = kk->in[10]; p.w_ukv = kk->in[11]; p.sc_w = kk->in[12]; p.sc_b = kk->in[13];
    p.flt_w1 = kk->in[14]; p.flt_b1 = kk->in[15]; p.flt_freq = kk->in[16]; p.flt_w2 = kk->in[17]; p.flt_b2 = kk->in[18]; p.flt_w3 = kk->in[19]; p.flt_bias = kk->in[20];
    p.w_hy_o = kk->in[21]; p.w_mla_o = kk->in[22]; p.w_out = kk->in[23]; p.norm2_g = kk->in[24]; p.w_rg = kk->in[25]; p.b_rg = kk->in[26]; p.w_re = kk->in[27]; p.b_re = kk->in[28];
    p.w_gate = kk->in[29]; p.w_up = kk->in[30]; p.w_down = kk->in[31]; p.final_g = kk->in[32];
    p.out = kk->out;
#define X(t, n, b) p.n = (t*)(ws + WSO.n);
    WS_LIST(X)
#undef X
    p.HT0 = (float*)(ws + WSO.G);
    return p;
}

constexpr int MODK = 32;
__device__ __forceinline__ void ph_mod_partial(const P& p, char* smem) {
    float* s = (float*)smem;
    const int tid = tid_opaque();
    for (int it = blockIdx.x; it < DEPTH * MODK * 3; it += gridDim.x) {
        const int l = it / (MODK * 3), kc = (it / 3) % MODK, jb = it % 3;
        __syncthreads();
        if (tid < 5 * 32) {
            const int r = tid / 32, kk = tid % 32, k = kc * 32 + kk;
            const float cv = (r < 4) ? p.c[r * DM + k] : p.c_ctx[k];
            s[tid] = cv / (1.0f + expf(-cv));
        }
        __syncthreads();
        const int j = jb * 2048 + tid * 4;
        f32x4 a0 = {0.f, 0.f, 0.f, 0.f}, a1 = a0, a2 = a0, a3 = a0, a4 = a0;
        const float* w = p.w_ada + ((size_t)l * DM + kc * 32) * NMOD + j;
#pragma unroll 8
        for (int kk = 0; kk < 32; ++kk) {
            const f32x4 wv = *(const f32x4*)(w + (size_t)kk * NMOD);
            a0 += wv * s[kk]; a1 += wv * s[32 + kk]; a2 += wv * s[64 + kk]; a3 += wv * s[96 + kk]; a4 += wv * s[128 + kk];
        }
        float* o = p.modp + ((size_t)(l * MODK + kc) * 5) * NMOD + j;
        *(f32x4*)o = a0; *(f32x4*)(o + NMOD) = a1; *(f32x4*)(o + 2 * NMOD) = a2; *(f32x4*)(o + 3 * NMOD) = a3; *(f32x4*)(o + 4 * NMOD) = a4;
    }
}

__device__ __forceinline__ void ph_filter_a(const P& p, char* smem) {
    float* zs = (float*)smem;
    float* h1s = zs + 8 * 36;
    const int tid = tid_opaque(), tt = tid >> 6, j = tid & 63;
    const int n0 = DEPTH * 512, n1 = DEPTH * 32;
    for (int it = blockIdx.x; it < n0 + n1; it += gridDim.x) {
        int l, ls, tg;
        if (it < n0) { ls = 0; l = it / 512; tg = it % 512; } else { ls = 1; l = (it - n0) / 32; tg = (it - n0) % 32; }
        const int L = ls ? CTXL : SEQ;
        const int t = tg * 8 + tt;
        __syncthreads();
        if (j < 33) {
            float f;
            if (j == 0) f = (float)t / (float)(L - 1);
            else {
                const int k = (j - 1) & 15;
                const float band = 1e-4f + (float)k * ((15.0f - 1e-4f) / 15.0f);
                const float w = 6.283185307179586f * (float)t / (float)L;
                const double ang = (double)band * (double)w;
                f = (j <= 16) ? (float)cos(ang) : (float)(-sin(ang));
            }
            zs[tt * 36 + j] = f;
        }
        __syncthreads();
        const float fr = p.flt_freq[l * 64 + j];
        float a = p.flt_b1[l * 64 + j];
        for (int i = 0; i < 33; ++i) a += zs[tt * 36 + i] * p.flt_w1[((size_t)l * 33 + i) * 64 + j];
        h1s[tt * 64 + j] = sinf(fr * a);
        __syncthreads();
        float a2 = p.flt_b2[l * 64 + j];
        for (int i = 0; i < 64; ++i) a2 += h1s[tt * 64 + i] * p.flt_w2[((size_t)l * 64 + i) * 64 + j];
        const float h2 = sinf(fr * a2);
        if (ls == 0) p.H2a[((size_t)l * SEQ + t) * 64 + j] = h2; else p.H2b[((size_t)l * CTXL + t) * 64 + j] = h2;
    }
}

typedef float f32x16 __attribute__((ext_vector_type(16)));
__device__ __forceinline__ void ph_filter_b2(const P& p, char* smem) {
    float* sA = (float*)smem;
    const int tid = tid_opaque(), lane = tid & 63, wv = tid >> 6, li = lane & 31, hf = lane >> 5;
    const int n0 = DEPTH * 128 * 8, n1 = DEPTH * 8 * 8;
    const float DA = -15.350567286626973f, DB = -3.0701134573253946f;
    for (int it = blockIdx.x; it < n0 + n1; it += gridDim.x) {
        int l, ls, tt, cg;
        if (it < n0) { ls = 0; l = it / 1024; tt = (it / 8) % 128; cg = it % 8; } else { const int i2 = it - n0; ls = 1; l = i2 / 64; tt = (i2 / 8) % 8; cg = i2 % 8; }
        const int L = ls ? CTXL : SEQ, t0 = tt * 32;
        const float* h2 = ls ? p.H2b + ((size_t)l * CTXL + t0) * 64 : p.H2a + ((size_t)l * SEQ + t0) * 64;
        __syncthreads();
        { const int r = tid >> 4, k4 = (tid & 15) * 4; const float4 v = *(const float4*)(h2 + r * 64 + k4); float* d = sA + r * 65 + k4; d[0] = v.x; d[1] = v.y; d[2] = v.z; d[3] = v.w; }
        __syncthreads();
        const int col = cg * 256 + wv * 32 + li;
        const float* wp = p.flt_w3 + (size_t)l * 64 * 2048 + col;
        f32x16 acc;
#pragma unroll
        for (int i = 0; i < 16; ++i) acc[i] = 0.f;
#pragma unroll 8
        for (int s2 = 0; s2 < 32; ++s2) {
            const int k = 2 * s2 + hf;
            acc = __builtin_amdgcn_mfma_f32_32x32x2f32(sA[li * 65 + k], wp[(size_t)k * 2048], acc, 0, 0, 0);
        }
        const int ch = col & 511;
        const float delta = fabsf(DA + (float)ch * ((DB - DA) / 511.0f));
        float q = 0.f;
        float* dst = (ls ? p.HT1 + ((size_t)l * 2048 + col) * CTXL : p.HT0 + ((size_t)l * 2048 + col) * SEQ) + t0 + 4 * hf;
#pragma unroll
        for (int g4 = 0; g4 < 4; ++g4) {
            float4 o;
            float* op = &o.x;
#pragma unroll
            for (int e = 0; e < 4; ++e) { const int t = t0 + 8 * g4 + 4 * hf + e; const float v = acc[4 * g4 + e] * expf(-((float)t / (float)(L - 1)) * delta); op[e] = v; q += v * v; }
            *(float4*)(dst + 8 * g4) = o;
        }
        q += shx(q, 32);
        if (hf == 0) { if (ls == 0) p.SSQ0[((size_t)l * 2048 + col) * 128 + tt] = q; else p.SSQ1[((size_t)l * 2048 + col) * 8 + tt] = q; }
    }
    __syncthreads();
}

__device__ __forceinline__ void ph_finalize(const P& p) {
    const int n_mod = DEPTH * 5 * NMOD, n_s = DEPTH * 2048;
    for (int i = blockIdx.x * NT + threadIdx.x; i < n_mod + 2 * n_s; i += gridDim.x * NT) {
        if (i < n_mod) {
            const int l = i / (5 * NMOD), r = (i / NMOD) % 5, j = i % NMOD;
            float a = p.b_ada[l * NMOD + j];
            for (int kc = 0; kc < MODK; ++kc) a += p.modp[((size_t)(l * MODK + kc) * 5 + r) * NMOD + j];
            p.mod[i] = a;
        } else if (i < n_mod + n_s) {
            const int k = i - n_mod; float a = 0.f;
            for (int q = 0; q < 128; ++q) a += p.SSQ0[(size_t)k * 128 + q];
            p.SCL0[k] = rsqrtf(a + epsf());
        } else {
            const int k = i - n_mod - n_s; float a = 0.f;
            for (int q = 0; q < 8; ++q) a += p.SSQ1[(size_t)k * 8 + q];
            p.SCL1[k] = rsqrtf(a + epsf());
        }
    }
}

__device__ __forceinline__ float rope_apply(float self, float partner, int d, int t) {
    const int a = d >> 4, s = (d >> 3) & 1, i = d & 7;
    const float pos = (float)(a == 0 ? (t >> 6) : (t & 63));
    const float inv = powf(10000.0f, -(float)i / 8.0f);
    const float ang = pos * inv;
    const float cs = cosf(ang), sn = sinf(ang);
    return s == 0 ? self * cs - partner * sn : partner * sn + self * cs;
}

namespace ge {
constexpr int BM = 256, BK = 64, HALF = 128, HTB = HALF * BK * 2, STAGE_BYTES = 8 * HTB, NXCD = 8, WGM = 8;
__device__ __forceinline__ int lds_byte(int r, int c) { const int st = (r >> 4) * 2 + (c >> 5), rr = r & 15, cc = c & 31, ob = rr * 64 + cc * 2; return st * 1024 + (ob ^ (((ob >> 9) & 1) << 5)); }
__device__ __forceinline__ void stage_rc(int b, int& R, int& C) { const int st = b / 1024, sb = b % 1024, swz = sb ^ (((sb >> 9) & 1) << 5); R = (st >> 1) * 16 + swz / 64; C = (st & 1) * 32 + (swz % 64) / 2; }
__device__ __forceinline__ int perm32(int rho) { const int n = rho >> 4, i = rho & 15; return 8 * (i >> 2) + 4 * n + (i & 3); }
__device__ __forceinline__ void tile_order(int L, int nM, int nN, int& pm, int& pn) {
    const int nwg = nM * nN; int wgid = L;
    { const int q = nwg / NXCD, r = nwg % NXCD, xcd = wgid % NXCD, off = wgid / NXCD; wgid = (xcd < r ? xcd * (q + 1) : r * (q + 1) + (xcd - r) * q) + off; }
    const int nig = WGM * nN, gid = wgid / nig, fm = gid * WGM, gsz = (nM - fm) < WGM ? (nM - fm) : WGM;
    pm = fm + ((wgid % nig) % gsz); pn = (wgid % nig) / gsz;
}
struct Unit { const char* a; const char* b0; const char* b1; const int* rows; int nrows; int pm, pn, kind; };
typedef f32x4 Acc[2][2][4][2];

template <bool GATHER, int ABLK = 0, class Sched, class Epi>
__device__ __forceinline__ void gemm_engine(LAS unsigned char* lds, const int lda, const int ldb, const int K, const Sched& S, const Epi& E) {
    const int tid = tid_opaque(), wid = __builtin_amdgcn_readfirstlane(tid >> 6), lane = tid & 63, wr = wid >> 2, wc = wid & 3, fr = lane & 15, fq = lane >> 4;
    const int nt = K / BK;
    int sR[2], sC[2];
    unsigned voffA[2], voffB[2];
#pragma unroll
    for (int i = 0; i < 2; ++i) { stage_rc(tid * 16 + i * 8192, sR[i], sC[i]); const int Rb = (sR[i] & ~31) + perm32(sR[i] & 31);
        voffA[i] = ABLK ? (unsigned)((sC[i] >> 3) * ABLK + sR[i]) * 16u : (unsigned)(sR[i] * lda + sC[i]) * 2u; voffB[i] = (unsigned)(Rb * ldb + sC[i]) * 2u; }
    const size_t kstep = (size_t)(BK * 2);
    const size_t hstepA = ABLK ? (size_t)HALF * 16 : (size_t)HALF * lda * 2;
    const size_t kstepA = ABLK ? (size_t)(BK / 8) * ABLK * 16 : kstep;
    const unsigned ldsw = (unsigned)wid * 1024u;
    const int aoff = lds_byte(wr * 64 + fr, fq * 8), boff = lds_byte(wc * 32 + fr, fq * 8);
    unsigned gvc[2][2], gvn[2][2];
#define GE_SA(b, h) (((b) * 2 + (h)) * HTB)
#define GE_SB(b, h) ((4 + (b) * 2 + (h)) * HTB)
#define GE_GLDS(src, bufoff, i) __builtin_amdgcn_global_load_lds((const unsigned*)(src), (LAS unsigned*)(lds + (bufoff) + ldsw + (i) * 8192), 16, 0, 0)
#define GE_STAGE_B(bufoff, bp) do { _Pragma("unroll") for (int _i = 0; _i < 2; ++_i) GE_GLDS((bp) + voffB[_i], bufoff, _i); } while (0)
#define GE_STAGE_A(bufoff, ap, h, gv) do { _Pragma("unroll") for (int _i = 0; _i < 2; ++_i) { \
        if constexpr (GATHER) GE_GLDS((ap) + (gv)[h][_i], bufoff, _i); else GE_GLDS((ap) + (size_t)(h) * hstepA + voffA[_i], bufoff, _i); } } while (0)
#define GE_STAGE_A2(bufoff, ap, h) do { _Pragma("unroll") for (int _i = 0; _i < 2; ++_i) { \
        if constexpr (GATHER) GE_GLDS((ap) + (last ? gvn[h][_i] : gvc[h][_i]), bufoff, _i); else GE_GLDS((ap) + (size_t)(h) * hstepA + voffA[_i], bufoff, _i); } } while (0)
#define GE_LDA(dst, b, h) do { _Pragma("unroll") for (int m = 0; m < 4; ++m) _Pragma("unroll") for (int k = 0; k < 2; ++k) dst[m][k] = *(const LAS bf16x8*)(lds + GE_SA(b, h) + aoff + m * 2048 + k * 1024); } while (0)
#define GE_LDB(dst, b, h) do { _Pragma("unroll") for (int n = 0; n < 2; ++n) _Pragma("unroll") for (int k = 0; k < 2; ++k) dst[n][k] = *(const LAS bf16x8*)(lds + GE_SB(b, h) + boff + n * 2048 + k * 1024); } while (0)
#define GE_MMA(ai, bj, At, Bt) do { __builtin_amdgcn_s_setprio(1); _Pragma("unroll") for (int m = 0; m < 4; ++m) _Pragma("unroll") for (int n = 0; n < 2; ++n) _Pragma("unroll") for (int k = 0; k < 2; ++k) \
        acc[ai][bj][m][n] = __builtin_amdgcn_mfma_f32_16x16x32_bf16(Bt[n][k], At[m][k], acc[ai][bj][m][n], 0, 0, 0); __builtin_amdgcn_s_setprio(0); } while (0)
#define GE_WAIT_V(n) asm volatile("s_waitcnt vmcnt(" #n ")" ::: "memory")
#define GE_WAIT_L(n) asm volatile("s_waitcnt lgkmcnt(" #n ")" ::: "memory")
#define GE_BAR __builtin_amdgcn_s_barrier()
#define GE_SCHED __builtin_amdgcn_sched_barrier(0)
#define GE_GATHER_OFFS(gv, u) do { if constexpr (GATHER) { _Pragma("unroll") for (int _h = 0; _h < 2; ++_h) _Pragma("unroll") for (int _i = 0; _i < 2; ++_i) { \
        int _r = (u).pm * BM + _h * HALF + sR[_i]; _r = _r < (u).nrows ? _r : (u).nrows - 1; (gv)[_h][_i] = (unsigned)((u).rows[_r] * lda + sC[_i]) * 2u; } } } while (0)
    Unit cur, nxt; int ui = 0;
    if (!S.next(0, cur)) return;
    Acc acc;
#pragma unroll
    for (int a = 0; a < 2; ++a)
#pragma unroll
        for (int b = 0; b < 2; ++b)
#pragma unroll
            for (int m = 0; m < 4; ++m)
#pragma unroll
                for (int n = 0; n < 2; ++n) acc[a][b][m][n] = (f32x4){0.f, 0.f, 0.f, 0.f};
    bf16x8 At[4][2], B0[2][2], B1[2][2];
    GE_GATHER_OFFS(gvc, cur);
    GE_STAGE_B(GE_SB(0, 0), cur.b0); GE_STAGE_A(GE_SA(0, 0), cur.a, 0, gvc); GE_STAGE_B(GE_SB(0, 1), cur.b1); GE_STAGE_A(GE_SA(0, 1), cur.a, 1, gvc);
    if (wr == 1) GE_BAR;
    GE_WAIT_V(4); GE_BAR;
    GE_STAGE_B(GE_SB(1, 0), cur.b0 + kstep); GE_STAGE_A(GE_SA(1, 0), cur.a + kstepA, 0, gvc); GE_STAGE_B(GE_SB(1, 1), cur.b1 + kstep);
    GE_WAIT_V(6); GE_BAR;
    for (;;) {
        const bool has_next = S.next(ui + 1, nxt);
        if (!has_next) nxt = cur;
        if constexpr (GATHER) { if (has_next) { GE_GATHER_OFFS(gvn, nxt); } else {
#pragma unroll
            for (int h = 0; h < 2; ++h)
#pragma unroll
                for (int i = 0; i < 2; ++i) gvn[h][i] = gvc[h][i]; } }
#pragma unroll 1
        for (int t = 0; t < nt; t += 2) {
            const bool last = (t == nt - 2);
            const char* a1 = cur.a + (size_t)(t + 1) * kstepA;
            const char* a2 = last ? nxt.a : cur.a + (size_t)(t + 2) * kstepA;
            const char* b20 = last ? nxt.b0 : cur.b0 + (size_t)(t + 2) * kstep;
            const char* b21 = last ? nxt.b1 : cur.b1 + (size_t)(t + 2) * kstep;
            const char* a3 = a2 + kstepA; const char* b30 = b20 + kstep; const char* b31 = b21 + kstep;
            GE_LDB(B0, 0, 0); GE_SCHED; GE_LDA(At, 0, 0); GE_STAGE_A(GE_SA(1, 1), a1, 1, gvc);
            GE_WAIT_L(8); GE_BAR; GE_WAIT_L(0); GE_MMA(0, 0, At, B0); GE_BAR; GE_SCHED;
            GE_LDB(B1, 0, 1); GE_STAGE_B(GE_SB(0, 0), b20);
            GE_BAR; GE_WAIT_L(0); GE_MMA(0, 1, At, B1); GE_BAR;
            GE_LDA(At, 0, 1); GE_STAGE_A2(GE_SA(0, 0), a2, 0);
            GE_BAR; GE_WAIT_L(0); GE_MMA(1, 0, At, B0); GE_BAR; GE_SCHED;
            GE_STAGE_B(GE_SB(0, 1), b21);
            GE_WAIT_V(6); GE_BAR; GE_MMA(1, 1, At, B1); GE_BAR;
            GE_LDB(B0, 1, 0); GE_SCHED; GE_LDA(At, 1, 0); GE_STAGE_A2(GE_SA(0, 1), a2, 1);
            GE_WAIT_L(8); GE_BAR; GE_WAIT_L(0); GE_MMA(0, 0, At, B0); GE_BAR; GE_SCHED;
            GE_LDB(B1, 1, 1); GE_STAGE_B(GE_SB(1, 0), b30);
            GE_BAR; GE_WAIT_L(0); GE_MMA(0, 1, At, B1); GE_BAR;
            GE_LDA(At, 1, 1); GE_STAGE_A2(GE_SA(1, 0), a3, 0);
            GE_BAR; GE_WAIT_L(0); GE_MMA(1, 0, At, B0); GE_BAR; GE_SCHED;
            GE_STAGE_B(GE_SB(1, 1), b31);
            GE_WAIT_V(6); GE_BAR; GE_MMA(1, 1, At, B1); GE_BAR;
        }
        E(acc, cur, wr, wc, fr, fq);
        if (!has_next) break;
#pragma unroll
        for (int a = 0; a < 2; ++a)
#pragma unroll
            for (int b = 0; b < 2; ++b)
#pragma unroll
                for (int m = 0; m < 4; ++m)
#pragma unroll
                    for (int n = 0; n < 2; ++n) acc[a][b][m][n] = (f32x4){0.f, 0.f, 0.f, 0.f};
        cur = nxt; ++ui;
        if constexpr (GATHER) {
#pragma unroll
            for (int h = 0; h < 2; ++h)
#pragma unroll
                for (int i = 0; i < 2; ++i) gvc[h][i] = gvn[h][i]; }
    }
    GE_WAIT_V(0);
    if (wr == 0) GE_BAR;
    GE_BAR;
#undef GE_SA
#undef GE_SB
#undef GE_GLDS
#undef GE_STAGE_A
#undef GE_STAGE_A2
#undef GE_STAGE_B
#undef GE_LDA
#undef GE_LDB
#undef GE_MMA
#undef GE_WAIT_V
#undef GE_WAIT_L
#undef GE_BAR
#undef GE_SCHED
#undef GE_GATHER_OFFS
}
}
__device__ __forceinline__ unsigned cvt_pk_bf16(float lo, float hi) { unsigned r; asm volatile("v_cvt_pk_bf16_f32 %0, %1, %2" : "=v"(r) : "v"(lo), "v"(hi)); return r; }
__device__ __forceinline__ u32x4 pack8(const f32x4 a, const f32x4 b) { u32x4 w; w.x = cvt_pk_bf16(a[0], a[1]); w.y = cvt_pk_bf16(a[2], a[3]); w.z = cvt_pk_bf16(b[0], b[1]); w.w = cvt_pk_bf16(b[2], b[3]); return w; }
__device__ __forceinline__ void unpack8(const u32x4 w, f32x4& a, f32x4& b) {
    a[0] = __uint_as_float(w.x << 16); a[1] = __uint_as_float(w.x & 0xFFFF0000u); a[2] = __uint_as_float(w.y << 16); a[3] = __uint_as_float(w.y & 0xFFFF0000u);
    b[0] = __uint_as_float(w.z << 16); b[1] = __uint_as_float(w.z & 0xFFFF0000u); b[2] = __uint_as_float(w.w << 16); b[3] = __uint_as_float(w.w & 0xFFFF0000u); }
__device__ __forceinline__ float sigmoidf_fast(float v) { return 1.0f / (1.0f + __expf(-v)); }

struct SchedDense {
    const char* A; const char* B; size_t arb, brb; int nM, nN, G, c;
    __device__ __forceinline__ bool next(int i, ge::Unit& u) const {
        const int L = i * G + c; if (L >= nM * nN) return false;
        int pm, pn; ge::tile_order(L, nM, nN, pm, pn);
        u.pm = pm; u.pn = pn; u.kind = 0; u.rows = nullptr; u.nrows = 0;
        u.a = A + (size_t)pm * 256 * arb; u.b0 = B + (size_t)pn * 256 * brb; u.b1 = u.b0 + 128 * brb; return true;
    }
};
struct SchedInproj {
    const char* WtHy; const char* WtRest; const char* U; int G, c;
    __device__ __forceinline__ bool next(int i, ge::Unit& u) const {
        const int L = i * G + c; if (L >= 408 + 748) return false;
        int pm, pn; u.rows = nullptr; u.nrows = 0;
        if (L < 408) { ge::tile_order(L, 6, 68, pm, pn); u.kind = 0; u.a = WtHy + (size_t)pm * 256 * 2048; u.b0 = U + (size_t)pn * 256 * 2048; }
        else { ge::tile_order(L - 408, 68, 11, pm, pn); u.kind = 1; u.a = U + (size_t)pm * 256 * 2048; u.b0 = WtRest + (size_t)pn * 256 * 2048; }
        u.b1 = u.b0 + 128 * 2048; u.pm = pm; u.pn = pn; return true;
    }
};
struct EpiInproj {
    bf16_t* PT; bf16_t* PTc; bf16_t* G;
    __device__ __forceinline__ void operator()(const ge::Acc& acc, const ge::Unit& u, int wr, int wc, int fr, int fq) const {
#pragma unroll
        for (int ai = 0; ai < 2; ++ai)
#pragma unroll
            for (int m = 0; m < 4; ++m) {
                const int r = u.pm * 256 + ai * 128 + wr * 64 + m * 16 + fr;
#pragma unroll
                for (int bj = 0; bj < 2; ++bj) {
                    const int c0 = bj * 128 + wc * 32 + fq * 8;
                    if (u.kind == 0) {
                        bf16_t* dst = (u.pn < 64) ? PT + ((size_t)((u.pn >> 4) * HYC + r)) * SEQ + (u.pn & 15) * 256 + c0
                                                  : PTc + ((size_t)((u.pn - 64) * HYC + r)) * CTXL + c0;
                        *(u32x4*)dst = pack8(acc[ai][bj][m][0], acc[ai][bj][m][1]);
                    } else {
                        const int c = (u.pn - 3) * 256 + c0;
                        f32x4 a = acc[ai][bj][m][0], b = acc[ai][bj][m][1];
#pragma unroll
                        for (int j = 0; j < 4; ++j) { a[j] = sigmoidf_fast(a[j]); b[j] = sigmoidf_fast(b[j]); }
                        *(u32x4*)(G + (size_t)r * 2048 + c) = pack8(a, b);
                    }
                }
            }
    }
};
struct EpiQ {
    bf16_t* Q; bf16_t* Qc; const LAS float* rope;
    const LAS float* rs;
    __device__ __forceinline__ void operator()(const ge::Acc& acc, const ge::Unit& u, int wr, int wc, int fr, int fq) const {
#pragma unroll
        for (int ai = 0; ai < 2; ++ai)
#pragma unroll
            for (int m = 0; m < 4; ++m) {
                const int r = u.pm * 256 + ai * 128 + wr * 64 + m * 16 + fr;
                const bool lat = r < TL;
                const int t = lat ? (r & 4095) : ((r - TL) & 255);
                const int b = lat ? (r >> 12) : ((r - TL) >> 8);
#pragma unroll
                for (int bj = 0; bj < 2; ++bj) {
                    const int c = u.pn * 256 + bj * 128 + wc * 32 + fq * 8;
                    const int h = c / 96, dd = c - h * 96;
                    const float rsc = QSCALE * rs[ai * 128 + wr * 64 + m * 16 + fr];
                    f32x4 v0 = acc[ai][bj][m][0] * rsc, v1 = acc[ai][bj][m][1] * rsc;
                    f32x4 p0, p1;
#pragma unroll
                    for (int j = 0; j < 4; ++j) { p0[j] = shx(v0[j], 16); p1[j] = shx(v1[j], 16); }
                    bf16_t* qrow = lat ? Q + ((size_t)(b * NH + h) * SEQ + t) * 128 : Qc + ((size_t)(b * NH + h) * CTXL + t) * 128;
                    if (dd < 64) *(u32x4*)(qrow + dd) = pack8(v0, v1);
                    else {
                        const int d0 = dd - 64;
                        f32x4 o0 = v0, o1 = v1;
                        if (lat) {
                            const LAS float* rp = rope + 2 * ((d0 >> 4) ? 32 + (t & 63) * 8 : ((t >> 6) & 3) * 8);
                            const bool s1 = (d0 >> 3) & 1;
#pragma unroll
                            for (int j = 0; j < 4; ++j) {
                                const float cax = rp[2 * j], cay = rp[2 * j + 1], cbx = rp[8 + 2 * j], cby = rp[9 + 2 * j];
                                o0[j] = s1 ? p0[j] * cay + v0[j] * cax : v0[j] * cax - p0[j] * cay;
                                o1[j] = s1 ? p1[j] * cby + v1[j] * cbx : v1[j] * cbx - p1[j] * cby;
                            }
                        }
                        *(u32x4*)(qrow + 64 + d0) = pack8(o0, o1);
                        *(u32x4*)(qrow + 96 + d0) = pack8(v0, v1);
                    }
                }
            }
    }
};
struct EpiKV {
    bf16_t* K; bf16_t* V; const LAS float* rs;
    __device__ __forceinline__ void operator()(const ge::Acc& acc, const ge::Unit& u, int wr, int wc, int fr, int fq) const {
#pragma unroll
        for (int ai = 0; ai < 2; ++ai)
#pragma unroll
            for (int m = 0; m < 4; ++m) {
                const int r = u.pm * 256 + ai * 128 + wr * 64 + m * 16 + fr;
                int b, key;
                if (r < TL) { b = r >> 12; key = r & 4095; } else { b = (r - TL) >> 8; key = SEQ + ((r - TL) & 255); }
#pragma unroll
                for (int bj = 0; bj < 2; ++bj) {
                    const int c = u.pn * 256 + bj * 128 + wc * 32 + fq * 8;
                    const int h = c >> 7, d = c & 127;
                    const size_t kb = (size_t)(b * NH + h) * NKEY + key;
                    bf16_t* dst = (d < 64) ? K + kb * DQK + d : V + kb * DV + (d - 64);
                    const float rk = rs[ai * 128 + wr * 64 + m * 16 + fr]; *(u32x4*)dst = pack8(acc[ai][bj][m][0] * rk, acc[ai][bj][m][1] * rk);
                }
            }
    }
};

constexpr int LDS_SSQ = ge::STAGE_BYTES + 2048;
struct EpiInprojMLA {
    bf16_t* PMLAb; bf16_t* K; const float2* rope; LAS float* ssq;
    __device__ __forceinline__ void operator()(const ge::Acc& acc, const ge::Unit& u, int wr, int wc, int fr, int fq) const {
#pragma unroll
        for (int ai = 0; ai < 2; ++ai)
#pragma unroll
            for (int m = 0; m < 4; ++m) {
                const int rl = ai * 128 + wr * 64 + m * 16 + fr, r = u.pm * 256 + rl;
#pragma unroll
                for (int bj = 0; bj < 2; ++bj) {
                    const int c0 = bj * 128 + wc * 32 + fq * 8;
                    const f32x4 a = acc[ai][bj][m][0], b = acc[ai][bj][m][1];
                    const bool isval = (u.pn < 2) || (bj == 0);
                    const bool isrope = (u.pn == 2) && (bj == 1) && (wc == 0);
                    if (isval) {
                        const int col = (u.pn == 0 ? 0 : (u.pn == 1 ? 256 : 512)) + c0;
                        *(u32x4*)(PMLAb + (size_t)r * 640 + col) = pack8(a, b);
                        float sq = (a[0] * a[0] + a[1] * a[1]) + (a[2] * a[2] + a[3] * a[3]) + (b[0] * b[0] + b[1] * b[1]) + (b[2] * b[2] + b[3] * b[3]);
                        sq += shx(sq, 16); sq += shx(sq, 32);
                        if (fq == 0) ssq[rl * 16 + (u.pn == 2 ? 8 : 0) + bj * 4 + wc] = sq;
                    } else if (isrope) {
                        f32x4 pa, pb;
#pragma unroll
                        for (int j = 0; j < 4; ++j) { pa[j] = shx(a[j], 16); pb[j] = shx(b[j], 16); }
                        int bb, key; f32x4 oa = a, ob = b;
                        if (r < TL) {
                            bb = r >> 12; key = r & 4095;
                            const float2* rp = rope + (size_t)key * 16 + (fq >> 1) * 8;
#pragma unroll
                            for (int j = 0; j < 4; ++j) { const float2 ca = rp[j], cb = rp[4 + j];
                                oa[j] = (fq & 1) ? pa[j] * ca.y + a[j] * ca.x : a[j] * ca.x - pa[j] * ca.y;
                                ob[j] = (fq & 1) ? pb[j] * cb.y + b[j] * cb.x : b[j] * cb.x - pb[j] * cb.y; }
                        } else { bb = (r - TL) >> 8; key = SEQ + ((r - TL) & 255); }
                        const u32x4 w = pack8(oa, ob);
#pragma unroll
                        for (int h = 0; h < NH; ++h) *(u32x4*)(K + ((size_t)(bb * NH + h) * NKEY + key) * DQK + 64 + fq * 8) = w;
                    }
                }
            }
    }
};
struct SchedChainIn {
    const char* U; const char* WtRest; int pm, pn0, npn;
    __device__ __forceinline__ bool next(int i, ge::Unit& u) const {
        if (i >= npn) return false;
        u.pm = pm; u.pn = pn0 + i; u.kind = 1; u.rows = nullptr; u.nrows = 0;
        u.a = U + (size_t)pm * 256 * 2048; u.b0 = WtRest + (size_t)u.pn * 256 * 2048; u.b1 = u.b0 + 128 * 2048; return true;
    }
};
struct SchedPanel {
    const char* A; const char* B; size_t arb, brb; int pm, nN, kind;
    __device__ __forceinline__ bool next(int i, ge::Unit& u) const {
        if (i >= nN) return false;
        u.pm = pm; u.pn = i; u.kind = kind; u.rows = nullptr; u.nrows = 0;
        u.a = A + (size_t)pm * 256 * arb; u.b0 = B + (size_t)i * 256 * brb; u.b1 = u.b0 + 128 * brb; return true;
    }
};
struct SchedPool {
    const char* WtHy; const char* WtRest; const char* U; int first, step, n;
    __device__ __forceinline__ bool next(int i, ge::Unit& u) const {
        if (i >= n) return false;
        const int X = first + i * step; int pm, pn; u.rows = nullptr; u.nrows = 0;
        if (X < 408) { ge::tile_order(X, 6, 68, pm, pn); u.kind = 0; u.a = WtHy + (size_t)pm * 256 * 2048; u.b0 = U + (size_t)pn * 256 * 2048; }
        else { ge::tile_order(X - 408, 68, 8, pm, pn); pn += 3; u.kind = 1; u.a = U + (size_t)pm * 256 * 2048; u.b0 = WtRest + (size_t)pn * 256 * 2048; }
        u.b1 = u.b0 + 128 * 2048; u.pm = pm; u.pn = pn; return true;
    }
};
struct EpiQKV {
    EpiQ q; EpiKV kv;
    __device__ __forceinline__ void operator()(const ge::Acc& acc, const ge::Unit& u, int wr, int wc, int fr, int fq) const { if (u.kind == 0) q(acc, u, wr, wc, fr, fq); else kv(acc, u, wr, wc, fr, fq); }
};
struct SchedMerge {
    const char* Yhy; const char* Yatt; const char* Whyo; const char* Wmlao; int G, c, nM;
    __device__ __forceinline__ bool next(int i, ge::Unit& u) const {
        const int T = (i >> 1) * G + c; if (T >= nM * 4) return false;
        const int seg = i & 1; int pm, pn; ge::tile_order(T, nM, 4, pm, pn);
        u.pm = pm; u.pn = pn; u.kind = seg; u.rows = nullptr; u.nrows = 0;
        u.a = (seg ? Yatt : Yhy) + (size_t)pm * 256 * 16; u.b0 = (seg ? Wmlao : Whyo) + (size_t)pn * 256 * 1024; u.b1 = u.b0 + 128 * 1024; return true;
    }
};
struct EpiMerge {
    const bf16_t* G; bf16_t* M1;
    __device__ __forceinline__ void operator()(const ge::Acc& acc, const ge::Unit& u, int wr, int wc, int fr, int fq) const {
#pragma unroll
        for (int ai = 0; ai < 2; ++ai) {
            u32x4 gv[4][2], mv[4][2];
#pragma unroll
            for (int m = 0; m < 4; ++m) {
                const int r = u.pm * 256 + ai * 128 + wr * 64 + m * 16 + fr;
#pragma unroll
                for (int bj = 0; bj < 2; ++bj) {
                    const int c = u.pn * 256 + bj * 128 + wc * 32 + fq * 8;
                    gv[m][bj] = *(const u32x4*)(G + (size_t)r * 2048 + u.kind * DM + c);
                    if (u.kind) mv[m][bj] = *(const u32x4*)(M1 + (size_t)r * DM + c);
                }
            }
#pragma unroll
            for (int m = 0; m < 4; ++m) {
                const int r = u.pm * 256 + ai * 128 + wr * 64 + m * 16 + fr;
#pragma unroll
                for (int bj = 0; bj < 2; ++bj) {
                    const int c = u.pn * 256 + bj * 128 + wc * 32 + fq * 8;
                    f32x4 g0, g1; unpack8(gv[m][bj], g0, g1);
                    f32x4 o0 = g0 * acc[ai][bj][m][0], o1 = g1 * acc[ai][bj][m][1];
                    if (u.kind) { f32x4 q0, q1; unpack8(mv[m][bj], q0, q1); o0 += q0; o1 += q1; }
                    *(u32x4*)(M1 + (size_t)r * DM + c) = pack8(o0, o1);
                }
            }
        }
    }
};
struct EpiOut {
    float* hx; const float* mod;
    __device__ __forceinline__ void operator()(const ge::Acc& acc, const ge::Unit& u, int wr, int wc, int fr, int fq) const {
        const int b = u.pm < 64 ? (u.pm >> 4) : 4;
        f32x4 gg[2][2];
#pragma unroll
        for (int bj = 0; bj < 2; ++bj) { const float* g = mod + (size_t)b * NMOD + 2 * DM + u.pn * 256 + bj * 128 + wc * 32 + fq * 8; gg[bj][0] = *(const f32x4*)g; gg[bj][1] = *(const f32x4*)(g + 4); }
#pragma unroll
        for (int ai = 0; ai < 2; ++ai) {
            f32x4 hv[4][2][2];
#pragma unroll
            for (int m = 0; m < 4; ++m) {
                const int r = u.pm * 256 + ai * 128 + wr * 64 + m * 16 + fr;
#pragma unroll
                for (int bj = 0; bj < 2; ++bj) { const float* src = hx + (size_t)r * DM + u.pn * 256 + bj * 128 + wc * 32 + fq * 8; hv[m][bj][0] = *(const f32x4*)src; hv[m][bj][1] = *(const f32x4*)(src + 4); }
            }
#pragma unroll
            for (int m = 0; m < 4; ++m) {
                const int r = u.pm * 256 + ai * 128 + wr * 64 + m * 16 + fr;
#pragma unroll
                for (int bj = 0; bj < 2; ++bj) {
                    float* dst = hx + (size_t)r * DM + u.pn * 256 + bj * 128 + wc * 32 + fq * 8;
                    *(f32x4*)dst = hv[m][bj][0] + gg[bj][0] * acc[ai][bj][m][0];
                    *(f32x4*)(dst + 4) = hv[m][bj][1] + gg[bj][1] * acc[ai][bj][m][1];
                }
            }
        }
    }
};
struct SchedGU {
    const char* U; const char* WtG; const char* WtU; const int* list; const LAS int* tpre; const LAS int* cntl; int G, c;
    __device__ __forceinline__ bool next(int i, ge::Unit& u) const {
        const int L = i * G + c; if (L >= 2 * tpre[64]) return false;
        const int rt = L >> 1, half = L & 1; int e = 0;
#pragma unroll
        for (int st_ = 32; st_ > 0; st_ >>= 1) { if (tpre[e + st_] <= rt) e += st_; }
        u.kind = e; u.pm = rt - tpre[e]; u.pn = half; u.rows = list + (size_t)e * CAP; u.nrows = cntl[e];
        u.a = U; u.b0 = WtG + ((size_t)e * DE + half * 128) * 2048; u.b1 = WtU + ((size_t)e * DE + half * 128) * 2048; return true;
    }
};
struct EpiGU {
    bf16_t* H; const LAS int* offs;
    __device__ __forceinline__ void operator()(const ge::Acc& acc, const ge::Unit& u, int wr, int wc, int fr, int fq) const {
        const int o = offs[u.kind];
#pragma unroll
        for (int ai = 0; ai < 2; ++ai)
#pragma unroll
            for (int m = 0; m < 4; ++m) {
                const int r = u.pm * 256 + ai * 128 + wr * 64 + m * 16 + fr;
                if (r < u.nrows) {
                    const int c = u.pn * 128 + wc * 32 + fq * 8;
                    f32x4 g0 = acc[ai][0][m][0], g1 = acc[ai][0][m][1];
#pragma unroll
                    for (int j = 0; j < 4; ++j) { g0[j] = g0[j] * sigmoidf_fast(g0[j]) * acc[ai][1][m][0][j]; g1[j] = g1[j] * sigmoidf_fast(g1[j]) * acc[ai][1][m][1][j]; }
                    *(u32x4*)(H + (size_t)(o + r) * DE + c) = pack8(g0, g1);
                }
            }
    }
};
struct SchedDown {
    const char* H; const char* WtD; const LAS int* tpre; const LAS int* cntl; const LAS int* offs; int G, c;
    __device__ __forceinline__ bool next(int i, ge::Unit& u) const {
        const int L = i * G + c; if (L >= 4 * tpre[64]) return false;
        const int rt = L >> 2, pn = L & 3; int e = 0;
#pragma unroll
        for (int st_ = 32; st_ > 0; st_ >>= 1) { if (tpre[e + st_] <= rt) e += st_; }
        u.kind = e; u.pm = rt - tpre[e]; u.pn = pn; u.rows = nullptr; u.nrows = cntl[e];
        u.a = H + ((size_t)offs[e] + (size_t)u.pm * 256) * 512; u.b0 = WtD + ((size_t)e * DM + pn * 256) * 512; u.b1 = u.b0 + 128 * 512; return true;
    }
};
struct EpiDown {
    bf16_t* Y; const float* wl; const LAS int* offs;
    __device__ __forceinline__ void operator()(const ge::Acc& acc, const ge::Unit& u, int wr, int wc, int fr, int fq) const {
        const int o = offs[u.kind];
        float w[2][4];
#pragma unroll
        for (int ai = 0; ai < 2; ++ai)
#pragma unroll
            for (int m = 0; m < 4; ++m) { const int r = u.pm * 256 + ai * 128 + wr * 64 + m * 16 + fr; w[ai][m] = wl[(size_t)u.kind * CAP + (r < u.nrows ? r : 0)]; }
#pragma unroll
        for (int ai = 0; ai < 2; ++ai)
#pragma unroll
            for (int m = 0; m < 4; ++m) {
                const int r = u.pm * 256 + ai * 128 + wr * 64 + m * 16 + fr;
                if (r < u.nrows) {
#pragma unroll
                    for (int bj = 0; bj < 2; ++bj) {
                        const int c = u.pn * 256 + bj * 128 + wc * 32 + fq * 8;
                        *(u32x4*)(Y + (size_t)(o + r) * DM + c) = pack8(acc[ai][bj][m][0] * w[ai][m], acc[ai][bj][m][1] * w[ai][m]);
                    }
                }
            }
    }
};


typedef short s16x4 __attribute__((ext_vector_type(4)));
#define AT_THR 8.0f
__device__ __forceinline__ void ph_attn2(const P& p, char* smem, bool with_ctx) {
    constexpr int KS = 112, VS = 80;
    constexpr int NSTG = NKEY / 128;
    bf16_t* sK = (bf16_t*)smem;
    bf16_t* sV = sK + 3 * 128 * KS;
    const int tid = tid_opaque(), lane = tid & 63, wv = tid >> 6, fr = lane & 15, g = lane >> 4;
    const int NUL = NB * NH * 16, NUC = with_ctx ? NB * NH : 0;
    const int kc0 = tid / 12, kp0 = tid % 12, kc1 = (512 + tid) / 12, kp1 = (512 + tid) % 12;
    const int vk = tid >> 3, vp = tid & 7;
#define AT_LOADK(st_, hs_) do { const bf16_t* kb_ = Kp + (size_t)((st_) * 128 + (hs_) * 64) * DQK; kr0 = *(const u32x4*)(kb_ + kc0 * DQK + kp0 * 8); if (tid < 256) kr1 = *(const u32x4*)(kb_ + kc1 * DQK + kp1 * 8); } while (0)
#define AT_LOADV(st_, hs_) do { vr0 = *(const u32x4*)(Vp + (size_t)((st_) * 128 + (hs_) * 64) * DV + vk * DV + vp * 8); } while (0)
#define AT_STOREK(buf_, hs_) do { bf16_t* d_ = sK + ((buf_) * 128 + (hs_) * 64) * KS; *(u32x4*)(d_ + kc0 * KS + kp0 * 8) = kr0; if (tid < 256) *(u32x4*)(d_ + kc1 * KS + kp1 * 8) = kr1; } while (0)
#define AT_STOREV(buf_, hs_) do { *(u32x4*)(sV + ((buf_) * 128 + (hs_) * 64) * VS + vk * VS + vp * 8) = vr0; } while (0)
#define AT_LDKF(dst, mk) do { _Pragma("unroll") for (int ks = 0; ks < 3; ++ks) dst[ks] = *(const bf16x8*)(sKn + (mk) * 16 * KS + ks * 32); } while (0)
#define AT_MMAS(src, mk) do { sN[mk][0] = (f32x4){0.f, 0.f, 0.f, 0.f}; sN[mk][1] = (f32x4){0.f, 0.f, 0.f, 0.f}; \
        _Pragma("unroll") for (int ks = 0; ks < 3; ++ks) _Pragma("unroll") for (int nq = 0; nq < 2; ++nq) { const bf16x8 bq_ = (ks < 2) ? qf[nq][ks] : (ctxn ? qf[nq][3] : qf[nq][2]); \
            sN[mk][nq] = __builtin_amdgcn_mfma_f32_16x16x32_bf16(src[ks], bq_, sN[mk][nq], 0, 0, 0); } } while (0)
#define AT_EXPS(nq) do { float r_ = (nq) ? rs[0] - rs[0] : 0.f; _Pragma("unroll") for (int mk = 0; mk < 4; ++mk) _Pragma("unroll") for (int r = 0; r < 4; ++r) { const float pv = __builtin_amdgcn_exp2f(sC[mk][nq][r] - mn[nq]); r_ += pv; sC[mk][nq][r] = pv; } rs[nq] = r_; } while (0)
#define AT_SUBTILE(sKn_, ctxn_, sVb_) do { \
        const bf16_t* sKn = (sKn_) + fr * KS + g * 8; const bool ctxn = (ctxn_); \
        bf16x8 kfA[3], kfB[3]; bf16x8 pf[2][2]; float mn[2], mxq[2], rs[2]; \
        AT_LDKF(kfA, 0); \
        AT_MMAS(kfA, 0); AT_LDKF(kfB, 1); \
        _Pragma("unroll") for (int nq = 0; nq < 2; ++nq) { float mx = sC[0][nq][0]; \
            _Pragma("unroll") for (int mk = 0; mk < 4; ++mk) _Pragma("unroll") for (int r = 0; r < 4; ++r) mx = fmaxf(mx, sC[mk][nq][r]); \
            mxq[nq] = rowmax4(mx); } \
          \
          \
        if (__any((mxq[0] - m[0] > AT_THR) || (mxq[1] - m[1] > AT_THR))) { \
            _Pragma("unroll") for (int nq = 0; nq < 2; ++nq) { const float mnew_ = fmaxf(m[nq], mxq[nq]); const float a_ = __builtin_amdgcn_exp2f(m[nq] - mnew_); m[nq] = mnew_; lsum[nq] *= a_; \
                _Pragma("unroll") for (int md = 0; md < 4; ++md) oT[md][nq] *= a_; } } \
        mn[0] = m[0]; mn[1] = m[1]; \
        __builtin_amdgcn_sched_barrier(0); \
        AT_MMAS(kfB, 1); AT_LDKF(kfA, 2); AT_EXPS(0); \
        __builtin_amdgcn_sched_barrier(0); \
        AT_MMAS(kfA, 2); AT_LDKF(kfB, 3); AT_EXPS(1); \
        __builtin_amdgcn_sched_barrier(0); \
        AT_MMAS(kfB, 3); \
        _Pragma("unroll") for (int nq = 0; nq < 2; ++nq) { lsum[nq] += rs[nq]; \
            _Pragma("unroll") for (int kp = 0; kp < 2; ++kp) { const u32x4 w_ = pack8(sC[2 * kp][nq], sC[2 * kp + 1][nq]); pf[kp][nq] = __builtin_bit_cast(bf16x8, w_); } } \
        __builtin_amdgcn_sched_barrier(0); \
        _Pragma("unroll") for (int kp = 0; kp < 2; ++kp) _Pragma("unroll") for (int md = 0; md < 4; ++md) { \
            const bf16_t* a0_ = (sVb_) + (32 * kp + 4 * g + (fr >> 2)) * VS + 16 * md + 4 * (fr & 3); \
            const s16x4 lo_ = __builtin_amdgcn_ds_read_tr16_b64_v4i16((LAS s16x4*)a0_); \
            const s16x4 hi_ = __builtin_amdgcn_ds_read_tr16_b64_v4i16((LAS s16x4*)(a0_ + 16 * VS)); \
            const bf16x8 vf_ = __builtin_shufflevector(lo_, hi_, 0, 1, 2, 3, 4, 5, 6, 7); \
            _Pragma("unroll") for (int nq = 0; nq < 2; ++nq) oT[md][nq] = __builtin_amdgcn_mfma_f32_16x16x32_bf16(vf_, pf[kp][nq], oT[md][nq], 0, 0, 0); } \
        _Pragma("unroll") for (int mk = 0; mk < 4; ++mk) { sC[mk][0] = sN[mk][0]; sC[mk][1] = sN[mk][1]; } \
    } while (0)
    for (int u = blockIdx.x; u < NUL + NUC; u += gridDim.x) {
        const bool isctx = u >= NUL;
        int b, h, q0;
        if (!isctx) {
            int bh, qb;
            if (gridDim.x == 256) { const int c = u & 255, r = u >> 8, x = c & 7, sl = c >> 3; bh = r * 16 + x * 2 + (sl >> 4); qb = sl & 15; } else { bh = u / 16; qb = u % 16; }
            b = bh / NH; h = bh % NH; q0 = qb * 256;
        } else { const int v = u - NUL; b = v / NH; h = v % NH; q0 = 0; }
        const bf16_t* Qp = (isctx ? p.Qc + ((size_t)(b * NH + h) * CTXL + q0) * 128 : p.Q + ((size_t)(b * NH + h) * SEQ + q0) * 128) + (size_t)(wv * 32) * 128;
        bf16x8 qf[2][4];
#pragma unroll
        for (int nq = 0; nq < 2; ++nq)
#pragma unroll
            for (int ks = 0; ks < 4; ++ks) qf[nq][ks] = *(const bf16x8*)(Qp + (size_t)(nq * 16 + fr) * 128 + ks * 32 + g * 8);
        const bf16_t* Kp = p.K + (size_t)(b * NH + h) * NKEY * DQK;
        const bf16_t* Vp = p.V + (size_t)(b * NH + h) * NKEY * DV;
        f32x4 oT[4][2]; float m[2], lsum[2];
#pragma unroll
        for (int nq = 0; nq < 2; ++nq) { m[nq] = -INFINITY; lsum[nq] = 0.f;
#pragma unroll
            for (int md = 0; md < 4; ++md) oT[md][nq] = (f32x4){0.f, 0.f, 0.f, 0.f}; }
        const int st0 = isctx ? 32 : 0;
        u32x4 kr0, kr1 = (u32x4){0u, 0u, 0u, 0u}, vr0;
        f32x4 sC[4][2], sN[4][2];
        __syncthreads();
        AT_LOADK(st0, 0); AT_LOADV(st0, 0); AT_STOREK(0, 0); AT_STOREV(0, 0);
        AT_LOADK(st0, 1); AT_LOADV(st0, 1); AT_STOREK(0, 1); AT_STOREV(0, 1);
        AT_LOADK(st0 + 1, 0); AT_STOREK(1, 0);
        AT_LOADK(st0 + 1, 1);
        __syncthreads();
        {
            const bf16_t* sKn = sK + fr * KS + g * 8; const bool ctxn = st0 >= 32;
            bf16x8 kfA[3];
#pragma unroll
            for (int mk = 0; mk < 4; ++mk) { AT_LDKF(kfA, mk); AT_MMAS(kfA, mk); }
#pragma unroll
            for (int mk = 0; mk < 4; ++mk) { sC[mk][0] = sN[mk][0]; sC[mk][1] = sN[mk][1]; }
        }
        AT_STOREK(1, 1);
        __syncthreads();
        int kb = 0;
        for (int st = st0; st < NSTG; ++st) {
            const int bufc = (st - st0) & 1;
            const int st1 = st + 1 < NSTG ? st + 1 : NSTG - 1, st2 = st + 2 < NSTG ? st + 2 : NSTG - 1;
            const int kb1 = kb == 2 ? 0 : kb + 1, kb2 = kb1 == 2 ? 0 : kb1 + 1;
            const bf16_t* sKc = sK + kb * 128 * KS; const bf16_t* sKx = sK + kb1 * 128 * KS; const bf16_t* sVc = sV + bufc * 128 * VS;
            AT_LOADK(st2, 0); AT_LOADV(st1, 0);
            AT_SUBTILE(sKc + 64 * KS, st >= 32, sVc);
            AT_STOREK(kb2, 0); AT_STOREV(bufc ^ 1, 0);
            AT_LOADK(st2, 1); AT_LOADV(st1, 1);
            AT_SUBTILE(sKx, st1 >= 32, sVc + 64 * VS);
            AT_STOREK(kb2, 1); AT_STOREV(bufc ^ 1, 1);
            __syncthreads();
            kb = kb1;
        }
        const size_t rbase = (isctx ? (size_t)TL + b * CTXL : (size_t)b * SEQ) + q0 + wv * 32;
#pragma unroll
        for (int nq = 0; nq < 2; ++nq) {
            const float l = rowsum4(lsum[nq]);
            const float inv = 1.0f / l;
#pragma unroll
            for (int md = 0; md < 4; ++md) {
                u32x2 o; o.x = cvt_pk_bf16(oT[md][nq][0] * inv, oT[md][nq][1] * inv); o.y = cvt_pk_bf16(oT[md][nq][2] * inv, oT[md][nq][3] * inv);
                *(u32x2*)(p.Yatt + ((size_t)(h * 8 + md * 2 + (g >> 1)) * TT + rbase + nq * 16 + fr) * 8 + 4 * (g & 1)) = o;
            }
        }
    }
#undef AT_LOADK
#undef AT_LOADV
#undef AT_STOREK
#undef AT_STOREV
#undef AT_LDKF
#undef AT_MMAS
#undef AT_EXPS
#undef AT_SUBTILE
}

constexpr int RT_PITCH = 1024 + 8;
__device__ __forceinline__ void ph_norm2_router(const P& p, int l, char* smem, int nrows_total) {
    bf16_t* thi = (bf16_t*)smem;
    bf16_t* tlo = thi + 16 * RT_PITCH;
    float* part = (float*)(tlo + 16 * RT_PITCH);
    float* lgs = part + 8 * 16 * 80;
    const int tid = tid_opaque(), lane = tid & 63, wv = tid >> 6, fr = lane & 15, g = lane >> 4;
    const float* ng = p.norm2_g + l * DM;
    const bf16_t* whi = p.WrT + (size_t)(l * 2 + 0) * 80 * DM; const bf16_t* wlo = p.WrT + (size_t)(l * 2 + 1) * 80 * DM;
    bf16x8 bh[4][5];
#pragma unroll
    for (int ks = 0; ks < 4; ++ks)
#pragma unroll
        for (int nt = 0; nt < 5; ++nt) { const size_t o = (size_t)(nt * 16 + fr) * DM + wv * 128 + ks * 32 + g * 8; bh[ks][nt] = *(const bf16x8*)(whi + o); }
    float* bias_s = lgs + 16 * 80;
    float* recs = bias_s + 80;
    int nrec = 0;
    if (tid < 72) bias_s[tid] = tid < 64 ? p.b_re[l * NE + tid] : p.b_rg[l * 8 + tid - 64];
    for (int rb = blockIdx.x * 16; rb < nrows_total; rb += gridDim.x * 16) {
        __syncthreads();
        {
            const int lr0 = wv * 2, row0 = rb + lr0;
            const int b = row0 < TL ? (row0 >> 12) : 4;
            const float* hp = p.hx + (size_t)row0 * DM;
            const float* md = p.mod + ((size_t)l * 5 + b) * NMOD + 3 * DM;
            float4 xv[2][4], gg4[4], sh4[4], sc4[4];
#pragma unroll
            for (int i = 0; i < 4; ++i) { const int j = i * 256 + lane * 4; xv[0][i] = *(const float4*)(hp + j); xv[1][i] = *(const float4*)(hp + DM + j); gg4[i] = *(const float4*)(ng + j); sh4[i] = *(const float4*)(md + j); sc4[i] = *(const float4*)(md + DM + j); }
            float ss0 = 0.f, ss1 = 0.f;
#pragma unroll
            for (int i = 0; i < 4; ++i) { ss0 += xv[0][i].x * xv[0][i].x + xv[0][i].y * xv[0][i].y + xv[0][i].z * xv[0][i].z + xv[0][i].w * xv[0][i].w;
                                          ss1 += xv[1][i].x * xv[1][i].x + xv[1][i].y * xv[1][i].y + xv[1][i].z * xv[1][i].z + xv[1][i].w * xv[1][i].w; }
#pragma unroll
            for (int o = 32; o > 0; o >>= 1) { ss0 += shx(ss0, o); ss1 += shx(ss1, o); }
            const float rs2[2] = {rsqrtf(ss0 * (1.0f / DM) + epsf()), rsqrtf(ss1 * (1.0f / DM) + epsf())};
#pragma unroll
            for (int i = 0; i < 4; ++i) {
                const int j = i * 256 + lane * 4;
                const float4 gg = gg4[i], sh = sh4[i], sc = sc4[i];
#pragma unroll
                for (int rr = 0; rr < 2; ++rr) {
                    const int lr = lr0 + rr; const float rs = rs2[rr];
                    float y[4];
                    y[0] = (xv[rr][i].x * rs * gg.x) * (1.f + sc.x) + sh.x; y[1] = (xv[rr][i].y * rs * gg.y) * (1.f + sc.y) + sh.y;
                    y[2] = (xv[rr][i].z * rs * gg.z) * (1.f + sc.z) + sh.z; y[3] = (xv[rr][i].w * rs * gg.w) * (1.f + sc.w) + sh.w;
                    bf16_t h[4], lo[4];
#pragma unroll
                    for (int e = 0; e < 4; ++e) { h[e] = f2bf(y[e]); lo[e] = f2bf(y[e] - bf2f(h[e])); }
                    u32x2 oh; oh.x = (unsigned)h[0] | ((unsigned)h[1] << 16); oh.y = (unsigned)h[2] | ((unsigned)h[3] << 16);
                    u32x2 ol; ol.x = (unsigned)lo[0] | ((unsigned)lo[1] << 16); ol.y = (unsigned)lo[2] | ((unsigned)lo[3] << 16);
                    *(u32x2*)(p.U + (size_t)(row0 + rr) * DM + j) = oh;
                    *(u32x2*)(thi + lr * RT_PITCH + j) = oh; *(u32x2*)(tlo + lr * RT_PITCH + j) = ol;
                }
            }
        }
        __syncthreads();
        f32x4 acc[5];
#pragma unroll
        for (int nt = 0; nt < 5; ++nt) acc[nt] = (f32x4){0.f, 0.f, 0.f, 0.f};
#pragma unroll
        for (int ks = 0; ks < 4; ++ks) {
            const int k0 = wv * 128 + ks * 32 + g * 8;
            const bf16x8 ah = *(const bf16x8*)(thi + fr * RT_PITCH + k0), al = *(const bf16x8*)(tlo + fr * RT_PITCH + k0);
#pragma unroll
            for (int nt = 0; nt < 5; ++nt) {
                const bf16x8 blf = *(const bf16x8*)(wlo + (size_t)(nt * 16 + fr) * DM + k0);
                acc[nt] = __builtin_amdgcn_mfma_f32_16x16x32_bf16(ah, bh[ks][nt], acc[nt], 0, 0, 0);
                acc[nt] = __builtin_amdgcn_mfma_f32_16x16x32_bf16(al, bh[ks][nt], acc[nt], 0, 0, 0);
                acc[nt] = __builtin_amdgcn_mfma_f32_16x16x32_bf16(ah, blf, acc[nt], 0, 0, 0);
            }
        }
#pragma unroll
        for (int nt = 0; nt < 5; ++nt)
#pragma unroll
            for (int r = 0; r < 4; ++r) part[(wv * 16 + g * 4 + r) * 80 + nt * 16 + fr] = acc[nt][r];
        __syncthreads();
        for (int i = tid; i < 16 * 80; i += NT) { float a = 0.f;
#pragma unroll
            for (int w = 0; w < 8; ++w) a += part[w * 16 * 80 + i];
            lgs[i] = a; }
        __syncthreads();
        if (tid < 128) {
            const int lrw = tid >> 3, i = tid & 7, row = rb + lrw;
            const float* le = lgs + lrw * 80; const float* lg = le + 64;
            const float* bre = bias_s; const float* brg = bias_s + 64;
            const float lgi = lg[i];
            float bv = lgi + brg[i]; int bi = i; float mx = lgi;
#pragma unroll
            for (int o = 1; o < 8; o <<= 1) { const float ov = shx(bv, o); const int oi = shx(bi, o); if (ov > bv || (ov == bv && oi < bi)) { bv = ov; bi = oi; } mx = fmaxf(mx, shx(mx, o)); }
            const int gs = bi;
            float den = __expf(lgi - mx);
#pragma unroll
            for (int o = 1; o < 8; o <<= 1) den += shx(den, o);
            const float pg = __expf(lg[gs] - mx) / den;
            const float lei = le[gs * 8 + i];
            float k0v = lei + bre[gs * 8 + i]; int k0i = i;
            const float keyi = k0v;
#pragma unroll
            for (int o = 1; o < 8; o <<= 1) { const float ov = shx(k0v, o); const int oi = shx(k0i, o); if (ov > k0v || (ov == k0v && oi < k0i)) { k0v = ov; k0i = oi; } }
            const int i0 = k0i;
            float k1v = (i == i0) ? -INFINITY : keyi; int k1i = (i == i0) ? 8 : i;
#pragma unroll
            for (int o = 1; o < 8; o <<= 1) { const float ov = shx(k1v, o); const int oi = shx(k1i, o); if (ov > k1v || (ov == k1v && oi < k1i)) { k1v = ov; k1i = oi; } }
            const int i1 = k1i;
            if (i == 0) {
                const float w0 = 1.0f / (1.0f + __expf(le[gs * 8 + i1] - le[gs * 8 + i0])), w1 = 1.0f - w0;
                float* rc = recs + (nrec * 16 + lrw) * 4;
                rc[0] = __int_as_float((gs * 8 + i0) | ((gs * 8 + i1) << 8)); rc[1] = pg * w0; rc[2] = pg * w1; rc[3] = __int_as_float(row);
            }
        }
        ++nrec;
    }
    __syncthreads();
    for (int q = tid; q < nrec * 16; q += NT) {
        const float* rc = recs + q * 4;
        const int ee = __float_as_int(rc[0]), e0 = ee & 255, e1 = ee >> 8, row = __float_as_int(rc[3]);
        const int r0 = atomicAdd(p.cnt + (l * NE + e0) * 64, 1), r1 = atomicAdd(p.cnt + (l * NE + e1) * 64, 1);
        p.list[(size_t)e0 * CAP + r0] = row; p.wl[(size_t)e0 * CAP + r0] = rc[1];
        p.list[(size_t)e1 * CAP + r1] = row; p.wl[(size_t)e1 * CAP + r1] = rc[2];
        *(int4*)(p.asg + (size_t)row * 4) = make_int4(e0, r0, e1, r1);
    }
    __syncthreads();
}

typedef float v2f __attribute__((ext_vector_type(2)));
#define HD __device__ __forceinline__
HD v2f vfma(v2f a, v2f b, v2f c) { return __builtin_elementwise_fma(a, b, c); }
HD v2f twk(v2f w) { return w.yy * (v2f){-1.f, 1.f}; }
HD v2f cmulk(v2f a, v2f w, v2f wk) { return vfma(a.yx, wk, a * w.xx); }
HD v2f cmulck(v2f a, v2f w, v2f wk) { return vfma(a.yx, -wk, a * w.xx); }
HD v2f cmul(v2f a, v2f w) { return cmulk(a, w, twk(w)); }
HD v2f cmulc(v2f a, v2f w) { return cmulck(a, w, twk(w)); }
HD int fphys(int i) { return (i >> 8) * 272 + ((i >> 4) & 15) * 17 + (i & 15); }
constexpr int FBUF = 4352;
template <bool INV> HD void dft4(v2f& x0, v2f& x1, v2f& x2, v2f& x3) {
    const v2f s02 = x0 + x2, d02 = x0 - x2, s13 = x1 + x3, d13 = x1 - x3;
    const v2f kj = INV ? (v2f){-1.f, 1.f} : (v2f){1.f, -1.f};
    x0 = s02 + s13; x2 = s02 - s13; x1 = vfma(d13.yx, kj, d02); x3 = vfma(d13.yx, -kj, d02);
}
template <bool INV> HD void dft16(v2f (&v)[16]) {
#pragma unroll
    for (int b = 0; b < 4; ++b) dft4<INV>(v[b], v[4 + b], v[8 + b], v[12 + b]);
    float C1 = 0.92387953251128674f, S1 = 0.38268343236508977f, C2 = 0.70710678118654752f;
    asm volatile("" : "+v"(C1), "+v"(S1), "+v"(C2));
#define TW(idx, cr, ci) v[idx] = vfma(v[idx].yx, INV ? (v2f){(ci), -(ci)} : (v2f){-(ci), (ci)}, v[idx] * (v2f){(cr), (cr)})
    TW(4 * 1 + 1, C1, -S1);
    TW(4 * 1 + 2, C2, -C2);
    TW(4 * 1 + 3, S1, -C1);
    TW(4 * 2 + 1, C2, -C2);
    v[4 * 2 + 2] = v[4 * 2 + 2].yx * (INV ? (v2f){-1.f, 1.f} : (v2f){1.f, -1.f});
    TW(4 * 2 + 3, -C2, -C2);
    TW(4 * 3 + 1, S1, -C1);
    TW(4 * 3 + 2, -C2, -C2);
    TW(4 * 3 + 3, -C1, S1);
#undef TW
#pragma unroll
    for (int c = 0; c < 4; ++c) dft4<INV>(v[4 * c], v[4 * c + 1], v[4 * c + 2], v[4 * c + 3]);
#define SW(i, j) { const v2f t_ = v[i]; v[i] = v[j]; v[j] = t_; }
    SW(1, 4) SW(2, 8) SW(3, 12) SW(6, 9) SW(7, 13) SW(11, 14)
#undef SW
}
template <class BUF, class TW> HD void fwd_pass0(int u, v2f (&v)[16], BUF buf, TW W) {
    dft16<false>(v);
    const v2f w1 = W[u], w1k = twk(w1); v2f wr = w1;
    const int pb = fphys(u);
    buf[pb] = v[0];
#pragma unroll
    for (int r = 1; r < 16; ++r) { v[r] = cmul(v[r], wr); buf[pb + 272 * r] = v[r]; wr = cmulk(wr, w1, w1k); }
}
template <class BUF, class TW> HD void fwd_pass1(int u, v2f (&v)[16], BUF buf, TW W) {
    const int j = u & 15, pb = (u >> 4) * 272 + j;
#pragma unroll
    for (int q = 0; q < 16; ++q) v[q] = buf[pb + 17 * q];
    dft16<false>(v);
    const v2f w1 = W[16 * j], w1k = twk(w1); v2f wr = w1;
    buf[pb] = v[0];
#pragma unroll
    for (int r = 1; r < 16; ++r) { v[r] = cmul(v[r], wr); buf[pb + 17 * r] = v[r]; wr = cmulk(wr, w1, w1k); }
}
template <class BUF> HD void fwd_pass2(int u, v2f (&v)[16], BUF buf) {
    const int pb = (u >> 4) * 272 + (u & 15) * 17;
#pragma unroll
    for (int q = 0; q < 16; ++q) v[q] = buf[pb + q];
    dft16<false>(v);
}
template <class BUF> HD void inv_passA(int u, v2f (&v)[16], BUF buf) {
    dft16<true>(v);
    const int pb = (u >> 4) * 272 + (u & 15) * 17;
#pragma unroll
    for (int r = 0; r < 16; ++r) buf[pb + r] = v[r];
}
template <class BUF, class TW> HD void inv_passB(int u, v2f (&v)[16], BUF buf, TW W) {
    const int j = u & 15, pb = (u >> 4) * 272 + j;
    const v2f w1 = W[16 * j], w1k = twk(w1); v2f wr = w1;
    v[0] = buf[pb];
#pragma unroll
    for (int q = 1; q < 16; ++q) { v[q] = cmulc(buf[pb + 17 * q], wr); wr = cmulk(wr, w1, w1k); }
    dft16<true>(v);
#pragma unroll
    for (int r = 0; r < 16; ++r) buf[pb + 17 * r] = v[r];
}
template <class BUF, class TW> HD void inv_passC(int u, v2f (&v)[16], BUF buf, TW W) {
    const v2f w1 = W[u], w1k = twk(w1); v2f wr = w1;
    const int pb = fphys(u);
    v[0] = buf[pb];
#pragma unroll
    for (int q = 1; q < 16; ++q) { v[q] = cmulc(buf[pb + 272 * q], wr); wr = cmulk(wr, w1, w1k); }
    dft16<true>(v);
}
HD int digitrev(int i) { return ((i & 15) << 8) | (i & 0xF0) | (i >> 8); }

#undef HD
constexpr int FFT_LDS_W = 2 * FBUF * 8;
constexpr int FFT_LDS_STG = FFT_LDS_W + 4096 * 8;
constexpr int STG_ROW = SEQ + 16;
constexpr int FFT_LDS_W2 = FFT_LDS_STG + 2 * STG_ROW * 2;
constexpr int FFT_LDS_END = FFT_LDS_W2 + 4096 * 8;
__device__ __forceinline__ void fft_load_w(const P& p, char* smem) {
    float2* Wl = (float2*)(smem + FFT_LDS_W); float2* W2l = (float2*)(smem + FFT_LDS_W2);
    __syncthreads();
    { const int t_ = tid_opaque();
      float4 a_[4], b_[4];
#pragma unroll
      for (int k = 0; k < 4; ++k) { a_[k] = ((const float4*)p.Wtab)[t_ + NT * k]; b_[k] = ((const float4*)p.W2tab)[t_ + NT * k]; }
#pragma unroll
      for (int k = 0; k < 4; ++k) { ((float4*)Wl)[t_ + NT * k] = a_[k]; ((float4*)W2l)[t_ + NT * k] = b_[k]; } }
    __syncthreads();
}
__device__ __forceinline__ void ph_tables(const P& p) {
    for (int i = blockIdx.x * NT + tid_opaque(); i < 8192; i += gridDim.x * NT) {
        float sn, cs;
        if (i < 4096) { sincospif((float)i * (1.0f / 2048.0f), &sn, &cs); p.Wtab[i] = make_float2(cs, -sn); }
        else { sincospif((float)(i - 4096) * (1.0f / 4096.0f), &sn, &cs); p.W2tab[i - 4096] = make_float2(cs, -sn); }
    }
    for (int i = blockIdx.x * NT + tid_opaque(); i < DEPTH * 80 * DM; i += gridDim.x * NT) {
        const int l = i / (80 * DM), n = (i / DM) % 80, kk = i % DM;
        const float v = n < 64 ? p.w_re[((size_t)l * DM + kk) * NE + n] : (n < 72 ? p.w_rg[((size_t)l * DM + kk) * 8 + (n - 64)] : 0.f);
        const bf16_t h = f2bf(v);
        p.WrT[((size_t)(l * 2 + 0) * 80 + n) * DM + kk] = h; p.WrT[((size_t)(l * 2 + 1) * 80 + n) * DM + kk] = f2bf(v - bf2f(h));
    }
}
__device__ __forceinline__ void ph_spectra(const P& p, char* smem) {
    v2f* bufE = (v2f*)smem; v2f* bufO = bufE + FBUF; const v2f* Wl = (const v2f*)(smem + FFT_LDS_W); const v2f* W2l = (const v2f*)(smem + FFT_LDS_W2);
    const int tid = tid_opaque(), half = tid >> 8, u = tid & 255;
    v2f* buf = half ? bufO : bufE;
    fft_load_w(p, smem);
    for (int un = blockIdx.x; un < DEPTH * HYW; un += gridDim.x) {
        const int l = un / HYW, c = un % HYW;
        const float* hf0 = p.HT0 + ((size_t)l * 2048 + c) * SEQ;        const float s_f0 = p.SCL0[l * 2048 + c];
        const float* hb0 = p.HT0 + ((size_t)l * 2048 + 512 + c) * SEQ;  const float s_b0 = p.SCL0[l * 2048 + 512 + c];
        const float* hf1 = p.HT0 + ((size_t)l * 2048 + 1024 + c) * SEQ; const float s_f1 = p.SCL0[l * 2048 + 1024 + c];
        const float* hb1 = p.HT0 + ((size_t)l * 2048 + 1536 + c) * SEQ; const float s_b1 = p.SCL0[l * 2048 + 1536 + c];
        v2f v[16];
#pragma unroll
        for (int q = 0; q < 16; ++q) {
            const int j = 2 * (u + 256 * q) + half;
            float a, b;
            if (j < SEQ) { a = hf0[j] * s_f0; b = hf1[j] * s_f1; } else if (j == SEQ) { a = 0.f; b = 0.f; } else { a = hb0[2 * SEQ - j] * s_b0; b = hb1[2 * SEQ - j] * s_b1; }
            if (j == 0) { a += p.flt_bias[(l * 2 + 0) * HYW + c]; b += p.flt_bias[(l * 2 + 1) * HYW + c]; }
            v[q] = (v2f){a, b};
        }
        __syncthreads();
        fwd_pass0(u, v, buf, Wl); __syncthreads();
        fwd_pass1(u, v, buf, Wl); __syncthreads();
        fwd_pass2(u, v, buf);
#pragma unroll
        for (int r = 0; r < 16; ++r) buf[fphys(16 * u + r)] = v[r];
        __syncthreads();
        v2f* out = (v2f*)p.Hs + (size_t)(l * HYW + c) * 4 * 4096;
        for (int idx = tid; idx < 8192; idx += NT) {
            const int par = idx >> 12, pi = idx & 4095, kp = 2 * digitrev(pi) + par, kpp = (8192 - kp) & 8191;
            const int k1 = kp & 4095, k2 = kpp & 4095;
            v2f t1 = cmul(W2l[k1], bufO[fphys(digitrev(k1))]); if (kp >= 4096) t1 = -t1;
            v2f t2 = cmul(W2l[k2], bufO[fphys(digitrev(k2))]); if (kpp >= 4096) t2 = -t2;
            const v2f F = bufE[fphys(digitrev(k1))] + t1, Gq = bufE[fphys(digitrev(k2))] + t2;
            const float sc = 0.5f / 8192.0f;
            out[(0 * 2 + par) * 4096 + pi] = (v2f){(F.x + Gq.x) * sc, (F.y - Gq.y) * sc};
            out[(1 * 2 + par) * 4096 + pi] = (v2f){(F.y + Gq.y) * sc, -(F.x - Gq.x) * sc};
        }
    }
    __syncthreads();
}
__device__ __forceinline__ void fft_conv(int half, int u, v2f (&v)[16], const v2f* W2g, const v2f* Hso, v2f* buf, const v2f* Wl) {
    float4 hreg[8];
    const float4* hp = (const float4*)(Hso + (size_t)half * 4096 + 16 * u);
#pragma unroll
    for (int r2 = 0; r2 < 8; ++r2) hreg[r2] = hp[r2];
    if (half) {
#pragma unroll
        for (int q = 0; q < 16; ++q) v[q] = cmul(v[q], W2g[u + 256 * q]);
    }
    fwd_pass0(u, v, buf, Wl); __syncthreads();
    fwd_pass1(u, v, buf, Wl); __syncthreads();
    fwd_pass2(u, v, buf);
#pragma unroll
    for (int r2 = 0; r2 < 8; ++r2) { const float4 h = hreg[r2]; v[2 * r2] = cmul(v[2 * r2], (v2f){h.x, h.y}); v[2 * r2 + 1] = cmul(v[2 * r2 + 1], (v2f){h.z, h.w}); }
    inv_passA(u, v, buf); __syncthreads();
    inv_passB(u, v, buf, Wl); __syncthreads();
    inv_passC(u, v, buf, Wl);
    if (half) {
#pragma unroll
        for (int r = 0; r < 16; ++r) v[r] = cmulc(v[r], W2g[u + 256 * r]);
    }
}

__device__ __forceinline__ void ph_hyena_fft(const P& p, int l, char* smem) {
    v2f* buf0 = (v2f*)smem; v2f* buf1 = buf0 + FBUF; const v2f* Wl = (const v2f*)(smem + FFT_LDS_W);
    bf16_t* stg = (bf16_t*)(smem + FFT_LDS_STG) + 8;
    const v2f* W2l = (const v2f*)(smem + FFT_LDS_W2);
    const int tid = tid_opaque(), half = tid >> 8, u = tid & 255;
    v2f* buf = half ? buf1 : buf0;
    const int pu = fphys(u);
    if (tid < 32) { const int rw = tid >> 4, k = tid & 15; (stg - 8 + rw * STG_ROW)[k < 8 ? k : SEQ + k] = 0; }
    fft_load_w(p, smem);
    for (int c = blockIdx.x; c < HYW; c += gridDim.x) {
        const v2f* Hs0 = (const v2f*)p.Hs + (size_t)(l * HYW + c) * 4 * 4096; const v2f* Hs1 = Hs0 + 2 * 4096;
        float scw[3][4];
#pragma unroll
        for (int w = 0; w < 3; ++w) { const int col = w * HYW + c; scw[w][0] = p.sc_w[(size_t)(l * 3 + 0) * HYC + col]; scw[w][1] = p.sc_w[(size_t)(l * 3 + 1) * HYC + col]; scw[w][2] = p.sc_w[(size_t)(l * 3 + 2) * HYC + col]; scw[w][3] = p.sc_b[l * HYC + col]; }
#define HY_TAP(sb, k, w) (scw[w][3] + scw[w][0] * __uint_as_float((unsigned)(sb)[(k) - 1] << 16) + scw[w][1] * __uint_as_float((unsigned)(sb)[(k)] << 16) + scw[w][2] * __uint_as_float((unsigned)(sb)[(k) + 1] << 16))
        u32x4 ra, rb;
#define HY_LOAD(sel, pr_) do { const bf16_t* r0_ = p.PT + ((size_t)(2 * (pr_)) * HYC + (sel) * HYW + c) * SEQ + tid * 8; ra = *(const u32x4*)r0_; rb = *(const u32x4*)(r0_ + (size_t)HYC * SEQ); } while (0)
#define HY_STAGE() do { *(u32x4*)(stg + tid * 8) = ra; *(u32x4*)(stg + STG_ROW + tid * 8) = rb; } while (0)
        HY_LOAD(0, 0);
        for (int pr = 0; pr < 2; ++pr) {
            const LAS bf16_t* sbA = (const LAS bf16_t*)stg + u; asm volatile("" : "+v"(sbA));
            const LAS bf16_t* sbB = sbA + STG_ROW;
            __syncthreads();
            HY_STAGE();
            __syncthreads();
            v2f v[16];
#pragma unroll
            for (int q = 0; q < 16; ++q) v[q] = (v2f){HY_TAP(sbA, 256 * q, 0), HY_TAP(sbB, 256 * q, 0)};
            HY_LOAD(1, pr);
            fft_conv(half, u, v, W2l, Hs0, buf, Wl);
            if (half) {
#pragma unroll
                for (int r = 0; r < 16; ++r) buf1[pu + 272 * r] = v[r];
            }
            HY_STAGE();
            __syncthreads();
            if (!half) {
#pragma unroll
                for (int r = 0; r < 16; ++r) {
                    const v2f y = v[r] + buf1[pu + 272 * r];
                    const float xa = HY_TAP(sbA, 256 * r, 1), xb = HY_TAP(sbB, 256 * r, 1);
                    const v2f z1 = (v2f){xa, xb} * y;
                    v[r] = z1; buf1[pu + 272 * r] = z1;
                }
            }
            HY_LOAD(2, pr);
            __syncthreads();
            if (half) {
#pragma unroll
                for (int r = 0; r < 16; ++r) v[r] = buf1[pu + 272 * r];
            }
            fft_conv(half, u, v, W2l, Hs1, buf, Wl);
            if (half) {
#pragma unroll
                for (int r = 0; r < 16; ++r) buf1[pu + 272 * r] = v[r];
            }
            HY_STAGE();
            if (pr == 0) HY_LOAD(0, 1);
            __syncthreads();
            if (!half) {
                bf16_t* oA = p.Yhy + ((size_t)(c >> 3) * TT + (size_t)(2 * pr) * SEQ + u) * 8 + (c & 7); bf16_t* oB = oA + (size_t)SEQ * 8;
#pragma unroll
                for (int r = 0; r < 16; ++r) {
                    const v2f y = v[r] + buf1[pu + 272 * r];
                    const float xa = HY_TAP(sbA, 256 * r, 2), xb = HY_TAP(sbB, 256 * r, 2);
                    oA[(size_t)(256 * r) * 8] = f2bf(xa * y.x);
                    oB[(size_t)(256 * r) * 8] = f2bf(xb * y.y);
                }
            }
        }
#undef HY_LOAD
#undef HY_STAGE
#undef HY_TAP
    }
    __syncthreads();
}

__device__ __forceinline__ float4 moe_combine4(const P& p, int lc, int b, size_t s0, size_t s1, int j, float4 hv) {
    const u32x2 y0 = *(const u32x2*)(p.Y + s0 * DM + j), y1 = *(const u32x2*)(p.Y + s1 * DM + j);
    const float4 g = *(const float4*)(p.mod + ((size_t)lc * 5 + b) * NMOD + 5 * DM + j);
    hv.x += g.x * (__uint_as_float(y0.x << 16) + __uint_as_float(y1.x << 16));
    hv.y += g.y * (__uint_as_float(y0.x & 0xFFFF0000u) + __uint_as_float(y1.x & 0xFFFF0000u));
    hv.z += g.z * (__uint_as_float(y0.y << 16) + __uint_as_float(y1.y << 16));
    hv.w += g.w * (__uint_as_float(y0.y & 0xFFFF0000u) + __uint_as_float(y1.y & 0xFFFF0000u));
    return hv;
}
__device__ __forceinline__ void ph_norm1c(const P& p, int l, const int* offs) {
    const int tid = tid_opaque(), lane = tid & 63, wv = tid >> 6;
    const float* ng = p.norm1_g + l * DM;
    for (int rb = blockIdx.x * 16; rb < TT; rb += gridDim.x * 16) {
        const int row0 = rb + wv * 2;
        const int b = row0 < TL ? (row0 >> 12) : 4;
        float* hp = p.hx + (size_t)row0 * DM;
        const float* src = l > 0 ? hp : (row0 < TL ? p.x + (size_t)row0 * DM : p.ctx + (size_t)(row0 - TL) * DM);
        const float* md = p.mod + ((size_t)l * 5 + b) * NMOD;
        float4 xv[2][4];
        u32x2 ya[2][4], yb[2][4];
        if (l > 0) {
            const int4 a0 = *(const int4*)(p.asg + (size_t)row0 * 4), a1 = *(const int4*)(p.asg + (size_t)(row0 + 1) * 4);
            const size_t s00 = (size_t)offs[a0.x] + a0.y, s01 = (size_t)offs[a0.z] + a0.w, s10 = (size_t)offs[a1.x] + a1.y, s11 = (size_t)offs[a1.z] + a1.w;
#pragma unroll
            for (int i = 0; i < 4; ++i) { const int j = i * 256 + lane * 4;
                ya[0][i] = *(const u32x2*)(p.Y + s00 * DM + j); yb[0][i] = *(const u32x2*)(p.Y + s01 * DM + j);
                ya[1][i] = *(const u32x2*)(p.Y + s10 * DM + j); yb[1][i] = *(const u32x2*)(p.Y + s11 * DM + j); }
        }
#pragma unroll
        for (int i = 0; i < 4; ++i) { const int j = i * 256 + lane * 4; xv[0][i] = *(const float4*)(src + j); xv[1][i] = *(const float4*)(src + DM + j); }
        float ss[2] = {0.f, 0.f};
#pragma unroll
        for (int rr = 0; rr < 2; ++rr)
#pragma unroll
            for (int i = 0; i < 4; ++i) {
                const int j = i * 256 + lane * 4;
                if (l > 0) {
                    const float4 g = *(const float4*)(p.mod + ((size_t)(l - 1) * 5 + b) * NMOD + 5 * DM + j);
                    const u32x2 y0 = ya[rr][i], y1 = yb[rr][i];
                    xv[rr][i].x += g.x * (__uint_as_float(y0.x << 16) + __uint_as_float(y1.x << 16));
                    xv[rr][i].y += g.y * (__uint_as_float(y0.x & 0xFFFF0000u) + __uint_as_float(y1.x & 0xFFFF0000u));
                    xv[rr][i].z += g.z * (__uint_as_float(y0.y << 16) + __uint_as_float(y1.y << 16));
                    xv[rr][i].w += g.w * (__uint_as_float(y0.y & 0xFFFF0000u) + __uint_as_float(y1.y & 0xFFFF0000u));
                }
                *(float4*)(hp + (size_t)rr * DM + j) = xv[rr][i];
                ss[rr] += xv[rr][i].x * xv[rr][i].x + xv[rr][i].y * xv[rr][i].y + xv[rr][i].z * xv[rr][i].z + xv[rr][i].w * xv[rr][i].w;
            }
        ss[0] = wave_sum(ss[0]); ss[1] = wave_sum(ss[1]);
        const float rs[2] = {rsqrtf(ss[0] * (1.0f / DM) + epsf()), rsqrtf(ss[1] * (1.0f / DM) + epsf())};
#pragma unroll
        for (int i = 0; i < 4; ++i) {
            const int j = i * 256 + lane * 4;
            const float4 g = *(const float4*)(ng + j), sh = *(const float4*)(md + j), sc = *(const float4*)(md + DM + j);
#pragma unroll
            for (int rr = 0; rr < 2; ++rr) {
                u32x2 o;
                o.x = pack2((xv[rr][i].x * rs[rr] * g.x) * (1.f + sc.x) + sh.x, (xv[rr][i].y * rs[rr] * g.y) * (1.f + sc.y) + sh.y);
                o.y = pack2((xv[rr][i].z * rs[rr] * g.z) * (1.f + sc.z) + sh.z, (xv[rr][i].w * rs[rr] * g.w) * (1.f + sc.w) + sh.w);
                *(u32x2*)(p.U + (size_t)(row0 + rr) * DM + j) = o;
            }
        }
    }
}
__device__ __forceinline__ void ph_final_c(const P& p, const int* offs) {
    const int tid = tid_opaque(), lane = tid & 63, wv = tid >> 6;
    for (int rb = blockIdx.x * 8; rb < TL; rb += gridDim.x * 8) {
        const int row = rb + wv, b = row >> 12;
        const float* hp = p.hx + (size_t)row * DM;
        const int4 a = *(const int4*)(p.asg + (size_t)row * 4);
        const size_t s0 = (size_t)offs[a.x] + a.y, s1 = (size_t)offs[a.z] + a.w;
        float4 xv[4]; float ss = 0.f;
#pragma unroll
        for (int i = 0; i < 4; ++i) {
            const int j = i * 256 + lane * 4;
            xv[i] = moe_combine4(p, DEPTH - 1, b, s0, s1, j, *(const float4*)(hp + j));
            ss += xv[i].x * xv[i].x + xv[i].y * xv[i].y + xv[i].z * xv[i].z + xv[i].w * xv[i].w;
        }
        ss = wave_sum(ss);
        const float rs = rsqrtf(ss * (1.0f / DM) + epsf());
#pragma unroll
        for (int i = 0; i < 4; ++i) {
            const int j = i * 256 + lane * 4;
            const float4 g = *(const float4*)(p.final_g + j);
            float4 y; y.x = xv[i].x * rs * g.x; y.y = xv[i].y * rs * g.y; y.z = xv[i].z * rs * g.z; y.w = xv[i].w * rs * g.w;
            *(float4*)(p.out + (size_t)row * DM + j) = y;
        }
    }
}


__device__ __forceinline__ void ph_hyena_ctx(const P& p, int l, char* smem) {
    constexpr int L = CTXL;
    float* kern0 = (float*)smem;
    float* kern1 = kern0 + 2 * L;
    float* zb = kern1 + 2 * L;
    const int tid = tid_opaque(), b = tid >> 7, t0 = tid & 127, t1 = t0 + 128;
    const float* HT = p.HT1 + (size_t)l * 2048 * L;
    const float* SCL = p.SCL1 + l * 2048;
    for (int c = blockIdx.x; c < HYW; c += gridDim.x) {
        __syncthreads();
        {
            const int d = tid - L;
            float k0, k1;
            if (d >= 0) { k0 = HT[(size_t)c * L + d] * SCL[c]; k1 = HT[(size_t)(1024 + c) * L + d] * SCL[1024 + c]; }
            else if (d > -L) { k0 = HT[(size_t)(512 + c) * L + (size_t)(-d)] * SCL[512 + c]; k1 = HT[(size_t)(1536 + c) * L + (size_t)(-d)] * SCL[1536 + c]; }
            else { k0 = 0.f; k1 = 0.f; }
            kern0[tid] = k0; kern1[tid] = k1;
        }
        float uv[3][2];
#pragma unroll
        for (int w = 0; w < 3; ++w) {
            const int col = w * HYW + c;
            const bf16_t* pr = p.PTc + ((size_t)b * HYC + col) * L;
            const float w0 = p.sc_w[(size_t)(l * 3 + 0) * HYC + col], w1 = p.sc_w[(size_t)(l * 3 + 1) * HYC + col], w2 = p.sc_w[(size_t)(l * 3 + 2) * HYC + col], bb = p.sc_b[l * HYC + col];
            uv[w][0] = bb + w0 * (t0 > 0 ? bf2f(pr[t0 - 1]) : 0.f) + w1 * bf2f(pr[t0]) + w2 * bf2f(pr[t0 + 1]);
            uv[w][1] = bb + w0 * bf2f(pr[t1 - 1]) + w1 * bf2f(pr[t1]) + w2 * (t1 < L - 1 ? bf2f(pr[t1 + 1]) : 0.f);
        }
        zb[b * L + t0] = uv[0][0]; zb[b * L + t1] = uv[0][1];
        __syncthreads();
        float a0 = 0.f, a1 = 0.f;
        const float* zr = zb + b * L;
#pragma unroll 8
        for (int s2 = 0; s2 < L; ++s2) { const float zs = zr[s2]; a0 += zs * kern0[t0 - s2 + L]; a1 += zs * kern0[t1 - s2 + L]; }
        const float bias0 = p.flt_bias[(l * 2 + 0) * HYW + c], bias1 = p.flt_bias[(l * 2 + 1) * HYW + c];
        const float z10 = uv[1][0] * (a0 + bias0 * uv[0][0]), z11 = uv[1][1] * (a1 + bias0 * uv[0][1]);
        __syncthreads();
        zb[b * L + t0] = z10; zb[b * L + t1] = z11;
        __syncthreads();
        a0 = 0.f; a1 = 0.f;
#pragma unroll 8
        for (int s2 = 0; s2 < L; ++s2) { const float zs = zr[s2]; a0 += zs * kern1[t0 - s2 + L]; a1 += zs * kern1[t1 - s2 + L]; }
        const size_t rbase = (size_t)TL + b * CTXL;
        p.Yhy[((size_t)(c >> 3) * TT + rbase + t0) * 8 + (c & 7)] = f2bf(uv[2][0] * (a0 + bias1 * z10));
        p.Yhy[((size_t)(c >> 3) * TT + rbase + t1) * 8 + (c & 7)] = f2bf(uv[2][1] * (a1 + bias1 * z11));
    }
    __syncthreads();
}

__device__ __forceinline__ void conv_tile(bf16_t* tile, const float* src, int ld, int c0, int ncols, int K, bf16_t* dst, int kt, int ntile, const float* kscale = nullptr) {
    const int tid = tid_opaque();
    const int k = tid >> 3, n8 = (tid & 7) * 8, nbase = ntile * 64;
    float4 x0 = make_float4(0.f, 0.f, 0.f, 0.f), x1 = x0;
    if (nbase + n8 < ncols) { const float* sp = src + (size_t)(kt * 64 + k) * ld + c0 + nbase + n8; x0 = *(const float4*)sp; x1 = *(const float4*)(sp + 4); }
    if (kscale) { const float ks = kscale[kt * 64 + k]; x0.x *= ks; x0.y *= ks; x0.z *= ks; x0.w *= ks; x1.x *= ks; x1.y *= ks; x1.z *= ks; x1.w *= ks; }
    __syncthreads();
    tile[(n8 + 0) * 72 + k] = f2bf(x0.x); tile[(n8 + 1) * 72 + k] = f2bf(x0.y); tile[(n8 + 2) * 72 + k] = f2bf(x0.z); tile[(n8 + 3) * 72 + k] = f2bf(x0.w);
    tile[(n8 + 4) * 72 + k] = f2bf(x1.x); tile[(n8 + 5) * 72 + k] = f2bf(x1.y); tile[(n8 + 6) * 72 + k] = f2bf(x1.z); tile[(n8 + 7) * 72 + k] = f2bf(x1.w);
    __syncthreads();
    const int n = tid >> 3, k8 = (tid & 7) * 8;
    if (nbase + n < ncols) *(u32x4*)(dst + (size_t)(nbase + n) * K + kt * 64 + k8) = *(const u32x4*)(tile + n * 72 + k8);
}
constexpr int DENSE_TILES = 1720;
__device__ __forceinline__ void ph_conv_dense(const P& p, char* smem) {
    bf16_t* tile = (bf16_t*)smem;
    for (int id = blockIdx.x; id < DEPTH * DENSE_TILES; id += gridDim.x) {
        const int l = id / DENSE_TILES; int r = id % DENSE_TILES;
        const float* win = p.w_in + (size_t)l * DM * INC;
        if (r < 384) conv_tile(tile, win, INC, 0, HYC, DM, p.WtHy + (size_t)l * HYC * DM, r / 24, r % 24);
        else if ((r -= 384) < 64) conv_tile(tile, win, INC, HYC + QL, KVL, DM, p.WtRest + (size_t)l * 2816 * DM, r / 4, r % 4);
        else if ((r -= 64) < 96) conv_tile(tile, win, INC, HYC, QL, DM, p.WtRest + ((size_t)l * 2816 + 256) * DM, r / 6, r % 6);
        else if ((r -= 96) < 16) conv_tile(tile, win, INC, HYC + QL + KVL, QKR, DM, p.WtRest + ((size_t)l * 2816 + 640) * DM, r, 0);
        else if ((r -= 16) < 512) conv_tile(tile, win, INC, MLA_END, 2048, DM, p.WtRest + ((size_t)l * 2816 + 768) * DM, r / 32, r % 32);
        else if ((r -= 512) < 72) conv_tile(tile, p.w_uq + (size_t)l * QL * 768, 768, 0, 768, QL, p.WtUq + (size_t)l * 768 * QL, r / 12, r % 12, p.q_norm_g + l * QL);
        else if ((r -= 72) < 64) conv_tile(tile, p.w_ukv + (size_t)l * KVL * 1024, 1024, 0, 1024, KVL, p.WtUkv + (size_t)l * 1024 * KVL, r / 16, r % 16, p.kv_norm_g + l * KVL);
        else if ((r -= 64) < 128) conv_tile(tile, p.w_hy_o + (size_t)l * HYW * DM, DM, 0, DM, HYW, p.WtHyo + (size_t)l * DM * HYW, r / 16, r % 16);
        else if ((r -= 128) < 128) conv_tile(tile, p.w_mla_o + (size_t)l * 512 * DM, DM, 0, DM, 512, p.WtMlao + (size_t)l * DM * 512, r / 16, r % 16);
        else { r -= 128; conv_tile(tile, p.w_out + (size_t)l * DM * DM, DM, 0, DM, DM, p.WtOut + (size_t)l * DM * DM, r / 16, r % 16); }
    }
    const int nz = DEPTH * 96 * DM / 8;
    for (int i = blockIdx.x * NT + threadIdx.x; i < nz + SEQ * 16; i += gridDim.x * NT) {
        if (i < nz) { const int l = i / (96 * DM / 8), o = i % (96 * DM / 8); *(u32x4*)(p.WtRest + ((size_t)l * 2816 + MLAW) * DM + (size_t)o * 8) = (u32x4){0u, 0u, 0u, 0u}; }
        else { const int k = i - nz, t = k >> 4, a = (k >> 3) & 1, ii = k & 7; const float ang = (float)(a == 0 ? (t >> 6) : (t & 63)) * powf(10000.0f, -(float)ii / 8.0f); p.rope[k] = make_float2(cosf(ang), sinf(ang)); }
    }
}
__device__ __forceinline__ void ph_conv_experts(const P& p, int l, char* smem, int t_begin, int t_end, int worker, int nworkers) {
    bf16_t* tile = (bf16_t*)smem;
    if (worker >= 0)
    for (int id = t_begin + worker; id < t_end; id += nworkers) {
        const int e = id / 192; int r = id % 192;
        const size_t le = (size_t)l * NE + e;
        if (r < 64) conv_tile(tile, p.w_gate + le * DM * DE, DE, 0, DE, DM, p.WtG + (size_t)e * DE * DM, r / 4, r % 4);
        else if (r < 128) { r -= 64; conv_tile(tile, p.w_up + le * DM * DE, DE, 0, DE, DM, p.WtU + (size_t)e * DE * DM, r / 4, r % 4); }
        else { r -= 128; conv_tile(tile, p.w_down + le * DE * DM, DM, 0, DM, DE, p.WtD + (size_t)e * DM * DE, r / 16, r % 16); }
    }
    __syncthreads();
}

constexpr int LDS_TAB = ge::STAGE_BYTES;
static_assert(FFT_LDS_END <= 160 * 1024 - 16, "FFT LDS image");
constexpr int LDS_TOTAL = 160 * 1024;
#define PH_P KArgP kp_ = (KArgP)__builtin_amdgcn_kernarg_segment_ptr(); asm volatile("" : "+s"(kp_)); const P p = make_p(kp_); int G = gridDim.x, c = blockIdx.x; asm volatile("" : "+s"(G), "+s"(c)); (void)G; (void)c;
#define GRID_BAR() do { XcdBarrier b_; b_.bar = (unsigned*)k.ws; b_.x = xb_xcc_id(); b_.st = xbw; xcd_barrier(b_); } while (0)
__global__ __launch_bounds__(NT, 2) void mega(PK k) {
    extern __shared__ __attribute__((aligned(16))) char smem[];
    LAS unsigned char* lds = (LAS unsigned char*)smem;
    volatile LAS unsigned* xbw = (volatile LAS unsigned*)(smem + LDS_TOTAL - 16);
    if (threadIdx.x == 0) { xbw[0] = 0u; xbw[1] = 0u; xbw[2] = 0u; xbw[3] = 0u; }
    __syncthreads();
    (void)xcd_barrier_post((unsigned*)k.ws, xbw);
#define PB(id) do { if (PROBE_ID == (id) && blockIdx.x == 0 && threadIdx.x == 0) xbw[2] = (unsigned)wall_clock64(); } while (0)
#define PE(id) do { if (PROBE_ID == (id) && blockIdx.x == 0 && threadIdx.x == 0) xbw[3] += (unsigned)wall_clock64() - xbw[2]; } while (0)
    int* offs = (int*)(smem + LDS_TAB); int* tpre = offs + 65; int* cntl = tpre + 65;
    const LAS int* offs_l = (const LAS int*)(lds + LDS_TAB); const LAS int* tpre_l = offs_l + 65; const LAS int* cntl_l = tpre_l + 65;
    PB(0);
    for (int rep = 0; rep < REP_PRO; ++rep) {
    PB(20);
    { PH_P ph_mod_partial(p, smem); ph_filter_a(p, smem); ph_conv_dense(p, smem); ph_tables(p); }
    GRID_BAR();
    PE(20); PB(21);
    { PH_P ph_filter_b2(p, smem); }
    GRID_BAR();
    PE(21); PB(22);
    { PH_P ph_finalize(p); }
    GRID_BAR();
    PE(22); PB(23);
    { PH_P ph_spectra(p, smem); }
    GRID_BAR();
    PE(23);
    }
    PE(0);
    for (int l = 0; l < DEPTH; ++l) {
        const bool last = (l == DEPTH - 1);
        PB(1);
        { PH_P ph_norm1c(p, l, offs); }
        GRID_BAR();
        PE(1); PB(2);
#define CHAIN_IDS int cw_ = blockIdx.x; asm volatile("" : "+s"(cw_)); const bool kvc = cw_ < 68, qc = !kvc && cw_ < 136; const int pm = kvc ? cw_ : cw_ - 68; (void)qc; (void)pm;
#define CHAIN_SSQ LAS float* ssq = (LAS float*)(lds + LDS_SSQ); LAS float* rsl = ssq + 256 * 16; (void)rsl;
        { CHAIN_IDS
          if (kvc || qc) { PH_P CHAIN_SSQ
              SchedChainIn S{(const char*)p.U, (const char*)(p.WtRest + (size_t)l * 2816 * DM), pm, kvc ? 0 : 1, kvc ? 1 : 2};
              EpiInprojMLA E{p.PMLAb, p.K, p.rope, ssq};
              ge::gemm_engine<false>(lds, DM, DM, DM, S, E);
          } }
        { CHAIN_IDS
          if (kvc || qc) { CHAIN_SSQ
              asm volatile("s_waitcnt vmcnt(0)" ::: "memory"); __syncthreads(); __builtin_amdgcn_fence(__ATOMIC_ACQUIRE, "agent"); asm volatile("s_waitcnt vmcnt(0)" ::: "memory");
              const int t_ = tid_opaque();
              if (t_ < 256) { float a_ = 0.f; const int ns = kvc ? 8 : 12;
                  for (int q_ = 0; q_ < ns; ++q_) a_ += ssq[t_ * 16 + q_];
                  rsl[t_] = rsqrtf(a_ * (kvc ? 1.0f / KVL : 1.0f / QL) + epsf()); }
              __syncthreads();
          } }
        { CHAIN_IDS
          if (kvc || qc) { PH_P CHAIN_SSQ
              LAS float* rpl = rsl + 256;
              { const int t0 = (pm & 15) * 256;
                if (pm < 64) for (int t_ = tid_opaque(); t_ < 544; t_ += NT) {
                    const float2 e_ = t_ < 32 ? p.rope[(size_t)(t0 + (t_ >> 3) * 64) * 16 + (t_ & 7)] : p.rope[(size_t)(t0 + ((t_ - 32) >> 3)) * 16 + 8 + ((t_ - 32) & 7)];
                    rpl[2 * t_] = e_.x; rpl[2 * t_ + 1] = e_.y; }
                __syncthreads(); }
              SchedPanel S{(const char*)(p.PMLAb + (kvc ? 0 : 256)), kvc ? (const char*)(p.WtUkv + (size_t)l * 1024 * KVL) : (const char*)(p.WtUq + (size_t)l * 768 * QL),
                           (size_t)640 * 2, (size_t)(kvc ? KVL : QL) * 2, pm, kvc ? 4 : 3, kvc ? 1 : 0};
              EpiQKV E{EpiQ{p.Q, p.Qc, rpl, rsl}, EpiKV{p.K, p.V, rsl}};
              ge::gemm_engine<false>(lds, 640, kvc ? KVL : QL, kvc ? KVL : QL, S, E);
          } }
        { CHAIN_IDS PH_P
            SchedPool S{(const char*)(p.WtHy + (size_t)l * HYC * DM), (const char*)(p.WtRest + (size_t)l * 2816 * DM), (const char*)p.U,
                        kvc ? 612 + 3 * cw_ : (qc ? 816 + 2 * (cw_ - 68) : cw_ - 136), (kvc || qc) ? 1 : G - 136, kvc ? 3 : (qc ? 2 : (612 - (cw_ - 136) + (G - 136) - 1) / (G - 136))};
            EpiInproj E{p.PT, p.PTc, p.G};
            ge::gemm_engine<false>(lds, DM, DM, DM, S, E);
        }
#undef CHAIN_IDS
#undef CHAIN_SSQ
        GRID_BAR();
        PE(2);
        PE(4); PB(5);
        for (int rep = 0; rep < REP_MIX; ++rep) {
        PB(31);
        { PH_P ph_attn2(p, smem, !last); }
        PE(31); PB(32);
        { PH_P ph_hyena_fft(p, l, smem); }
        PE(32); PB(33);
        if (!last) { PH_P ph_hyena_ctx(p, l, smem); }
        PE(33); }
        GRID_BAR();
        PE(5); PB(6);
        for (int rep = 0; rep < REP_DENSE; ++rep) { PH_P
            SchedMerge S{(const char*)p.Yhy, (const char*)p.Yatt, (const char*)(p.WtHyo + (size_t)l * DM * HYW), (const char*)(p.WtMlao + (size_t)l * DM * 512), G, c, last ? 64 : 68};
            EpiMerge E{p.G, p.M1};
            ge::gemm_engine<false, TT>(lds, 512, 512, 512, S, E);
        }
        { PH_P ph_conv_experts(p, l, smem, 0, NE * 96, c - 16, G - 16); }
        GRID_BAR();
        PE(6); PB(7);
        { PH_P
            SchedDense S{(const char*)p.M1, (const char*)(p.WtOut + (size_t)l * DM * DM), (size_t)DM * 2, (size_t)DM * 2, last ? 64 : 68, 4, G, c};
            EpiOut E{p.hx, p.mod + (size_t)l * 5 * NMOD};
            ge::gemm_engine<false>(lds, DM, DM, DM, S, E);
        }
        { PH_P ph_conv_experts(p, l, smem, NE * 96, NE * 192, c - 16, G - 16); }
        GRID_BAR();
        PE(7); PB(8);
        { PH_P ph_norm2_router(p, l, smem, last ? TL : TT); }
        GRID_BAR();
        PE(8); PB(9);
        for (int rep = 0; rep < REP_MOE; ++rep) { PH_P
            if (threadIdx.x < NE) cntl[threadIdx.x] = p.cnt[(l * NE + threadIdx.x) * 64];
            __syncthreads();
            if (threadIdx.x == 0) { int a = 0, t = 0; for (int e = 0; e < NE; ++e) { const int n = cntl[e]; offs[e] = a; tpre[e] = t; a += n; t += (n + 255) >> 8; } offs[64] = a; tpre[64] = t; }
            __syncthreads();
            SchedGU S{(const char*)p.U, (const char*)p.WtG, (const char*)p.WtU, p.list, tpre_l, cntl_l, G, c};
            EpiGU E{p.Hb, offs_l};
            ge::gemm_engine<true>(lds, DM, DM, DM, S, E);
        }
        GRID_BAR();
        PE(9); PB(10);
        for (int rep = 0; rep < REP_MOE; ++rep) { PH_P
            SchedDown S{(const char*)p.Hb, (const char*)p.WtD, tpre_l, cntl_l, offs_l, G, c};
            EpiDown E{p.Y, p.wl, offs_l};
            ge::gemm_engine<false>(lds, DE, DE, DE, S, E);
        }
        GRID_BAR();
        PE(10);
        if (PROBE_ID == 12) { PB(12); GRID_BAR(); PE(12); }
    }
    PB(11);
    { PH_P ph_final_c(p, offs); }
    PE(11);
    if (PROBE_ID >= 0 && blockIdx.x == 0 && threadIdx.x == 0) { const unsigned long long t0 = wall_clock64(), wait = (unsigned long long)xbw[3] * PROBE_K; while (wall_clock64() - t0 < wait) __builtin_amdgcn_s_sleep(8); }
}

extern "C" void kernel_launch(void* const* d_in, const int* in_sizes, int n_in, void* d_out, int out_size, void* d_ws, size_t ws_size, hipStream_t stream) {
    (void)in_sizes; (void)out_size;
    if (n_in < 33 || WSO.total > ws_size) { fprintf(stderr, "kernel_launch: need 33 inputs and %zu bytes of workspace; got %d, %zu\n", (size_t)WSO.total, n_in, ws_size); return; }
    PK k{};
    for (int i = 0; i < 33; ++i) k.in[i] = (const float*)d_in[i];
    k.out = (float*)d_out; k.ws = (char*)d_ws;
    (void)hipMemsetAsync(d_ws, 0, WS_ZERO_BYTES, stream);
    static int grid = 0;
    if (!grid) {
        int dev = 0, cus = 0, per_cu = 0;
        (void)hipGetDevice(&dev);
        (void)hipDeviceGetAttribute(&cus, hipDeviceAttributeMultiprocessorCount, dev);
        (void)hipFuncSetAttribute((const void*)mega, hipFuncAttributeMaxDynamicSharedMemorySize, LDS_TOTAL);
        (void)hipOccupancyMaxActiveBlocksPerMultiprocessor(&per_cu, (const void*)mega, NT, LDS_TOTAL);
        if (per_cu < 1) fprintf(stderr, "kernel_launch: occupancy query reports %d blocks per CU\n", per_cu);
        grid = cus > 0 ? cus : 256;
    }
    hipLaunchKernelGGL(mega, dim3(grid), dim3(NT), LDS_TOTAL, stream, k);
}
```

```cpp
#include <hip/hip_runtime.h>
#include <stdint.h>
#include <stdio.h>

typedef unsigned short bf16_t;
typedef short bf16x8 __attribute__((ext_vector_type(8)));
typedef float f32x4 __attribute__((ext_vector_type(4)));
typedef unsigned u32x4 __attribute__((ext_vector_type(4)));
typedef unsigned u32x2 __attribute__((ext_vector_type(2)));

#define NT 512
#ifndef PROBE_ID
#define PROBE_ID (-1)
#endif
#define PROBE_K 8
#ifndef REP_PRO
#define REP_PRO 1
#endif
#ifndef REP_DENSE
#define REP_DENSE 1
#endif
#ifndef REP_MOE
#define REP_MOE 1
#endif
#ifndef REP_MIX
#define REP_MIX 1
#endif
#ifndef REP_MISC
#define REP_MISC 1
#endif
constexpr int DM = 1024, NB = 4, SEQ = 4096, DEPTH = 4, CTXL = 256;
constexpr int TL = NB * SEQ, TC = NB * CTXL, TT = TL + TC;
constexpr int HYW = 512, HYC = 1536, QL = 384, KVL = 256, QKR = 32;
constexpr int MLAW = QL + KVL + QKR, MLA_END = HYC + MLAW, INC = MLA_END + 2 * DM;
constexpr int NH = 8, DQK = 96, DV = 64, NKEY = SEQ + CTXL;
constexpr int NE = 64, DE = 256, CAP = TT;
constexpr int NMOD = 6 * DM;
constexpr float EPSF = 1e-6f;
constexpr float QSCALE = 0.10206207261596577f * 1.4426950408889634f;

__device__ __forceinline__ bf16_t f2bf(float f) { unsigned u = __float_as_uint(f); u += 0x7FFFu + ((u >> 16) & 1u); return (bf16_t)(u >> 16); }
__device__ __forceinline__ float bf2f(bf16_t b) { return __uint_as_float(((unsigned)b) << 16); }
__device__ __forceinline__ unsigned pack2(float lo, float hi) { return (unsigned)f2bf(lo) | ((unsigned)f2bf(hi) << 16); }
__device__ __forceinline__ float epsf() { float e = EPSF; asm volatile("" : "+v"(e)); return e; }
__device__ __forceinline__ int tid_opaque() { int t = threadIdx.x; asm volatile("" : "+v"(t)); return t; }
__device__ __forceinline__ int shx_i(int v, int mask) {
    switch (mask) {
        case 1: return __builtin_amdgcn_ds_swizzle(v, (1 << 10) | 0x1F);
        case 2: return __builtin_amdgcn_ds_swizzle(v, (2 << 10) | 0x1F);
        case 4: return __builtin_amdgcn_ds_swizzle(v, (4 << 10) | 0x1F);
        case 8: return __builtin_amdgcn_ds_swizzle(v, (8 << 10) | 0x1F);
        case 16: return __builtin_amdgcn_ds_swizzle(v, (16 << 10) | 0x1F);
        default: {
            typedef unsigned u32x2s_t __attribute__((ext_vector_type(2)));
            const u32x2s_t r = __builtin_amdgcn_permlane32_swap((unsigned)v, (unsigned)v, false, false);
            return (int)(((threadIdx.x & 32u) == 0u) ? r.y : r.x); }
    }
}
__device__ __forceinline__ float shx(float v, int mask) { return __int_as_float(shx_i(__float_as_int(v), mask)); }
__device__ __forceinline__ int shx(int v, int mask) { return shx_i(v, mask); }
typedef unsigned u32x2_t __attribute__((ext_vector_type(2)));
__device__ __forceinline__ float rowmax4(float v) {
    u32x2_t r = __builtin_amdgcn_permlane16_swap(__float_as_uint(v), __float_as_uint(v), false, false);
    v = fmaxf(__uint_as_float(r.x), __uint_as_float(r.y));
    r = __builtin_amdgcn_permlane32_swap(__float_as_uint(v), __float_as_uint(v), false, false);
    return fmaxf(__uint_as_float(r.x), __uint_as_float(r.y));
}
__device__ __forceinline__ float rowsum4(float v) {
    u32x2_t r = __builtin_amdgcn_permlane16_swap(__float_as_uint(v), __float_as_uint(v), false, false);
    v = __uint_as_float(r.x) + __uint_as_float(r.y);
    r = __builtin_amdgcn_permlane32_swap(__float_as_uint(v), __float_as_uint(v), false, false);
    return __uint_as_float(r.x) + __uint_as_float(r.y);
}
__device__ __forceinline__ float wave_sum(float v) {
#pragma unroll
    for (int o = 32; o > 0; o >>= 1) v += shx(v, o);
    return v;
}


#define XB_TMO      128
#define XB_XCNT(j)  (256  + 64 * (j))
#define XB_XSUB(j)  (1280 + 64 * (j))
#define XB_XGEN(j)  (2304 + 64 * (j))
#define XB_TOP      3328
#define XB_TOPGEN   3392
#define XCD_BAR_WORDS 3456
#define XB_SPIN_CAP (1u << 22)
#define LAS __attribute__((address_space(3)))
__device__ __forceinline__ unsigned xb_ld(unsigned* p)              { return __hip_atomic_load(p, __ATOMIC_RELAXED, __HIP_MEMORY_SCOPE_AGENT); }
__device__ __forceinline__ unsigned xb_add(unsigned* p, unsigned v) { return __hip_atomic_fetch_add(p, v, __ATOMIC_RELAXED, __HIP_MEMORY_SCOPE_AGENT); }
__device__ __forceinline__ unsigned xb_xcc_id() { return (unsigned)__builtin_amdgcn_s_getreg((3 << 11) | 20) & 0xFu; }
#define XB_SPIN(cond, bar) do { unsigned _sp = 0; while (cond) { __builtin_amdgcn_s_sleep(1); \
    if ((++_sp & 255u) == 0u) { if (xb_ld(&(bar)[XB_TMO])) break; if (_sp > XB_SPIN_CAP) { atomicAdd(&(bar)[XB_TMO], 1u); break; } } } } while (0)
struct XcdBarrier { unsigned* bar; unsigned x; volatile LAS unsigned* st; };
__device__ __forceinline__ XcdBarrier xcd_barrier_post(unsigned* bar, volatile LAS unsigned* st) {
    XcdBarrier b; b.bar = bar; b.x = xb_xcc_id(); b.st = st;
    if (threadIdx.x == 0) (void)xb_add(&bar[XB_XCNT(b.x)], 1u);
    return b;
}
__device__ __forceinline__ void xcd_barrier_complete(unsigned* bar, unsigned x, unsigned& nloc, unsigned& nx) {
    const unsigned G = gridDim.x * gridDim.y * gridDim.z;
    unsigned sum, cnt, mine, sp = 0u;
    for (;;) {
        sum = 0u; cnt = 0u; mine = 0u;
#pragma unroll
        for (unsigned j = 0; j < 16; ++j) { const unsigned c = xb_ld(&bar[XB_XCNT(j)]); sum += c; cnt += (c > 0u) ? 1u : 0u; mine = (j == x) ? c : mine; }
        if (sum == G) break;
        __builtin_amdgcn_s_sleep(1);
        if ((++sp & 255u) == 0u) { if (xb_ld(&bar[XB_TMO])) break; if (sp > XB_SPIN_CAP) { atomicAdd(&bar[XB_TMO], 1u); break; } }
    }
    nloc = mine > 0u ? mine : 1u; nx = cnt > 0u ? cnt : 1u;
}
__device__ __forceinline__ void xcd_barrier(const XcdBarrier& b) {
    asm volatile("s_waitcnt vmcnt(0)" ::: "memory");
    __syncthreads();
    if (threadIdx.x == 0) {
        unsigned* bar = b.bar;
        __builtin_amdgcn_s_waitcnt(0);
        unsigned nloc = b.st[0], nx = b.st[1];
        if (nloc == 0u) { xcd_barrier_complete(bar, b.x, nloc, nx); b.st[0] = nloc; b.st[1] = nx; }
        const unsigned old = xb_add(&bar[XB_XSUB(b.x)], 1u);
        const unsigned gen = old / nloc;
        if (old + 1u == (gen + 1u) * nloc) {
            __builtin_amdgcn_fence(__ATOMIC_RELEASE, "agent");
            asm volatile("s_waitcnt vmcnt(0)" ::: "memory");
            const unsigned og = xb_add(&bar[XB_TOP], 1u);
            const unsigned tg = og / nx;
            if (og + 1u == (tg + 1u) * nx) xb_add(&bar[XB_TOPGEN], 1u);
            else XB_SPIN(xb_ld(&bar[XB_TOPGEN]) == tg, bar);
            __builtin_amdgcn_fence(__ATOMIC_ACQUIRE, "agent");
            xb_add(&bar[XB_XGEN(b.x)], 1u);
            asm volatile("s_waitcnt vmcnt(0)" ::: "memory");
        } else {
            XB_SPIN(xb_ld(&bar[XB_XGEN(b.x)]) == gen, bar);
            __builtin_amdgcn_fence(__ATOMIC_ACQUIRE, "agent");
            asm volatile("s_waitcnt vmcnt(0)" ::: "memory");
        }
    }
    __syncthreads();
}

#define WS_LIST(X) \
    X(unsigned, bar, XCD_BAR_WORDS * 4)                         \
    X(int, cnt, DEPTH * 64 * 256)                               \
    X(float, modp, (size_t)DEPTH * 32 * 5 * NMOD * 4)           \
    X(float, mod, (size_t)DEPTH * 5 * NMOD * 4)                 \
    X(float, H2a, (size_t)DEPTH * SEQ * 64 * 4) \
    X(float, H2b, (size_t)DEPTH * CTXL * 64 * 4) \
    X(float, HT1, (size_t)DEPTH * 2048 * CTXL * 4) \
    X(float, SSQ0, (size_t)DEPTH * 2048 * 128 * 4) \
    X(float, SSQ1, (size_t)DEPTH * 2048 * 8 * 4) \
    X(float, SCL0, (size_t)DEPTH * 2048 * 4) \
    X(float, SCL1, (size_t)DEPTH * 2048 * 4) \
    X(float, hx, (size_t)TT * DM * 4)                           \
    X(bf16_t, U, (size_t)TT * DM * 2)                           \
    X(bf16_t, PT, (size_t)NB * HYC * SEQ * 2)                   \
    X(bf16_t, PTc, (size_t)NB * HYC * CTXL * 2) \
    X(bf16_t, PMLAb, (size_t)TT * 640 * 2)                      \
    X(bf16_t, G, (size_t)TT * 2048 * 2)                         \
    X(bf16_t, Q, (size_t)NB * NH * SEQ * 128 * 2)               \
    X(bf16_t, Qc, (size_t)NB * NH * CTXL * 128 * 2) \
    X(bf16_t, K, (size_t)NB * NH * NKEY * DQK * 2)              \
    X(bf16_t, V, (size_t)NB * NH * NKEY * DV * 2)               \
    X(bf16_t, Yatt, (size_t)TT * 512 * 2) \
    X(bf16_t, Yhy, (size_t)TT * 512 * 2) \
    X(bf16_t, M1, (size_t)TT * DM * 2) \
    X(int, list, (size_t)NE * CAP * 4) \
    X(float, wl, (size_t)NE * CAP * 4) \
    X(int, asg, (size_t)TT * 4 * 4) \
    X(bf16_t, Hb, (size_t)(2 * TT + 256) * DE * 2) \
    X(bf16_t, Y, (size_t)2 * TT * DM * 2) \
    X(bf16_t, WtHy, (size_t)DEPTH * HYC * DM * 2)               \
    X(bf16_t, WtRest, (size_t)DEPTH * 2816 * DM * 2) \
    X(bf16_t, WtUq, (size_t)DEPTH * 768 * QL * 2) \
    X(bf16_t, WtUkv, (size_t)DEPTH * 1024 * KVL * 2) \
    X(bf16_t, WtHyo, (size_t)DEPTH * DM * HYW * 2) \
    X(bf16_t, WtMlao, (size_t)DEPTH * DM * 512 * 2) \
    X(bf16_t, WtOut, (size_t)DEPTH * DM * DM * 2) \
    X(bf16_t, WtG, (size_t)NE * DE * DM * 2)                    \
    X(bf16_t, WtU, (size_t)NE * DE * DM * 2) \
    X(bf16_t, WtD, (size_t)NE * DM * DE * 2) \
    X(float2, rope, (size_t)SEQ * 16 * 8)                       \
    X(float2, Hs, (size_t)DEPTH * HYW * 4 * 4096 * 8)           \
    X(float2, Wtab, 4096 * 8) \
    X(bf16_t, WrT, (size_t)DEPTH * 2 * 80 * DM * 2)             \
    X(float2, W2tab, 4096 * 8)
struct WsOff {
#define X(t, n, b) size_t n;
    WS_LIST(X)
#undef X
    size_t total;
};
constexpr WsOff ws_layout() {
    WsOff o{}; size_t a = 0;
#define X(t, n, b) o.n = a; a += (((size_t)(b)) + 255) & ~(size_t)255;
    WS_LIST(X)
#undef X
    o.total = a; return o;
}
constexpr WsOff WSO = ws_layout();
constexpr size_t WS_ZERO_BYTES = WSO.modp;
static_assert(WSO.Yatt - WSO.G >= (size_t)DEPTH * 2048 * SEQ * 4, "HT0 alias region too small");

struct PK { const float* in[33]; float* out; char* ws; };
struct P {
    const float *x, *c, *ctx, *c_ctx, *w_ada, *b_ada, *norm1_g, *w_in, *q_norm_g, *kv_norm_g, *w_uq, *w_ukv, *sc_w, *sc_b;
    const float *flt_w1, *flt_b1, *flt_freq, *flt_w2, *flt_b2, *flt_w3, *flt_bias, *w_hy_o, *w_mla_o, *w_out, *norm2_g;
    const float *w_rg, *b_rg, *w_re, *b_re, *w_gate, *w_up, *w_down, *final_g;
    float* out;
#define X(t, n, b) t* n;
    WS_LIST(X)
#undef X
    float* HT0;
};
typedef const __attribute__((address_space(4))) PK* KArgP;
__device__ __forceinline__ P make_p(KArgP kp) {
    P p; const KArgP& kk = kp; char* ws = kk->ws;
    p.x = kk->in[0]; p.c = kk->in[1]; p.ctx = kk->in[2]; p.c_ctx = kk->in[3]; p.w_ada = kk->in[4]; p.b_ada = kk->in[5]; p.norm1_g = kk->in[6]; p.w_in = kk->in[7];
    p.q_norm_g = kk->in[8]; p.kv_norm_g = kk->in[9]; p.w_uq = kk->in[10]; p.w_ukv = kk->in[11]; p.sc_w = kk->in[12]; p.sc_b = kk->in[13];
    p.flt_w1 = kk->in[14]; p.flt_b1 = kk->in[15]; p.flt_freq = kk->in[16]; p.flt_w2 = kk->in[17]; p.flt_b2 = kk->in[18]; p.flt_w3 = kk->in[19]; p.flt_bias = kk->in[20];
    p.w_hy_o = kk->in[21]; p.w_mla_o = kk->in[22]; p.w_out = kk->in[23]; p.norm2_g = kk->in[24]; p.w_rg = kk->in[25]; p.b_rg = kk->in[26]; p.w_re = kk->in[27]; p.b_re = kk->in[28];
    p.w_gate = kk->in[29]; p.w_up = kk->in[30]; p.w_down = kk->in[31]; p.final_g = kk->in[32];
    p.out = kk->out;
#define X(t, n, b) p.n = (t*)(ws + WSO.n);
    WS_LIST(X)
#undef X
    p.HT0 = (float*)(ws + WSO.G);
    return p;
}

constexpr int MODK = 32;
__device__ __forceinline__ void ph_mod_partial(const P& p, char* smem) {
    float* s = (float*)smem;
    const int tid = tid_opaque();
    for (int it = blockIdx.x; it < DEPTH * MODK * 3; it += gridDim.x) {
        const int l = it / (MODK * 3), kc = (it / 3) % MODK, jb = it % 3;
        __syncthreads();
        if (tid < 5 * 32) {
            const int r = tid / 32, kk = tid % 32, k = kc * 32 + kk;
            const float cv = (r < 4) ? p.c[r * DM + k] : p.c_ctx[k];
            s[tid] = cv / (1.0f + expf(-cv));
        }
        __syncthreads();
        const int j = jb * 2048 + tid * 4;
        f32x4 a0 = {0.f, 0.f, 0.f, 0.f}, a1 = a0, a2 = a0, a3 = a0, a4 = a0;
        const float* w = p.w_ada + ((size_t)l * DM + kc * 32) * NMOD + j;
#pragma unroll 8
        for (int kk = 0; kk < 32; ++kk) {
            const f32x4 wv = *(const f32x4*)(w + (size_t)kk * NMOD);
            a0 += wv * s[kk]; a1 += wv * s[32 + kk]; a2 += wv * s[64 + kk]; a3 += wv * s[96 + kk]; a4 += wv * s[128 + kk];
        }
        float* o = p.modp + ((size_t)(l * MODK + kc) * 5) * NMOD + j;
        *(f32x4*)o = a0; *(f32x4*)(o + NMOD) = a1; *(f32x4*)(o + 2 * NMOD) = a2; *(f32x4*)(o + 3 * NMOD) = a3; *(f32x4*)(o + 4 * NMOD) = a4;
    }
}

__device__ __forceinline__ void ph_filter_a(const P& p, char* smem) {
    float* zs = (float*)smem;
    float* h1s = zs + 8 * 36;
    const int tid = tid_opaque(), tt = tid >> 6, j = tid & 63;
    const int n0 = DEPTH * 512, n1 = DEPTH * 32;
    for (int it = blockIdx.x; it < n0 + n1; it += gridDim.x) {
        int l, ls, tg;
        if (it < n0) { ls = 0; l = it / 512; tg = it % 512; } else { ls = 1; l = (it - n0) / 32; tg = (it - n0) % 32; }
        const int L = ls ? CTXL : SEQ;
        const int t = tg * 8 + tt;
        __syncthreads();
        if (j < 33) {
            float f;
            if (j == 0) f = (float)t / (float)(L - 1);
            else {
                const int k = (j - 1) & 15;
                const float band = 1e-4f + (float)k * ((15.0f - 1e-4f) / 15.0f);
                const float w = 6.283185307179586f * (float)t / (float)L;
                const double ang = (double)band * (double)w;
                f = (j <= 16) ? (float)cos(ang) : (float)(-sin(ang));
            }
            zs[tt * 36 + j] = f;
        }
        __syncthreads();
        const float fr = p.flt_freq[l * 64 + j];
        float a = p.flt_b1[l * 64 + j];
        for (int i = 0; i < 33; ++i) a += zs[tt * 36 + i] * p.flt_w1[((size_t)l * 33 + i) * 64 + j];
        h1s[tt * 64 + j] = sinf(fr * a);
        __syncthreads();
        float a2 = p.flt_b2[l * 64 + j];
        for (int i = 0; i < 64; ++i) a2 += h1s[tt * 64 + i] * p.flt_w2[((size_t)l * 64 + i) * 64 + j];
        const float h2 = sinf(fr * a2);
        if (ls == 0) p.H2a[((size_t)l * SEQ + t) * 64 + j] = h2; else p.H2b[((size_t)l * CTXL + t) * 64 + j] = h2;
    }
}

typedef float f32x16 __attribute__((ext_vector_type(16)));
__device__ __forceinline__ void ph_filter_b2(const P& p, char* smem) {
    float* sA = (float*)smem;
    const int tid = tid_opaque(), lane = tid & 63, wv = tid >> 6, li = lane & 31, hf = lane >> 5;
    const int n0 = DEPTH * 128 * 8, n1 = DEPTH * 8 * 8;
    const float DA = -15.350567286626973f, DB = -3.0701134573253946f;
    for (int it = blockIdx.x; it < n0 + n1; it += gridDim.x) {
        int l, ls, tt, cg;
        if (it < n0) { ls = 0; l = it / 1024; tt = (it / 8) % 128; cg = it % 8; } else { const int i2 = it - n0; ls = 1; l = i2 / 64; tt = (i2 / 8) % 8; cg = i2 % 8; }
        const int L = ls ? CTXL : SEQ, t0 = tt * 32;
        const float* h2 = ls ? p.H2b + ((size_t)l * CTXL + t0) * 64 : p.H2a + ((size_t)l * SEQ + t0) * 64;
        __syncthreads();
        { const int r = tid >> 4, k4 = (tid & 15) * 4; const float4 v = *(const float4*)(h2 + r * 64 + k4); float* d = sA + r * 65 + k4; d[0] = v.x; d[1] = v.y; d[2] = v.z; d[3] = v.w; }
        __syncthreads();
        const int col = cg * 256 + wv * 32 + li;
        const float* wp = p.flt_w3 + (size_t)l * 64 * 2048 + col;
        f32x16 acc;
#pragma unroll
        for (int i = 0; i < 16; ++i) acc[i] = 0.f;
#pragma unroll 8
        for (int s2 = 0; s2 < 32; ++s2) {
            const int k = 2 * s2 + hf;
            acc = __builtin_amdgcn_mfma_f32_32x32x2f32(sA[li * 65 + k], wp[(size_t)k * 2048], acc, 0, 0, 0);
        }
        const int ch = col & 511;
        const float delta = fabsf(DA + (float)ch * ((DB - DA) / 511.0f));
        float q = 0.f;
        float* dst = (ls ? p.HT1 + ((size_t)l * 2048 + col) * CTXL : p.HT0 + ((size_t)l * 2048 + col) * SEQ) + t0 + 4 * hf;
#pragma unroll
        for (int g4 = 0; g4 < 4; ++g4) {
            float4 o;
            float* op = &o.x;
#pragma unroll
            for (int e = 0; e < 4; ++e) { const int t = t0 + 8 * g4 + 4 * hf + e; const float v = acc[4 * g4 + e] * expf(-((float)t / (float)(L - 1)) * delta); op[e] = v; q += v * v; }
            *(float4*)(dst + 8 * g4) = o;
        }
        q += shx(q, 32);
        if (hf == 0) { if (ls == 0) p.SSQ0[((size_t)l * 2048 + col) * 128 + tt] = q; else p.SSQ1[((size_t)l * 2048 + col) * 8 + tt] = q; }
    }
    __syncthreads();
}

__device__ __forceinline__ void ph_finalize(const P& p) {
    const int n_mod = DEPTH * 5 * NMOD, n_s = DEPTH * 2048;
    for (int i = blockIdx.x * NT + threadIdx.x; i < n_mod + 2 * n_s; i += gridDim.x * NT) {
        if (i < n_mod) {
            const int l = i / (5 * NMOD), r = (i / NMOD) % 5, j = i % NMOD;
            float a = p.b_ada[l * NMOD + j];
            for (int kc = 0; kc < MODK; ++kc) a += p.modp[((size_t)(l * MODK + kc) * 5 + r) * NMOD + j];
            p.mod[i] = a;
        } else if (i < n_mod + n_s) {
            const int k = i - n_mod; float a = 0.f;
            for (int q = 0; q < 128; ++q) a += p.SSQ0[(size_t)k * 128 + q];
            p.SCL0[k] = rsqrtf(a + epsf());
        } else {
            const int k = i - n_mod - n_s; float a = 0.f;
            for (int q = 0; q < 8; ++q) a += p.SSQ1[(size_t)k * 8 + q];
            p.SCL1[k] = rsqrtf(a + epsf());
        }
    }
}

__device__ __forceinline__ float rope_apply(float self, float partner, int d, int t) {
    const int a = d >> 4, s = (d >> 3) & 1, i = d & 7;
    const float pos = (float)(a == 0 ? (t >> 6) : (t & 63));
    const float inv = powf(10000.0f, -(float)i / 8.0f);
    const float ang = pos * inv;
    const float cs = cosf(ang), sn = sinf(ang);
    return s == 0 ? self * cs - partner * sn : partner * sn + self * cs;
}

namespace ge {
constexpr int BM = 256, BK = 64, HALF = 128, HTB = HALF * BK * 2, STAGE_BYTES = 8 * HTB, NXCD = 8, WGM = 8;
__device__ __forceinline__ int lds_byte(int r, int c) { const int st = (r >> 4) * 2 + (c >> 5), rr = r & 15, cc = c & 31, ob = rr * 64 + cc * 2; return st * 1024 + (ob ^ (((ob >> 9) & 1) << 5)); }
__device__ __forceinline__ void stage_rc(int b, int& R, int& C) { const int st = b / 1024, sb = b % 1024, swz = sb ^ (((sb >> 9) & 1) << 5); R = (st >> 1) * 16 + swz / 64; C = (st & 1) * 32 + (swz % 64) / 2; }
__device__ __forceinline__ int perm32(int rho) { const int n = rho >> 4, i = rho & 15; return 8 * (i >> 2) + 4 * n + (i & 3); }
__device__ __forceinline__ void tile_order(int L, int nM, int nN, int& pm, int& pn) {
    const int nwg = nM * nN; int wgid = L;
    { const int q = nwg / NXCD, r = nwg % NXCD, xcd = wgid % NXCD, off = wgid / NXCD; wgid = (xcd < r ? xcd * (q + 1) : r * (q + 1) + (xcd - r) * q) + off; }
    const int nig = WGM * nN, gid = wgid / nig, fm = gid * WGM, gsz = (nM - fm) < WGM ? (nM - fm) : WGM;
    pm = fm + ((wgid % nig) % gsz); pn = (wgid % nig) / gsz;
}
struct Unit { const char* a; const char* b0; const char* b1; const int* rows; int nrows; int pm, pn, kind; };
typedef f32x4 Acc[2][2][4][2];

template <bool GATHER, int ABLK = 0, class Sched, class Epi>
__device__ __forceinline__ void gemm_engine(LAS unsigned char* lds, const int lda, const int ldb, const int K, const Sched& S, const Epi& E) {
    const int tid = tid_opaque(), wid = __builtin_amdgcn_readfirstlane(tid >> 6), lane = tid & 63, wr = wid >> 2, wc = wid & 3, fr = lane & 15, fq = lane >> 4;
    const int nt = K / BK;
    int sR[2], sC[2];
    unsigned voffA[2], voffB[2];
#pragma unroll
    for (int i = 0; i < 2; ++i) { stage_rc(tid * 16 + i * 8192, sR[i], sC[i]); const int Rb = (sR[i] & ~31) + perm32(sR[i] & 31);
        voffA[i] = ABLK ? (unsigned)((sC[i] >> 3) * ABLK + sR[i]) * 16u : (unsigned)(sR[i] * lda + sC[i]) * 2u; voffB[i] = (unsigned)(Rb * ldb + sC[i]) * 2u; }
    const size_t kstep = (size_t)(BK * 2);
    const size_t hstepA = ABLK ? (size_t)HALF * 16 : (size_t)HALF * lda * 2;
    const size_t kstepA = ABLK ? (size_t)(BK / 8) * ABLK * 16 : kstep;
    const unsigned ldsw = (unsigned)wid * 1024u;
    const int aoff = lds_byte(wr * 64 + fr, fq * 8), boff = lds_byte(wc * 32 + fr, fq * 8);
    unsigned gvc[2][2], gvn[2][2];
#define GE_SA(b, h) (((b) * 2 + (h)) * HTB)
#define GE_SB(b, h) ((4 + (b) * 2 + (h)) * HTB)
#define GE_GLDS(src, bufoff, i) __builtin_amdgcn_global_load_lds((const unsigned*)(src), (LAS unsigned*)(lds + (bufoff) + ldsw + (i) * 8192), 16, 0, 0)
#define GE_STAGE_B(bufoff, bp) do { _Pragma("unroll") for (int _i = 0; _i < 2; ++_i) GE_GLDS((bp) + voffB[_i], bufoff, _i); } while (0)
#define GE_STAGE_A(bufoff, ap, h, gv) do { _Pragma("unroll") for (int _i = 0; _i < 2; ++_i) { \
        if constexpr (GATHER) GE_GLDS((ap) + (gv)[h][_i], bufoff, _i); else GE_GLDS((ap) + (size_t)(h) * hstepA + voffA[_i], bufoff, _i); } } while (0)
#define GE_STAGE_A2(bufoff, ap, h) do { _Pragma("unroll") for (int _i = 0; _i < 2; ++_i) { \
        if constexpr (GATHER) GE_GLDS((ap) + (last ? gvn[h][_i] : gvc[h][_i]), bufoff, _i); else GE_GLDS((ap) + (size_t)(h) * hstepA + voffA[_i], bufoff, _i); } } while (0)
#define GE_LDA(dst, b, h) do { _Pragma("unroll") for (int m = 0; m < 4; ++m) _Pragma("unroll") for (int k = 0; k < 2; ++k) dst[m][k] = *(const LAS bf16x8*)(lds + GE_SA(b, h) + aoff + m * 2048 + k * 1024); } while (0)
#define GE_LDB(dst, b, h) do { _Pragma("unroll") for (int n = 0; n < 2; ++n) _Pragma("unroll") for (int k = 0; k < 2; ++k) dst[n][k] = *(const LAS bf16x8*)(lds + GE_SB(b, h) + boff + n * 2048 + k * 1024); } while (0)
#define GE_MMA(ai, bj, At, Bt) do { __builtin_amdgcn_s_setprio(1); _Pragma("unroll") for (int m = 0; m < 4; ++m) _Pragma("unroll") for (int n = 0; n < 2; ++n) _Pragma("unroll") for (int k = 0; k < 2; ++k) \
        acc[ai][bj][m][n] = __builtin_amdgcn_mfma_f32_16x16x32_bf16(Bt[n][k], At[m][k], acc[ai][bj][m][n], 0, 0, 0); __builtin_amdgcn_s_setprio(0); } while (0)
#define GE_WAIT_V(n) asm volatile("s_waitcnt vmcnt(" #n ")" ::: "memory")
#define GE_WAIT_L(n) asm volatile("s_waitcnt lgkmcnt(" #n ")" ::: "memory")
#define GE_BAR __builtin_amdgcn_s_barrier()
#define GE_SCHED __builtin_amdgcn_sched_barrier(0)
#define GE_GATHER_OFFS(gv, u) do { if constexpr (GATHER) { _Pragma("unroll") for (int _h = 0; _h < 2; ++_h) _Pragma("unroll") for (int _i = 0; _i < 2; ++_i) { \
        int _r = (u).pm * BM + _h * HALF + sR[_i]; _r = _r < (u).nrows ? _r : (u).nrows - 1; (gv)[_h][_i] = (unsigned)((u).rows[_r] * lda + sC[_i]) * 2u; } } } while (0)
    Unit cur, nxt; int ui = 0;
    if (!S.next(0, cur)) return;
    Acc acc;
#pragma unroll
    for (int a = 0; a < 2; ++a)
#pragma unroll
        for (int b = 0; b < 2; ++b)
#pragma unroll
            for (int m = 0; m < 4; ++m)
#pragma unroll
                for (int n = 0; n < 2; ++n) acc[a][b][m][n] = (f32x4){0.f, 0.f, 0.f, 0.f};
    bf16x8 At[4][2], B0[2][2], B1[2][2];
    GE_GATHER_OFFS(gvc, cur);
    GE_STAGE_B(GE_SB(0, 0), cur.b0); GE_STAGE_A(GE_SA(0, 0), cur.a, 0, gvc); GE_STAGE_B(GE_SB(0, 1), cur.b1); GE_STAGE_A(GE_SA(0, 1), cur.a, 1, gvc);
    if (wr == 1) GE_BAR;
    GE_WAIT_V(4); GE_BAR;
    GE_STAGE_B(GE_SB(1, 0), cur.b0 + kstep); GE_STAGE_A(GE_SA(1, 0), cur.a + kstepA, 0, gvc); GE_STAGE_B(GE_SB(1, 1), cur.b1 + kstep);
    GE_WAIT_V(6); GE_BAR;
    for (;;) {
        const bool has_next = S.next(ui + 1, nxt);
        if (!has_next) nxt = cur;
        if constexpr (GATHER) { if (has_next) { GE_GATHER_OFFS(gvn, nxt); } else {
#pragma unroll
            for (int h = 0; h < 2; ++h)
#pragma unroll
                for (int i = 0; i < 2; ++i) gvn[h][i] = gvc[h][i]; } }
#pragma unroll 1
        for (int t = 0; t < nt; t += 2) {
            const bool last = (t == nt - 2);
            const char* a1 = cur.a + (size_t)(t + 1) * kstepA;
            const char* a2 = last ? nxt.a : cur.a + (size_t)(t + 2) * kstepA;
            const char* b20 = last ? nxt.b0 : cur.b0 + (size_t)(t + 2) * kstep;
            const char* b21 = last ? nxt.b1 : cur.b1 + (size_t)(t + 2) * kstep;
            const char* a3 = a2 + kstepA; const char* b30 = b20 + kstep; const char* b31 = b21 + kstep;
            GE_LDB(B0, 0, 0); GE_SCHED; GE_LDA(At, 0, 0); GE_STAGE_A(GE_SA(1, 1), a1, 1, gvc);
            GE_WAIT_L(8); GE_BAR; GE_WAIT_L(0); GE_MMA(0, 0, At, B0); GE_BAR; GE_SCHED;
            GE_LDB(B1, 0, 1); GE_STAGE_B(GE_SB(0, 0), b20);
            GE_BAR; GE_WAIT_L(0); GE_MMA(0, 1, At, B1); GE_BAR;
            GE_LDA(At, 0, 1); GE_STAGE_A2(GE_SA(0, 0), a2, 0);
            GE_BAR; GE_WAIT_L(0); GE_MMA(1, 0, At, B0); GE_BAR; GE_SCHED;
            GE_STAGE_B(GE_SB(0, 1), b21);
            GE_WAIT_V(6); GE_BAR; GE_MMA(1, 1, At, B1); GE_BAR;
            GE_LDB(B0, 1, 0); GE_SCHED; GE_LDA(At, 1, 0); GE_STAGE_A2(GE_SA(0, 1), a2, 1);
            GE_WAIT_L(8); GE_BAR; GE_WAIT_L(0); GE_MMA(0, 0, At, B0); GE_BAR; GE_SCHED;
            GE_LDB(B1, 1, 1); GE_STAGE_B(GE_SB(1, 0), b30);
            GE_BAR; GE_WAIT_L(0); GE_MMA(0, 1, At, B1); GE_BAR;
            GE_LDA(At, 1, 1); GE_STAGE_A2(GE_SA(1, 0), a3, 0);
            GE_BAR; GE_WAIT_L(0); GE_MMA(1, 0, At, B0); GE_BAR; GE_SCHED;
            GE_STAGE_B(GE_SB(1, 1), b31);
            GE_WAIT_V(6); GE_BAR; GE_MMA(1, 1, At, B1); GE_BAR;
        }
        E(acc, cur, wr, wc, fr, fq);
        if (!has_next) break;
#pragma unroll
        for (int a = 0; a < 2; ++a)
#pragma unroll
            for (int b = 0; b < 2; ++b)
#pragma unroll
                for (int m = 0; m < 4; ++m)
#pragma unroll
                    for (int n = 0; n < 2; ++n) acc[a][b][m][n] = (f32x4){0.f, 0.f, 0.f, 0.f};
        cur = nxt; ++ui;
        if constexpr (GATHER) {
#pragma unroll
            for (int h = 0; h < 2; ++h)
#pragma unroll
                for (int i = 0; i < 2; ++i) gvc[h][i] = gvn[h][i]; }
    }
    GE_WAIT_V(0);
    if (wr == 0) GE_BAR;
    GE_BAR;
#undef GE_SA
#undef GE_SB
#undef GE_GLDS
#undef GE_STAGE_A
#undef GE_STAGE_A2
#undef GE_STAGE_B
#undef GE_LDA
#undef GE_LDB
#undef GE_MMA
#undef GE_WAIT_V
#undef GE_WAIT_L
#undef GE_BAR
#undef GE_SCHED
#undef GE_GATHER_OFFS
}
}
__device__ __forceinline__ unsigned cvt_pk_bf16(float lo, float hi) { unsigned r; asm volatile("v_cvt_pk_bf16_f32 %0, %1, %2" : "=v"(r) : "v"(lo), "v"(hi)); return r; }
__device__ __forceinline__ u32x4 pack8(const f32x4 a, const f32x4 b) { u32x4 w; w.x = cvt_pk_bf16(a[0], a[1]); w.y = cvt_pk_bf16(a[2], a[3]); w.z = cvt_pk_bf16(b[0], b[1]); w.w = cvt_pk_bf16(b[2], b[3]); return w; }
__device__ __forceinline__ void unpack8(const u32x4 w, f32x4& a, f32x4& b) {
    a[0] = __uint_as_float(w.x << 16); a[1] = __uint_as_float(w.x & 0xFFFF0000u); a[2] = __uint_as_float(w.y << 16); a[3] = __uint_as_float(w.y & 0xFFFF0000u);
    b[0] = __uint_as_float(w.z << 16); b[1] = __uint_as_float(w.z & 0xFFFF0000u); b[2] = __uint_as_float(w.w << 16); b[3] = __uint_as_float(w.w & 0xFFFF0000u); }
__device__ __forceinline__ float sigmoidf_fast(float v) { return 1.0f / (1.0f + __expf(-v)); }

struct SchedDense {
    const char* A; const char* B; size_t arb, brb; int nM, nN, G, c;
    __device__ __forceinline__ bool next(int i, ge::Unit& u) const {
        const int L = i * G + c; if (L >= nM * nN) return false;
        int pm, pn; ge::tile_order(L, nM, nN, pm, pn);
        u.pm = pm; u.pn = pn; u.kind = 0; u.rows = nullptr; u.nrows = 0;
        u.a = A + (size_t)pm * 256 * arb; u.b0 = B + (size_t)pn * 256 * brb; u.b1 = u.b0 + 128 * brb; return true;
    }
};
struct SchedInproj {
    const char* WtHy; const char* WtRest; const char* U; int G, c;
    __device__ __forceinline__ bool next(int i, ge::Unit& u) const {
        const int L = i * G + c; if (L >= 408 + 748) return false;
        int pm, pn; u.rows = nullptr; u.nrows = 0;
        if (L < 408) { ge::tile_order(L, 6, 68, pm, pn); u.kind = 0; u.a = WtHy + (size_t)pm * 256 * 2048; u.b0 = U + (size_t)pn * 256 * 2048; }
        else { ge::tile_order(L - 408, 68, 11, pm, pn); u.kind = 1; u.a = U + (size_t)pm * 256 * 2048; u.b0 = WtRest + (size_t)pn * 256 * 2048; }
        u.b1 = u.b0 + 128 * 2048; u.pm = pm; u.pn = pn; return true;
    }
};
struct EpiInproj {
    bf16_t* PT; bf16_t* PTc; bf16_t* G;
    __device__ __forceinline__ void operator()(const ge::Acc& acc, const ge::Unit& u, int wr, int wc, int fr, int fq) const {
#pragma unroll
        for (int ai = 0; ai < 2; ++ai)
#pragma unroll
            for (int m = 0; m < 4; ++m) {
                const int r = u.pm * 256 + ai * 128 + wr * 64 + m * 16 + fr;
#pragma unroll
                for (int bj = 0; bj < 2; ++bj) {
                    const int c0 = bj * 128 + wc * 32 + fq * 8;
                    if (u.kind == 0) {
                        bf16_t* dst = (u.pn < 64) ? PT + ((size_t)((u.pn >> 4) * HYC + r)) * SEQ + (u.pn & 15) * 256 + c0
                                                  : PTc + ((size_t)((u.pn - 64) * HYC + r)) * CTXL + c0;
                        *(u32x4*)dst = pack8(acc[ai][bj][m][0], acc[ai][bj][m][1]);
                    } else {
                        const int c = (u.pn - 3) * 256 + c0;
                        f32x4 a = acc[ai][bj][m][0], b = acc[ai][bj][m][1];
#pragma unroll
                        for (int j = 0; j < 4; ++j) { a[j] = sigmoidf_fast(a[j]); b[j] = sigmoidf_fast(b[j]); }
                        *(u32x4*)(G + (size_t)r * 2048 + c) = pack8(a, b);
                    }
                }
            }
    }
};
struct EpiQ {
    bf16_t* Q; bf16_t* Qc; const LAS float* rope;
    const LAS float* rs;
    __device__ __forceinline__ void operator()(const ge::Acc& acc, const ge::Unit& u, int wr, int wc, int fr, int fq) const {
#pragma unroll
        for (int ai = 0; ai < 2; ++ai)
#pragma unroll
            for (int m = 0; m < 4; ++m) {
                const int r = u.pm * 256 + ai * 128 + wr * 64 + m * 16 + fr;
                const bool lat = r < TL;
                const int t = lat ? (r & 4095) : ((r - TL) & 255);
                const int b = lat ? (r >> 12) : ((r - TL) >> 8);
#pragma unroll
                for (int bj = 0; bj < 2; ++bj) {
                    const int c = u.pn * 256 + bj * 128 + wc * 32 + fq * 8;
                    const int h = c / 96, dd = c - h * 96;
                    const float rsc = QSCALE * rs[ai * 128 + wr * 64 + m * 16 + fr];
                    f32x4 v0 = acc[ai][bj][m][0] * rsc, v1 = acc[ai][bj][m][1] * rsc;
                    f32x4 p0, p1;
#pragma unroll
                    for (int j = 0; j < 4; ++j) { p0[j] = shx(v0[j], 16); p1[j] = shx(v1[j], 16); }
                    bf16_t* qrow = lat ? Q + ((size_t)(b * NH + h) * SEQ + t) * 128 : Qc + ((size_t)(b * NH + h) * CTXL + t) * 128;
                    if (dd < 64) *(u32x4*)(qrow + dd) = pack8(v0, v1);
                    else {
                        const int d0 = dd - 64;
                        f32x4 o0 = v0, o1 = v1;
                        if (lat) {
                            const LAS float* rp = rope + 2 * ((d0 >> 4) ? 32 + (t & 63) * 8 : ((t >> 6) & 3) * 8);
                            const bool s1 = (d0 >> 3) & 1;
#pragma unroll
                            for (int j = 0; j < 4; ++j) {
                                const float cax = rp[2 * j], cay = rp[2 * j + 1], cbx = rp[8 + 2 * j], cby = rp[9 + 2 * j];
                                o0[j] = s1 ? p0[j] * cay + v0[j] * cax : v0[j] * cax - p0[j] * cay;
                                o1[j] = s1 ? p1[j] * cby + v1[j] * cbx : v1[j] * cbx - p1[j] * cby;
                            }
                        }
                        *(u32x4*)(qrow + 64 + d0) = pack8(o0, o1);
                        *(u32x4*)(qrow + 96 + d0) = pack8(v0, v1);
                    }
                }
            }
    }
};
struct EpiKV {
    bf16_t* K; bf16_t* V; const LAS float* rs;
    __device__ __forceinline__ void operator()(const ge::Acc& acc, const ge::Unit& u, int wr, int wc, int fr, int fq) const {
#pragma unroll
        for (int ai = 0; ai < 2; ++ai)
#pragma unroll
            for (int m = 0; m < 4; ++m) {
                const int r = u.pm * 256 + ai * 128 + wr * 64 + m * 16 + fr;
                int b, key;
                if (r < TL) { b = r >> 12; key = r & 4095; } else { b = (r - TL) >> 8; key = SEQ + ((r - TL) & 255); }
#pragma unroll
                for (int bj = 0; bj < 2; ++bj) {
                    const int c = u.pn * 256 + bj * 128 + wc * 32 + fq * 8;
                    const int h = c >> 7, d = c & 127;
                    const size_t kb = (size_t)(b * NH + h) * NKEY + key;
                    bf16_t* dst = (d < 64) ? K + kb * DQK + d : V + kb * DV + (d - 64);
                    const float rk = rs[ai * 128 + wr * 64 + m * 16 + fr]; *(u32x4*)dst = pack8(acc[ai][bj][m][0] * rk, acc[ai][bj][m][1] * rk);
                }
            }
    }
};

constexpr int LDS_SSQ = ge::STAGE_BYTES + 2048;
struct EpiInprojMLA {
    bf16_t* PMLAb; bf16_t* K; const float2* rope; LAS float* ssq;
    __device__ __forceinline__ void operator()(const ge::Acc& acc, const ge::Unit& u, int wr, int wc, int fr, int fq) const {
#pragma unroll
        for (int ai = 0; ai < 2; ++ai)
#pragma unroll
            for (int m = 0; m < 4; ++m) {
                const int rl = ai * 128 + wr * 64 + m * 16 + fr, r = u.pm * 256 + rl;
#pragma unroll
                for (int bj = 0; bj < 2; ++bj) {
                    const int c0 = bj * 128 + wc * 32 + fq * 8;
                    const f32x4 a = acc[ai][bj][m][0], b = acc[ai][bj][m][1];
                    const bool isval = (u.pn < 2) || (bj == 0);
                    const bool isrope = (u.pn == 2) && (bj == 1) && (wc == 0);
                    if (isval) {
                        const int col = (u.pn == 0 ? 0 : (u.pn == 1 ? 256 : 512)) + c0;
                        *(u32x4*)(PMLAb + (size_t)r * 640 + col) = pack8(a, b);
                        float sq = (a[0] * a[0] + a[1] * a[1]) + (a[2] * a[2] + a[3] * a[3]) + (b[0] * b[0] + b[1] * b[1]) + (b[2] * b[2] + b[3] * b[3]);
                        sq += shx(sq, 16); sq += shx(sq, 32);
                        if (fq == 0) ssq[rl * 16 + (u.pn == 2 ? 8 : 0) + bj * 4 + wc] = sq;
                    } else if (isrope) {
                        f32x4 pa, pb;
#pragma unroll
                        for (int j = 0; j < 4; ++j) { pa[j] = shx(a[j], 16); pb[j] = shx(b[j], 16); }
                        int bb, key; f32x4 oa = a, ob = b;
                        if (r < TL) {
                            bb = r >> 12; key = r & 4095;
                            const float2* rp = rope + (size_t)key * 16 + (fq >> 1) * 8;
#pragma unroll
                            for (int j = 0; j < 4; ++j) { const float2 ca = rp[j], cb = rp[4 + j];
                                oa[j] = (fq & 1) ? pa[j] * ca.y + a[j] * ca.x : a[j] * ca.x - pa[j] * ca.y;
                                ob[j] = (fq & 1) ? pb[j] * cb.y + b[j] * cb.x : b[j] * cb.x - pb[j] * cb.y; }
                        } else { bb = (r - TL) >> 8; key = SEQ + ((r - TL) & 255); }
                        const u32x4 w = pack8(oa, ob);
#pragma unroll
                        for (int h = 0; h < NH; ++h) *(u32x4*)(K + ((size_t)(bb * NH + h) * NKEY + key) * DQK + 64 + fq * 8) = w;
                    }
                }
            }
    }
};
struct SchedChainIn {
    const char* U; const char* WtRest; int pm, pn0, npn;
    __device__ __forceinline__ bool next(int i, ge::Unit& u) const {
        if (i >= npn) return false;
        u.pm = pm; u.pn = pn0 + i; u.kind = 1; u.rows = nullptr; u.nrows = 0;
        u.a = U + (size_t)pm * 256 * 2048; u.b0 = WtRest + (size_t)u.pn * 256 * 2048; u.b1 = u.b0 + 128 * 2048; return true;
    }
};
struct SchedPanel {
    const char* A; const char* B; size_t arb, brb; int pm, nN, kind;
    __device__ __forceinline__ bool next(int i, ge::Unit& u) const {
        if (i >= nN) return false;
        u.pm = pm; u.pn = i; u.kind = kind; u.rows = nullptr; u.nrows = 0;
        u.a = A + (size_t)pm * 256 * arb; u.b0 = B + (size_t)i * 256 * brb; u.b1 = u.b0 + 128 * brb; return true;
    }
};
struct SchedPool {
    const char* WtHy; const char* WtRest; const char* U; int first, step, n;
    __device__ __forceinline__ bool next(int i, ge::Unit& u) const {
        if (i >= n) return false;
        const int X = first + i * step; int pm, pn; u.rows = nullptr; u.nrows = 0;
        if (X < 408) { ge::tile_order(X, 6, 68, pm, pn); u.kind = 0; u.a = WtHy + (size_t)pm * 256 * 2048; u.b0 = U + (size_t)pn * 256 * 2048; }
        else { ge::tile_order(X - 408, 68, 8, pm, pn); pn += 3; u.kind = 1; u.a = U + (size_t)pm * 256 * 2048; u.b0 = WtRest + (size_t)pn * 256 * 2048; }
        u.b1 = u.b0 + 128 * 2048; u.pm = pm; u.pn = pn; return true;
    }
};
struct EpiQKV {
    EpiQ q; EpiKV kv;
    __device__ __forceinline__ void operator()(const ge::Acc& acc, const ge::Unit& u, int wr, int wc, int fr, int fq) const { if (u.kind == 0) q(acc, u, wr, wc, fr, fq); else kv(acc, u, wr, wc, fr, fq); }
};
struct SchedMerge {
    const char* Yhy; const char* Yatt; const char* Whyo; const char* Wmlao; int G, c, nM;
    __device__ __forceinline__ bool next(int i, ge::Unit& u) const {
        const int T = (i >> 1) * G + c; if (T >= nM * 4) return false;
        const int seg = i & 1; int pm, pn; ge::tile_order(T, nM, 4, pm, pn);
        u.pm = pm; u.pn = pn; u.kind = seg; u.rows = nullptr; u.nrows = 0;
        u.a = (seg ? Yatt : Yhy) + (size_t)pm * 256 * 16; u.b0 = (seg ? Wmlao : Whyo) + (size_t)pn * 256 * 1024; u.b1 = u.b0 + 128 * 1024; return true;
    }
};
struct EpiMerge {
    const bf16_t* G; bf16_t* M1;
    __device__ __forceinline__ void operator()(const ge::Acc& acc, const ge::Unit& u, int wr, int wc, int fr, int fq) const {
#pragma unroll
        for (int ai = 0; ai < 2; ++ai) {
            u32x4 gv[4][2], mv[4][2];
#pragma unroll
            for (int m = 0; m < 4; ++m) {
                const int r = u.pm * 256 + ai * 128 + wr * 64 + m * 16 + fr;
#pragma unroll
                for (int bj = 0; bj < 2; ++bj) {
                    const int c = u.pn * 256 + bj * 128 + wc * 32 + fq * 8;
                    gv[m][bj] = *(const u32x4*)(G + (size_t)r * 2048 + u.kind * DM + c);
                    if (u.kind) mv[m][bj] = *(const u32x4*)(M1 + (size_t)r * DM + c);
                }
            }
#pragma unroll
            for (int m = 0; m < 4; ++m) {
                const int r = u.pm * 256 + ai * 128 + wr * 64 + m * 16 + fr;
#pragma unroll
                for (int bj = 0; bj < 2; ++bj) {
                    const int c = u.pn * 256 + bj * 128 + wc * 32 + fq * 8;
                    f32x4 g0, g1; unpack8(gv[m][bj], g0, g1);
                    f32x4 o0 = g0 * acc[ai][bj][m][0], o1 = g1 * acc[ai][bj][m][1];
                    if (u.kind) { f32x4 q0, q1; unpack8(mv[m][bj], q0, q1); o0 += q0; o1 += q1; }
                    *(u32x4*)(M1 + (size_t)r * DM + c) = pack8(o0, o1);
                }
            }
        }
    }
};
struct EpiOut {
    float* hx; const float* mod;
    __device__ __forceinline__ void operator()(const ge::Acc& acc, const ge::Unit& u, int wr, int wc, int fr, int fq) const {
        const int b = u.pm < 64 ? (u.pm >> 4) : 4;
        f32x4 gg[2][2];
#pragma unroll
        for (int bj = 0; bj < 2; ++bj) { const float* g = mod + (size_t)b * NMOD + 2 * DM + u.pn * 256 + bj * 128 + wc * 32 + fq * 8; gg[bj][0] = *(const f32x4*)g; gg[bj][1] = *(const f32x4*)(g + 4); }
#pragma unroll
        for (int ai = 0; ai < 2; ++ai) {
            f32x4 hv[4][2][2];
#pragma unroll
            for (int m = 0; m < 4; ++m) {
                const int r = u.pm * 256 + ai * 128 + wr * 64 + m * 16 + fr;
#pragma unroll
                for (int bj = 0; bj < 2; ++bj) { const float* src = hx + (size_t)r * DM + u.pn * 256 + bj * 128 + wc * 32 + fq * 8; hv[m][bj][0] = *(const f32x4*)src; hv[m][bj][1] = *(const f32x4*)(src + 4); }
            }
#pragma unroll
            for (int m = 0; m < 4; ++m) {
                const int r = u.pm * 256 + ai * 128 + wr * 64 + m * 16 + fr;
#pragma unroll
                for (int bj = 0; bj < 2; ++bj) {
                    float* dst = hx + (size_t)r * DM + u.pn * 256 + bj * 128 + wc * 32 + fq * 8;
                    *(f32x4*)dst = hv[m][bj][0] + gg[bj][0] * acc[ai][bj][m][0];
                    *(f32x4*)(dst + 4) = hv[m][bj][1] + gg[bj][1] * acc[ai][bj][m][1];
                }
            }
        }
    }
};
struct SchedGU {
    const char* U; const char* WtG; const char* WtU; const int* list; const LAS int* tpre; const LAS int* cntl; int G, c;
    __device__ __forceinline__ bool next(int i, ge::Unit& u) const {
        const int L = i * G + c; if (L >= 2 * tpre[64]) return false;
        const int rt = L >> 1, half = L & 1; int e = 0;
#pragma unroll
        for (int st_ = 32; st_ > 0; st_ >>= 1) { if (tpre[e + st_] <= rt) e += st_; }
        u.kind = e; u.pm = rt - tpre[e]; u.pn = half; u.rows = list + (size_t)e * CAP; u.nrows = cntl[e];
        u.a = U; u.b0 = WtG + ((size_t)e * DE + half * 128) * 2048; u.b1 = WtU + ((size_t)e * DE + half * 128) * 2048; return true;
    }
};
struct EpiGU {
    bf16_t* H; const LAS int* offs;
    __device__ __forceinline__ void operator()(const ge::Acc& acc, const ge::Unit& u, int wr, int wc, int fr, int fq) const {
        const int o = offs[u.kind];
#pragma unroll
        for (int ai = 0; ai < 2; ++ai)
#pragma unroll
            for (int m = 0; m < 4; ++m) {
                const int r = u.pm * 256 + ai * 128 + wr * 64 + m * 16 + fr;
                if (r < u.nrows) {
                    const int c = u.pn * 128 + wc * 32 + fq * 8;
                    f32x4 g0 = acc[ai][0][m][0], g1 = acc[ai][0][m][1];
#pragma unroll
                    for (int j = 0; j < 4; ++j) { g0[j] = g0[j] * sigmoidf_fast(g0[j]) * acc[ai][1][m][0][j]; g1[j] = g1[j] * sigmoidf_fast(g1[j]) * acc[ai][1][m][1][j]; }
                    *(u32x4*)(H + (size_t)(o + r) * DE + c) = pack8(g0, g1);
                }
            }
    }
};
struct SchedDown {
    const char* H; const char* WtD; const LAS int* tpre; const LAS int* cntl; const LAS int* offs; int G, c;
    __device__ __forceinline__ bool next(int i, ge::Unit& u) const {
        const int L = i * G + c; if (L >= 4 * tpre[64]) return false;
        const int rt = L >> 2, pn = L & 3; int e = 0;
#pragma unroll
        for (int st_ = 32; st_ > 0; st_ >>= 1) { if (tpre[e + st_] <= rt) e += st_; }
        u.kind = e; u.pm = rt - tpre[e]; u.pn = pn; u.rows = nullptr; u.nrows = cntl[e];
        u.a = H + ((size_t)offs[e] + (size_t)u.pm * 256) * 512; u.b0 = WtD + ((size_t)e * DM + pn * 256) * 512; u.b1 = u.b0 + 128 * 512; return true;
    }
};
struct EpiDown {
    bf16_t* Y; const float* wl; const LAS int* offs;
    __device__ __forceinline__ void operator()(const ge::Acc& acc, const ge::Unit& u, int wr, int wc, int fr, int fq) const {
        const int o = offs[u.kind];
        float w[2][4];
#pragma unroll
        for (int ai = 0; ai < 2; ++ai)
#pragma unroll
            for (int m = 0; m < 4; ++m) { const int r = u.pm * 256 + ai * 128 + wr * 64 + m * 16 + fr; w[ai][m] = wl[(size_t)u.kind * CAP + (r < u.nrows ? r : 0)]; }
#pragma unroll
        for (int ai = 0; ai < 2; ++ai)
#pragma unroll
            for (int m = 0; m < 4; ++m) {
                const int r = u.pm * 256 + ai * 128 + wr * 64 + m * 16 + fr;
                if (r < u.nrows) {
#pragma unroll
                    for (int bj = 0; bj < 2; ++bj) {
                        const int c = u.pn * 256 + bj * 128 + wc * 32 + fq * 8;
                        *(u32x4*)(Y + (size_t)(o + r) * DM + c) = pack8(acc[ai][bj][m][0] * w[ai][m], acc[ai][bj][m][1] * w[ai][m]);
                    }
                }
            }
    }
};


typedef short s16x4 __attribute__((ext_vector_type(4)));
#define AT_THR 8.0f
__device__ __forceinline__ void ph_attn2(const P& p, char* smem, bool with_ctx) {
    constexpr int KS = 112, VS = 80;
    constexpr int NSTG = NKEY / 128;
    bf16_t* sK = (bf16_t*)smem;
    bf16_t* sV = sK + 3 * 128 * KS;
    const int tid = tid_opaque(), lane = tid & 63, wv = tid >> 6, fr = lane & 15, g = lane >> 4;
    const int NUL = NB * NH * 16, NUC = with_ctx ? NB * NH : 0;
    const int kc0 = tid / 12, kp0 = tid % 12, kc1 = (512 + tid) / 12, kp1 = (512 + tid) % 12;
    const int vk = tid >> 3, vp = tid & 7;
#define AT_LOADK(st_, hs_) do { const bf16_t* kb_ = Kp + (size_t)((st_) * 128 + (hs_) * 64) * DQK; kr0 = *(const u32x4*)(kb_ + kc0 * DQK + kp0 * 8); if (tid < 256) kr1 = *(const u32x4*)(kb_ + kc1 * DQK + kp1 * 8); } while (0)
#define AT_LOADV(st_, hs_) do { vr0 = *(const u32x4*)(Vp + (size_t)((st_) * 128 + (hs_) * 64) * DV + vk * DV + vp * 8); } while (0)
#define AT_STOREK(buf_, hs_) do { bf16_t* d_ = sK + ((buf_) * 128 + (hs_) * 64) * KS; *(u32x4*)(d_ + kc0 * KS + kp0 * 8) = kr0; if (tid < 256) *(u32x4*)(d_ + kc1 * KS + kp1 * 8) = kr1; } while (0)
#define AT_STOREV(buf_, hs_) do { *(u32x4*)(sV + ((buf_) * 128 + (hs_) * 64) * VS + vk * VS + vp * 8) = vr0; } while (0)
#define AT_LDKF(dst, mk) do { _Pragma("unroll") for (int ks = 0; ks < 3; ++ks) dst[ks] = *(const bf16x8*)(sKn + (mk) * 16 * KS + ks * 32); } while (0)
#define AT_MMAS(src, mk) do { sN[mk][0] = (f32x4){0.f, 0.f, 0.f, 0.f}; sN[mk][1] = (f32x4){0.f, 0.f, 0.f, 0.f}; \
        _Pragma("unroll") for (int ks = 0; ks < 3; ++ks) _Pragma("unroll") for (int nq = 0; nq < 2; ++nq) { const bf16x8 bq_ = (ks < 2) ? qf[nq][ks] : (ctxn ? qf[nq][3] : qf[nq][2]); \
            sN[mk][nq] = __builtin_amdgcn_mfma_f32_16x16x32_bf16(src[ks], bq_, sN[mk][nq], 0, 0, 0); } } while (0)
#define AT_EXPS(nq) do { float r_ = (nq) ? rs[0] - rs[0] : 0.f; _Pragma("unroll") for (int mk = 0; mk < 4; ++mk) _Pragma("unroll") for (int r = 0; r < 4; ++r) { const float pv = __builtin_amdgcn_exp2f(sC[mk][nq][r] - mn[nq]); r_ += pv; sC[mk][nq][r] = pv; } rs[nq] = r_; } while (0)
#define AT_SUBTILE(sKn_, ctxn_, sVb_) do { \
        const bf16_t* sKn = (sKn_) + fr * KS + g * 8; const bool ctxn = (ctxn_); \
        bf16x8 kfA[3], kfB[3]; bf16x8 pf[2][2]; float mn[2], mxq[2], rs[2]; \
        AT_LDKF(kfA, 0); \
        AT_MMAS(kfA, 0); AT_LDKF(kfB, 1); \
        _Pragma("unroll") for (int nq = 0; nq < 2; ++nq) { float mx = sC[0][nq][0]; \
            _Pragma("unroll") for (int mk = 0; mk < 4; ++mk) _Pragma("unroll") for (int r = 0; r < 4; ++r) mx = fmaxf(mx, sC[mk][nq][r]); \
            mxq[nq] = rowmax4(mx); } \
          \
          \
        if (__any((mxq[0] - m[0] > AT_THR) || (mxq[1] - m[1] > AT_THR))) { \
            _Pragma("unroll") for (int nq = 0; nq < 2; ++nq) { const float mnew_ = fmaxf(m[nq], mxq[nq]); const float a_ = __builtin_amdgcn_exp2f(m[nq] - mnew_); m[nq] = mnew_; lsum[nq] *= a_; \
                _Pragma("unroll") for (int md = 0; md < 4; ++md) oT[md][nq] *= a_; } } \
        mn[0] = m[0]; mn[1] = m[1]; \
        __builtin_amdgcn_sched_barrier(0); \
        AT_MMAS(kfB, 1); AT_LDKF(kfA, 2); AT_EXPS(0); \
        __builtin_amdgcn_sched_barrier(0); \
        AT_MMAS(kfA, 2); AT_LDKF(kfB, 3); AT_EXPS(1); \
        __builtin_amdgcn_sched_barrier(0); \
        AT_MMAS(kfB, 3); \
        _Pragma("unroll") for (int nq = 0; nq < 2; ++nq) { lsum[nq] += rs[nq]; \
            _Pragma("unroll") for (int kp = 0; kp < 2; ++kp) { const u32x4 w_ = pack8(sC[2 * kp][nq], sC[2 * kp + 1][nq]); pf[kp][nq] = __builtin_bit_cast(bf16x8, w_); } } \
        __builtin_amdgcn_sched_barrier(0); \
        _Pragma("unroll") for (int kp = 0; kp < 2; ++kp) _Pragma("unroll") for (int md = 0; md < 4; ++md) { \
            const bf16_t* a0_ = (sVb_) + (32 * kp + 4 * g + (fr >> 2)) * VS + 16 * md + 4 * (fr & 3); \
            const s16x4 lo_ = __builtin_amdgcn_ds_read_tr16_b64_v4i16((LAS s16x4*)a0_); \
            const s16x4 hi_ = __builtin_amdgcn_ds_read_tr16_b64_v4i16((LAS s16x4*)(a0_ + 16 * VS)); \
            const bf16x8 vf_ = __builtin_shufflevector(lo_, hi_, 0, 1, 2, 3, 4, 5, 6, 7); \
            _Pragma("unroll") for (int nq = 0; nq < 2; ++nq) oT[md][nq] = __builtin_amdgcn_mfma_f32_16x16x32_bf16(vf_, pf[kp][nq], oT[md][nq], 0, 0, 0); } \
        _Pragma("unroll") for (int mk = 0; mk < 4; ++mk) { sC[mk][0] = sN[mk][0]; sC[mk][1] = sN[mk][1]; } \
    } while (0)
    for (int u = blockIdx.x; u < NUL + NUC; u += gridDim.x) {
        const bool isctx = u >= NUL;
        int b, h, q0;
        if (!isctx) {
            int bh, qb;
            if (gridDim.x == 256) { const int c = u & 255, r = u >> 8, x = c & 7, sl = c >> 3; bh = r * 16 + x * 2 + (sl >> 4); qb = sl & 15; } else { bh = u / 16; qb = u % 16; }
            b = bh / NH; h = bh % NH; q0 = qb * 256;
        } else { const int v = u - NUL; b = v / NH; h = v % NH; q0 = 0; }
        const bf16_t* Qp = (isctx ? p.Qc + ((size_t)(b * NH + h) * CTXL + q0) * 128 : p.Q + ((size_t)(b * NH + h) * SEQ + q0) * 128) + (size_t)(wv * 32) * 128;
        bf16x8 qf[2][4];
#pragma unroll
        for (int nq = 0; nq < 2; ++nq)
#pragma unroll
            for (int ks = 0; ks < 4; ++ks) qf[nq][ks] = *(const bf16x8*)(Qp + (size_t)(nq * 16 + fr) * 128 + ks * 32 + g * 8);
        const bf16_t* Kp = p.K + (size_t)(b * NH + h) * NKEY * DQK;
        const bf16_t* Vp = p.V + (size_t)(b * NH + h) * NKEY * DV;
        f32x4 oT[4][2]; float m[2], lsum[2];
#pragma unroll
        for (int nq = 0; nq < 2; ++nq) { m[nq] = -INFINITY; lsum[nq] = 0.f;
#pragma unroll
            for (int md = 0; md < 4; ++md) oT[md][nq] = (f32x4){0.f, 0.f, 0.f, 0.f}; }
        const int st0 = isctx ? 32 : 0;
        u32x4 kr0, kr1 = (u32x4){0u, 0u, 0u, 0u}, vr0;
        f32x4 sC[4][2], sN[4][2];
        __syncthreads();
        AT_LOADK(st0, 0); AT_LOADV(st0, 0); AT_STOREK(0, 0); AT_STOREV(0, 0);
        AT_LOADK(st0, 1); AT_LOADV(st0, 1); AT_STOREK(0, 1); AT_STOREV(0, 1);
        AT_LOADK(st0 + 1, 0); AT_STOREK(1, 0);
        AT_LOADK(st0 + 1, 1);
        __syncthreads();
        {
            const bf16_t* sKn = sK + fr * KS + g * 8; const bool ctxn = st0 >= 32;
            bf16x8 kfA[3];
#pragma unroll
            for (int mk = 0; mk < 4; ++mk) { AT_LDKF(kfA, mk); AT_MMAS(kfA, mk); }
#pragma unroll
            for (int mk = 0; mk < 4; ++mk) { sC[mk][0] = sN[mk][0]; sC[mk][1] = sN[mk][1]; }
        }
        AT_STOREK(1, 1);
        __syncthreads();
        int kb = 0;
        for (int st = st0; st < NSTG; ++st) {
            const int bufc = (st - st0) & 1;
            const int st1 = st + 1 < NSTG ? st + 1 : NSTG - 1, st2 = st + 2 < NSTG ? st + 2 : NSTG - 1;
            const int kb1 = kb == 2 ? 0 : kb + 1, kb2 = kb1 == 2 ? 0 : kb1 + 1;
            const bf16_t* sKc = sK + kb * 128 * KS; const bf16_t* sKx = sK + kb1 * 128 * KS; const bf16_t* sVc = sV + bufc * 128 * VS;
            AT_LOADK(st2, 0); AT_LOADV(st1, 0);
            AT_SUBTILE(sKc + 64 * KS, st >= 32, sVc);
            AT_STOREK(kb2, 0); AT_STOREV(bufc ^ 1, 0);
            AT_LOADK(st2, 1); AT_LOADV(st1, 1);
            AT_SUBTILE(sKx, st1 >= 32, sVc + 64 * VS);
            AT_STOREK(kb2, 1); AT_STOREV(bufc ^ 1, 1);
            __syncthreads();
            kb = kb1;
        }
        const size_t rbase = (isctx ? (size_t)TL + b * CTXL : (size_t)b * SEQ) + q0 + wv * 32;
#pragma unroll
        for (int nq = 0; nq < 2; ++nq) {
            const float l = rowsum4(lsum[nq]);
            const float inv = 1.0f / l;
#pragma unroll
            for (int md = 0; md < 4; ++md) {
                u32x2 o; o.x = cvt_pk_bf16(oT[md][nq][0] * inv, oT[md][nq][1] * inv); o.y = cvt_pk_bf16(oT[md][nq][2] * inv, oT[md][nq][3] * inv);
                *(u32x2*)(p.Yatt + ((size_t)(h * 8 + md * 2 + (g >> 1)) * TT + rbase + nq * 16 + fr) * 8 + 4 * (g & 1)) = o;
            }
        }
    }
#undef AT_LOADK
#undef AT_LOADV
#undef AT_STOREK
#undef AT_STOREV
#undef AT_LDKF
#undef AT_MMAS
#undef AT_EXPS
#undef AT_SUBTILE
}

constexpr int RT_PITCH = 1024 + 8;
__device__ __forceinline__ void ph_norm2_router(const P& p, int l, char* smem, int nrows_total) {
    bf16_t* thi = (bf16_t*)smem;
    bf16_t* tlo = thi + 16 * RT_PITCH;
    float* part = (float*)(tlo + 16 * RT_PITCH);
    float* lgs = part + 8 * 16 * 80;
    const int tid = tid_opaque(), lane = tid & 63, wv = tid >> 6, fr = lane & 15, g = lane >> 4;
    const float* ng = p.norm2_g + l * DM;
    const bf16_t* whi = p.WrT + (size_t)(l * 2 + 0) * 80 * DM; const bf16_t* wlo = p.WrT + (size_t)(l * 2 + 1) * 80 * DM;
    bf16x8 bh[4][5];
#pragma unroll
    for (int ks = 0; ks < 4; ++ks)
#pragma unroll
        for (int nt = 0; nt < 5; ++nt) { const size_t o = (size_t)(nt * 16 + fr) * DM + wv * 128 + ks * 32 + g * 8; bh[ks][nt] = *(const bf16x8*)(whi + o); }
    float* bias_s = lgs + 16 * 80;
    float* recs = bias_s + 80;
    int nrec = 0;
    if (tid < 72) bias_s[tid] = tid < 64 ? p.b_re[l * NE + tid] : p.b_rg[l * 8 + tid - 64];
    for (int rb = blockIdx.x * 16; rb < nrows_total; rb += gridDim.x * 16) {
        __syncthreads();
        {
            const int lr0 = wv * 2, row0 = rb + lr0;
            const int b = row0 < TL ? (row0 >> 12) : 4;
            const float* hp = p.hx + (size_t)row0 * DM;
            const float* md = p.mod + ((size_t)l * 5 + b) * NMOD + 3 * DM;
            float4 xv[2][4], gg4[4], sh4[4], sc4[4];
#pragma unroll
            for (int i = 0; i < 4; ++i) { const int j = i * 256 + lane * 4; xv[0][i] = *(const float4*)(hp + j); xv[1][i] = *(const float4*)(hp + DM + j); gg4[i] = *(const float4*)(ng + j); sh4[i] = *(const float4*)(md + j); sc4[i] = *(const float4*)(md + DM + j); }
            float ss0 = 0.f, ss1 = 0.f;
#pragma unroll
            for (int i = 0; i < 4; ++i) { ss0 += xv[0][i].x * xv[0][i].x + xv[0][i].y * xv[0][i].y + xv[0][i].z * xv[0][i].z + xv[0][i].w * xv[0][i].w;
                                          ss1 += xv[1][i].x * xv[1][i].x + xv[1][i].y * xv[1][i].y + xv[1][i].z * xv[1][i].z + xv[1][i].w * xv[1][i].w; }
#pragma unroll
            for (int o = 32; o > 0; o >>= 1) { ss0 += shx(ss0, o); ss1 += shx(ss1, o); }
            const float rs2[2] = {rsqrtf(ss0 * (1.0f / DM) + epsf()), rsqrtf(ss1 * (1.0f / DM) + epsf())};
#pragma unroll
            for (int i = 0; i < 4; ++i) {
                const int j = i * 256 + lane * 4;
                const float4 gg = gg4[i], sh = sh4[i], sc = sc4[i];
#pragma unroll
                for (int rr = 0; rr < 2; ++rr) {
                    const int lr = lr0 + rr; const float rs = rs2[rr];
                    float y[4];
                    y[0] = (xv[rr][i].x * rs * gg.x) * (1.f + sc.x) + sh.x; y[1] = (xv[rr][i].y * rs * gg.y) * (1.f + sc.y) + sh.y;
                    y[2] = (xv[rr][i].z * rs * gg.z) * (1.f + sc.z) + sh.z; y[3] = (xv[rr][i].w * rs * gg.w) * (1.f + sc.w) + sh.w;
                    bf16_t h[4], lo[4];
#pragma unroll
                    for (int e = 0; e < 4; ++e) { h[e] = f2bf(y[e]); lo[e] = f2bf(y[e] - bf2f(h[e])); }
                    u32x2 oh; oh.x = (unsigned)h[0] | ((unsigned)h[1] << 16); oh.y = (unsigned)h[2] | ((unsigned)h[3] << 16);
                    u32x2 ol; ol.x = (unsigned)lo[0] | ((unsigned)lo[1] << 16); ol.y = (unsigned)lo[2] | ((unsigned)lo[3] << 16);
                    *(u32x2*)(p.U + (size_t)(row0 + rr) * DM + j) = oh;
                    *(u32x2*)(thi + lr * RT_PITCH + j) = oh; *(u32x2*)(tlo + lr * RT_PITCH + j) = ol;
                }
            }
        }
        __syncthreads();
        f32x4 acc[5];
#pragma unroll
        for (int nt = 0; nt < 5; ++nt) acc[nt] = (f32x4){0.f, 0.f, 0.f, 0.f};
#pragma unroll
        for (int ks = 0; ks < 4; ++ks) {
            const int k0 = wv * 128 + ks * 32 + g * 8;
            const bf16x8 ah = *(const bf16x8*)(thi + fr * RT_PITCH + k0), al = *(const bf16x8*)(tlo + fr * RT_PITCH + k0);
#pragma unroll
            for (int nt = 0; nt < 5; ++nt) {
                const bf16x8 blf = *(const bf16x8*)(wlo + (size_t)(nt * 16 + fr) * DM + k0);
                acc[nt] = __builtin_amdgcn_mfma_f32_16x16x32_bf16(ah, bh[ks][nt], acc[nt], 0, 0, 0);
                acc[nt] = __builtin_amdgcn_mfma_f32_16x16x32_bf16(al, bh[ks][nt], acc[nt], 0, 0, 0);
                acc[nt] = __builtin_amdgcn_mfma_f32_16x16x32_bf16(ah, blf, acc[nt], 0, 0, 0);
            }
        }
#pragma unroll
        for (int nt = 0; nt < 5; ++nt)
#pragma unroll
            for (int r = 0; r < 4; ++r) part[(wv * 16 + g * 4 + r) * 80 + nt * 16 + fr] = acc[nt][r];
        __syncthreads();
        for (int i = tid; i < 16 * 80; i += NT) { float a = 0.f;
#pragma unroll
            for (int w = 0; w < 8; ++w) a += part[w * 16 * 80 + i];
            lgs[i] = a; }
        __syncthreads();
        if (tid < 128) {
            const int lrw = tid >> 3, i = tid & 7, row = rb + lrw;
            const float* le = lgs + lrw * 80; const float* lg = le + 64;
            const float* bre = bias_s; const float* brg = bias_s + 64;
            const float lgi = lg[i];
            float bv = lgi + brg[i]; int bi = i; float mx = lgi;
#pragma unroll
            for (int o = 1; o < 8; o <<= 1) { const float ov = shx(bv, o); const int oi = shx(bi, o); if (ov > bv || (ov == bv && oi < bi)) { bv = ov; bi = oi; } mx = fmaxf(mx, shx(mx, o)); }
            const int gs = bi;
            float den = __expf(lgi - mx);
#pragma unroll
            for (int o = 1; o < 8; o <<= 1) den += shx(den, o);
            const float pg = __expf(lg[gs] - mx) / den;
            const float lei = le[gs * 8 + i];
            float k0v = lei + bre[gs * 8 + i]; int k0i = i;
            const float keyi = k0v;
#pragma unroll
            for (int o = 1; o < 8; o <<= 1) { const float ov = shx(k0v, o); const int oi = shx(k0i, o); if (ov > k0v || (ov == k0v && oi < k0i)) { k0v = ov; k0i = oi; } }
            const int i0 = k0i;
            float k1v = (i == i0) ? -INFINITY : keyi; int k1i = (i == i0) ? 8 : i;
#pragma unroll
            for (int o = 1; o < 8; o <<= 1) { const float ov = shx(k1v, o); const int oi = shx(k1i, o); if (ov > k1v || (ov == k1v && oi < k1i)) { k1v = ov; k1i = oi; } }
            const int i1 = k1i;
            if (i == 0) {
                const float w0 = 1.0f / (1.0f + __expf(le[gs * 8 + i1] - le[gs * 8 + i0])), w1 = 1.0f - w0;
                float* rc = recs + (nrec * 16 + lrw) * 4;
                rc[0] = __int_as_float((gs * 8 + i0) | ((gs * 8 + i1) << 8)); rc[1] = pg * w0; rc[2] = pg * w1; rc[3] = __int_as_float(row);
            }
        }
        ++nrec;
    }
    __syncthreads();
    for (int q = tid; q < nrec * 16; q += NT) {
        const float* rc = recs + q * 4;
        const int ee = __float_as_int(rc[0]), e0 = ee & 255, e1 = ee >> 8, row = __float_as_int(rc[3]);
        const int r0 = atomicAdd(p.cnt + (l * NE + e0) * 64, 1), r1 = atomicAdd(p.cnt + (l * NE + e1) * 64, 1);
        p.list[(size_t)e0 * CAP + r0] = row; p.wl[(size_t)e0 * CAP + r0] = rc[1];
        p.list[(size_t)e1 * CAP + r1] = row; p.wl[(size_t)e1 * CAP + r1] = rc[2];
        *(int4*)(p.asg + (size_t)row * 4) = make_int4(e0, r0, e1, r1);
    }
    __syncthreads();
}

typedef float v2f __attribute__((ext_vector_type(2)));
#define HD __device__ __forceinline__
HD v2f vfma(v2f a, v2f b, v2f c) { return __builtin_elementwise_fma(a, b, c); }
HD v2f twk(v2f w) { return w.yy * (v2f){-1.f, 1.f}; }
HD v2f cmulk(v2f a, v2f w, v2f wk) { return vfma(a.yx, wk, a * w.xx); }
HD v2f cmulck(v2f a, v2f w, v2f wk) { return vfma(a.yx, -wk, a * w.xx); }
HD v2f cmul(v2f a, v2f w) { return cmulk(a, w, twk(w)); }
HD v2f cmulc(v2f a, v2f w) { return cmulck(a, w, twk(w)); }
HD int fphys(int i) { return (i >> 8) * 272 + ((i >> 4) & 15) * 17 + (i & 15); }
constexpr int FBUF = 4352;
template <bool INV> HD void dft4(v2f& x0, v2f& x1, v2f& x2, v2f& x3) {
    const v2f s02 = x0 + x2, d02 = x0 - x2, s13 = x1 + x3, d13 = x1 - x3;
    const v2f kj = INV ? (v2f){-1.f, 1.f} : (v2f){1.f, -1.f};
    x0 = s02 + s13; x2 = s02 - s13; x1 = vfma(d13.yx, kj, d02); x3 = vfma(d13.yx, -kj, d02);
}
template <bool INV> HD void dft16(v2f (&v)[16]) {
#pragma unroll
    for (int b = 0; b < 4; ++b) dft4<INV>(v[b], v[4 + b], v[8 + b], v[12 + b]);
    float C1 = 0.92387953251128674f, S1 = 0.38268343236508977f, C2 = 0.70710678118654752f;
    asm volatile("" : "+v"(C1), "+v"(S1), "+v"(C2));
#define TW(idx, cr, ci) v[idx] = vfma(v[idx].yx, INV ? (v2f){(ci), -(ci)} : (v2f){-(ci), (ci)}, v[idx] * (v2f){(cr), (cr)})
    TW(4 * 1 + 1, C1, -S1);
    TW(4 * 1 + 2, C2, -C2);
    TW(4 * 1 + 3, S1, -C1);
    TW(4 * 2 + 1, C2, -C2);
    v[4 * 2 + 2] = v[4 * 2 + 2].yx * (INV ? (v2f){-1.f, 1.f} : (v2f){1.f, -1.f});
    TW(4 * 2 + 3, -C2, -C2);
    TW(4 * 3 + 1, S1, -C1);
    TW(4 * 3 + 2, -C2, -C2);
    TW(4 * 3 + 3, -C1, S1);
#undef TW
#pragma unroll
    for (int c = 0; c < 4; ++c) dft4<INV>(v[4 * c], v[4 * c + 1], v[4 * c + 2], v[4 * c + 3]);
#define SW(i, j) { const v2f t_ = v[i]; v[i] = v[j]; v[j] = t_; }
    SW(1, 4) SW(2, 8) SW(3, 12) SW(6, 9) SW(7, 13) SW(11, 14)
#undef SW
}
template <class BUF, class TW> HD void fwd_pass0(int u, v2f (&v)[16], BUF buf, TW W) {
    dft16<false>(v);
    const v2f w1 = W[u], w1k = twk(w1); v2f wr = w1;
    const int pb = fphys(u);
    buf[pb] = v[0];
#pragma unroll
    for (int r = 1; r < 16; ++r) { v[r] = cmul(v[r], wr); buf[pb + 272 * r] = v[r]; wr = cmulk(wr, w1, w1k); }
}
template <class BUF, class TW> HD void fwd_pass1(int u, v2f (&v)[16], BUF buf, TW W) {
    const int j = u & 15, pb = (u >> 4) * 272 + j;
#pragma unroll
    for (int q = 0; q < 16; ++q) v[q] = buf[pb + 17 * q];
    dft16<false>(v);
    const v2f w1 = W[16 * j], w1k = twk(w1); v2f wr = w1;
    buf[pb] = v[0];
#pragma unroll
    for (int r = 1; r < 16; ++r) { v[r] = cmul(v[r], wr); buf[pb + 17 * r] = v[r]; wr = cmulk(wr, w1, w1k); }
}
template <class BUF> HD void fwd_pass2(int u, v2f (&v)[16], BUF buf) {
    const int pb = (u >> 4) * 272 + (u & 15) * 17;
#pragma unroll
    for (int q = 0; q < 16; ++q) v[q] = buf[pb + q];
    dft16<false>(v);
}
template <class BUF> HD void inv_passA(int u, v2f (&v)[16], BUF buf) {
    dft16<true>(v);
    const int pb = (u >> 4) * 272 + (u & 15) * 17;
#pragma unroll
    for (int r = 0; r < 16; ++r) buf[pb + r] = v[r];
}
template <class BUF, class TW> HD void inv_passB(int u, v2f (&v)[16], BUF buf, TW W) {
    const int j = u & 15, pb = (u >> 4) * 272 + j;
    const v2f w1 = W[16 * j], w1k = twk(w1); v2f wr = w1;
    v[0] = buf[pb];
#pragma unroll
    for (int q = 1; q < 16; ++q) { v[q] = cmulc(buf[pb + 17 * q], wr); wr = cmulk(wr, w1, w1k); }
    dft16<true>(v);
#pragma unroll
    for (int r = 0; r < 16; ++r) buf[pb + 17 * r] = v[r];
}
template <class BUF, class TW> HD void inv_passC(int u, v2f (&v)[16], BUF buf, TW W) {
    const v2f w1 = W[u], w1k = twk(w1); v2f wr = w1;
    const int pb = fphys(u);
    v[0] = buf[pb];
#pragma unroll
    for (int q = 1; q < 16; ++q) { v[q] = cmulc(buf[pb + 272 * q], wr); wr = cmulk(wr, w1, w1k); }
    dft16<true>(v);
}
HD int digitrev(int i) { return ((i & 15) << 8) | (i & 0xF0) | (i >> 8); }

#undef HD
constexpr int FFT_LDS_W = 2 * FBUF * 8;
constexpr int FFT_LDS_STG = FFT_LDS_W + 4096 * 8;
constexpr int STG_ROW = SEQ + 16;
constexpr int FFT_LDS_W2 = FFT_LDS_STG + 2 * STG_ROW * 2;
constexpr int FFT_LDS_END = FFT_LDS_W2 + 4096 * 8;
__device__ __forceinline__ void fft_load_w(const P& p, char* smem) {
    float2* Wl = (float2*)(smem + FFT_LDS_W); float2* W2l = (float2*)(smem + FFT_LDS_W2);
    __syncthreads();
    { const int t_ = tid_opaque();
      float4 a_[4], b_[4];
#pragma unroll
      for (int k = 0; k < 4; ++k) { a_[k] = ((const float4*)p.Wtab)[t_ + NT * k]; b_[k] = ((const float4*)p.W2tab)[t_ + NT * k]; }
#pragma unroll
      for (int k = 0; k < 4; ++k) { ((float4*)Wl)[t_ + NT * k] = a_[k]; ((float4*)W2l)[t_ + NT * k] = b_[k]; } }
    __syncthreads();
}
__device__ __forceinline__ void ph_tables(const P& p) {
    for (int i = blockIdx.x * NT + tid_opaque(); i < 8192; i += gridDim.x * NT) {
        float sn, cs;
        if (i < 4096) { sincospif((float)i * (1.0f / 2048.0f), &sn, &cs); p.Wtab[i] = make_float2(cs, -sn); }
        else { sincospif((float)(i - 4096) * (1.0f / 4096.0f), &sn, &cs); p.W2tab[i - 4096] = make_float2(cs, -sn); }
    }
    for (int i = blockIdx.x * NT + tid_opaque(); i < DEPTH * 80 * DM; i += gridDim.x * NT) {
        const int l = i / (80 * DM), n = (i / DM) % 80, kk = i % DM;
        const float v = n < 64 ? p.w_re[((size_t)l * DM + kk) * NE + n] : (n < 72 ? p.w_rg[((size_t)l * DM + kk) * 8 + (n - 64)] : 0.f);
        const bf16_t h = f2bf(v);
        p.WrT[((size_t)(l * 2 + 0) * 80 + n) * DM + kk] = h; p.WrT[((size_t)(l * 2 + 1) * 80 + n) * DM + kk] = f2bf(v - bf2f(h));
    }
}
__device__ __forceinline__ void ph_spectra(const P& p, char* smem) {
    v2f* bufE = (v2f*)smem; v2f* bufO = bufE + FBUF; const v2f* Wl = (const v2f*)(smem + FFT_LDS_W); const v2f* W2l = (const v2f*)(smem + FFT_LDS_W2);
    const int tid = tid_opaque(), half = tid >> 8, u = tid & 255;
    v2f* buf = half ? bufO : bufE;
    fft_load_w(p, smem);
    for (int un = blockIdx.x; un < DEPTH * HYW; un += gridDim.x) {
        const int l = un / HYW, c = un % HYW;
        const float* hf0 = p.HT0 + ((size_t)l * 2048 + c) * SEQ;        const float s_f0 = p.SCL0[l * 2048 + c];
        const float* hb0 = p.HT0 + ((size_t)l * 2048 + 512 + c) * SEQ;  const float s_b0 = p.SCL0[l * 2048 + 512 + c];
        const float* hf1 = p.HT0 + ((size_t)l * 2048 + 1024 + c) * SEQ; const float s_f1 = p.SCL0[l * 2048 + 1024 + c];
        const float* hb1 = p.HT0 + ((size_t)l * 2048 + 1536 + c) * SEQ; const float s_b1 = p.SCL0[l * 2048 + 1536 + c];
        v2f v[16];
#pragma unroll
        for (int q = 0; q < 16; ++q) {
            const int j = 2 * (u + 256 * q) + half;
            float a, b;
            if (j < SEQ) { a = hf0[j] * s_f0; b = hf1[j] * s_f1; } else if (j == SEQ) { a = 0.f; b = 0.f; } else { a = hb0[2 * SEQ - j] * s_b0; b = hb1[2 * SEQ - j] * s_b1; }
            if (j == 0) { a += p.flt_bias[(l * 2 + 0) * HYW + c]; b += p.flt_bias[(l * 2 + 1) * HYW + c]; }
            v[q] = (v2f){a, b};
        }
        __syncthreads();
        fwd_pass0(u, v, buf, Wl); __syncthreads();
        fwd_pass1(u, v, buf, Wl); __syncthreads();
        fwd_pass2(u, v, buf);
#pragma unroll
        for (int r = 0; r < 16; ++r) buf[fphys(16 * u + r)] = v[r];
        __syncthreads();
        v2f* out = (v2f*)p.Hs + (size_t)(l * HYW + c) * 4 * 4096;
        for (int idx = tid; idx < 8192; idx += NT) {
            const int par = idx >> 12, pi = idx & 4095, kp = 2 * digitrev(pi) + par, kpp = (8192 - kp) & 8191;
            const int k1 = kp & 4095, k2 = kpp & 4095;
            v2f t1 = cmul(W2l[k1], bufO[fphys(digitrev(k1))]); if (kp >= 4096) t1 = -t1;
            v2f t2 = cmul(W2l[k2], bufO[fphys(digitrev(k2))]); if (kpp >= 4096) t2 = -t2;
            const v2f F = bufE[fphys(digitrev(k1))] + t1, Gq = bufE[fphys(digitrev(k2))] + t2;
            const float sc = 0.5f / 8192.0f;
            out[(0 * 2 + par) * 4096 + pi] = (v2f){(F.x + Gq.x) * sc, (F.y - Gq.y) * sc};
            out[(1 * 2 + par) * 4096 + pi] = (v2f){(F.y + Gq.y) * sc, -(F.x - Gq.x) * sc};
        }
    }
    __syncthreads();
}
__device__ __forceinline__ void fft_conv(int half, int u, v2f (&v)[16], const v2f* W2g, const v2f* Hso, v2f* buf, const v2f* Wl) {
    float4 hreg[8];
    const float4* hp = (const float4*)(Hso + (size_t)half * 4096 + 16 * u);
#pragma unroll
    for (int r2 = 0; r2 < 8; ++r2) hreg[r2] = hp[r2];
    if (half) {
#pragma unroll
        for (int q = 0; q < 16; ++q) v[q] = cmul(v[q], W2g[u + 256 * q]);
    }
    fwd_pass0(u, v, buf, Wl); __syncthreads();
    fwd_pass1(u, v, buf, Wl); __syncthreads();
    fwd_pass2(u, v, buf);
#pragma unroll
    for (int r2 = 0; r2 < 8; ++r2) { const float4 h = hreg[r2]; v[2 * r2] = cmul(v[2 * r2], (v2f){h.x, h.y}); v[2 * r2 + 1] = cmul(v[2 * r2 + 1], (v2f){h.z, h.w}); }
    inv_passA(u, v, buf); __syncthreads();
    inv_passB(u, v, buf, Wl); __syncthreads();
    inv_passC(u, v, buf, Wl);
    if (half) {
#pragma unroll
        for (int r = 0; r < 16; ++r) v[r] = cmulc(v[r], W2g[u + 256 * r]);
    }
}

__device__ __forceinline__ void ph_hyena_fft(const P& p, int l, char* smem) {
    v2f* buf0 = (v2f*)smem; v2f* buf1 = buf0 + FBUF; const v2f* Wl = (const v2f*)(smem + FFT_LDS_W);
    bf16_t* stg = (bf16_t*)(smem + FFT_LDS_STG) + 8;
    const v2f* W2l = (const v2f*)(smem + FFT_LDS_W2);
    const int tid = tid_opaque(), half = tid >> 8, u = tid & 255;
    v2f* buf = half ? buf1 : buf0;
    const int pu = fphys(u);
    if (tid < 32) { const int rw = tid >> 4, k = tid & 15; (stg - 8 + rw * STG_ROW)[k < 8 ? k : SEQ + k] = 0; }
    fft_load_w(p, smem);
    for (int c = blockIdx.x; c < HYW; c += gridDim.x) {
        const v2f* Hs0 = (const v2f*)p.Hs + (size_t)(l * HYW + c) * 4 * 4096; const v2f* Hs1 = Hs0 + 2 * 4096;
        float scw[3][4];
#pragma unroll
        for (int w = 0; w < 3; ++w) { const int col = w * HYW + c; scw[w][0] = p.sc_w[(size_t)(l * 3 + 0) * HYC + col]; scw[w][1] = p.sc_w[(size_t)(l * 3 + 1) * HYC + col]; scw[w][2] = p.sc_w[(size_t)(l * 3 + 2) * HYC + col]; scw[w][3] = p.sc_b[l * HYC + col]; }
#define HY_TAP(sb, k, w) (scw[w][3] + scw[w][0] * __uint_as_float((unsigned)(sb)[(k) - 1] << 16) + scw[w][1] * __uint_as_float((unsigned)(sb)[(k)] << 16) + scw[w][2] * __uint_as_float((unsigned)(sb)[(k) + 1] << 16))
        u32x4 ra, rb;
#define HY_LOAD(sel, pr_) do { const bf16_t* r0_ = p.PT + ((size_t)(2 * (pr_)) * HYC + (sel) * HYW + c) * SEQ + tid * 8; ra = *(const u32x4*)r0_; rb = *(const u32x4*)(r0_ + (size_t)HYC * SEQ); } while (0)
#define HY_STAGE() do { *(u32x4*)(stg + tid * 8) = ra; *(u32x4*)(stg + STG_ROW + tid * 8) = rb; } while (0)
        HY_LOAD(0, 0);
        for (int pr = 0; pr < 2; ++pr) {
            const LAS bf16_t* sbA = (const LAS bf16_t*)stg + u; asm volatile("" : "+v"(sbA));
            const LAS bf16_t* sbB = sbA + STG_ROW;
            __syncthreads();
            HY_STAGE();
            __syncthreads();
            v2f v[16];
#pragma unroll
            for (int q = 0; q < 16; ++q) v[q] = (v2f){HY_TAP(sbA, 256 * q, 0), HY_TAP(sbB, 256 * q, 0)};
            HY_LOAD(1, pr);
            fft_conv(half, u, v, W2l, Hs0, buf, Wl);
            if (half) {
#pragma unroll
                for (int r = 0; r < 16; ++r) buf1[pu + 272 * r] = v[r];
            }
            HY_STAGE();
            __syncthreads();
            if (!half) {
#pragma unroll
                for (int r = 0; r < 16; ++r) {
                    const v2f y = v[r] + buf1[pu + 272 * r];
                    const float xa = HY_TAP(sbA, 256 * r, 1), xb = HY_TAP(sbB, 256 * r, 1);
                    const v2f z1 = (v2f){xa, xb} * y;
                    v[r] = z1; buf1[pu + 272 * r] = z1;
                }
            }
            HY_LOAD(2, pr);
            __syncthreads();
            if (half) {
#pragma unroll
                for (int r = 0; r < 16; ++r) v[r] = buf1[pu + 272 * r];
            }
            fft_conv(half, u, v, W2l, Hs1, buf, Wl);
            if (half) {
#pragma unroll
                for (int r = 0; r < 16; ++r) buf1[pu + 272 * r] = v[r];
            }
            HY_STAGE();
            if (pr == 0) HY_LOAD(0, 1);
            __syncthreads();
            if (!half) {
                bf16_t* oA = p.Yhy + ((size_t)(c >> 3) * TT + (size_t)(2 * pr) * SEQ + u) * 8 + (c & 7); bf16_t* oB = oA + (size_t)SEQ * 8;
#pragma unroll
                for (int r = 0; r < 16; ++r) {
                    const v2f y = v[r] + buf1[pu + 272 * r];
                    const float xa = HY_TAP(sbA, 256 * r, 2), xb = HY_TAP(sbB, 256 * r, 2);
                    oA[(size_t)(256 * r) * 8] = f2bf(xa * y.x);
                    oB[(size_t)(256 * r) * 8] = f2bf(xb * y.y);
                }
            }
        }
#undef HY_LOAD
#undef HY_STAGE
#undef HY_TAP
    }
    __syncthreads();
}

__device__ __forceinline__ float4 moe_combine4(const P& p, int lc, int b, size_t s0, size_t s1, int j, float4 hv) {
    const u32x2 y0 = *(const u32x2*)(p.Y + s0 * DM + j), y1 = *(const u32x2*)(p.Y + s1 * DM + j);
    const float4 g = *(const float4*)(p.mod + ((size_t)lc * 5 + b) * NMOD + 5 * DM + j);
    hv.x += g.x * (__uint_as_float(y0.x << 16) + __uint_as_float(y1.x << 16));
    hv.y += g.y * (__uint_as_float(y0.x & 0xFFFF0000u) + __uint_as_float(y1.x & 0xFFFF0000u));
    hv.z += g.z * (__uint_as_float(y0.y << 16) + __uint_as_float(y1.y << 16));
    hv.w += g.w * (__uint_as_float(y0.y & 0xFFFF0000u) + __uint_as_float(y1.y & 0xFFFF0000u));
    return hv;
}
__device__ __forceinline__ void ph_norm1c(const P& p, int l, const int* offs) {
    const int tid = tid_opaque(), lane = tid & 63, wv = tid >> 6;
    const float* ng = p.norm1_g + l * DM;
    for (int rb = blockIdx.x * 16; rb < TT; rb += gridDim.x * 16) {
        const int row0 = rb + wv * 2;
        const int b = row0 < TL ? (row0 >> 12) : 4;
        float* hp = p.hx + (size_t)row0 * DM;
        const float* src = l > 0 ? hp : (row0 < TL ? p.x + (size_t)row0 * DM : p.ctx + (size_t)(row0 - TL) * DM);
        const float* md = p.mod + ((size_t)l * 5 + b) * NMOD;
        float4 xv[2][4];
        u32x2 ya[2][4], yb[2][4];
        if (l > 0) {
            const int4 a0 = *(const int4*)(p.asg + (size_t)row0 * 4), a1 = *(const int4*)(p.asg + (size_t)(row0 + 1) * 4);
            const size_t s00 = (size_t)offs[a0.x] + a0.y, s01 = (size_t)offs[a0.z] + a0.w, s10 = (size_t)offs[a1.x] + a1.y, s11 = (size_t)offs[a1.z] + a1.w;
#pragma unroll
            for (int i = 0; i < 4; ++i) { const int j = i * 256 + lane * 4;
                ya[0][i] = *(const u32x2*)(p.Y + s00 * DM + j); yb[0][i] = *(const u32x2*)(p.Y + s01 * DM + j);
                ya[1][i] = *(const u32x2*)(p.Y + s10 * DM + j); yb[1][i] = *(const u32x2*)(p.Y + s11 * DM + j); }
        }
#pragma unroll
        for (int i = 0; i < 4; ++i) { const int j = i * 256 + lane * 4; xv[0][i] = *(const float4*)(src + j); xv[1][i] = *(const float4*)(src + DM + j); }
        float ss[2] = {0.f, 0.f};
#pragma unroll
        for (int rr = 0; rr < 2; ++rr)
#pragma unroll
            for (int i = 0; i < 4; ++i) {
                const int j = i * 256 + lane * 4;
                if (l > 0) {
                    const float4 g = *(const float4*)(p.mod + ((size_t)(l - 1) * 5 + b) * NMOD + 5 * DM + j);
                    const u32x2 y0 = ya[rr][i], y1 = yb[rr][i];
                    xv[rr][i].x += g.x * (__uint_as_float(y0.x << 16) + __uint_as_float(y1.x << 16));
                    xv[rr][i].y += g.y * (__uint_as_float(y0.x & 0xFFFF0000u) + __uint_as_float(y1.x & 0xFFFF0000u));
                    xv[rr][i].z += g.z * (__uint_as_float(y0.y << 16) + __uint_as_float(y1.y << 16));
                    xv[rr][i].w += g.w * (__uint_as_float(y0.y & 0xFFFF0000u) + __uint_as_float(y1.y & 0xFFFF0000u));
                }
                *(float4*)(hp + (size_t)rr * DM + j) = xv[rr][i];
                ss[rr] += xv[rr][i].x * xv[rr][i].x + xv[rr][i].y * xv[rr][i].y + xv[rr][i].z * xv[rr][i].z + xv[rr][i].w * xv[rr][i].w;
            }
        ss[0] = wave_sum(ss[0]); ss[1] = wave_sum(ss[1]);
        const float rs[2] = {rsqrtf(ss[0] * (1.0f / DM) + epsf()), rsqrtf(ss[1] * (1.0f / DM) + epsf())};
#pragma unroll
        for (int i = 0; i < 4; ++i) {
            const int j = i * 256 + lane * 4;
            const float4 g = *(const float4*)(ng + j), sh = *(const float4*)(md + j), sc = *(const float4*)(md + DM + j);
#pragma unroll
            for (int rr = 0; rr < 2; ++rr) {
                u32x2 o;
                o.x = pack2((xv[rr][i].x * rs[rr] * g.x) * (1.f + sc.x) + sh.x, (xv[rr][i].y * rs[rr] * g.y) * (1.f + sc.y) + sh.y);
                o.y = pack2((xv[rr][i].z * rs[rr] * g.z) * (1.f + sc.z) + sh.z, (xv[rr][i].w * rs[rr] * g.w) * (1.f + sc.w) + sh.w);
                *(u32x2*)(p.U + (size_t)(row0 + rr) * DM + j) = o;
            }
        }
    }
}
__device__ __forceinline__ void ph_final_c(const P& p, const int* offs) {
    const int tid = tid_opaque(), lane = tid & 63, wv = tid >> 6;
    for (int rb = blockIdx.x * 8; rb < TL; rb += gridDim.x * 8) {
        const int row = rb + wv, b = row >> 12;
        const float* hp = p.hx + (size_t)row * DM;
        const int4 a = *(const int4*)(p.asg + (size_t)row * 4);
        const size_t s0 = (size_t)offs[a.x] + a.y, s1 = (size_t)offs[a.z] + a.w;
        float4 xv[4]; float ss = 0.f;
#pragma unroll
        for (int i = 0; i < 4; ++i) {
            const int j = i * 256 + lane * 4;
            xv[i] = moe_combine4(p, DEPTH - 1, b, s0, s1, j, *(const float4*)(hp + j));
            ss += xv[i].x * xv[i].x + xv[i].y * xv[i].y + xv[i].z * xv[i].z + xv[i].w * xv[i].w;
        }
        ss = wave_sum(ss);
        const float rs = rsqrtf(ss * (1.0f / DM) + epsf());
#pragma unroll
        for (int i = 0; i < 4; ++i) {
            const int j = i * 256 + lane * 4;
            const float4 g = *(const float4*)(p.final_g + j);
            float4 y; y.x = xv[i].x * rs * g.x; y.y = xv[i].y * rs * g.y; y.z = xv[i].z * rs * g.z; y.w = xv[i].w * rs * g.w;
            *(float4*)(p.out + (size_t)row * DM + j) = y;
        }
    }
}


__device__ __forceinline__ void ph_hyena_ctx(const P& p, int l, char* smem) {
    constexpr int L = CTXL;
    const int tid = tid_opaque(), hf = tid >> 8, tl = tid & 255, b = tl >> 6, t0 = (tl & 63) * 4;
    float* kern0 = (float*)smem + hf * (8 * L);
    float* kern1 = kern0 + 2 * L;
    float* zb = kern1 + 2 * L;
    const float* HT = p.HT1 + (size_t)l * 2048 * L;
    const float* SCL = p.SCL1 + l * 2048;
    for (int cb = blockIdx.x; cb < HYW; cb += 2 * gridDim.x) {
        const int c = cb + hf * gridDim.x;
        const bool act = c < HYW;
        __syncthreads();
        float uv[3][4];
        if (act) {
            const float kb0 = tl > 0 ? HT[(size_t)(512 + c) * L + (L - tl)] * SCL[512 + c] : 0.f, kb1 = tl > 0 ? HT[(size_t)(1536 + c) * L + (L - tl)] * SCL[1536 + c] : 0.f;
            const float kf0 = HT[(size_t)c * L + tl] * SCL[c], kf1 = HT[(size_t)(1024 + c) * L + tl] * SCL[1024 + c];
            kern0[tl] = kb0; kern1[tl] = kb1; kern0[L + tl] = kf0; kern1[L + tl] = kf1;
#pragma unroll
            for (int w = 0; w < 3; ++w) {
                const int col = w * HYW + c;
                const bf16_t* pr = p.PTc + ((size_t)b * HYC + col) * L + t0;
                const float w0 = p.sc_w[(size_t)(l * 3 + 0) * HYC + col], w1 = p.sc_w[(size_t)(l * 3 + 1) * HYC + col], w2 = p.sc_w[(size_t)(l * 3 + 2) * HYC + col], bb = p.sc_b[l * HYC + col];
                const u32x2 mid = *(const u32x2*)pr;
                float e[6];
                e[0] = t0 > 0 ? bf2f(pr[-1]) : 0.f; e[5] = t0 + 4 < L ? bf2f(pr[4]) : 0.f;
                e[1] = __uint_as_float(mid.x << 16); e[2] = __uint_as_float(mid.x & 0xFFFF0000u); e[3] = __uint_as_float(mid.y << 16); e[4] = __uint_as_float(mid.y & 0xFFFF0000u);
#pragma unroll
                for (int j = 0; j < 4; ++j) uv[w][j] = bb + w0 * e[j] + w1 * e[j + 1] + w2 * e[j + 2];
            }
            *(float4*)(zb + b * L + t0) = make_float4(uv[0][0], uv[0][1], uv[0][2], uv[0][3]);
        }
        __syncthreads();
        const float* zr = zb + b * L;
        float a[4];
#define CTX_CONV(kern) do { a[0] = 0.f; a[1] = 0.f; a[2] = 0.f; a[3] = 0.f; \
            float4 khi = *(const float4*)((kern) + t0 + L); \
            _Pragma("unroll 4") for (int m = 0; m < L / 4; ++m) { \
                const float4 klo = *(const float4*)((kern) + t0 + L - 4 * m - 4); const float4 z = *(const float4*)(zr + 4 * m); \
                a[0] += z.x * khi.x; a[1] += z.x * khi.y; a[2] += z.x * khi.z; a[3] += z.x * khi.w; \
                a[0] += z.y * klo.w; a[1] += z.y * khi.x; a[2] += z.y * khi.y; a[3] += z.y * khi.z; \
                a[0] += z.z * klo.z; a[1] += z.z * klo.w; a[2] += z.z * khi.x; a[3] += z.z * khi.y; \
                a[0] += z.w * klo.y; a[1] += z.w * klo.z; a[2] += z.w * klo.w; a[3] += z.w * khi.x; \
                khi = klo; } } while (0)
        float z1[4];
        if (act) {
            CTX_CONV(kern0);
            const float bias0 = p.flt_bias[(l * 2 + 0) * HYW + c];
#pragma unroll
            for (int j = 0; j < 4; ++j) z1[j] = uv[1][j] * (a[j] + bias0 * uv[0][j]);
        }
        __syncthreads();
        if (act) *(float4*)(zb + b * L + t0) = make_float4(z1[0], z1[1], z1[2], z1[3]);
        __syncthreads();
        if (act) {
            CTX_CONV(kern1);
            const float bias1 = p.flt_bias[(l * 2 + 1) * HYW + c];
            bf16_t* o = p.Yhy + ((size_t)(c >> 3) * TT + (size_t)TL + b * CTXL + t0) * 8 + (c & 7);
#pragma unroll
            for (int j = 0; j < 4; ++j) o[j * 8] = f2bf(uv[2][j] * (a[j] + bias1 * z1[j]));
        }
#undef CTX_CONV
    }
    __syncthreads();
}

__device__ __forceinline__ void conv_tile(bf16_t* tile, const float* src, int ld, int c0, int ncols, int K, bf16_t* dst, int kt, int ntile, const float* kscale = nullptr) {
    const int tid = tid_opaque();
    const int k = tid >> 3, n8 = (tid & 7) * 8, nbase = ntile * 64;
    float4 x0 = make_float4(0.f, 0.f, 0.f, 0.f), x1 = x0;
    if (nbase + n8 < ncols) { const float* sp = src + (size_t)(kt * 64 + k) * ld + c0 + nbase + n8; x0 = *(const float4*)sp; x1 = *(const float4*)(sp + 4); }
    if (kscale) { const float ks = kscale[kt * 64 + k]; x0.x *= ks; x0.y *= ks; x0.z *= ks; x0.w *= ks; x1.x *= ks; x1.y *= ks; x1.z *= ks; x1.w *= ks; }
    __syncthreads();
    tile[(n8 + 0) * 72 + k] = f2bf(x0.x); tile[(n8 + 1) * 72 + k] = f2bf(x0.y); tile[(n8 + 2) * 72 + k] = f2bf(x0.z); tile[(n8 + 3) * 72 + k] = f2bf(x0.w);
    tile[(n8 + 4) * 72 + k] = f2bf(x1.x); tile[(n8 + 5) * 72 + k] = f2bf(x1.y); tile[(n8 + 6) * 72 + k] = f2bf(x1.z); tile[(n8 + 7) * 72 + k] = f2bf(x1.w);
    __syncthreads();
    const int n = tid >> 3, k8 = (tid & 7) * 8;
    if (nbase + n < ncols) *(u32x4*)(dst + (size_t)(nbase + n) * K + kt * 64 + k8) = *(const u32x4*)(tile + n * 72 + k8);
}
constexpr int DENSE_TILES = 1720;
__device__ __forceinline__ void ph_conv_dense(const P& p, char* smem) {
    bf16_t* tile = (bf16_t*)smem;
    for (int id = blockIdx.x; id < DEPTH * DENSE_TILES; id += gridDim.x) {
        const int l = id / DENSE_TILES; int r = id % DENSE_TILES;
        const float* win = p.w_in + (size_t)l * DM * INC;
        if (r < 384) conv_tile(tile, win, INC, 0, HYC, DM, p.WtHy + (size_t)l * HYC * DM, r / 24, r % 24);
        else if ((r -= 384) < 64) conv_tile(tile, win, INC, HYC + QL, KVL, DM, p.WtRest + (size_t)l * 2816 * DM, r / 4, r % 4);
        else if ((r -= 64) < 96) conv_tile(tile, win, INC, HYC, QL, DM, p.WtRest + ((size_t)l * 2816 + 256) * DM, r / 6, r % 6);
        else if ((r -= 96) < 16) conv_tile(tile, win, INC, HYC + QL + KVL, QKR, DM, p.WtRest + ((size_t)l * 2816 + 640) * DM, r, 0);
        else if ((r -= 16) < 512) conv_tile(tile, win, INC, MLA_END, 2048, DM, p.WtRest + ((size_t)l * 2816 + 768) * DM, r / 32, r % 32);
        else if ((r -= 512) < 72) conv_tile(tile, p.w_uq + (size_t)l * QL * 768, 768, 0, 768, QL, p.WtUq + (size_t)l * 768 * QL, r / 12, r % 12, p.q_norm_g + l * QL);
        else if ((r -= 72) < 64) conv_tile(tile, p.w_ukv + (size_t)l * KVL * 1024, 1024, 0, 1024, KVL, p.WtUkv + (size_t)l * 1024 * KVL, r / 16, r % 16, p.kv_norm_g + l * KVL);
        else if ((r -= 64) < 128) conv_tile(tile, p.w_hy_o + (size_t)l * HYW * DM, DM, 0, DM, HYW, p.WtHyo + (size_t)l * DM * HYW, r / 16, r % 16);
        else if ((r -= 128) < 128) conv_tile(tile, p.w_mla_o + (size_t)l * 512 * DM, DM, 0, DM, 512, p.WtMlao + (size_t)l * DM * 512, r / 16, r % 16);
        else { r -= 128; conv_tile(tile, p.w_out + (size_t)l * DM * DM, DM, 0, DM, DM, p.WtOut + (size_t)l * DM * DM, r / 16, r % 16); }
    }
    const int nz = DEPTH * 96 * DM / 8;
    for (int i = blockIdx.x * NT + threadIdx.x; i < nz + SEQ * 16; i += gridDim.x * NT) {
        if (i < nz) { const int l = i / (96 * DM / 8), o = i % (96 * DM / 8); *(u32x4*)(p.WtRest + ((size_t)l * 2816 + MLAW) * DM + (size_t)o * 8) = (u32x4){0u, 0u, 0u, 0u}; }
        else { const int k = i - nz, t = k >> 4, a = (k >> 3) & 1, ii = k & 7; const float ang = (float)(a == 0 ? (t >> 6) : (t & 63)) * powf(10000.0f, -(float)ii / 8.0f); p.rope[k] = make_float2(cosf(ang), sinf(ang)); }
    }
}
__device__ __forceinline__ void ph_conv_experts(const P& p, int l, char* smem, int t_begin, int t_end, int worker, int nworkers) {
    bf16_t* tile = (bf16_t*)smem;
    if (worker >= 0)
    for (int id = t_begin + worker; id < t_end; id += nworkers) {
        const int e = id / 192; int r = id % 192;
        const size_t le = (size_t)l * NE + e;
        if (r < 64) conv_tile(tile, p.w_gate + le * DM * DE, DE, 0, DE, DM, p.WtG + (size_t)e * DE * DM, r / 4, r % 4);
        else if (r < 128) { r -= 64; conv_tile(tile, p.w_up + le * DM * DE, DE, 0, DE, DM, p.WtU + (size_t)e * DE * DM, r / 4, r % 4); }
        else { r -= 128; conv_tile(tile, p.w_down + le * DE * DM, DM, 0, DM, DE, p.WtD + (size_t)e * DM * DE, r / 16, r % 16); }
    }
    __syncthreads();
}

constexpr int LDS_TAB = ge::STAGE_BYTES;
static_assert(FFT_LDS_END <= 160 * 1024 - 16, "FFT LDS image");
constexpr int LDS_TOTAL = 160 * 1024;
#define PH_P KArgP kp_ = (KArgP)__builtin_amdgcn_kernarg_segment_ptr(); asm volatile("" : "+s"(kp_)); const P p = make_p(kp_); int G = gridDim.x, c = blockIdx.x; asm volatile("" : "+s"(G), "+s"(c)); (void)G; (void)c;
#define GRID_BAR() do { XcdBarrier b_; b_.bar = (unsigned*)k.ws; b_.x = xb_xcc_id(); b_.st = xbw; xcd_barrier(b_); } while (0)
__global__ __launch_bounds__(NT, 2) void mega(PK k) {
    extern __shared__ __attribute__((aligned(16))) char smem[];
    LAS unsigned char* lds = (LAS unsigned char*)smem;
    volatile LAS unsigned* xbw = (volatile LAS unsigned*)(smem + LDS_TOTAL - 16);
    if (threadIdx.x == 0) { xbw[0] = 0u; xbw[1] = 0u; xbw[2] = 0u; xbw[3] = 0u; }
    __syncthreads();
    (void)xcd_barrier_post((unsigned*)k.ws, xbw);
#define PB(id) do { if (PROBE_ID == (id) && blockIdx.x == 0 && threadIdx.x == 0) xbw[2] = (unsigned)wall_clock64(); } while (0)
#define PE(id) do { if (PROBE_ID == (id) && blockIdx.x == 0 && threadIdx.x == 0) xbw[3] += (unsigned)wall_clock64() - xbw[2]; } while (0)
    int* offs = (int*)(smem + LDS_TAB); int* tpre = offs + 65; int* cntl = tpre + 65;
    const LAS int* offs_l = (const LAS int*)(lds + LDS_TAB); const LAS int* tpre_l = offs_l + 65; const LAS int* cntl_l = tpre_l + 65;
    PB(0);
    for (int rep = 0; rep < REP_PRO; ++rep) {
    PB(20);
    { PH_P ph_mod_partial(p, smem); ph_filter_a(p, smem); ph_conv_dense(p, smem); ph_tables(p); }
    GRID_BAR();
    PE(20); PB(21);
    { PH_P ph_filter_b2(p, smem); }
    GRID_BAR();
    PE(21); PB(22);
    { PH_P ph_finalize(p); }
    GRID_BAR();
    PE(22); PB(23);
    { PH_P ph_spectra(p, smem); }
    GRID_BAR();
    PE(23);
    }
    PE(0);
    for (int l = 0; l < DEPTH; ++l) {
        const bool last = (l == DEPTH - 1);
        PB(1);
        { PH_P ph_norm1c(p, l, offs); }
        GRID_BAR();
        PE(1); PB(2);
#define CHAIN_IDS int cw_ = blockIdx.x; asm volatile("" : "+s"(cw_)); const bool kvc = cw_ < 68, qc = !kvc && cw_ < 136; const int pm = kvc ? cw_ : cw_ - 68; (void)qc; (void)pm;
#define CHAIN_SSQ LAS float* ssq = (LAS float*)(lds + LDS_SSQ); LAS float* rsl = ssq + 256 * 16; (void)rsl;
        { CHAIN_IDS
          if (kvc || qc) { PH_P CHAIN_SSQ
              SchedChainIn S{(const char*)p.U, (const char*)(p.WtRest + (size_t)l * 2816 * DM), pm, kvc ? 0 : 1, kvc ? 1 : 2};
              EpiInprojMLA E{p.PMLAb, p.K, p.rope, ssq};
              ge::gemm_engine<false>(lds, DM, DM, DM, S, E);
          } }
        { CHAIN_IDS
          if (kvc || qc) { CHAIN_SSQ
              asm volatile("s_waitcnt vmcnt(0)" ::: "memory"); __syncthreads(); __builtin_amdgcn_fence(__ATOMIC_ACQUIRE, "agent"); asm volatile("s_waitcnt vmcnt(0)" ::: "memory");
              const int t_ = tid_opaque();
              if (t_ < 256) { float a_ = 0.f; const int ns = kvc ? 8 : 12;
                  for (int q_ = 0; q_ < ns; ++q_) a_ += ssq[t_ * 16 + q_];
                  rsl[t_] = rsqrtf(a_ * (kvc ? 1.0f / KVL : 1.0f / QL) + epsf()); }
              __syncthreads();
          } }
        { CHAIN_IDS
          if (kvc || qc) { PH_P CHAIN_SSQ
              LAS float* rpl = rsl + 256;
              { const int t0 = (pm & 15) * 256;
                if (pm < 64) for (int t_ = tid_opaque(); t_ < 544; t_ += NT) {
                    const float2 e_ = t_ < 32 ? p.rope[(size_t)(t0 + (t_ >> 3) * 64) * 16 + (t_ & 7)] : p.rope[(size_t)(t0 + ((t_ - 32) >> 3)) * 16 + 8 + ((t_ - 32) & 7)];
                    rpl[2 * t_] = e_.x; rpl[2 * t_ + 1] = e_.y; }
                __syncthreads(); }
              SchedPanel S{(const char*)(p.PMLAb + (kvc ? 0 : 256)), kvc ? (const char*)(p.WtUkv + (size_t)l * 1024 * KVL) : (const char*)(p.WtUq + (size_t)l * 768 * QL),
                           (size_t)640 * 2, (size_t)(kvc ? KVL : QL) * 2, pm, kvc ? 4 : 3, kvc ? 1 : 0};
              EpiQKV E{EpiQ{p.Q, p.Qc, rpl, rsl}, EpiKV{p.K, p.V, rsl}};
              ge::gemm_engine<false>(lds, 640, kvc ? KVL : QL, kvc ? KVL : QL, S, E);
          } }
        { CHAIN_IDS PH_P
            SchedPool S{(const char*)(p.WtHy + (size_t)l * HYC * DM), (const char*)(p.WtRest + (size_t)l * 2816 * DM), (const char*)p.U,
                        kvc ? 612 + 3 * cw_ : (qc ? 816 + 2 * (cw_ - 68) : cw_ - 136), (kvc || qc) ? 1 : G - 136, kvc ? 3 : (qc ? 2 : (612 - (cw_ - 136) + (G - 136) - 1) / (G - 136))};
            EpiInproj E{p.PT, p.PTc, p.G};
            ge::gemm_engine<false>(lds, DM, DM, DM, S, E);
        }
#undef CHAIN_IDS
#undef CHAIN_SSQ
        GRID_BAR();
        PE(2);
        PE(4); PB(5);
        for (int rep = 0; rep < REP_MIX; ++rep) {
        PB(31);
        { PH_P ph_attn2(p, smem, !last); }
        PE(31); PB(32);
        { PH_P ph_hyena_fft(p, l, smem); }
        PE(32); PB(33);
        if (!last) { PH_P ph_hyena_ctx(p, l, smem); }
        PE(33); }
        GRID_BAR();
        PE(5); PB(6);
        for (int rep = 0; rep < REP_DENSE; ++rep) { PH_P
            SchedMerge S{(const char*)p.Yhy, (const char*)p.Yatt, (const char*)(p.WtHyo + (size_t)l * DM * HYW), (const char*)(p.WtMlao + (size_t)l * DM * 512), G, c, last ? 64 : 68};
            EpiMerge E{p.G, p.M1};
            ge::gemm_engine<false, TT>(lds, 512, 512, 512, S, E);
        }
        { PH_P ph_conv_experts(p, l, smem, 0, NE * 96, c - 16, G - 16); }
        GRID_BAR();
        PE(6); PB(7);
        { PH_P
            SchedDense S{(const char*)p.M1, (const char*)(p.WtOut + (size_t)l * DM * DM), (size_t)DM * 2, (size_t)DM * 2, last ? 64 : 68, 4, G, c};
            EpiOut E{p.hx, p.mod + (size_t)l * 5 * NMOD};
            ge::gemm_engine<false>(lds, DM, DM, DM, S, E);
        }
        { PH_P ph_conv_experts(p, l, smem, NE * 96, NE * 192, c - 16, G - 16); }
        GRID_BAR();
        PE(7); PB(8);
        { PH_P ph_norm2_router(p, l, smem, last ? TL : TT); }
        GRID_BAR();
        PE(8); PB(9);
        for (int rep = 0; rep < REP_MOE; ++rep) { PH_P
            if (threadIdx.x < NE) cntl[threadIdx.x] = p.cnt[(l * NE + threadIdx.x) * 64];
            __syncthreads();
            if (threadIdx.x == 0) { int a = 0, t = 0; for (int e = 0; e < NE; ++e) { const int n = cntl[e]; offs[e] = a; tpre[e] = t; a += n; t += (n + 255) >> 8; } offs[64] = a; tpre[64] = t; }
            __syncthreads();
            SchedGU S{(const char*)p.U, (const char*)p.WtG, (const char*)p.WtU, p.list, tpre_l, cntl_l, G, c};
            EpiGU E{p.Hb, offs_l};
            ge::gemm_engine<true>(lds, DM, DM, DM, S, E);
        }
        GRID_BAR();
        PE(9); PB(10);
        for (int rep = 0; rep < REP_MOE; ++rep) { PH_P
            SchedDown S{(const char*)p.Hb, (const char*)p.WtD, tpre_l, cntl_l, offs_l, G, c};
            EpiDown E{p.Y, p.wl, offs_l};
            ge::gemm_engine<false>(lds, DE, DE, DE, S, E);
        }
        GRID_BAR();
        PE(10);
        if (PROBE_ID == 12) { PB(12); GRID_BAR(); PE(12); }
    }
    PB(11);
    { PH_P ph_final_c(p, offs); }
    PE(11);
    if (PROBE_ID >= 0 && blockIdx.x == 0 && threadIdx.x == 0) { const unsigned long long t0 = wall_clock64(), wait = (unsigned long long)xbw[3] * PROBE_K; while (wall_clock64() - t0 < wait) __builtin_amdgcn_s_sleep(8); }
}

extern "C" void kernel_launch(void* const* d_in, const int* in_sizes, int n_in, void* d_out, int out_size, void* d_ws, size_t ws_size, hipStream_t stream) {
    (void)in_sizes; (void)out_size;
    if (n_in < 33 || WSO.total > ws_size) { fprintf(stderr, "kernel_launch: need 33 inputs and %zu bytes of workspace; got %d, %zu\n", (size_t)WSO.total, n_in, ws_size); return; }
    PK k{};
    for (int i = 0; i < 33; ++i) k.in[i] = (const float*)d_in[i];
    k.out = (float*)d_out; k.ws = (char*)d_ws;
    (void)hipMemsetAsync(d_ws, 0, WS_ZERO_BYTES, stream);
    static int grid = 0;
    if (!grid) {
        int dev = 0, cus = 0, per_cu = 0;
        (void)hipGetDevice(&dev);
        (void)hipDeviceGetAttribute(&cus, hipDeviceAttributeMultiprocessorCount, dev);
        (void)hipFuncSetAttribute((const void*)mega, hipFuncAttributeMaxDynamicSharedMemorySize, LDS_TOTAL);
        (void)hipOccupancyMaxActiveBlocksPerMultiprocessor(&per_cu, (const void*)mega, NT, LDS_TOTAL);
        if (per_cu < 1) fprintf(stderr, "kernel_launch: occupancy query reports %d blocks per CU\n", per_cu);
        grid = cus > 0 ? cus : 256;
    }
    hipLaunchKernelGGL(mega, dim3(grid), dim3(NT), LDS_TOTAL, stream, k);
}
```

```cpp
#include <hip/hip_runtime.h>
#include <stdint.h>
#include <stdio.h>

typedef unsigned short bf16_t;
typedef short bf16x8 __attribute__((ext_vector_type(8)));
typedef float f32x4 __attribute__((ext_vector_type(4)));
typedef unsigned u32x4 __attribute__((ext_vector_type(4)));
typedef unsigned u32x2 __attribute__((ext_vector_type(2)));

#define NT 512
#ifndef PROBE_BLK
#define PROBE_BLK 0
#endif
#ifndef PROBE_ID
#define PROBE_ID (-1)
#endif
#define PROBE_K 8
#ifndef REP_PRO
#define REP_PRO 1
#endif
#ifndef REP_DENSE
#define REP_DENSE 1
#endif
#ifndef REP_MOE
#define REP_MOE 1
#endif
#ifndef REP_MIX
#define REP_MIX 1
#endif
#ifndef REP_MISC
#define REP_MISC 1
#endif
constexpr int DM = 1024, NB = 4, SEQ = 4096, DEPTH = 4, CTXL = 256;
constexpr int TL = NB * SEQ, TC = NB * CTXL, TT = TL + TC;
constexpr int HYW = 512, HYC = 1536, QL = 384, KVL = 256, QKR = 32;
constexpr int MLAW = QL + KVL + QKR, MLA_END = HYC + MLAW, INC = MLA_END + 2 * DM;
constexpr int NH = 8, DQK = 96, DV = 64, NKEY = SEQ + CTXL;
constexpr int NE = 64, DE = 256, CAP = TT;
constexpr int NMOD = 6 * DM;
constexpr float EPSF = 1e-6f;
constexpr float QSCALE = 0.10206207261596577f * 1.4426950408889634f;

__device__ __forceinline__ bf16_t f2bf(float f) { unsigned u = __float_as_uint(f); u += 0x7FFFu + ((u >> 16) & 1u); return (bf16_t)(u >> 16); }
__device__ __forceinline__ float bf2f(bf16_t b) { return __uint_as_float(((unsigned)b) << 16); }
__device__ __forceinline__ unsigned pack2(float lo, float hi) { return (unsigned)f2bf(lo) | ((unsigned)f2bf(hi) << 16); }
__device__ __forceinline__ float epsf() { float e = EPSF; asm volatile("" : "+v"(e)); return e; }
__device__ __forceinline__ int tid_opaque() { int t = threadIdx.x; asm volatile("" : "+v"(t)); return t; }
__device__ __forceinline__ int shx_i(int v, int mask) {
    switch (mask) {
        case 1: return __builtin_amdgcn_ds_swizzle(v, (1 << 10) | 0x1F);
        case 2: return __builtin_amdgcn_ds_swizzle(v, (2 << 10) | 0x1F);
        case 4: return __builtin_amdgcn_ds_swizzle(v, (4 << 10) | 0x1F);
        case 8: return __builtin_amdgcn_ds_swizzle(v, (8 << 10) | 0x1F);
        case 16: return __builtin_amdgcn_ds_swizzle(v, (16 << 10) | 0x1F);
        default: {
            typedef unsigned u32x2s_t __attribute__((ext_vector_type(2)));
            const u32x2s_t r = __builtin_amdgcn_permlane32_swap((unsigned)v, (unsigned)v, false, false);
            return (int)(((threadIdx.x & 32u) == 0u) ? r.y : r.x); }
    }
}
__device__ __forceinline__ float shx(float v, int mask) { return __int_as_float(shx_i(__float_as_int(v), mask)); }
__device__ __forceinline__ int shx(int v, int mask) { return shx_i(v, mask); }
typedef unsigned u32x2_t __attribute__((ext_vector_type(2)));
__device__ __forceinline__ float rowmax4(float v) {
    u32x2_t r = __builtin_amdgcn_permlane16_swap(__float_as_uint(v), __float_as_uint(v), false, false);
    v = fmaxf(__uint_as_float(r.x), __uint_as_float(r.y));
    r = __builtin_amdgcn_permlane32_swap(__float_as_uint(v), __float_as_uint(v), false, false);
    return fmaxf(__uint_as_float(r.x), __uint_as_float(r.y));
}
__device__ __forceinline__ float rowsum4(float v) {
    u32x2_t r = __builtin_amdgcn_permlane16_swap(__float_as_uint(v), __float_as_uint(v), false, false);
    v = __uint_as_float(r.x) + __uint_as_float(r.y);
    r = __builtin_amdgcn_permlane32_swap(__float_as_uint(v), __float_as_uint(v), false, false);
    return __uint_as_float(r.x) + __uint_as_float(r.y);
}
__device__ __forceinline__ float wave_sum(float v) {
#pragma unroll
    for (int o = 32; o > 0; o >>= 1) v += shx(v, o);
    return v;
}


#define XB_TMO      128
#define XB_XCNT(j)  (256  + 64 * (j))
#define XB_XSUB(j)  (1280 + 64 * (j))
#define XB_XGEN(j)  (2304 + 64 * (j))
#define XB_TOP      3328
#define XB_TOPGEN   3392
#define XCD_BAR_WORDS 3456
#define XB_SPIN_CAP (1u << 22)
#define LAS __attribute__((address_space(3)))
__device__ __forceinline__ unsigned xb_ld(unsigned* p)              { return __hip_atomic_load(p, __ATOMIC_RELAXED, __HIP_MEMORY_SCOPE_AGENT); }
__device__ __forceinline__ unsigned xb_add(unsigned* p, unsigned v) { return __hip_atomic_fetch_add(p, v, __ATOMIC_RELAXED, __HIP_MEMORY_SCOPE_AGENT); }
__device__ __forceinline__ unsigned xb_xcc_id() { return (unsigned)__builtin_amdgcn_s_getreg((3 << 11) | 20) & 0xFu; }
#define XB_SPIN(cond, bar) do { unsigned _sp = 0; while (cond) { __builtin_amdgcn_s_sleep(1); \
    if ((++_sp & 255u) == 0u) { if (xb_ld(&(bar)[XB_TMO])) break; if (_sp > XB_SPIN_CAP) { atomicAdd(&(bar)[XB_TMO], 1u); break; } } } } while (0)
struct XcdBarrier { unsigned* bar; unsigned x; volatile LAS unsigned* st; };
__device__ __forceinline__ XcdBarrier xcd_barrier_post(unsigned* bar, volatile LAS unsigned* st) {
    XcdBarrier b; b.bar = bar; b.x = xb_xcc_id(); b.st = st;
    if (threadIdx.x == 0) (void)xb_add(&bar[XB_XCNT(b.x)], 1u);
    return b;
}
__device__ __forceinline__ void xcd_barrier_complete(unsigned* bar, unsigned x, unsigned& nloc, unsigned& nx) {
    const unsigned G = gridDim.x * gridDim.y * gridDim.z;
    unsigned sum, cnt, mine, sp = 0u;
    for (;;) {
        sum = 0u; cnt = 0u; mine = 0u;
#pragma unroll
        for (unsigned j = 0; j < 16; ++j) { const unsigned c = xb_ld(&bar[XB_XCNT(j)]); sum += c; cnt += (c > 0u) ? 1u : 0u; mine = (j == x) ? c : mine; }
        if (sum == G) break;
        __builtin_amdgcn_s_sleep(1);
        if ((++sp & 255u) == 0u) { if (xb_ld(&bar[XB_TMO])) break; if (sp > XB_SPIN_CAP) { atomicAdd(&bar[XB_TMO], 1u); break; } }
    }
    nloc = mine > 0u ? mine : 1u; nx = cnt > 0u ? cnt : 1u;
}
__device__ __forceinline__ void xcd_barrier(const XcdBarrier& b) {
    asm volatile("s_waitcnt vmcnt(0)" ::: "memory");
    __syncthreads();
    if (threadIdx.x == 0) {
        unsigned* bar = b.bar;
        __builtin_amdgcn_s_waitcnt(0);
        unsigned nloc = b.st[0], nx = b.st[1];
        if (nloc == 0u) { xcd_barrier_complete(bar, b.x, nloc, nx); b.st[0] = nloc; b.st[1] = nx; }
        const unsigned old = xb_add(&bar[XB_XSUB(b.x)], 1u);
        const unsigned gen = old / nloc;
        if (old + 1u == (gen + 1u) * nloc) {
            __builtin_amdgcn_fence(__ATOMIC_RELEASE, "agent");
            asm volatile("s_waitcnt vmcnt(0)" ::: "memory");
            const unsigned og = xb_add(&bar[XB_TOP], 1u);
            const unsigned tg = og / nx;
            if (og + 1u == (tg + 1u) * nx) xb_add(&bar[XB_TOPGEN], 1u);
            else XB_SPIN(xb_ld(&bar[XB_TOPGEN]) == tg, bar);
            __builtin_amdgcn_fence(__ATOMIC_ACQUIRE, "agent");
            xb_add(&bar[XB_XGEN(b.x)], 1u);
            asm volatile("s_waitcnt vmcnt(0)" ::: "memory");
        } else {
            XB_SPIN(xb_ld(&bar[XB_XGEN(b.x)]) == gen, bar);
            __builtin_amdgcn_fence(__ATOMIC_ACQUIRE, "agent");
            asm volatile("s_waitcnt vmcnt(0)" ::: "memory");
        }
    }
    __syncthreads();
}

#define WS_LIST(X) \
    X(unsigned, bar, XCD_BAR_WORDS * 4)                         \
    X(int, cnt, DEPTH * 64 * 256)                               \
    X(float, modp, (size_t)DEPTH * 32 * 5 * NMOD * 4)           \
    X(float, mod, (size_t)DEPTH * 5 * NMOD * 4)                 \
    X(float, H2a, (size_t)DEPTH * SEQ * 64 * 4) \
    X(float, H2b, (size_t)DEPTH * CTXL * 64 * 4) \
    X(float, HT1, (size_t)DEPTH * 2048 * CTXL * 4) \
    X(float, SSQ0, (size_t)DEPTH * 2048 * 128 * 4) \
    X(float, SSQ1, (size_t)DEPTH * 2048 * 8 * 4) \
    X(float, SCL0, (size_t)DEPTH * 2048 * 4) \
    X(float, SCL1, (size_t)DEPTH * 2048 * 4) \
    X(float, hx, (size_t)TT * DM * 4)                           \
    X(bf16_t, U, (size_t)TT * DM * 2)                           \
    X(bf16_t, PT, (size_t)NB * HYC * SEQ * 2)                   \
    X(bf16_t, PTc, (size_t)NB * HYC * CTXL * 2) \
    X(bf16_t, PMLAb, (size_t)TT * 640 * 2)                      \
    X(bf16_t, G, (size_t)TT * 2048 * 2)                         \
    X(bf16_t, Q, (size_t)NB * NH * SEQ * 128 * 2)               \
    X(bf16_t, Qc, (size_t)NB * NH * CTXL * 128 * 2) \
    X(bf16_t, K, (size_t)NB * NH * NKEY * DQK * 2)              \
    X(bf16_t, V, (size_t)NB * NH * NKEY * DV * 2)               \
    X(bf16_t, Yatt, (size_t)TT * 512 * 2) \
    X(bf16_t, Yhy, (size_t)TT * 512 * 2) \
    X(bf16_t, M1, (size_t)TT * DM * 2) \
    X(int, list, (size_t)NE * CAP * 4) \
    X(float, wl, (size_t)NE * CAP * 4) \
    X(int, asg, (size_t)TT * 4 * 4) \
    X(bf16_t, Hb, (size_t)(2 * TT + 256) * DE * 2) \
    X(bf16_t, Y, (size_t)2 * TT * DM * 2) \
    X(bf16_t, WtHy, (size_t)DEPTH * HYC * DM * 2)               \
    X(bf16_t, WtRest, (size_t)DEPTH * 2816 * DM * 2) \
    X(bf16_t, WtUq, (size_t)DEPTH * 768 * QL * 2) \
    X(bf16_t, WtUkv, (size_t)DEPTH * 1024 * KVL * 2) \
    X(bf16_t, WtHyo, (size_t)DEPTH * DM * HYW * 2) \
    X(bf16_t, WtMlao, (size_t)DEPTH * DM * 512 * 2) \
    X(bf16_t, WtOut, (size_t)DEPTH * DM * DM * 2) \
    X(bf16_t, WtG, (size_t)NE * DE * DM * 2)                    \
    X(bf16_t, WtU, (size_t)NE * DE * DM * 2) \
    X(bf16_t, WtD, (size_t)NE * DM * DE * 2) \
    X(float2, rope, (size_t)SEQ * 16 * 8)                       \
    X(float2, Hs, (size_t)DEPTH * HYW * 4 * 4096 * 8)           \
    X(float2, Wtab, 4096 * 8) \
    X(bf16_t, WrT, (size_t)DEPTH * 2 * 80 * DM * 2)             \
    X(float2, W2tab, 4096 * 8)
struct WsOff {
#define X(t, n, b) size_t n;
    WS_LIST(X)
#undef X
    size_t total;
};
constexpr WsOff ws_layout() {
    WsOff o{}; size_t a = 0;
#define X(t, n, b) o.n = a; a += (((size_t)(b)) + 255) & ~(size_t)255;
    WS_LIST(X)
#undef X
    o.total = a; return o;
}
constexpr WsOff WSO = ws_layout();
constexpr size_t WS_ZERO_BYTES = WSO.modp;
static_assert(WSO.Yatt - WSO.G >= (size_t)DEPTH * 2048 * SEQ * 4, "HT0 alias region too small");

struct PK { const float* in[33]; float* out; char* ws; };
struct P {
    const float *x, *c, *ctx, *c_ctx, *w_ada, *b_ada, *norm1_g, *w_in, *q_norm_g, *kv_norm_g, *w_uq, *w_ukv, *sc_w, *sc_b;
    const float *flt_w1, *flt_b1, *flt_freq, *flt_w2, *flt_b2, *flt_w3, *flt_bias, *w_hy_o, *w_mla_o, *w_out, *norm2_g;
    const float *w_rg, *b_rg, *w_re, *b_re, *w_gate, *w_up, *w_down, *final_g;
    float* out;
#define X(t, n, b) t* n;
    WS_LIST(X)
#undef X
    float* HT0;
};
typedef const __attribute__((address_space(4))) PK* KArgP;
__device__ __forceinline__ P make_p(KArgP kp) {
    P p; const KArgP& kk = kp; char* ws = kk->ws;
    p.x = kk->in[0]; p.c = kk->in[1]; p.ctx = kk->in[2]; p.c_ctx = kk->in[3]; p.w_ada = kk->in[4]; p.b_ada = kk->in[5]; p.norm1_g = kk->in[6]; p.w_in = kk->in[7];
    p.q_norm_g = kk->in[8]; p.kv_norm_g = kk->in[9]; p.w_uq = kk->in[10]; p.w_ukv = kk->in[11]; p.sc_w = kk->in[12]; p.sc_b = kk->in[13];
    p.flt_w1 = kk->in[14]; p.flt_b1 = kk->in[15]; p.flt_freq = kk->in[16]; p.flt_w2 = kk->in[17]; p.flt_b2 = kk->in[18]; p.flt_w3 = kk->in[19]; p.flt_bias = kk->in[20];
    p.w_hy_o = kk->in[21]; p.w_mla_o = kk->in[22]; p.w_out = kk->in[23]; p.norm2_g = kk->in[24]; p.w_rg = kk->in[25]; p.b_rg = kk->in[26]; p.w_re = kk->in[27]; p.b_re = kk->in[28];
    p.w_gate = kk->in[29]; p.w_up = kk->in[30]; p.w_down = kk->in[31]; p.final_g = kk->in[32];
    p.out = kk->out;
#define X(t, n, b) p.n = (t*)(ws + WSO.n);
    WS_LIST(X)
#undef X
    p.HT0 = (float*)(ws + WSO.G);
    return p;
}

constexpr int MODK = 32;
__device__ __forceinline__ void ph_mod_partial(const P& p, char* smem) {
    float* s = (float*)smem;
    const int tid = tid_opaque();
    for (int it = blockIdx.x; it < DEPTH * MODK * 3; it += gridDim.x) {
        const int l = it / (MODK * 3), kc = (it / 3) % MODK, jb = it % 3;
        __syncthreads();
        if (tid < 5 * 32) {
            const int r = tid / 32, kk = tid % 32, k = kc * 32 + kk;
            const float cv = (r < 4) ? p.c[r * DM + k] : p.c_ctx[k];
            s[tid] = cv / (1.0f + expf(-cv));
        }
        __syncthreads();
        const int j = jb * 2048 + tid * 4;
        f32x4 a0 = {0.f, 0.f, 0.f, 0.f}, a1 = a0, a2 = a0, a3 = a0, a4 = a0;
        const float* w = p.w_ada + ((size_t)l * DM + kc * 32) * NMOD + j;
#pragma unroll 8
        for (int kk = 0; kk < 32; ++kk) {
            const f32x4 wv = *(const f32x4*)(w + (size_t)kk * NMOD);
            a0 += wv * s[kk]; a1 += wv * s[32 + kk]; a2 += wv * s[64 + kk]; a3 += wv * s[96 + kk]; a4 += wv * s[128 + kk];
        }
        float* o = p.modp + ((size_t)(l * MODK + kc) * 5) * NMOD + j;
        *(f32x4*)o = a0; *(f32x4*)(o + NMOD) = a1; *(f32x4*)(o + 2 * NMOD) = a2; *(f32x4*)(o + 3 * NMOD) = a3; *(f32x4*)(o + 4 * NMOD) = a4;
    }
}

__device__ __forceinline__ void ph_filter_a(const P& p, char* smem) {
    float* zs = (float*)smem;
    float* h1s = zs + 8 * 36;
    const int tid = tid_opaque(), tt = tid >> 6, j = tid & 63;
    const int n0 = DEPTH * 512, n1 = DEPTH * 32;
    for (int it = blockIdx.x; it < n0 + n1; it += gridDim.x) {
        int l, ls, tg;
        if (it < n0) { ls = 0; l = it / 512; tg = it % 512; } else { ls = 1; l = (it - n0) / 32; tg = (it - n0) % 32; }
        const int L = ls ? CTXL : SEQ;
        const int t = tg * 8 + tt;
        __syncthreads();
        if (j < 33) {
            float f;
            if (j == 0) f = (float)t / (float)(L - 1);
            else {
                const int k = (j - 1) & 15;
                const float band = 1e-4f + (float)k * ((15.0f - 1e-4f) / 15.0f);
                const float w = 6.283185307179586f * (float)t / (float)L;
                const double ang = (double)band * (double)w;
                f = (j <= 16) ? (float)cos(ang) : (float)(-sin(ang));
            }
            zs[tt * 36 + j] = f;
        }
        __syncthreads();
        const float fr = p.flt_freq[l * 64 + j];
        float a = p.flt_b1[l * 64 + j];
        for (int i = 0; i < 33; ++i) a += zs[tt * 36 + i] * p.flt_w1[((size_t)l * 33 + i) * 64 + j];
        h1s[tt * 64 + j] = sinf(fr * a);
        __syncthreads();
        float a2 = p.flt_b2[l * 64 + j];
        for (int i = 0; i < 64; ++i) a2 += h1s[tt * 64 + i] * p.flt_w2[((size_t)l * 64 + i) * 64 + j];
        const float h2 = sinf(fr * a2);
        if (ls == 0) p.H2a[((size_t)l * SEQ + t) * 64 + j] = h2; else p.H2b[((size_t)l * CTXL + t) * 64 + j] = h2;
    }
}

typedef float f32x16 __attribute__((ext_vector_type(16)));
__device__ __forceinline__ void ph_filter_b2(const P& p, char* smem) {
    float* sA = (float*)smem;
    const int tid = tid_opaque(), lane = tid & 63, wv = tid >> 6, li = lane & 31, hf = lane >> 5;
    const int n0 = DEPTH * 128 * 8, n1 = DEPTH * 8 * 8;
    const float DA = -15.350567286626973f, DB = -3.0701134573253946f;
    for (int it = blockIdx.x; it < n0 + n1; it += gridDim.x) {
        int l, ls, tt, cg;
        if (it < n0) { ls = 0; l = it / 1024; tt = (it / 8) % 128; cg = it % 8; } else { const int i2 = it - n0; ls = 1; l = i2 / 64; tt = (i2 / 8) % 8; cg = i2 % 8; }
        const int L = ls ? CTXL : SEQ, t0 = tt * 32;
        const float* h2 = ls ? p.H2b + ((size_t)l * CTXL + t0) * 64 : p.H2a + ((size_t)l * SEQ + t0) * 64;
        __syncthreads();
        { const int r = tid >> 4, k4 = (tid & 15) * 4; const float4 v = *(const float4*)(h2 + r * 64 + k4); float* d = sA + r * 65 + k4; d[0] = v.x; d[1] = v.y; d[2] = v.z; d[3] = v.w; }
        __syncthreads();
        const int col = cg * 256 + wv * 32 + li;
        const float* wp = p.flt_w3 + (size_t)l * 64 * 2048 + col;
        f32x16 acc;
#pragma unroll
        for (int i = 0; i < 16; ++i) acc[i] = 0.f;
#pragma unroll 8
        for (int s2 = 0; s2 < 32; ++s2) {
            const int k = 2 * s2 + hf;
            acc = __builtin_amdgcn_mfma_f32_32x32x2f32(sA[li * 65 + k], wp[(size_t)k * 2048], acc, 0, 0, 0);
        }
        const int ch = col & 511;
        const float delta = fabsf(DA + (float)ch * ((DB - DA) / 511.0f));
        float q = 0.f;
        float* dst = (ls ? p.HT1 + ((size_t)l * 2048 + col) * CTXL : p.HT0 + ((size_t)l * 2048 + col) * SEQ) + t0 + 4 * hf;
#pragma unroll
        for (int g4 = 0; g4 < 4; ++g4) {
            float4 o;
            float* op = &o.x;
#pragma unroll
            for (int e = 0; e < 4; ++e) { const int t = t0 + 8 * g4 + 4 * hf + e; const float v = acc[4 * g4 + e] * expf(-((float)t / (float)(L - 1)) * delta); op[e] = v; q += v * v; }
            *(float4*)(dst + 8 * g4) = o;
        }
        q += shx(q, 32);
        if (hf == 0) { if (ls == 0) p.SSQ0[((size_t)l * 2048 + col) * 128 + tt] = q; else p.SSQ1[((size_t)l * 2048 + col) * 8 + tt] = q; }
    }
    __syncthreads();
}

__device__ __forceinline__ void ph_finalize(const P& p) {
    const int n_mod = DEPTH * 5 * NMOD, n_s = DEPTH * 2048;
    for (int i = blockIdx.x * NT + threadIdx.x; i < n_mod + 2 * n_s; i += gridDim.x * NT) {
        if (i < n_mod) {
            const int l = i / (5 * NMOD), r = (i / NMOD) % 5, j = i % NMOD;
            float a = p.b_ada[l * NMOD + j];
            for (int kc = 0; kc < MODK; ++kc) a += p.modp[((size_t)(l * MODK + kc) * 5 + r) * NMOD + j];
            p.mod[i] = a;
        } else if (i < n_mod + n_s) {
            const int k = i - n_mod; float a = 0.f;
            for (int q = 0; q < 128; ++q) a += p.SSQ0[(size_t)k * 128 + q];
            p.SCL0[k] = rsqrtf(a + epsf());
        } else {
            const int k = i - n_mod - n_s; float a = 0.f;
            for (int q = 0; q < 8; ++q) a += p.SSQ1[(size_t)k * 8 + q];
            p.SCL1[k] = rsqrtf(a + epsf());
        }
    }
}

__device__ __forceinline__ float rope_apply(float self, float partner, int d, int t) {
    const int a = d >> 4, s = (d >> 3) & 1, i = d & 7;
    const float pos = (float)(a == 0 ? (t >> 6) : (t & 63));
    const float inv = powf(10000.0f, -(float)i / 8.0f);
    const float ang = pos * inv;
    const float cs = cosf(ang), sn = sinf(ang);
    return s == 0 ? self * cs - partner * sn : partner * sn + self * cs;
}

namespace ge {
constexpr int BM = 256, BK = 64, HALF = 128, HTB = HALF * BK * 2, STAGE_BYTES = 8 * HTB, NXCD = 8, WGM = 8;
__device__ __forceinline__ int lds_byte(int r, int c) { const int st = (r >> 4) * 2 + (c >> 5), rr = r & 15, cc = c & 31, ob = rr * 64 + cc * 2; return st * 1024 + (ob ^ (((ob >> 9) & 1) << 5)); }
__device__ __forceinline__ void stage_rc(int b, int& R, int& C) { const int st = b / 1024, sb = b % 1024, swz = sb ^ (((sb >> 9) & 1) << 5); R = (st >> 1) * 16 + swz / 64; C = (st & 1) * 32 + (swz % 64) / 2; }
__device__ __forceinline__ int perm32(int rho) { const int n = rho >> 4, i = rho & 15; return 8 * (i >> 2) + 4 * n + (i & 3); }
__device__ __forceinline__ void tile_order(int L, int nM, int nN, int& pm, int& pn) {
    const int nwg = nM * nN; int wgid = L;
    { const int q = nwg / NXCD, r = nwg % NXCD, xcd = wgid % NXCD, off = wgid / NXCD; wgid = (xcd < r ? xcd * (q + 1) : r * (q + 1) + (xcd - r) * q) + off; }
    const int nig = WGM * nN, gid = wgid / nig, fm = gid * WGM, gsz = (nM - fm) < WGM ? (nM - fm) : WGM;
    pm = fm + ((wgid % nig) % gsz); pn = (wgid % nig) / gsz;
}
struct Unit { const char* a; const char* b0; const char* b1; const int* rows; int nrows; int pm, pn, kind; };
typedef f32x4 Acc[2][2][4][2];

template <bool GATHER, int ABLK = 0, class Sched, class Epi>
__device__ __forceinline__ void gemm_engine(LAS unsigned char* lds, const int lda, const int ldb, const int K, const Sched& S, const Epi& E) {
    const int tid = tid_opaque(), wid = __builtin_amdgcn_readfirstlane(tid >> 6), lane = tid & 63, wr = wid >> 2, wc = wid & 3, fr = lane & 15, fq = lane >> 4;
    const int nt = K / BK;
    int sR[2], sC[2];
    unsigned voffA[2], voffB[2];
#pragma unroll
    for (int i = 0; i < 2; ++i) { stage_rc(tid * 16 + i * 8192, sR[i], sC[i]); const int Rb = (sR[i] & ~31) + perm32(sR[i] & 31);
        voffA[i] = ABLK ? (unsigned)((sC[i] >> 3) * ABLK + sR[i]) * 16u : (unsigned)(sR[i] * lda + sC[i]) * 2u; voffB[i] = (unsigned)(Rb * ldb + sC[i]) * 2u; }
    const size_t kstep = (size_t)(BK * 2);
    const size_t hstepA = ABLK ? (size_t)HALF * 16 : (size_t)HALF * lda * 2;
    const size_t kstepA = ABLK ? (size_t)(BK / 8) * ABLK * 16 : kstep;
    const unsigned ldsw = (unsigned)wid * 1024u;
    const int aoff = lds_byte(wr * 64 + fr, fq * 8), boff = lds_byte(wc * 32 + fr, fq * 8);
    unsigned gvc[2][2], gvn[2][2];
#define GE_SA(b, h) (((b) * 2 + (h)) * HTB)
#define GE_SB(b, h) ((4 + (b) * 2 + (h)) * HTB)
#define GE_GLDS(src, bufoff, i) __builtin_amdgcn_global_load_lds((const unsigned*)(src), (LAS unsigned*)(lds + (bufoff) + ldsw + (i) * 8192), 16, 0, 0)
#define GE_STAGE_B(bufoff, bp) do { _Pragma("unroll") for (int _i = 0; _i < 2; ++_i) GE_GLDS((bp) + voffB[_i], bufoff, _i); } while (0)
#define GE_STAGE_A(bufoff, ap, h, gv) do { _Pragma("unroll") for (int _i = 0; _i < 2; ++_i) { \
        if constexpr (GATHER) GE_GLDS((ap) + (gv)[h][_i], bufoff, _i); else GE_GLDS((ap) + (size_t)(h) * hstepA + voffA[_i], bufoff, _i); } } while (0)
#define GE_STAGE_A2(bufoff, ap, h) do { _Pragma("unroll") for (int _i = 0; _i < 2; ++_i) { \
        if constexpr (GATHER) GE_GLDS((ap) + (last ? gvn[h][_i] : gvc[h][_i]), bufoff, _i); else GE_GLDS((ap) + (size_t)(h) * hstepA + voffA[_i], bufoff, _i); } } while (0)
#define GE_LDA(dst, b, h) do { _Pragma("unroll") for (int m = 0; m < 4; ++m) _Pragma("unroll") for (int k = 0; k < 2; ++k) dst[m][k] = *(const LAS bf16x8*)(lds + GE_SA(b, h) + aoff + m * 2048 + k * 1024); } while (0)
#define GE_LDB(dst, b, h) do { _Pragma("unroll") for (int n = 0; n < 2; ++n) _Pragma("unroll") for (int k = 0; k < 2; ++k) dst[n][k] = *(const LAS bf16x8*)(lds + GE_SB(b, h) + boff + n * 2048 + k * 1024); } while (0)
#define GE_MMA(ai, bj, At, Bt) do { __builtin_amdgcn_s_setprio(1); _Pragma("unroll") for (int m = 0; m < 4; ++m) _Pragma("unroll") for (int n = 0; n < 2; ++n) _Pragma("unroll") for (int k = 0; k < 2; ++k) \
        acc[ai][bj][m][n] = __builtin_amdgcn_mfma_f32_16x16x32_bf16(Bt[n][k], At[m][k], acc[ai][bj][m][n], 0, 0, 0); __builtin_amdgcn_s_setprio(0); } while (0)
#define GE_WAIT_V(n) asm volatile("s_waitcnt vmcnt(" #n ")" ::: "memory")
#define GE_WAIT_L(n) asm volatile("s_waitcnt lgkmcnt(" #n ")" ::: "memory")
#define GE_BAR __builtin_amdgcn_s_barrier()
#define GE_SCHED __builtin_amdgcn_sched_barrier(0)
#define GE_GATHER_OFFS(gv, u) do { if constexpr (GATHER) { _Pragma("unroll") for (int _h = 0; _h < 2; ++_h) _Pragma("unroll") for (int _i = 0; _i < 2; ++_i) { \
        int _r = (u).pm * BM + _h * HALF + sR[_i]; _r = _r < (u).nrows ? _r : (u).nrows - 1; (gv)[_h][_i] = (unsigned)((u).rows[_r] * lda + sC[_i]) * 2u; } } } while (0)
    Unit cur, nxt; int ui = 0;
    if (!S.next(0, cur)) return;
    Acc acc;
#pragma unroll
    for (int a = 0; a < 2; ++a)
#pragma unroll
        for (int b = 0; b < 2; ++b)
#pragma unroll
            for (int m = 0; m < 4; ++m)
#pragma unroll
                for (int n = 0; n < 2; ++n) acc[a][b][m][n] = (f32x4){0.f, 0.f, 0.f, 0.f};
    bf16x8 At[4][2], B0[2][2], B1[2][2];
    GE_GATHER_OFFS(gvc, cur);
    GE_STAGE_B(GE_SB(0, 0), cur.b0); GE_STAGE_A(GE_SA(0, 0), cur.a, 0, gvc); GE_STAGE_B(GE_SB(0, 1), cur.b1); GE_STAGE_A(GE_SA(0, 1), cur.a, 1, gvc);
    if (wr == 1) GE_BAR;
    GE_WAIT_V(4); GE_BAR;
    GE_STAGE_B(GE_SB(1, 0), cur.b0 + kstep); GE_STAGE_A(GE_SA(1, 0), cur.a + kstepA, 0, gvc); GE_STAGE_B(GE_SB(1, 1), cur.b1 + kstep);
    GE_WAIT_V(6); GE_BAR;
    for (;;) {
        const bool has_next = S.next(ui + 1, nxt);
        if (!has_next) nxt = cur;
        if constexpr (GATHER) { if (has_next) { GE_GATHER_OFFS(gvn, nxt); } else {
#pragma unroll
            for (int h = 0; h < 2; ++h)
#pragma unroll
                for (int i = 0; i < 2; ++i) gvn[h][i] = gvc[h][i]; } }
#pragma unroll 1
        for (int t = 0; t < nt; t += 2) {
            const bool last = (t == nt - 2);
            const char* a1 = cur.a + (size_t)(t + 1) * kstepA;
            const char* a2 = last ? nxt.a : cur.a + (size_t)(t + 2) * kstepA;
            const char* b20 = last ? nxt.b0 : cur.b0 + (size_t)(t + 2) * kstep;
            const char* b21 = last ? nxt.b1 : cur.b1 + (size_t)(t + 2) * kstep;
            const char* a3 = a2 + kstepA; const char* b30 = b20 + kstep; const char* b31 = b21 + kstep;
            GE_LDB(B0, 0, 0); GE_SCHED; GE_LDA(At, 0, 0); GE_STAGE_A(GE_SA(1, 1), a1, 1, gvc);
            GE_WAIT_L(8); GE_BAR; GE_WAIT_L(0); GE_MMA(0, 0, At, B0); GE_BAR; GE_SCHED;
            GE_LDB(B1, 0, 1); GE_STAGE_B(GE_SB(0, 0), b20);
            GE_BAR; GE_WAIT_L(0); GE_MMA(0, 1, At, B1); GE_BAR;
            GE_LDA(At, 0, 1); GE_STAGE_A2(GE_SA(0, 0), a2, 0);
            GE_BAR; GE_WAIT_L(0); GE_MMA(1, 0, At, B0); GE_BAR; GE_SCHED;
            GE_STAGE_B(GE_SB(0, 1), b21);
            GE_WAIT_V(6); GE_BAR; GE_MMA(1, 1, At, B1); GE_BAR;
            GE_LDB(B0, 1, 0); GE_SCHED; GE_LDA(At, 1, 0); GE_STAGE_A2(GE_SA(0, 1), a2, 1);
            GE_WAIT_L(8); GE_BAR; GE_WAIT_L(0); GE_MMA(0, 0, At, B0); GE_BAR; GE_SCHED;
            GE_LDB(B1, 1, 1); GE_STAGE_B(GE_SB(1, 0), b30);
            GE_BAR; GE_WAIT_L(0); GE_MMA(0, 1, At, B1); GE_BAR;
            GE_LDA(At, 1, 1); GE_STAGE_A2(GE_SA(1, 0), a3, 0);
            GE_BAR; GE_WAIT_L(0); GE_MMA(1, 0, At, B0); GE_BAR; GE_SCHED;
            GE_STAGE_B(GE_SB(1, 1), b31);
            GE_WAIT_V(6); GE_BAR; GE_MMA(1, 1, At, B1); GE_BAR;
        }
        E(acc, cur, wr, wc, fr, fq);
        if (!has_next) break;
#pragma unroll
        for (int a = 0; a < 2; ++a)
#pragma unroll
            for (int b = 0; b < 2; ++b)
#pragma unroll
                for (int m = 0; m < 4; ++m)
#pragma unroll
                    for (int n = 0; n < 2; ++n) acc[a][b][m][n] = (f32x4){0.f, 0.f, 0.f, 0.f};
        cur = nxt; ++ui;
        if constexpr (GATHER) {
#pragma unroll
            for (int h = 0; h < 2; ++h)
#pragma unroll
                for (int i = 0; i < 2; ++i) gvc[h][i] = gvn[h][i]; }
    }
    GE_WAIT_V(0);
    if (wr == 0) GE_BAR;
    GE_BAR;
#undef GE_SA
#undef GE_SB
#undef GE_GLDS
#undef GE_STAGE_A
#undef GE_STAGE_A2
#undef GE_STAGE_B
#undef GE_LDA
#undef GE_LDB
#undef GE_MMA
#undef GE_WAIT_V
#undef GE_WAIT_L
#undef GE_BAR
#undef GE_SCHED
#undef GE_GATHER_OFFS
}
}
__device__ __forceinline__ unsigned cvt_pk_bf16(float lo, float hi) { unsigned r; asm volatile("v_cvt_pk_bf16_f32 %0, %1, %2" : "=v"(r) : "v"(lo), "v"(hi)); return r; }
__device__ __forceinline__ u32x4 pack8(const f32x4 a, const f32x4 b) { u32x4 w; w.x = cvt_pk_bf16(a[0], a[1]); w.y = cvt_pk_bf16(a[2], a[3]); w.z = cvt_pk_bf16(b[0], b[1]); w.w = cvt_pk_bf16(b[2], b[3]); return w; }
__device__ __forceinline__ void unpack8(const u32x4 w, f32x4& a, f32x4& b) {
    a[0] = __uint_as_float(w.x << 16); a[1] = __uint_as_float(w.x & 0xFFFF0000u); a[2] = __uint_as_float(w.y << 16); a[3] = __uint_as_float(w.y & 0xFFFF0000u);
    b[0] = __uint_as_float(w.z << 16); b[1] = __uint_as_float(w.z & 0xFFFF0000u); b[2] = __uint_as_float(w.w << 16); b[3] = __uint_as_float(w.w & 0xFFFF0000u); }
__device__ __forceinline__ float sigmoidf_fast(float v) { return 1.0f / (1.0f + __expf(-v)); }

struct SchedDense {
    const char* A; const char* B; size_t arb, brb; int nM, nN, G, c;
    __device__ __forceinline__ bool next(int i, ge::Unit& u) const {
        const int L = i * G + c; if (L >= nM * nN) return false;
        int pm, pn; ge::tile_order(L, nM, nN, pm, pn);
        u.pm = pm; u.pn = pn; u.kind = 0; u.rows = nullptr; u.nrows = 0;
        u.a = A + (size_t)pm * 256 * arb; u.b0 = B + (size_t)pn * 256 * brb; u.b1 = u.b0 + 128 * brb; return true;
    }
};
struct SchedInproj {
    const char* WtHy; const char* WtRest; const char* U; int G, c;
    __device__ __forceinline__ bool next(int i, ge::Unit& u) const {
        const int L = i * G + c; if (L >= 408 + 748) return false;
        int pm, pn; u.rows = nullptr; u.nrows = 0;
        if (L < 408) { ge::tile_order(L, 6, 68, pm, pn); u.kind = 0; u.a = WtHy + (size_t)pm * 256 * 2048; u.b0 = U + (size_t)pn * 256 * 2048; }
        else { ge::tile_order(L - 408, 68, 11, pm, pn); u.kind = 1; u.a = U + (size_t)pm * 256 * 2048; u.b0 = WtRest + (size_t)pn * 256 * 2048; }
        u.b1 = u.b0 + 128 * 2048; u.pm = pm; u.pn = pn; return true;
    }
};
struct EpiInproj {
    bf16_t* PT; bf16_t* PTc; bf16_t* G;
    __device__ __forceinline__ void operator()(const ge::Acc& acc, const ge::Unit& u, int wr, int wc, int fr, int fq) const {
#pragma unroll
        for (int ai = 0; ai < 2; ++ai)
#pragma unroll
            for (int m = 0; m < 4; ++m) {
                const int r = u.pm * 256 + ai * 128 + wr * 64 + m * 16 + fr;
#pragma unroll
                for (int bj = 0; bj < 2; ++bj) {
                    const int c0 = bj * 128 + wc * 32 + fq * 8;
                    if (u.kind == 0) {
                        bf16_t* dst = (u.pn < 64) ? PT + ((size_t)((u.pn >> 4) * HYC + r)) * SEQ + (u.pn & 15) * 256 + c0
                                                  : PTc + ((size_t)((u.pn - 64) * HYC + r)) * CTXL + c0;
                        *(u32x4*)dst = pack8(acc[ai][bj][m][0], acc[ai][bj][m][1]);
                    } else {
                        const int c = (u.pn - 3) * 256 + c0;
                        f32x4 a = acc[ai][bj][m][0], b = acc[ai][bj][m][1];
#pragma unroll
                        for (int j = 0; j < 4; ++j) { a[j] = sigmoidf_fast(a[j]); b[j] = sigmoidf_fast(b[j]); }
                        *(u32x4*)(G + (size_t)r * 2048 + c) = pack8(a, b);
                    }
                }
            }
    }
};
struct EpiQ {
    bf16_t* Q; bf16_t* Qc; const LAS float* rope;
    const LAS float* rs;
    __device__ __forceinline__ void operator()(const ge::Acc& acc, const ge::Unit& u, int wr, int wc, int fr, int fq) const {
#pragma unroll
        for (int ai = 0; ai < 2; ++ai)
#pragma unroll
            for (int m = 0; m < 4; ++m) {
                const int r = u.pm * 256 + ai * 128 + wr * 64 + m * 16 + fr;
                const bool lat = r < TL;
                const int t = lat ? (r & 4095) : ((r - TL) & 255);
                const int b = lat ? (r >> 12) : ((r - TL) >> 8);
#pragma unroll
                for (int bj = 0; bj < 2; ++bj) {
                    const int c = u.pn * 256 + bj * 128 + wc * 32 + fq * 8;
                    const int h = c / 96, dd = c - h * 96;
                    const float rsc = QSCALE * rs[ai * 128 + wr * 64 + m * 16 + fr];
                    f32x4 v0 = acc[ai][bj][m][0] * rsc, v1 = acc[ai][bj][m][1] * rsc;
                    f32x4 p0, p1;
#pragma unroll
                    for (int j = 0; j < 4; ++j) { p0[j] = shx(v0[j], 16); p1[j] = shx(v1[j], 16); }
                    bf16_t* qrow = lat ? Q + ((size_t)(b * NH + h) * SEQ + t) * 128 : Qc + ((size_t)(b * NH + h) * CTXL + t) * 128;
                    if (dd < 64) *(u32x4*)(qrow + dd) = pack8(v0, v1);
                    else {
                        const int d0 = dd - 64;
                        f32x4 o0 = v0, o1 = v1;
                        if (lat) {
                            const LAS float* rp = rope + 2 * ((d0 >> 4) ? 32 + (t & 63) * 8 : ((t >> 6) & 3) * 8);
                            const bool s1 = (d0 >> 3) & 1;
#pragma unroll
                            for (int j = 0; j < 4; ++j) {
                                const float cax = rp[2 * j], cay = rp[2 * j + 1], cbx = rp[8 + 2 * j], cby = rp[9 + 2 * j];
                                o0[j] = s1 ? p0[j] * cay + v0[j] * cax : v0[j] * cax - p0[j] * cay;
                                o1[j] = s1 ? p1[j] * cby + v1[j] * cbx : v1[j] * cbx - p1[j] * cby;
                            }
                        }
                        *(u32x4*)(qrow + 64 + d0) = pack8(o0, o1);
                        *(u32x4*)(qrow + 96 + d0) = pack8(v0, v1);
                    }
                }
            }
    }
};
struct EpiKV {
    bf16_t* K; bf16_t* V; const LAS float* rs;
    __device__ __forceinline__ void operator()(const ge::Acc& acc, const ge::Unit& u, int wr, int wc, int fr, int fq) const {
#pragma unroll
        for (int ai = 0; ai < 2; ++ai)
#pragma unroll
            for (int m = 0; m < 4; ++m) {
                const int r = u.pm * 256 + ai * 128 + wr * 64 + m * 16 + fr;
                int b, key;
                if (r < TL) { b = r >> 12; key = r & 4095; } else { b = (r - TL) >> 8; key = SEQ + ((r - TL) & 255); }
#pragma unroll
                for (int bj = 0; bj < 2; ++bj) {
                    const int c = u.pn * 256 + bj * 128 + wc * 32 + fq * 8;
                    const int h = c >> 7, d = c & 127;
                    const size_t kb = (size_t)(b * NH + h) * NKEY + key;
                    bf16_t* dst = (d < 64) ? K + kb * DQK + d : V + kb * DV + (d - 64);
                    const float rk = rs[ai * 128 + wr * 64 + m * 16 + fr]; *(u32x4*)dst = pack8(acc[ai][bj][m][0] * rk, acc[ai][bj][m][1] * rk);
                }
            }
    }
};

constexpr int LDS_SSQ = ge::STAGE_BYTES + 2048;
struct EpiInprojMLA {
    bf16_t* PMLAb; bf16_t* K; const float2* rope; LAS float* ssq;
    __device__ __forceinline__ void operator()(const ge::Acc& acc, const ge::Unit& u, int wr, int wc, int fr, int fq) const {
#pragma unroll
        for (int ai = 0; ai < 2; ++ai)
#pragma unroll
            for (int m = 0; m < 4; ++m) {
                const int rl = ai * 128 + wr * 64 + m * 16 + fr, r = u.pm * 256 + rl;
#pragma unroll
                for (int bj = 0; bj < 2; ++bj) {
                    const int c0 = bj * 128 + wc * 32 + fq * 8;
                    const f32x4 a = acc[ai][bj][m][0], b = acc[ai][bj][m][1];
                    const bool isval = (u.pn < 2) || (bj == 0);
                    const bool isrope = (u.pn == 2) && (bj == 1) && (wc == 0);
                    if (isval) {
                        const int col = (u.pn == 0 ? 0 : (u.pn == 1 ? 256 : 512)) + c0;
                        *(u32x4*)(PMLAb + (size_t)r * 640 + col) = pack8(a, b);
                        float sq = (a[0] * a[0] + a[1] * a[1]) + (a[2] * a[2] + a[3] * a[3]) + (b[0] * b[0] + b[1] * b[1]) + (b[2] * b[2] + b[3] * b[3]);
                        sq += shx(sq, 16); sq += shx(sq, 32);
                        if (fq == 0) ssq[rl * 16 + (u.pn == 2 ? 8 : 0) + bj * 4 + wc] = sq;
                    } else if (isrope) {
                        f32x4 pa, pb;
#pragma unroll
                        for (int j = 0; j < 4; ++j) { pa[j] = shx(a[j], 16); pb[j] = shx(b[j], 16); }
                        int bb, key; f32x4 oa = a, ob = b;
                        if (r < TL) {
                            bb = r >> 12; key = r & 4095;
                            const float2* rp = rope + (size_t)key * 16 + (fq >> 1) * 8;
#pragma unroll
                            for (int j = 0; j < 4; ++j) { const float2 ca = rp[j], cb = rp[4 + j];
                                oa[j] = (fq & 1) ? pa[j] * ca.y + a[j] * ca.x : a[j] * ca.x - pa[j] * ca.y;
                                ob[j] = (fq & 1) ? pb[j] * cb.y + b[j] * cb.x : b[j] * cb.x - pb[j] * cb.y; }
                        } else { bb = (r - TL) >> 8; key = SEQ + ((r - TL) & 255); }
                        const u32x4 w = pack8(oa, ob);
#pragma unroll
                        for (int h = 0; h < NH; ++h) *(u32x4*)(K + ((size_t)(bb * NH + h) * NKEY + key) * DQK + 64 + fq * 8) = w;
                    }
                }
            }
    }
};
struct SchedChainIn {
    const char* U; const char* WtRest; int pm, pn0, npn;
    __device__ __forceinline__ bool next(int i, ge::Unit& u) const {
        if (i >= npn) return false;
        u.pm = pm; u.pn = pn0 + i; u.kind = 1; u.rows = nullptr; u.nrows = 0;
        u.a = U + (size_t)pm * 256 * 2048; u.b0 = WtRest + (size_t)u.pn * 256 * 2048; u.b1 = u.b0 + 128 * 2048; return true;
    }
};
struct SchedPanel {
    const char* A; const char* B; size_t arb, brb; int pm, nN, kind;
    __device__ __forceinline__ bool next(int i, ge::Unit& u) const {
        if (i >= nN) return false;
        u.pm = pm; u.pn = i; u.kind = kind; u.rows = nullptr; u.nrows = 0;
        u.a = A + (size_t)pm * 256 * arb; u.b0 = B + (size_t)i * 256 * brb; u.b1 = u.b0 + 128 * brb; return true;
    }
};
struct SchedPool {
    const char* WtHy; const char* WtRest; const char* U; int first, step, n;
    __device__ __forceinline__ bool next(int i, ge::Unit& u) const {
        if (i >= n) return false;
        const int X = first + i * step; int pm, pn; u.rows = nullptr; u.nrows = 0;
        if (X < 408) { ge::tile_order(X, 6, 68, pm, pn); u.kind = 0; u.a = WtHy + (size_t)pm * 256 * 2048; u.b0 = U + (size_t)pn * 256 * 2048; }
        else { ge::tile_order(X - 408, 68, 8, pm, pn); pn += 3; u.kind = 1; u.a = U + (size_t)pm * 256 * 2048; u.b0 = WtRest + (size_t)pn * 256 * 2048; }
        u.b1 = u.b0 + 128 * 2048; u.pm = pm; u.pn = pn; return true;
    }
};
struct EpiQKV {
    EpiQ q; EpiKV kv;
    __device__ __forceinline__ void operator()(const ge::Acc& acc, const ge::Unit& u, int wr, int wc, int fr, int fq) const { if (u.kind == 0) q(acc, u, wr, wc, fr, fq); else kv(acc, u, wr, wc, fr, fq); }
};
struct SchedMerge {
    const char* Yhy; const char* Yatt; const char* Whyo; const char* Wmlao; int G, c, nM;
    __device__ __forceinline__ bool next(int i, ge::Unit& u) const {
        const int T = (i >> 1) * G + c; if (T >= nM * 4) return false;
        const int seg = i & 1; int pm, pn; ge::tile_order(T, nM, 4, pm, pn);
        u.pm = pm; u.pn = pn; u.kind = seg; u.rows = nullptr; u.nrows = 0;
        u.a = (seg ? Yatt : Yhy) + (size_t)pm * 256 * 16; u.b0 = (seg ? Wmlao : Whyo) + (size_t)pn * 256 * 1024; u.b1 = u.b0 + 128 * 1024; return true;
    }
};
struct EpiMerge {
    const bf16_t* G; bf16_t* M1;
    __device__ __forceinline__ void operator()(const ge::Acc& acc, const ge::Unit& u, int wr, int wc, int fr, int fq) const {
#pragma unroll
        for (int ai = 0; ai < 2; ++ai) {
            u32x4 gv[4][2], mv[4][2];
#pragma unroll
            for (int m = 0; m < 4; ++m) {
                const int r = u.pm * 256 + ai * 128 + wr * 64 + m * 16 + fr;
#pragma unroll
                for (int bj = 0; bj < 2; ++bj) {
                    const int c = u.pn * 256 + bj * 128 + wc * 32 + fq * 8;
                    gv[m][bj] = *(const u32x4*)(G + (size_t)r * 2048 + u.kind * DM + c);
                    if (u.kind) mv[m][bj] = *(const u32x4*)(M1 + (size_t)r * DM + c);
                }
            }
#pragma unroll
            for (int m = 0; m < 4; ++m) {
                const int r = u.pm * 256 + ai * 128 + wr * 64 + m * 16 + fr;
#pragma unroll
                for (int bj = 0; bj < 2; ++bj) {
                    const int c = u.pn * 256 + bj * 128 + wc * 32 + fq * 8;
                    f32x4 g0, g1; unpack8(gv[m][bj], g0, g1);
                    f32x4 o0 = g0 * acc[ai][bj][m][0], o1 = g1 * acc[ai][bj][m][1];
                    if (u.kind) { f32x4 q0, q1; unpack8(mv[m][bj], q0, q1); o0 += q0; o1 += q1; }
                    *(u32x4*)(M1 + (size_t)r * DM + c) = pack8(o0, o1);
                }
            }
        }
    }
};
struct EpiOut {
    float* hx; const float* mod;
    __device__ __forceinline__ void operator()(const ge::Acc& acc, const ge::Unit& u, int wr, int wc, int fr, int fq) const {
        const int b = u.pm < 64 ? (u.pm >> 4) : 4;
        f32x4 gg[2][2];
#pragma unroll
        for (int bj = 0; bj < 2; ++bj) { const float* g = mod + (size_t)b * NMOD + 2 * DM + u.pn * 256 + bj * 128 + wc * 32 + fq * 8; gg[bj][0] = *(const f32x4*)g; gg[bj][1] = *(const f32x4*)(g + 4); }
#pragma unroll
        for (int ai = 0; ai < 2; ++ai) {
            f32x4 hv[4][2][2];
#pragma unroll
            for (int m = 0; m < 4; ++m) {
                const int r = u.pm * 256 + ai * 128 + wr * 64 + m * 16 + fr;
#pragma unroll
                for (int bj = 0; bj < 2; ++bj) { const float* src = hx + (size_t)r * DM + u.pn * 256 + bj * 128 + wc * 32 + fq * 8; hv[m][bj][0] = *(const f32x4*)src; hv[m][bj][1] = *(const f32x4*)(src + 4); }
            }
#pragma unroll
            for (int m = 0; m < 4; ++m) {
                const int r = u.pm * 256 + ai * 128 + wr * 64 + m * 16 + fr;
#pragma unroll
                for (int bj = 0; bj < 2; ++bj) {
                    float* dst = hx + (size_t)r * DM + u.pn * 256 + bj * 128 + wc * 32 + fq * 8;
                    *(f32x4*)dst = hv[m][bj][0] + gg[bj][0] * acc[ai][bj][m][0];
                    *(f32x4*)(dst + 4) = hv[m][bj][1] + gg[bj][1] * acc[ai][bj][m][1];
                }
            }
        }
    }
};
struct SchedGU {
    const char* U; const char* WtG; const char* WtU; const int* list; const LAS int* tpre; const LAS int* cntl; int G, c;
    __device__ __forceinline__ bool next(int i, ge::Unit& u) const {
        const int L = i * G + c; if (L >= 2 * tpre[64]) return false;
        const int rt = L >> 1, half = L & 1; int e = 0;
#pragma unroll
        for (int st_ = 32; st_ > 0; st_ >>= 1) { if (tpre[e + st_] <= rt) e += st_; }
        u.kind = e; u.pm = rt - tpre[e]; u.pn = half; u.rows = list + (size_t)e * CAP; u.nrows = cntl[e];
        u.a = U; u.b0 = WtG + ((size_t)e * DE + half * 128) * 2048; u.b1 = WtU + ((size_t)e * DE + half * 128) * 2048; return true;
    }
};
struct EpiGU {
    bf16_t* H; const LAS int* offs;
    __device__ __forceinline__ void operator()(const ge::Acc& acc, const ge::Unit& u, int wr, int wc, int fr, int fq) const {
        const int o = offs[u.kind];
#pragma unroll
        for (int ai = 0; ai < 2; ++ai)
#pragma unroll
            for (int m = 0; m < 4; ++m) {
                const int r = u.pm * 256 + ai * 128 + wr * 64 + m * 16 + fr;
                if (r < u.nrows) {
                    const int c = u.pn * 128 + wc * 32 + fq * 8;
                    f32x4 g0 = acc[ai][0][m][0], g1 = acc[ai][0][m][1];
#pragma unroll
                    for (int j = 0; j < 4; ++j) { g0[j] = g0[j] * sigmoidf_fast(g0[j]) * acc[ai][1][m][0][j]; g1[j] = g1[j] * sigmoidf_fast(g1[j]) * acc[ai][1][m][1][j]; }
                    *(u32x4*)(H + (size_t)(o + r) * DE + c) = pack8(g0, g1);
                }
            }
    }
};
struct SchedDown {
    const char* H; const char* WtD; const LAS int* tpre; const LAS int* cntl; const LAS int* offs; int G, c;
    __device__ __forceinline__ bool next(int i, ge::Unit& u) const {
        const int L = i * G + c; if (L >= 4 * tpre[64]) return false;
        const int rt = L >> 2, pn = L & 3; int e = 0;
#pragma unroll
        for (int st_ = 32; st_ > 0; st_ >>= 1) { if (tpre[e + st_] <= rt) e += st_; }
        u.kind = e; u.pm = rt - tpre[e]; u.pn = pn; u.rows = nullptr; u.nrows = cntl[e];
        u.a = H + ((size_t)offs[e] + (size_t)u.pm * 256) * 512; u.b0 = WtD + ((size_t)e * DM + pn * 256) * 512; u.b1 = u.b0 + 128 * 512; return true;
    }
};
struct EpiDown {
    bf16_t* Y; const float* wl; const LAS int* offs;
    __device__ __forceinline__ void operator()(const ge::Acc& acc, const ge::Unit& u, int wr, int wc, int fr, int fq) const {
        const int o = offs[u.kind];
        float w[2][4];
#pragma unroll
        for (int ai = 0; ai < 2; ++ai)
#pragma unroll
            for (int m = 0; m < 4; ++m) { const int r = u.pm * 256 + ai * 128 + wr * 64 + m * 16 + fr; w[ai][m] = wl[(size_t)u.kind * CAP + (r < u.nrows ? r : 0)]; }
#pragma unroll
        for (int ai = 0; ai < 2; ++ai)
#pragma unroll
            for (int m = 0; m < 4; ++m) {
                const int r = u.pm * 256 + ai * 128 + wr * 64 + m * 16 + fr;
                if (r < u.nrows) {
#pragma unroll
                    for (int bj = 0; bj < 2; ++bj) {
                        const int c = u.pn * 256 + bj * 128 + wc * 32 + fq * 8;
                        *(u32x4*)(Y + (size_t)(o + r) * DM + c) = pack8(acc[ai][bj][m][0] * w[ai][m], acc[ai][bj][m][1] * w[ai][m]);
                    }
                }
            }
    }
};


typedef short s16x4 __attribute__((ext_vector_type(4)));
#define AT_THR 8.0f
__device__ __forceinline__ void ph_attn2(const P& p, char* smem, bool with_ctx) {
    constexpr int KS = 112, VS = 80;
    constexpr int NSTG = NKEY / 128;
    bf16_t* sK = (bf16_t*)smem;
    bf16_t* sV = sK + 3 * 128 * KS;
    const int tid = tid_opaque(), lane = tid & 63, wv = tid >> 6, fr = lane & 15, g = lane >> 4;
    const int NUL = NB * NH * 16, NUC = with_ctx ? NB * NH : 0;
    const int kc0 = tid / 12, kp0 = tid % 12, kc1 = (512 + tid) / 12, kp1 = (512 + tid) % 12;
    const int vk = tid >> 3, vp = tid & 7;
#define AT_LOADK(st_, hs_) do { const bf16_t* kb_ = Kp + (size_t)((st_) * 128 + (hs_) * 64) * DQK; kr0 = *(const u32x4*)(kb_ + kc0 * DQK + kp0 * 8); if (tid < 256) kr1 = *(const u32x4*)(kb_ + kc1 * DQK + kp1 * 8); } while (0)
#define AT_LOADV(st_, hs_) do { vr0 = *(const u32x4*)(Vp + (size_t)((st_) * 128 + (hs_) * 64) * DV + vk * DV + vp * 8); } while (0)
#define AT_STOREK(buf_, hs_) do { bf16_t* d_ = sK + ((buf_) * 128 + (hs_) * 64) * KS; *(u32x4*)(d_ + kc0 * KS + kp0 * 8) = kr0; if (tid < 256) *(u32x4*)(d_ + kc1 * KS + kp1 * 8) = kr1; } while (0)
#define AT_STOREV(buf_, hs_) do { *(u32x4*)(sV + ((buf_) * 128 + (hs_) * 64) * VS + vk * VS + vp * 8) = vr0; } while (0)
#define AT_LDKF(dst, mk) do { _Pragma("unroll") for (int ks = 0; ks < 3; ++ks) dst[ks] = *(const bf16x8*)(sKn + (mk) * 16 * KS + ks * 32); } while (0)
#define AT_MMAS(src, mk) do { sN[mk][0] = (f32x4){0.f, 0.f, 0.f, 0.f}; sN[mk][1] = (f32x4){0.f, 0.f, 0.f, 0.f}; \
        _Pragma("unroll") for (int ks = 0; ks < 3; ++ks) _Pragma("unroll") for (int nq = 0; nq < 2; ++nq) { const bf16x8 bq_ = (ks < 2) ? qf[nq][ks] : (ctxn ? qf[nq][3] : qf[nq][2]); \
            sN[mk][nq] = __builtin_amdgcn_mfma_f32_16x16x32_bf16(src[ks], bq_, sN[mk][nq], 0, 0, 0); } } while (0)
#define AT_EXPS(nq) do { float r_ = (nq) ? rs[0] - rs[0] : 0.f; _Pragma("unroll") for (int mk = 0; mk < 4; ++mk) _Pragma("unroll") for (int r = 0; r < 4; ++r) { const float pv = __builtin_amdgcn_exp2f(sC[mk][nq][r] - mn[nq]); r_ += pv; sC[mk][nq][r] = pv; } rs[nq] = r_; } while (0)
#define AT_SUBTILE(sKn_, ctxn_, sVb_) do { \
        const bf16_t* sKn = (sKn_) + fr * KS + g * 8; const bool ctxn = (ctxn_); \
        bf16x8 kfA[3], kfB[3]; bf16x8 pf[2][2]; float mn[2], mxq[2], rs[2]; \
        AT_LDKF(kfA, 0); \
        AT_MMAS(kfA, 0); AT_LDKF(kfB, 1); \
        _Pragma("unroll") for (int nq = 0; nq < 2; ++nq) { float mx = sC[0][nq][0]; \
            _Pragma("unroll") for (int mk = 0; mk < 4; ++mk) _Pragma("unroll") for (int r = 0; r < 4; ++r) mx = fmaxf(mx, sC[mk][nq][r]); \
            mxq[nq] = rowmax4(mx); } \
          \
          \
        if (__any((mxq[0] - m[0] > AT_THR) || (mxq[1] - m[1] > AT_THR))) { \
            _Pragma("unroll") for (int nq = 0; nq < 2; ++nq) { const float mnew_ = fmaxf(m[nq], mxq[nq]); const float a_ = __builtin_amdgcn_exp2f(m[nq] - mnew_); m[nq] = mnew_; lsum[nq] *= a_; \
                _Pragma("unroll") for (int md = 0; md < 4; ++md) oT[md][nq] *= a_; } } \
        mn[0] = m[0]; mn[1] = m[1]; \
        __builtin_amdgcn_sched_barrier(0); \
        AT_MMAS(kfB, 1); AT_LDKF(kfA, 2); AT_EXPS(0); \
        __builtin_amdgcn_sched_barrier(0); \
        AT_MMAS(kfA, 2); AT_LDKF(kfB, 3); AT_EXPS(1); \
        __builtin_amdgcn_sched_barrier(0); \
        AT_MMAS(kfB, 3); \
        _Pragma("unroll") for (int nq = 0; nq < 2; ++nq) { lsum[nq] += rs[nq]; \
            _Pragma("unroll") for (int kp = 0; kp < 2; ++kp) { const u32x4 w_ = pack8(sC[2 * kp][nq], sC[2 * kp + 1][nq]); pf[kp][nq] = __builtin_bit_cast(bf16x8, w_); } } \
        __builtin_amdgcn_sched_barrier(0); \
        _Pragma("unroll") for (int kp = 0; kp < 2; ++kp) _Pragma("unroll") for (int md = 0; md < 4; ++md) { \
            const bf16_t* a0_ = (sVb_) + (32 * kp + 4 * g + (fr >> 2)) * VS + 16 * md + 4 * (fr & 3); \
            const s16x4 lo_ = __builtin_amdgcn_ds_read_tr16_b64_v4i16((LAS s16x4*)a0_); \
            const s16x4 hi_ = __builtin_amdgcn_ds_read_tr16_b64_v4i16((LAS s16x4*)(a0_ + 16 * VS)); \
            const bf16x8 vf_ = __builtin_shufflevector(lo_, hi_, 0, 1, 2, 3, 4, 5, 6, 7); \
            _Pragma("unroll") for (int nq = 0; nq < 2; ++nq) oT[md][nq] = __builtin_amdgcn_mfma_f32_16x16x32_bf16(vf_, pf[kp][nq], oT[md][nq], 0, 0, 0); } \
        _Pragma("unroll") for (int mk = 0; mk < 4; ++mk) { sC[mk][0] = sN[mk][0]; sC[mk][1] = sN[mk][1]; } \
    } while (0)
    for (int u = blockIdx.x; u < NUL + NUC; u += gridDim.x) {
        const bool isctx = u >= NUL;
        int b, h, q0;
        if (!isctx) {
            int bh, qb;
            if (gridDim.x == 256) { const int c = u & 255, r = u >> 8, x = c & 7, sl = c >> 3; bh = r * 16 + x * 2 + (sl >> 4); qb = sl & 15; } else { bh = u / 16; qb = u % 16; }
            b = bh / NH; h = bh % NH; q0 = qb * 256;
        } else { const int v = u - NUL; b = v / NH; h = v % NH; q0 = 0; }
        const bf16_t* Qp = (isctx ? p.Qc + ((size_t)(b * NH + h) * CTXL + q0) * 128 : p.Q + ((size_t)(b * NH + h) * SEQ + q0) * 128) + (size_t)(wv * 32) * 128;
        bf16x8 qf[2][4];
#pragma unroll
        for (int nq = 0; nq < 2; ++nq)
#pragma unroll
            for (int ks = 0; ks < 4; ++ks) qf[nq][ks] = *(const bf16x8*)(Qp + (size_t)(nq * 16 + fr) * 128 + ks * 32 + g * 8);
        const bf16_t* Kp = p.K + (size_t)(b * NH + h) * NKEY * DQK;
        const bf16_t* Vp = p.V + (size_t)(b * NH + h) * NKEY * DV;
        f32x4 oT[4][2]; float m[2], lsum[2];
#pragma unroll
        for (int nq = 0; nq < 2; ++nq) { m[nq] = -INFINITY; lsum[nq] = 0.f;
#pragma unroll
            for (int md = 0; md < 4; ++md) oT[md][nq] = (f32x4){0.f, 0.f, 0.f, 0.f}; }
        const int st0 = isctx ? 32 : 0;
        u32x4 kr0, kr1 = (u32x4){0u, 0u, 0u, 0u}, vr0;
        f32x4 sC[4][2], sN[4][2];
        __syncthreads();
        AT_LOADK(st0, 0); AT_LOADV(st0, 0); AT_STOREK(0, 0); AT_STOREV(0, 0);
        AT_LOADK(st0, 1); AT_LOADV(st0, 1); AT_STOREK(0, 1); AT_STOREV(0, 1);
        AT_LOADK(st0 + 1, 0); AT_STOREK(1, 0);
        AT_LOADK(st0 + 1, 1);
        __syncthreads();
        {
            const bf16_t* sKn = sK + fr * KS + g * 8; const bool ctxn = st0 >= 32;
            bf16x8 kfA[3];
#pragma unroll
            for (int mk = 0; mk < 4; ++mk) { AT_LDKF(kfA, mk); AT_MMAS(kfA, mk); }
#pragma unroll
            for (int mk = 0; mk < 4; ++mk) { sC[mk][0] = sN[mk][0]; sC[mk][1] = sN[mk][1]; }
        }
        AT_STOREK(1, 1);
        __syncthreads();
        int kb = 0;
        for (int st = st0; st < NSTG; ++st) {
            const int bufc = (st - st0) & 1;
            const int st1 = st + 1 < NSTG ? st + 1 : NSTG - 1, st2 = st + 2 < NSTG ? st + 2 : NSTG - 1;
            const int kb1 = kb == 2 ? 0 : kb + 1, kb2 = kb1 == 2 ? 0 : kb1 + 1;
            const bf16_t* sKc = sK + kb * 128 * KS; const bf16_t* sKx = sK + kb1 * 128 * KS; const bf16_t* sVc = sV + bufc * 128 * VS;
            AT_LOADK(st2, 0); AT_LOADV(st1, 0);
            AT_SUBTILE(sKc + 64 * KS, st >= 32, sVc);
            AT_STOREK(kb2, 0); AT_STOREV(bufc ^ 1, 0);
            AT_LOADK(st2, 1); AT_LOADV(st1, 1);
            AT_SUBTILE(sKx, st1 >= 32, sVc + 64 * VS);
            AT_STOREK(kb2, 1); AT_STOREV(bufc ^ 1, 1);
            __syncthreads();
            kb = kb1;
        }
        const size_t rbase = (isctx ? (size_t)TL + b * CTXL : (size_t)b * SEQ) + q0 + wv * 32;
#pragma unroll
        for (int nq = 0; nq < 2; ++nq) {
            const float l = rowsum4(lsum[nq]);
            const float inv = 1.0f / l;
#pragma unroll
            for (int md = 0; md < 4; ++md) {
                u32x2 o; o.x = cvt_pk_bf16(oT[md][nq][0] * inv, oT[md][nq][1] * inv); o.y = cvt_pk_bf16(oT[md][nq][2] * inv, oT[md][nq][3] * inv);
                *(u32x2*)(p.Yatt + ((size_t)(h * 8 + md * 2 + (g >> 1)) * TT + rbase + nq * 16 + fr) * 8 + 4 * (g & 1)) = o;
            }
        }
    }
#undef AT_LOADK
#undef AT_LOADV
#undef AT_STOREK
#undef AT_STOREV
#undef AT_LDKF
#undef AT_MMAS
#undef AT_EXPS
#undef AT_SUBTILE
}

constexpr int RT_PITCH = 1024 + 8;
__device__ __forceinline__ void ph_norm2_router(const P& p, int l, char* smem, int nrows_total) {
    bf16_t* thi = (bf16_t*)smem;
    bf16_t* tlo = thi + 16 * RT_PITCH;
    float* part = (float*)(tlo + 16 * RT_PITCH);
    float* lgs = part + 8 * 16 * 80;
    const int tid = tid_opaque(), lane = tid & 63, wv = tid >> 6, fr = lane & 15, g = lane >> 4;
    const float* ng = p.norm2_g + l * DM;
    const bf16_t* whi = p.WrT + (size_t)(l * 2 + 0) * 80 * DM; const bf16_t* wlo = p.WrT + (size_t)(l * 2 + 1) * 80 * DM;
    bf16x8 bh[4][5];
#pragma unroll
    for (int ks = 0; ks < 4; ++ks)
#pragma unroll
        for (int nt = 0; nt < 5; ++nt) { const size_t o = (size_t)(nt * 16 + fr) * DM + wv * 128 + ks * 32 + g * 8; bh[ks][nt] = *(const bf16x8*)(whi + o); }
    float* bias_s = lgs + 16 * 80;
    float* recs = bias_s + 80;
    int nrec = 0;
    if (tid < 72) bias_s[tid] = tid < 64 ? p.b_re[l * NE + tid] : p.b_rg[l * 8 + tid - 64];
    for (int rb = blockIdx.x * 16; rb < nrows_total; rb += gridDim.x * 16) {
        __syncthreads();
        {
            const int lr0 = wv * 2, row0 = rb + lr0;
            const int b = row0 < TL ? (row0 >> 12) : 4;
            const float* hp = p.hx + (size_t)row0 * DM;
            const float* md = p.mod + ((size_t)l * 5 + b) * NMOD + 3 * DM;
            float4 xv[2][4], gg4[4], sh4[4], sc4[4];
#pragma unroll
            for (int i = 0; i < 4; ++i) { const int j = i * 256 + lane * 4; xv[0][i] = *(const float4*)(hp + j); xv[1][i] = *(const float4*)(hp + DM + j); gg4[i] = *(const float4*)(ng + j); sh4[i] = *(const float4*)(md + j); sc4[i] = *(const float4*)(md + DM + j); }
            float ss0 = 0.f, ss1 = 0.f;
#pragma unroll
            for (int i = 0; i < 4; ++i) { ss0 += xv[0][i].x * xv[0][i].x + xv[0][i].y * xv[0][i].y + xv[0][i].z * xv[0][i].z + xv[0][i].w * xv[0][i].w;
                                          ss1 += xv[1][i].x * xv[1][i].x + xv[1][i].y * xv[1][i].y + xv[1][i].z * xv[1][i].z + xv[1][i].w * xv[1][i].w; }
#pragma unroll
            for (int o = 32; o > 0; o >>= 1) { ss0 += shx(ss0, o); ss1 += shx(ss1, o); }
            const float rs2[2] = {rsqrtf(ss0 * (1.0f / DM) + epsf()), rsqrtf(ss1 * (1.0f / DM) + epsf())};
#pragma unroll
            for (int i = 0; i < 4; ++i) {
                const int j = i * 256 + lane * 4;
                const float4 gg = gg4[i], sh = sh4[i], sc = sc4[i];
#pragma unroll
                for (int rr = 0; rr < 2; ++rr) {
                    const int lr = lr0 + rr; const float rs = rs2[rr];
                    float y[4];
                    y[0] = (xv[rr][i].x * rs * gg.x) * (1.f + sc.x) + sh.x; y[1] = (xv[rr][i].y * rs * gg.y) * (1.f + sc.y) + sh.y;
                    y[2] = (xv[rr][i].z * rs * gg.z) * (1.f + sc.z) + sh.z; y[3] = (xv[rr][i].w * rs * gg.w) * (1.f + sc.w) + sh.w;
                    bf16_t h[4], lo[4];
#pragma unroll
                    for (int e = 0; e < 4; ++e) { h[e] = f2bf(y[e]); lo[e] = f2bf(y[e] - bf2f(h[e])); }
                    u32x2 oh; oh.x = (unsigned)h[0] | ((unsigned)h[1] << 16); oh.y = (unsigned)h[2] | ((unsigned)h[3] << 16);
                    u32x2 ol; ol.x = (unsigned)lo[0] | ((unsigned)lo[1] << 16); ol.y = (unsigned)lo[2] | ((unsigned)lo[3] << 16);
                    *(u32x2*)(p.U + (size_t)(row0 + rr) * DM + j) = oh;
                    *(u32x2*)(thi + lr * RT_PITCH + j) = oh; *(u32x2*)(tlo + lr * RT_PITCH + j) = ol;
                }
            }
        }
        __syncthreads();
        f32x4 acc[5];
#pragma unroll
        for (int nt = 0; nt < 5; ++nt) acc[nt] = (f32x4){0.f, 0.f, 0.f, 0.f};
#pragma unroll
        for (int ks = 0; ks < 4; ++ks) {
            const int k0 = wv * 128 + ks * 32 + g * 8;
            const bf16x8 ah = *(const bf16x8*)(thi + fr * RT_PITCH + k0), al = *(const bf16x8*)(tlo + fr * RT_PITCH + k0);
#pragma unroll
            for (int nt = 0; nt < 5; ++nt) {
                const bf16x8 blf = *(const bf16x8*)(wlo + (size_t)(nt * 16 + fr) * DM + k0);
                acc[nt] = __builtin_amdgcn_mfma_f32_16x16x32_bf16(ah, bh[ks][nt], acc[nt], 0, 0, 0);
                acc[nt] = __builtin_amdgcn_mfma_f32_16x16x32_bf16(al, bh[ks][nt], acc[nt], 0, 0, 0);
                acc[nt] = __builtin_amdgcn_mfma_f32_16x16x32_bf16(ah, blf, acc[nt], 0, 0, 0);
            }
        }
#pragma unroll
        for (int nt = 0; nt < 5; ++nt)
#pragma unroll
            for (int r = 0; r < 4; ++r) part[(wv * 16 + g * 4 + r) * 80 + nt * 16 + fr] = acc[nt][r];
        __syncthreads();
        for (int i = tid; i < 16 * 80; i += NT) { float a = 0.f;
#pragma unroll
            for (int w = 0; w < 8; ++w) a += part[w * 16 * 80 + i];
            lgs[i] = a; }
        __syncthreads();
        if (tid < 128) {
            const int lrw = tid >> 3, i = tid & 7, row = rb + lrw;
            const float* le = lgs + lrw * 80; const float* lg = le + 64;
            const float* bre = bias_s; const float* brg = bias_s + 64;
            const float lgi = lg[i];
            float bv = lgi + brg[i]; int bi = i; float mx = lgi;
#pragma unroll
            for (int o = 1; o < 8; o <<= 1) { const float ov = shx(bv, o); const int oi = shx(bi, o); if (ov > bv || (ov == bv && oi < bi)) { bv = ov; bi = oi; } mx = fmaxf(mx, shx(mx, o)); }
            const int gs = bi;
            float den = __expf(lgi - mx);
#pragma unroll
            for (int o = 1; o < 8; o <<= 1) den += shx(den, o);
            const float pg = __expf(lg[gs] - mx) / den;
            const float lei = le[gs * 8 + i];
            float k0v = lei + bre[gs * 8 + i]; int k0i = i;
            const float keyi = k0v;
#pragma unroll
            for (int o = 1; o < 8; o <<= 1) { const float ov = shx(k0v, o); const int oi = shx(k0i, o); if (ov > k0v || (ov == k0v && oi < k0i)) { k0v = ov; k0i = oi; } }
            const int i0 = k0i;
            float k1v = (i == i0) ? -INFINITY : keyi; int k1i = (i == i0) ? 8 : i;
#pragma unroll
            for (int o = 1; o < 8; o <<= 1) { const float ov = shx(k1v, o); const int oi = shx(k1i, o); if (ov > k1v || (ov == k1v && oi < k1i)) { k1v = ov; k1i = oi; } }
            const int i1 = k1i;
            if (i == 0) {
                const float w0 = 1.0f / (1.0f + __expf(le[gs * 8 + i1] - le[gs * 8 + i0])), w1 = 1.0f - w0;
                float* rc = recs + (nrec * 16 + lrw) * 4;
                rc[0] = __int_as_float((gs * 8 + i0) | ((gs * 8 + i1) << 8)); rc[1] = pg * w0; rc[2] = pg * w1; rc[3] = __int_as_float(row);
            }
        }
        ++nrec;
    }
    __syncthreads();
    for (int q = tid; q < nrec * 16; q += NT) {
        const float* rc = recs + q * 4;
        const int ee = __float_as_int(rc[0]), e0 = ee & 255, e1 = ee >> 8, row = __float_as_int(rc[3]);
        const int r0 = atomicAdd(p.cnt + (l * NE + e0) * 64, 1), r1 = atomicAdd(p.cnt + (l * NE + e1) * 64, 1);
        p.list[(size_t)e0 * CAP + r0] = row; p.wl[(size_t)e0 * CAP + r0] = rc[1];
        p.list[(size_t)e1 * CAP + r1] = row; p.wl[(size_t)e1 * CAP + r1] = rc[2];
        *(int4*)(p.asg + (size_t)row * 4) = make_int4(e0, r0, e1, r1);
    }
    __syncthreads();
}

typedef float v2f __attribute__((ext_vector_type(2)));
#define HD __device__ __forceinline__
HD v2f vfma(v2f a, v2f b, v2f c) { return __builtin_elementwise_fma(a, b, c); }
HD v2f twk(v2f w) { return w.yy * (v2f){-1.f, 1.f}; }
HD v2f cmulk(v2f a, v2f w, v2f wk) { return vfma(a.yx, wk, a * w.xx); }
HD v2f cmulck(v2f a, v2f w, v2f wk) { return vfma(a.yx, -wk, a * w.xx); }
HD v2f cmul(v2f a, v2f w) { return cmulk(a, w, twk(w)); }
HD v2f cmulc(v2f a, v2f w) { return cmulck(a, w, twk(w)); }
HD int fphys(int i) { return (i >> 8) * 272 + ((i >> 4) & 15) * 17 + (i & 15); }
constexpr int FBUF = 4352;
template <bool INV> HD void dft4(v2f& x0, v2f& x1, v2f& x2, v2f& x3) {
    const v2f s02 = x0 + x2, d02 = x0 - x2, s13 = x1 + x3, d13 = x1 - x3;
    const v2f kj = INV ? (v2f){-1.f, 1.f} : (v2f){1.f, -1.f};
    x0 = s02 + s13; x2 = s02 - s13; x1 = vfma(d13.yx, kj, d02); x3 = vfma(d13.yx, -kj, d02);
}
template <bool INV> HD void dft16(v2f (&v)[16]) {
#pragma unroll
    for (int b = 0; b < 4; ++b) dft4<INV>(v[b], v[4 + b], v[8 + b], v[12 + b]);
    float C1 = 0.92387953251128674f, S1 = 0.38268343236508977f, C2 = 0.70710678118654752f;
    asm volatile("" : "+v"(C1), "+v"(S1), "+v"(C2));
#define TW(idx, cr, ci) v[idx] = vfma(v[idx].yx, INV ? (v2f){(ci), -(ci)} : (v2f){-(ci), (ci)}, v[idx] * (v2f){(cr), (cr)})
    TW(4 * 1 + 1, C1, -S1);
    TW(4 * 1 + 2, C2, -C2);
    TW(4 * 1 + 3, S1, -C1);
    TW(4 * 2 + 1, C2, -C2);
    v[4 * 2 + 2] = v[4 * 2 + 2].yx * (INV ? (v2f){-1.f, 1.f} : (v2f){1.f, -1.f});
    TW(4 * 2 + 3, -C2, -C2);
    TW(4 * 3 + 1, S1, -C1);
    TW(4 * 3 + 2, -C2, -C2);
    TW(4 * 3 + 3, -C1, S1);
#undef TW
#pragma unroll
    for (int c = 0; c < 4; ++c) dft4<INV>(v[4 * c], v[4 * c + 1], v[4 * c + 2], v[4 * c + 3]);
#define SW(i, j) { const v2f t_ = v[i]; v[i] = v[j]; v[j] = t_; }
    SW(1, 4) SW(2, 8) SW(3, 12) SW(6, 9) SW(7, 13) SW(11, 14)
#undef SW
}
template <class BUF, class TW> HD void fwd_pass0(int u, v2f (&v)[16], BUF buf, TW W) {
    dft16<false>(v);
    const v2f w1 = W[u], w1k = twk(w1); v2f wr = w1;
    const int pb = fphys(u);
    buf[pb] = v[0];
#pragma unroll
    for (int r = 1; r < 16; ++r) { v[r] = cmul(v[r], wr); buf[pb + 272 * r] = v[r]; wr = cmulk(wr, w1, w1k); }
}
template <class BUF, class TW> HD void fwd_pass1(int u, v2f (&v)[16], BUF buf, TW W) {
    const int j = u & 15, pb = (u >> 4) * 272 + j;
#pragma unroll
    for (int q = 0; q < 16; ++q) v[q] = buf[pb + 17 * q];
    dft16<false>(v);
    const v2f w1 = W[16 * j], w1k = twk(w1); v2f wr = w1;
    buf[pb] = v[0];
#pragma unroll
    for (int r = 1; r < 16; ++r) { v[r] = cmul(v[r], wr); buf[pb + 17 * r] = v[r]; wr = cmulk(wr, w1, w1k); }
}
template <class BUF> HD void fwd_pass2(int u, v2f (&v)[16], BUF buf) {
    const int pb = (u >> 4) * 272 + (u & 15) * 17;
#pragma unroll
    for (int q = 0; q < 16; ++q) v[q] = buf[pb + q];
    dft16<false>(v);
}
template <class BUF> HD void inv_passA(int u, v2f (&v)[16], BUF buf) {
    dft16<true>(v);
    const int pb = (u >> 4) * 272 + (u & 15) * 17;
#pragma unroll
    for (int r = 0; r < 16; ++r) buf[pb + r] = v[r];
}
template <class BUF, class TW> HD void inv_passB(int u, v2f (&v)[16], BUF buf, TW W) {
    const int j = u & 15, pb = (u >> 4) * 272 + j;
    const v2f w1 = W[16 * j], w1k = twk(w1); v2f wr = w1;
    v[0] = buf[pb];
#pragma unroll
    for (int q = 1; q < 16; ++q) { v[q] = cmulc(buf[pb + 17 * q], wr); wr = cmulk(wr, w1, w1k); }
    dft16<true>(v);
#pragma unroll
    for (int r = 0; r < 16; ++r) buf[pb + 17 * r] = v[r];
}
template <class BUF, class TW> HD void inv_passC(int u, v2f (&v)[16], BUF buf, TW W) {
    const v2f w1 = W[u], w1k = twk(w1); v2f wr = w1;
    const int pb = fphys(u);
    v[0] = buf[pb];
#pragma unroll
    for (int q = 1; q < 16; ++q) { v[q] = cmulc(buf[pb + 272 * q], wr); wr = cmulk(wr, w1, w1k); }
    dft16<true>(v);
}
HD int digitrev(int i) { return ((i & 15) << 8) | (i & 0xF0) | (i >> 8); }

#undef HD
constexpr int FFT_LDS_W = 2 * FBUF * 8;
constexpr int FFT_LDS_STG = FFT_LDS_W + 4096 * 8;
constexpr int STG_ROW = SEQ + 16;
constexpr int FFT_LDS_W2 = FFT_LDS_STG + 2 * STG_ROW * 2;
constexpr int FFT_LDS_END = FFT_LDS_W2 + 4096 * 8;
__device__ __forceinline__ void fft_load_w(const P& p, char* smem) {
    float2* Wl = (float2*)(smem + FFT_LDS_W); float2* W2l = (float2*)(smem + FFT_LDS_W2);
    __syncthreads();
    { const int t_ = tid_opaque();
      float4 a_[4], b_[4];
#pragma unroll
      for (int k = 0; k < 4; ++k) { a_[k] = ((const float4*)p.Wtab)[t_ + NT * k]; b_[k] = ((const float4*)p.W2tab)[t_ + NT * k]; }
#pragma unroll
      for (int k = 0; k < 4; ++k) { ((float4*)Wl)[t_ + NT * k] = a_[k]; ((float4*)W2l)[t_ + NT * k] = b_[k]; } }
    __syncthreads();
}
__device__ __forceinline__ void ph_tables(const P& p) {
    for (int i = blockIdx.x * NT + tid_opaque(); i < 8192; i += gridDim.x * NT) {
        float sn, cs;
        if (i < 4096) { sincospif((float)i * (1.0f / 2048.0f), &sn, &cs); p.Wtab[i] = make_float2(cs, -sn); }
        else { sincospif((float)(i - 4096) * (1.0f / 4096.0f), &sn, &cs); p.W2tab[i - 4096] = make_float2(cs, -sn); }
    }
    for (int i = blockIdx.x * NT + tid_opaque(); i < DEPTH * 80 * DM; i += gridDim.x * NT) {
        const int l = i / (80 * DM), n = (i / DM) % 80, kk = i % DM;
        const float v = n < 64 ? p.w_re[((size_t)l * DM + kk) * NE + n] : (n < 72 ? p.w_rg[((size_t)l * DM + kk) * 8 + (n - 64)] : 0.f);
        const bf16_t h = f2bf(v);
        p.WrT[((size_t)(l * 2 + 0) * 80 + n) * DM + kk] = h; p.WrT[((size_t)(l * 2 + 1) * 80 + n) * DM + kk] = f2bf(v - bf2f(h));
    }
}
__device__ __forceinline__ void ph_spectra(const P& p, char* smem) {
    v2f* bufE = (v2f*)smem; v2f* bufO = bufE + FBUF; const v2f* Wl = (const v2f*)(smem + FFT_LDS_W); const v2f* W2l = (const v2f*)(smem + FFT_LDS_W2);
    const int tid = tid_opaque(), half = tid >> 8, u = tid & 255;
    v2f* buf = half ? bufO : bufE;
    fft_load_w(p, smem);
    for (int un = blockIdx.x; un < DEPTH * HYW; un += gridDim.x) {
        const int l = un / HYW, c = un % HYW;
        const float* hf0 = p.HT0 + ((size_t)l * 2048 + c) * SEQ;        const float s_f0 = p.SCL0[l * 2048 + c];
        const float* hb0 = p.HT0 + ((size_t)l * 2048 + 512 + c) * SEQ;  const float s_b0 = p.SCL0[l * 2048 + 512 + c];
        const float* hf1 = p.HT0 + ((size_t)l * 2048 + 1024 + c) * SEQ; const float s_f1 = p.SCL0[l * 2048 + 1024 + c];
        const float* hb1 = p.HT0 + ((size_t)l * 2048 + 1536 + c) * SEQ; const float s_b1 = p.SCL0[l * 2048 + 1536 + c];
        v2f v[16];
#pragma unroll
        for (int q = 0; q < 16; ++q) {
            const int j = 2 * (u + 256 * q) + half;
            float a, b;
            if (j < SEQ) { a = hf0[j] * s_f0; b = hf1[j] * s_f1; } else if (j == SEQ) { a = 0.f; b = 0.f; } else { a = hb0[2 * SEQ - j] * s_b0; b = hb1[2 * SEQ - j] * s_b1; }
            if (j == 0) { a += p.flt_bias[(l * 2 + 0) * HYW + c]; b += p.flt_bias[(l * 2 + 1) * HYW + c]; }
            v[q] = (v2f){a, b};
        }
        __syncthreads();
        fwd_pass0(u, v, buf, Wl); __syncthreads();
        fwd_pass1(u, v, buf, Wl); __syncthreads();
        fwd_pass2(u, v, buf);
#pragma unroll
        for (int r = 0; r < 16; ++r) buf[fphys(16 * u + r)] = v[r];
        __syncthreads();
        v2f* out = (v2f*)p.Hs + (size_t)(l * HYW + c) * 4 * 4096;
        for (int idx = tid; idx < 8192; idx += NT) {
            const int par = idx >> 12, pi = idx & 4095, kp = 2 * digitrev(pi) + par, kpp = (8192 - kp) & 8191;
            const int k1 = kp & 4095, k2 = kpp & 4095;
            v2f t1 = cmul(W2l[k1], bufO[fphys(digitrev(k1))]); if (kp >= 4096) t1 = -t1;
            v2f t2 = cmul(W2l[k2], bufO[fphys(digitrev(k2))]); if (kpp >= 4096) t2 = -t2;
            const v2f F = bufE[fphys(digitrev(k1))] + t1, Gq = bufE[fphys(digitrev(k2))] + t2;
            const float sc = 0.5f / 8192.0f;
            out[(0 * 2 + par) * 4096 + pi] = (v2f){(F.x + Gq.x) * sc, (F.y - Gq.y) * sc};
            out[(1 * 2 + par) * 4096 + pi] = (v2f){(F.y + Gq.y) * sc, -(F.x - Gq.x) * sc};
        }
    }
    __syncthreads();
}
__device__ __forceinline__ void fft_conv(int half, int u, v2f (&v)[16], const v2f* W2g, const v2f* Hso, v2f* buf, const v2f* Wl) {
    float4 hreg[8];
    const float4* hp = (const float4*)(Hso + (size_t)half * 4096 + 16 * u);
#pragma unroll
    for (int r2 = 0; r2 < 8; ++r2) hreg[r2] = hp[r2];
    if (half) {
#pragma unroll
        for (int q = 0; q < 16; ++q) v[q] = cmul(v[q], W2g[u + 256 * q]);
    }
    fwd_pass0(u, v, buf, Wl); __syncthreads();
    fwd_pass1(u, v, buf, Wl); __syncthreads();
    fwd_pass2(u, v, buf);
#pragma unroll
    for (int r2 = 0; r2 < 8; ++r2) { const float4 h = hreg[r2]; v[2 * r2] = cmul(v[2 * r2], (v2f){h.x, h.y}); v[2 * r2 + 1] = cmul(v[2 * r2 + 1], (v2f){h.z, h.w}); }
    inv_passA(u, v, buf); __syncthreads();
    inv_passB(u, v, buf, Wl); __syncthreads();
    inv_passC(u, v, buf, Wl);
    if (half) {
#pragma unroll
        for (int r = 0; r < 16; ++r) v[r] = cmulc(v[r], W2g[u + 256 * r]);
    }
}

__device__ __forceinline__ void ph_hyena_fft(const P& p, int l, char* smem) {
    v2f* buf0 = (v2f*)smem; v2f* buf1 = buf0 + FBUF; const v2f* Wl = (const v2f*)(smem + FFT_LDS_W);
    bf16_t* stg = (bf16_t*)(smem + FFT_LDS_STG) + 8;
    const v2f* W2l = (const v2f*)(smem + FFT_LDS_W2);
    const int tid = tid_opaque(), half = tid >> 8, u = tid & 255;
    v2f* buf = half ? buf1 : buf0;
    const int pu = fphys(u);
    if (tid < 32) { const int rw = tid >> 4, k = tid & 15; (stg - 8 + rw * STG_ROW)[k < 8 ? k : SEQ + k] = 0; }
    fft_load_w(p, smem);
    for (int c = blockIdx.x; c < HYW; c += gridDim.x) {
        const v2f* Hs0 = (const v2f*)p.Hs + (size_t)(l * HYW + c) * 4 * 4096; const v2f* Hs1 = Hs0 + 2 * 4096;
        float scw[3][4];
#pragma unroll
        for (int w = 0; w < 3; ++w) { const int col = w * HYW + c; scw[w][0] = p.sc_w[(size_t)(l * 3 + 0) * HYC + col]; scw[w][1] = p.sc_w[(size_t)(l * 3 + 1) * HYC + col]; scw[w][2] = p.sc_w[(size_t)(l * 3 + 2) * HYC + col]; scw[w][3] = p.sc_b[l * HYC + col]; }
#define HY_TAP(sb, k, w) (scw[w][3] + scw[w][0] * __uint_as_float((unsigned)(sb)[(k) - 1] << 16) + scw[w][1] * __uint_as_float((unsigned)(sb)[(k)] << 16) + scw[w][2] * __uint_as_float((unsigned)(sb)[(k) + 1] << 16))
        u32x4 ra, rb;
#define HY_LOAD(sel, pr_) do { const bf16_t* r0_ = p.PT + ((size_t)(2 * (pr_)) * HYC + (sel) * HYW + c) * SEQ + tid * 8; ra = *(const u32x4*)r0_; rb = *(const u32x4*)(r0_ + (size_t)HYC * SEQ); } while (0)
#define HY_STAGE() do { *(u32x4*)(stg + tid * 8) = ra; *(u32x4*)(stg + STG_ROW + tid * 8) = rb; } while (0)
        HY_LOAD(0, 0);
        for (int pr = 0; pr < 2; ++pr) {
            const LAS bf16_t* sbA = (const LAS bf16_t*)stg + u; asm volatile("" : "+v"(sbA));
            const LAS bf16_t* sbB = sbA + STG_ROW;
            __syncthreads();
            HY_STAGE();
            __syncthreads();
            v2f v[16];
#pragma unroll
            for (int q = 0; q < 16; ++q) v[q] = (v2f){HY_TAP(sbA, 256 * q, 0), HY_TAP(sbB, 256 * q, 0)};
            HY_LOAD(1, pr);
            fft_conv(half, u, v, W2l, Hs0, buf, Wl);
            if (half) {
#pragma unroll
                for (int r = 0; r < 16; ++r) buf1[pu + 272 * r] = v[r];
            }
            HY_STAGE();
            __syncthreads();
            if (!half) {
#pragma unroll
                for (int r = 0; r < 16; ++r) {
                    const v2f y = v[r] + buf1[pu + 272 * r];
                    const float xa = HY_TAP(sbA, 256 * r, 1), xb = HY_TAP(sbB, 256 * r, 1);
                    const v2f z1 = (v2f){xa, xb} * y;
                    v[r] = z1; buf1[pu + 272 * r] = z1;
                }
            }
            HY_LOAD(2, pr);
            __syncthreads();
            if (half) {
#pragma unroll
                for (int r = 0; r < 16; ++r) v[r] = buf1[pu + 272 * r];
            }
            fft_conv(half, u, v, W2l, Hs1, buf, Wl);
            if (half) {
#pragma unroll
                for (int r = 0; r < 16; ++r) buf1[pu + 272 * r] = v[r];
            }
            HY_STAGE();
            if (pr == 0) HY_LOAD(0, 1);
            __syncthreads();
            if (!half) {
                bf16_t* oA = p.Yhy + ((size_t)(c >> 3) * TT + (size_t)(2 * pr) * SEQ + u) * 8 + (c & 7); bf16_t* oB = oA + (size_t)SEQ * 8;
#pragma unroll
                for (int r = 0; r < 16; ++r) {
                    const v2f y = v[r] + buf1[pu + 272 * r];
                    const float xa = HY_TAP(sbA, 256 * r, 2), xb = HY_TAP(sbB, 256 * r, 2);
                    oA[(size_t)(256 * r) * 8] = f2bf(xa * y.x);
                    oB[(size_t)(256 * r) * 8] = f2bf(xb * y.y);
                }
            }
        }
#undef HY_LOAD
#undef HY_STAGE
#undef HY_TAP
    }
    __syncthreads();
}

__device__ __forceinline__ float4 moe_combine4(const P& p, int lc, int b, size_t s0, size_t s1, int j, float4 hv) {
    const u32x2 y0 = *(const u32x2*)(p.Y + s0 * DM + j), y1 = *(const u32x2*)(p.Y + s1 * DM + j);
    const float4 g = *(const float4*)(p.mod + ((size_t)lc * 5 + b) * NMOD + 5 * DM + j);
    hv.x += g.x * (__uint_as_float(y0.x << 16) + __uint_as_float(y1.x << 16));
    hv.y += g.y * (__uint_as_float(y0.x & 0xFFFF0000u) + __uint_as_float(y1.x & 0xFFFF0000u));
    hv.z += g.z * (__uint_as_float(y0.y << 16) + __uint_as_float(y1.y << 16));
    hv.w += g.w * (__uint_as_float(y0.y & 0xFFFF0000u) + __uint_as_float(y1.y & 0xFFFF0000u));
    return hv;
}
__device__ __forceinline__ void ph_norm1c(const P& p, int l, const int* offs) {
    const int tid = tid_opaque(), lane = tid & 63, wv = tid >> 6;
    const float* ng = p.norm1_g + l * DM;
    for (int rb = blockIdx.x * 16; rb < TT; rb += gridDim.x * 16) {
        const int row0 = rb + wv * 2;
        const int b = row0 < TL ? (row0 >> 12) : 4;
        float* hp = p.hx + (size_t)row0 * DM;
        const float* src = l > 0 ? hp : (row0 < TL ? p.x + (size_t)row0 * DM : p.ctx + (size_t)(row0 - TL) * DM);
        const float* md = p.mod + ((size_t)l * 5 + b) * NMOD;
        float4 xv[2][4];
        u32x2 ya[2][4], yb[2][4];
        if (l > 0) {
            const int4 a0 = *(const int4*)(p.asg + (size_t)row0 * 4), a1 = *(const int4*)(p.asg + (size_t)(row0 + 1) * 4);
            const size_t s00 = (size_t)offs[a0.x] + a0.y, s01 = (size_t)offs[a0.z] + a0.w, s10 = (size_t)offs[a1.x] + a1.y, s11 = (size_t)offs[a1.z] + a1.w;
#pragma unroll
            for (int i = 0; i < 4; ++i) { const int j = i * 256 + lane * 4;
                ya[0][i] = *(const u32x2*)(p.Y + s00 * DM + j); yb[0][i] = *(const u32x2*)(p.Y + s01 * DM + j);
                ya[1][i] = *(const u32x2*)(p.Y + s10 * DM + j); yb[1][i] = *(const u32x2*)(p.Y + s11 * DM + j); }
        }
#pragma unroll
        for (int i = 0; i < 4; ++i) { const int j = i * 256 + lane * 4; xv[0][i] = *(const float4*)(src + j); xv[1][i] = *(const float4*)(src + DM + j); }
        float ss[2] = {0.f, 0.f};
#pragma unroll
        for (int rr = 0; rr < 2; ++rr)
#pragma unroll
            for (int i = 0; i < 4; ++i) {
                const int j = i * 256 + lane * 4;
                if (l > 0) {
                    const float4 g = *(const float4*)(p.mod + ((size_t)(l - 1) * 5 + b) * NMOD + 5 * DM + j);
                    const u32x2 y0 = ya[rr][i], y1 = yb[rr][i];
                    xv[rr][i].x += g.x * (__uint_as_float(y0.x << 16) + __uint_as_float(y1.x << 16));
                    xv[rr][i].y += g.y * (__uint_as_float(y0.x & 0xFFFF0000u) + __uint_as_float(y1.x & 0xFFFF0000u));
                    xv[rr][i].z += g.z * (__uint_as_float(y0.y << 16) + __uint_as_float(y1.y << 16));
                    xv[rr][i].w += g.w * (__uint_as_float(y0.y & 0xFFFF0000u) + __uint_as_float(y1.y & 0xFFFF0000u));
                }
                *(float4*)(hp + (size_t)rr * DM + j) = xv[rr][i];
                ss[rr] += xv[rr][i].x * xv[rr][i].x + xv[rr][i].y * xv[rr][i].y + xv[rr][i].z * xv[rr][i].z + xv[rr][i].w * xv[rr][i].w;
            }
        ss[0] = wave_sum(ss[0]); ss[1] = wave_sum(ss[1]);
        const float rs[2] = {rsqrtf(ss[0] * (1.0f / DM) + epsf()), rsqrtf(ss[1] * (1.0f / DM) + epsf())};
#pragma unroll
        for (int i = 0; i < 4; ++i) {
            const int j = i * 256 + lane * 4;
            const float4 g = *(const float4*)(ng + j), sh = *(const float4*)(md + j), sc = *(const float4*)(md + DM + j);
#pragma unroll
            for (int rr = 0; rr < 2; ++rr) {
                u32x2 o;
                o.x = pack2((xv[rr][i].x * rs[rr] * g.x) * (1.f + sc.x) + sh.x, (xv[rr][i].y * rs[rr] * g.y) * (1.f + sc.y) + sh.y);
                o.y = pack2((xv[rr][i].z * rs[rr] * g.z) * (1.f + sc.z) + sh.z, (xv[rr][i].w * rs[rr] * g.w) * (1.f + sc.w) + sh.w);
                *(u32x2*)(p.U + (size_t)(row0 + rr) * DM + j) = o;
            }
        }
    }
}
__device__ __forceinline__ void ph_final_c(const P& p, const int* offs) {
    const int tid = tid_opaque(), lane = tid & 63, wv = tid >> 6;
    for (int rb = blockIdx.x * 8; rb < TL; rb += gridDim.x * 8) {
        const int row = rb + wv, b = row >> 12;
        const float* hp = p.hx + (size_t)row * DM;
        const int4 a = *(const int4*)(p.asg + (size_t)row * 4);
        const size_t s0 = (size_t)offs[a.x] + a.y, s1 = (size_t)offs[a.z] + a.w;
        float4 xv[4]; float ss = 0.f;
#pragma unroll
        for (int i = 0; i < 4; ++i) {
            const int j = i * 256 + lane * 4;
            xv[i] = moe_combine4(p, DEPTH - 1, b, s0, s1, j, *(const float4*)(hp + j));
            ss += xv[i].x * xv[i].x + xv[i].y * xv[i].y + xv[i].z * xv[i].z + xv[i].w * xv[i].w;
        }
        ss = wave_sum(ss);
        const float rs = rsqrtf(ss * (1.0f / DM) + epsf());
#pragma unroll
        for (int i = 0; i < 4; ++i) {
            const int j = i * 256 + lane * 4;
            const float4 g = *(const float4*)(p.final_g + j);
            float4 y; y.x = xv[i].x * rs * g.x; y.y = xv[i].y * rs * g.y; y.z = xv[i].z * rs * g.z; y.w = xv[i].w * rs * g.w;
            *(float4*)(p.out + (size_t)row * DM + j) = y;
        }
    }
}


__device__ __forceinline__ void ph_hyena_ctx(const P& p, int l, char* smem) {
    constexpr int L = CTXL;
    const int tid = tid_opaque(), hf = tid >> 8, tl = tid & 255, b = tl >> 6, t0 = (tl & 63) * 4;
    float* kern0 = (float*)smem + hf * (8 * L);
    float* kern1 = kern0 + 2 * L;
    float* zb = kern1 + 2 * L;
    const float* HT = p.HT1 + (size_t)l * 2048 * L;
    const float* SCL = p.SCL1 + l * 2048;
    for (int cb = blockIdx.x; cb < HYW; cb += 2 * gridDim.x) {
        const int c = cb + hf * gridDim.x;
        const bool act = c < HYW;
        __syncthreads();
        float uv[3][4];
        if (act) {
            const float kb0 = tl > 0 ? HT[(size_t)(512 + c) * L + (L - tl)] * SCL[512 + c] : 0.f, kb1 = tl > 0 ? HT[(size_t)(1536 + c) * L + (L - tl)] * SCL[1536 + c] : 0.f;
            const float kf0 = HT[(size_t)c * L + tl] * SCL[c], kf1 = HT[(size_t)(1024 + c) * L + tl] * SCL[1024 + c];
            kern0[tl] = kb0; kern1[tl] = kb1; kern0[L + tl] = kf0; kern1[L + tl] = kf1;
#pragma unroll
            for (int w = 0; w < 3; ++w) {
                const int col = w * HYW + c;
                const bf16_t* pr = p.PTc + ((size_t)b * HYC + col) * L + t0;
                const float w0 = p.sc_w[(size_t)(l * 3 + 0) * HYC + col], w1 = p.sc_w[(size_t)(l * 3 + 1) * HYC + col], w2 = p.sc_w[(size_t)(l * 3 + 2) * HYC + col], bb = p.sc_b[l * HYC + col];
                const u32x2 mid = *(const u32x2*)pr;
                float e[6];
                e[0] = t0 > 0 ? bf2f(pr[-1]) : 0.f; e[5] = t0 + 4 < L ? bf2f(pr[4]) : 0.f;
                e[1] = __uint_as_float(mid.x << 16); e[2] = __uint_as_float(mid.x & 0xFFFF0000u); e[3] = __uint_as_float(mid.y << 16); e[4] = __uint_as_float(mid.y & 0xFFFF0000u);
#pragma unroll
                for (int j = 0; j < 4; ++j) uv[w][j] = bb + w0 * e[j] + w1 * e[j + 1] + w2 * e[j + 2];
            }
            *(float4*)(zb + b * L + t0) = make_float4(uv[0][0], uv[0][1], uv[0][2], uv[0][3]);
        }
        __syncthreads();
        const float* zr = zb + b * L;
        float a[4];
#define CTX_CONV(kern) do { a[0] = 0.f; a[1] = 0.f; a[2] = 0.f; a[3] = 0.f; \
            float4 khi = *(const float4*)((kern) + t0 + L); \
            _Pragma("unroll 4") for (int m = 0; m < L / 4; ++m) { \
                const float4 klo = *(const float4*)((kern) + t0 + L - 4 * m - 4); const float4 z = *(const float4*)(zr + 4 * m); \
                a[0] += z.x * khi.x; a[1] += z.x * khi.y; a[2] += z.x * khi.z; a[3] += z.x * khi.w; \
                a[0] += z.y * klo.w; a[1] += z.y * khi.x; a[2] += z.y * khi.y; a[3] += z.y * khi.z; \
                a[0] += z.z * klo.z; a[1] += z.z * klo.w; a[2] += z.z * khi.x; a[3] += z.z * khi.y; \
                a[0] += z.w * klo.y; a[1] += z.w * klo.z; a[2] += z.w * klo.w; a[3] += z.w * khi.x; \
                khi = klo; } } while (0)
        float z1[4];
        if (act) {
            CTX_CONV(kern0);
            const float bias0 = p.flt_bias[(l * 2 + 0) * HYW + c];
#pragma unroll
            for (int j = 0; j < 4; ++j) z1[j] = uv[1][j] * (a[j] + bias0 * uv[0][j]);
        }
        __syncthreads();
        if (act) *(float4*)(zb + b * L + t0) = make_float4(z1[0], z1[1], z1[2], z1[3]);
        __syncthreads();
        if (act) {
            CTX_CONV(kern1);
            const float bias1 = p.flt_bias[(l * 2 + 1) * HYW + c];
            bf16_t* o = p.Yhy + ((size_t)(c >> 3) * TT + (size_t)TL + b * CTXL + t0) * 8 + (c & 7);
#pragma unroll
            for (int j = 0; j < 4; ++j) o[j * 8] = f2bf(uv[2][j] * (a[j] + bias1 * z1[j]));
        }
#undef CTX_CONV
    }
    __syncthreads();
}

__device__ __forceinline__ void conv_tile(bf16_t* tile, const float* src, int ld, int c0, int ncols, int K, bf16_t* dst, int kt, int ntile, const float* kscale = nullptr) {
    const int tid = tid_opaque();
    const int k = tid >> 3, n8 = (tid & 7) * 8, nbase = ntile * 64;
    float4 x0 = make_float4(0.f, 0.f, 0.f, 0.f), x1 = x0;
    if (nbase + n8 < ncols) { const float* sp = src + (size_t)(kt * 64 + k) * ld + c0 + nbase + n8; x0 = *(const float4*)sp; x1 = *(const float4*)(sp + 4); }
    if (kscale) { const float ks = kscale[kt * 64 + k]; x0.x *= ks; x0.y *= ks; x0.z *= ks; x0.w *= ks; x1.x *= ks; x1.y *= ks; x1.z *= ks; x1.w *= ks; }
    __syncthreads();
    tile[(n8 + 0) * 72 + k] = f2bf(x0.x); tile[(n8 + 1) * 72 + k] = f2bf(x0.y); tile[(n8 + 2) * 72 + k] = f2bf(x0.z); tile[(n8 + 3) * 72 + k] = f2bf(x0.w);
    tile[(n8 + 4) * 72 + k] = f2bf(x1.x); tile[(n8 + 5) * 72 + k] = f2bf(x1.y); tile[(n8 + 6) * 72 + k] = f2bf(x1.z); tile[(n8 + 7) * 72 + k] = f2bf(x1.w);
    __syncthreads();
    const int n = tid >> 3, k8 = (tid & 7) * 8;
    if (nbase + n < ncols) *(u32x4*)(dst + (size_t)(nbase + n) * K + kt * 64 + k8) = *(const u32x4*)(tile + n * 72 + k8);
}
constexpr int DENSE_TILES = 1720;
__device__ __forceinline__ void ph_conv_dense(const P& p, char* smem) {
    bf16_t* tile = (bf16_t*)smem;
    for (int id = blockIdx.x; id < DEPTH * DENSE_TILES; id += gridDim.x) {
        const int l = id / DENSE_TILES; int r = id % DENSE_TILES;
        const float* win = p.w_in + (size_t)l * DM * INC;
        if (r < 384) conv_tile(tile, win, INC, 0, HYC, DM, p.WtHy + (size_t)l * HYC * DM, r / 24, r % 24);
        else if ((r -= 384) < 64) conv_tile(tile, win, INC, HYC + QL, KVL, DM, p.WtRest + (size_t)l * 2816 * DM, r / 4, r % 4);
        else if ((r -= 64) < 96) conv_tile(tile, win, INC, HYC, QL, DM, p.WtRest + ((size_t)l * 2816 + 256) * DM, r / 6, r % 6);
        else if ((r -= 96) < 16) conv_tile(tile, win, INC, HYC + QL + KVL, QKR, DM, p.WtRest + ((size_t)l * 2816 + 640) * DM, r, 0);
        else if ((r -= 16) < 512) conv_tile(tile, win, INC, MLA_END, 2048, DM, p.WtRest + ((size_t)l * 2816 + 768) * DM, r / 32, r % 32);
        else if ((r -= 512) < 72) conv_tile(tile, p.w_uq + (size_t)l * QL * 768, 768, 0, 768, QL, p.WtUq + (size_t)l * 768 * QL, r / 12, r % 12, p.q_norm_g + l * QL);
        else if ((r -= 72) < 64) conv_tile(tile, p.w_ukv + (size_t)l * KVL * 1024, 1024, 0, 1024, KVL, p.WtUkv + (size_t)l * 1024 * KVL, r / 16, r % 16, p.kv_norm_g + l * KVL);
        else if ((r -= 64) < 128) conv_tile(tile, p.w_hy_o + (size_t)l * HYW * DM, DM, 0, DM, HYW, p.WtHyo + (size_t)l * DM * HYW, r / 16, r % 16);
        else if ((r -= 128) < 128) conv_tile(tile, p.w_mla_o + (size_t)l * 512 * DM, DM, 0, DM, 512, p.WtMlao + (size_t)l * DM * 512, r / 16, r % 16);
        else { r -= 128; conv_tile(tile, p.w_out + (size_t)l * DM * DM, DM, 0, DM, DM, p.WtOut + (size_t)l * DM * DM, r / 16, r % 16); }
    }
    const int nz = DEPTH * 96 * DM / 8;
    for (int i = blockIdx.x * NT + threadIdx.x; i < nz + SEQ * 16; i += gridDim.x * NT) {
        if (i < nz) { const int l = i / (96 * DM / 8), o = i % (96 * DM / 8); *(u32x4*)(p.WtRest + ((size_t)l * 2816 + MLAW) * DM + (size_t)o * 8) = (u32x4){0u, 0u, 0u, 0u}; }
        else { const int k = i - nz, t = k >> 4, a = (k >> 3) & 1, ii = k & 7; const float ang = (float)(a == 0 ? (t >> 6) : (t & 63)) * powf(10000.0f, -(float)ii / 8.0f); p.rope[k] = make_float2(cosf(ang), sinf(ang)); }
    }
}
__device__ __forceinline__ void ph_conv_experts(const P& p, int l, char* smem, int t_begin, int t_end, int worker, int nworkers) {
    bf16_t* tile = (bf16_t*)smem;
    if (worker >= 0)
    for (int id = t_begin + worker; id < t_end; id += nworkers) {
        const int e = id / 192; int r = id % 192;
        const size_t le = (size_t)l * NE + e;
        if (r < 64) conv_tile(tile, p.w_gate + le * DM * DE, DE, 0, DE, DM, p.WtG + (size_t)e * DE * DM, r / 4, r % 4);
        else if (r < 128) { r -= 64; conv_tile(tile, p.w_up + le * DM * DE, DE, 0, DE, DM, p.WtU + (size_t)e * DE * DM, r / 4, r % 4); }
        else { r -= 128; conv_tile(tile, p.w_down + le * DE * DM, DM, 0, DM, DE, p.WtD + (size_t)e * DM * DE, r / 16, r % 16); }
    }
    __syncthreads();
}

constexpr int LDS_TAB = ge::STAGE_BYTES;
static_assert(FFT_LDS_END <= 160 * 1024 - 16, "FFT LDS image");
constexpr int LDS_TOTAL = 160 * 1024;
#define PH_P KArgP kp_ = (KArgP)__builtin_amdgcn_kernarg_segment_ptr(); asm volatile("" : "+s"(kp_)); const P p = make_p(kp_); int G = gridDim.x, c = blockIdx.x; asm volatile("" : "+s"(G), "+s"(c)); (void)G; (void)c;
#define GRID_BAR() do { XcdBarrier b_; b_.bar = (unsigned*)k.ws; b_.x = xb_xcc_id(); b_.st = xbw; xcd_barrier(b_); } while (0)
__global__ __launch_bounds__(NT, 2) void mega(PK k) {
    extern __shared__ __attribute__((aligned(16))) char smem[];
    LAS unsigned char* lds = (LAS unsigned char*)smem;
    volatile LAS unsigned* xbw = (volatile LAS unsigned*)(smem + LDS_TOTAL - 16);
    if (threadIdx.x == 0) { xbw[0] = 0u; xbw[1] = 0u; xbw[2] = 0u; xbw[3] = 0u; }
    __syncthreads();
    (void)xcd_barrier_post((unsigned*)k.ws, xbw);
#define PB(id) do { if (PROBE_ID == (id) && blockIdx.x == PROBE_BLK && threadIdx.x == 0) xbw[2] = (unsigned)wall_clock64(); } while (0)
#define PE(id) do { if (PROBE_ID == (id) && blockIdx.x == PROBE_BLK && threadIdx.x == 0) xbw[3] += (unsigned)wall_clock64() - xbw[2]; } while (0)
    int* offs = (int*)(smem + LDS_TAB); int* tpre = offs + 65; int* cntl = tpre + 65;
    const LAS int* offs_l = (const LAS int*)(lds + LDS_TAB); const LAS int* tpre_l = offs_l + 65; const LAS int* cntl_l = tpre_l + 65;
    PB(0);
    for (int rep = 0; rep < REP_PRO; ++rep) {
    PB(20);
    { PH_P ph_mod_partial(p, smem); ph_filter_a(p, smem); ph_conv_dense(p, smem); ph_tables(p); }
    GRID_BAR();
    PE(20); PB(21);
    { PH_P ph_filter_b2(p, smem); }
    GRID_BAR();
    PE(21); PB(22);
    { PH_P ph_finalize(p); }
    GRID_BAR();
    PE(22); PB(23);
    { PH_P ph_spectra(p, smem); }
    GRID_BAR();
    PE(23);
    }
    PE(0);
    for (int l = 0; l < DEPTH; ++l) {
        const bool last = (l == DEPTH - 1);
        PB(1);
        { PH_P ph_norm1c(p, l, offs); }
        GRID_BAR();
        PE(1); PB(2); PB(40);
#define CHAIN_IDS int cw_ = blockIdx.x; asm volatile("" : "+s"(cw_)); const bool kvc = cw_ < 68, qc = !kvc && cw_ < 136; const int pm = kvc ? cw_ : cw_ - 68; (void)qc; (void)pm;
#define CHAIN_SSQ LAS float* ssq = (LAS float*)(lds + LDS_SSQ); LAS float* rsl = ssq + 256 * 16; (void)rsl;
        { CHAIN_IDS
          if (kvc || qc) { PH_P CHAIN_SSQ
              SchedChainIn S{(const char*)p.U, (const char*)(p.WtRest + (size_t)l * 2816 * DM), pm, kvc ? 0 : 1, kvc ? 1 : 2};
              EpiInprojMLA E{p.PMLAb, p.K, p.rope, ssq};
              ge::gemm_engine<false>(lds, DM, DM, DM, S, E);
          } }
        { CHAIN_IDS
          if (kvc || qc) { CHAIN_SSQ
              asm volatile("s_waitcnt vmcnt(0)" ::: "memory"); __syncthreads(); __builtin_amdgcn_fence(__ATOMIC_ACQUIRE, "agent"); asm volatile("s_waitcnt vmcnt(0)" ::: "memory");
              const int t_ = tid_opaque();
              if (t_ < 256) { float a_ = 0.f; const int ns = kvc ? 8 : 12;
                  for (int q_ = 0; q_ < ns; ++q_) a_ += ssq[t_ * 16 + q_];
                  rsl[t_] = rsqrtf(a_ * (kvc ? 1.0f / KVL : 1.0f / QL) + epsf()); }
              __syncthreads();
          } }
        { CHAIN_IDS
          if (kvc || qc) { PH_P CHAIN_SSQ
              LAS float* rpl = rsl + 256;
              { const int t0 = (pm & 15) * 256;
                if (pm < 64) for (int t_ = tid_opaque(); t_ < 544; t_ += NT) {
                    const float2 e_ = t_ < 32 ? p.rope[(size_t)(t0 + (t_ >> 3) * 64) * 16 + (t_ & 7)] : p.rope[(size_t)(t0 + ((t_ - 32) >> 3)) * 16 + 8 + ((t_ - 32) & 7)];
                    rpl[2 * t_] = e_.x; rpl[2 * t_ + 1] = e_.y; }
                __syncthreads(); }
              SchedPanel S{(const char*)(p.PMLAb + (kvc ? 0 : 256)), kvc ? (const char*)(p.WtUkv + (size_t)l * 1024 * KVL) : (const char*)(p.WtUq + (size_t)l * 768 * QL),
                           (size_t)640 * 2, (size_t)(kvc ? KVL : QL) * 2, pm, kvc ? 4 : 3, kvc ? 1 : 0};
              EpiQKV E{EpiQ{p.Q, p.Qc, rpl, rsl}, EpiKV{p.K, p.V, rsl}};
              ge::gemm_engine<false>(lds, 640, kvc ? KVL : QL, kvc ? KVL : QL, S, E);
          } }
        { CHAIN_IDS PH_P
            SchedPool S{(const char*)(p.WtHy + (size_t)l * HYC * DM), (const char*)(p.WtRest + (size_t)l * 2816 * DM), (const char*)p.U,
                        kvc ? 680 + 3 * cw_ : (qc ? 884 + (cw_ - 68) : cw_ - 136), (kvc || qc) ? 1 : G - 136, kvc ? 3 : (qc ? 1 : (680 - (cw_ - 136) + (G - 136) - 1) / (G - 136))};
            EpiInproj E{p.PT, p.PTc, p.G};
            ge::gemm_engine<false>(lds, DM, DM, DM, S, E);
        }
#undef CHAIN_IDS
#undef CHAIN_SSQ
        PE(40);
        GRID_BAR();
        PE(2);
        PE(4); PB(5);
        for (int rep = 0; rep < REP_MIX; ++rep) {
        PB(31);
        { PH_P ph_attn2(p, smem, !last); }
        PE(31); PB(32);
        { PH_P ph_hyena_fft(p, l, smem); }
        PE(32); PB(33);
        if (!last) { PH_P ph_hyena_ctx(p, l, smem); }
        PE(33); }
        GRID_BAR();
        PE(5); PB(6);
        for (int rep = 0; rep < REP_DENSE; ++rep) { PH_P
            SchedMerge S{(const char*)p.Yhy, (const char*)p.Yatt, (const char*)(p.WtHyo + (size_t)l * DM * HYW), (const char*)(p.WtMlao + (size_t)l * DM * 512), G, c, last ? 64 : 68};
            EpiMerge E{p.G, p.M1};
            ge::gemm_engine<false, TT>(lds, 512, 512, 512, S, E);
        }
        { PH_P ph_conv_experts(p, l, smem, 0, NE * 96, c - 16, G - 16); }
        GRID_BAR();
        PE(6); PB(7);
        { PH_P
            SchedDense S{(const char*)p.M1, (const char*)(p.WtOut + (size_t)l * DM * DM), (size_t)DM * 2, (size_t)DM * 2, last ? 64 : 68, 4, G, c};
            EpiOut E{p.hx, p.mod + (size_t)l * 5 * NMOD};
            ge::gemm_engine<false>(lds, DM, DM, DM, S, E);
        }
        { PH_P ph_conv_experts(p, l, smem, NE * 96, NE * 192, c - 16, G - 16); }
        GRID_BAR();
        PE(7); PB(8);
        { PH_P ph_norm2_router(p, l, smem, last ? TL : TT); }
        GRID_BAR();
        PE(8); PB(9);
        for (int rep = 0; rep < REP_MOE; ++rep) { PH_P
            if (threadIdx.x < NE) cntl[threadIdx.x] = p.cnt[(l * NE + threadIdx.x) * 64];
            __syncthreads();
            if (threadIdx.x == 0) { int a = 0, t = 0; for (int e = 0; e < NE; ++e) { const int n = cntl[e]; offs[e] = a; tpre[e] = t; a += n; t += (n + 255) >> 8; } offs[64] = a; tpre[64] = t; }
            __syncthreads();
            SchedGU S{(const char*)p.U, (const char*)p.WtG, (const char*)p.WtU, p.list, tpre_l, cntl_l, G, c};
            EpiGU E{p.Hb, offs_l};
            ge::gemm_engine<true>(lds, DM, DM, DM, S, E);
        }
        GRID_BAR();
        PE(9); PB(10);
        for (int rep = 0; rep < REP_MOE; ++rep) { PH_P
            SchedDown S{(const char*)p.Hb, (const char*)p.WtD, tpre_l, cntl_l, offs_l, G, c};
            EpiDown E{p.Y, p.wl, offs_l};
            ge::gemm_engine<false>(lds, DE, DE, DE, S, E);
        }
        GRID_BAR();
        PE(10);
        if (PROBE_ID == 12) { PB(12); GRID_BAR(); PE(12); }
    }
    PB(11);
    { PH_P ph_final_c(p, offs); }
    PE(11);
    if (PROBE_ID >= 0 && blockIdx.x == PROBE_BLK && threadIdx.x == 0) { const unsigned long long t0 = wall_clock64(), wait = (unsigned long long)xbw[3] * PROBE_K; while (wall_clock64() - t0 < wait) __builtin_amdgcn_s_sleep(8); }
}

extern "C" void kernel_launch(void* const* d_in, const int* in_sizes, int n_in, void* d_out, int out_size, void* d_ws, size_t ws_size, hipStream_t stream) {
    (void)in_sizes; (void)out_size;
    if (n_in < 33 || WSO.total > ws_size) { fprintf(stderr, "kernel_launch: need 33 inputs and %zu bytes of workspace; got %d, %zu\n", (size_t)WSO.total, n_in, ws_size); return; }
    PK k{};
    for (int i = 0; i < 33; ++i) k.in[i] = (const float*)d_in[i];
    k.out = (float*)d_out; k.ws = (char*)d_ws;
    (void)hipMemsetAsync(d_ws, 0, WS_ZERO_BYTES, stream);
    static int grid = 0;
    if (!grid) {
        int dev = 0, cus = 0, per_cu = 0;
        (void)hipGetDevice(&dev);
        (void)hipDeviceGetAttribute(&cus, hipDeviceAttributeMultiprocessorCount, dev);
        (void)hipFuncSetAttribute((const void*)mega, hipFuncAttributeMaxDynamicSharedMemorySize, LDS_TOTAL);
        (void)hipOccupancyMaxActiveBlocksPerMultiprocessor(&per_cu, (const void*)mega, NT, LDS_TOTAL);
        if (per_cu < 1) fprintf(stderr, "kernel_launch: occupancy query reports %d blocks per CU\n", per_cu);
        grid = cus > 0 ? cus : 256;
    }
    hipLaunchKernelGGL(mega, dim3(grid), dim3(NT), LDS_TOTAL, stream, k);
}
```

```cpp
#include <hip/hip_runtime.h>
#include <stdint.h>
#include <stdio.h>

typedef unsigned short bf16_t;
typedef short bf16x8 __attribute__((ext_vector_type(8)));
typedef float f32x4 __attribute__((ext_vector_type(4)));
typedef unsigned u32x4 __attribute__((ext_vector_type(4)));
typedef unsigned u32x2 __attribute__((ext_vector_type(2)));

#define NT 512
#ifndef PROBE_BLK
#define PROBE_BLK 0
#endif
#ifndef PROBE_ID
#define PROBE_ID (-1)
#endif
#define PROBE_K 8
#ifndef REP_PRO
#define REP_PRO 1
#endif
#ifndef REP_DENSE
#define REP_DENSE 1
#endif
#ifndef REP_MOE
#define REP_MOE 1
#endif
#ifndef REP_MIX
#define REP_MIX 1
#endif
#ifndef REP_MISC
#define REP_MISC 1
#endif
constexpr int DM = 1024, NB = 4, SEQ = 4096, DEPTH = 4, CTXL = 256;
constexpr int TL = NB * SEQ, TC = NB * CTXL, TT = TL + TC;
constexpr int HYW = 512, HYC = 1536, QL = 384, KVL = 256, QKR = 32;
constexpr int MLAW = QL + KVL + QKR, MLA_END = HYC + MLAW, INC = MLA_END + 2 * DM;
constexpr int NH = 8, DQK = 96, DV = 64, NKEY = SEQ + CTXL;
constexpr int NE = 64, DE = 256, CAP = TT;
constexpr int NMOD = 6 * DM;
constexpr float EPSF = 1e-6f;
constexpr float QSCALE = 0.10206207261596577f * 1.4426950408889634f;

__device__ __forceinline__ bf16_t f2bf(float f) { unsigned u = __float_as_uint(f); u += 0x7FFFu + ((u >> 16) & 1u); return (bf16_t)(u >> 16); }
__device__ __forceinline__ float bf2f(bf16_t b) { return __uint_as_float(((unsigned)b) << 16); }
__device__ __forceinline__ unsigned pack2(float lo, float hi) { return (unsigned)f2bf(lo) | ((unsigned)f2bf(hi) << 16); }
__device__ __forceinline__ float epsf() { float e = EPSF; asm volatile("" : "+v"(e)); return e; }
__device__ __forceinline__ int tid_opaque() { int t = threadIdx.x; asm volatile("" : "+v"(t)); return t; }
__device__ __forceinline__ int shx_i(int v, int mask) {
    switch (mask) {
        case 1: return __builtin_amdgcn_ds_swizzle(v, (1 << 10) | 0x1F);
        case 2: return __builtin_amdgcn_ds_swizzle(v, (2 << 10) | 0x1F);
        case 4: return __builtin_amdgcn_ds_swizzle(v, (4 << 10) | 0x1F);
        case 8: return __builtin_amdgcn_ds_swizzle(v, (8 << 10) | 0x1F);
        case 16: return __builtin_amdgcn_ds_swizzle(v, (16 << 10) | 0x1F);
        default: {
            typedef unsigned u32x2s_t __attribute__((ext_vector_type(2)));
            const u32x2s_t r = __builtin_amdgcn_permlane32_swap((unsigned)v, (unsigned)v, false, false);
            return (int)(((threadIdx.x & 32u) == 0u) ? r.y : r.x); }
    }
}
__device__ __forceinline__ float shx(float v, int mask) { return __int_as_float(shx_i(__float_as_int(v), mask)); }
__device__ __forceinline__ int shx(int v, int mask) { return shx_i(v, mask); }
typedef unsigned u32x2_t __attribute__((ext_vector_type(2)));
__device__ __forceinline__ float rowmax4(float v) {
    u32x2_t r = __builtin_amdgcn_permlane16_swap(__float_as_uint(v), __float_as_uint(v), false, false);
    v = fmaxf(__uint_as_float(r.x), __uint_as_float(r.y));
    r = __builtin_amdgcn_permlane32_swap(__float_as_uint(v), __float_as_uint(v), false, false);
    return fmaxf(__uint_as_float(r.x), __uint_as_float(r.y));
}
__device__ __forceinline__ float rowsum4(float v) {
    u32x2_t r = __builtin_amdgcn_permlane16_swap(__float_as_uint(v), __float_as_uint(v), false, false);
    v = __uint_as_float(r.x) + __uint_as_float(r.y);
    r = __builtin_amdgcn_permlane32_swap(__float_as_uint(v), __float_as_uint(v), false, false);
    return __uint_as_float(r.x) + __uint_as_float(r.y);
}
__device__ __forceinline__ float wave_sum(float v) {
#pragma unroll
    for (int o = 32; o > 0; o >>= 1) v += shx(v, o);
    return v;
}


#define XB_TMO      128
#define XB_XCNT(j)  (256  + 64 * (j))
#define XB_XSUB(j)  (1280 + 64 * (j))
#define XB_XGEN(j)  (2304 + 64 * (j))
#define XB_TOP      3328
#define XB_TOPGEN   3392
#define XCD_BAR_WORDS 3456
#define XB_SPIN_CAP (1u << 22)
#define LAS __attribute__((address_space(3)))
__device__ __forceinline__ unsigned xb_ld(unsigned* p)              { return __hip_atomic_load(p, __ATOMIC_RELAXED, __HIP_MEMORY_SCOPE_AGENT); }
__device__ __forceinline__ unsigned xb_add(unsigned* p, unsigned v) { return __hip_atomic_fetch_add(p, v, __ATOMIC_RELAXED, __HIP_MEMORY_SCOPE_AGENT); }
__device__ __forceinline__ unsigned xb_xcc_id() { return (unsigned)__builtin_amdgcn_s_getreg((3 << 11) | 20) & 0xFu; }
#define XB_SPIN(cond, bar) do { unsigned _sp = 0; while (cond) { __builtin_amdgcn_s_sleep(1); \
    if ((++_sp & 255u) == 0u) { if (xb_ld(&(bar)[XB_TMO])) break; if (_sp > XB_SPIN_CAP) { atomicAdd(&(bar)[XB_TMO], 1u); break; } } } } while (0)
struct XcdBarrier { unsigned* bar; unsigned x; volatile LAS unsigned* st; };
__device__ __forceinline__ XcdBarrier xcd_barrier_post(unsigned* bar, volatile LAS unsigned* st) {
    XcdBarrier b; b.bar = bar; b.x = xb_xcc_id(); b.st = st;
    if (threadIdx.x == 0) (void)xb_add(&bar[XB_XCNT(b.x)], 1u);
    return b;
}
__device__ __forceinline__ void xcd_barrier_complete(unsigned* bar, unsigned x, unsigned& nloc, unsigned& nx) {
    const unsigned G = gridDim.x * gridDim.y * gridDim.z;
    unsigned sum, cnt, mine, sp = 0u;
    for (;;) {
        sum = 0u; cnt = 0u; mine = 0u;
#pragma unroll
        for (unsigned j = 0; j < 16; ++j) { const unsigned c = xb_ld(&bar[XB_XCNT(j)]); sum += c; cnt += (c > 0u) ? 1u : 0u; mine = (j == x) ? c : mine; }
        if (sum == G) break;
        __builtin_amdgcn_s_sleep(1);
        if ((++sp & 255u) == 0u) { if (xb_ld(&bar[XB_TMO])) break; if (sp > XB_SPIN_CAP) { atomicAdd(&bar[XB_TMO], 1u); break; } }
    }
    nloc = mine > 0u ? mine : 1u; nx = cnt > 0u ? cnt : 1u;
}
__device__ __forceinline__ void xcd_barrier(const XcdBarrier& b) {
    asm volatile("s_waitcnt vmcnt(0)" ::: "memory");
    __syncthreads();
    if (threadIdx.x == 0) {
        unsigned* bar = b.bar;
        __builtin_amdgcn_s_waitcnt(0);
        unsigned nloc = b.st[0], nx = b.st[1];
        if (nloc == 0u) { xcd_barrier_complete(bar, b.x, nloc, nx); b.st[0] = nloc; b.st[1] = nx; }
        const unsigned old = xb_add(&bar[XB_XSUB(b.x)], 1u);
        const unsigned gen = old / nloc;
        if (old + 1u == (gen + 1u) * nloc) {
            __builtin_amdgcn_fence(__ATOMIC_RELEASE, "agent");
            asm volatile("s_waitcnt vmcnt(0)" ::: "memory");
            const unsigned og = xb_add(&bar[XB_TOP], 1u);
            const unsigned tg = og / nx;
            if (og + 1u == (tg + 1u) * nx) xb_add(&bar[XB_TOPGEN], 1u);
            else XB_SPIN(xb_ld(&bar[XB_TOPGEN]) == tg, bar);
            __builtin_amdgcn_fence(__ATOMIC_ACQUIRE, "agent");
            xb_add(&bar[XB_XGEN(b.x)], 1u);
            asm volatile("s_waitcnt vmcnt(0)" ::: "memory");
        } else {
            XB_SPIN(xb_ld(&bar[XB_XGEN(b.x)]) == gen, bar);
            __builtin_amdgcn_fence(__ATOMIC_ACQUIRE, "agent");
            asm volatile("s_waitcnt vmcnt(0)" ::: "memory");
        }
    }
    __syncthreads();
}

#define WS_LIST(X) \
    X(unsigned, bar, XCD_BAR_WORDS * 4)                         \
    X(int, cnt, DEPTH * 64 * 256)                               \
    X(float, modp, (size_t)DEPTH * 32 * 5 * NMOD * 4)           \
    X(float, mod, (size_t)DEPTH * 5 * NMOD * 4)                 \
    X(float, H2a, (size_t)DEPTH * SEQ * 64 * 4) \
    X(float, H2b, (size_t)DEPTH * CTXL * 64 * 4) \
    X(float, HT1, (size_t)DEPTH * 2048 * CTXL * 4) \
    X(float, SSQ0, (size_t)DEPTH * 2048 * 128 * 4) \
    X(float, SSQ1, (size_t)DEPTH * 2048 * 8 * 4) \
    X(float, SCL0, (size_t)DEPTH * 2048 * 4) \
    X(float, SCL1, (size_t)DEPTH * 2048 * 4) \
    X(float, hx, (size_t)TT * DM * 4)                           \
    X(bf16_t, U, (size_t)TT * DM * 2)                           \
    X(bf16_t, PT, (size_t)NB * HYC * SEQ * 2)                   \
    X(bf16_t, PTc, (size_t)NB * HYC * CTXL * 2) \
    X(bf16_t, PMLAb, (size_t)TT * 640 * 2)                      \
    X(bf16_t, G, (size_t)TT * 2048 * 2)                         \
    X(bf16_t, Q, (size_t)NB * NH * SEQ * 128 * 2)               \
    X(bf16_t, Qc, (size_t)NB * NH * CTXL * 128 * 2) \
    X(bf16_t, K, (size_t)NB * NH * NKEY * DQK * 2)              \
    X(bf16_t, V, (size_t)NB * NH * NKEY * DV * 2)               \
    X(bf16_t, Yatt, (size_t)TT * 512 * 2) \
    X(bf16_t, Yhy, (size_t)TT * 512 * 2) \
    X(bf16_t, M1, (size_t)TT * DM * 2) \
    X(int, list, (size_t)NE * CAP * 4) \
    X(float, wl, (size_t)NE * CAP * 4) \
    X(int, asg, (size_t)TT * 4 * 4) \
    X(bf16_t, Hb, (size_t)(2 * TT + 256) * DE * 2) \
    X(bf16_t, Y, (size_t)2 * TT * DM * 2) \
    X(bf16_t, WtHy, (size_t)DEPTH * HYC * DM * 2)               \
    X(bf16_t, WtRest, (size_t)DEPTH * 2816 * DM * 2) \
    X(bf16_t, WtUq, (size_t)DEPTH * 768 * QL * 2) \
    X(bf16_t, WtUkv, (size_t)DEPTH * 1024 * KVL * 2) \
    X(bf16_t, WtHyo, (size_t)DEPTH * DM * HYW * 2) \
    X(bf16_t, WtMlao, (size_t)DEPTH * DM * 512 * 2) \
    X(bf16_t, WtOut, (size_t)DEPTH * DM * DM * 2) \
    X(bf16_t, WtG, (size_t)NE * DE * DM * 2)                    \
    X(bf16_t, WtU, (size_t)NE * DE * DM * 2) \
    X(bf16_t, WtD, (size_t)NE * DM * DE * 2) \
    X(float2, rope, (size_t)SEQ * 16 * 8)                       \
    X(float2, Hs, (size_t)DEPTH * HYW * 4 * 4096 * 8)           \
    X(float2, Wtab, 4096 * 8) \
    X(bf16_t, WrT, (size_t)DEPTH * 2 * 80 * DM * 2)             \
    X(float2, W2tab, 4096 * 8)
struct WsOff {
#define X(t, n, b) size_t n;
    WS_LIST(X)
#undef X
    size_t total;
};
constexpr WsOff ws_layout() {
    WsOff o{}; size_t a = 0;
#define X(t, n, b) o.n = a; a += (((size_t)(b)) + 255) & ~(size_t)255;
    WS_LIST(X)
#undef X
    o.total = a; return o;
}
constexpr WsOff WSO = ws_layout();
constexpr size_t WS_ZERO_BYTES = WSO.modp;
static_assert(WSO.Yatt - WSO.G >= (size_t)DEPTH * 2048 * SEQ * 4, "HT0 alias region too small");

struct PK { const float* in[33]; float* out; char* ws; };
struct P {
    const float *x, *c, *ctx, *c_ctx, *w_ada, *b_ada, *norm1_g, *w_in, *q_norm_g, *kv_norm_g, *w_uq, *w_ukv, *sc_w, *sc_b;
    const float *flt_w1, *flt_b1, *flt_freq, *flt_w2, *flt_b2, *flt_w3, *flt_bias, *w_hy_o, *w_mla_o, *w_out, *norm2_g;
    const float *w_rg, *b_rg, *w_re, *b_re, *w_gate, *w_up, *w_down, *final_g;
    float* out;
#define X(t, n, b) t* n;
    WS_LIST(X)
#undef X
    float* HT0;
};
typedef const __attribute__((address_space(4))) PK* KArgP;
__device__ __forceinline__ P make_p(KArgP kp) {
    P p; const KArgP& kk = kp; char* ws = kk->ws;
    p.x = kk->in[0]; p.c = kk->in[1]; p.ctx = kk->in[2]; p.c_ctx = kk->in[3]; p.w_ada = kk->in[4]; p.b_ada = kk->in[5]; p.norm1_g = kk->in[6]; p.w_in = kk->in[7];
    p.q_norm_g = kk->in[8]; p.kv_norm_g = kk->in[9]; p.w_uq = kk->in[10]; p.w_ukv = kk->in[11]; p.sc_w = kk->in[12]; p.sc_b = kk->in[13];
    p.flt_w1 = kk->in[14]; p.flt_b1 = kk->in[15]; p.flt_freq = kk->in[16]; p.flt_w2 = kk->in[17]; p.flt_b2 = kk->in[18]; p.flt_w3 = kk->in[19]; p.flt_bias = kk->in[20];
    p.w_hy_o = kk->in[21]; p.w_mla_o = kk->in[22]; p.w_out = kk->in[23]; p.norm2_g = kk->in[24]; p.w_rg = kk->in[25]; p.b_rg = kk->in[26]; p.w_re = kk->in[27]; p.b_re = kk->in[28];
    p.w_gate = kk->in[29]; p.w_up = kk->in[30]; p.w_down = kk->in[31]; p.final_g = kk->in[32];
    p.out = kk->out;
#define X(t, n, b) p.n = (t*)(ws + WSO.n);
    WS_LIST(X)
#undef X
    p.HT0 = (float*)(ws + WSO.G);
    return p;
}

constexpr int MODK = 32;
__device__ __forceinline__ void ph_mod_partial(const P& p, char* smem) {
    float* s = (float*)smem;
    const int tid = tid_opaque();
    for (int it = blockIdx.x; it < DEPTH * MODK * 3; it += gridDim.x) {
        const int l = it / (MODK * 3), kc = (it / 3) % MODK, jb = it % 3;
        __syncthreads();
        if (tid < 5 * 32) {
            const int r = tid / 32, kk = tid % 32, k = kc * 32 + kk;
            const float cv = (r < 4) ? p.c[r * DM + k] : p.c_ctx[k];
            s[tid] = cv / (1.0f + expf(-cv));
        }
        __syncthreads();
        const int j = jb * 2048 + tid * 4;
        f32x4 a0 = {0.f, 0.f, 0.f, 0.f}, a1 = a0, a2 = a0, a3 = a0, a4 = a0;
        const float* w = p.w_ada + ((size_t)l * DM + kc * 32) * NMOD + j;
#pragma unroll 8
        for (int kk = 0; kk < 32; ++kk) {
            const f32x4 wv = *(const f32x4*)(w + (size_t)kk * NMOD);
            a0 += wv * s[kk]; a1 += wv * s[32 + kk]; a2 += wv * s[64 + kk]; a3 += wv * s[96 + kk]; a4 += wv * s[128 + kk];
        }
        float* o = p.modp + ((size_t)(l * MODK + kc) * 5) * NMOD + j;
        *(f32x4*)o = a0; *(f32x4*)(o + NMOD) = a1; *(f32x4*)(o + 2 * NMOD) = a2; *(f32x4*)(o + 3 * NMOD) = a3; *(f32x4*)(o + 4 * NMOD) = a4;
    }
}

__device__ __forceinline__ void ph_filter_a(const P& p, char* smem) {
    float* zs = (float*)smem;
    float* h1s = zs + 8 * 36;
    const int tid = tid_opaque(), tt = tid >> 6, j = tid & 63;
    const int n0 = DEPTH * 512, n1 = DEPTH * 32;
    for (int it = blockIdx.x; it < n0 + n1; it += gridDim.x) {
        int l, ls, tg;
        if (it < n0) { ls = 0; l = it / 512; tg = it % 512; } else { ls = 1; l = (it - n0) / 32; tg = (it - n0) % 32; }
        const int L = ls ? CTXL : SEQ;
        const int t = tg * 8 + tt;
        __syncthreads();
        if (j < 33) {
            float f;
            if (j == 0) f = (float)t / (float)(L - 1);
            else {
                const int k = (j - 1) & 15;
                const float band = 1e-4f + (float)k * ((15.0f - 1e-4f) / 15.0f);
                const float w = 6.283185307179586f * (float)t / (float)L;
                const double ang = (double)band * (double)w;
                f = (j <= 16) ? (float)cos(ang) : (float)(-sin(ang));
            }
            zs[tt * 36 + j] = f;
        }
        __syncthreads();
        const float fr = p.flt_freq[l * 64 + j];
        float a = p.flt_b1[l * 64 + j];
        for (int i = 0; i < 33; ++i) a += zs[tt * 36 + i] * p.flt_w1[((size_t)l * 33 + i) * 64 + j];
        h1s[tt * 64 + j] = sinf(fr * a);
        __syncthreads();
        float a2 = p.flt_b2[l * 64 + j];
        for (int i = 0; i < 64; ++i) a2 += h1s[tt * 64 + i] * p.flt_w2[((size_t)l * 64 + i) * 64 + j];
        const float h2 = sinf(fr * a2);
        if (ls == 0) p.H2a[((size_t)l * SEQ + t) * 64 + j] = h2; else p.H2b[((size_t)l * CTXL + t) * 64 + j] = h2;
    }
}

typedef float f32x16 __attribute__((ext_vector_type(16)));
__device__ __forceinline__ void ph_filter_b2(const P& p, char* smem) {
    float* sA = (float*)smem;
    const int tid = tid_opaque(), lane = tid & 63, wv = tid >> 6, li = lane & 31, hf = lane >> 5;
    const int n0 = DEPTH * 128 * 8, n1 = DEPTH * 8 * 8;
    const float DA = -15.350567286626973f, DB = -3.0701134573253946f;
    for (int it = blockIdx.x; it < n0 + n1; it += gridDim.x) {
        int l, ls, tt, cg;
        if (it < n0) { ls = 0; l = it / 1024; tt = (it / 8) % 128; cg = it % 8; } else { const int i2 = it - n0; ls = 1; l = i2 / 64; tt = (i2 / 8) % 8; cg = i2 % 8; }
        const int L = ls ? CTXL : SEQ, t0 = tt * 32;
        const float* h2 = ls ? p.H2b + ((size_t)l * CTXL + t0) * 64 : p.H2a + ((size_t)l * SEQ + t0) * 64;
        __syncthreads();
        { const int r = tid >> 4, k4 = (tid & 15) * 4; const float4 v = *(const float4*)(h2 + r * 64 + k4); float* d = sA + r * 65 + k4; d[0] = v.x; d[1] = v.y; d[2] = v.z; d[3] = v.w; }
        __syncthreads();
        const int col = cg * 256 + wv * 32 + li;
        const float* wp = p.flt_w3 + (size_t)l * 64 * 2048 + col;
        f32x16 acc;
#pragma unroll
        for (int i = 0; i < 16; ++i) acc[i] = 0.f;
#pragma unroll 8
        for (int s2 = 0; s2 < 32; ++s2) {
            const int k = 2 * s2 + hf;
            acc = __builtin_amdgcn_mfma_f32_32x32x2f32(sA[li * 65 + k], wp[(size_t)k * 2048], acc, 0, 0, 0);
        }
        const int ch = col & 511;
        const float delta = fabsf(DA + (float)ch * ((DB - DA) / 511.0f));
        float q = 0.f;
        float* dst = (ls ? p.HT1 + ((size_t)l * 2048 + col) * CTXL : p.HT0 + ((size_t)l * 2048 + col) * SEQ) + t0 + 4 * hf;
#pragma unroll
        for (int g4 = 0; g4 < 4; ++g4) {
            float4 o;
            float* op = &o.x;
#pragma unroll
            for (int e = 0; e < 4; ++e) { const int t = t0 + 8 * g4 + 4 * hf + e; const float v = acc[4 * g4 + e] * expf(-((float)t / (float)(L - 1)) * delta); op[e] = v; q += v * v; }
            *(float4*)(dst + 8 * g4) = o;
        }
        q += shx(q, 32);
        if (hf == 0) { if (ls == 0) p.SSQ0[((size_t)l * 2048 + col) * 128 + tt] = q; else p.SSQ1[((size_t)l * 2048 + col) * 8 + tt] = q; }
    }
    __syncthreads();
}

__device__ __forceinline__ void ph_finalize(const P& p) {
    const int n_mod = DEPTH * 5 * NMOD, n_s = DEPTH * 2048;
    for (int i = blockIdx.x * NT + threadIdx.x; i < n_mod + 2 * n_s; i += gridDim.x * NT) {
        if (i < n_mod) {
            const int l = i / (5 * NMOD), r = (i / NMOD) % 5, j = i % NMOD;
            float a = p.b_ada[l * NMOD + j];
            for (int kc = 0; kc < MODK; ++kc) a += p.modp[((size_t)(l * MODK + kc) * 5 + r) * NMOD + j];
            p.mod[i] = a;
        } else if (i < n_mod + n_s) {
            const int k = i - n_mod; float a = 0.f;
            for (int q = 0; q < 128; ++q) a += p.SSQ0[(size_t)k * 128 + q];
            p.SCL0[k] = rsqrtf(a + epsf());
        } else {
            const int k = i - n_mod - n_s; float a = 0.f;
            for (int q = 0; q < 8; ++q) a += p.SSQ1[(size_t)k * 8 + q];
            p.SCL1[k] = rsqrtf(a + epsf());
        }
    }
}

__device__ __forceinline__ float rope_apply(float self, float partner, int d, int t) {
    const int a = d >> 4, s = (d >> 3) & 1, i = d & 7;
    const float pos = (float)(a == 0 ? (t >> 6) : (t & 63));
    const float inv = powf(10000.0f, -(float)i / 8.0f);
    const float ang = pos * inv;
    const float cs = cosf(ang), sn = sinf(ang);
    return s == 0 ? self * cs - partner * sn : partner * sn + self * cs;
}

namespace ge {
constexpr int BM = 256, BK = 64, HALF = 128, HTB = HALF * BK * 2, STAGE_BYTES = 8 * HTB, NXCD = 8, WGM = 8;
__device__ __forceinline__ int lds_byte(int r, int c) { const int st = (r >> 4) * 2 + (c >> 5), rr = r & 15, cc = c & 31, ob = rr * 64 + cc * 2; return st * 1024 + (ob ^ (((ob >> 9) & 1) << 5)); }
__device__ __forceinline__ void stage_rc(int b, int& R, int& C) { const int st = b / 1024, sb = b % 1024, swz = sb ^ (((sb >> 9) & 1) << 5); R = (st >> 1) * 16 + swz / 64; C = (st & 1) * 32 + (swz % 64) / 2; }
__device__ __forceinline__ int perm32(int rho) { const int n = rho >> 4, i = rho & 15; return 8 * (i >> 2) + 4 * n + (i & 3); }
__device__ __forceinline__ void tile_order(int L, int nM, int nN, int& pm, int& pn) {
    const int nwg = nM * nN; int wgid = L;
    { const int q = nwg / NXCD, r = nwg % NXCD, xcd = wgid % NXCD, off = wgid / NXCD; wgid = (xcd < r ? xcd * (q + 1) : r * (q + 1) + (xcd - r) * q) + off; }
    const int nig = WGM * nN, gid = wgid / nig, fm = gid * WGM, gsz = (nM - fm) < WGM ? (nM - fm) : WGM;
    pm = fm + ((wgid % nig) % gsz); pn = (wgid % nig) / gsz;
}
struct Unit { const char* a; const char* b0; const char* b1; const int* rows; int nrows; int pm, pn, kind; };
typedef f32x4 Acc[2][2][4][2];

template <bool GATHER, int ABLK = 0, class Sched, class Epi>
__device__ __forceinline__ void gemm_engine(LAS unsigned char* lds, const int lda, const int ldb, const int K, const Sched& S, const Epi& E) {
    const int tid = tid_opaque(), wid = __builtin_amdgcn_readfirstlane(tid >> 6), lane = tid & 63, wr = wid >> 2, wc = wid & 3, fr = lane & 15, fq = lane >> 4;
    const int nt = K / BK;
    int sR[2], sC[2];
    unsigned voffA[2], voffB[2];
#pragma unroll
    for (int i = 0; i < 2; ++i) { stage_rc(tid * 16 + i * 8192, sR[i], sC[i]); const int Rb = (sR[i] & ~31) + perm32(sR[i] & 31);
        voffA[i] = ABLK ? (unsigned)((sC[i] >> 3) * ABLK + sR[i]) * 16u : (unsigned)(sR[i] * lda + sC[i]) * 2u; voffB[i] = (unsigned)(Rb * ldb + sC[i]) * 2u; }
    const size_t kstep = (size_t)(BK * 2);
    const size_t hstepA = ABLK ? (size_t)HALF * 16 : (size_t)HALF * lda * 2;
    const size_t kstepA = ABLK ? (size_t)(BK / 8) * ABLK * 16 : kstep;
    const unsigned ldsw = (unsigned)wid * 1024u;
    const int aoff = lds_byte(wr * 64 + fr, fq * 8), boff = lds_byte(wc * 32 + fr, fq * 8);
    unsigned gvc[2][2], gvn[2][2];
#define GE_SA(b, h) (((b) * 2 + (h)) * HTB)
#define GE_SB(b, h) ((4 + (b) * 2 + (h)) * HTB)
#define GE_GLDS(src, bufoff, i) __builtin_amdgcn_global_load_lds((const unsigned*)(src), (LAS unsigned*)(lds + (bufoff) + ldsw + (i) * 8192), 16, 0, 0)
#define GE_STAGE_B(bufoff, bp) do { _Pragma("unroll") for (int _i = 0; _i < 2; ++_i) GE_GLDS((bp) + voffB[_i], bufoff, _i); } while (0)
#define GE_STAGE_A(bufoff, ap, h, gv) do { _Pragma("unroll") for (int _i = 0; _i < 2; ++_i) { \
        if constexpr (GATHER) GE_GLDS((ap) + (gv)[h][_i], bufoff, _i); else GE_GLDS((ap) + (size_t)(h) * hstepA + voffA[_i], bufoff, _i); } } while (0)
#define GE_STAGE_A2(bufoff, ap, h) do { _Pragma("unroll") for (int _i = 0; _i < 2; ++_i) { \
        if constexpr (GATHER) GE_GLDS((ap) + (last ? gvn[h][_i] : gvc[h][_i]), bufoff, _i); else GE_GLDS((ap) + (size_t)(h) * hstepA + voffA[_i], bufoff, _i); } } while (0)
#define GE_LDA(dst, b, h) do { _Pragma("unroll") for (int m = 0; m < 4; ++m) _Pragma("unroll") for (int k = 0; k < 2; ++k) dst[m][k] = *(const LAS bf16x8*)(lds + GE_SA(b, h) + aoff + m * 2048 + k * 1024); } while (0)
#define GE_LDB(dst, b, h) do { _Pragma("unroll") for (int n = 0; n < 2; ++n) _Pragma("unroll") for (int k = 0; k < 2; ++k) dst[n][k] = *(const LAS bf16x8*)(lds + GE_SB(b, h) + boff + n * 2048 + k * 1024); } while (0)
#define GE_MMA(ai, bj, At, Bt) do { __builtin_amdgcn_s_setprio(1); _Pragma("unroll") for (int m = 0; m < 4; ++m) _Pragma("unroll") for (int n = 0; n < 2; ++n) _Pragma("unroll") for (int k = 0; k < 2; ++k) \
        acc[ai][bj][m][n] = __builtin_amdgcn_mfma_f32_16x16x32_bf16(Bt[n][k], At[m][k], acc[ai][bj][m][n], 0, 0, 0); __builtin_amdgcn_s_setprio(0); } while (0)
#define GE_WAIT_V(n) asm volatile("s_waitcnt vmcnt(" #n ")" ::: "memory")
#define GE_WAIT_L(n) asm volatile("s_waitcnt lgkmcnt(" #n ")" ::: "memory")
#define GE_BAR __builtin_amdgcn_s_barrier()
#define GE_SCHED __builtin_amdgcn_sched_barrier(0)
#define GE_GATHER_OFFS(gv, u) do { if constexpr (GATHER) { _Pragma("unroll") for (int _h = 0; _h < 2; ++_h) _Pragma("unroll") for (int _i = 0; _i < 2; ++_i) { \
        int _r = (u).pm * BM + _h * HALF + sR[_i]; _r = _r < (u).nrows ? _r : (u).nrows - 1; (gv)[_h][_i] = (unsigned)((u).rows[_r] * lda + sC[_i]) * 2u; } } } while (0)
    Unit cur, nxt; int ui = 0;
    if (!S.next(0, cur)) return;
    Acc acc;
#pragma unroll
    for (int a = 0; a < 2; ++a)
#pragma unroll
        for (int b = 0; b < 2; ++b)
#pragma unroll
            for (int m = 0; m < 4; ++m)
#pragma unroll
                for (int n = 0; n < 2; ++n) acc[a][b][m][n] = (f32x4){0.f, 0.f, 0.f, 0.f};
    bf16x8 At[4][2], B0[2][2], B1[2][2];
    GE_GATHER_OFFS(gvc, cur);
    GE_STAGE_B(GE_SB(0, 0), cur.b0); GE_STAGE_A(GE_SA(0, 0), cur.a, 0, gvc); GE_STAGE_B(GE_SB(0, 1), cur.b1); GE_STAGE_A(GE_SA(0, 1), cur.a, 1, gvc);
    if (wr == 1) GE_BAR;
    GE_WAIT_V(4); GE_BAR;
    GE_STAGE_B(GE_SB(1, 0), cur.b0 + kstep); GE_STAGE_A(GE_SA(1, 0), cur.a + kstepA, 0, gvc); GE_STAGE_B(GE_SB(1, 1), cur.b1 + kstep);
    GE_WAIT_V(6); GE_BAR;
    for (;;) {
        const bool has_next = S.next(ui + 1, nxt);
        if (!has_next) nxt = cur;
        if constexpr (GATHER) { if (has_next) { GE_GATHER_OFFS(gvn, nxt); } else {
#pragma unroll
            for (int h = 0; h < 2; ++h)
#pragma unroll
                for (int i = 0; i < 2; ++i) gvn[h][i] = gvc[h][i]; } }
#pragma unroll 1
        for (int t = 0; t < nt; t += 2) {
            const bool last = (t == nt - 2);
            const char* a1 = cur.a + (size_t)(t + 1) * kstepA;
            const char* a2 = last ? nxt.a : cur.a + (size_t)(t + 2) * kstepA;
            const char* b20 = last ? nxt.b0 : cur.b0 + (size_t)(t + 2) * kstep;
            const char* b21 = last ? nxt.b1 : cur.b1 + (size_t)(t + 2) * kstep;
            const char* a3 = a2 + kstepA; const char* b30 = b20 + kstep; const char* b31 = b21 + kstep;
            GE_LDB(B0, 0, 0); GE_SCHED; GE_LDA(At, 0, 0); GE_STAGE_A(GE_SA(1, 1), a1, 1, gvc);
            GE_WAIT_L(8); GE_BAR; GE_WAIT_L(0); GE_MMA(0, 0, At, B0); GE_BAR; GE_SCHED;
            GE_LDB(B1, 0, 1); GE_STAGE_B(GE_SB(0, 0), b20);
            GE_BAR; GE_WAIT_L(0); GE_MMA(0, 1, At, B1); GE_BAR;
            GE_LDA(At, 0, 1); GE_STAGE_A2(GE_SA(0, 0), a2, 0);
            GE_BAR; GE_WAIT_L(0); GE_MMA(1, 0, At, B0); GE_BAR; GE_SCHED;
            GE_STAGE_B(GE_SB(0, 1), b21);
            GE_WAIT_V(6); GE_BAR; GE_MMA(1, 1, At, B1); GE_BAR;
            GE_LDB(B0, 1, 0); GE_SCHED; GE_LDA(At, 1, 0); GE_STAGE_A2(GE_SA(0, 1), a2, 1);
            GE_WAIT_L(8); GE_BAR; GE_WAIT_L(0); GE_MMA(0, 0, At, B0); GE_BAR; GE_SCHED;
            GE_LDB(B1, 1, 1); GE_STAGE_B(GE_SB(1, 0), b30);
            GE_BAR; GE_WAIT_L(0); GE_MMA(0, 1, At, B1); GE_BAR;
            GE_LDA(At, 1, 1); GE_STAGE_A2(GE_SA(1, 0), a3, 0);
            GE_BAR; GE_WAIT_L(0); GE_MMA(1, 0, At, B0); GE_BAR; GE_SCHED;
            GE_STAGE_B(GE_SB(1, 1), b31);
            GE_WAIT_V(6); GE_BAR; GE_MMA(1, 1, At, B1); GE_BAR;
        }
        E(acc, cur, wr, wc, fr, fq);
        if (!has_next) break;
#pragma unroll
        for (int a = 0; a < 2; ++a)
#pragma unroll
            for (int b = 0; b < 2; ++b)
#pragma unroll
                for (int m = 0; m < 4; ++m)
#pragma unroll
                    for (int n = 0; n < 2; ++n) acc[a][b][m][n] = (f32x4){0.f, 0.f, 0.f, 0.f};
        cur = nxt; ++ui;
        if constexpr (GATHER) {
#pragma unroll
            for (int h = 0; h < 2; ++h)
#pragma unroll
                for (int i = 0; i < 2; ++i) gvc[h][i] = gvn[h][i]; }
    }
    GE_WAIT_V(0);
    if (wr == 0) GE_BAR;
    GE_BAR;
#undef GE_SA
#undef GE_SB
#undef GE_GLDS
#undef GE_STAGE_A
#undef GE_STAGE_A2
#undef GE_STAGE_B
#undef GE_LDA
#undef GE_LDB
#undef GE_MMA
#undef GE_WAIT_V
#undef GE_WAIT_L
#undef GE_BAR
#undef GE_SCHED
#undef GE_GATHER_OFFS
}
}
__device__ __forceinline__ unsigned cvt_pk_bf16(float lo, float hi) { unsigned r; asm volatile("v_cvt_pk_bf16_f32 %0, %1, %2" : "=v"(r) : "v"(lo), "v"(hi)); return r; }
__device__ __forceinline__ u32x4 pack8(const f32x4 a, const f32x4 b) { u32x4 w; w.x = cvt_pk_bf16(a[0], a[1]); w.y = cvt_pk_bf16(a[2], a[3]); w.z = cvt_pk_bf16(b[0], b[1]); w.w = cvt_pk_bf16(b[2], b[3]); return w; }
__device__ __forceinline__ void unpack8(const u32x4 w, f32x4& a, f32x4& b) {
    a[0] = __uint_as_float(w.x << 16); a[1] = __uint_as_float(w.x & 0xFFFF0000u); a[2] = __uint_as_float(w.y << 16); a[3] = __uint_as_float(w.y & 0xFFFF0000u);
    b[0] = __uint_as_float(w.z << 16); b[1] = __uint_as_float(w.z & 0xFFFF0000u); b[2] = __uint_as_float(w.w << 16); b[3] = __uint_as_float(w.w & 0xFFFF0000u); }
__device__ __forceinline__ float sigmoidf_fast(float v) { return 1.0f / (1.0f + __expf(-v)); }

struct SchedDense {
    const char* A; const char* B; size_t arb, brb; int nM, nN, G, c;
    __device__ __forceinline__ bool next(int i, ge::Unit& u) const {
        const int L = i * G + c; if (L >= nM * nN) return false;
        int pm, pn; ge::tile_order(L, nM, nN, pm, pn);
        u.pm = pm; u.pn = pn; u.kind = 0; u.rows = nullptr; u.nrows = 0;
        u.a = A + (size_t)pm * 256 * arb; u.b0 = B + (size_t)pn * 256 * brb; u.b1 = u.b0 + 128 * brb; return true;
    }
};
struct SchedInproj {
    const char* WtHy; const char* WtRest; const char* U; int G, c;
    __device__ __forceinline__ bool next(int i, ge::Unit& u) const {
        const int L = i * G + c; if (L >= 408 + 748) return false;
        int pm, pn; u.rows = nullptr; u.nrows = 0;
        if (L < 408) { ge::tile_order(L, 6, 68, pm, pn); u.kind = 0; u.a = WtHy + (size_t)pm * 256 * 2048; u.b0 = U + (size_t)pn * 256 * 2048; }
        else { ge::tile_order(L - 408, 68, 11, pm, pn); u.kind = 1; u.a = U + (size_t)pm * 256 * 2048; u.b0 = WtRest + (size_t)pn * 256 * 2048; }
        u.b1 = u.b0 + 128 * 2048; u.pm = pm; u.pn = pn; return true;
    }
};
struct EpiInproj {
    bf16_t* PT; bf16_t* PTc; bf16_t* G;
    __device__ __forceinline__ void operator()(const ge::Acc& acc, const ge::Unit& u, int wr, int wc, int fr, int fq) const {
#pragma unroll
        for (int ai = 0; ai < 2; ++ai)
#pragma unroll
            for (int m = 0; m < 4; ++m) {
                const int r = u.pm * 256 + ai * 128 + wr * 64 + m * 16 + fr;
#pragma unroll
                for (int bj = 0; bj < 2; ++bj) {
                    const int c0 = bj * 128 + wc * 32 + fq * 8;
                    if (u.kind == 0) {
                        bf16_t* dst = (u.pn < 64) ? PT + ((size_t)((u.pn >> 4) * HYC + r)) * SEQ + (u.pn & 15) * 256 + c0
                                                  : PTc + ((size_t)((u.pn - 64) * HYC + r)) * CTXL + c0;
                        *(u32x4*)dst = pack8(acc[ai][bj][m][0], acc[ai][bj][m][1]);
                    } else {
                        const int c = (u.pn - 3) * 256 + c0;
                        f32x4 a = acc[ai][bj][m][0], b = acc[ai][bj][m][1];
#pragma unroll
                        for (int j = 0; j < 4; ++j) { a[j] = sigmoidf_fast(a[j]); b[j] = sigmoidf_fast(b[j]); }
                        *(u32x4*)(G + (size_t)r * 2048 + c) = pack8(a, b);
                    }
                }
            }
    }
};
struct EpiQ {
    bf16_t* Q; bf16_t* Qc; const LAS float* rope;
    const LAS float* rs;
    __device__ __forceinline__ void operator()(const ge::Acc& acc, const ge::Unit& u, int wr, int wc, int fr, int fq) const {
#pragma unroll
        for (int ai = 0; ai < 2; ++ai)
#pragma unroll
            for (int m = 0; m < 4; ++m) {
                const int r = u.pm * 256 + ai * 128 + wr * 64 + m * 16 + fr;
                const bool lat = r < TL;
                const int t = lat ? (r & 4095) : ((r - TL) & 255);
                const int b = lat ? (r >> 12) : ((r - TL) >> 8);
#pragma unroll
                for (int bj = 0; bj < 2; ++bj) {
                    const int c = u.pn * 256 + bj * 128 + wc * 32 + fq * 8;
                    const int h = c / 96, dd = c - h * 96;
                    const float rsc = QSCALE * rs[ai * 128 + wr * 64 + m * 16 + fr];
                    f32x4 v0 = acc[ai][bj][m][0] * rsc, v1 = acc[ai][bj][m][1] * rsc;
                    f32x4 p0, p1;
#pragma unroll
                    for (int j = 0; j < 4; ++j) { p0[j] = shx(v0[j], 16); p1[j] = shx(v1[j], 16); }
                    bf16_t* qrow = lat ? Q + ((size_t)(b * NH + h) * SEQ + t) * 128 : Qc + ((size_t)(b * NH + h) * CTXL + t) * 128;
                    if (dd < 64) *(u32x4*)(qrow + dd) = pack8(v0, v1);
                    else {
                        const int d0 = dd - 64;
                        f32x4 o0 = v0, o1 = v1;
                        if (lat) {
                            const LAS float* rp = rope + 2 * ((d0 >> 4) ? 32 + (t & 63) * 8 : ((t >> 6) & 3) * 8);
                            const bool s1 = (d0 >> 3) & 1;
#pragma unroll
                            for (int j = 0; j < 4; ++j) {
                                const float cax = rp[2 * j], cay = rp[2 * j + 1], cbx = rp[8 + 2 * j], cby = rp[9 + 2 * j];
                                o0[j] = s1 ? p0[j] * cay + v0[j] * cax : v0[j] * cax - p0[j] * cay;
                                o1[j] = s1 ? p1[j] * cby + v1[j] * cbx : v1[j] * cbx - p1[j] * cby;
                            }
                        }
                        *(u32x4*)(qrow + 64 + d0) = pack8(o0, o1);
                        *(u32x4*)(qrow + 96 + d0) = pack8(v0, v1);
                    }
                }
            }
    }
};
struct EpiKV {
    bf16_t* K; bf16_t* V; const LAS float* rs;
    __device__ __forceinline__ void operator()(const ge::Acc& acc, const ge::Unit& u, int wr, int wc, int fr, int fq) const {
#pragma unroll
        for (int ai = 0; ai < 2; ++ai)
#pragma unroll
            for (int m = 0; m < 4; ++m) {
                const int r = u.pm * 256 + ai * 128 + wr * 64 + m * 16 + fr;
                int b, key;
                if (r < TL) { b = r >> 12; key = r & 4095; } else { b = (r - TL) >> 8; key = SEQ + ((r - TL) & 255); }
#pragma unroll
                for (int bj = 0; bj < 2; ++bj) {
                    const int c = u.pn * 256 + bj * 128 + wc * 32 + fq * 8;
                    const int h = c >> 7, d = c & 127;
                    const size_t kb = (size_t)(b * NH + h) * NKEY + key;
                    bf16_t* dst = (d < 64) ? K + kb * DQK + d : V + kb * DV + (d - 64);
                    const float rk = rs[ai * 128 + wr * 64 + m * 16 + fr]; *(u32x4*)dst = pack8(acc[ai][bj][m][0] * rk, acc[ai][bj][m][1] * rk);
                }
            }
    }
};

constexpr int LDS_SSQ = ge::STAGE_BYTES + 2048;
struct EpiInprojMLA {
    bf16_t* PMLAb; bf16_t* K; const float2* rope; LAS float* ssq;
    __device__ __forceinline__ void operator()(const ge::Acc& acc, const ge::Unit& u, int wr, int wc, int fr, int fq) const {
#pragma unroll
        for (int ai = 0; ai < 2; ++ai)
#pragma unroll
            for (int m = 0; m < 4; ++m) {
                const int rl = ai * 128 + wr * 64 + m * 16 + fr, r = u.pm * 256 + rl;
#pragma unroll
                for (int bj = 0; bj < 2; ++bj) {
                    const int c0 = bj * 128 + wc * 32 + fq * 8;
                    const f32x4 a = acc[ai][bj][m][0], b = acc[ai][bj][m][1];
                    const bool isval = (u.pn < 2) || (bj == 0);
                    const bool isrope = (u.pn == 2) && (bj == 1) && (wc == 0);
                    if (isval) {
                        const int col = (u.pn == 0 ? 0 : (u.pn == 1 ? 256 : 512)) + c0;
                        *(u32x4*)(PMLAb + (size_t)r * 640 + col) = pack8(a, b);
                        float sq = (a[0] * a[0] + a[1] * a[1]) + (a[2] * a[2] + a[3] * a[3]) + (b[0] * b[0] + b[1] * b[1]) + (b[2] * b[2] + b[3] * b[3]);
                        sq += shx(sq, 16); sq += shx(sq, 32);
                        if (fq == 0) ssq[rl * 16 + (u.pn == 2 ? 8 : 0) + bj * 4 + wc] = sq;
                    } else if (isrope) {
                        f32x4 pa, pb;
#pragma unroll
                        for (int j = 0; j < 4; ++j) { pa[j] = shx(a[j], 16); pb[j] = shx(b[j], 16); }
                        int bb, key; f32x4 oa = a, ob = b;
                        if (r < TL) {
                            bb = r >> 12; key = r & 4095;
                            const float2* rp = rope + (size_t)key * 16 + (fq >> 1) * 8;
#pragma unroll
                            for (int j = 0; j < 4; ++j) { const float2 ca = rp[j], cb = rp[4 + j];
                                oa[j] = (fq & 1) ? pa[j] * ca.y + a[j] * ca.x : a[j] * ca.x - pa[j] * ca.y;
                                ob[j] = (fq & 1) ? pb[j] * cb.y + b[j] * cb.x : b[j] * cb.x - pb[j] * cb.y; }
                        } else { bb = (r - TL) >> 8; key = SEQ + ((r - TL) & 255); }
                        const u32x4 w = pack8(oa, ob);
#pragma unroll
                        for (int h = 0; h < NH; ++h) *(u32x4*)(K + ((size_t)(bb * NH + h) * NKEY + key) * DQK + 64 + fq * 8) = w;
                    }
                }
            }
    }
};
struct SchedChainIn {
    const char* U; const char* WtRest; int pm, pn0, npn;
    __device__ __forceinline__ bool next(int i, ge::Unit& u) const {
        if (i >= npn) return false;
        u.pm = pm; u.pn = pn0 + i; u.kind = 1; u.rows = nullptr; u.nrows = 0;
        u.a = U + (size_t)pm * 256 * 2048; u.b0 = WtRest + (size_t)u.pn * 256 * 2048; u.b1 = u.b0 + 128 * 2048; return true;
    }
};
struct SchedPanel {
    const char* A; const char* B; size_t arb, brb; int pm, nN, kind;
    __device__ __forceinline__ bool next(int i, ge::Unit& u) const {
        if (i >= nN) return false;
        u.pm = pm; u.pn = i; u.kind = kind; u.rows = nullptr; u.nrows = 0;
        u.a = A + (size_t)pm * 256 * arb; u.b0 = B + (size_t)i * 256 * brb; u.b1 = u.b0 + 128 * brb; return true;
    }
};
struct SchedPool {
    const char* WtHy; const char* WtRest; const char* U; int first, step, n;
    __device__ __forceinline__ bool next(int i, ge::Unit& u) const {
        if (i >= n) return false;
        const int X = first + i * step; int pm, pn; u.rows = nullptr; u.nrows = 0;
        if (X < 408) { ge::tile_order(X, 6, 68, pm, pn); u.kind = 0; u.a = WtHy + (size_t)pm * 256 * 2048; u.b0 = U + (size_t)pn * 256 * 2048; }
        else { ge::tile_order(X - 408, 68, 8, pm, pn); pn += 3; u.kind = 1; u.a = U + (size_t)pm * 256 * 2048; u.b0 = WtRest + (size_t)pn * 256 * 2048; }
        u.b1 = u.b0 + 128 * 2048; u.pm = pm; u.pn = pn; return true;
    }
};
struct EpiQKV {
    EpiQ q; EpiKV kv;
    __device__ __forceinline__ void operator()(const ge::Acc& acc, const ge::Unit& u, int wr, int wc, int fr, int fq) const { if (u.kind == 0) q(acc, u, wr, wc, fr, fq); else kv(acc, u, wr, wc, fr, fq); }
};
struct SchedMerge {
    const char* Yhy; const char* Yatt; const char* Whyo; const char* Wmlao; int G, c, nM;
    __device__ __forceinline__ bool next(int i, ge::Unit& u) const {
        const int T = (i >> 1) * G + c; if (T >= nM * 4) return false;
        const int seg = i & 1; int pm, pn; ge::tile_order(T, nM, 4, pm, pn);
        u.pm = pm; u.pn = pn; u.kind = seg; u.rows = nullptr; u.nrows = 0;
        u.a = (seg ? Yatt : Yhy) + (size_t)pm * 256 * 16; u.b0 = (seg ? Wmlao : Whyo) + (size_t)pn * 256 * 1024; u.b1 = u.b0 + 128 * 1024; return true;
    }
};
struct EpiMerge {
    const bf16_t* G; bf16_t* M1;
    __device__ __forceinline__ void operator()(const ge::Acc& acc, const ge::Unit& u, int wr, int wc, int fr, int fq) const {
#pragma unroll
        for (int ai = 0; ai < 2; ++ai) {
            u32x4 gv[4][2], mv[4][2];
#pragma unroll
            for (int m = 0; m < 4; ++m) {
                const int r = u.pm * 256 + ai * 128 + wr * 64 + m * 16 + fr;
#pragma unroll
                for (int bj = 0; bj < 2; ++bj) {
                    const int c = u.pn * 256 + bj * 128 + wc * 32 + fq * 8;
                    gv[m][bj] = *(const u32x4*)(G + (size_t)r * 2048 + u.kind * DM + c);
                    if (u.kind) mv[m][bj] = *(const u32x4*)(M1 + (size_t)r * DM + c);
                }
            }
#pragma unroll
            for (int m = 0; m < 4; ++m) {
                const int r = u.pm * 256 + ai * 128 + wr * 64 + m * 16 + fr;
#pragma unroll
                for (int bj = 0; bj < 2; ++bj) {
                    const int c = u.pn * 256 + bj * 128 + wc * 32 + fq * 8;
                    f32x4 g0, g1; unpack8(gv[m][bj], g0, g1);
                    f32x4 o0 = g0 * acc[ai][bj][m][0], o1 = g1 * acc[ai][bj][m][1];
                    if (u.kind) { f32x4 q0, q1; unpack8(mv[m][bj], q0, q1); o0 += q0; o1 += q1; }
                    *(u32x4*)(M1 + (size_t)r * DM + c) = pack8(o0, o1);
                }
            }
        }
    }
};
struct EpiOut {
    float* hx; const float* mod;
    __device__ __forceinline__ void operator()(const ge::Acc& acc, const ge::Unit& u, int wr, int wc, int fr, int fq) const {
        const int b = u.pm < 64 ? (u.pm >> 4) : 4;
        f32x4 gg[2][2];
#pragma unroll
        for (int bj = 0; bj < 2; ++bj) { const float* g = mod + (size_t)b * NMOD + 2 * DM + u.pn * 256 + bj * 128 + wc * 32 + fq * 8; gg[bj][0] = *(const f32x4*)g; gg[bj][1] = *(const f32x4*)(g + 4); }
#pragma unroll
        for (int ai = 0; ai < 2; ++ai) {
            f32x4 hv[4][2][2];
#pragma unroll
            for (int m = 0; m < 4; ++m) {
                const int r = u.pm * 256 + ai * 128 + wr * 64 + m * 16 + fr;
#pragma unroll
                for (int bj = 0; bj < 2; ++bj) { const float* src = hx + (size_t)r * DM + u.pn * 256 + bj * 128 + wc * 32 + fq * 8; hv[m][bj][0] = *(const f32x4*)src; hv[m][bj][1] = *(const f32x4*)(src + 4); }
            }
#pragma unroll
            for (int m = 0; m < 4; ++m) {
                const int r = u.pm * 256 + ai * 128 + wr * 64 + m * 16 + fr;
#pragma unroll
                for (int bj = 0; bj < 2; ++bj) {
                    float* dst = hx + (size_t)r * DM + u.pn * 256 + bj * 128 + wc * 32 + fq * 8;
                    *(f32x4*)dst = hv[m][bj][0] + gg[bj][0] * acc[ai][bj][m][0];
                    *(f32x4*)(dst + 4) = hv[m][bj][1] + gg[bj][1] * acc[ai][bj][m][1];
                }
            }
        }
    }
};
struct SchedGU {
    const char* U; const char* WtG; const char* WtU; const int* list; const LAS int* tpre; const LAS int* cntl; int G, c;
    __device__ __forceinline__ bool next(int i, ge::Unit& u) const {
        const int L = i * G + ((G & 7) ? c : (c & 7) * (G >> 3) + (c >> 3)); if (L >= 2 * tpre[64]) return false;
        const int rt = L >> 1, half = L & 1; int e = 0;
#pragma unroll
        for (int st_ = 32; st_ > 0; st_ >>= 1) { if (tpre[e + st_] <= rt) e += st_; }
        u.kind = e; u.pm = rt - tpre[e]; u.pn = half; u.rows = list + (size_t)e * CAP; u.nrows = cntl[e];
        u.a = U; u.b0 = WtG + ((size_t)e * DE + half * 128) * 2048; u.b1 = WtU + ((size_t)e * DE + half * 128) * 2048; return true;
    }
};
struct EpiGU {
    bf16_t* H; const LAS int* offs;
    __device__ __forceinline__ void operator()(const ge::Acc& acc, const ge::Unit& u, int wr, int wc, int fr, int fq) const {
        const int o = offs[u.kind];
#pragma unroll
        for (int ai = 0; ai < 2; ++ai)
#pragma unroll
            for (int m = 0; m < 4; ++m) {
                const int r = u.pm * 256 + ai * 128 + wr * 64 + m * 16 + fr;
                if (r < u.nrows) {
                    const int c = u.pn * 128 + wc * 32 + fq * 8;
                    f32x4 g0 = acc[ai][0][m][0], g1 = acc[ai][0][m][1];
#pragma unroll
                    for (int j = 0; j < 4; ++j) { g0[j] = g0[j] * sigmoidf_fast(g0[j]) * acc[ai][1][m][0][j]; g1[j] = g1[j] * sigmoidf_fast(g1[j]) * acc[ai][1][m][1][j]; }
                    *(u32x4*)(H + (size_t)(o + r) * DE + c) = pack8(g0, g1);
                }
            }
    }
};
struct SchedDown {
    const char* H; const char* WtD; const LAS int* tpre; const LAS int* cntl; const LAS int* offs; int G, c;
    __device__ __forceinline__ bool next(int i, ge::Unit& u) const {
        const int L = i * G + ((G & 7) ? c : (c & 7) * (G >> 3) + (c >> 3)); if (L >= 4 * tpre[64]) return false;
        const int rt = L >> 2, pn = L & 3; int e = 0;
#pragma unroll
        for (int st_ = 32; st_ > 0; st_ >>= 1) { if (tpre[e + st_] <= rt) e += st_; }
        u.kind = e; u.pm = rt - tpre[e]; u.pn = pn; u.rows = nullptr; u.nrows = cntl[e];
        u.a = H + ((size_t)offs[e] + (size_t)u.pm * 256) * 512; u.b0 = WtD + ((size_t)e * DM + pn * 256) * 512; u.b1 = u.b0 + 128 * 512; return true;
    }
};
struct EpiDown {
    bf16_t* Y; const float* wl; const LAS int* offs;
    __device__ __forceinline__ void operator()(const ge::Acc& acc, const ge::Unit& u, int wr, int wc, int fr, int fq) const {
        const int o = offs[u.kind];
        float w[2][4];
#pragma unroll
        for (int ai = 0; ai < 2; ++ai)
#pragma unroll
            for (int m = 0; m < 4; ++m) { const int r = u.pm * 256 + ai * 128 + wr * 64 + m * 16 + fr; w[ai][m] = wl[(size_t)u.kind * CAP + (r < u.nrows ? r : 0)]; }
#pragma unroll
        for (int ai = 0; ai < 2; ++ai)
#pragma unroll
            for (int m = 0; m < 4; ++m) {
                const int r = u.pm * 256 + ai * 128 + wr * 64 + m * 16 + fr;
                if (r < u.nrows) {
#pragma unroll
                    for (int bj = 0; bj < 2; ++bj) {
                        const int c = u.pn * 256 + bj * 128 + wc * 32 + fq * 8;
                        *(u32x4*)(Y + (size_t)(o + r) * DM + c) = pack8(acc[ai][bj][m][0] * w[ai][m], acc[ai][bj][m][1] * w[ai][m]);
                    }
                }
            }
    }
};


typedef short s16x4 __attribute__((ext_vector_type(4)));
#define AT_THR 8.0f
__device__ __forceinline__ void ph_attn2(const P& p, char* smem, bool with_ctx) {
    constexpr int KS = 112, VS = 80;
    constexpr int NSTG = NKEY / 128;
    bf16_t* sK = (bf16_t*)smem;
    bf16_t* sV = sK + 3 * 128 * KS;
    const int tid = tid_opaque(), lane = tid & 63, wv = tid >> 6, fr = lane & 15, g = lane >> 4;
    const int NUL = NB * NH * 16, NUC = with_ctx ? NB * NH : 0;
    const int kc0 = tid / 12, kp0 = tid % 12, kc1 = (512 + tid) / 12, kp1 = (512 + tid) % 12;
    const int vk = tid >> 3, vp = tid & 7;
#define AT_LOADK(st_, hs_) do { const bf16_t* kb_ = Kp + (size_t)((st_) * 128 + (hs_) * 64) * DQK; kr0 = *(const u32x4*)(kb_ + kc0 * DQK + kp0 * 8); if (tid < 256) kr1 = *(const u32x4*)(kb_ + kc1 * DQK + kp1 * 8); } while (0)
#define AT_LOADV(st_, hs_) do { vr0 = *(const u32x4*)(Vp + (size_t)((st_) * 128 + (hs_) * 64) * DV + vk * DV + vp * 8); } while (0)
#define AT_STOREK(buf_, hs_) do { bf16_t* d_ = sK + ((buf_) * 128 + (hs_) * 64) * KS; *(u32x4*)(d_ + kc0 * KS + kp0 * 8) = kr0; if (tid < 256) *(u32x4*)(d_ + kc1 * KS + kp1 * 8) = kr1; } while (0)
#define AT_STOREV(buf_, hs_) do { *(u32x4*)(sV + ((buf_) * 128 + (hs_) * 64) * VS + vk * VS + vp * 8) = vr0; } while (0)
#define AT_LDKF(dst, mk) do { _Pragma("unroll") for (int ks = 0; ks < 3; ++ks) dst[ks] = *(const bf16x8*)(sKn + (mk) * 16 * KS + ks * 32); } while (0)
#define AT_MMAS(src, mk) do { sN[mk][0] = (f32x4){0.f, 0.f, 0.f, 0.f}; sN[mk][1] = (f32x4){0.f, 0.f, 0.f, 0.f}; \
        _Pragma("unroll") for (int ks = 0; ks < 3; ++ks) _Pragma("unroll") for (int nq = 0; nq < 2; ++nq) { const bf16x8 bq_ = (ks < 2) ? qf[nq][ks] : (ctxn ? qf[nq][3] : qf[nq][2]); \
            sN[mk][nq] = __builtin_amdgcn_mfma_f32_16x16x32_bf16(src[ks], bq_, sN[mk][nq], 0, 0, 0); } } while (0)
#define AT_EXPS(nq) do { float r_ = (nq) ? rs[0] - rs[0] : 0.f; _Pragma("unroll") for (int mk = 0; mk < 4; ++mk) _Pragma("unroll") for (int r = 0; r < 4; ++r) { const float pv = __builtin_amdgcn_exp2f(sC[mk][nq][r] - mn[nq]); r_ += pv; sC[mk][nq][r] = pv; } rs[nq] = r_; } while (0)
#define AT_SUBTILE(sKn_, ctxn_, sVb_) do { \
        const bf16_t* sKn = (sKn_) + fr * KS + g * 8; const bool ctxn = (ctxn_); \
        bf16x8 kfA[3], kfB[3]; bf16x8 pf[2][2]; float mn[2], mxq[2], rs[2]; \
        AT_LDKF(kfA, 0); \
        AT_MMAS(kfA, 0); AT_LDKF(kfB, 1); \
        _Pragma("unroll") for (int nq = 0; nq < 2; ++nq) { float mx = sC[0][nq][0]; \
            _Pragma("unroll") for (int mk = 0; mk < 4; ++mk) _Pragma("unroll") for (int r = 0; r < 4; ++r) mx = fmaxf(mx, sC[mk][nq][r]); \
            mxq[nq] = rowmax4(mx); } \
          \
          \
        if (__any((mxq[0] - m[0] > AT_THR) || (mxq[1] - m[1] > AT_THR))) { \
            _Pragma("unroll") for (int nq = 0; nq < 2; ++nq) { const float mnew_ = fmaxf(m[nq], mxq[nq]); const float a_ = __builtin_amdgcn_exp2f(m[nq] - mnew_); m[nq] = mnew_; lsum[nq] *= a_; \
                _Pragma("unroll") for (int md = 0; md < 4; ++md) oT[md][nq] *= a_; } } \
        mn[0] = m[0]; mn[1] = m[1]; \
        __builtin_amdgcn_sched_barrier(0); \
        AT_MMAS(kfB, 1); AT_LDKF(kfA, 2); AT_EXPS(0); \
        __builtin_amdgcn_sched_barrier(0); \
        AT_MMAS(kfA, 2); AT_LDKF(kfB, 3); AT_EXPS(1); \
        __builtin_amdgcn_sched_barrier(0); \
        AT_MMAS(kfB, 3); \
        _Pragma("unroll") for (int nq = 0; nq < 2; ++nq) { lsum[nq] += rs[nq]; \
            _Pragma("unroll") for (int kp = 0; kp < 2; ++kp) { const u32x4 w_ = pack8(sC[2 * kp][nq], sC[2 * kp + 1][nq]); pf[kp][nq] = __builtin_bit_cast(bf16x8, w_); } } \
        __builtin_amdgcn_sched_barrier(0); \
        _Pragma("unroll") for (int kp = 0; kp < 2; ++kp) _Pragma("unroll") for (int md = 0; md < 4; ++md) { \
            const bf16_t* a0_ = (sVb_) + (32 * kp + 4 * g + (fr >> 2)) * VS + 16 * md + 4 * (fr & 3); \
            const s16x4 lo_ = __builtin_amdgcn_ds_read_tr16_b64_v4i16((LAS s16x4*)a0_); \
            const s16x4 hi_ = __builtin_amdgcn_ds_read_tr16_b64_v4i16((LAS s16x4*)(a0_ + 16 * VS)); \
            const bf16x8 vf_ = __builtin_shufflevector(lo_, hi_, 0, 1, 2, 3, 4, 5, 6, 7); \
            _Pragma("unroll") for (int nq = 0; nq < 2; ++nq) oT[md][nq] = __builtin_amdgcn_mfma_f32_16x16x32_bf16(vf_, pf[kp][nq], oT[md][nq], 0, 0, 0); } \
        _Pragma("unroll") for (int mk = 0; mk < 4; ++mk) { sC[mk][0] = sN[mk][0]; sC[mk][1] = sN[mk][1]; } \
    } while (0)
    for (int u = blockIdx.x; u < NUL + NUC; u += gridDim.x) {
        const bool isctx = u >= NUL;
        int b, h, q0;
        if (!isctx) {
            int bh, qb;
            if (gridDim.x == 256) { const int c = u & 255, r = u >> 8, x = c & 7, sl = c >> 3; bh = r * 16 + x * 2 + (sl >> 4); qb = sl & 15; } else { bh = u / 16; qb = u % 16; }
            b = bh / NH; h = bh % NH; q0 = qb * 256;
        } else { const int v = u - NUL; b = v / NH; h = v % NH; q0 = 0; }
        const bf16_t* Qp = (isctx ? p.Qc + ((size_t)(b * NH + h) * CTXL + q0) * 128 : p.Q + ((size_t)(b * NH + h) * SEQ + q0) * 128) + (size_t)(wv * 32) * 128;
        bf16x8 qf[2][4];
#pragma unroll
        for (int nq = 0; nq < 2; ++nq)
#pragma unroll
            for (int ks = 0; ks < 4; ++ks) qf[nq][ks] = *(const bf16x8*)(Qp + (size_t)(nq * 16 + fr) * 128 + ks * 32 + g * 8);
        const bf16_t* Kp = p.K + (size_t)(b * NH + h) * NKEY * DQK;
        const bf16_t* Vp = p.V + (size_t)(b * NH + h) * NKEY * DV;
        f32x4 oT[4][2]; float m[2], lsum[2];
#pragma unroll
        for (int nq = 0; nq < 2; ++nq) { m[nq] = -INFINITY; lsum[nq] = 0.f;
#pragma unroll
            for (int md = 0; md < 4; ++md) oT[md][nq] = (f32x4){0.f, 0.f, 0.f, 0.f}; }
        const int st0 = isctx ? 32 : 0;
        u32x4 kr0, kr1 = (u32x4){0u, 0u, 0u, 0u}, vr0;
        f32x4 sC[4][2], sN[4][2];
        __syncthreads();
        AT_LOADK(st0, 0); AT_LOADV(st0, 0); AT_STOREK(0, 0); AT_STOREV(0, 0);
        AT_LOADK(st0, 1); AT_LOADV(st0, 1); AT_STOREK(0, 1); AT_STOREV(0, 1);
        AT_LOADK(st0 + 1, 0); AT_STOREK(1, 0);
        AT_LOADK(st0 + 1, 1);
        __syncthreads();
        {
            const bf16_t* sKn = sK + fr * KS + g * 8; const bool ctxn = st0 >= 32;
            bf16x8 kfA[3];
#pragma unroll
            for (int mk = 0; mk < 4; ++mk) { AT_LDKF(kfA, mk); AT_MMAS(kfA, mk); }
#pragma unroll
            for (int mk = 0; mk < 4; ++mk) { sC[mk][0] = sN[mk][0]; sC[mk][1] = sN[mk][1]; }
        }
        AT_STOREK(1, 1);
        __syncthreads();
        int kb = 0;
        for (int st = st0; st < NSTG; ++st) {
            const int bufc = (st - st0) & 1;
            const int st1 = st + 1 < NSTG ? st + 1 : NSTG - 1, st2 = st + 2 < NSTG ? st + 2 : NSTG - 1;
            const int kb1 = kb == 2 ? 0 : kb + 1, kb2 = kb1 == 2 ? 0 : kb1 + 1;
            const bf16_t* sKc = sK + kb * 128 * KS; const bf16_t* sKx = sK + kb1 * 128 * KS; const bf16_t* sVc = sV + bufc * 128 * VS;
            AT_LOADK(st2, 0); AT_LOADV(st1, 0);
            AT_SUBTILE(sKc + 64 * KS, st >= 32, sVc);
            AT_STOREK(kb2, 0); AT_STOREV(bufc ^ 1, 0);
            AT_LOADK(st2, 1); AT_LOADV(st1, 1);
            AT_SUBTILE(sKx, st1 >= 32, sVc + 64 * VS);
            AT_STOREK(kb2, 1); AT_STOREV(bufc ^ 1, 1);
            __syncthreads();
            kb = kb1;
        }
        const size_t rbase = (isctx ? (size_t)TL + b * CTXL : (size_t)b * SEQ) + q0 + wv * 32;
#pragma unroll
        for (int nq = 0; nq < 2; ++nq) {
            const float l = rowsum4(lsum[nq]);
            const float inv = 1.0f / l;
#pragma unroll
            for (int md = 0; md < 4; ++md) {
                u32x2 o; o.x = cvt_pk_bf16(oT[md][nq][0] * inv, oT[md][nq][1] * inv); o.y = cvt_pk_bf16(oT[md][nq][2] * inv, oT[md][nq][3] * inv);
                *(u32x2*)(p.Yatt + ((size_t)(h * 8 + md * 2 + (g >> 1)) * TT + rbase + nq * 16 + fr) * 8 + 4 * (g & 1)) = o;
            }
        }
    }
#undef AT_LOADK
#undef AT_LOADV
#undef AT_STOREK
#undef AT_STOREV
#undef AT_LDKF
#undef AT_MMAS
#undef AT_EXPS
#undef AT_SUBTILE
}

constexpr int RT_PITCH = 1024 + 8;
__device__ __forceinline__ void ph_norm2_router(const P& p, int l, char* smem, int nrows_total) {
    bf16_t* thi = (bf16_t*)smem;
    bf16_t* tlo = thi + 16 * RT_PITCH;
    float* part = (float*)(tlo + 16 * RT_PITCH);
    float* lgs = part + 8 * 16 * 80;
    const int tid = tid_opaque(), lane = tid & 63, wv = tid >> 6, fr = lane & 15, g = lane >> 4;
    const float* ng = p.norm2_g + l * DM;
    const bf16_t* whi = p.WrT + (size_t)(l * 2 + 0) * 80 * DM; const bf16_t* wlo = p.WrT + (size_t)(l * 2 + 1) * 80 * DM;
    bf16x8 bh[4][5];
#pragma unroll
    for (int ks = 0; ks < 4; ++ks)
#pragma unroll
        for (int nt = 0; nt < 5; ++nt) { const size_t o = (size_t)(nt * 16 + fr) * DM + wv * 128 + ks * 32 + g * 8; bh[ks][nt] = *(const bf16x8*)(whi + o); }
    float* bias_s = lgs + 16 * 80;
    float* recs = bias_s + 80;
    int nrec = 0;
    if (tid < 72) bias_s[tid] = tid < 64 ? p.b_re[l * NE + tid] : p.b_rg[l * 8 + tid - 64];
    for (int rb = blockIdx.x * 16; rb < nrows_total; rb += gridDim.x * 16) {
        __syncthreads();
        {
            const int lr0 = wv * 2, row0 = rb + lr0;
            const int b = row0 < TL ? (row0 >> 12) : 4;
            const float* hp = p.hx + (size_t)row0 * DM;
            const float* md = p.mod + ((size_t)l * 5 + b) * NMOD + 3 * DM;
            float4 xv[2][4], gg4[4], sh4[4], sc4[4];
#pragma unroll
            for (int i = 0; i < 4; ++i) { const int j = i * 256 + lane * 4; xv[0][i] = *(const float4*)(hp + j); xv[1][i] = *(const float4*)(hp + DM + j); gg4[i] = *(const float4*)(ng + j); sh4[i] = *(const float4*)(md + j); sc4[i] = *(const float4*)(md + DM + j); }
            float ss0 = 0.f, ss1 = 0.f;
#pragma unroll
            for (int i = 0; i < 4; ++i) { ss0 += xv[0][i].x * xv[0][i].x + xv[0][i].y * xv[0][i].y + xv[0][i].z * xv[0][i].z + xv[0][i].w * xv[0][i].w;
                                          ss1 += xv[1][i].x * xv[1][i].x + xv[1][i].y * xv[1][i].y + xv[1][i].z * xv[1][i].z + xv[1][i].w * xv[1][i].w; }
#pragma unroll
            for (int o = 32; o > 0; o >>= 1) { ss0 += shx(ss0, o); ss1 += shx(ss1, o); }
            const float rs2[2] = {rsqrtf(ss0 * (1.0f / DM) + epsf()), rsqrtf(ss1 * (1.0f / DM) + epsf())};
#pragma unroll
            for (int i = 0; i < 4; ++i) {
                const int j = i * 256 + lane * 4;
                const float4 gg = gg4[i], sh = sh4[i], sc = sc4[i];
#pragma unroll
                for (int rr = 0; rr < 2; ++rr) {
                    const int lr = lr0 + rr; const float rs = rs2[rr];
                    float y[4];
                    y[0] = (xv[rr][i].x * rs * gg.x) * (1.f + sc.x) + sh.x; y[1] = (xv[rr][i].y * rs * gg.y) * (1.f + sc.y) + sh.y;
                    y[2] = (xv[rr][i].z * rs * gg.z) * (1.f + sc.z) + sh.z; y[3] = (xv[rr][i].w * rs * gg.w) * (1.f + sc.w) + sh.w;
                    bf16_t h[4], lo[4];
#pragma unroll
                    for (int e = 0; e < 4; ++e) { h[e] = f2bf(y[e]); lo[e] = f2bf(y[e] - bf2f(h[e])); }
                    u32x2 oh; oh.x = (unsigned)h[0] | ((unsigned)h[1] << 16); oh.y = (unsigned)h[2] | ((unsigned)h[3] << 16);
                    u32x2 ol; ol.x = (unsigned)lo[0] | ((unsigned)lo[1] << 16); ol.y = (unsigned)lo[2] | ((unsigned)lo[3] << 16);
                    *(u32x2*)(p.U + (size_t)(row0 + rr) * DM + j) = oh;
                    *(u32x2*)(thi + lr * RT_PITCH + j) = oh; *(u32x2*)(tlo + lr * RT_PITCH + j) = ol;
                }
            }
        }
        __syncthreads();
        f32x4 acc[5];
#pragma unroll
        for (int nt = 0; nt < 5; ++nt) acc[nt] = (f32x4){0.f, 0.f, 0.f, 0.f};
#pragma unroll
        for (int ks = 0; ks < 4; ++ks) {
            const int k0 = wv * 128 + ks * 32 + g * 8;
            const bf16x8 ah = *(const bf16x8*)(thi + fr * RT_PITCH + k0), al = *(const bf16x8*)(tlo + fr * RT_PITCH + k0);
#pragma unroll
            for (int nt = 0; nt < 5; ++nt) {
                const bf16x8 blf = *(const bf16x8*)(wlo + (size_t)(nt * 16 + fr) * DM + k0);
                acc[nt] = __builtin_amdgcn_mfma_f32_16x16x32_bf16(ah, bh[ks][nt], acc[nt], 0, 0, 0);
                acc[nt] = __builtin_amdgcn_mfma_f32_16x16x32_bf16(al, bh[ks][nt], acc[nt], 0, 0, 0);
                acc[nt] = __builtin_amdgcn_mfma_f32_16x16x32_bf16(ah, blf, acc[nt], 0, 0, 0);
            }
        }
#pragma unroll
        for (int nt = 0; nt < 5; ++nt)
#pragma unroll
            for (int r = 0; r < 4; ++r) part[(wv * 16 + g * 4 + r) * 80 + nt * 16 + fr] = acc[nt][r];
        __syncthreads();
        for (int i = tid; i < 16 * 80; i += NT) { float a = 0.f;
#pragma unroll
            for (int w = 0; w < 8; ++w) a += part[w * 16 * 80 + i];
            lgs[i] = a; }
        __syncthreads();
        if (tid < 128) {
            const int lrw = tid >> 3, i = tid & 7, row = rb + lrw;
            const float* le = lgs + lrw * 80; const float* lg = le + 64;
            const float* bre = bias_s; const float* brg = bias_s + 64;
            const float lgi = lg[i];
            float bv = lgi + brg[i]; int bi = i; float mx = lgi;
#pragma unroll
            for (int o = 1; o < 8; o <<= 1) { const float ov = shx(bv, o); const int oi = shx(bi, o); if (ov > bv || (ov == bv && oi < bi)) { bv = ov; bi = oi; } mx = fmaxf(mx, shx(mx, o)); }
            const int gs = bi;
            float den = __expf(lgi - mx);
#pragma unroll
            for (int o = 1; o < 8; o <<= 1) den += shx(den, o);
            const float pg = __expf(lg[gs] - mx) / den;
            const float lei = le[gs * 8 + i];
            float k0v = lei + bre[gs * 8 + i]; int k0i = i;
            const float keyi = k0v;
#pragma unroll
            for (int o = 1; o < 8; o <<= 1) { const float ov = shx(k0v, o); const int oi = shx(k0i, o); if (ov > k0v || (ov == k0v && oi < k0i)) { k0v = ov; k0i = oi; } }
            const int i0 = k0i;
            float k1v = (i == i0) ? -INFINITY : keyi; int k1i = (i == i0) ? 8 : i;
#pragma unroll
            for (int o = 1; o < 8; o <<= 1) { const float ov = shx(k1v, o); const int oi = shx(k1i, o); if (ov > k1v || (ov == k1v && oi < k1i)) { k1v = ov; k1i = oi; } }
            const int i1 = k1i;
            if (i == 0) {
                const float w0 = 1.0f / (1.0f + __expf(le[gs * 8 + i1] - le[gs * 8 + i0])), w1 = 1.0f - w0;
                float* rc = recs + (nrec * 16 + lrw) * 4;
                rc[0] = __int_as_float((gs * 8 + i0) | ((gs * 8 + i1) << 8)); rc[1] = pg * w0; rc[2] = pg * w1; rc[3] = __int_as_float(row);
            }
        }
        ++nrec;
    }
    __syncthreads();
    for (int q = tid; q < nrec * 16; q += NT) {
        const float* rc = recs + q * 4;
        const int ee = __float_as_int(rc[0]), e0 = ee & 255, e1 = ee >> 8, row = __float_as_int(rc[3]);
        const int r0 = atomicAdd(p.cnt + (l * NE + e0) * 64, 1), r1 = atomicAdd(p.cnt + (l * NE + e1) * 64, 1);
        p.list[(size_t)e0 * CAP + r0] = row; p.wl[(size_t)e0 * CAP + r0] = rc[1];
        p.list[(size_t)e1 * CAP + r1] = row; p.wl[(size_t)e1 * CAP + r1] = rc[2];
        *(int4*)(p.asg + (size_t)row * 4) = make_int4(e0, r0, e1, r1);
    }
    __syncthreads();
}

typedef float v2f __attribute__((ext_vector_type(2)));
#define HD __device__ __forceinline__
HD v2f vfma(v2f a, v2f b, v2f c) { return __builtin_elementwise_fma(a, b, c); }
HD v2f twk(v2f w) { return w.yy * (v2f){-1.f, 1.f}; }
HD v2f cmulk(v2f a, v2f w, v2f wk) { return vfma(a.yx, wk, a * w.xx); }
HD v2f cmulck(v2f a, v2f w, v2f wk) { return vfma(a.yx, -wk, a * w.xx); }
HD v2f cmul(v2f a, v2f w) { return cmulk(a, w, twk(w)); }
HD v2f cmulc(v2f a, v2f w) { return cmulck(a, w, twk(w)); }
HD int fphys(int i) { return (i >> 8) * 272 + ((i >> 4) & 15) * 17 + (i & 15); }
constexpr int FBUF = 4352;
template <bool INV> HD void dft4(v2f& x0, v2f& x1, v2f& x2, v2f& x3) {
    const v2f s02 = x0 + x2, d02 = x0 - x2, s13 = x1 + x3, d13 = x1 - x3;
    const v2f kj = INV ? (v2f){-1.f, 1.f} : (v2f){1.f, -1.f};
    x0 = s02 + s13; x2 = s02 - s13; x1 = vfma(d13.yx, kj, d02); x3 = vfma(d13.yx, -kj, d02);
}
template <bool INV> HD void dft16(v2f (&v)[16]) {
#pragma unroll
    for (int b = 0; b < 4; ++b) dft4<INV>(v[b], v[4 + b], v[8 + b], v[12 + b]);
    float C1 = 0.92387953251128674f, S1 = 0.38268343236508977f, C2 = 0.70710678118654752f;
    asm volatile("" : "+v"(C1), "+v"(S1), "+v"(C2));
#define TW(idx, cr, ci) v[idx] = vfma(v[idx].yx, INV ? (v2f){(ci), -(ci)} : (v2f){-(ci), (ci)}, v[idx] * (v2f){(cr), (cr)})
    TW(4 * 1 + 1, C1, -S1);
    TW(4 * 1 + 2, C2, -C2);
    TW(4 * 1 + 3, S1, -C1);
    TW(4 * 2 + 1, C2, -C2);
    v[4 * 2 + 2] = v[4 * 2 + 2].yx * (INV ? (v2f){-1.f, 1.f} : (v2f){1.f, -1.f});
    TW(4 * 2 + 3, -C2, -C2);
    TW(4 * 3 + 1, S1, -C1);
    TW(4 * 3 + 2, -C2, -C2);
    TW(4 * 3 + 3, -C1, S1);
#undef TW
#pragma unroll
    for (int c = 0; c < 4; ++c) dft4<INV>(v[4 * c], v[4 * c + 1], v[4 * c + 2], v[4 * c + 3]);
#define SW(i, j) { const v2f t_ = v[i]; v[i] = v[j]; v[j] = t_; }
    SW(1, 4) SW(2, 8) SW(3, 12) SW(6, 9) SW(7, 13) SW(11, 14)
#undef SW
}
template <class BUF, class TW> HD void fwd_pass0(int u, v2f (&v)[16], BUF buf, TW W) {
    dft16<false>(v);
    const v2f w1 = W[u], w1k = twk(w1); v2f wr = w1;
    const int pb = fphys(u);
    buf[pb] = v[0];
#pragma unroll
    for (int r = 1; r < 16; ++r) { v[r] = cmul(v[r], wr); buf[pb + 272 * r] = v[r]; wr = cmulk(wr, w1, w1k); }
}
template <class BUF, class TW> HD void fwd_pass1(int u, v2f (&v)[16], BUF buf, TW W) {
    const int j = u & 15, pb = (u >> 4) * 272 + j;
#pragma unroll
    for (int q = 0; q < 16; ++q) v[q] = buf[pb + 17 * q];
    dft16<false>(v);
    const v2f w1 = W[16 * j], w1k = twk(w1); v2f wr = w1;
    buf[pb] = v[0];
#pragma unroll
    for (int r = 1; r < 16; ++r) { v[r] = cmul(v[r], wr); buf[pb + 17 * r] = v[r]; wr = cmulk(wr, w1, w1k); }
}
template <class BUF> HD void fwd_pass2(int u, v2f (&v)[16], BUF buf) {
    const int pb = (u >> 4) * 272 + (u & 15) * 17;
#pragma unroll
    for (int q = 0; q < 16; ++q) v[q] = buf[pb + q];
    dft16<false>(v);
}
template <class BUF> HD void inv_passA(int u, v2f (&v)[16], BUF buf) {
    dft16<true>(v);
    const int pb = (u >> 4) * 272 + (u & 15) * 17;
#pragma unroll
    for (int r = 0; r < 16; ++r) buf[pb + r] = v[r];
}
template <class BUF, class TW> HD void inv_passB(int u, v2f (&v)[16], BUF buf, TW W) {
    const int j = u & 15, pb = (u >> 4) * 272 + j;
    const v2f w1 = W[16 * j], w1k = twk(w1); v2f wr = w1;
    v[0] = buf[pb];
#pragma unroll
    for (int q = 1; q < 16; ++q) { v[q] = cmulc(buf[pb + 17 * q], wr); wr = cmulk(wr, w1, w1k); }
    dft16<true>(v);
#pragma unroll
    for (int r = 0; r < 16; ++r) buf[pb + 17 * r] = v[r];
}
template <class BUF, class TW> HD void inv_passC(int u, v2f (&v)[16], BUF buf, TW W) {
    const v2f w1 = W[u], w1k = twk(w1); v2f wr = w1;
    const int pb = fphys(u);
    v[0] = buf[pb];
#pragma unroll
    for (int q = 1; q < 16; ++q) { v[q] = cmulc(buf[pb + 272 * q], wr); wr = cmulk(wr, w1, w1k); }
    dft16<true>(v);
}
HD int digitrev(int i) { return ((i & 15) << 8) | (i & 0xF0) | (i >> 8); }

#undef HD
constexpr int FFT_LDS_W = 2 * FBUF * 8;
constexpr int FFT_LDS_STG = FFT_LDS_W + 4096 * 8;
constexpr int STG_ROW = SEQ + 16;
constexpr int FFT_LDS_W2 = FFT_LDS_STG + 2 * STG_ROW * 2;
constexpr int FFT_LDS_END = FFT_LDS_W2 + 4096 * 8;
__device__ __forceinline__ void fft_load_w(const P& p, char* smem) {
    float2* Wl = (float2*)(smem + FFT_LDS_W); float2* W2l = (float2*)(smem + FFT_LDS_W2);
    __syncthreads();
    { const int t_ = tid_opaque();
      float4 a_[4], b_[4];
#pragma unroll
      for (int k = 0; k < 4; ++k) { a_[k] = ((const float4*)p.Wtab)[t_ + NT * k]; b_[k] = ((const float4*)p.W2tab)[t_ + NT * k]; }
#pragma unroll
      for (int k = 0; k < 4; ++k) { ((float4*)Wl)[t_ + NT * k] = a_[k]; ((float4*)W2l)[t_ + NT * k] = b_[k]; } }
    __syncthreads();
}
__device__ __forceinline__ void ph_tables(const P& p) {
    for (int i = blockIdx.x * NT + tid_opaque(); i < 8192; i += gridDim.x * NT) {
        float sn, cs;
        if (i < 4096) { sincospif((float)i * (1.0f / 2048.0f), &sn, &cs); p.Wtab[i] = make_float2(cs, -sn); }
        else { sincospif((float)(i - 4096) * (1.0f / 4096.0f), &sn, &cs); p.W2tab[i - 4096] = make_float2(cs, -sn); }
    }
    for (int i = blockIdx.x * NT + tid_opaque(); i < DEPTH * 80 * DM; i += gridDim.x * NT) {
        const int l = i / (80 * DM), n = (i / DM) % 80, kk = i % DM;
        const float v = n < 64 ? p.w_re[((size_t)l * DM + kk) * NE + n] : (n < 72 ? p.w_rg[((size_t)l * DM + kk) * 8 + (n - 64)] : 0.f);
        const bf16_t h = f2bf(v);
        p.WrT[((size_t)(l * 2 + 0) * 80 + n) * DM + kk] = h; p.WrT[((size_t)(l * 2 + 1) * 80 + n) * DM + kk] = f2bf(v - bf2f(h));
    }
}
__device__ __forceinline__ void ph_spectra(const P& p, char* smem) {
    v2f* bufE = (v2f*)smem; v2f* bufO = bufE + FBUF; const v2f* Wl = (const v2f*)(smem + FFT_LDS_W); const v2f* W2l = (const v2f*)(smem + FFT_LDS_W2);
    const int tid = tid_opaque(), half = tid >> 8, u = tid & 255;
    v2f* buf = half ? bufO : bufE;
    fft_load_w(p, smem);
    for (int un = blockIdx.x; un < DEPTH * HYW; un += gridDim.x) {
        const int l = un / HYW, c = un % HYW;
        const float* hf0 = p.HT0 + ((size_t)l * 2048 + c) * SEQ;        const float s_f0 = p.SCL0[l * 2048 + c];
        const float* hb0 = p.HT0 + ((size_t)l * 2048 + 512 + c) * SEQ;  const float s_b0 = p.SCL0[l * 2048 + 512 + c];
        const float* hf1 = p.HT0 + ((size_t)l * 2048 + 1024 + c) * SEQ; const float s_f1 = p.SCL0[l * 2048 + 1024 + c];
        const float* hb1 = p.HT0 + ((size_t)l * 2048 + 1536 + c) * SEQ; const float s_b1 = p.SCL0[l * 2048 + 1536 + c];
        v2f v[16];
#pragma unroll
        for (int q = 0; q < 16; ++q) {
            const int j = 2 * (u + 256 * q) + half;
            float a, b;
            if (j < SEQ) { a = hf0[j] * s_f0; b = hf1[j] * s_f1; } else if (j == SEQ) { a = 0.f; b = 0.f; } else { a = hb0[2 * SEQ - j] * s_b0; b = hb1[2 * SEQ - j] * s_b1; }
            if (j == 0) { a += p.flt_bias[(l * 2 + 0) * HYW + c]; b += p.flt_bias[(l * 2 + 1) * HYW + c]; }
            v[q] = (v2f){a, b};
        }
        __syncthreads();
        fwd_pass0(u, v, buf, Wl); __syncthreads();
        fwd_pass1(u, v, buf, Wl); __syncthreads();
        fwd_pass2(u, v, buf);
#pragma unroll
        for (int r = 0; r < 16; ++r) buf[fphys(16 * u + r)] = v[r];
        __syncthreads();
        unsigned* out = (unsigned*)p.Hs + (size_t)(l * HYW + c) * 4 * 4096;
        for (int idx = tid; idx < 8192; idx += NT) {
            const int par = idx >> 12, pi = idx & 4095, kp = 2 * digitrev(pi) + par, kpp = (8192 - kp) & 8191;
            const int k1 = kp & 4095, k2 = kpp & 4095;
            v2f t1 = cmul(W2l[k1], bufO[fphys(digitrev(k1))]); if (kp >= 4096) t1 = -t1;
            v2f t2 = cmul(W2l[k2], bufO[fphys(digitrev(k2))]); if (kpp >= 4096) t2 = -t2;
            const v2f F = bufE[fphys(digitrev(k1))] + t1, Gq = bufE[fphys(digitrev(k2))] + t2;
            const float sc = 0.5f / 8192.0f;
            out[(0 * 2 + par) * 4096 + pi] = pack2((F.x + Gq.x) * sc, (F.y - Gq.y) * sc);
            out[(1 * 2 + par) * 4096 + pi] = pack2((F.y + Gq.y) * sc, -(F.x - Gq.x) * sc);
        }
    }
    __syncthreads();
}
__device__ __forceinline__ void fft_conv(int half, int u, v2f (&v)[16], const v2f* W2g, const unsigned* Hso, v2f* buf, const v2f* Wl) {
    u32x4 hreg[4];
    const u32x4* hp = (const u32x4*)(Hso + (size_t)half * 4096 + 16 * u);
#pragma unroll
    for (int r4 = 0; r4 < 4; ++r4) hreg[r4] = hp[r4];
    if (half) {
#pragma unroll
        for (int q = 0; q < 16; ++q) v[q] = cmul(v[q], W2g[u + 256 * q]);
    }
    fwd_pass0(u, v, buf, Wl); __syncthreads();
    fwd_pass1(u, v, buf, Wl); __syncthreads();
    fwd_pass2(u, v, buf);
#pragma unroll
    for (int r4 = 0; r4 < 4; ++r4) { const u32x4 h = hreg[r4];
#define HSV(w_) ((v2f){__uint_as_float((w_) << 16), __uint_as_float((w_) & 0xFFFF0000u)})
        v[4 * r4] = cmul(v[4 * r4], HSV(h.x)); v[4 * r4 + 1] = cmul(v[4 * r4 + 1], HSV(h.y)); v[4 * r4 + 2] = cmul(v[4 * r4 + 2], HSV(h.z)); v[4 * r4 + 3] = cmul(v[4 * r4 + 3], HSV(h.w));
#undef HSV
    }
    inv_passA(u, v, buf); __syncthreads();
    inv_passB(u, v, buf, Wl); __syncthreads();
    inv_passC(u, v, buf, Wl);
    if (half) {
#pragma unroll
        for (int r = 0; r < 16; ++r) v[r] = cmulc(v[r], W2g[u + 256 * r]);
    }
}

__device__ __forceinline__ void ph_hyena_fft(const P& p, int l, char* smem) {
    v2f* buf0 = (v2f*)smem; v2f* buf1 = buf0 + FBUF; const v2f* Wl = (const v2f*)(smem + FFT_LDS_W);
    bf16_t* stg = (bf16_t*)(smem + FFT_LDS_STG) + 8;
    const v2f* W2l = (const v2f*)(smem + FFT_LDS_W2);
    const int tid = tid_opaque(), half = tid >> 8, u = tid & 255;
    v2f* buf = half ? buf1 : buf0;
    const int pu = fphys(u);
    if (tid < 32) { const int rw = tid >> 4, k = tid & 15; (stg - 8 + rw * STG_ROW)[k < 8 ? k : SEQ + k] = 0; }
    fft_load_w(p, smem);
    for (int c = blockIdx.x; c < HYW; c += gridDim.x) {
        const unsigned* Hs0 = (const unsigned*)p.Hs + (size_t)(l * HYW + c) * 4 * 4096; const unsigned* Hs1 = Hs0 + 2 * 4096;
        float scw[3][4];
#pragma unroll
        for (int w = 0; w < 3; ++w) { const int col = w * HYW + c; scw[w][0] = p.sc_w[(size_t)(l * 3 + 0) * HYC + col]; scw[w][1] = p.sc_w[(size_t)(l * 3 + 1) * HYC + col]; scw[w][2] = p.sc_w[(size_t)(l * 3 + 2) * HYC + col]; scw[w][3] = p.sc_b[l * HYC + col]; }
#define HY_TAP(sb, k, w) (scw[w][3] + scw[w][0] * __uint_as_float((unsigned)(sb)[(k) - 1] << 16) + scw[w][1] * __uint_as_float((unsigned)(sb)[(k)] << 16) + scw[w][2] * __uint_as_float((unsigned)(sb)[(k) + 1] << 16))
        u32x4 ra, rb;
#define HY_LOAD(sel, pr_) do { const bf16_t* r0_ = p.PT + ((size_t)(2 * (pr_)) * HYC + (sel) * HYW + c) * SEQ + tid * 8; ra = *(const u32x4*)r0_; rb = *(const u32x4*)(r0_ + (size_t)HYC * SEQ); } while (0)
#define HY_STAGE() do { *(u32x4*)(stg + tid * 8) = ra; *(u32x4*)(stg + STG_ROW + tid * 8) = rb; } while (0)
        HY_LOAD(0, 0);
        for (int pr = 0; pr < 2; ++pr) {
            const LAS bf16_t* sbA = (const LAS bf16_t*)stg + u; asm volatile("" : "+v"(sbA));
            const LAS bf16_t* sbB = sbA + STG_ROW;
            __syncthreads();
            HY_STAGE();
            __syncthreads();
            v2f v[16];
#pragma unroll
            for (int q = 0; q < 16; ++q) v[q] = (v2f){HY_TAP(sbA, 256 * q, 0), HY_TAP(sbB, 256 * q, 0)};
            HY_LOAD(1, pr);
            fft_conv(half, u, v, W2l, Hs0, buf, Wl);
            if (half) {
#pragma unroll
                for (int r = 0; r < 16; ++r) buf1[pu + 272 * r] = v[r];
            }
            HY_STAGE();
            __syncthreads();
            if (!half) {
#pragma unroll
                for (int r = 0; r < 16; ++r) {
                    const v2f y = v[r] + buf1[pu + 272 * r];
                    const float xa = HY_TAP(sbA, 256 * r, 1), xb = HY_TAP(sbB, 256 * r, 1);
                    const v2f z1 = (v2f){xa, xb} * y;
                    v[r] = z1; buf1[pu + 272 * r] = z1;
                }
            }
            HY_LOAD(2, pr);
            __syncthreads();
            if (half) {
#pragma unroll
                for (int r = 0; r < 16; ++r) v[r] = buf1[pu + 272 * r];
            }
            fft_conv(half, u, v, W2l, Hs1, buf, Wl);
            if (half) {
#pragma unroll
                for (int r = 0; r < 16; ++r) buf1[pu + 272 * r] = v[r];
            }
            HY_STAGE();
            if (pr == 0) HY_LOAD(0, 1);
            __syncthreads();
            if (!half) {
                bf16_t* oA = p.Yhy + ((size_t)(c >> 3) * TT + (size_t)(2 * pr) * SEQ + u) * 8 + (c & 7); bf16_t* oB = oA + (size_t)SEQ * 8;
#pragma unroll
                for (int r = 0; r < 16; ++r) {
                    const v2f y = v[r] + buf1[pu + 272 * r];
                    const float xa = HY_TAP(sbA, 256 * r, 2), xb = HY_TAP(sbB, 256 * r, 2);
                    oA[(size_t)(256 * r) * 8] = f2bf(xa * y.x);
                    oB[(size_t)(256 * r) * 8] = f2bf(xb * y.y);
                }
            }
        }
#undef HY_LOAD
#undef HY_STAGE
#undef HY_TAP
    }
    __syncthreads();
}

__device__ __forceinline__ float4 moe_combine4(const P& p, int lc, int b, size_t s0, size_t s1, int j, float4 hv) {
    const u32x2 y0 = *(const u32x2*)(p.Y + s0 * DM + j), y1 = *(const u32x2*)(p.Y + s1 * DM + j);
    const float4 g = *(const float4*)(p.mod + ((size_t)lc * 5 + b) * NMOD + 5 * DM + j);
    hv.x += g.x * (__uint_as_float(y0.x << 16) + __uint_as_float(y1.x << 16));
    hv.y += g.y * (__uint_as_float(y0.x & 0xFFFF0000u) + __uint_as_float(y1.x & 0xFFFF0000u));
    hv.z += g.z * (__uint_as_float(y0.y << 16) + __uint_as_float(y1.y << 16));
    hv.w += g.w * (__uint_as_float(y0.y & 0xFFFF0000u) + __uint_as_float(y1.y & 0xFFFF0000u));
    return hv;
}
__device__ __forceinline__ void ph_norm1c(const P& p, int l, const int* offs) {
    const int tid = tid_opaque(), lane = tid & 63, wv = tid >> 6;
    const float* ng = p.norm1_g + l * DM;
    for (int rb = blockIdx.x * 16; rb < TT; rb += gridDim.x * 16) {
        const int row0 = rb + wv * 2;
        const int b = row0 < TL ? (row0 >> 12) : 4;
        float* hp = p.hx + (size_t)row0 * DM;
        const float* src = l > 0 ? hp : (row0 < TL ? p.x + (size_t)row0 * DM : p.ctx + (size_t)(row0 - TL) * DM);
        const float* md = p.mod + ((size_t)l * 5 + b) * NMOD;
        float4 xv[2][4];
        u32x2 ya[2][4], yb[2][4];
        if (l > 0) {
            const int4 a0 = *(const int4*)(p.asg + (size_t)row0 * 4), a1 = *(const int4*)(p.asg + (size_t)(row0 + 1) * 4);
            const size_t s00 = (size_t)offs[a0.x] + a0.y, s01 = (size_t)offs[a0.z] + a0.w, s10 = (size_t)offs[a1.x] + a1.y, s11 = (size_t)offs[a1.z] + a1.w;
#pragma unroll
            for (int i = 0; i < 4; ++i) { const int j = i * 256 + lane * 4;
                ya[0][i] = *(const u32x2*)(p.Y + s00 * DM + j); yb[0][i] = *(const u32x2*)(p.Y + s01 * DM + j);
                ya[1][i] = *(const u32x2*)(p.Y + s10 * DM + j); yb[1][i] = *(const u32x2*)(p.Y + s11 * DM + j); }
        }
#pragma unroll
        for (int i = 0; i < 4; ++i) { const int j = i * 256 + lane * 4; xv[0][i] = *(const float4*)(src + j); xv[1][i] = *(const float4*)(src + DM + j); }
        float ss[2] = {0.f, 0.f};
#pragma unroll
        for (int rr = 0; rr < 2; ++rr)
#pragma unroll
            for (int i = 0; i < 4; ++i) {
                const int j = i * 256 + lane * 4;
                if (l > 0) {
                    const float4 g = *(const float4*)(p.mod + ((size_t)(l - 1) * 5 + b) * NMOD + 5 * DM + j);
                    const u32x2 y0 = ya[rr][i], y1 = yb[rr][i];
                    xv[rr][i].x += g.x * (__uint_as_float(y0.x << 16) + __uint_as_float(y1.x << 16));
                    xv[rr][i].y += g.y * (__uint_as_float(y0.x & 0xFFFF0000u) + __uint_as_float(y1.x & 0xFFFF0000u));
                    xv[rr][i].z += g.z * (__uint_as_float(y0.y << 16) + __uint_as_float(y1.y << 16));
                    xv[rr][i].w += g.w * (__uint_as_float(y0.y & 0xFFFF0000u) + __uint_as_float(y1.y & 0xFFFF0000u));
                }
                *(float4*)(hp + (size_t)rr * DM + j) = xv[rr][i];
                ss[rr] += xv[rr][i].x * xv[rr][i].x + xv[rr][i].y * xv[rr][i].y + xv[rr][i].z * xv[rr][i].z + xv[rr][i].w * xv[rr][i].w;
            }
        ss[0] = wave_sum(ss[0]); ss[1] = wave_sum(ss[1]);
        const float rs[2] = {rsqrtf(ss[0] * (1.0f / DM) + epsf()), rsqrtf(ss[1] * (1.0f / DM) + epsf())};
#pragma unroll
        for (int i = 0; i < 4; ++i) {
            const int j = i * 256 + lane * 4;
            const float4 g = *(const float4*)(ng + j), sh = *(const float4*)(md + j), sc = *(const float4*)(md + DM + j);
#pragma unroll
            for (int rr = 0; rr < 2; ++rr) {
                u32x2 o;
                o.x = pack2((xv[rr][i].x * rs[rr] * g.x) * (1.f + sc.x) + sh.x, (xv[rr][i].y * rs[rr] * g.y) * (1.f + sc.y) + sh.y);
                o.y = pack2((xv[rr][i].z * rs[rr] * g.z) * (1.f + sc.z) + sh.z, (xv[rr][i].w * rs[rr] * g.w) * (1.f + sc.w) + sh.w);
                *(u32x2*)(p.U + (size_t)(row0 + rr) * DM + j) = o;
            }
        }
    }
}
__device__ __forceinline__ void ph_final_c(const P& p, const int* offs) {
    const int tid = tid_opaque(), lane = tid & 63, wv = tid >> 6;
    for (int rb = blockIdx.x * 8; rb < TL; rb += gridDim.x * 8) {
        const int row = rb + wv, b = row >> 12;
        const float* hp = p.hx + (size_t)row * DM;
        const int4 a = *(const int4*)(p.asg + (size_t)row * 4);
        const size_t s0 = (size_t)offs[a.x] + a.y, s1 = (size_t)offs[a.z] + a.w;
        float4 xv[4]; float ss = 0.f;
#pragma unroll
        for (int i = 0; i < 4; ++i) {
            const int j = i * 256 + lane * 4;
            xv[i] = moe_combine4(p, DEPTH - 1, b, s0, s1, j, *(const float4*)(hp + j));
            ss += xv[i].x * xv[i].x + xv[i].y * xv[i].y + xv[i].z * xv[i].z + xv[i].w * xv[i].w;
        }
        ss = wave_sum(ss);
        const float rs = rsqrtf(ss * (1.0f / DM) + epsf());
#pragma unroll
        for (int i = 0; i < 4; ++i) {
            const int j = i * 256 + lane * 4;
            const float4 g = *(const float4*)(p.final_g + j);
            float4 y; y.x = xv[i].x * rs * g.x; y.y = xv[i].y * rs * g.y; y.z = xv[i].z * rs * g.z; y.w = xv[i].w * rs * g.w;
            *(float4*)(p.out + (size_t)row * DM + j) = y;
        }
    }
}


__device__ __forceinline__ void ph_hyena_ctx(const P& p, int l, char* smem) {
    constexpr int L = CTXL;
    const int tid = tid_opaque(), hf = tid >> 8, tl = tid & 255, b = tl >> 6, t0 = (tl & 63) * 4;
    float* kern0 = (float*)smem + hf * (8 * L);
    float* kern1 = kern0 + 2 * L;
    float* zb = kern1 + 2 * L;
    const float* HT = p.HT1 + (size_t)l * 2048 * L;
    const float* SCL = p.SCL1 + l * 2048;
    for (int cb = blockIdx.x; cb < HYW; cb += 2 * gridDim.x) {
        const int c = cb + hf * gridDim.x;
        const bool act = c < HYW;
        __syncthreads();
        float uv[3][4];
        if (act) {
            const float kb0 = tl > 0 ? HT[(size_t)(512 + c) * L + (L - tl)] * SCL[512 + c] : 0.f, kb1 = tl > 0 ? HT[(size_t)(1536 + c) * L + (L - tl)] * SCL[1536 + c] : 0.f;
            const float kf0 = HT[(size_t)c * L + tl] * SCL[c], kf1 = HT[(size_t)(1024 + c) * L + tl] * SCL[1024 + c];
            kern0[tl] = kb0; kern1[tl] = kb1; kern0[L + tl] = kf0; kern1[L + tl] = kf1;
#pragma unroll
            for (int w = 0; w < 3; ++w) {
                const int col = w * HYW + c;
                const bf16_t* pr = p.PTc + ((size_t)b * HYC + col) * L + t0;
                const float w0 = p.sc_w[(size_t)(l * 3 + 0) * HYC + col], w1 = p.sc_w[(size_t)(l * 3 + 1) * HYC + col], w2 = p.sc_w[(size_t)(l * 3 + 2) * HYC + col], bb = p.sc_b[l * HYC + col];
                const u32x2 mid = *(const u32x2*)pr;
                float e[6];
                e[0] = t0 > 0 ? bf2f(pr[-1]) : 0.f; e[5] = t0 + 4 < L ? bf2f(pr[4]) : 0.f;
                e[1] = __uint_as_float(mid.x << 16); e[2] = __uint_as_float(mid.x & 0xFFFF0000u); e[3] = __uint_as_float(mid.y << 16); e[4] = __uint_as_float(mid.y & 0xFFFF0000u);
#pragma unroll
                for (int j = 0; j < 4; ++j) uv[w][j] = bb + w0 * e[j] + w1 * e[j + 1] + w2 * e[j + 2];
            }
            *(float4*)(zb + b * L + t0) = make_float4(uv[0][0], uv[0][1], uv[0][2], uv[0][3]);
        }
        __syncthreads();
        const float* zr = zb + b * L;
        float a[4];
#define CTX_CONV(kern) do { a[0] = 0.f; a[1] = 0.f; a[2] = 0.f; a[3] = 0.f; \
            float4 khi = *(const float4*)((kern) + t0 + L); \
            _Pragma("unroll 4") for (int m = 0; m < L / 4; ++m) { \
                const float4 klo = *(const float4*)((kern) + t0 + L - 4 * m - 4); const float4 z = *(const float4*)(zr + 4 * m); \
                a[0] += z.x * khi.x; a[1] += z.x * khi.y; a[2] += z.x * khi.z; a[3] += z.x * khi.w; \
                a[0] += z.y * klo.w; a[1] += z.y * khi.x; a[2] += z.y * khi.y; a[3] += z.y * khi.z; \
                a[0] += z.z * klo.z; a[1] += z.z * klo.w; a[2] += z.z * khi.x; a[3] += z.z * khi.y; \
                a[0] += z.w * klo.y; a[1] += z.w * klo.z; a[2] += z.w * klo.w; a[3] += z.w * khi.x; \
                khi = klo; } } while (0)
        float z1[4];
        if (act) {
            CTX_CONV(kern0);
            const float bias0 = p.flt_bias[(l * 2 + 0) * HYW + c];
#pragma unroll
            for (int j = 0; j < 4; ++j) z1[j] = uv[1][j] * (a[j] + bias0 * uv[0][j]);
        }
        __syncthreads();
        if (act) *(float4*)(zb + b * L + t0) = make_float4(z1[0], z1[1], z1[2], z1[3]);
        __syncthreads();
        if (act) {
            CTX_CONV(kern1);
            const float bias1 = p.flt_bias[(l * 2 + 1) * HYW + c];
            bf16_t* o = p.Yhy + ((size_t)(c >> 3) * TT + (size_t)TL + b * CTXL + t0) * 8 + (c & 7);
#pragma unroll
            for (int j = 0; j < 4; ++j) o[j * 8] = f2bf(uv[2][j] * (a[j] + bias1 * z1[j]));
        }
#undef CTX_CONV
    }
    __syncthreads();
}

__device__ __forceinline__ void conv_tile(bf16_t* tile, const float* src, int ld, int c0, int ncols, int K, bf16_t* dst, int kt, int ntile, const float* kscale = nullptr) {
    const int tid = tid_opaque();
    const int k = tid >> 3, n8 = (tid & 7) * 8, nbase = ntile * 64;
    float4 x0 = make_float4(0.f, 0.f, 0.f, 0.f), x1 = x0;
    if (nbase + n8 < ncols) { const float* sp = src + (size_t)(kt * 64 + k) * ld + c0 + nbase + n8; x0 = *(const float4*)sp; x1 = *(const float4*)(sp + 4); }
    if (kscale) { const float ks = kscale[kt * 64 + k]; x0.x *= ks; x0.y *= ks; x0.z *= ks; x0.w *= ks; x1.x *= ks; x1.y *= ks; x1.z *= ks; x1.w *= ks; }
    __syncthreads();
    tile[(n8 + 0) * 72 + k] = f2bf(x0.x); tile[(n8 + 1) * 72 + k] = f2bf(x0.y); tile[(n8 + 2) * 72 + k] = f2bf(x0.z); tile[(n8 + 3) * 72 + k] = f2bf(x0.w);
    tile[(n8 + 4) * 72 + k] = f2bf(x1.x); tile[(n8 + 5) * 72 + k] = f2bf(x1.y); tile[(n8 + 6) * 72 + k] = f2bf(x1.z); tile[(n8 + 7) * 72 + k] = f2bf(x1.w);
    __syncthreads();
    const int n = tid >> 3, k8 = (tid & 7) * 8;
    if (nbase + n < ncols) *(u32x4*)(dst + (size_t)(nbase + n) * K + kt * 64 + k8) = *(const u32x4*)(tile + n * 72 + k8);
}
constexpr int DENSE_TILES = 1720;
__device__ __forceinline__ void ph_conv_dense(const P& p, char* smem) {
    bf16_t* tile = (bf16_t*)smem;
    for (int id = blockIdx.x; id < DEPTH * DENSE_TILES; id += gridDim.x) {
        const int l = id / DENSE_TILES; int r = id % DENSE_TILES;
        const float* win = p.w_in + (size_t)l * DM * INC;
        if (r < 384) conv_tile(tile, win, INC, 0, HYC, DM, p.WtHy + (size_t)l * HYC * DM, r / 24, r % 24);
        else if ((r -= 384) < 64) conv_tile(tile, win, INC, HYC + QL, KVL, DM, p.WtRest + (size_t)l * 2816 * DM, r / 4, r % 4);
        else if ((r -= 64) < 96) conv_tile(tile, win, INC, HYC, QL, DM, p.WtRest + ((size_t)l * 2816 + 256) * DM, r / 6, r % 6);
        else if ((r -= 96) < 16) conv_tile(tile, win, INC, HYC + QL + KVL, QKR, DM, p.WtRest + ((size_t)l * 2816 + 640) * DM, r, 0);
        else if ((r -= 16) < 512) conv_tile(tile, win, INC, MLA_END, 2048, DM, p.WtRest + ((size_t)l * 2816 + 768) * DM, r / 32, r % 32);
        else if ((r -= 512) < 72) conv_tile(tile, p.w_uq + (size_t)l * QL * 768, 768, 0, 768, QL, p.WtUq + (size_t)l * 768 * QL, r / 12, r % 12, p.q_norm_g + l * QL);
        else if ((r -= 72) < 64) conv_tile(tile, p.w_ukv + (size_t)l * KVL * 1024, 1024, 0, 1024, KVL, p.WtUkv + (size_t)l * 1024 * KVL, r / 16, r % 16, p.kv_norm_g + l * KVL);
        else if ((r -= 64) < 128) conv_tile(tile, p.w_hy_o + (size_t)l * HYW * DM, DM, 0, DM, HYW, p.WtHyo + (size_t)l * DM * HYW, r / 16, r % 16);
        else if ((r -= 128) < 128) conv_tile(tile, p.w_mla_o + (size_t)l * 512 * DM, DM, 0, DM, 512, p.WtMlao + (size_t)l * DM * 512, r / 16, r % 16);
        else { r -= 128; conv_tile(tile, p.w_out + (size_t)l * DM * DM, DM, 0, DM, DM, p.WtOut + (size_t)l * DM * DM, r / 16, r % 16); }
    }
    const int nz = DEPTH * 96 * DM / 8;
    for (int i = blockIdx.x * NT + threadIdx.x; i < nz + SEQ * 16; i += gridDim.x * NT) {
        if (i < nz) { const int l = i / (96 * DM / 8), o = i % (96 * DM / 8); *(u32x4*)(p.WtRest + ((size_t)l * 2816 + MLAW) * DM + (size_t)o * 8) = (u32x4){0u, 0u, 0u, 0u}; }
        else { const int k = i - nz, t = k >> 4, a = (k >> 3) & 1, ii = k & 7; const float ang = (float)(a == 0 ? (t >> 6) : (t & 63)) * powf(10000.0f, -(float)ii / 8.0f); p.rope[k] = make_float2(cosf(ang), sinf(ang)); }
    }
}
__device__ __forceinline__ void ph_conv_experts(const P& p, int l, char* smem, int t_begin, int t_end, int worker, int nworkers) {
    bf16_t* tile = (bf16_t*)smem;
    if (worker >= 0)
    for (int id = t_begin + worker; id < t_end; id += nworkers) {
        const int e = id / 192; int r = id % 192;
        const size_t le = (size_t)l * NE + e;
        if (r < 64) conv_tile(tile, p.w_gate + le * DM * DE, DE, 0, DE, DM, p.WtG + (size_t)e * DE * DM, r / 4, r % 4);
        else if (r < 128) { r -= 64; conv_tile(tile, p.w_up + le * DM * DE, DE, 0, DE, DM, p.WtU + (size_t)e * DE * DM, r / 4, r % 4); }
        else { r -= 128; conv_tile(tile, p.w_down + le * DE * DM, DM, 0, DM, DE, p.WtD + (size_t)e * DM * DE, r / 16, r % 16); }
    }
    __syncthreads();
}

constexpr int LDS_TAB = ge::STAGE_BYTES;
static_assert(FFT_LDS_END <= 160 * 1024 - 16, "FFT LDS image");
constexpr int LDS_TOTAL = 160 * 1024;
#define PH_P KArgP kp_ = (KArgP)__builtin_amdgcn_kernarg_segment_ptr(); asm volatile("" : "+s"(kp_)); const P p = make_p(kp_); int G = gridDim.x, c = blockIdx.x; asm volatile("" : "+s"(G), "+s"(c)); (void)G; (void)c;
#define GRID_BAR() do { XcdBarrier b_; b_.bar = (unsigned*)k.ws; b_.x = xb_xcc_id(); b_.st = xbw; xcd_barrier(b_); } while (0)
__global__ __launch_bounds__(NT, 2) void mega(PK k) {
    extern __shared__ __attribute__((aligned(16))) char smem[];
    LAS unsigned char* lds = (LAS unsigned char*)smem;
    volatile LAS unsigned* xbw = (volatile LAS unsigned*)(smem + LDS_TOTAL - 16);
    if (threadIdx.x == 0) { xbw[0] = 0u; xbw[1] = 0u; xbw[2] = 0u; xbw[3] = 0u; }
    __syncthreads();
    (void)xcd_barrier_post((unsigned*)k.ws, xbw);
#define PB(id) do { if (PROBE_ID == (id) && blockIdx.x == PROBE_BLK && threadIdx.x == 0) xbw[2] = (unsigned)wall_clock64(); } while (0)
#define PE(id) do { if (PROBE_ID == (id) && blockIdx.x == PROBE_BLK && threadIdx.x == 0) xbw[3] += (unsigned)wall_clock64() - xbw[2]; } while (0)
    int* offs = (int*)(smem + LDS_TAB); int* tpre = offs + 65; int* cntl = tpre + 65;
    const LAS int* offs_l = (const LAS int*)(lds + LDS_TAB); const LAS int* tpre_l = offs_l + 65; const LAS int* cntl_l = tpre_l + 65;
    PB(0);
    for (int rep = 0; rep < REP_PRO; ++rep) {
    PB(20);
    { PH_P ph_mod_partial(p, smem); ph_filter_a(p, smem); ph_conv_dense(p, smem); ph_tables(p); }
    GRID_BAR();
    PE(20); PB(21);
    { PH_P ph_filter_b2(p, smem); }
    GRID_BAR();
    PE(21); PB(22);
    { PH_P ph_finalize(p); }
    GRID_BAR();
    PE(22); PB(23);
    { PH_P ph_spectra(p, smem); }
    GRID_BAR();
    PE(23);
    }
    PE(0);
    for (int l = 0; l < DEPTH; ++l) {
        const bool last = (l == DEPTH - 1);
        PB(1);
        { PH_P ph_norm1c(p, l, offs); }
        GRID_BAR();
        PE(1); PB(2); PB(40);
#define CHAIN_IDS int cw_ = blockIdx.x; asm volatile("" : "+s"(cw_)); const bool kvc = cw_ < 68, qc = !kvc && cw_ < 136; const int pm = kvc ? cw_ : cw_ - 68; (void)qc; (void)pm;
#define CHAIN_SSQ LAS float* ssq = (LAS float*)(lds + LDS_SSQ); LAS float* rsl = ssq + 256 * 16; (void)rsl;
        { CHAIN_IDS
          if (kvc || qc) { PH_P CHAIN_SSQ
              SchedChainIn S{(const char*)p.U, (const char*)(p.WtRest + (size_t)l * 2816 * DM), pm, kvc ? 0 : 1, kvc ? 1 : 2};
              EpiInprojMLA E{p.PMLAb, p.K, p.rope, ssq};
              ge::gemm_engine<false>(lds, DM, DM, DM, S, E);
          } }
        { CHAIN_IDS
          if (kvc || qc) { CHAIN_SSQ
              asm volatile("s_waitcnt vmcnt(0)" ::: "memory"); __syncthreads(); __builtin_amdgcn_fence(__ATOMIC_ACQUIRE, "agent"); asm volatile("s_waitcnt vmcnt(0)" ::: "memory");
              const int t_ = tid_opaque();
              if (t_ < 256) { float a_ = 0.f; const int ns = kvc ? 8 : 12;
                  for (int q_ = 0; q_ < ns; ++q_) a_ += ssq[t_ * 16 + q_];
                  rsl[t_] = rsqrtf(a_ * (kvc ? 1.0f / KVL : 1.0f / QL) + epsf()); }
              __syncthreads();
          } }
        { CHAIN_IDS
          if (kvc || qc) { PH_P CHAIN_SSQ
              LAS float* rpl = rsl + 256;
              { const int t0 = (pm & 15) * 256;
                if (pm < 64) for (int t_ = tid_opaque(); t_ < 544; t_ += NT) {
                    const float2 e_ = t_ < 32 ? p.rope[(size_t)(t0 + (t_ >> 3) * 64) * 16 + (t_ & 7)] : p.rope[(size_t)(t0 + ((t_ - 32) >> 3)) * 16 + 8 + ((t_ - 32) & 7)];
                    rpl[2 * t_] = e_.x; rpl[2 * t_ + 1] = e_.y; }
                __syncthreads(); }
              SchedPanel S{(const char*)(p.PMLAb + (kvc ? 0 : 256)), kvc ? (const char*)(p.WtUkv + (size_t)l * 1024 * KVL) : (const char*)(p.WtUq + (size_t)l * 768 * QL),
                           (size_t)640 * 2, (size_t)(kvc ? KVL : QL) * 2, pm, kvc ? 4 : 3, kvc ? 1 : 0};
              EpiQKV E{EpiQ{p.Q, p.Qc, rpl, rsl}, EpiKV{p.K, p.V, rsl}};
              ge::gemm_engine<false>(lds, 640, kvc ? KVL : QL, kvc ? KVL : QL, S, E);
          } }
        { CHAIN_IDS PH_P
            SchedPool S{(const char*)(p.WtHy + (size_t)l * HYC * DM), (const char*)(p.WtRest + (size_t)l * 2816 * DM), (const char*)p.U,
                        kvc ? 680 + 3 * cw_ : (qc ? 884 + (cw_ - 68) : cw_ - 136), (kvc || qc) ? 1 : G - 136, kvc ? 3 : (qc ? 1 : (680 - (cw_ - 136) + (G - 136) - 1) / (G - 136))};
            EpiInproj E{p.PT, p.PTc, p.G};
            ge::gemm_engine<false>(lds, DM, DM, DM, S, E);
        }
#undef CHAIN_IDS
#undef CHAIN_SSQ
        PE(40);
        GRID_BAR();
        PE(2);
        PE(4); PB(5);
        for (int rep = 0; rep < REP_MIX; ++rep) {
        PB(31);
        { PH_P ph_attn2(p, smem, !last); }
        PE(31); PB(32);
        { PH_P ph_hyena_fft(p, l, smem); }
        PE(32); PB(33);
        if (!last) { PH_P ph_hyena_ctx(p, l, smem); }
        PE(33); }
        GRID_BAR();
        PE(5); PB(6); PB(41);
        for (int rep = 0; rep < REP_DENSE; ++rep) { PH_P
            SchedMerge S{(const char*)p.Yhy, (const char*)p.Yatt, (const char*)(p.WtHyo + (size_t)l * DM * HYW), (const char*)(p.WtMlao + (size_t)l * DM * 512), G, c, last ? 64 : 68};
            EpiMerge E{p.G, p.M1};
            ge::gemm_engine<false, TT>(lds, 512, 512, 512, S, E);
        }
        { PH_P ph_conv_experts(p, l, smem, 0, NE * 96, c - 16, G - 16); }
        PE(41);
        GRID_BAR();
        PE(6); PB(7); PB(42);
        { PH_P
            SchedDense S{(const char*)p.M1, (const char*)(p.WtOut + (size_t)l * DM * DM), (size_t)DM * 2, (size_t)DM * 2, last ? 64 : 68, 4, G, c};
            EpiOut E{p.hx, p.mod + (size_t)l * 5 * NMOD};
            ge::gemm_engine<false>(lds, DM, DM, DM, S, E);
        }
        { PH_P ph_conv_experts(p, l, smem, NE * 96, NE * 192, c - 16, G - 16); }
        PE(42);
        GRID_BAR();
        PE(7); PB(8);
        { PH_P ph_norm2_router(p, l, smem, last ? TL : TT); }
        GRID_BAR();
        PE(8); PB(9);
        for (int rep = 0; rep < REP_MOE; ++rep) { PH_P
            if (threadIdx.x < NE) cntl[threadIdx.x] = p.cnt[(l * NE + threadIdx.x) * 64];
            __syncthreads();
            if (threadIdx.x == 0) { int a = 0, t = 0; for (int e = 0; e < NE; ++e) { const int n = cntl[e]; offs[e] = a; tpre[e] = t; a += n; t += (n + 255) >> 8; } offs[64] = a; tpre[64] = t; }
            __syncthreads();
            SchedGU S{(const char*)p.U, (const char*)p.WtG, (const char*)p.WtU, p.list, tpre_l, cntl_l, G, c};
            EpiGU E{p.Hb, offs_l};
            ge::gemm_engine<true>(lds, DM, DM, DM, S, E);
        }
        GRID_BAR();
        PE(9); PB(10);
        for (int rep = 0; rep < REP_MOE; ++rep) { PH_P
            SchedDown S{(const char*)p.Hb, (const char*)p.WtD, tpre_l, cntl_l, offs_l, G, c};
            EpiDown E{p.Y, p.wl, offs_l};
            ge::gemm_engine<false>(lds, DE, DE, DE, S, E);
        }
        GRID_BAR();
        PE(10);
        if (PROBE_ID == 12) { PB(12); GRID_BAR(); PE(12); }
    }
    PB(11);
    { PH_P ph_final_c(p, offs); }
    PE(11);
    if (PROBE_ID >= 0 && blockIdx.x == PROBE_BLK && threadIdx.x == 0) { const unsigned long long t0 = wall_clock64(), wait = (unsigned long long)xbw[3] * PROBE_K; while (wall_clock64() - t0 < wait) __builtin_amdgcn_s_sleep(8); }
}

extern "C" void kernel_launch(void* const* d_in, const int* in_sizes, int n_in, void* d_out, int out_size, void* d_ws, size_t ws_size, hipStream_t stream) {
    (void)in_sizes; (void)out_size;
    if (n_in < 33 || WSO.total > ws_size) { fprintf(stderr, "kernel_launch: need 33 inputs and %zu bytes of workspace; got %d, %zu\n", (size_t)WSO.total, n_in, ws_size); return; }
    PK k{};
    for (int i = 0; i < 33; ++i) k.in[i] = (const float*)d_in[i];
    k.out = (float*)d_out; k.ws = (char*)d_ws;
    (void)hipMemsetAsync(d_ws, 0, WS_ZERO_BYTES, stream);
    static int grid = 0;
    if (!grid) {
        int dev = 0, cus = 0, per_cu = 0;
        (void)hipGetDevice(&dev);
        (void)hipDeviceGetAttribute(&cus, hipDeviceAttributeMultiprocessorCount, dev);
        (void)hipFuncSetAttribute((const void*)mega, hipFuncAttributeMaxDynamicSharedMemorySize, LDS_TOTAL);
        (void)hipOccupancyMaxActiveBlocksPerMultiprocessor(&per_cu, (const void*)mega, NT, LDS_TOTAL);
        if (per_cu < 1) fprintf(stderr, "kernel_launch: occupancy query reports %d blocks per CU\n", per_cu);
        grid = cus > 0 ? cus : 256;
    }
    hipLaunchKernelGGL(mega, dim3(grid), dim3(NT), LDS_TOTAL, stream, k);
}
```

```cpp
#include <hip/hip_runtime.h>
#include <stdint.h>
#include <stdio.h>

typedef unsigned short bf16_t;
typedef short bf16x8 __attribute__((ext_vector_type(8)));
typedef float f32x4 __attribute__((ext_vector_type(4)));
typedef unsigned u32x4 __attribute__((ext_vector_type(4)));
typedef unsigned u32x2 __attribute__((ext_vector_type(2)));

#define NT 512
#ifndef PROBE_BLK
#define PROBE_BLK 0
#endif
#ifndef PROBE_ID
#define PROBE_ID (-1)
#endif
#define PROBE_K 8
#ifndef REP_PRO
#define REP_PRO 1
#endif
#ifndef REP_DENSE
#define REP_DENSE 1
#endif
#ifndef REP_MOE
#define REP_MOE 1
#endif
#ifndef REP_MIX
#define REP_MIX 1
#endif
#ifndef REP_MISC
#define REP_MISC 1
#endif
constexpr int DM = 1024, NB = 4, SEQ = 4096, DEPTH = 4, CTXL = 256;
constexpr int TL = NB * SEQ, TC = NB * CTXL, TT = TL + TC;
constexpr int HYW = 512, HYC = 1536, QL = 384, KVL = 256, QKR = 32;
constexpr int MLAW = QL + KVL + QKR, MLA_END = HYC + MLAW, INC = MLA_END + 2 * DM;
constexpr int NH = 8, DQK = 96, DV = 64, NKEY = SEQ + CTXL;
constexpr int NE = 64, DE = 256, CAP = TT;
constexpr int NMOD = 6 * DM;
constexpr float EPSF = 1e-6f;
constexpr float QSCALE = 0.10206207261596577f * 1.4426950408889634f;

__device__ __forceinline__ bf16_t f2bf(float f) { unsigned u = __float_as_uint(f); u += 0x7FFFu + ((u >> 16) & 1u); return (bf16_t)(u >> 16); }
__device__ __forceinline__ float bf2f(bf16_t b) { return __uint_as_float(((unsigned)b) << 16); }
__device__ __forceinline__ unsigned pack2(float lo, float hi) { return (unsigned)f2bf(lo) | ((unsigned)f2bf(hi) << 16); }
__device__ __forceinline__ float epsf() { float e = EPSF; asm volatile("" : "+v"(e)); return e; }
__device__ __forceinline__ int tid_opaque() { int t = threadIdx.x; asm volatile("" : "+v"(t)); return t; }
__device__ __forceinline__ int shx_i(int v, int mask) {
    switch (mask) {
        case 1: return __builtin_amdgcn_ds_swizzle(v, (1 << 10) | 0x1F);
        case 2: return __builtin_amdgcn_ds_swizzle(v, (2 << 10) | 0x1F);
        case 4: return __builtin_amdgcn_ds_swizzle(v, (4 << 10) | 0x1F);
        case 8: return __builtin_amdgcn_ds_swizzle(v, (8 << 10) | 0x1F);
        case 16: return __builtin_amdgcn_ds_swizzle(v, (16 << 10) | 0x1F);
        default: {
            typedef unsigned u32x2s_t __attribute__((ext_vector_type(2)));
            const u32x2s_t r = __builtin_amdgcn_permlane32_swap((unsigned)v, (unsigned)v, false, false);
            return (int)(((threadIdx.x & 32u) == 0u) ? r.y : r.x); }
    }
}
__device__ __forceinline__ float shx(float v, int mask) { return __int_as_float(shx_i(__float_as_int(v), mask)); }
__device__ __forceinline__ int shx(int v, int mask) { return shx_i(v, mask); }
typedef unsigned u32x2_t __attribute__((ext_vector_type(2)));
__device__ __forceinline__ float rowmax4(float v) {
    u32x2_t r = __builtin_amdgcn_permlane16_swap(__float_as_uint(v), __float_as_uint(v), false, false);
    v = fmaxf(__uint_as_float(r.x), __uint_as_float(r.y));
    r = __builtin_amdgcn_permlane32_swap(__float_as_uint(v), __float_as_uint(v), false, false);
    return fmaxf(__uint_as_float(r.x), __uint_as_float(r.y));
}
__device__ __forceinline__ float rowsum4(float v) {
    u32x2_t r = __builtin_amdgcn_permlane16_swap(__float_as_uint(v), __float_as_uint(v), false, false);
    v = __uint_as_float(r.x) + __uint_as_float(r.y);
    r = __builtin_amdgcn_permlane32_swap(__float_as_uint(v), __float_as_uint(v), false, false);
    return __uint_as_float(r.x) + __uint_as_float(r.y);
}
__device__ __forceinline__ float wave_sum(float v) {
#pragma unroll
    for (int o = 32; o > 0; o >>= 1) v += shx(v, o);
    return v;
}


#define XB_TMO      128
#define XB_XCNT(j)  (256  + 64 * (j))
#define XB_XSUB(j)  (1280 + 64 * (j))
#define XB_XGEN(j)  (2304 + 64 * (j))
#define XB_TOP      3328
#define XB_TOPGEN   3392
#define XCD_BAR_WORDS 3456
#define XB_SPIN_CAP (1u << 22)
#define LAS __attribute__((address_space(3)))
__device__ __forceinline__ unsigned xb_ld(unsigned* p)              { return __hip_atomic_load(p, __ATOMIC_RELAXED, __HIP_MEMORY_SCOPE_AGENT); }
__device__ __forceinline__ unsigned xb_add(unsigned* p, unsigned v) { return __hip_atomic_fetch_add(p, v, __ATOMIC_RELAXED, __HIP_MEMORY_SCOPE_AGENT); }
__device__ __forceinline__ unsigned xb_xcc_id() { return (unsigned)__builtin_amdgcn_s_getreg((3 << 11) | 20) & 0xFu; }
#define XB_SPIN(cond, bar) do { unsigned _sp = 0; while (cond) { __builtin_amdgcn_s_sleep(1); \
    if ((++_sp & 255u) == 0u) { if (xb_ld(&(bar)[XB_TMO])) break; if (_sp > XB_SPIN_CAP) { atomicAdd(&(bar)[XB_TMO], 1u); break; } } } } while (0)
struct XcdBarrier { unsigned* bar; unsigned x; volatile LAS unsigned* st; };
__device__ __forceinline__ XcdBarrier xcd_barrier_post(unsigned* bar, volatile LAS unsigned* st) {
    XcdBarrier b; b.bar = bar; b.x = xb_xcc_id(); b.st = st;
    if (threadIdx.x == 0) (void)xb_add(&bar[XB_XCNT(b.x)], 1u);
    return b;
}
__device__ __forceinline__ void xcd_barrier_complete(unsigned* bar, unsigned x, unsigned& nloc, unsigned& nx) {
    const unsigned G = gridDim.x * gridDim.y * gridDim.z;
    unsigned sum, cnt, mine, sp = 0u;
    for (;;) {
        sum = 0u; cnt = 0u; mine = 0u;
#pragma unroll
        for (unsigned j = 0; j < 16; ++j) { const unsigned c = xb_ld(&bar[XB_XCNT(j)]); sum += c; cnt += (c > 0u) ? 1u : 0u; mine = (j == x) ? c : mine; }
        if (sum == G) break;
        __builtin_amdgcn_s_sleep(1);
        if ((++sp & 255u) == 0u) { if (xb_ld(&bar[XB_TMO])) break; if (sp > XB_SPIN_CAP) { atomicAdd(&bar[XB_TMO], 1u); break; } }
    }
    nloc = mine > 0u ? mine : 1u; nx = cnt > 0u ? cnt : 1u;
}
__device__ __forceinline__ void xcd_barrier(const XcdBarrier& b) {
    asm volatile("s_waitcnt vmcnt(0)" ::: "memory");
    __syncthreads();
    if (threadIdx.x == 0) {
        unsigned* bar = b.bar;
        __builtin_amdgcn_s_waitcnt(0);
        unsigned nloc = b.st[0], nx = b.st[1];
        if (nloc == 0u) { xcd_barrier_complete(bar, b.x, nloc, nx); b.st[0] = nloc; b.st[1] = nx; }
        const unsigned old = xb_add(&bar[XB_XSUB(b.x)], 1u);
        const unsigned gen = old / nloc;
        if (old + 1u == (gen + 1u) * nloc) {
            __builtin_amdgcn_fence(__ATOMIC_RELEASE, "agent");
            asm volatile("s_waitcnt vmcnt(0)" ::: "memory");
            const unsigned og = xb_add(&bar[XB_TOP], 1u);
            const unsigned tg = og / nx;
            if (og + 1u == (tg + 1u) * nx) xb_add(&bar[XB_TOPGEN], 1u);
            else XB_SPIN(xb_ld(&bar[XB_TOPGEN]) == tg, bar);
            __builtin_amdgcn_fence(__ATOMIC_ACQUIRE, "agent");
            xb_add(&bar[XB_XGEN(b.x)], 1u);
            asm volatile("s_waitcnt vmcnt(0)" ::: "memory");
        } else {
            XB_SPIN(xb_ld(&bar[XB_XGEN(b.x)]) == gen, bar);
            __builtin_amdgcn_fence(__ATOMIC_ACQUIRE, "agent");
            asm volatile("s_waitcnt vmcnt(0)" ::: "memory");
        }
    }
    __syncthreads();
}

#define WS_LIST(X) \
    X(unsigned, bar, XCD_BAR_WORDS * 4)                         \
    X(int, cnt, DEPTH * 64 * 256)                               \
    X(float, modp, (size_t)DEPTH * 32 * 5 * NMOD * 4)           \
    X(float, mod, (size_t)DEPTH * 5 * NMOD * 4)                 \
    X(float, H2a, (size_t)DEPTH * SEQ * 64 * 4) \
    X(float, H2b, (size_t)DEPTH * CTXL * 64 * 4) \
    X(float, HT1, (size_t)DEPTH * 2048 * CTXL * 4) \
    X(float, SSQ0, (size_t)DEPTH * 2048 * 128 * 4) \
    X(float, SSQ1, (size_t)DEPTH * 2048 * 8 * 4) \
    X(float, SCL0, (size_t)DEPTH * 2048 * 4) \
    X(float, SCL1, (size_t)DEPTH * 2048 * 4) \
    X(float, hx, (size_t)TT * DM * 4)                           \
    X(bf16_t, U, (size_t)TT * DM * 2)                           \
    X(bf16_t, PT, (size_t)NB * HYC * SEQ * 2)                   \
    X(bf16_t, PTc, (size_t)NB * HYC * CTXL * 2) \
    X(bf16_t, PMLAb, (size_t)TT * 640 * 2)                      \
    X(bf16_t, G, (size_t)TT * 2048 * 2)                         \
    X(bf16_t, Q, (size_t)NB * NH * SEQ * 128 * 2)               \
    X(bf16_t, Qc, (size_t)NB * NH * CTXL * 128 * 2) \
    X(bf16_t, K, (size_t)NB * NH * NKEY * DQK * 2)              \
    X(bf16_t, V, (size_t)NB * NH * NKEY * DV * 2)               \
    X(bf16_t, Yatt, (size_t)TT * 512 * 2) \
    X(bf16_t, Yhy, (size_t)TT * 512 * 2) \
    X(bf16_t, M1, (size_t)TT * DM * 2) \
    X(int, list, (size_t)NE * CAP * 4) \
    X(float, wl, (size_t)NE * CAP * 4) \
    X(int, asg, (size_t)TT * 4 * 4) \
    X(bf16_t, Hb, (size_t)(2 * TT + 256) * DE * 2) \
    X(bf16_t, Y, (size_t)2 * TT * DM * 2) \
    X(bf16_t, WtHy, (size_t)DEPTH * HYC * DM * 2)               \
    X(bf16_t, WtRest, (size_t)DEPTH * 2816 * DM * 2) \
    X(bf16_t, WtUq, (size_t)DEPTH * 768 * QL * 2) \
    X(bf16_t, WtUkv, (size_t)DEPTH * 1024 * KVL * 2) \
    X(bf16_t, WtHyo, (size_t)DEPTH * DM * HYW * 2) \
    X(bf16_t, WtMlao, (size_t)DEPTH * DM * 512 * 2) \
    X(bf16_t, WtOut, (size_t)DEPTH * DM * DM * 2) \
    X(bf16_t, WtG, (size_t)NE * DE * DM * 2)                    \
    X(bf16_t, WtU, (size_t)NE * DE * DM * 2) \
    X(bf16_t, WtD, (size_t)NE * DM * DE * 2) \
    X(float2, rope, (size_t)SEQ * 16 * 8)                       \
    X(float2, Hs, (size_t)DEPTH * HYW * 4 * 4096 * 8)           \
    X(float2, Wtab, 4096 * 8) \
    X(bf16_t, WrT, (size_t)DEPTH * 2 * 80 * DM * 2)             \
    X(float2, W2tab, 4096 * 8)
struct WsOff {
#define X(t, n, b) size_t n;
    WS_LIST(X)
#undef X
    size_t total;
};
constexpr WsOff ws_layout() {
    WsOff o{}; size_t a = 0;
#define X(t, n, b) o.n = a; a += (((size_t)(b)) + 255) & ~(size_t)255;
    WS_LIST(X)
#undef X
    o.total = a; return o;
}
constexpr WsOff WSO = ws_layout();
constexpr size_t WS_ZERO_BYTES = WSO.modp;
static_assert(WSO.Yatt - WSO.G >= (size_t)DEPTH * 2048 * SEQ * 4, "HT0 alias region too small");

struct PK { const float* in[33]; float* out; char* ws; };
struct P {
    const float *x, *c, *ctx, *c_ctx, *w_ada, *b_ada, *norm1_g, *w_in, *q_norm_g, *kv_norm_g, *w_uq, *w_ukv, *sc_w, *sc_b;
    const float *flt_w1, *flt_b1, *flt_freq, *flt_w2, *flt_b2, *flt_w3, *flt_bias, *w_hy_o, *w_mla_o, *w_out, *norm2_g;
    const float *w_rg, *b_rg, *w_re, *b_re, *w_gate, *w_up, *w_down, *final_g;
    float* out;
#define X(t, n, b) t* n;
    WS_LIST(X)
#undef X
    float* HT0;
};
typedef const __attribute__((address_space(4))) PK* KArgP;
__device__ __forceinline__ P make_p(KArgP kp) {
    P p; const KArgP& kk = kp; char* ws = kk->ws;
    p.x = kk->in[0]; p.c = kk->in[1]; p.ctx = kk->in[2]; p.c_ctx = kk->in[3]; p.w_ada = kk->in[4]; p.b_ada = kk->in[5]; p.norm1_g = kk->in[6]; p.w_in = kk->in[7];
    p.q_norm_g = kk->in[8]; p.kv_norm_g = kk->in[9]; p.w_uq = kk->in[10]; p.w_ukv = kk->in[11]; p.sc_w = kk->in[12]; p.sc_b = kk->in[13];
    p.flt_w1 = kk->in[14]; p.flt_b1 = kk->in[15]; p.flt_freq = kk->in[16]; p.flt_w2 = kk->in[17]; p.flt_b2 = kk->in[18]; p.flt_w3 = kk->in[19]; p.flt_bias = kk->in[20];
    p.w_hy_o = kk->in[21]; p.w_mla_o = kk->in[22]; p.w_out = kk->in[23]; p.norm2_g = kk->in[24]; p.w_rg = kk->in[25]; p.b_rg = kk->in[26]; p.w_re = kk->in[27]; p.b_re = kk->in[28];
    p.w_gate = kk->in[29]; p.w_up = kk->in[30]; p.w_down = kk->in[31]; p.final_g = kk->in[32];
    p.out = kk->out;
#define X(t, n, b) p.n = (t*)(ws + WSO.n);
    WS_LIST(X)
#undef X
    p.HT0 = (float*)(ws + WSO.G);
    return p;
}

constexpr int MODK = 32;
__device__ __forceinline__ void ph_mod_partial(const P& p, char* smem) {
    float* s = (float*)smem;
    const int tid = tid_opaque();
    for (int it = blockIdx.x; it < DEPTH * MODK * 3; it += gridDim.x) {
        const int l = it / (MODK * 3), kc = (it / 3) % MODK, jb = it % 3;
        __syncthreads();
        if (tid < 5 * 32) {
            const int r = tid / 32, kk = tid % 32, k = kc * 32 + kk;
            const float cv = (r < 4) ? p.c[r * DM + k] : p.c_ctx[k];
            s[tid] = cv / (1.0f + expf(-cv));
        }
        __syncthreads();
        const int j = jb * 2048 + tid * 4;
        f32x4 a0 = {0.f, 0.f, 0.f, 0.f}, a1 = a0, a2 = a0, a3 = a0, a4 = a0;
        const float* w = p.w_ada + ((size_t)l * DM + kc * 32) * NMOD + j;
#pragma unroll 8
        for (int kk = 0; kk < 32; ++kk) {
            const f32x4 wv = *(const f32x4*)(w + (size_t)kk * NMOD);
            a0 += wv * s[kk]; a1 += wv * s[32 + kk]; a2 += wv * s[64 + kk]; a3 += wv * s[96 + kk]; a4 += wv * s[128 + kk];
        }
        float* o = p.modp + ((size_t)(l * MODK + kc) * 5) * NMOD + j;
        *(f32x4*)o = a0; *(f32x4*)(o + NMOD) = a1; *(f32x4*)(o + 2 * NMOD) = a2; *(f32x4*)(o + 3 * NMOD) = a3; *(f32x4*)(o + 4 * NMOD) = a4;
    }
}

__device__ __forceinline__ void ph_filter_a(const P& p, char* smem) {
    float* zs = (float*)smem;
    float* h1s = zs + 8 * 36;
    const int tid = tid_opaque(), tt = tid >> 6, j = tid & 63;
    const int n0 = DEPTH * 512, n1 = DEPTH * 32;
    for (int it = blockIdx.x; it < n0 + n1; it += gridDim.x) {
        int l, ls, tg;
        if (it < n0) { ls = 0; l = it / 512; tg = it % 512; } else { ls = 1; l = (it - n0) / 32; tg = (it - n0) % 32; }
        const int L = ls ? CTXL : SEQ;
        const int t = tg * 8 + tt;
        __syncthreads();
        if (j < 33) {
            float f;
            if (j == 0) f = (float)t / (float)(L - 1);
            else {
                const int k = (j - 1) & 15;
                const float band = 1e-4f + (float)k * ((15.0f - 1e-4f) / 15.0f);
                const float w = 6.283185307179586f * (float)t / (float)L;
                const double ang = (double)band * (double)w;
                f = (j <= 16) ? (float)cos(ang) : (float)(-sin(ang));
            }
            zs[tt * 36 + j] = f;
        }
        __syncthreads();
        const float fr = p.flt_freq[l * 64 + j];
        float a = p.flt_b1[l * 64 + j];
        for (int i = 0; i < 33; ++i) a += zs[tt * 36 + i] * p.flt_w1[((size_t)l * 33 + i) * 64 + j];
        h1s[tt * 64 + j] = sinf(fr * a);
        __syncthreads();
        float a2 = p.flt_b2[l * 64 + j];
        for (int i = 0; i < 64; ++i) a2 += h1s[tt * 64 + i] * p.flt_w2[((size_t)l * 64 + i) * 64 + j];
        const float h2 = sinf(fr * a2);
        if (ls == 0) p.H2a[((size_t)l * SEQ + t) * 64 + j] = h2; else p.H2b[((size_t)l * CTXL + t) * 64 + j] = h2;
    }
}

typedef float f32x16 __attribute__((ext_vector_type(16)));
__device__ __forceinline__ void ph_filter_b2(const P& p, char* smem) {
    float* sA = (float*)smem;
    const int tid = tid_opaque(), lane = tid & 63, wv = tid >> 6, li = lane & 31, hf = lane >> 5;
    const int n0 = DEPTH * 128 * 8, n1 = DEPTH * 8 * 8;
    const float DA = -15.350567286626973f, DB = -3.0701134573253946f;
    for (int it = blockIdx.x; it < n0 + n1; it += gridDim.x) {
        int l, ls, tt, cg;
        if (it < n0) { ls = 0; l = it / 1024; tt = (it / 8) % 128; cg = it % 8; } else { const int i2 = it - n0; ls = 1; l = i2 / 64; tt = (i2 / 8) % 8; cg = i2 % 8; }
        const int L = ls ? CTXL : SEQ, t0 = tt * 32;
        const float* h2 = ls ? p.H2b + ((size_t)l * CTXL + t0) * 64 : p.H2a + ((size_t)l * SEQ + t0) * 64;
        __syncthreads();
        { const int r = tid >> 4, k4 = (tid & 15) * 4; const float4 v = *(const float4*)(h2 + r * 64 + k4); float* d = sA + r * 65 + k4; d[0] = v.x; d[1] = v.y; d[2] = v.z; d[3] = v.w; }
        __syncthreads();
        const int col = cg * 256 + wv * 32 + li;
        const float* wp = p.flt_w3 + (size_t)l * 64 * 2048 + col;
        f32x16 acc;
#pragma unroll
        for (int i = 0; i < 16; ++i) acc[i] = 0.f;
#pragma unroll 8
        for (int s2 = 0; s2 < 32; ++s2) {
            const int k = 2 * s2 + hf;
            acc = __builtin_amdgcn_mfma_f32_32x32x2f32(sA[li * 65 + k], wp[(size_t)k * 2048], acc, 0, 0, 0);
        }
        const int ch = col & 511;
        const float delta = fabsf(DA + (float)ch * ((DB - DA) / 511.0f));
        float q = 0.f;
        float* dst = (ls ? p.HT1 + ((size_t)l * 2048 + col) * CTXL : p.HT0 + ((size_t)l * 2048 + col) * SEQ) + t0 + 4 * hf;
#pragma unroll
        for (int g4 = 0; g4 < 4; ++g4) {
            float4 o;
            float* op = &o.x;
#pragma unroll
            for (int e = 0; e < 4; ++e) { const int t = t0 + 8 * g4 + 4 * hf + e; const float v = acc[4 * g4 + e] * expf(-((float)t / (float)(L - 1)) * delta); op[e] = v; q += v * v; }
            *(float4*)(dst + 8 * g4) = o;
        }
        q += shx(q, 32);
        if (hf == 0) { if (ls == 0) p.SSQ0[((size_t)l * 2048 + col) * 128 + tt] = q; else p.SSQ1[((size_t)l * 2048 + col) * 8 + tt] = q; }
    }
    __syncthreads();
}

__device__ __forceinline__ void ph_finalize(const P& p) {
    const int n_mod = DEPTH * 5 * NMOD, n_s = DEPTH * 2048;
    for (int i = blockIdx.x * NT + threadIdx.x; i < n_mod + 2 * n_s; i += gridDim.x * NT) {
        if (i < n_mod) {
            const int l = i / (5 * NMOD), r = (i / NMOD) % 5, j = i % NMOD;
            float a = p.b_ada[l * NMOD + j];
            for (int kc = 0; kc < MODK; ++kc) a += p.modp[((size_t)(l * MODK + kc) * 5 + r) * NMOD + j];
            p.mod[i] = a;
        } else if (i < n_mod + n_s) {
            const int k = i - n_mod; float a = 0.f;
            for (int q = 0; q < 128; ++q) a += p.SSQ0[(size_t)k * 128 + q];
            p.SCL0[k] = rsqrtf(a + epsf());
        } else {
            const int k = i - n_mod - n_s; float a = 0.f;
            for (int q = 0; q < 8; ++q) a += p.SSQ1[(size_t)k * 8 + q];
            p.SCL1[k] = rsqrtf(a + epsf());
        }
    }
}

__device__ __forceinline__ float rope_apply(float self, float partner, int d, int t) {
    const int a = d >> 4, s = (d >> 3) & 1, i = d & 7;
    const float pos = (float)(a == 0 ? (t >> 6) : (t & 63));
    const float inv = powf(10000.0f, -(float)i / 8.0f);
    const float ang = pos * inv;
    const float cs = cosf(ang), sn = sinf(ang);
    return s == 0 ? self * cs - partner * sn : partner * sn + self * cs;
}

namespace ge {
constexpr int BM = 256, BK = 64, HALF = 128, HTB = HALF * BK * 2, STAGE_BYTES = 8 * HTB, NXCD = 8, WGM = 8;
__device__ __forceinline__ int lds_byte(int r, int c) { const int st = (r >> 4) * 2 + (c >> 5), rr = r & 15, cc = c & 31, ob = rr * 64 + cc * 2; return st * 1024 + (ob ^ (((ob >> 9) & 1) << 5)); }
__device__ __forceinline__ void stage_rc(int b, int& R, int& C) { const int st = b / 1024, sb = b % 1024, swz = sb ^ (((sb >> 9) & 1) << 5); R = (st >> 1) * 16 + swz / 64; C = (st & 1) * 32 + (swz % 64) / 2; }
__device__ __forceinline__ int perm32(int rho) { const int n = rho >> 4, i = rho & 15; return 8 * (i >> 2) + 4 * n + (i & 3); }
__device__ __forceinline__ void tile_order(int L, int nM, int nN, int& pm, int& pn) {
    const int nwg = nM * nN; int wgid = L;
    { const int q = nwg / NXCD, r = nwg % NXCD, xcd = wgid % NXCD, off = wgid / NXCD; wgid = (xcd < r ? xcd * (q + 1) : r * (q + 1) + (xcd - r) * q) + off; }
    const int nig = WGM * nN, gid = wgid / nig, fm = gid * WGM, gsz = (nM - fm) < WGM ? (nM - fm) : WGM;
    pm = fm + ((wgid % nig) % gsz); pn = (wgid % nig) / gsz;
}
struct Unit { const char* a; const char* b0; const char* b1; const int* rows; int nrows; int pm, pn, kind; };
typedef f32x4 Acc[2][2][4][2];

template <bool GATHER, int ABLK = 0, class Sched, class Epi>
__device__ __forceinline__ void gemm_engine(LAS unsigned char* lds, const int lda, const int ldb, const int K, const Sched& S, const Epi& E) {
    const int tid = tid_opaque(), wid = __builtin_amdgcn_readfirstlane(tid >> 6), lane = tid & 63, wr = wid >> 2, wc = wid & 3, fr = lane & 15, fq = lane >> 4;
    const int nt = K / BK;
    int sR[2], sC[2];
    unsigned voffA[2], voffB[2];
#pragma unroll
    for (int i = 0; i < 2; ++i) { stage_rc(tid * 16 + i * 8192, sR[i], sC[i]); const int Rb = (sR[i] & ~31) + perm32(sR[i] & 31);
        voffA[i] = ABLK ? (unsigned)((sC[i] >> 3) * ABLK + sR[i]) * 16u : (unsigned)(sR[i] * lda + sC[i]) * 2u; voffB[i] = (unsigned)(Rb * ldb + sC[i]) * 2u; }
    const size_t kstep = (size_t)(BK * 2);
    const size_t hstepA = ABLK ? (size_t)HALF * 16 : (size_t)HALF * lda * 2;
    const size_t kstepA = ABLK ? (size_t)(BK / 8) * ABLK * 16 : kstep;
    const unsigned ldsw = (unsigned)wid * 1024u;
    const int aoff = lds_byte(wr * 64 + fr, fq * 8), boff = lds_byte(wc * 32 + fr, fq * 8);
    unsigned gvc[2][2], gvn[2][2];
#define GE_SA(b, h) (((b) * 2 + (h)) * HTB)
#define GE_SB(b, h) ((4 + (b) * 2 + (h)) * HTB)
#define GE_GLDS(src, bufoff, i) __builtin_amdgcn_global_load_lds((const unsigned*)(src), (LAS unsigned*)(lds + (bufoff) + ldsw + (i) * 8192), 16, 0, 0)
#define GE_STAGE_B(bufoff, bp) do { _Pragma("unroll") for (int _i = 0; _i < 2; ++_i) GE_GLDS((bp) + voffB[_i], bufoff, _i); } while (0)
#define GE_STAGE_A(bufoff, ap, h, gv) do { _Pragma("unroll") for (int _i = 0; _i < 2; ++_i) { \
        if constexpr (GATHER) GE_GLDS((ap) + (gv)[h][_i], bufoff, _i); else GE_GLDS((ap) + (size_t)(h) * hstepA + voffA[_i], bufoff, _i); } } while (0)
#define GE_STAGE_A2(bufoff, ap, h) do { _Pragma("unroll") for (int _i = 0; _i < 2; ++_i) { \
        if constexpr (GATHER) GE_GLDS((ap) + (last ? gvn[h][_i] : gvc[h][_i]), bufoff, _i); else GE_GLDS((ap) + (size_t)(h) * hstepA + voffA[_i], bufoff, _i); } } while (0)
#define GE_LDA(dst, b, h) do { _Pragma("unroll") for (int m = 0; m < 4; ++m) _Pragma("unroll") for (int k = 0; k < 2; ++k) dst[m][k] = *(const LAS bf16x8*)(lds + GE_SA(b, h) + aoff + m * 2048 + k * 1024); } while (0)
#define GE_LDB(dst, b, h) do { _Pragma("unroll") for (int n = 0; n < 2; ++n) _Pragma("unroll") for (int k = 0; k < 2; ++k) dst[n][k] = *(const LAS bf16x8*)(lds + GE_SB(b, h) + boff + n * 2048 + k * 1024); } while (0)
#define GE_MMA(ai, bj, At, Bt) do { __builtin_amdgcn_s_setprio(1); _Pragma("unroll") for (int m = 0; m < 4; ++m) _Pragma("unroll") for (int n = 0; n < 2; ++n) _Pragma("unroll") for (int k = 0; k < 2; ++k) \
        acc[ai][bj][m][n] = __builtin_amdgcn_mfma_f32_16x16x32_bf16(Bt[n][k], At[m][k], acc[ai][bj][m][n], 0, 0, 0); __builtin_amdgcn_s_setprio(0); } while (0)
#define GE_WAIT_V(n) asm volatile("s_waitcnt vmcnt(" #n ")" ::: "memory")
#define GE_WAIT_L(n) asm volatile("s_waitcnt lgkmcnt(" #n ")" ::: "memory")
#define GE_BAR __builtin_amdgcn_s_barrier()
#define GE_SCHED __builtin_amdgcn_sched_barrier(0)
#define GE_GATHER_OFFS(gv, u) do { if constexpr (GATHER) { _Pragma("unroll") for (int _h = 0; _h < 2; ++_h) _Pragma("unroll") for (int _i = 0; _i < 2; ++_i) { \
        int _r = (u).pm * BM + _h * HALF + sR[_i]; _r = _r < (u).nrows ? _r : (u).nrows - 1; (gv)[_h][_i] = (unsigned)((u).rows[_r] * lda + sC[_i]) * 2u; } } } while (0)
    Unit cur, nxt; int ui = 0;
    if (!S.next(0, cur)) return;
    Acc acc;
#pragma unroll
    for (int a = 0; a < 2; ++a)
#pragma unroll
        for (int b = 0; b < 2; ++b)
#pragma unroll
            for (int m = 0; m < 4; ++m)
#pragma unroll
                for (int n = 0; n < 2; ++n) acc[a][b][m][n] = (f32x4){0.f, 0.f, 0.f, 0.f};
    bf16x8 At[4][2], B0[2][2], B1[2][2];
    GE_GATHER_OFFS(gvc, cur);
    GE_STAGE_B(GE_SB(0, 0), cur.b0); GE_STAGE_A(GE_SA(0, 0), cur.a, 0, gvc); GE_STAGE_B(GE_SB(0, 1), cur.b1); GE_STAGE_A(GE_SA(0, 1), cur.a, 1, gvc);
    if (wr == 1) GE_BAR;
    GE_WAIT_V(4); GE_BAR;
    GE_STAGE_B(GE_SB(1, 0), cur.b0 + kstep); GE_STAGE_A(GE_SA(1, 0), cur.a + kstepA, 0, gvc); GE_STAGE_B(GE_SB(1, 1), cur.b1 + kstep);
    GE_WAIT_V(6); GE_BAR;
    for (;;) {
        const bool has_next = S.next(ui + 1, nxt);
        if (!has_next) nxt = cur;
        if constexpr (GATHER) { if (has_next) { GE_GATHER_OFFS(gvn, nxt); } else {
#pragma unroll
            for (int h = 0; h < 2; ++h)
#pragma unroll
                for (int i = 0; i < 2; ++i) gvn[h][i] = gvc[h][i]; } }
#pragma unroll 1
        for (int t = 0; t < nt; t += 2) {
            const bool last = (t == nt - 2);
            const char* a1 = cur.a + (size_t)(t + 1) * kstepA;
            const char* a2 = last ? nxt.a : cur.a + (size_t)(t + 2) * kstepA;
            const char* b20 = last ? nxt.b0 : cur.b0 + (size_t)(t + 2) * kstep;
            const char* b21 = last ? nxt.b1 : cur.b1 + (size_t)(t + 2) * kstep;
            const char* a3 = a2 + kstepA; const char* b30 = b20 + kstep; const char* b31 = b21 + kstep;
            GE_LDB(B0, 0, 0); GE_SCHED; GE_LDA(At, 0, 0); GE_STAGE_A(GE_SA(1, 1), a1, 1, gvc);
            GE_WAIT_L(8); GE_BAR; GE_WAIT_L(0); GE_MMA(0, 0, At, B0); GE_BAR; GE_SCHED;
            GE_LDB(B1, 0, 1); GE_STAGE_B(GE_SB(0, 0), b20);
            GE_BAR; GE_WAIT_L(0); GE_MMA(0, 1, At, B1); GE_BAR;
            GE_LDA(At, 0, 1); GE_STAGE_A2(GE_SA(0, 0), a2, 0);
            GE_BAR; GE_WAIT_L(0); GE_MMA(1, 0, At, B0); GE_BAR; GE_SCHED;
            GE_STAGE_B(GE_SB(0, 1), b21);
            GE_WAIT_V(6); GE_BAR; GE_MMA(1, 1, At, B1); GE_BAR;
            GE_LDB(B0, 1, 0); GE_SCHED; GE_LDA(At, 1, 0); GE_STAGE_A2(GE_SA(0, 1), a2, 1);
            GE_WAIT_L(8); GE_BAR; GE_WAIT_L(0); GE_MMA(0, 0, At, B0); GE_BAR; GE_SCHED;
            GE_LDB(B1, 1, 1); GE_STAGE_B(GE_SB(1, 0), b30);
            GE_BAR; GE_WAIT_L(0); GE_MMA(0, 1, At, B1); GE_BAR;
            GE_LDA(At, 1, 1); GE_STAGE_A2(GE_SA(1, 0), a3, 0);
            GE_BAR; GE_WAIT_L(0); GE_MMA(1, 0, At, B0); GE_BAR; GE_SCHED;
            GE_STAGE_B(GE_SB(1, 1), b31);
            GE_WAIT_V(6); GE_BAR; GE_MMA(1, 1, At, B1); GE_BAR;
        }
        E(acc, cur, wr, wc, fr, fq);
        if (!has_next) break;
#pragma unroll
        for (int a = 0; a < 2; ++a)
#pragma unroll
            for (int b = 0; b < 2; ++b)
#pragma unroll
                for (int m = 0; m < 4; ++m)
#pragma unroll
                    for (int n = 0; n < 2; ++n) acc[a][b][m][n] = (f32x4){0.f, 0.f, 0.f, 0.f};
        cur = nxt; ++ui;
        if constexpr (GATHER) {
#pragma unroll
            for (int h = 0; h < 2; ++h)
#pragma unroll
                for (int i = 0; i < 2; ++i) gvc[h][i] = gvn[h][i]; }
    }
    GE_WAIT_V(0);
    if (wr == 0) GE_BAR;
    GE_BAR;
#undef GE_SA
#undef GE_SB
#undef GE_GLDS
#undef GE_STAGE_A
#undef GE_STAGE_A2
#undef GE_STAGE_B
#undef GE_LDA
#undef GE_LDB
#undef GE_MMA
#undef GE_WAIT_V
#undef GE_WAIT_L
#undef GE_BAR
#undef GE_SCHED
#undef GE_GATHER_OFFS
}
}
__device__ __forceinline__ unsigned cvt_pk_bf16(float lo, float hi) { unsigned r; asm volatile("v_cvt_pk_bf16_f32 %0, %1, %2" : "=v"(r) : "v"(lo), "v"(hi)); return r; }
__device__ __forceinline__ u32x4 pack8(const f32x4 a, const f32x4 b) { u32x4 w; w.x = cvt_pk_bf16(a[0], a[1]); w.y = cvt_pk_bf16(a[2], a[3]); w.z = cvt_pk_bf16(b[0], b[1]); w.w = cvt_pk_bf16(b[2], b[3]); return w; }
__device__ __forceinline__ void unpack8(const u32x4 w, f32x4& a, f32x4& b) {
    a[0] = __uint_as_float(w.x << 16); a[1] = __uint_as_float(w.x & 0xFFFF0000u); a[2] = __uint_as_float(w.y << 16); a[3] = __uint_as_float(w.y & 0xFFFF0000u);
    b[0] = __uint_as_float(w.z << 16); b[1] = __uint_as_float(w.z & 0xFFFF0000u); b[2] = __uint_as_float(w.w << 16); b[3] = __uint_as_float(w.w & 0xFFFF0000u); }
__device__ __forceinline__ float sigmoidf_fast(float v) { return 1.0f / (1.0f + __expf(-v)); }

struct SchedDense {
    const char* A; const char* B; size_t arb, brb; int nM, nN, G, c;
    __device__ __forceinline__ bool next(int i, ge::Unit& u) const {
        const int L = i * G + c; if (L >= nM * nN) return false;
        int pm, pn; ge::tile_order(L, nM, nN, pm, pn);
        u.pm = pm; u.pn = pn; u.kind = 0; u.rows = nullptr; u.nrows = 0;
        u.a = A + (size_t)pm * 256 * arb; u.b0 = B + (size_t)pn * 256 * brb; u.b1 = u.b0 + 128 * brb; return true;
    }
};
struct SchedInproj {
    const char* WtHy; const char* WtRest; const char* U; int G, c;
    __device__ __forceinline__ bool next(int i, ge::Unit& u) const {
        const int L = i * G + c; if (L >= 408 + 748) return false;
        int pm, pn; u.rows = nullptr; u.nrows = 0;
        if (L < 408) { ge::tile_order(L, 6, 68, pm, pn); u.kind = 0; u.a = WtHy + (size_t)pm * 256 * 2048; u.b0 = U + (size_t)pn * 256 * 2048; }
        else { ge::tile_order(L - 408, 68, 11, pm, pn); u.kind = 1; u.a = U + (size_t)pm * 256 * 2048; u.b0 = WtRest + (size_t)pn * 256 * 2048; }
        u.b1 = u.b0 + 128 * 2048; u.pm = pm; u.pn = pn; return true;
    }
};
struct EpiInproj {
    bf16_t* PT; bf16_t* PTc; bf16_t* G;
    __device__ __forceinline__ void operator()(const ge::Acc& acc, const ge::Unit& u, int wr, int wc, int fr, int fq) const {
#pragma unroll
        for (int ai = 0; ai < 2; ++ai)
#pragma unroll
            for (int m = 0; m < 4; ++m) {
                const int r = u.pm * 256 + ai * 128 + wr * 64 + m * 16 + fr;
#pragma unroll
                for (int bj = 0; bj < 2; ++bj) {
                    const int c0 = bj * 128 + wc * 32 + fq * 8;
                    if (u.kind == 0) {
                        bf16_t* dst = (u.pn < 64) ? PT + ((size_t)((u.pn >> 4) * HYC + r)) * SEQ + (u.pn & 15) * 256 + c0
                                                  : PTc + ((size_t)((u.pn - 64) * HYC + r)) * CTXL + c0;
                        *(u32x4*)dst = pack8(acc[ai][bj][m][0], acc[ai][bj][m][1]);
                    } else {
                        const int c = (u.pn - 3) * 256 + c0;
                        f32x4 a = acc[ai][bj][m][0], b = acc[ai][bj][m][1];
#pragma unroll
                        for (int j = 0; j < 4; ++j) { a[j] = sigmoidf_fast(a[j]); b[j] = sigmoidf_fast(b[j]); }
                        *(u32x4*)(G + (size_t)r * 2048 + c) = pack8(a, b);
                    }
                }
            }
    }
};
struct EpiQ {
    bf16_t* Q; bf16_t* Qc; const LAS float* rope;
    const LAS float* rs;
    __device__ __forceinline__ void operator()(const ge::Acc& acc, const ge::Unit& u, int wr, int wc, int fr, int fq) const {
#pragma unroll
        for (int ai = 0; ai < 2; ++ai)
#pragma unroll
            for (int m = 0; m < 4; ++m) {
                const int r = u.pm * 256 + ai * 128 + wr * 64 + m * 16 + fr;
                const bool lat = r < TL;
                const int t = lat ? (r & 4095) : ((r - TL) & 255);
                const int b = lat ? (r >> 12) : ((r - TL) >> 8);
#pragma unroll
                for (int bj = 0; bj < 2; ++bj) {
                    const int c = u.pn * 256 + bj * 128 + wc * 32 + fq * 8;
                    const int h = c / 96, dd = c - h * 96;
                    const float rsc = QSCALE * rs[ai * 128 + wr * 64 + m * 16 + fr];
                    f32x4 v0 = acc[ai][bj][m][0] * rsc, v1 = acc[ai][bj][m][1] * rsc;
                    f32x4 p0, p1;
#pragma unroll
                    for (int j = 0; j < 4; ++j) { p0[j] = shx(v0[j], 16); p1[j] = shx(v1[j], 16); }
                    bf16_t* qrow = lat ? Q + ((size_t)(b * NH + h) * SEQ + t) * 128 : Qc + ((size_t)(b * NH + h) * CTXL + t) * 128;
                    if (dd < 64) *(u32x4*)(qrow + dd) = pack8(v0, v1);
                    else {
                        const int d0 = dd - 64;
                        f32x4 o0 = v0, o1 = v1;
                        if (lat) {
                            const LAS float* rp = rope + 2 * ((d0 >> 4) ? 32 + (t & 63) * 8 : ((t >> 6) & 3) * 8);
                            const bool s1 = (d0 >> 3) & 1;
#pragma unroll
                            for (int j = 0; j < 4; ++j) {
                                const float cax = rp[2 * j], cay = rp[2 * j + 1], cbx = rp[8 + 2 * j], cby = rp[9 + 2 * j];
                                o0[j] = s1 ? p0[j] * cay + v0[j] * cax : v0[j] * cax - p0[j] * cay;
                                o1[j] = s1 ? p1[j] * cby + v1[j] * cbx : v1[j] * cbx - p1[j] * cby;
                            }
                        }
                        *(u32x4*)(qrow + 64 + d0) = pack8(o0, o1);
                        *(u32x4*)(qrow + 96 + d0) = pack8(v0, v1);
                    }
                }
            }
    }
};
struct EpiKV {
    bf16_t* K; bf16_t* V; const LAS float* rs;
    __device__ __forceinline__ void operator()(const ge::Acc& acc, const ge::Unit& u, int wr, int wc, int fr, int fq) const {
#pragma unroll
        for (int ai = 0; ai < 2; ++ai)
#pragma unroll
            for (int m = 0; m < 4; ++m) {
                const int r = u.pm * 256 + ai * 128 + wr * 64 + m * 16 + fr;
                int b, key;
                if (r < TL) { b = r >> 12; key = r & 4095; } else { b = (r - TL) >> 8; key = SEQ + ((r - TL) & 255); }
#pragma unroll
                for (int bj = 0; bj < 2; ++bj) {
                    const int c = u.pn * 256 + bj * 128 + wc * 32 + fq * 8;
                    const int h = c >> 7, d = c & 127;
                    const size_t kb = (size_t)(b * NH + h) * NKEY + key;
                    bf16_t* dst = (d < 64) ? K + kb * DQK + d : V + kb * DV + (d - 64);
                    const float rk = rs[ai * 128 + wr * 64 + m * 16 + fr]; *(u32x4*)dst = pack8(acc[ai][bj][m][0] * rk, acc[ai][bj][m][1] * rk);
                }
            }
    }
};

constexpr int LDS_SSQ = ge::STAGE_BYTES + 2048;
struct EpiInprojMLA {
    bf16_t* PMLAb; bf16_t* K; const float2* rope; LAS float* ssq;
    __device__ __forceinline__ void operator()(const ge::Acc& acc, const ge::Unit& u, int wr, int wc, int fr, int fq) const {
#pragma unroll
        for (int ai = 0; ai < 2; ++ai)
#pragma unroll
            for (int m = 0; m < 4; ++m) {
                const int rl = ai * 128 + wr * 64 + m * 16 + fr, r = u.pm * 256 + rl;
#pragma unroll
                for (int bj = 0; bj < 2; ++bj) {
                    const int c0 = bj * 128 + wc * 32 + fq * 8;
                    const f32x4 a = acc[ai][bj][m][0], b = acc[ai][bj][m][1];
                    const bool isval = (u.pn < 2) || (bj == 0);
                    const bool isrope = (u.pn == 2) && (bj == 1) && (wc == 0);
                    if (isval) {
                        const int col = (u.pn == 0 ? 0 : (u.pn == 1 ? 256 : 512)) + c0;
                        *(u32x4*)(PMLAb + (size_t)r * 640 + col) = pack8(a, b);
                        float sq = (a[0] * a[0] + a[1] * a[1]) + (a[2] * a[2] + a[3] * a[3]) + (b[0] * b[0] + b[1] * b[1]) + (b[2] * b[2] + b[3] * b[3]);
                        sq += shx(sq, 16); sq += shx(sq, 32);
                        if (fq == 0) ssq[rl * 16 + (u.pn == 2 ? 8 : 0) + bj * 4 + wc] = sq;
                    } else if (isrope) {
                        f32x4 pa, pb;
#pragma unroll
                        for (int j = 0; j < 4; ++j) { pa[j] = shx(a[j], 16); pb[j] = shx(b[j], 16); }
                        int bb, key; f32x4 oa = a, ob = b;
                        if (r < TL) {
                            bb = r >> 12; key = r & 4095;
                            const float2* rp = rope + (size_t)key * 16 + (fq >> 1) * 8;
#pragma unroll
                            for (int j = 0; j < 4; ++j) { const float2 ca = rp[j], cb = rp[4 + j];
                                oa[j] = (fq & 1) ? pa[j] * ca.y + a[j] * ca.x : a[j] * ca.x - pa[j] * ca.y;
                                ob[j] = (fq & 1) ? pb[j] * cb.y + b[j] * cb.x : b[j] * cb.x - pb[j] * cb.y; }
                        } else { bb = (r - TL) >> 8; key = SEQ + ((r - TL) & 255); }
                        const u32x4 w = pack8(oa, ob);
#pragma unroll
                        for (int h = 0; h < NH; ++h) *(u32x4*)(K + ((size_t)(bb * NH + h) * NKEY + key) * DQK + 64 + fq * 8) = w;
                    }
                }
            }
    }
};
struct SchedChainIn {
    const char* U; const char* WtRest; int pm, pn0, npn;
    __device__ __forceinline__ bool next(int i, ge::Unit& u) const {
        if (i >= npn) return false;
        u.pm = pm; u.pn = pn0 + i; u.kind = 1; u.rows = nullptr; u.nrows = 0;
        u.a = U + (size_t)pm * 256 * 2048; u.b0 = WtRest + (size_t)u.pn * 256 * 2048; u.b1 = u.b0 + 128 * 2048; return true;
    }
};
struct SchedPanel {
    const char* A; const char* B; size_t arb, brb; int pm, nN, kind;
    __device__ __forceinline__ bool next(int i, ge::Unit& u) const {
        if (i >= nN) return false;
        u.pm = pm; u.pn = i; u.kind = kind; u.rows = nullptr; u.nrows = 0;
        u.a = A + (size_t)pm * 256 * arb; u.b0 = B + (size_t)i * 256 * brb; u.b1 = u.b0 + 128 * brb; return true;
    }
};
struct SchedPool {
    const char* WtHy; const char* WtRest; const char* U; int first, step, n;
    __device__ __forceinline__ bool next(int i, ge::Unit& u) const {
        if (i >= n) return false;
        const int X = first + i * step; int pm, pn; u.rows = nullptr; u.nrows = 0;
        if (X < 408) { ge::tile_order(X, 6, 68, pm, pn); u.kind = 0; u.a = WtHy + (size_t)pm * 256 * 2048; u.b0 = U + (size_t)pn * 256 * 2048; }
        else { ge::tile_order(X - 408, 68, 8, pm, pn); pn += 3; u.kind = 1; u.a = U + (size_t)pm * 256 * 2048; u.b0 = WtRest + (size_t)pn * 256 * 2048; }
        u.b1 = u.b0 + 128 * 2048; u.pm = pm; u.pn = pn; return true;
    }
};
struct EpiQKV {
    EpiQ q; EpiKV kv;
    __device__ __forceinline__ void operator()(const ge::Acc& acc, const ge::Unit& u, int wr, int wc, int fr, int fq) const { if (u.kind == 0) q(acc, u, wr, wc, fr, fq); else kv(acc, u, wr, wc, fr, fq); }
};
struct SchedMerge {
    const char* Yhy; const char* Yatt; const char* Whyo; const char* Wmlao; int G, c, nM;
    __device__ __forceinline__ bool next(int i, ge::Unit& u) const {
        const int T = (i >> 1) * G + c; if (T >= nM * 4) return false;
        const int seg = i & 1; int pm, pn; ge::tile_order(T, nM, 4, pm, pn);
        u.pm = pm; u.pn = pn; u.kind = seg; u.rows = nullptr; u.nrows = 0;
        u.a = (seg ? Yatt : Yhy) + (size_t)pm * 256 * 16; u.b0 = (seg ? Wmlao : Whyo) + (size_t)pn * 256 * 1024; u.b1 = u.b0 + 128 * 1024; return true;
    }
};
struct EpiMerge {
    const bf16_t* G; bf16_t* M1;
    __device__ __forceinline__ void operator()(const ge::Acc& acc, const ge::Unit& u, int wr, int wc, int fr, int fq) const {
#pragma unroll
        for (int ai = 0; ai < 2; ++ai) {
            u32x4 gv[4][2], mv[4][2];
#pragma unroll
            for (int m = 0; m < 4; ++m) {
                const int r = u.pm * 256 + ai * 128 + wr * 64 + m * 16 + fr;
#pragma unroll
                for (int bj = 0; bj < 2; ++bj) {
                    const int c = u.pn * 256 + bj * 128 + wc * 32 + fq * 8;
                    gv[m][bj] = *(const u32x4*)(G + (size_t)r * 2048 + u.kind * DM + c);
                    if (u.kind) mv[m][bj] = *(const u32x4*)(M1 + (size_t)r * DM + c);
                }
            }
#pragma unroll
            for (int m = 0; m < 4; ++m) {
                const int r = u.pm * 256 + ai * 128 + wr * 64 + m * 16 + fr;
#pragma unroll
                for (int bj = 0; bj < 2; ++bj) {
                    const int c = u.pn * 256 + bj * 128 + wc * 32 + fq * 8;
                    f32x4 g0, g1; unpack8(gv[m][bj], g0, g1);
                    f32x4 o0 = g0 * acc[ai][bj][m][0], o1 = g1 * acc[ai][bj][m][1];
                    if (u.kind) { f32x4 q0, q1; unpack8(mv[m][bj], q0, q1); o0 += q0; o1 += q1; }
                    *(u32x4*)(M1 + (size_t)r * DM + c) = pack8(o0, o1);
                }
            }
        }
    }
};
__device__ __forceinline__ float4 ld_hx4(const bf16_t* q) { const u32x2 w = *(const u32x2*)q; return make_float4(__uint_as_float(w.x << 16), __uint_as_float(w.x & 0xFFFF0000u), __uint_as_float(w.y << 16), __uint_as_float(w.y & 0xFFFF0000u)); }
__device__ __forceinline__ void st_hx4(bf16_t* q, const float4 v) { u32x2 w; w.x = pack2(v.x, v.y); w.y = pack2(v.z, v.w); *(u32x2*)q = w; }
struct EpiOut {
    bf16_t* hx; const float* mod;
    __device__ __forceinline__ void operator()(const ge::Acc& acc, const ge::Unit& u, int wr, int wc, int fr, int fq) const {
        const int b = u.pm < 64 ? (u.pm >> 4) : 4;
        f32x4 gg[2][2];
#pragma unroll
        for (int bj = 0; bj < 2; ++bj) { const float* g = mod + (size_t)b * NMOD + 2 * DM + u.pn * 256 + bj * 128 + wc * 32 + fq * 8; gg[bj][0] = *(const f32x4*)g; gg[bj][1] = *(const f32x4*)(g + 4); }
#pragma unroll
        for (int ai = 0; ai < 2; ++ai) {
            u32x4 hv[4][2];
#pragma unroll
            for (int m = 0; m < 4; ++m) {
                const int r = u.pm * 256 + ai * 128 + wr * 64 + m * 16 + fr;
#pragma unroll
                for (int bj = 0; bj < 2; ++bj) hv[m][bj] = *(const u32x4*)(hx + (size_t)r * DM + u.pn * 256 + bj * 128 + wc * 32 + fq * 8);
            }
#pragma unroll
            for (int m = 0; m < 4; ++m) {
                const int r = u.pm * 256 + ai * 128 + wr * 64 + m * 16 + fr;
#pragma unroll
                for (int bj = 0; bj < 2; ++bj) {
                    f32x4 h0, h1; unpack8(hv[m][bj], h0, h1);
                    *(u32x4*)(hx + (size_t)r * DM + u.pn * 256 + bj * 128 + wc * 32 + fq * 8) = pack8(h0 + gg[bj][0] * acc[ai][bj][m][0], h1 + gg[bj][1] * acc[ai][bj][m][1]);
                }
            }
        }
    }
};
struct SchedGU {
    const char* U; const char* WtG; const char* WtU; const int* list; const LAS int* tpre; const LAS int* cntl; int G, c;
    __device__ __forceinline__ bool next(int i, ge::Unit& u) const {
        const int L = i * G + ((G & 7) ? c : (c & 7) * (G >> 3) + (c >> 3)); if (L >= 2 * tpre[64]) return false;
        const int rt = L >> 1, half = L & 1; int e = 0;
#pragma unroll
        for (int st_ = 32; st_ > 0; st_ >>= 1) { if (tpre[e + st_] <= rt) e += st_; }
        u.kind = e; u.pm = rt - tpre[e]; u.pn = half; u.rows = list + (size_t)e * CAP; u.nrows = cntl[e];
        u.a = U; u.b0 = WtG + ((size_t)e * DE + half * 128) * 2048; u.b1 = WtU + ((size_t)e * DE + half * 128) * 2048; return true;
    }
};
struct EpiGU {
    bf16_t* H; const LAS int* offs;
    __device__ __forceinline__ void operator()(const ge::Acc& acc, const ge::Unit& u, int wr, int wc, int fr, int fq) const {
        const int o = offs[u.kind];
#pragma unroll
        for (int ai = 0; ai < 2; ++ai)
#pragma unroll
            for (int m = 0; m < 4; ++m) {
                const int r = u.pm * 256 + ai * 128 + wr * 64 + m * 16 + fr;
                if (r < u.nrows) {
                    const int c = u.pn * 128 + wc * 32 + fq * 8;
                    f32x4 g0 = acc[ai][0][m][0], g1 = acc[ai][0][m][1];
#pragma unroll
                    for (int j = 0; j < 4; ++j) { g0[j] = g0[j] * sigmoidf_fast(g0[j]) * acc[ai][1][m][0][j]; g1[j] = g1[j] * sigmoidf_fast(g1[j]) * acc[ai][1][m][1][j]; }
                    *(u32x4*)(H + (size_t)(o + r) * DE + c) = pack8(g0, g1);
                }
            }
    }
};
struct SchedDown {
    const char* H; const char* WtD; const LAS int* tpre; const LAS int* cntl; const LAS int* offs; int G, c;
    __device__ __forceinline__ bool next(int i, ge::Unit& u) const {
        const int L = i * G + ((G & 7) ? c : (c & 7) * (G >> 3) + (c >> 3)); if (L >= 4 * tpre[64]) return false;
        const int rt = L >> 2, pn = L & 3; int e = 0;
#pragma unroll
        for (int st_ = 32; st_ > 0; st_ >>= 1) { if (tpre[e + st_] <= rt) e += st_; }
        u.kind = e; u.pm = rt - tpre[e]; u.pn = pn; u.rows = nullptr; u.nrows = cntl[e];
        u.a = H + ((size_t)offs[e] + (size_t)u.pm * 256) * 512; u.b0 = WtD + ((size_t)e * DM + pn * 256) * 512; u.b1 = u.b0 + 128 * 512; return true;
    }
};
struct EpiDown {
    bf16_t* Y; const float* wl; const LAS int* offs;
    __device__ __forceinline__ void operator()(const ge::Acc& acc, const ge::Unit& u, int wr, int wc, int fr, int fq) const {
        const int o = offs[u.kind];
        float w[2][4];
#pragma unroll
        for (int ai = 0; ai < 2; ++ai)
#pragma unroll
            for (int m = 0; m < 4; ++m) { const int r = u.pm * 256 + ai * 128 + wr * 64 + m * 16 + fr; w[ai][m] = wl[(size_t)u.kind * CAP + (r < u.nrows ? r : 0)]; }
#pragma unroll
        for (int ai = 0; ai < 2; ++ai)
#pragma unroll
            for (int m = 0; m < 4; ++m) {
                const int r = u.pm * 256 + ai * 128 + wr * 64 + m * 16 + fr;
                if (r < u.nrows) {
#pragma unroll
                    for (int bj = 0; bj < 2; ++bj) {
                        const int c = u.pn * 256 + bj * 128 + wc * 32 + fq * 8;
                        *(u32x4*)(Y + (size_t)(o + r) * DM + c) = pack8(acc[ai][bj][m][0] * w[ai][m], acc[ai][bj][m][1] * w[ai][m]);
                    }
                }
            }
    }
};


typedef short s16x4 __attribute__((ext_vector_type(4)));
#define AT_THR 8.0f
__device__ __forceinline__ void ph_attn2(const P& p, char* smem, bool with_ctx) {
    constexpr int KS = 112, VS = 80;
    constexpr int NSTG = NKEY / 128;
    bf16_t* sK = (bf16_t*)smem;
    bf16_t* sV = sK + 3 * 128 * KS;
    const int tid = tid_opaque(), lane = tid & 63, wv = tid >> 6, fr = lane & 15, g = lane >> 4;
    const int NUL = NB * NH * 16, NUC = with_ctx ? NB * NH : 0;
    const int kc0 = tid / 12, kp0 = tid % 12, kc1 = (512 + tid) / 12, kp1 = (512 + tid) % 12;
    const int vk = tid >> 3, vp = tid & 7;
#define AT_LOADK(st_, hs_) do { const bf16_t* kb_ = Kp + (size_t)((st_) * 128 + (hs_) * 64) * DQK; kr0 = *(const u32x4*)(kb_ + kc0 * DQK + kp0 * 8); if (tid < 256) kr1 = *(const u32x4*)(kb_ + kc1 * DQK + kp1 * 8); } while (0)
#define AT_LOADV(st_, hs_) do { vr0 = *(const u32x4*)(Vp + (size_t)((st_) * 128 + (hs_) * 64) * DV + vk * DV + vp * 8); } while (0)
#define AT_STOREK(buf_, hs_) do { bf16_t* d_ = sK + ((buf_) * 128 + (hs_) * 64) * KS; *(u32x4*)(d_ + kc0 * KS + kp0 * 8) = kr0; if (tid < 256) *(u32x4*)(d_ + kc1 * KS + kp1 * 8) = kr1; } while (0)
#define AT_STOREV(buf_, hs_) do { *(u32x4*)(sV + ((buf_) * 128 + (hs_) * 64) * VS + vk * VS + vp * 8) = vr0; } while (0)
#define AT_LDKF(dst, mk) do { _Pragma("unroll") for (int ks = 0; ks < 3; ++ks) dst[ks] = *(const bf16x8*)(sKn + (mk) * 16 * KS + ks * 32); } while (0)
#define AT_MMAS(src, mk) do { sN[mk][0] = (f32x4){0.f, 0.f, 0.f, 0.f}; sN[mk][1] = (f32x4){0.f, 0.f, 0.f, 0.f}; \
        _Pragma("unroll") for (int ks = 0; ks < 3; ++ks) _Pragma("unroll") for (int nq = 0; nq < 2; ++nq) { const bf16x8 bq_ = (ks < 2) ? qf[nq][ks] : (ctxn ? qf[nq][3] : qf[nq][2]); \
            sN[mk][nq] = __builtin_amdgcn_mfma_f32_16x16x32_bf16(src[ks], bq_, sN[mk][nq], 0, 0, 0); } } while (0)
#define AT_EXPS(nq) do { float r_ = (nq) ? rs[0] - rs[0] : 0.f; _Pragma("unroll") for (int mk = 0; mk < 4; ++mk) _Pragma("unroll") for (int r = 0; r < 4; ++r) { const float pv = __builtin_amdgcn_exp2f(sC[mk][nq][r] - mn[nq]); r_ += pv; sC[mk][nq][r] = pv; } rs[nq] = r_; } while (0)
#define AT_SUBTILE(sKn_, ctxn_, sVb_) do { \
        const bf16_t* sKn = (sKn_) + fr * KS + g * 8; const bool ctxn = (ctxn_); \
        bf16x8 kfA[3], kfB[3]; bf16x8 pf[2][2]; float mn[2], mxq[2], rs[2]; \
        AT_LDKF(kfA, 0); \
        AT_MMAS(kfA, 0); AT_LDKF(kfB, 1); \
        _Pragma("unroll") for (int nq = 0; nq < 2; ++nq) { float mx = sC[0][nq][0]; \
            _Pragma("unroll") for (int mk = 0; mk < 4; ++mk) _Pragma("unroll") for (int r = 0; r < 4; ++r) mx = fmaxf(mx, sC[mk][nq][r]); \
            mxq[nq] = rowmax4(mx); } \
          \
          \
        if (__any((mxq[0] - m[0] > AT_THR) || (mxq[1] - m[1] > AT_THR))) { \
            _Pragma("unroll") for (int nq = 0; nq < 2; ++nq) { const float mnew_ = fmaxf(m[nq], mxq[nq]); const float a_ = __builtin_amdgcn_exp2f(m[nq] - mnew_); m[nq] = mnew_; lsum[nq] *= a_; \
                _Pragma("unroll") for (int md = 0; md < 4; ++md) oT[md][nq] *= a_; } } \
        mn[0] = m[0]; mn[1] = m[1]; \
        __builtin_amdgcn_sched_barrier(0); \
        AT_MMAS(kfB, 1); AT_LDKF(kfA, 2); AT_EXPS(0); \
        __builtin_amdgcn_sched_barrier(0); \
        AT_MMAS(kfA, 2); AT_LDKF(kfB, 3); AT_EXPS(1); \
        __builtin_amdgcn_sched_barrier(0); \
        AT_MMAS(kfB, 3); \
        _Pragma("unroll") for (int nq = 0; nq < 2; ++nq) { lsum[nq] += rs[nq]; \
            _Pragma("unroll") for (int kp = 0; kp < 2; ++kp) { const u32x4 w_ = pack8(sC[2 * kp][nq], sC[2 * kp + 1][nq]); pf[kp][nq] = __builtin_bit_cast(bf16x8, w_); } } \
        __builtin_amdgcn_sched_barrier(0); \
        _Pragma("unroll") for (int kp = 0; kp < 2; ++kp) _Pragma("unroll") for (int md = 0; md < 4; ++md) { \
            const bf16_t* a0_ = (sVb_) + (32 * kp + 4 * g + (fr >> 2)) * VS + 16 * md + 4 * (fr & 3); \
            const s16x4 lo_ = __builtin_amdgcn_ds_read_tr16_b64_v4i16((LAS s16x4*)a0_); \
            const s16x4 hi_ = __builtin_amdgcn_ds_read_tr16_b64_v4i16((LAS s16x4*)(a0_ + 16 * VS)); \
            const bf16x8 vf_ = __builtin_shufflevector(lo_, hi_, 0, 1, 2, 3, 4, 5, 6, 7); \
            _Pragma("unroll") for (int nq = 0; nq < 2; ++nq) oT[md][nq] = __builtin_amdgcn_mfma_f32_16x16x32_bf16(vf_, pf[kp][nq], oT[md][nq], 0, 0, 0); } \
        _Pragma("unroll") for (int mk = 0; mk < 4; ++mk) { sC[mk][0] = sN[mk][0]; sC[mk][1] = sN[mk][1]; } \
    } while (0)
    for (int u = blockIdx.x; u < NUL + NUC; u += gridDim.x) {
        const bool isctx = u >= NUL;
        int b, h, q0;
        if (!isctx) {
            int bh, qb;
            if (gridDim.x == 256) { const int c = u & 255, r = u >> 8, x = c & 7, sl = c >> 3; bh = r * 16 + x * 2 + (sl >> 4); qb = sl & 15; } else { bh = u / 16; qb = u % 16; }
            b = bh / NH; h = bh % NH; q0 = qb * 256;
        } else { const int v = u - NUL; b = v / NH; h = v % NH; q0 = 0; }
        const bf16_t* Qp = (isctx ? p.Qc + ((size_t)(b * NH + h) * CTXL + q0) * 128 : p.Q + ((size_t)(b * NH + h) * SEQ + q0) * 128) + (size_t)(wv * 32) * 128;
        bf16x8 qf[2][4];
#pragma unroll
        for (int nq = 0; nq < 2; ++nq)
#pragma unroll
            for (int ks = 0; ks < 4; ++ks) qf[nq][ks] = *(const bf16x8*)(Qp + (size_t)(nq * 16 + fr) * 128 + ks * 32 + g * 8);
        const bf16_t* Kp = p.K + (size_t)(b * NH + h) * NKEY * DQK;
        const bf16_t* Vp = p.V + (size_t)(b * NH + h) * NKEY * DV;
        f32x4 oT[4][2]; float m[2], lsum[2];
#pragma unroll
        for (int nq = 0; nq < 2; ++nq) { m[nq] = -INFINITY; lsum[nq] = 0.f;
#pragma unroll
            for (int md = 0; md < 4; ++md) oT[md][nq] = (f32x4){0.f, 0.f, 0.f, 0.f}; }
        const int st0 = isctx ? 32 : 0;
        u32x4 kr0, kr1 = (u32x4){0u, 0u, 0u, 0u}, vr0;
        f32x4 sC[4][2], sN[4][2];
        __syncthreads();
        AT_LOADK(st0, 0); AT_LOADV(st0, 0); AT_STOREK(0, 0); AT_STOREV(0, 0);
        AT_LOADK(st0, 1); AT_LOADV(st0, 1); AT_STOREK(0, 1); AT_STOREV(0, 1);
        AT_LOADK(st0 + 1, 0); AT_STOREK(1, 0);
        AT_LOADK(st0 + 1, 1);
        __syncthreads();
        {
            const bf16_t* sKn = sK + fr * KS + g * 8; const bool ctxn = st0 >= 32;
            bf16x8 kfA[3];
#pragma unroll
            for (int mk = 0; mk < 4; ++mk) { AT_LDKF(kfA, mk); AT_MMAS(kfA, mk); }
#pragma unroll
            for (int mk = 0; mk < 4; ++mk) { sC[mk][0] = sN[mk][0]; sC[mk][1] = sN[mk][1]; }
        }
        AT_STOREK(1, 1);
        __syncthreads();
        int kb = 0;
        for (int st = st0; st < NSTG; ++st) {
            const int bufc = (st - st0) & 1;
            const int st1 = st + 1 < NSTG ? st + 1 : NSTG - 1, st2 = st + 2 < NSTG ? st + 2 : NSTG - 1;
            const int kb1 = kb == 2 ? 0 : kb + 1, kb2 = kb1 == 2 ? 0 : kb1 + 1;
            const bf16_t* sKc = sK + kb * 128 * KS; const bf16_t* sKx = sK + kb1 * 128 * KS; const bf16_t* sVc = sV + bufc * 128 * VS;
            AT_LOADK(st2, 0); AT_LOADV(st1, 0);
            AT_SUBTILE(sKc + 64 * KS, st >= 32, sVc);
            AT_STOREK(kb2, 0); AT_STOREV(bufc ^ 1, 0);
            AT_LOADK(st2, 1); AT_LOADV(st1, 1);
            AT_SUBTILE(sKx, st1 >= 32, sVc + 64 * VS);
            AT_STOREK(kb2, 1); AT_STOREV(bufc ^ 1, 1);
            __syncthreads();
            kb = kb1;
        }
        const size_t rbase = (isctx ? (size_t)TL + b * CTXL : (size_t)b * SEQ) + q0 + wv * 32;
#pragma unroll
        for (int nq = 0; nq < 2; ++nq) {
            const float l = rowsum4(lsum[nq]);
            const float inv = 1.0f / l;
#pragma unroll
            for (int md = 0; md < 4; ++md) {
                u32x2 o; o.x = cvt_pk_bf16(oT[md][nq][0] * inv, oT[md][nq][1] * inv); o.y = cvt_pk_bf16(oT[md][nq][2] * inv, oT[md][nq][3] * inv);
                *(u32x2*)(p.Yatt + ((size_t)(h * 8 + md * 2 + (g >> 1)) * TT + rbase + nq * 16 + fr) * 8 + 4 * (g & 1)) = o;
            }
        }
    }
#undef AT_LOADK
#undef AT_LOADV
#undef AT_STOREK
#undef AT_STOREV
#undef AT_LDKF
#undef AT_MMAS
#undef AT_EXPS
#undef AT_SUBTILE
}

constexpr int RT_PITCH = 1024 + 8;
__device__ __forceinline__ void ph_norm2_router(const P& p, int l, char* smem, int nrows_total) {
    bf16_t* thi = (bf16_t*)smem;
    bf16_t* tlo = thi + 16 * RT_PITCH;
    float* part = (float*)(tlo + 16 * RT_PITCH);
    float* lgs = part + 8 * 16 * 80;
    const int tid = tid_opaque(), lane = tid & 63, wv = tid >> 6, fr = lane & 15, g = lane >> 4;
    const float* ng = p.norm2_g + l * DM;
    const bf16_t* whi = p.WrT + (size_t)(l * 2 + 0) * 80 * DM; const bf16_t* wlo = p.WrT + (size_t)(l * 2 + 1) * 80 * DM;
    bf16x8 bh[4][5];
#pragma unroll
    for (int ks = 0; ks < 4; ++ks)
#pragma unroll
        for (int nt = 0; nt < 5; ++nt) { const size_t o = (size_t)(nt * 16 + fr) * DM + wv * 128 + ks * 32 + g * 8; bh[ks][nt] = *(const bf16x8*)(whi + o); }
    float* bias_s = lgs + 16 * 80;
    float* recs = bias_s + 80;
    int nrec = 0;
    if (tid < 72) bias_s[tid] = tid < 64 ? p.b_re[l * NE + tid] : p.b_rg[l * 8 + tid - 64];
    for (int rb = blockIdx.x * 16; rb < nrows_total; rb += gridDim.x * 16) {
        __syncthreads();
        {
            const int lr0 = wv * 2, row0 = rb + lr0;
            const int b = row0 < TL ? (row0 >> 12) : 4;
            const bf16_t* hp = (const bf16_t*)p.hx + (size_t)row0 * DM;
            const float* md = p.mod + ((size_t)l * 5 + b) * NMOD + 3 * DM;
            float4 xv[2][4], gg4[4], sh4[4], sc4[4];
#pragma unroll
            for (int i = 0; i < 4; ++i) { const int j = i * 256 + lane * 4; xv[0][i] = ld_hx4(hp + j); xv[1][i] = ld_hx4(hp + DM + j); gg4[i] = *(const float4*)(ng + j); sh4[i] = *(const float4*)(md + j); sc4[i] = *(const float4*)(md + DM + j); }
            float ss0 = 0.f, ss1 = 0.f;
#pragma unroll
            for (int i = 0; i < 4; ++i) { ss0 += xv[0][i].x * xv[0][i].x + xv[0][i].y * xv[0][i].y + xv[0][i].z * xv[0][i].z + xv[0][i].w * xv[0][i].w;
                                          ss1 += xv[1][i].x * xv[1][i].x + xv[1][i].y * xv[1][i].y + xv[1][i].z * xv[1][i].z + xv[1][i].w * xv[1][i].w; }
#pragma unroll
            for (int o = 32; o > 0; o >>= 1) { ss0 += shx(ss0, o); ss1 += shx(ss1, o); }
            const float rs2[2] = {rsqrtf(ss0 * (1.0f / DM) + epsf()), rsqrtf(ss1 * (1.0f / DM) + epsf())};
#pragma unroll
            for (int i = 0; i < 4; ++i) {
                const int j = i * 256 + lane * 4;
                const float4 gg = gg4[i], sh = sh4[i], sc = sc4[i];
#pragma unroll
                for (int rr = 0; rr < 2; ++rr) {
                    const int lr = lr0 + rr; const float rs = rs2[rr];
                    float y[4];
                    y[0] = (xv[rr][i].x * rs * gg.x) * (1.f + sc.x) + sh.x; y[1] = (xv[rr][i].y * rs * gg.y) * (1.f + sc.y) + sh.y;
                    y[2] = (xv[rr][i].z * rs * gg.z) * (1.f + sc.z) + sh.z; y[3] = (xv[rr][i].w * rs * gg.w) * (1.f + sc.w) + sh.w;
                    bf16_t h[4], lo[4];
#pragma unroll
                    for (int e = 0; e < 4; ++e) { h[e] = f2bf(y[e]); lo[e] = f2bf(y[e] - bf2f(h[e])); }
                    u32x2 oh; oh.x = (unsigned)h[0] | ((unsigned)h[1] << 16); oh.y = (unsigned)h[2] | ((unsigned)h[3] << 16);
                    u32x2 ol; ol.x = (unsigned)lo[0] | ((unsigned)lo[1] << 16); ol.y = (unsigned)lo[2] | ((unsigned)lo[3] << 16);
                    *(u32x2*)(p.U + (size_t)(row0 + rr) * DM + j) = oh;
                    *(u32x2*)(thi + lr * RT_PITCH + j) = oh; *(u32x2*)(tlo + lr * RT_PITCH + j) = ol;
                }
            }
        }
        __syncthreads();
        f32x4 acc[5];
#pragma unroll
        for (int nt = 0; nt < 5; ++nt) acc[nt] = (f32x4){0.f, 0.f, 0.f, 0.f};
#pragma unroll
        for (int ks = 0; ks < 4; ++ks) {
            const int k0 = wv * 128 + ks * 32 + g * 8;
            const bf16x8 ah = *(const bf16x8*)(thi + fr * RT_PITCH + k0), al = *(const bf16x8*)(tlo + fr * RT_PITCH + k0);
#pragma unroll
            for (int nt = 0; nt < 5; ++nt) {
                const bf16x8 blf = *(const bf16x8*)(wlo + (size_t)(nt * 16 + fr) * DM + k0);
                acc[nt] = __builtin_amdgcn_mfma_f32_16x16x32_bf16(ah, bh[ks][nt], acc[nt], 0, 0, 0);
                acc[nt] = __builtin_amdgcn_mfma_f32_16x16x32_bf16(al, bh[ks][nt], acc[nt], 0, 0, 0);
                acc[nt] = __builtin_amdgcn_mfma_f32_16x16x32_bf16(ah, blf, acc[nt], 0, 0, 0);
            }
        }
#pragma unroll
        for (int nt = 0; nt < 5; ++nt)
#pragma unroll
            for (int r = 0; r < 4; ++r) part[(wv * 16 + g * 4 + r) * 80 + nt * 16 + fr] = acc[nt][r];
        __syncthreads();
        for (int i = tid; i < 16 * 80; i += NT) { float a = 0.f;
#pragma unroll
            for (int w = 0; w < 8; ++w) a += part[w * 16 * 80 + i];
            lgs[i] = a; }
        __syncthreads();
        if (tid < 128) {
            const int lrw = tid >> 3, i = tid & 7, row = rb + lrw;
            const float* le = lgs + lrw * 80; const float* lg = le + 64;
            const float* bre = bias_s; const float* brg = bias_s + 64;
            const float lgi = lg[i];
            float bv = lgi + brg[i]; int bi = i; float mx = lgi;
#pragma unroll
            for (int o = 1; o < 8; o <<= 1) { const float ov = shx(bv, o); const int oi = shx(bi, o); if (ov > bv || (ov == bv && oi < bi)) { bv = ov; bi = oi; } mx = fmaxf(mx, shx(mx, o)); }
            const int gs = bi;
            float den = __expf(lgi - mx);
#pragma unroll
            for (int o = 1; o < 8; o <<= 1) den += shx(den, o);
            const float pg = __expf(lg[gs] - mx) / den;
            const float lei = le[gs * 8 + i];
            float k0v = lei + bre[gs * 8 + i]; int k0i = i;
            const float keyi = k0v;
#pragma unroll
            for (int o = 1; o < 8; o <<= 1) { const float ov = shx(k0v, o); const int oi = shx(k0i, o); if (ov > k0v || (ov == k0v && oi < k0i)) { k0v = ov; k0i = oi; } }
            const int i0 = k0i;
            float k1v = (i == i0) ? -INFINITY : keyi; int k1i = (i == i0) ? 8 : i;
#pragma unroll
            for (int o = 1; o < 8; o <<= 1) { const float ov = shx(k1v, o); const int oi = shx(k1i, o); if (ov > k1v || (ov == k1v && oi < k1i)) { k1v = ov; k1i = oi; } }
            const int i1 = k1i;
            if (i == 0) {
                const float w0 = 1.0f / (1.0f + __expf(le[gs * 8 + i1] - le[gs * 8 + i0])), w1 = 1.0f - w0;
                float* rc = recs + (nrec * 16 + lrw) * 4;
                rc[0] = __int_as_float((gs * 8 + i0) | ((gs * 8 + i1) << 8)); rc[1] = pg * w0; rc[2] = pg * w1; rc[3] = __int_as_float(row);
            }
        }
        ++nrec;
    }
    __syncthreads();
    for (int q = tid; q < nrec * 16; q += NT) {
        const float* rc = recs + q * 4;
        const int ee = __float_as_int(rc[0]), e0 = ee & 255, e1 = ee >> 8, row = __float_as_int(rc[3]);
        const int r0 = atomicAdd(p.cnt + (l * NE + e0) * 64, 1), r1 = atomicAdd(p.cnt + (l * NE + e1) * 64, 1);
        p.list[(size_t)e0 * CAP + r0] = row; p.wl[(size_t)e0 * CAP + r0] = rc[1];
        p.list[(size_t)e1 * CAP + r1] = row; p.wl[(size_t)e1 * CAP + r1] = rc[2];
        *(int4*)(p.asg + (size_t)row * 4) = make_int4(e0, r0, e1, r1);
    }
    __syncthreads();
}

typedef float v2f __attribute__((ext_vector_type(2)));
#define HD __device__ __forceinline__
HD v2f vfma(v2f a, v2f b, v2f c) { return __builtin_elementwise_fma(a, b, c); }
HD v2f twk(v2f w) { return w.yy * (v2f){-1.f, 1.f}; }
HD v2f cmulk(v2f a, v2f w, v2f wk) { return vfma(a.yx, wk, a * w.xx); }
HD v2f cmulck(v2f a, v2f w, v2f wk) { return vfma(a.yx, -wk, a * w.xx); }
HD v2f cmul(v2f a, v2f w) { return cmulk(a, w, twk(w)); }
HD v2f cmulc(v2f a, v2f w) { return cmulck(a, w, twk(w)); }
HD int fphys(int i) { return (i >> 8) * 272 + ((i >> 4) & 15) * 17 + (i & 15); }
constexpr int FBUF = 4352;
template <bool INV> HD void dft4(v2f& x0, v2f& x1, v2f& x2, v2f& x3) {
    const v2f s02 = x0 + x2, d02 = x0 - x2, s13 = x1 + x3, d13 = x1 - x3;
    const v2f kj = INV ? (v2f){-1.f, 1.f} : (v2f){1.f, -1.f};
    x0 = s02 + s13; x2 = s02 - s13; x1 = vfma(d13.yx, kj, d02); x3 = vfma(d13.yx, -kj, d02);
}
template <bool INV> HD void dft16(v2f (&v)[16]) {
#pragma unroll
    for (int b = 0; b < 4; ++b) dft4<INV>(v[b], v[4 + b], v[8 + b], v[12 + b]);
    float C1 = 0.92387953251128674f, S1 = 0.38268343236508977f, C2 = 0.70710678118654752f;
    asm volatile("" : "+v"(C1), "+v"(S1), "+v"(C2));
#define TW(idx, cr, ci) v[idx] = vfma(v[idx].yx, INV ? (v2f){(ci), -(ci)} : (v2f){-(ci), (ci)}, v[idx] * (v2f){(cr), (cr)})
    TW(4 * 1 + 1, C1, -S1);
    TW(4 * 1 + 2, C2, -C2);
    TW(4 * 1 + 3, S1, -C1);
    TW(4 * 2 + 1, C2, -C2);
    v[4 * 2 + 2] = v[4 * 2 + 2].yx * (INV ? (v2f){-1.f, 1.f} : (v2f){1.f, -1.f});
    TW(4 * 2 + 3, -C2, -C2);
    TW(4 * 3 + 1, S1, -C1);
    TW(4 * 3 + 2, -C2, -C2);
    TW(4 * 3 + 3, -C1, S1);
#undef TW
#pragma unroll
    for (int c = 0; c < 4; ++c) dft4<INV>(v[4 * c], v[4 * c + 1], v[4 * c + 2], v[4 * c + 3]);
#define SW(i, j) { const v2f t_ = v[i]; v[i] = v[j]; v[j] = t_; }
    SW(1, 4) SW(2, 8) SW(3, 12) SW(6, 9) SW(7, 13) SW(11, 14)
#undef SW
}
template <class BUF, class TW> HD void fwd_pass0(int u, v2f (&v)[16], BUF buf, TW W) {
    dft16<false>(v);
    const v2f w1 = W[u], w1k = twk(w1); v2f wr = w1;
    const int pb = fphys(u);
    buf[pb] = v[0];
#pragma unroll
    for (int r = 1; r < 16; ++r) { v[r] = cmul(v[r], wr); buf[pb + 272 * r] = v[r]; wr = cmulk(wr, w1, w1k); }
}
template <class BUF, class TW> HD void fwd_pass1(int u, v2f (&v)[16], BUF buf, TW W) {
    const int j = u & 15, pb = (u >> 4) * 272 + j;
#pragma unroll
    for (int q = 0; q < 16; ++q) v[q] = buf[pb + 17 * q];
    dft16<false>(v);
    const v2f w1 = W[16 * j], w1k = twk(w1); v2f wr = w1;
    buf[pb] = v[0];
#pragma unroll
    for (int r = 1; r < 16; ++r) { v[r] = cmul(v[r], wr); buf[pb + 17 * r] = v[r]; wr = cmulk(wr, w1, w1k); }
}
template <class BUF> HD void fwd_pass2(int u, v2f (&v)[16], BUF buf) {
    const int pb = (u >> 4) * 272 + (u & 15) * 17;
#pragma unroll
    for (int q = 0; q < 16; ++q) v[q] = buf[pb + q];
    dft16<false>(v);
}
template <class BUF> HD void inv_passA(int u, v2f (&v)[16], BUF buf) {
    dft16<true>(v);
    const int pb = (u >> 4) * 272 + (u & 15) * 17;
#pragma unroll
    for (int r = 0; r < 16; ++r) buf[pb + r] = v[r];
}
template <class BUF, class TW> HD void inv_passB(int u, v2f (&v)[16], BUF buf, TW W) {
    const int j = u & 15, pb = (u >> 4) * 272 + j;
    const v2f w1 = W[16 * j], w1k = twk(w1); v2f wr = w1;
    v[0] = buf[pb];
#pragma unroll
    for (int q = 1; q < 16; ++q) { v[q] = cmulc(buf[pb + 17 * q], wr); wr = cmulk(wr, w1, w1k); }
    dft16<true>(v);
#pragma unroll
    for (int r = 0; r < 16; ++r) buf[pb + 17 * r] = v[r];
}
template <class BUF, class TW> HD void inv_passC(int u, v2f (&v)[16], BUF buf, TW W) {
    const v2f w1 = W[u], w1k = twk(w1); v2f wr = w1;
    const int pb = fphys(u);
    v[0] = buf[pb];
#pragma unroll
    for (int q = 1; q < 16; ++q) { v[q] = cmulc(buf[pb + 272 * q], wr); wr = cmulk(wr, w1, w1k); }
    dft16<true>(v);
}
HD int digitrev(int i) { return ((i & 15) << 8) | (i & 0xF0) | (i >> 8); }

#undef HD
constexpr int FFT_LDS_W = 2 * FBUF * 8;
constexpr int FFT_LDS_STG = FFT_LDS_W + 4096 * 8;
constexpr int STG_ROW = SEQ + 16;
constexpr int FFT_LDS_W2 = FFT_LDS_STG + 2 * STG_ROW * 2;
constexpr int FFT_LDS_END = FFT_LDS_W2 + 4096 * 8;
__device__ __forceinline__ void fft_load_w(const P& p, char* smem) {
    float2* Wl = (float2*)(smem + FFT_LDS_W); float2* W2l = (float2*)(smem + FFT_LDS_W2);
    __syncthreads();
    { const int t_ = tid_opaque();
      float4 a_[4], b_[4];
#pragma unroll
      for (int k = 0; k < 4; ++k) { a_[k] = ((const float4*)p.Wtab)[t_ + NT * k]; b_[k] = ((const float4*)p.W2tab)[t_ + NT * k]; }
#pragma unroll
      for (int k = 0; k < 4; ++k) { ((float4*)Wl)[t_ + NT * k] = a_[k]; ((float4*)W2l)[t_ + NT * k] = b_[k]; } }
    __syncthreads();
}
__device__ __forceinline__ void ph_tables(const P& p) {
    for (int i = blockIdx.x * NT + tid_opaque(); i < 8192; i += gridDim.x * NT) {
        float sn, cs;
        if (i < 4096) { sincospif((float)i * (1.0f / 2048.0f), &sn, &cs); p.Wtab[i] = make_float2(cs, -sn); }
        else { sincospif((float)(i - 4096) * (1.0f / 4096.0f), &sn, &cs); p.W2tab[i - 4096] = make_float2(cs, -sn); }
    }
    for (int i = blockIdx.x * NT + tid_opaque(); i < DEPTH * 80 * DM; i += gridDim.x * NT) {
        const int l = i / (80 * DM), n = (i / DM) % 80, kk = i % DM;
        const float v = n < 64 ? p.w_re[((size_t)l * DM + kk) * NE + n] : (n < 72 ? p.w_rg[((size_t)l * DM + kk) * 8 + (n - 64)] : 0.f);
        const bf16_t h = f2bf(v);
        p.WrT[((size_t)(l * 2 + 0) * 80 + n) * DM + kk] = h; p.WrT[((size_t)(l * 2 + 1) * 80 + n) * DM + kk] = f2bf(v - bf2f(h));
    }
}
__device__ __forceinline__ void ph_spectra(const P& p, char* smem) {
    v2f* bufE = (v2f*)smem; v2f* bufO = bufE + FBUF; const v2f* Wl = (const v2f*)(smem + FFT_LDS_W); const v2f* W2l = (const v2f*)(smem + FFT_LDS_W2);
    const int tid = tid_opaque(), half = tid >> 8, u = tid & 255;
    v2f* buf = half ? bufO : bufE;
    fft_load_w(p, smem);
    for (int un = blockIdx.x; un < DEPTH * HYW; un += gridDim.x) {
        const int l = un / HYW, c = un % HYW;
        const float* hf0 = p.HT0 + ((size_t)l * 2048 + c) * SEQ;        const float s_f0 = p.SCL0[l * 2048 + c];
        const float* hb0 = p.HT0 + ((size_t)l * 2048 + 512 + c) * SEQ;  const float s_b0 = p.SCL0[l * 2048 + 512 + c];
        const float* hf1 = p.HT0 + ((size_t)l * 2048 + 1024 + c) * SEQ; const float s_f1 = p.SCL0[l * 2048 + 1024 + c];
        const float* hb1 = p.HT0 + ((size_t)l * 2048 + 1536 + c) * SEQ; const float s_b1 = p.SCL0[l * 2048 + 1536 + c];
        v2f v[16];
#pragma unroll
        for (int q = 0; q < 16; ++q) {
            const int j = 2 * (u + 256 * q) + half;
            float a, b;
            if (j < SEQ) { a = hf0[j] * s_f0; b = hf1[j] * s_f1; } else if (j == SEQ) { a = 0.f; b = 0.f; } else { a = hb0[2 * SEQ - j] * s_b0; b = hb1[2 * SEQ - j] * s_b1; }
            if (j == 0) { a += p.flt_bias[(l * 2 + 0) * HYW + c]; b += p.flt_bias[(l * 2 + 1) * HYW + c]; }
            v[q] = (v2f){a, b};
        }
        __syncthreads();
        fwd_pass0(u, v, buf, Wl); __syncthreads();
        fwd_pass1(u, v, buf, Wl); __syncthreads();
        fwd_pass2(u, v, buf);
#pragma unroll
        for (int r = 0; r < 16; ++r) buf[fphys(16 * u + r)] = v[r];
        __syncthreads();
        unsigned* out = (unsigned*)p.Hs + (size_t)(l * HYW + c) * 4 * 4096;
        for (int idx = tid; idx < 8192; idx += NT) {
            const int par = idx >> 12, pi = idx & 4095, kp = 2 * digitrev(pi) + par, kpp = (8192 - kp) & 8191;
            const int k1 = kp & 4095, k2 = kpp & 4095;
            v2f t1 = cmul(W2l[k1], bufO[fphys(digitrev(k1))]); if (kp >= 4096) t1 = -t1;
            v2f t2 = cmul(W2l[k2], bufO[fphys(digitrev(k2))]); if (kpp >= 4096) t2 = -t2;
            const v2f F = bufE[fphys(digitrev(k1))] + t1, Gq = bufE[fphys(digitrev(k2))] + t2;
            const float sc = 0.5f / 8192.0f;
            out[(0 * 2 + par) * 4096 + pi] = pack2((F.x + Gq.x) * sc, (F.y - Gq.y) * sc);
            out[(1 * 2 + par) * 4096 + pi] = pack2((F.y + Gq.y) * sc, -(F.x - Gq.x) * sc);
        }
    }
    __syncthreads();
}
__device__ __forceinline__ void fft_conv(int half, int u, v2f (&v)[16], const v2f* W2g, const unsigned* Hso, v2f* buf, const v2f* Wl) {
    u32x4 hreg[4];
    const u32x4* hp = (const u32x4*)(Hso + (size_t)half * 4096 + 16 * u);
#pragma unroll
    for (int r4 = 0; r4 < 4; ++r4) hreg[r4] = hp[r4];
    if (half) {
#pragma unroll
        for (int q = 0; q < 16; ++q) v[q] = cmul(v[q], W2g[u + 256 * q]);
    }
    fwd_pass0(u, v, buf, Wl); __syncthreads();
    fwd_pass1(u, v, buf, Wl); __syncthreads();
    fwd_pass2(u, v, buf);
#pragma unroll
    for (int r4 = 0; r4 < 4; ++r4) { const u32x4 h = hreg[r4];
#define HSV(w_) ((v2f){__uint_as_float((w_) << 16), __uint_as_float((w_) & 0xFFFF0000u)})
        v[4 * r4] = cmul(v[4 * r4], HSV(h.x)); v[4 * r4 + 1] = cmul(v[4 * r4 + 1], HSV(h.y)); v[4 * r4 + 2] = cmul(v[4 * r4 + 2], HSV(h.z)); v[4 * r4 + 3] = cmul(v[4 * r4 + 3], HSV(h.w));
#undef HSV
    }
    inv_passA(u, v, buf); __syncthreads();
    inv_passB(u, v, buf, Wl); __syncthreads();
    inv_passC(u, v, buf, Wl);
    if (half) {
#pragma unroll
        for (int r = 0; r < 16; ++r) v[r] = cmulc(v[r], W2g[u + 256 * r]);
    }
}

__device__ __forceinline__ void ph_hyena_fft(const P& p, int l, char* smem) {
    v2f* buf0 = (v2f*)smem; v2f* buf1 = buf0 + FBUF; const v2f* Wl = (const v2f*)(smem + FFT_LDS_W);
    bf16_t* stg = (bf16_t*)(smem + FFT_LDS_STG) + 8;
    const v2f* W2l = (const v2f*)(smem + FFT_LDS_W2);
    const int tid = tid_opaque(), half = tid >> 8, u = tid & 255;
    v2f* buf = half ? buf1 : buf0;
    const int pu = fphys(u);
    if (tid < 32) { const int rw = tid >> 4, k = tid & 15; (stg - 8 + rw * STG_ROW)[k < 8 ? k : SEQ + k] = 0; }
    fft_load_w(p, smem);
    for (int c = blockIdx.x; c < HYW; c += gridDim.x) {
        const unsigned* Hs0 = (const unsigned*)p.Hs + (size_t)(l * HYW + c) * 4 * 4096; const unsigned* Hs1 = Hs0 + 2 * 4096;
        float scw[3][4];
#pragma unroll
        for (int w = 0; w < 3; ++w) { const int col = w * HYW + c; scw[w][0] = p.sc_w[(size_t)(l * 3 + 0) * HYC + col]; scw[w][1] = p.sc_w[(size_t)(l * 3 + 1) * HYC + col]; scw[w][2] = p.sc_w[(size_t)(l * 3 + 2) * HYC + col]; scw[w][3] = p.sc_b[l * HYC + col]; }
#define HY_TAP(sb, k, w) (scw[w][3] + scw[w][0] * __uint_as_float((unsigned)(sb)[(k) - 1] << 16) + scw[w][1] * __uint_as_float((unsigned)(sb)[(k)] << 16) + scw[w][2] * __uint_as_float((unsigned)(sb)[(k) + 1] << 16))
        u32x4 ra, rb;
#define HY_LOAD(sel, pr_) do { const bf16_t* r0_ = p.PT + ((size_t)(2 * (pr_)) * HYC + (sel) * HYW + c) * SEQ + tid * 8; ra = *(const u32x4*)r0_; rb = *(const u32x4*)(r0_ + (size_t)HYC * SEQ); } while (0)
#define HY_STAGE() do { *(u32x4*)(stg + tid * 8) = ra; *(u32x4*)(stg + STG_ROW + tid * 8) = rb; } while (0)
        HY_LOAD(0, 0);
        for (int pr = 0; pr < 2; ++pr) {
            const LAS bf16_t* sbA = (const LAS bf16_t*)stg + u; asm volatile("" : "+v"(sbA));
            const LAS bf16_t* sbB = sbA + STG_ROW;
            __syncthreads();
            HY_STAGE();
            __syncthreads();
            v2f v[16];
#pragma unroll
            for (int q = 0; q < 16; ++q) v[q] = (v2f){HY_TAP(sbA, 256 * q, 0), HY_TAP(sbB, 256 * q, 0)};
            HY_LOAD(1, pr);
            fft_conv(half, u, v, W2l, Hs0, buf, Wl);
            if (half) {
#pragma unroll
                for (int r = 0; r < 16; ++r) buf1[pu + 272 * r] = v[r];
            }
            HY_STAGE();
            __syncthreads();
            if (!half) {
#pragma unroll
                for (int r = 0; r < 16; ++r) {
                    const v2f y = v[r] + buf1[pu + 272 * r];
                    const float xa = HY_TAP(sbA, 256 * r, 1), xb = HY_TAP(sbB, 256 * r, 1);
                    const v2f z1 = (v2f){xa, xb} * y;
                    v[r] = z1; buf1[pu + 272 * r] = z1;
                }
            }
            HY_LOAD(2, pr);
            __syncthreads();
            if (half) {
#pragma unroll
                for (int r = 0; r < 16; ++r) v[r] = buf1[pu + 272 * r];
            }
            fft_conv(half, u, v, W2l, Hs1, buf, Wl);
            if (half) {
#pragma unroll
                for (int r = 0; r < 16; ++r) buf1[pu + 272 * r] = v[r];
            }
            HY_STAGE();
            if (pr == 0) HY_LOAD(0, 1);
            __syncthreads();
            if (!half) {
                bf16_t* oA = p.Yhy + ((size_t)(c >> 3) * TT + (size_t)(2 * pr) * SEQ + u) * 8 + (c & 7); bf16_t* oB = oA + (size_t)SEQ * 8;
#pragma unroll
                for (int r = 0; r < 16; ++r) {
                    const v2f y = v[r] + buf1[pu + 272 * r];
                    const float xa = HY_TAP(sbA, 256 * r, 2), xb = HY_TAP(sbB, 256 * r, 2);
                    oA[(size_t)(256 * r) * 8] = f2bf(xa * y.x);
                    oB[(size_t)(256 * r) * 8] = f2bf(xb * y.y);
                }
            }
        }
#undef HY_LOAD
#undef HY_STAGE
#undef HY_TAP
    }
    __syncthreads();
}

__device__ __forceinline__ float4 moe_combine4(const P& p, int lc, int b, size_t s0, size_t s1, int j, float4 hv) {
    const u32x2 y0 = *(const u32x2*)(p.Y + s0 * DM + j), y1 = *(const u32x2*)(p.Y + s1 * DM + j);
    const float4 g = *(const float4*)(p.mod + ((size_t)lc * 5 + b) * NMOD + 5 * DM + j);
    hv.x += g.x * (__uint_as_float(y0.x << 16) + __uint_as_float(y1.x << 16));
    hv.y += g.y * (__uint_as_float(y0.x & 0xFFFF0000u) + __uint_as_float(y1.x & 0xFFFF0000u));
    hv.z += g.z * (__uint_as_float(y0.y << 16) + __uint_as_float(y1.y << 16));
    hv.w += g.w * (__uint_as_float(y0.y & 0xFFFF0000u) + __uint_as_float(y1.y & 0xFFFF0000u));
    return hv;
}
__device__ __forceinline__ void ph_norm1c(const P& p, int l, const int* offs) {
    const int tid = tid_opaque(), lane = tid & 63, wv = tid >> 6;
    const float* ng = p.norm1_g + l * DM;
    for (int rb = blockIdx.x * 16; rb < TT; rb += gridDim.x * 16) {
        const int row0 = rb + wv * 2;
        const int b = row0 < TL ? (row0 >> 12) : 4;
        bf16_t* hp = (bf16_t*)p.hx + (size_t)row0 * DM;
        const float* src = row0 < TL ? p.x + (size_t)row0 * DM : p.ctx + (size_t)(row0 - TL) * DM;
        const float* md = p.mod + ((size_t)l * 5 + b) * NMOD;
        float4 xv[2][4];
        u32x2 ya[2][4], yb[2][4];
        if (l > 0) {
            const int4 a0 = *(const int4*)(p.asg + (size_t)row0 * 4), a1 = *(const int4*)(p.asg + (size_t)(row0 + 1) * 4);
            const size_t s00 = (size_t)offs[a0.x] + a0.y, s01 = (size_t)offs[a0.z] + a0.w, s10 = (size_t)offs[a1.x] + a1.y, s11 = (size_t)offs[a1.z] + a1.w;
#pragma unroll
            for (int i = 0; i < 4; ++i) { const int j = i * 256 + lane * 4;
                ya[0][i] = *(const u32x2*)(p.Y + s00 * DM + j); yb[0][i] = *(const u32x2*)(p.Y + s01 * DM + j);
                ya[1][i] = *(const u32x2*)(p.Y + s10 * DM + j); yb[1][i] = *(const u32x2*)(p.Y + s11 * DM + j); }
        }
#pragma unroll
        for (int i = 0; i < 4; ++i) { const int j = i * 256 + lane * 4;
            if (l > 0) { xv[0][i] = ld_hx4(hp + j); xv[1][i] = ld_hx4(hp + DM + j); } else { xv[0][i] = *(const float4*)(src + j); xv[1][i] = *(const float4*)(src + DM + j); } }
        float ss[2] = {0.f, 0.f};
#pragma unroll
        for (int rr = 0; rr < 2; ++rr)
#pragma unroll
            for (int i = 0; i < 4; ++i) {
                const int j = i * 256 + lane * 4;
                if (l > 0) {
                    const float4 g = *(const float4*)(p.mod + ((size_t)(l - 1) * 5 + b) * NMOD + 5 * DM + j);
                    const u32x2 y0 = ya[rr][i], y1 = yb[rr][i];
                    xv[rr][i].x += g.x * (__uint_as_float(y0.x << 16) + __uint_as_float(y1.x << 16));
                    xv[rr][i].y += g.y * (__uint_as_float(y0.x & 0xFFFF0000u) + __uint_as_float(y1.x & 0xFFFF0000u));
                    xv[rr][i].z += g.z * (__uint_as_float(y0.y << 16) + __uint_as_float(y1.y << 16));
                    xv[rr][i].w += g.w * (__uint_as_float(y0.y & 0xFFFF0000u) + __uint_as_float(y1.y & 0xFFFF0000u));
                }
                st_hx4(hp + (size_t)rr * DM + j, xv[rr][i]);
                ss[rr] += xv[rr][i].x * xv[rr][i].x + xv[rr][i].y * xv[rr][i].y + xv[rr][i].z * xv[rr][i].z + xv[rr][i].w * xv[rr][i].w;
            }
        ss[0] = wave_sum(ss[0]); ss[1] = wave_sum(ss[1]);
        const float rs[2] = {rsqrtf(ss[0] * (1.0f / DM) + epsf()), rsqrtf(ss[1] * (1.0f / DM) + epsf())};
#pragma unroll
        for (int i = 0; i < 4; ++i) {
            const int j = i * 256 + lane * 4;
            const float4 g = *(const float4*)(ng + j), sh = *(const float4*)(md + j), sc = *(const float4*)(md + DM + j);
#pragma unroll
            for (int rr = 0; rr < 2; ++rr) {
                u32x2 o;
                o.x = pack2((xv[rr][i].x * rs[rr] * g.x) * (1.f + sc.x) + sh.x, (xv[rr][i].y * rs[rr] * g.y) * (1.f + sc.y) + sh.y);
                o.y = pack2((xv[rr][i].z * rs[rr] * g.z) * (1.f + sc.z) + sh.z, (xv[rr][i].w * rs[rr] * g.w) * (1.f + sc.w) + sh.w);
                *(u32x2*)(p.U + (size_t)(row0 + rr) * DM + j) = o;
            }
        }
    }
}
__device__ __forceinline__ void ph_final_c(const P& p, const int* offs) {
    const int tid = tid_opaque(), lane = tid & 63, wv = tid >> 6;
    for (int rb = blockIdx.x * 8; rb < TL; rb += gridDim.x * 8) {
        const int row = rb + wv, b = row >> 12;
        const bf16_t* hp = (const bf16_t*)p.hx + (size_t)row * DM;
        const int4 a = *(const int4*)(p.asg + (size_t)row * 4);
        const size_t s0 = (size_t)offs[a.x] + a.y, s1 = (size_t)offs[a.z] + a.w;
        float4 xv[4]; float ss = 0.f;
#pragma unroll
        for (int i = 0; i < 4; ++i) {
            const int j = i * 256 + lane * 4;
            xv[i] = moe_combine4(p, DEPTH - 1, b, s0, s1, j, ld_hx4(hp + j));
            ss += xv[i].x * xv[i].x + xv[i].y * xv[i].y + xv[i].z * xv[i].z + xv[i].w * xv[i].w;
        }
        ss = wave_sum(ss);
        const float rs = rsqrtf(ss * (1.0f / DM) + epsf());
#pragma unroll
        for (int i = 0; i < 4; ++i) {
            const int j = i * 256 + lane * 4;
            const float4 g = *(const float4*)(p.final_g + j);
            float4 y; y.x = xv[i].x * rs * g.x; y.y = xv[i].y * rs * g.y; y.z = xv[i].z * rs * g.z; y.w = xv[i].w * rs * g.w;
            *(float4*)(p.out + (size_t)row * DM + j) = y;
        }
    }
}


__device__ __forceinline__ void ph_hyena_ctx(const P& p, int l, char* smem) {
    constexpr int L = CTXL;
    const int tid = tid_opaque(), hf = tid >> 8, tl = tid & 255, b = tl >> 6, t0 = (tl & 63) * 4;
    float* kern0 = (float*)smem + hf * (8 * L);
    float* kern1 = kern0 + 2 * L;
    float* zb = kern1 + 2 * L;
    const float* HT = p.HT1 + (size_t)l * 2048 * L;
    const float* SCL = p.SCL1 + l * 2048;
    for (int cb = blockIdx.x; cb < HYW; cb += 2 * gridDim.x) {
        const int c = cb + hf * gridDim.x;
        const bool act = c < HYW;
        __syncthreads();
        float uv[3][4];
        if (act) {
            const float kb0 = tl > 0 ? HT[(size_t)(512 + c) * L + (L - tl)] * SCL[512 + c] : 0.f, kb1 = tl > 0 ? HT[(size_t)(1536 + c) * L + (L - tl)] * SCL[1536 + c] : 0.f;
            const float kf0 = HT[(size_t)c * L + tl] * SCL[c], kf1 = HT[(size_t)(1024 + c) * L + tl] * SCL[1024 + c];
            kern0[tl] = kb0; kern1[tl] = kb1; kern0[L + tl] = kf0; kern1[L + tl] = kf1;
#pragma unroll
            for (int w = 0; w < 3; ++w) {
                const int col = w * HYW + c;
                const bf16_t* pr = p.PTc + ((size_t)b * HYC + col) * L + t0;
                const float w0 = p.sc_w[(size_t)(l * 3 + 0) * HYC + col], w1 = p.sc_w[(size_t)(l * 3 + 1) * HYC + col], w2 = p.sc_w[(size_t)(l * 3 + 2) * HYC + col], bb = p.sc_b[l * HYC + col];
                const u32x2 mid = *(const u32x2*)pr;
                float e[6];
                e[0] = t0 > 0 ? bf2f(pr[-1]) : 0.f; e[5] = t0 + 4 < L ? bf2f(pr[4]) : 0.f;
                e[1] = __uint_as_float(mid.x << 16); e[2] = __uint_as_float(mid.x & 0xFFFF0000u); e[3] = __uint_as_float(mid.y << 16); e[4] = __uint_as_float(mid.y & 0xFFFF0000u);
#pragma unroll
                for (int j = 0; j < 4; ++j) uv[w][j] = bb + w0 * e[j] + w1 * e[j + 1] + w2 * e[j + 2];
            }
            *(float4*)(zb + b * L + t0) = make_float4(uv[0][0], uv[0][1], uv[0][2], uv[0][3]);
        }
        __syncthreads();
        const float* zr = zb + b * L;
        float a[4];
#define CTX_CONV(kern) do { a[0] = 0.f; a[1] = 0.f; a[2] = 0.f; a[3] = 0.f; \
            float4 khi = *(const float4*)((kern) + t0 + L); \
            _Pragma("unroll 4") for (int m = 0; m < L / 4; ++m) { \
                const float4 klo = *(const float4*)((kern) + t0 + L - 4 * m - 4); const float4 z = *(const float4*)(zr + 4 * m); \
                a[0] += z.x * khi.x; a[1] += z.x * khi.y; a[2] += z.x * khi.z; a[3] += z.x * khi.w; \
                a[0] += z.y * klo.w; a[1] += z.y * khi.x; a[2] += z.y * khi.y; a[3] += z.y * khi.z; \
                a[0] += z.z * klo.z; a[1] += z.z * klo.w; a[2] += z.z * khi.x; a[3] += z.z * khi.y; \
                a[0] += z.w * klo.y; a[1] += z.w * klo.z; a[2] += z.w * klo.w; a[3] += z.w * khi.x; \
                khi = klo; } } while (0)
        float z1[4];
        if (act) {
            CTX_CONV(kern0);
            const float bias0 = p.flt_bias[(l * 2 + 0) * HYW + c];
#pragma unroll
            for (int j = 0; j < 4; ++j) z1[j] = uv[1][j] * (a[j] + bias0 * uv[0][j]);
        }
        __syncthreads();
        if (act) *(float4*)(zb + b * L + t0) = make_float4(z1[0], z1[1], z1[2], z1[3]);
        __syncthreads();
        if (act) {
            CTX_CONV(kern1);
            const float bias1 = p.flt_bias[(l * 2 + 1) * HYW + c];
            bf16_t* o = p.Yhy + ((size_t)(c >> 3) * TT + (size_t)TL + b * CTXL + t0) * 8 + (c & 7);
#pragma unroll
            for (int j = 0; j < 4; ++j) o[j * 8] = f2bf(uv[2][j] * (a[j] + bias1 * z1[j]));
        }
#undef CTX_CONV
    }
    __syncthreads();
}

__device__ __forceinline__ void conv_tile(bf16_t* tile, const float* src, int ld, int c0, int ncols, int K, bf16_t* dst, int kt, int ntile, const float* kscale = nullptr) {
    const int tid = tid_opaque();
    const int k = tid >> 3, n8 = (tid & 7) * 8, nbase = ntile * 64;
    float4 x0 = make_float4(0.f, 0.f, 0.f, 0.f), x1 = x0;
    if (nbase + n8 < ncols) { const float* sp = src + (size_t)(kt * 64 + k) * ld + c0 + nbase + n8; x0 = *(const float4*)sp; x1 = *(const float4*)(sp + 4); }
    if (kscale) { const float ks = kscale[kt * 64 + k]; x0.x *= ks; x0.y *= ks; x0.z *= ks; x0.w *= ks; x1.x *= ks; x1.y *= ks; x1.z *= ks; x1.w *= ks; }
    __syncthreads();
    tile[(n8 + 0) * 72 + k] = f2bf(x0.x); tile[(n8 + 1) * 72 + k] = f2bf(x0.y); tile[(n8 + 2) * 72 + k] = f2bf(x0.z); tile[(n8 + 3) * 72 + k] = f2bf(x0.w);
    tile[(n8 + 4) * 72 + k] = f2bf(x1.x); tile[(n8 + 5) * 72 + k] = f2bf(x1.y); tile[(n8 + 6) * 72 + k] = f2bf(x1.z); tile[(n8 + 7) * 72 + k] = f2bf(x1.w);
    __syncthreads();
    const int n = tid >> 3, k8 = (tid & 7) * 8;
    if (nbase + n < ncols) *(u32x4*)(dst + (size_t)(nbase + n) * K + kt * 64 + k8) = *(const u32x4*)(tile + n * 72 + k8);
}
constexpr int DENSE_TILES = 1720;
__device__ __forceinline__ void ph_conv_dense(const P& p, char* smem) {
    bf16_t* tile = (bf16_t*)smem;
    for (int id = blockIdx.x; id < DEPTH * DENSE_TILES; id += gridDim.x) {
        const int l = id / DENSE_TILES; int r = id % DENSE_TILES;
        const float* win = p.w_in + (size_t)l * DM * INC;
        if (r < 384) conv_tile(tile, win, INC, 0, HYC, DM, p.WtHy + (size_t)l * HYC * DM, r / 24, r % 24);
        else if ((r -= 384) < 64) conv_tile(tile, win, INC, HYC + QL, KVL, DM, p.WtRest + (size_t)l * 2816 * DM, r / 4, r % 4);
        else if ((r -= 64) < 96) conv_tile(tile, win, INC, HYC, QL, DM, p.WtRest + ((size_t)l * 2816 + 256) * DM, r / 6, r % 6);
        else if ((r -= 96) < 16) conv_tile(tile, win, INC, HYC + QL + KVL, QKR, DM, p.WtRest + ((size_t)l * 2816 + 640) * DM, r, 0);
        else if ((r -= 16) < 512) conv_tile(tile, win, INC, MLA_END, 2048, DM, p.WtRest + ((size_t)l * 2816 + 768) * DM, r / 32, r % 32);
        else if ((r -= 512) < 72) conv_tile(tile, p.w_uq + (size_t)l * QL * 768, 768, 0, 768, QL, p.WtUq + (size_t)l * 768 * QL, r / 12, r % 12, p.q_norm_g + l * QL);
        else if ((r -= 72) < 64) conv_tile(tile, p.w_ukv + (size_t)l * KVL * 1024, 1024, 0, 1024, KVL, p.WtUkv + (size_t)l * 1024 * KVL, r / 16, r % 16, p.kv_norm_g + l * KVL);
        else if ((r -= 64) < 128) conv_tile(tile, p.w_hy_o + (size_t)l * HYW * DM, DM, 0, DM, HYW, p.WtHyo + (size_t)l * DM * HYW, r / 16, r % 16);
        else if ((r -= 128) < 128) conv_tile(tile, p.w_mla_o + (size_t)l * 512 * DM, DM, 0, DM, 512, p.WtMlao + (size_t)l * DM * 512, r / 16, r % 16);
        else { r -= 128; conv_tile(tile, p.w_out + (size_t)l * DM * DM, DM, 0, DM, DM, p.WtOut + (size_t)l * DM * DM, r / 16, r % 16); }
    }
    const int nz = DEPTH * 96 * DM / 8;
    for (int i = blockIdx.x * NT + threadIdx.x; i < nz + SEQ * 16; i += gridDim.x * NT) {
        if (i < nz) { const int l = i / (96 * DM / 8), o = i % (96 * DM / 8); *(u32x4*)(p.WtRest + ((size_t)l * 2816 + MLAW) * DM + (size_t)o * 8) = (u32x4){0u, 0u, 0u, 0u}; }
        else { const int k = i - nz, t = k >> 4, a = (k >> 3) & 1, ii = k & 7; const float ang = (float)(a == 0 ? (t >> 6) : (t & 63)) * powf(10000.0f, -(float)ii / 8.0f); p.rope[k] = make_float2(cosf(ang), sinf(ang)); }
    }
}
__device__ __forceinline__ void ph_conv_experts(const P& p, int l, char* smem, int t_begin, int t_end, int worker, int nworkers) {
    bf16_t* tile = (bf16_t*)smem;
    if (worker >= 0)
    for (int id = t_begin + worker; id < t_end; id += nworkers) {
        const int e = id / 192; int r = id % 192;
        const size_t le = (size_t)l * NE + e;
        if (r < 64) conv_tile(tile, p.w_gate + le * DM * DE, DE, 0, DE, DM, p.WtG + (size_t)e * DE * DM, r / 4, r % 4);
        else if (r < 128) { r -= 64; conv_tile(tile, p.w_up + le * DM * DE, DE, 0, DE, DM, p.WtU + (size_t)e * DE * DM, r / 4, r % 4); }
        else { r -= 128; conv_tile(tile, p.w_down + le * DE * DM, DM, 0, DM, DE, p.WtD + (size_t)e * DM * DE, r / 16, r % 16); }
    }
    __syncthreads();
}

constexpr int LDS_TAB = ge::STAGE_BYTES;
static_assert(FFT_LDS_END <= 160 * 1024 - 16, "FFT LDS image");
constexpr int LDS_TOTAL = 160 * 1024;
#define PH_P KArgP kp_ = (KArgP)__builtin_amdgcn_kernarg_segment_ptr(); asm volatile("" : "+s"(kp_)); const P p = make_p(kp_); int G = gridDim.x, c = blockIdx.x; asm volatile("" : "+s"(G), "+s"(c)); (void)G; (void)c;
#define GRID_BAR() do { XcdBarrier b_; b_.bar = (unsigned*)k.ws; b_.x = xb_xcc_id(); b_.st = xbw; xcd_barrier(b_); } while (0)
__global__ __launch_bounds__(NT, 2) void mega(PK k) {
    extern __shared__ __attribute__((aligned(16))) char smem[];
    LAS unsigned char* lds = (LAS unsigned char*)smem;
    volatile LAS unsigned* xbw = (volatile LAS unsigned*)(smem + LDS_TOTAL - 16);
    if (threadIdx.x == 0) { xbw[0] = 0u; xbw[1] = 0u; xbw[2] = 0u; xbw[3] = 0u; }
    __syncthreads();
    (void)xcd_barrier_post((unsigned*)k.ws, xbw);
#define PB(id) do { if (PROBE_ID == (id) && blockIdx.x == PROBE_BLK && threadIdx.x == 0) xbw[2] = (unsigned)wall_clock64(); } while (0)
#define PE(id) do { if (PROBE_ID == (id) && blockIdx.x == PROBE_BLK && threadIdx.x == 0) xbw[3] += (unsigned)wall_clock64() - xbw[2]; } while (0)
    int* offs = (int*)(smem + LDS_TAB); int* tpre = offs + 65; int* cntl = tpre + 65;
    const LAS int* offs_l = (const LAS int*)(lds + LDS_TAB); const LAS int* tpre_l = offs_l + 65; const LAS int* cntl_l = tpre_l + 65;
    PB(0);
    for (int rep = 0; rep < REP_PRO; ++rep) {
    PB(20);
    { PH_P ph_mod_partial(p, smem); ph_filter_a(p, smem); ph_conv_dense(p, smem); ph_tables(p); }
    GRID_BAR();
    PE(20); PB(21);
    { PH_P ph_filter_b2(p, smem); }
    GRID_BAR();
    PE(21); PB(22);
    { PH_P ph_finalize(p); }
    GRID_BAR();
    PE(22); PB(23);
    { PH_P ph_spectra(p, smem); }
    GRID_BAR();
    PE(23);
    }
    PE(0);
    for (int l = 0; l < DEPTH; ++l) {
        const bool last = (l == DEPTH - 1);
        PB(1);
        { PH_P ph_norm1c(p, l, offs); }
        GRID_BAR();
        PE(1); PB(2); PB(40);
#define CHAIN_IDS int cw_ = blockIdx.x; asm volatile("" : "+s"(cw_)); const bool kvc = cw_ < 68, qc = !kvc && cw_ < 136; const int pm = kvc ? cw_ : cw_ - 68; (void)qc; (void)pm;
#define CHAIN_SSQ LAS float* ssq = (LAS float*)(lds + LDS_SSQ); LAS float* rsl = ssq + 256 * 16; (void)rsl;
        { CHAIN_IDS
          if (kvc || qc) { PH_P CHAIN_SSQ
              SchedChainIn S{(const char*)p.U, (const char*)(p.WtRest + (size_t)l * 2816 * DM), pm, kvc ? 0 : 1, kvc ? 1 : 2};
              EpiInprojMLA E{p.PMLAb, p.K, p.rope, ssq};
              ge::gemm_engine<false>(lds, DM, DM, DM, S, E);
          } }
        { CHAIN_IDS
          if (kvc || qc) { CHAIN_SSQ
              asm volatile("s_waitcnt vmcnt(0)" ::: "memory"); __syncthreads(); __builtin_amdgcn_fence(__ATOMIC_ACQUIRE, "agent"); asm volatile("s_waitcnt vmcnt(0)" ::: "memory");
              const int t_ = tid_opaque();
              if (t_ < 256) { float a_ = 0.f; const int ns = kvc ? 8 : 12;
                  for (int q_ = 0; q_ < ns; ++q_) a_ += ssq[t_ * 16 + q_];
                  rsl[t_] = rsqrtf(a_ * (kvc ? 1.0f / KVL : 1.0f / QL) + epsf()); }
              __syncthreads();
          } }
        { CHAIN_IDS
          if (kvc || qc) { PH_P CHAIN_SSQ
              LAS float* rpl = rsl + 256;
              { const int t0 = (pm & 15) * 256;
                if (pm < 64) for (int t_ = tid_opaque(); t_ < 544; t_ += NT) {
                    const float2 e_ = t_ < 32 ? p.rope[(size_t)(t0 + (t_ >> 3) * 64) * 16 + (t_ & 7)] : p.rope[(size_t)(t0 + ((t_ - 32) >> 3)) * 16 + 8 + ((t_ - 32) & 7)];
                    rpl[2 * t_] = e_.x; rpl[2 * t_ + 1] = e_.y; }
                __syncthreads(); }
              SchedPanel S{(const char*)(p.PMLAb + (kvc ? 0 : 256)), kvc ? (const char*)(p.WtUkv + (size_t)l * 1024 * KVL) : (const char*)(p.WtUq + (size_t)l * 768 * QL),
                           (size_t)640 * 2, (size_t)(kvc ? KVL : QL) * 2, pm, kvc ? 4 : 3, kvc ? 1 : 0};
              EpiQKV E{EpiQ{p.Q, p.Qc, rpl, rsl}, EpiKV{p.K, p.V, rsl}};
              ge::gemm_engine<false>(lds, 640, kvc ? KVL : QL, kvc ? KVL : QL, S, E);
          } }
        { CHAIN_IDS PH_P
            SchedPool S{(const char*)(p.WtHy + (size_t)l * HYC * DM), (const char*)(p.WtRest + (size_t)l * 2816 * DM), (const char*)p.U,
                        kvc ? 680 + 3 * cw_ : (qc ? 884 + (cw_ - 68) : cw_ - 136), (kvc || qc) ? 1 : G - 136, kvc ? 3 : (qc ? 1 : (680 - (cw_ - 136) + (G - 136) - 1) / (G - 136))};
            EpiInproj E{p.PT, p.PTc, p.G};
            ge::gemm_engine<false>(lds, DM, DM, DM, S, E);
        }
#undef CHAIN_IDS
#undef CHAIN_SSQ
        PE(40);
        GRID_BAR();
        PE(2);
        PE(4); PB(5);
        for (int rep = 0; rep < REP_MIX; ++rep) {
        PB(31);
        { PH_P ph_attn2(p, smem, !last); }
        PE(31); PB(32);
        { PH_P ph_hyena_fft(p, l, smem); }
        PE(32); PB(33);
        if (!last) { PH_P ph_hyena_ctx(p, l, smem); }
        PE(33); }
        GRID_BAR();
        PE(5); PB(6); PB(41);
        for (int rep = 0; rep < REP_DENSE; ++rep) { PH_P
            SchedMerge S{(const char*)p.Yhy, (const char*)p.Yatt, (const char*)(p.WtHyo + (size_t)l * DM * HYW), (const char*)(p.WtMlao + (size_t)l * DM * 512), G, c, last ? 64 : 68};
            EpiMerge E{p.G, p.M1};
            ge::gemm_engine<false, TT>(lds, 512, 512, 512, S, E);
        }
        { PH_P ph_conv_experts(p, l, smem, 0, NE * 96, c - 16, G - 16); }
        PE(41);
        GRID_BAR();
        PE(6); PB(7); PB(42);
        { PH_P
            SchedDense S{(const char*)p.M1, (const char*)(p.WtOut + (size_t)l * DM * DM), (size_t)DM * 2, (size_t)DM * 2, last ? 64 : 68, 4, G, c};
            EpiOut E{(bf16_t*)p.hx, p.mod + (size_t)l * 5 * NMOD};
            ge::gemm_engine<false>(lds, DM, DM, DM, S, E);
        }
        { PH_P ph_conv_experts(p, l, smem, NE * 96, NE * 192, c - 16, G - 16); }
        PE(42);
        GRID_BAR();
        PE(7); PB(8);
        { PH_P ph_norm2_router(p, l, smem, last ? TL : TT); }
        GRID_BAR();
        PE(8); PB(9);
        for (int rep = 0; rep < REP_MOE; ++rep) { PH_P
            if (threadIdx.x < NE) cntl[threadIdx.x] = p.cnt[(l * NE + threadIdx.x) * 64];
            __syncthreads();
            if (threadIdx.x == 0) { int a = 0, t = 0; for (int e = 0; e < NE; ++e) { const int n = cntl[e]; offs[e] = a; tpre[e] = t; a += n; t += (n + 255) >> 8; } offs[64] = a; tpre[64] = t; }
            __syncthreads();
            SchedGU S{(const char*)p.U, (const char*)p.WtG, (const char*)p.WtU, p.list, tpre_l, cntl_l, G, c};
            EpiGU E{p.Hb, offs_l};
            ge::gemm_engine<true>(lds, DM, DM, DM, S, E);
        }
        GRID_BAR();
        PE(9); PB(10);
        for (int rep = 0; rep < REP_MOE; ++rep) { PH_P
            SchedDown S{(const char*)p.Hb, (const char*)p.WtD, tpre_l, cntl_l, offs_l, G, c};
            EpiDown E{p.Y, p.wl, offs_l};
            ge::gemm_engine<false>(lds, DE, DE, DE, S, E);
        }
        GRID_BAR();
        PE(10);
        if (PROBE_ID == 12) { PB(12); GRID_BAR(); PE(12); }
    }
    PB(11);
    { PH_P ph_final_c(p, offs); }
    PE(11);
    if (PROBE_ID >= 0 && blockIdx.x == PROBE_BLK && threadIdx.x == 0) { const unsigned long long t0 = wall_clock64(), wait = (unsigned long long)xbw[3] * PROBE_K; while (wall_clock64() - t0 < wait) __builtin_amdgcn_s_sleep(8); }
}

extern "C" void kernel_launch(void* const* d_in, const int* in_sizes, int n_in, void* d_out, int out_size, void* d_ws, size_t ws_size, hipStream_t stream) {
    (void)in_sizes; (void)out_size;
    if (n_in < 33 || WSO.total > ws_size) { fprintf(stderr, "kernel_launch: need 33 inputs and %zu bytes of workspace; got %d, %zu\n", (size_t)WSO.total, n_in, ws_size); return; }
    PK k{};
    for (int i = 0; i < 33; ++i) k.in[i] = (const float*)d_in[i];
    k.out = (float*)d_out; k.ws = (char*)d_ws;
    (void)hipMemsetAsync(d_ws, 0, WS_ZERO_BYTES, stream);
    static int grid = 0;
    if (!grid) {
        int dev = 0, cus = 0, per_cu = 0;
        (void)hipGetDevice(&dev);
        (void)hipDeviceGetAttribute(&cus, hipDeviceAttributeMultiprocessorCount, dev);
        (void)hipFuncSetAttribute((const void*)mega, hipFuncAttributeMaxDynamicSharedMemorySize, LDS_TOTAL);
        (void)hipOccupancyMaxActiveBlocksPerMultiprocessor(&per_cu, (const void*)mega, NT, LDS_TOTAL);
        if (per_cu < 1) fprintf(stderr, "kernel_launch: occupancy query reports %d blocks per CU\n", per_cu);
        grid = cus > 0 ? cus : 256;
    }
    hipLaunchKernelGGL(mega, dim3(grid), dim3(NT), LDS_TOTAL, stream, k);
}
```

```cpp
#include <hip/hip_runtime.h>
#include <stdint.h>
#include <stdio.h>

typedef unsigned short bf16_t;
typedef short bf16x8 __attribute__((ext_vector_type(8)));
typedef float f32x4 __attribute__((ext_vector_type(4)));
typedef unsigned u32x4 __attribute__((ext_vector_type(4)));
typedef unsigned u32x2 __attribute__((ext_vector_type(2)));

#define NT 512
#ifndef PROBE_BLK
#define PROBE_BLK 0
#endif
#ifndef PROBE_ID
#define PROBE_ID (-1)
#endif
#define PROBE_K 8
#ifndef REP_PRO
#define REP_PRO 1
#endif
#ifndef REP_DENSE
#define REP_DENSE 1
#endif
#ifndef REP_MOE
#define REP_MOE 1
#endif
#ifndef REP_MIX
#define REP_MIX 1
#endif
#ifndef REP_MISC
#define REP_MISC 1
#endif
constexpr int DM = 1024, NB = 4, SEQ = 4096, DEPTH = 4, CTXL = 256;
constexpr int TL = NB * SEQ, TC = NB * CTXL, TT = TL + TC;
constexpr int HYW = 512, HYC = 1536, QL = 384, KVL = 256, QKR = 32;
constexpr int MLAW = QL + KVL + QKR, MLA_END = HYC + MLAW, INC = MLA_END + 2 * DM;
constexpr int NH = 8, DQK = 96, DV = 64, NKEY = SEQ + CTXL;
constexpr int NE = 64, DE = 256, CAP = TT;
constexpr int NMOD = 6 * DM;
constexpr float EPSF = 1e-6f;
constexpr float QSCALE = 0.10206207261596577f * 1.4426950408889634f;

__device__ __forceinline__ bf16_t f2bf(float f) { unsigned u = __float_as_uint(f); u += 0x7FFFu + ((u >> 16) & 1u); return (bf16_t)(u >> 16); }
__device__ __forceinline__ float bf2f(bf16_t b) { return __uint_as_float(((unsigned)b) << 16); }
__device__ __forceinline__ unsigned pack2(float lo, float hi) { return (unsigned)f2bf(lo) | ((unsigned)f2bf(hi) << 16); }
__device__ __forceinline__ float epsf() { float e = EPSF; asm volatile("" : "+v"(e)); return e; }
__device__ __forceinline__ int tid_opaque() { int t = threadIdx.x; asm volatile("" : "+v"(t)); return t; }
__device__ __forceinline__ int shx_i(int v, int mask) {
    switch (mask) {
        case 1: return __builtin_amdgcn_ds_swizzle(v, (1 << 10) | 0x1F);
        case 2: return __builtin_amdgcn_ds_swizzle(v, (2 << 10) | 0x1F);
        case 4: return __builtin_amdgcn_ds_swizzle(v, (4 << 10) | 0x1F);
        case 8: return __builtin_amdgcn_ds_swizzle(v, (8 << 10) | 0x1F);
        case 16: return __builtin_amdgcn_ds_swizzle(v, (16 << 10) | 0x1F);
        default: {
            typedef unsigned u32x2s_t __attribute__((ext_vector_type(2)));
            const u32x2s_t r = __builtin_amdgcn_permlane32_swap((unsigned)v, (unsigned)v, false, false);
            return (int)(((threadIdx.x & 32u) == 0u) ? r.y : r.x); }
    }
}
__device__ __forceinline__ float shx(float v, int mask) { return __int_as_float(shx_i(__float_as_int(v), mask)); }
__device__ __forceinline__ int shx(int v, int mask) { return shx_i(v, mask); }
typedef unsigned u32x2_t __attribute__((ext_vector_type(2)));
__device__ __forceinline__ float rowmax4(float v) {
    u32x2_t r = __builtin_amdgcn_permlane16_swap(__float_as_uint(v), __float_as_uint(v), false, false);
    v = fmaxf(__uint_as_float(r.x), __uint_as_float(r.y));
    r = __builtin_amdgcn_permlane32_swap(__float_as_uint(v), __float_as_uint(v), false, false);
    return fmaxf(__uint_as_float(r.x), __uint_as_float(r.y));
}
__device__ __forceinline__ float rowsum4(float v) {
    u32x2_t r = __builtin_amdgcn_permlane16_swap(__float_as_uint(v), __float_as_uint(v), false, false);
    v = __uint_as_float(r.x) + __uint_as_float(r.y);
    r = __builtin_amdgcn_permlane32_swap(__float_as_uint(v), __float_as_uint(v), false, false);
    return __uint_as_float(r.x) + __uint_as_float(r.y);
}
__device__ __forceinline__ float wave_sum(float v) {
#pragma unroll
    for (int o = 32; o > 0; o >>= 1) v += shx(v, o);
    return v;
}


#define XB_TMO      128
#define XB_XCNT(j)  (256  + 64 * (j))
#define XB_XSUB(j)  (1280 + 64 * (j))
#define XB_XGEN(j)  (2304 + 64 * (j))
#define XB_TOP      3328
#define XB_TOPGEN   3392
#define XCD_BAR_WORDS 3456
#define XB_SPIN_CAP (1u << 22)
#define LAS __attribute__((address_space(3)))
__device__ __forceinline__ unsigned xb_ld(unsigned* p)              { return __hip_atomic_load(p, __ATOMIC_RELAXED, __HIP_MEMORY_SCOPE_AGENT); }
__device__ __forceinline__ unsigned xb_add(unsigned* p, unsigned v) { return __hip_atomic_fetch_add(p, v, __ATOMIC_RELAXED, __HIP_MEMORY_SCOPE_AGENT); }
__device__ __forceinline__ unsigned xb_xcc_id() { return (unsigned)__builtin_amdgcn_s_getreg((3 << 11) | 20) & 0xFu; }
#define XB_SPIN(cond, bar) do { unsigned _sp = 0; while (cond) { __builtin_amdgcn_s_sleep(1); \
    if ((++_sp & 255u) == 0u) { if (xb_ld(&(bar)[XB_TMO])) break; if (_sp > XB_SPIN_CAP) { atomicAdd(&(bar)[XB_TMO], 1u); break; } } } } while (0)
struct XcdBarrier { unsigned* bar; unsigned x; volatile LAS unsigned* st; };
__device__ __forceinline__ XcdBarrier xcd_barrier_post(unsigned* bar, volatile LAS unsigned* st) {
    XcdBarrier b; b.bar = bar; b.x = xb_xcc_id(); b.st = st;
    if (threadIdx.x == 0) (void)xb_add(&bar[XB_XCNT(b.x)], 1u);
    return b;
}
__device__ __forceinline__ void xcd_barrier_complete(unsigned* bar, unsigned x, unsigned& nloc, unsigned& nx) {
    const unsigned G = gridDim.x * gridDim.y * gridDim.z;
    unsigned sum, cnt, mine, sp = 0u;
    for (;;) {
        sum = 0u; cnt = 0u; mine = 0u;
#pragma unroll
        for (unsigned j = 0; j < 16; ++j) { const unsigned c = xb_ld(&bar[XB_XCNT(j)]); sum += c; cnt += (c > 0u) ? 1u : 0u; mine = (j == x) ? c : mine; }
        if (sum == G) break;
        __builtin_amdgcn_s_sleep(1);
        if ((++sp & 255u) == 0u) { if (xb_ld(&bar[XB_TMO])) break; if (sp > XB_SPIN_CAP) { atomicAdd(&bar[XB_TMO], 1u); break; } }
    }
    nloc = mine > 0u ? mine : 1u; nx = cnt > 0u ? cnt : 1u;
}
__device__ __forceinline__ void xcd_barrier(const XcdBarrier& b) {
    asm volatile("s_waitcnt vmcnt(0)" ::: "memory");
    __syncthreads();
    if (threadIdx.x == 0) {
        unsigned* bar = b.bar;
        __builtin_amdgcn_s_waitcnt(0);
        unsigned nloc = b.st[0], nx = b.st[1];
        if (nloc == 0u) { xcd_barrier_complete(bar, b.x, nloc, nx); b.st[0] = nloc; b.st[1] = nx; }
        const unsigned old = xb_add(&bar[XB_XSUB(b.x)], 1u);
        const unsigned gen = old / nloc;
        if (old + 1u == (gen + 1u) * nloc) {
            __builtin_amdgcn_fence(__ATOMIC_RELEASE, "agent");
            asm volatile("s_waitcnt vmcnt(0)" ::: "memory");
            const unsigned og = xb_add(&bar[XB_TOP], 1u);
            const unsigned tg = og / nx;
            if (og + 1u == (tg + 1u) * nx) xb_add(&bar[XB_TOPGEN], 1u);
            else XB_SPIN(xb_ld(&bar[XB_TOPGEN]) == tg, bar);
            __builtin_amdgcn_fence(__ATOMIC_ACQUIRE, "agent");
            xb_add(&bar[XB_XGEN(b.x)], 1u);
            asm volatile("s_waitcnt vmcnt(0)" ::: "memory");
        } else {
            XB_SPIN(xb_ld(&bar[XB_XGEN(b.x)]) == gen, bar);
            __builtin_amdgcn_fence(__ATOMIC_ACQUIRE, "agent");
            asm volatile("s_waitcnt vmcnt(0)" ::: "memory");
        }
    }
    __syncthreads();
}

#define WS_LIST(X) \
    X(unsigned, bar, XCD_BAR_WORDS * 4)                         \
    X(int, cnt, DEPTH * 64 * 256)                               \
    X(float, modp, (size_t)DEPTH * 32 * 5 * NMOD * 4)           \
    X(float, mod, (size_t)DEPTH * 5 * NMOD * 4)                 \
    X(float, H2a, (size_t)DEPTH * SEQ * 64 * 4) \
    X(float, H2b, (size_t)DEPTH * CTXL * 64 * 4) \
    X(float, HT1, (size_t)DEPTH * 2048 * CTXL * 4) \
    X(float, SSQ0, (size_t)DEPTH * 2048 * 128 * 4) \
    X(float, SSQ1, (size_t)DEPTH * 2048 * 8 * 4) \
    X(float, SCL0, (size_t)DEPTH * 2048 * 4) \
    X(float, SCL1, (size_t)DEPTH * 2048 * 4) \
    X(float, hx, (size_t)TT * DM * 4)                           \
    X(bf16_t, U, (size_t)TT * DM * 2)                           \
    X(bf16_t, PT, (size_t)NB * HYC * SEQ * 2)                   \
    X(bf16_t, PTc, (size_t)NB * HYC * CTXL * 2) \
    X(bf16_t, PMLAb, (size_t)TT * 640 * 2)                      \
    X(bf16_t, G, (size_t)TT * 2048 * 2)                         \
    X(bf16_t, Q, (size_t)NB * NH * SEQ * 128 * 2)               \
    X(bf16_t, Qc, (size_t)NB * NH * CTXL * 128 * 2) \
    X(bf16_t, K, (size_t)NB * NH * NKEY * DQK * 2)              \
    X(bf16_t, V, (size_t)NB * NH * NKEY * DV * 2)               \
    X(bf16_t, Yatt, (size_t)TT * 512 * 2) \
    X(bf16_t, Yhy, (size_t)TT * 512 * 2) \
    X(bf16_t, M1, (size_t)TT * DM * 2) \
    X(int, list, (size_t)NE * CAP * 4) \
    X(float, wl, (size_t)NE * CAP * 4) \
    X(int, asg, (size_t)TT * 4 * 4) \
    X(bf16_t, Hb, (size_t)(2 * TT + 256) * DE * 2) \
    X(bf16_t, Y, (size_t)2 * TT * DM * 2) \
    X(bf16_t, WtHy, (size_t)DEPTH * HYC * DM * 2)               \
    X(bf16_t, WtRest, (size_t)DEPTH * 2816 * DM * 2) \
    X(bf16_t, WtUq, (size_t)DEPTH * 768 * QL * 2) \
    X(bf16_t, WtUkv, (size_t)DEPTH * 1024 * KVL * 2) \
    X(bf16_t, WtHyo, (size_t)DEPTH * DM * HYW * 2) \
    X(bf16_t, WtMlao, (size_t)DEPTH * DM * 512 * 2) \
    X(bf16_t, WtOut, (size_t)DEPTH * DM * DM * 2) \
    X(bf16_t, WtG, (size_t)NE * DE * DM * 2)                    \
    X(bf16_t, WtU, (size_t)NE * DE * DM * 2) \
    X(bf16_t, WtD, (size_t)NE * DM * DE * 2) \
    X(float2, rope, (size_t)SEQ * 16 * 8)                       \
    X(float2, Hs, (size_t)DEPTH * HYW * 4 * 4096 * 8)           \
    X(float2, Wtab, 4096 * 8) \
    X(bf16_t, WrT, (size_t)DEPTH * 2 * 80 * DM * 2)             \
    X(float2, W2tab, 4096 * 8)
struct WsOff {
#define X(t, n, b) size_t n;
    WS_LIST(X)
#undef X
    size_t total;
};
constexpr WsOff ws_layout() {
    WsOff o{}; size_t a = 0;
#define X(t, n, b) o.n = a; a += (((size_t)(b)) + 255) & ~(size_t)255;
    WS_LIST(X)
#undef X
    o.total = a; return o;
}
constexpr WsOff WSO = ws_layout();
constexpr size_t WS_ZERO_BYTES = WSO.modp;
static_assert(WSO.Yatt - WSO.G >= (size_t)DEPTH * 2048 * SEQ * 4, "HT0 alias region too small");

struct PK { const float* in[33]; float* out; char* ws; };
struct P {
    const float *x, *c, *ctx, *c_ctx, *w_ada, *b_ada, *norm1_g, *w_in, *q_norm_g, *kv_norm_g, *w_uq, *w_ukv, *sc_w, *sc_b;
    const float *flt_w1, *flt_b1, *flt_freq, *flt_w2, *flt_b2, *flt_w3, *flt_bias, *w_hy_o, *w_mla_o, *w_out, *norm2_g;
    const float *w_rg, *b_rg, *w_re, *b_re, *w_gate, *w_up, *w_down, *final_g;
    float* out;
#define X(t, n, b) t* n;
    WS_LIST(X)
#undef X
    float* HT0;
};
typedef const __attribute__((address_space(4))) PK* KArgP;
__device__ __forceinline__ P make_p(KArgP kp) {
    P p; const KArgP& kk = kp; char* ws = kk->ws;
    p.x = kk->in[0]; p.c = kk->in[1]; p.ctx = kk->in[2]; p.c_ctx = kk->in[3]; p.w_ada = kk->in[4]; p.b_ada = kk->in[5]; p.norm1_g = kk->in[6]; p.w_in = kk->in[7];
    p.q_norm_g = kk->in[8]; p.kv_norm_g = kk->in[9]; p.w_uq = kk->in[10]; p.w_ukv = kk->in[11]; p.sc_w = kk->in[12]; p.sc_b = kk->in[13];
    p.flt_w1 = kk->in[14]; p.flt_b1 = kk->in[15]; p.flt_freq = kk->in[16]; p.flt_w2 = kk->in[17]; p.flt_b2 = kk->in[18]; p.flt_w3 = kk->in[19]; p.flt_bias = kk->in[20];
    p.w_hy_o = kk->in[21]; p.w_mla_o = kk->in[22]; p.w_out = kk->in[23]; p.norm2_g = kk->in[24]; p.w_rg = kk->in[25]; p.b_rg = kk->in[26]; p.w_re = kk->in[27]; p.b_re = kk->in[28];
    p.w_gate = kk->in[29]; p.w_up = kk->in[30]; p.w_down = kk->in[31]; p.final_g = kk->in[32];
    p.out = kk->out;
#define X(t, n, b) p.n = (t*)(ws + WSO.n);
    WS_LIST(X)
#undef X
    p.HT0 = (float*)(ws + WSO.G);
    return p;
}

constexpr int MODK = 32;
__device__ __forceinline__ void ph_mod_partial(const P& p, char* smem) {
    float* s = (float*)smem;
    const int tid = tid_opaque();
    for (int it = blockIdx.x; it < DEPTH * MODK * 3; it += gridDim.x) {
        const int l = it / (MODK * 3), kc = (it / 3) % MODK, jb = it % 3;
        __syncthreads();
        if (tid < 5 * 32) {
            const int r = tid / 32, kk = tid % 32, k = kc * 32 + kk;
            const float cv = (r < 4) ? p.c[r * DM + k] : p.c_ctx[k];
            s[tid] = cv / (1.0f + expf(-cv));
        }
        __syncthreads();
        const int j = jb * 2048 + tid * 4;
        f32x4 a0 = {0.f, 0.f, 0.f, 0.f}, a1 = a0, a2 = a0, a3 = a0, a4 = a0;
        const float* w = p.w_ada + ((size_t)l * DM + kc * 32) * NMOD + j;
#pragma unroll 8
        for (int kk = 0; kk < 32; ++kk) {
            const f32x4 wv = *(const f32x4*)(w + (size_t)kk * NMOD);
            a0 += wv * s[kk]; a1 += wv * s[32 + kk]; a2 += wv * s[64 + kk]; a3 += wv * s[96 + kk]; a4 += wv * s[128 + kk];
        }
        float* o = p.modp + ((size_t)(l * MODK + kc) * 5) * NMOD + j;
        *(f32x4*)o = a0; *(f32x4*)(o + NMOD) = a1; *(f32x4*)(o + 2 * NMOD) = a2; *(f32x4*)(o + 3 * NMOD) = a3; *(f32x4*)(o + 4 * NMOD) = a4;
    }
}

__device__ __forceinline__ void ph_filter_a(const P& p, char* smem) {
    float* zs = (float*)smem;
    float* h1s = zs + 8 * 36;
    const int tid = tid_opaque(), tt = tid >> 6, j = tid & 63;
    const int n0 = DEPTH * 512, n1 = DEPTH * 32;
    for (int it = blockIdx.x; it < n0 + n1; it += gridDim.x) {
        int l, ls, tg;
        if (it < n0) { ls = 0; l = it / 512; tg = it % 512; } else { ls = 1; l = (it - n0) / 32; tg = (it - n0) % 32; }
        const int L = ls ? CTXL : SEQ;
        const int t = tg * 8 + tt;
        __syncthreads();
        if (j < 33) {
            float f;
            if (j == 0) f = (float)t / (float)(L - 1);
            else {
                const int k = (j - 1) & 15;
                const float band = 1e-4f + (float)k * ((15.0f - 1e-4f) / 15.0f);
                const float w = 6.283185307179586f * (float)t / (float)L;
                const double ang = (double)band * (double)w;
                f = (j <= 16) ? (float)cos(ang) : (float)(-sin(ang));
            }
            zs[tt * 36 + j] = f;
        }
        __syncthreads();
        const float fr = p.flt_freq[l * 64 + j];
        float a = p.flt_b1[l * 64 + j];
        for (int i = 0; i < 33; ++i) a += zs[tt * 36 + i] * p.flt_w1[((size_t)l * 33 + i) * 64 + j];
        h1s[tt * 64 + j] = sinf(fr * a);
        __syncthreads();
        float a2 = p.flt_b2[l * 64 + j];
        for (int i = 0; i < 64; ++i) a2 += h1s[tt * 64 + i] * p.flt_w2[((size_t)l * 64 + i) * 64 + j];
        const float h2 = sinf(fr * a2);
        if (ls == 0) p.H2a[((size_t)l * SEQ + t) * 64 + j] = h2; else p.H2b[((size_t)l * CTXL + t) * 64 + j] = h2;
    }
}

typedef float f32x16 __attribute__((ext_vector_type(16)));
__device__ __forceinline__ void ph_filter_b2(const P& p, char* smem) {
    float* sA = (float*)smem;
    const int tid = tid_opaque(), lane = tid & 63, wv = tid >> 6, li = lane & 31, hf = lane >> 5;
    const int n0 = DEPTH * 128 * 8, n1 = DEPTH * 8 * 8;
    const float DA = -15.350567286626973f, DB = -3.0701134573253946f;
    for (int it = blockIdx.x; it < n0 + n1; it += gridDim.x) {
        int l, ls, tt, cg;
        if (it < n0) { ls = 0; l = it / 1024; tt = (it / 8) % 128; cg = it % 8; } else { const int i2 = it - n0; ls = 1; l = i2 / 64; tt = (i2 / 8) % 8; cg = i2 % 8; }
        const int L = ls ? CTXL : SEQ, t0 = tt * 32;
        const float* h2 = ls ? p.H2b + ((size_t)l * CTXL + t0) * 64 : p.H2a + ((size_t)l * SEQ + t0) * 64;
        const int col = cg * 256 + wv * 32 + li;
        const float* wp = p.flt_w3 + (size_t)l * 64 * 2048 + col;
        float wv_[32];
#pragma unroll
        for (int s2 = 0; s2 < 32; ++s2) wv_[s2] = wp[(size_t)(2 * s2 + hf) * 2048];
        { const int r = tid >> 4, k4 = (tid & 15) * 4; const float4 v = *(const float4*)(h2 + r * 64 + k4);
          __syncthreads();
          float* d = sA + r * 65 + k4; d[0] = v.x; d[1] = v.y; d[2] = v.z; d[3] = v.w; }
        __syncthreads();
        f32x16 acc;
#pragma unroll
        for (int i = 0; i < 16; ++i) acc[i] = 0.f;
#pragma unroll
        for (int s2 = 0; s2 < 32; ++s2) {
            const int k = 2 * s2 + hf;
            acc = __builtin_amdgcn_mfma_f32_32x32x2f32(sA[li * 65 + k], wv_[s2], acc, 0, 0, 0);
        }
        const int ch = col & 511;
        const float delta = fabsf(DA + (float)ch * ((DB - DA) / 511.0f));
        float q = 0.f;
        float* dst = (ls ? p.HT1 + ((size_t)l * 2048 + col) * CTXL : p.HT0 + ((size_t)l * 2048 + col) * SEQ) + t0 + 4 * hf;
#pragma unroll
        for (int g4 = 0; g4 < 4; ++g4) {
            float4 o;
            float* op = &o.x;
#pragma unroll
            for (int e = 0; e < 4; ++e) { const int t = t0 + 8 * g4 + 4 * hf + e; const float v = acc[4 * g4 + e] * expf(-((float)t / (float)(L - 1)) * delta); op[e] = v; q += v * v; }
            *(float4*)(dst + 8 * g4) = o;
        }
        q += shx(q, 32);
        if (hf == 0) { if (ls == 0) p.SSQ0[((size_t)l * 2048 + col) * 128 + tt] = q; else p.SSQ1[((size_t)l * 2048 + col) * 8 + tt] = q; }
    }
    __syncthreads();
}

__device__ __forceinline__ void ph_finalize(const P& p) {
    const int n_mod = DEPTH * 5 * NMOD, n_s = DEPTH * 2048;
    for (int i = blockIdx.x * NT + threadIdx.x; i < n_mod + 2 * n_s; i += gridDim.x * NT) {
        if (i < n_mod) {
            const int l = i / (5 * NMOD), r = (i / NMOD) % 5, j = i % NMOD;
            float a = p.b_ada[l * NMOD + j];
            for (int kc = 0; kc < MODK; ++kc) a += p.modp[((size_t)(l * MODK + kc) * 5 + r) * NMOD + j];
            p.mod[i] = a;
        } else if (i < n_mod + n_s) {
            const int k = i - n_mod; float a = 0.f;
            for (int q = 0; q < 128; ++q) a += p.SSQ0[(size_t)k * 128 + q];
            p.SCL0[k] = rsqrtf(a + epsf());
        } else {
            const int k = i - n_mod - n_s; float a = 0.f;
            for (int q = 0; q < 8; ++q) a += p.SSQ1[(size_t)k * 8 + q];
            p.SCL1[k] = rsqrtf(a + epsf());
        }
    }
}

__device__ __forceinline__ float rope_apply(float self, float partner, int d, int t) {
    const int a = d >> 4, s = (d >> 3) & 1, i = d & 7;
    const float pos = (float)(a == 0 ? (t >> 6) : (t & 63));
    const float inv = powf(10000.0f, -(float)i / 8.0f);
    const float ang = pos * inv;
    const float cs = cosf(ang), sn = sinf(ang);
    return s == 0 ? self * cs - partner * sn : partner * sn + self * cs;
}

namespace ge {
constexpr int BM = 256, BK = 64, HALF = 128, HTB = HALF * BK * 2, STAGE_BYTES = 8 * HTB, NXCD = 8, WGM = 8;
__device__ __forceinline__ int lds_byte(int r, int c) { const int st = (r >> 4) * 2 + (c >> 5), rr = r & 15, cc = c & 31, ob = rr * 64 + cc * 2; return st * 1024 + (ob ^ (((ob >> 9) & 1) << 5)); }
__device__ __forceinline__ void stage_rc(int b, int& R, int& C) { const int st = b / 1024, sb = b % 1024, swz = sb ^ (((sb >> 9) & 1) << 5); R = (st >> 1) * 16 + swz / 64; C = (st & 1) * 32 + (swz % 64) / 2; }
__device__ __forceinline__ int perm32(int rho) { const int n = rho >> 4, i = rho & 15; return 8 * (i >> 2) + 4 * n + (i & 3); }
__device__ __forceinline__ void tile_order(int L, int nM, int nN, int& pm, int& pn) {
    const int nwg = nM * nN; int wgid = L;
    { const int q = nwg / NXCD, r = nwg % NXCD, xcd = wgid % NXCD, off = wgid / NXCD; wgid = (xcd < r ? xcd * (q + 1) : r * (q + 1) + (xcd - r) * q) + off; }
    const int nig = WGM * nN, gid = wgid / nig, fm = gid * WGM, gsz = (nM - fm) < WGM ? (nM - fm) : WGM;
    pm = fm + ((wgid % nig) % gsz); pn = (wgid % nig) / gsz;
}
struct Unit { const char* a; const char* b0; const char* b1; const int* rows; int nrows; int pm, pn, kind; };
typedef f32x4 Acc[2][2][4][2];

template <bool GATHER, int ABLK = 0, class Sched, class Epi>
__device__ __forceinline__ void gemm_engine(LAS unsigned char* lds, const int lda, const int ldb, const int K, const Sched& S, const Epi& E) {
    const int tid = tid_opaque(), wid = __builtin_amdgcn_readfirstlane(tid >> 6), lane = tid & 63, wr = wid >> 2, wc = wid & 3, fr = lane & 15, fq = lane >> 4;
    const int nt = K / BK;
    int sR[2], sC[2];
    unsigned voffA[2], voffB[2];
#pragma unroll
    for (int i = 0; i < 2; ++i) { stage_rc(tid * 16 + i * 8192, sR[i], sC[i]); const int Rb = (sR[i] & ~31) + perm32(sR[i] & 31);
        voffA[i] = ABLK ? (unsigned)((sC[i] >> 3) * ABLK + sR[i]) * 16u : (unsigned)(sR[i] * lda + sC[i]) * 2u; voffB[i] = (unsigned)(Rb * ldb + sC[i]) * 2u; }
    const size_t kstep = (size_t)(BK * 2);
    const size_t hstepA = ABLK ? (size_t)HALF * 16 : (size_t)HALF * lda * 2;
    const size_t kstepA = ABLK ? (size_t)(BK / 8) * ABLK * 16 : kstep;
    const unsigned ldsw = (unsigned)wid * 1024u;
    const int aoff = lds_byte(wr * 64 + fr, fq * 8), boff = lds_byte(wc * 32 + fr, fq * 8);
    unsigned gvc[2][2], gvn[2][2];
#define GE_SA(b, h) (((b) * 2 + (h)) * HTB)
#define GE_SB(b, h) ((4 + (b) * 2 + (h)) * HTB)
#define GE_GLDS(src, bufoff, i) __builtin_amdgcn_global_load_lds((const unsigned*)(src), (LAS unsigned*)(lds + (bufoff) + ldsw + (i) * 8192), 16, 0, 0)
#define GE_STAGE_B(bufoff, bp) do { _Pragma("unroll") for (int _i = 0; _i < 2; ++_i) GE_GLDS((bp) + voffB[_i], bufoff, _i); } while (0)
#define GE_STAGE_A(bufoff, ap, h, gv) do { _Pragma("unroll") for (int _i = 0; _i < 2; ++_i) { \
        if constexpr (GATHER) GE_GLDS((ap) + (gv)[h][_i], bufoff, _i); else GE_GLDS((ap) + (size_t)(h) * hstepA + voffA[_i], bufoff, _i); } } while (0)
#define GE_STAGE_A2(bufoff, ap, h) do { _Pragma("unroll") for (int _i = 0; _i < 2; ++_i) { \
        if constexpr (GATHER) GE_GLDS((ap) + (last ? gvn[h][_i] : gvc[h][_i]), bufoff, _i); else GE_GLDS((ap) + (size_t)(h) * hstepA + voffA[_i], bufoff, _i); } } while (0)
#define GE_LDA(dst, b, h) do { _Pragma("unroll") for (int m = 0; m < 4; ++m) _Pragma("unroll") for (int k = 0; k < 2; ++k) dst[m][k] = *(const LAS bf16x8*)(lds + GE_SA(b, h) + aoff + m * 2048 + k * 1024); } while (0)
#define GE_LDB(dst, b, h) do { _Pragma("unroll") for (int n = 0; n < 2; ++n) _Pragma("unroll") for (int k = 0; k < 2; ++k) dst[n][k] = *(const LAS bf16x8*)(lds + GE_SB(b, h) + boff + n * 2048 + k * 1024); } while (0)
#define GE_MMA(ai, bj, At, Bt) do { __builtin_amdgcn_s_setprio(1); _Pragma("unroll") for (int m = 0; m < 4; ++m) _Pragma("unroll") for (int n = 0; n < 2; ++n) _Pragma("unroll") for (int k = 0; k < 2; ++k) \
        acc[ai][bj][m][n] = __builtin_amdgcn_mfma_f32_16x16x32_bf16(Bt[n][k], At[m][k], acc[ai][bj][m][n], 0, 0, 0); __builtin_amdgcn_s_setprio(0); } while (0)
#define GE_WAIT_V(n) asm volatile("s_waitcnt vmcnt(" #n ")" ::: "memory")
#define GE_WAIT_L(n) asm volatile("s_waitcnt lgkmcnt(" #n ")" ::: "memory")
#define GE_BAR __builtin_amdgcn_s_barrier()
#define GE_SCHED __builtin_amdgcn_sched_barrier(0)
#define GE_GATHER_OFFS(gv, u) do { if constexpr (GATHER) { _Pragma("unroll") for (int _h = 0; _h < 2; ++_h) _Pragma("unroll") for (int _i = 0; _i < 2; ++_i) { \
        int _r = (u).pm * BM + _h * HALF + sR[_i]; _r = _r < (u).nrows ? _r : (u).nrows - 1; (gv)[_h][_i] = (unsigned)((u).rows[_r] * lda + sC[_i]) * 2u; } } } while (0)
    Unit cur, nxt; int ui = 0;
    if (!S.next(0, cur)) return;
    Acc acc;
#pragma unroll
    for (int a = 0; a < 2; ++a)
#pragma unroll
        for (int b = 0; b < 2; ++b)
#pragma unroll
            for (int m = 0; m < 4; ++m)
#pragma unroll
                for (int n = 0; n < 2; ++n) acc[a][b][m][n] = (f32x4){0.f, 0.f, 0.f, 0.f};
    bf16x8 At[4][2], B0[2][2], B1[2][2];
    GE_GATHER_OFFS(gvc, cur);
    GE_STAGE_B(GE_SB(0, 0), cur.b0); GE_STAGE_A(GE_SA(0, 0), cur.a, 0, gvc); GE_STAGE_B(GE_SB(0, 1), cur.b1); GE_STAGE_A(GE_SA(0, 1), cur.a, 1, gvc);
    if (wr == 1) GE_BAR;
    GE_WAIT_V(4); GE_BAR;
    GE_STAGE_B(GE_SB(1, 0), cur.b0 + kstep); GE_STAGE_A(GE_SA(1, 0), cur.a + kstepA, 0, gvc); GE_STAGE_B(GE_SB(1, 1), cur.b1 + kstep);
    GE_WAIT_V(6); GE_BAR;
    for (;;) {
        const bool has_next = S.next(ui + 1, nxt);
        if (!has_next) nxt = cur;
        if constexpr (GATHER) { if (has_next) { GE_GATHER_OFFS(gvn, nxt); } else {
#pragma unroll
            for (int h = 0; h < 2; ++h)
#pragma unroll
                for (int i = 0; i < 2; ++i) gvn[h][i] = gvc[h][i]; } }
#pragma unroll 1
        for (int t = 0; t < nt; t += 2) {
            const bool last = (t == nt - 2);
            const char* a1 = cur.a + (size_t)(t + 1) * kstepA;
            const char* a2 = last ? nxt.a : cur.a + (size_t)(t + 2) * kstepA;
            const char* b20 = last ? nxt.b0 : cur.b0 + (size_t)(t + 2) * kstep;
            const char* b21 = last ? nxt.b1 : cur.b1 + (size_t)(t + 2) * kstep;
            const char* a3 = a2 + kstepA; const char* b30 = b20 + kstep; const char* b31 = b21 + kstep;
            GE_LDB(B0, 0, 0); GE_SCHED; GE_LDA(At, 0, 0); GE_STAGE_A(GE_SA(1, 1), a1, 1, gvc);
            GE_WAIT_L(8); GE_BAR; GE_WAIT_L(0); GE_MMA(0, 0, At, B0); GE_BAR; GE_SCHED;
            GE_LDB(B1, 0, 1); GE_STAGE_B(GE_SB(0, 0), b20);
            GE_BAR; GE_WAIT_L(0); GE_MMA(0, 1, At, B1); GE_BAR;
            GE_LDA(At, 0, 1); GE_STAGE_A2(GE_SA(0, 0), a2, 0);
            GE_BAR; GE_WAIT_L(0); GE_MMA(1, 0, At, B0); GE_BAR; GE_SCHED;
            GE_STAGE_B(GE_SB(0, 1), b21);
            GE_WAIT_V(6); GE_BAR; GE_MMA(1, 1, At, B1); GE_BAR;
            GE_LDB(B0, 1, 0); GE_SCHED; GE_LDA(At, 1, 0); GE_STAGE_A2(GE_SA(0, 1), a2, 1);
            GE_WAIT_L(8); GE_BAR; GE_WAIT_L(0); GE_MMA(0, 0, At, B0); GE_BAR; GE_SCHED;
            GE_LDB(B1, 1, 1); GE_STAGE_B(GE_SB(1, 0), b30);
            GE_BAR; GE_WAIT_L(0); GE_MMA(0, 1, At, B1); GE_BAR;
            GE_LDA(At, 1, 1); GE_STAGE_A2(GE_SA(1, 0), a3, 0);
            GE_BAR; GE_WAIT_L(0); GE_MMA(1, 0, At, B0); GE_BAR; GE_SCHED;
            GE_STAGE_B(GE_SB(1, 1), b31);
            GE_WAIT_V(6); GE_BAR; GE_MMA(1, 1, At, B1); GE_BAR;
        }
        E(acc, cur, wr, wc, fr, fq);
        if (!has_next) break;
#pragma unroll
        for (int a = 0; a < 2; ++a)
#pragma unroll
            for (int b = 0; b < 2; ++b)
#pragma unroll
                for (int m = 0; m < 4; ++m)
#pragma unroll
                    for (int n = 0; n < 2; ++n) acc[a][b][m][n] = (f32x4){0.f, 0.f, 0.f, 0.f};
        cur = nxt; ++ui;
        if constexpr (GATHER) {
#pragma unroll
            for (int h = 0; h < 2; ++h)
#pragma unroll
                for (int i = 0; i < 2; ++i) gvc[h][i] = gvn[h][i]; }
    }
    GE_WAIT_V(0);
    if (wr == 0) GE_BAR;
    GE_BAR;
#undef GE_SA
#undef GE_SB
#undef GE_GLDS
#undef GE_STAGE_A
#undef GE_STAGE_A2
#undef GE_STAGE_B
#undef GE_LDA
#undef GE_LDB
#undef GE_MMA
#undef GE_WAIT_V
#undef GE_WAIT_L
#undef GE_BAR
#undef GE_SCHED
#undef GE_GATHER_OFFS
}
}
__device__ __forceinline__ unsigned cvt_pk_bf16(float lo, float hi) { unsigned r; asm volatile("v_cvt_pk_bf16_f32 %0, %1, %2" : "=v"(r) : "v"(lo), "v"(hi)); return r; }
__device__ __forceinline__ u32x4 pack8(const f32x4 a, const f32x4 b) { u32x4 w; w.x = cvt_pk_bf16(a[0], a[1]); w.y = cvt_pk_bf16(a[2], a[3]); w.z = cvt_pk_bf16(b[0], b[1]); w.w = cvt_pk_bf16(b[2], b[3]); return w; }
__device__ __forceinline__ void unpack8(const u32x4 w, f32x4& a, f32x4& b) {
    a[0] = __uint_as_float(w.x << 16); a[1] = __uint_as_float(w.x & 0xFFFF0000u); a[2] = __uint_as_float(w.y << 16); a[3] = __uint_as_float(w.y & 0xFFFF0000u);
    b[0] = __uint_as_float(w.z << 16); b[1] = __uint_as_float(w.z & 0xFFFF0000u); b[2] = __uint_as_float(w.w << 16); b[3] = __uint_as_float(w.w & 0xFFFF0000u); }
__device__ __forceinline__ float sigmoidf_fast(float v) { return 1.0f / (1.0f + __expf(-v)); }

struct SchedDense {
    const char* A; const char* B; size_t arb, brb; int nM, nN, G, c;
    __device__ __forceinline__ bool next(int i, ge::Unit& u) const {
        const int L = i * G + c; if (L >= nM * nN) return false;
        int pm, pn; ge::tile_order(L, nM, nN, pm, pn);
        u.pm = pm; u.pn = pn; u.kind = 0; u.rows = nullptr; u.nrows = 0;
        u.a = A + (size_t)pm * 256 * arb; u.b0 = B + (size_t)pn * 256 * brb; u.b1 = u.b0 + 128 * brb; return true;
    }
};
struct SchedInproj {
    const char* WtHy; const char* WtRest; const char* U; int G, c;
    __device__ __forceinline__ bool next(int i, ge::Unit& u) const {
        const int L = i * G + c; if (L >= 408 + 748) return false;
        int pm, pn; u.rows = nullptr; u.nrows = 0;
        if (L < 408) { ge::tile_order(L, 6, 68, pm, pn); u.kind = 0; u.a = WtHy + (size_t)pm * 256 * 2048; u.b0 = U + (size_t)pn * 256 * 2048; }
        else { ge::tile_order(L - 408, 68, 11, pm, pn); u.kind = 1; u.a = U + (size_t)pm * 256 * 2048; u.b0 = WtRest + (size_t)pn * 256 * 2048; }
        u.b1 = u.b0 + 128 * 2048; u.pm = pm; u.pn = pn; return true;
    }
};
struct EpiInproj {
    bf16_t* PT; bf16_t* PTc; bf16_t* G;
    __device__ __forceinline__ void operator()(const ge::Acc& acc, const ge::Unit& u, int wr, int wc, int fr, int fq) const {
#pragma unroll
        for (int ai = 0; ai < 2; ++ai)
#pragma unroll
            for (int m = 0; m < 4; ++m) {
                const int r = u.pm * 256 + ai * 128 + wr * 64 + m * 16 + fr;
#pragma unroll
                for (int bj = 0; bj < 2; ++bj) {
                    const int c0 = bj * 128 + wc * 32 + fq * 8;
                    if (u.kind == 0) {
                        bf16_t* dst = (u.pn < 64) ? PT + ((size_t)((u.pn >> 4) * HYC + r)) * SEQ + (u.pn & 15) * 256 + c0
                                                  : PTc + ((size_t)((u.pn - 64) * HYC + r)) * CTXL + c0;
                        *(u32x4*)dst = pack8(acc[ai][bj][m][0], acc[ai][bj][m][1]);
                    } else {
                        const int c = (u.pn - 3) * 256 + c0;
                        f32x4 a = acc[ai][bj][m][0], b = acc[ai][bj][m][1];
#pragma unroll
                        for (int j = 0; j < 4; ++j) { a[j] = sigmoidf_fast(a[j]); b[j] = sigmoidf_fast(b[j]); }
                        *(u32x4*)(G + (size_t)r * 2048 + c) = pack8(a, b);
                    }
                }
            }
    }
};
struct EpiQ {
    bf16_t* Q; bf16_t* Qc; const LAS float* rope;
    const LAS float* rs;
    __device__ __forceinline__ void operator()(const ge::Acc& acc, const ge::Unit& u, int wr, int wc, int fr, int fq) const {
#pragma unroll
        for (int ai = 0; ai < 2; ++ai)
#pragma unroll
            for (int m = 0; m < 4; ++m) {
                const int r = u.pm * 256 + ai * 128 + wr * 64 + m * 16 + fr;
                const bool lat = r < TL;
                const int t = lat ? (r & 4095) : ((r - TL) & 255);
                const int b = lat ? (r >> 12) : ((r - TL) >> 8);
#pragma unroll
                for (int bj = 0; bj < 2; ++bj) {
                    const int c = u.pn * 256 + bj * 128 + wc * 32 + fq * 8;
                    const int h = c / 96, dd = c - h * 96;
                    const float rsc = QSCALE * rs[ai * 128 + wr * 64 + m * 16 + fr];
                    f32x4 v0 = acc[ai][bj][m][0] * rsc, v1 = acc[ai][bj][m][1] * rsc;
                    f32x4 p0, p1;
#pragma unroll
                    for (int j = 0; j < 4; ++j) { p0[j] = shx(v0[j], 16); p1[j] = shx(v1[j], 16); }
                    bf16_t* qrow = lat ? Q + ((size_t)(b * NH + h) * SEQ + t) * 128 : Qc + ((size_t)(b * NH + h) * CTXL + t) * 128;
                    if (dd < 64) *(u32x4*)(qrow + dd) = pack8(v0, v1);
                    else {
                        const int d0 = dd - 64;
                        f32x4 o0 = v0, o1 = v1;
                        if (lat) {
                            const LAS float* rp = rope + 2 * ((d0 >> 4) ? 32 + (t & 63) * 8 : ((t >> 6) & 3) * 8);
                            const bool s1 = (d0 >> 3) & 1;
#pragma unroll
                            for (int j = 0; j < 4; ++j) {
                                const float cax = rp[2 * j], cay = rp[2 * j + 1], cbx = rp[8 + 2 * j], cby = rp[9 + 2 * j];
                                o0[j] = s1 ? p0[j] * cay + v0[j] * cax : v0[j] * cax - p0[j] * cay;
                                o1[j] = s1 ? p1[j] * cby + v1[j] * cbx : v1[j] * cbx - p1[j] * cby;
                            }
                        }
                        *(u32x4*)(qrow + 64 + d0) = pack8(o0, o1);
                        *(u32x4*)(qrow + 96 + d0) = pack8(v0, v1);
                    }
                }
            }
    }
};
struct EpiKV {
    bf16_t* K; bf16_t* V; const LAS float* rs;
    __device__ __forceinline__ void operator()(const ge::Acc& acc, const ge::Unit& u, int wr, int wc, int fr, int fq) const {
#pragma unroll
        for (int ai = 0; ai < 2; ++ai)
#pragma unroll
            for (int m = 0; m < 4; ++m) {
                const int r = u.pm * 256 + ai * 128 + wr * 64 + m * 16 + fr;
                int b, key;
                if (r < TL) { b = r >> 12; key = r & 4095; } else { b = (r - TL) >> 8; key = SEQ + ((r - TL) & 255); }
#pragma unroll
                for (int bj = 0; bj < 2; ++bj) {
                    const int c = u.pn * 256 + bj * 128 + wc * 32 + fq * 8;
                    const int h = c >> 7, d = c & 127;
                    const size_t kb = (size_t)(b * NH + h) * NKEY + key;
                    bf16_t* dst = (d < 64) ? K + kb * DQK + d : V + kb * DV + (d - 64);
                    const float rk = rs[ai * 128 + wr * 64 + m * 16 + fr]; *(u32x4*)dst = pack8(acc[ai][bj][m][0] * rk, acc[ai][bj][m][1] * rk);
                }
            }
    }
};

constexpr int LDS_SSQ = ge::STAGE_BYTES + 2048;
struct EpiInprojMLA {
    bf16_t* PMLAb; bf16_t* K; const float2* rope; LAS float* ssq;
    __device__ __forceinline__ void operator()(const ge::Acc& acc, const ge::Unit& u, int wr, int wc, int fr, int fq) const {
#pragma unroll
        for (int ai = 0; ai < 2; ++ai)
#pragma unroll
            for (int m = 0; m < 4; ++m) {
                const int rl = ai * 128 + wr * 64 + m * 16 + fr, r = u.pm * 256 + rl;
#pragma unroll
                for (int bj = 0; bj < 2; ++bj) {
                    const int c0 = bj * 128 + wc * 32 + fq * 8;
                    const f32x4 a = acc[ai][bj][m][0], b = acc[ai][bj][m][1];
                    const bool isval = (u.pn < 2) || (bj == 0);
                    const bool isrope = (u.pn == 2) && (bj == 1) && (wc == 0);
                    if (isval) {
                        const int col = (u.pn == 0 ? 0 : (u.pn == 1 ? 256 : 512)) + c0;
                        *(u32x4*)(PMLAb + (size_t)r * 640 + col) = pack8(a, b);
                        float sq = (a[0] * a[0] + a[1] * a[1]) + (a[2] * a[2] + a[3] * a[3]) + (b[0] * b[0] + b[1] * b[1]) + (b[2] * b[2] + b[3] * b[3]);
                        sq += shx(sq, 16); sq += shx(sq, 32);
                        if (fq == 0) ssq[rl * 16 + (u.pn == 2 ? 8 : 0) + bj * 4 + wc] = sq;
                    } else if (isrope) {
                        f32x4 pa, pb;
#pragma unroll
                        for (int j = 0; j < 4; ++j) { pa[j] = shx(a[j], 16); pb[j] = shx(b[j], 16); }
                        int bb, key; f32x4 oa = a, ob = b;
                        if (r < TL) {
                            bb = r >> 12; key = r & 4095;
                            const float2* rp = rope + (size_t)key * 16 + (fq >> 1) * 8;
#pragma unroll
                            for (int j = 0; j < 4; ++j) { const float2 ca = rp[j], cb = rp[4 + j];
                                oa[j] = (fq & 1) ? pa[j] * ca.y + a[j] * ca.x : a[j] * ca.x - pa[j] * ca.y;
                                ob[j] = (fq & 1) ? pb[j] * cb.y + b[j] * cb.x : b[j] * cb.x - pb[j] * cb.y; }
                        } else { bb = (r - TL) >> 8; key = SEQ + ((r - TL) & 255); }
                        const u32x4 w = pack8(oa, ob);
#pragma unroll
                        for (int h = 0; h < NH; ++h) *(u32x4*)(K + ((size_t)(bb * NH + h) * NKEY + key) * DQK + 64 + fq * 8) = w;
                    }
                }
            }
    }
};
struct SchedChainIn {
    const char* U; const char* WtRest; int pm, pn0, npn;
    __device__ __forceinline__ bool next(int i, ge::Unit& u) const {
        if (i >= npn) return false;
        u.pm = pm; u.pn = pn0 + i; u.kind = 1; u.rows = nullptr; u.nrows = 0;
        u.a = U + (size_t)pm * 256 * 2048; u.b0 = WtRest + (size_t)u.pn * 256 * 2048; u.b1 = u.b0 + 128 * 2048; return true;
    }
};
struct SchedPanel {
    const char* A; const char* B; size_t arb, brb; int pm, nN, kind;
    __device__ __forceinline__ bool next(int i, ge::Unit& u) const {
        if (i >= nN) return false;
        u.pm = pm; u.pn = i; u.kind = kind; u.rows = nullptr; u.nrows = 0;
        u.a = A + (size_t)pm * 256 * arb; u.b0 = B + (size_t)i * 256 * brb; u.b1 = u.b0 + 128 * brb; return true;
    }
};
struct SchedPool {
    const char* WtHy; const char* WtRest; const char* U; int first, step, n;
    __device__ __forceinline__ bool next(int i, ge::Unit& u) const {
        if (i >= n) return false;
        const int X = first + i * step; int pm, pn; u.rows = nullptr; u.nrows = 0;
        if (X < 408) { ge::tile_order(X, 6, 68, pm, pn); u.kind = 0; u.a = WtHy + (size_t)pm * 256 * 2048; u.b0 = U + (size_t)pn * 256 * 2048; }
        else { ge::tile_order(X - 408, 68, 8, pm, pn); pn += 3; u.kind = 1; u.a = U + (size_t)pm * 256 * 2048; u.b0 = WtRest + (size_t)pn * 256 * 2048; }
        u.b1 = u.b0 + 128 * 2048; u.pm = pm; u.pn = pn; return true;
    }
};
struct EpiQKV {
    EpiQ q; EpiKV kv;
    __device__ __forceinline__ void operator()(const ge::Acc& acc, const ge::Unit& u, int wr, int wc, int fr, int fq) const { if (u.kind == 0) q(acc, u, wr, wc, fr, fq); else kv(acc, u, wr, wc, fr, fq); }
};
struct SchedMerge {
    const char* Yhy; const char* Yatt; const char* Whyo; const char* Wmlao; int G, c, nM;
    __device__ __forceinline__ bool next(int i, ge::Unit& u) const {
        const int T = (i >> 1) * G + c; if (T >= nM * 4) return false;
        const int seg = i & 1; int pm, pn; ge::tile_order(T, nM, 4, pm, pn);
        u.pm = pm; u.pn = pn; u.kind = seg; u.rows = nullptr; u.nrows = 0;
        u.a = (seg ? Yatt : Yhy) + (size_t)pm * 256 * 16; u.b0 = (seg ? Wmlao : Whyo) + (size_t)pn * 256 * 1024; u.b1 = u.b0 + 128 * 1024; return true;
    }
};
struct EpiMerge {
    const bf16_t* G; bf16_t* M1;
    __device__ __forceinline__ void operator()(const ge::Acc& acc, const ge::Unit& u, int wr, int wc, int fr, int fq) const {
#pragma unroll
        for (int ai = 0; ai < 2; ++ai) {
            u32x4 gv[4][2], mv[4][2];
#pragma unroll
            for (int m = 0; m < 4; ++m) {
                const int r = u.pm * 256 + ai * 128 + wr * 64 + m * 16 + fr;
#pragma unroll
                for (int bj = 0; bj < 2; ++bj) {
                    const int c = u.pn * 256 + bj * 128 + wc * 32 + fq * 8;
                    gv[m][bj] = *(const u32x4*)(G + (size_t)r * 2048 + u.kind * DM + c);
                    if (u.kind) mv[m][bj] = *(const u32x4*)(M1 + (size_t)r * DM + c);
                }
            }
#pragma unroll
            for (int m = 0; m < 4; ++m) {
                const int r = u.pm * 256 + ai * 128 + wr * 64 + m * 16 + fr;
#pragma unroll
                for (int bj = 0; bj < 2; ++bj) {
                    const int c = u.pn * 256 + bj * 128 + wc * 32 + fq * 8;
                    f32x4 g0, g1; unpack8(gv[m][bj], g0, g1);
                    f32x4 o0 = g0 * acc[ai][bj][m][0], o1 = g1 * acc[ai][bj][m][1];
                    if (u.kind) { f32x4 q0, q1; unpack8(mv[m][bj], q0, q1); o0 += q0; o1 += q1; }
                    *(u32x4*)(M1 + (size_t)r * DM + c) = pack8(o0, o1);
                }
            }
        }
    }
};
__device__ __forceinline__ float4 ld_hx4(const bf16_t* q) { const u32x2 w = *(const u32x2*)q; return make_float4(__uint_as_float(w.x << 16), __uint_as_float(w.x & 0xFFFF0000u), __uint_as_float(w.y << 16), __uint_as_float(w.y & 0xFFFF0000u)); }
__device__ __forceinline__ void st_hx4(bf16_t* q, const float4 v) { u32x2 w; w.x = pack2(v.x, v.y); w.y = pack2(v.z, v.w); *(u32x2*)q = w; }
struct EpiOut {
    bf16_t* hx; const float* mod;
    __device__ __forceinline__ void operator()(const ge::Acc& acc, const ge::Unit& u, int wr, int wc, int fr, int fq) const {
        const int b = u.pm < 64 ? (u.pm >> 4) : 4;
        f32x4 gg[2][2];
#pragma unroll
        for (int bj = 0; bj < 2; ++bj) { const float* g = mod + (size_t)b * NMOD + 2 * DM + u.pn * 256 + bj * 128 + wc * 32 + fq * 8; gg[bj][0] = *(const f32x4*)g; gg[bj][1] = *(const f32x4*)(g + 4); }
#pragma unroll
        for (int ai = 0; ai < 2; ++ai) {
            u32x4 hv[4][2];
#pragma unroll
            for (int m = 0; m < 4; ++m) {
                const int r = u.pm * 256 + ai * 128 + wr * 64 + m * 16 + fr;
#pragma unroll
                for (int bj = 0; bj < 2; ++bj) hv[m][bj] = *(const u32x4*)(hx + (size_t)r * DM + u.pn * 256 + bj * 128 + wc * 32 + fq * 8);
            }
#pragma unroll
            for (int m = 0; m < 4; ++m) {
                const int r = u.pm * 256 + ai * 128 + wr * 64 + m * 16 + fr;
#pragma unroll
                for (int bj = 0; bj < 2; ++bj) {
                    f32x4 h0, h1; unpack8(hv[m][bj], h0, h1);
                    *(u32x4*)(hx + (size_t)r * DM + u.pn * 256 + bj * 128 + wc * 32 + fq * 8) = pack8(h0 + gg[bj][0] * acc[ai][bj][m][0], h1 + gg[bj][1] * acc[ai][bj][m][1]);
                }
            }
        }
    }
};
struct SchedGU {
    const char* U; const char* WtG; const char* WtU; const int* list; const LAS int* tpre; const LAS int* cntl; int G, c;
    __device__ __forceinline__ bool next(int i, ge::Unit& u) const {
        const int L = i * G + ((G & 7) ? c : (c & 7) * (G >> 3) + (c >> 3)); if (L >= 2 * tpre[64]) return false;
        const int rt = L >> 1, half = L & 1; int e = 0;
#pragma unroll
        for (int st_ = 32; st_ > 0; st_ >>= 1) { if (tpre[e + st_] <= rt) e += st_; }
        u.kind = e; u.pm = rt - tpre[e]; u.pn = half; u.rows = list + (size_t)e * CAP; u.nrows = cntl[e];
        u.a = U; u.b0 = WtG + ((size_t)e * DE + half * 128) * 2048; u.b1 = WtU + ((size_t)e * DE + half * 128) * 2048; return true;
    }
};
struct EpiGU {
    bf16_t* H; const LAS int* offs;
    __device__ __forceinline__ void operator()(const ge::Acc& acc, const ge::Unit& u, int wr, int wc, int fr, int fq) const {
        const int o = offs[u.kind];
#pragma unroll
        for (int ai = 0; ai < 2; ++ai)
#pragma unroll
            for (int m = 0; m < 4; ++m) {
                const int r = u.pm * 256 + ai * 128 + wr * 64 + m * 16 + fr;
                if (r < u.nrows) {
                    const int c = u.pn * 128 + wc * 32 + fq * 8;
                    f32x4 g0 = acc[ai][0][m][0], g1 = acc[ai][0][m][1];
#pragma unroll
                    for (int j = 0; j < 4; ++j) { g0[j] = g0[j] * sigmoidf_fast(g0[j]) * acc[ai][1][m][0][j]; g1[j] = g1[j] * sigmoidf_fast(g1[j]) * acc[ai][1][m][1][j]; }
                    *(u32x4*)(H + (size_t)(o + r) * DE + c) = pack8(g0, g1);
                }
            }
    }
};
struct SchedDown {
    const char* H; const char* WtD; const LAS int* tpre; const LAS int* cntl; const LAS int* offs; int G, c;
    __device__ __forceinline__ bool next(int i, ge::Unit& u) const {
        const int L = i * G + ((G & 7) ? c : (c & 7) * (G >> 3) + (c >> 3)); if (L >= 4 * tpre[64]) return false;
        const int rt = L >> 2, pn = L & 3; int e = 0;
#pragma unroll
        for (int st_ = 32; st_ > 0; st_ >>= 1) { if (tpre[e + st_] <= rt) e += st_; }
        u.kind = e; u.pm = rt - tpre[e]; u.pn = pn; u.rows = nullptr; u.nrows = cntl[e];
        u.a = H + ((size_t)offs[e] + (size_t)u.pm * 256) * 512; u.b0 = WtD + ((size_t)e * DM + pn * 256) * 512; u.b1 = u.b0 + 128 * 512; return true;
    }
};
struct EpiDown {
    bf16_t* Y; const float* wl; const LAS int* offs;
    __device__ __forceinline__ void operator()(const ge::Acc& acc, const ge::Unit& u, int wr, int wc, int fr, int fq) const {
        const int o = offs[u.kind];
        float w[2][4];
#pragma unroll
        for (int ai = 0; ai < 2; ++ai)
#pragma unroll
            for (int m = 0; m < 4; ++m) { const int r = u.pm * 256 + ai * 128 + wr * 64 + m * 16 + fr; w[ai][m] = wl[(size_t)u.kind * CAP + (r < u.nrows ? r : 0)]; }
#pragma unroll
        for (int ai = 0; ai < 2; ++ai)
#pragma unroll
            for (int m = 0; m < 4; ++m) {
                const int r = u.pm * 256 + ai * 128 + wr * 64 + m * 16 + fr;
                if (r < u.nrows) {
#pragma unroll
                    for (int bj = 0; bj < 2; ++bj) {
                        const int c = u.pn * 256 + bj * 128 + wc * 32 + fq * 8;
                        *(u32x4*)(Y + (size_t)(o + r) * DM + c) = pack8(acc[ai][bj][m][0] * w[ai][m], acc[ai][bj][m][1] * w[ai][m]);
                    }
                }
            }
    }
};


typedef short s16x4 __attribute__((ext_vector_type(4)));
#define AT_THR 8.0f
__device__ __forceinline__ void ph_attn2(const P& p, char* smem, bool with_ctx) {
    constexpr int KS = 112, VS = 80;
    constexpr int NSTG = NKEY / 128;
    bf16_t* sK = (bf16_t*)smem;
    bf16_t* sV = sK + 3 * 128 * KS;
    const int tid = tid_opaque(), lane = tid & 63, wv = tid >> 6, fr = lane & 15, g = lane >> 4;
    const int NUL = NB * NH * 16, NUC = with_ctx ? NB * NH : 0;
    const int kc0 = tid / 12, kp0 = tid % 12, kc1 = (512 + tid) / 12, kp1 = (512 + tid) % 12;
    const int vk = tid >> 3, vp = tid & 7;
#define AT_LOADK(st_, hs_) do { const bf16_t* kb_ = Kp + (size_t)((st_) * 128 + (hs_) * 64) * DQK; kr0 = *(const u32x4*)(kb_ + kc0 * DQK + kp0 * 8); if (tid < 256) kr1 = *(const u32x4*)(kb_ + kc1 * DQK + kp1 * 8); } while (0)
#define AT_LOADV(st_, hs_) do { vr0 = *(const u32x4*)(Vp + (size_t)((st_) * 128 + (hs_) * 64) * DV + vk * DV + vp * 8); } while (0)
#define AT_STOREK(buf_, hs_) do { bf16_t* d_ = sK + ((buf_) * 128 + (hs_) * 64) * KS; *(u32x4*)(d_ + kc0 * KS + kp0 * 8) = kr0; if (tid < 256) *(u32x4*)(d_ + kc1 * KS + kp1 * 8) = kr1; } while (0)
#define AT_STOREV(buf_, hs_) do { *(u32x4*)(sV + ((buf_) * 128 + (hs_) * 64) * VS + vk * VS + vp * 8) = vr0; } while (0)
#define AT_LDKF(dst, mk) do { _Pragma("unroll") for (int ks = 0; ks < 3; ++ks) dst[ks] = *(const bf16x8*)(sKn + (mk) * 16 * KS + ks * 32); } while (0)
#define AT_MMAS(src, mk) do { sN[mk][0] = (f32x4){0.f, 0.f, 0.f, 0.f}; sN[mk][1] = (f32x4){0.f, 0.f, 0.f, 0.f}; \
        _Pragma("unroll") for (int ks = 0; ks < 3; ++ks) _Pragma("unroll") for (int nq = 0; nq < 2; ++nq) { const bf16x8 bq_ = (ks < 2) ? qf[nq][ks] : (ctxn ? qf[nq][3] : qf[nq][2]); \
            sN[mk][nq] = __builtin_amdgcn_mfma_f32_16x16x32_bf16(src[ks], bq_, sN[mk][nq], 0, 0, 0); } } while (0)
#define AT_EXPS(nq) do { float r_ = (nq) ? rs[0] - rs[0] : 0.f; _Pragma("unroll") for (int mk = 0; mk < 4; ++mk) _Pragma("unroll") for (int r = 0; r < 4; ++r) { const float pv = __builtin_amdgcn_exp2f(sC[mk][nq][r] - mn[nq]); r_ += pv; sC[mk][nq][r] = pv; } rs[nq] = r_; } while (0)
#define AT_SUBTILE(sKn_, ctxn_, sVb_) do { \
        const bf16_t* sKn = (sKn_) + fr * KS + g * 8; const bool ctxn = (ctxn_); \
        bf16x8 kfA[3], kfB[3]; bf16x8 pf[2][2]; float mn[2], mxq[2], rs[2]; \
        AT_LDKF(kfA, 0); \
        AT_MMAS(kfA, 0); AT_LDKF(kfB, 1); \
        _Pragma("unroll") for (int nq = 0; nq < 2; ++nq) { float mx = sC[0][nq][0]; \
            _Pragma("unroll") for (int mk = 0; mk < 4; ++mk) _Pragma("unroll") for (int r = 0; r < 4; ++r) mx = fmaxf(mx, sC[mk][nq][r]); \
            mxq[nq] = rowmax4(mx); } \
          \
          \
        if (__any((mxq[0] - m[0] > AT_THR) || (mxq[1] - m[1] > AT_THR))) { \
            _Pragma("unroll") for (int nq = 0; nq < 2; ++nq) { const float mnew_ = fmaxf(m[nq], mxq[nq]); const float a_ = __builtin_amdgcn_exp2f(m[nq] - mnew_); m[nq] = mnew_; lsum[nq] *= a_; \
                _Pragma("unroll") for (int md = 0; md < 4; ++md) oT[md][nq] *= a_; } } \
        mn[0] = m[0]; mn[1] = m[1]; \
        __builtin_amdgcn_sched_barrier(0); \
        AT_MMAS(kfB, 1); AT_LDKF(kfA, 2); AT_EXPS(0); \
        __builtin_amdgcn_sched_barrier(0); \
        AT_MMAS(kfA, 2); AT_LDKF(kfB, 3); AT_EXPS(1); \
        __builtin_amdgcn_sched_barrier(0); \
        AT_MMAS(kfB, 3); \
        _Pragma("unroll") for (int nq = 0; nq < 2; ++nq) { lsum[nq] += rs[nq]; \
            _Pragma("unroll") for (int kp = 0; kp < 2; ++kp) { const u32x4 w_ = pack8(sC[2 * kp][nq], sC[2 * kp + 1][nq]); pf[kp][nq] = __builtin_bit_cast(bf16x8, w_); } } \
        __builtin_amdgcn_sched_barrier(0); \
        _Pragma("unroll") for (int kp = 0; kp < 2; ++kp) _Pragma("unroll") for (int md = 0; md < 4; ++md) { \
            const bf16_t* a0_ = (sVb_) + (32 * kp + 4 * g + (fr >> 2)) * VS + 16 * md + 4 * (fr & 3); \
            const s16x4 lo_ = __builtin_amdgcn_ds_read_tr16_b64_v4i16((LAS s16x4*)a0_); \
            const s16x4 hi_ = __builtin_amdgcn_ds_read_tr16_b64_v4i16((LAS s16x4*)(a0_ + 16 * VS)); \
            const bf16x8 vf_ = __builtin_shufflevector(lo_, hi_, 0, 1, 2, 3, 4, 5, 6, 7); \
            _Pragma("unroll") for (int nq = 0; nq < 2; ++nq) oT[md][nq] = __builtin_amdgcn_mfma_f32_16x16x32_bf16(vf_, pf[kp][nq], oT[md][nq], 0, 0, 0); } \
        _Pragma("unroll") for (int mk = 0; mk < 4; ++mk) { sC[mk][0] = sN[mk][0]; sC[mk][1] = sN[mk][1]; } \
    } while (0)
    for (int u = blockIdx.x; u < NUL + NUC; u += gridDim.x) {
        const bool isctx = u >= NUL;
        int b, h, q0;
        if (!isctx) {
            int bh, qb;
            if (gridDim.x == 256) { const int c = u & 255, r = u >> 8, x = c & 7, sl = c >> 3; bh = r * 16 + x * 2 + (sl >> 4); qb = sl & 15; } else { bh = u / 16; qb = u % 16; }
            b = bh / NH; h = bh % NH; q0 = qb * 256;
        } else { const int v = u - NUL; b = v / NH; h = v % NH; q0 = 0; }
        const bf16_t* Qp = (isctx ? p.Qc + ((size_t)(b * NH + h) * CTXL + q0) * 128 : p.Q + ((size_t)(b * NH + h) * SEQ + q0) * 128) + (size_t)(wv * 32) * 128;
        bf16x8 qf[2][4];
#pragma unroll
        for (int nq = 0; nq < 2; ++nq)
#pragma unroll
            for (int ks = 0; ks < 4; ++ks) qf[nq][ks] = *(const bf16x8*)(Qp + (size_t)(nq * 16 + fr) * 128 + ks * 32 + g * 8);
        const bf16_t* Kp = p.K + (size_t)(b * NH + h) * NKEY * DQK;
        const bf16_t* Vp = p.V + (size_t)(b * NH + h) * NKEY * DV;
        f32x4 oT[4][2]; float m[2], lsum[2];
#pragma unroll
        for (int nq = 0; nq < 2; ++nq) { m[nq] = -INFINITY; lsum[nq] = 0.f;
#pragma unroll
            for (int md = 0; md < 4; ++md) oT[md][nq] = (f32x4){0.f, 0.f, 0.f, 0.f}; }
        const int st0 = isctx ? 32 : 0;
        u32x4 kr0, kr1 = (u32x4){0u, 0u, 0u, 0u}, vr0;
        f32x4 sC[4][2], sN[4][2];
        __syncthreads();
        AT_LOADK(st0, 0); AT_LOADV(st0, 0); AT_STOREK(0, 0); AT_STOREV(0, 0);
        AT_LOADK(st0, 1); AT_LOADV(st0, 1); AT_STOREK(0, 1); AT_STOREV(0, 1);
        AT_LOADK(st0 + 1, 0); AT_STOREK(1, 0);
        AT_LOADK(st0 + 1, 1);
        __syncthreads();
        {
            const bf16_t* sKn = sK + fr * KS + g * 8; const bool ctxn = st0 >= 32;
            bf16x8 kfA[3];
#pragma unroll
            for (int mk = 0; mk < 4; ++mk) { AT_LDKF(kfA, mk); AT_MMAS(kfA, mk); }
#pragma unroll
            for (int mk = 0; mk < 4; ++mk) { sC[mk][0] = sN[mk][0]; sC[mk][1] = sN[mk][1]; }
        }
        AT_STOREK(1, 1);
        __syncthreads();
        int kb = 0;
        for (int st = st0; st < NSTG; ++st) {
            const int bufc = (st - st0) & 1;
            const int st1 = st + 1 < NSTG ? st + 1 : NSTG - 1, st2 = st + 2 < NSTG ? st + 2 : NSTG - 1;
            const int kb1 = kb == 2 ? 0 : kb + 1, kb2 = kb1 == 2 ? 0 : kb1 + 1;
            const bf16_t* sKc = sK + kb * 128 * KS; const bf16_t* sKx = sK + kb1 * 128 * KS; const bf16_t* sVc = sV + bufc * 128 * VS;
            AT_LOADK(st2, 0); AT_LOADV(st1, 0);
            AT_SUBTILE(sKc + 64 * KS, st >= 32, sVc);
            AT_STOREK(kb2, 0); AT_STOREV(bufc ^ 1, 0);
            AT_LOADK(st2, 1); AT_LOADV(st1, 1);
            AT_SUBTILE(sKx, st1 >= 32, sVc + 64 * VS);
            AT_STOREK(kb2, 1); AT_STOREV(bufc ^ 1, 1);
            __syncthreads();
            kb = kb1;
        }
        const size_t rbase = (isctx ? (size_t)TL + b * CTXL : (size_t)b * SEQ) + q0 + wv * 32;
#pragma unroll
        for (int nq = 0; nq < 2; ++nq) {
            const float l = rowsum4(lsum[nq]);
            const float inv = 1.0f / l;
#pragma unroll
            for (int md = 0; md < 4; ++md) {
                u32x2 o; o.x = cvt_pk_bf16(oT[md][nq][0] * inv, oT[md][nq][1] * inv); o.y = cvt_pk_bf16(oT[md][nq][2] * inv, oT[md][nq][3] * inv);
                *(u32x2*)(p.Yatt + ((size_t)(h * 8 + md * 2 + (g >> 1)) * TT + rbase + nq * 16 + fr) * 8 + 4 * (g & 1)) = o;
            }
        }
    }
#undef AT_LOADK
#undef AT_LOADV
#undef AT_STOREK
#undef AT_STOREV
#undef AT_LDKF
#undef AT_MMAS
#undef AT_EXPS
#undef AT_SUBTILE
}

constexpr int RT_PITCH = 1024 + 8;
__device__ __forceinline__ void ph_norm2_router(const P& p, int l, char* smem, int nrows_total) {
    bf16_t* thi = (bf16_t*)smem;
    bf16_t* tlo = thi + 16 * RT_PITCH;
    float* part = (float*)(tlo + 16 * RT_PITCH);
    float* lgs = part + 8 * 16 * 80;
    const int tid = tid_opaque(), lane = tid & 63, wv = tid >> 6, fr = lane & 15, g = lane >> 4;
    const float* ng = p.norm2_g + l * DM;
    const bf16_t* whi = p.WrT + (size_t)(l * 2 + 0) * 80 * DM; const bf16_t* wlo = p.WrT + (size_t)(l * 2 + 1) * 80 * DM;
    bf16x8 bh[4][5];
#pragma unroll
    for (int ks = 0; ks < 4; ++ks)
#pragma unroll
        for (int nt = 0; nt < 5; ++nt) { const size_t o = (size_t)(nt * 16 + fr) * DM + wv * 128 + ks * 32 + g * 8; bh[ks][nt] = *(const bf16x8*)(whi + o); }
    float* bias_s = lgs + 16 * 80;
    float* recs = bias_s + 80;
    int nrec = 0;
    if (tid < 72) bias_s[tid] = tid < 64 ? p.b_re[l * NE + tid] : p.b_rg[l * 8 + tid - 64];
    for (int rb = blockIdx.x * 16; rb < nrows_total; rb += gridDim.x * 16) {
        __syncthreads();
        {
            const int lr0 = wv * 2, row0 = rb + lr0;
            const int b = row0 < TL ? (row0 >> 12) : 4;
            const bf16_t* hp = (const bf16_t*)p.hx + (size_t)row0 * DM;
            const float* md = p.mod + ((size_t)l * 5 + b) * NMOD + 3 * DM;
            float4 xv[2][4], gg4[4], sh4[4], sc4[4];
#pragma unroll
            for (int i = 0; i < 4; ++i) { const int j = i * 256 + lane * 4; xv[0][i] = ld_hx4(hp + j); xv[1][i] = ld_hx4(hp + DM + j); gg4[i] = *(const float4*)(ng + j); sh4[i] = *(const float4*)(md + j); sc4[i] = *(const float4*)(md + DM + j); }
            float ss0 = 0.f, ss1 = 0.f;
#pragma unroll
            for (int i = 0; i < 4; ++i) { ss0 += xv[0][i].x * xv[0][i].x + xv[0][i].y * xv[0][i].y + xv[0][i].z * xv[0][i].z + xv[0][i].w * xv[0][i].w;
                                          ss1 += xv[1][i].x * xv[1][i].x + xv[1][i].y * xv[1][i].y + xv[1][i].z * xv[1][i].z + xv[1][i].w * xv[1][i].w; }
#pragma unroll
            for (int o = 32; o > 0; o >>= 1) { ss0 += shx(ss0, o); ss1 += shx(ss1, o); }
            const float rs2[2] = {rsqrtf(ss0 * (1.0f / DM) + epsf()), rsqrtf(ss1 * (1.0f / DM) + epsf())};
#pragma unroll
            for (int i = 0; i < 4; ++i) {
                const int j = i * 256 + lane * 4;
                const float4 gg = gg4[i], sh = sh4[i], sc = sc4[i];
#pragma unroll
                for (int rr = 0; rr < 2; ++rr) {
                    const int lr = lr0 + rr; const float rs = rs2[rr];
                    float y[4];
                    y[0] = (xv[rr][i].x * rs * gg.x) * (1.f + sc.x) + sh.x; y[1] = (xv[rr][i].y * rs * gg.y) * (1.f + sc.y) + sh.y;
                    y[2] = (xv[rr][i].z * rs * gg.z) * (1.f + sc.z) + sh.z; y[3] = (xv[rr][i].w * rs * gg.w) * (1.f + sc.w) + sh.w;
                    bf16_t h[4], lo[4];
#pragma unroll
                    for (int e = 0; e < 4; ++e) { h[e] = f2bf(y[e]); lo[e] = f2bf(y[e] - bf2f(h[e])); }
                    u32x2 oh; oh.x = (unsigned)h[0] | ((unsigned)h[1] << 16); oh.y = (unsigned)h[2] | ((unsigned)h[3] << 16);
                    u32x2 ol; ol.x = (unsigned)lo[0] | ((unsigned)lo[1] << 16); ol.y = (unsigned)lo[2] | ((unsigned)lo[3] << 16);
                    *(u32x2*)(p.U + (size_t)(row0 + rr) * DM + j) = oh;
                    *(u32x2*)(thi + lr * RT_PITCH + j) = oh; *(u32x2*)(tlo + lr * RT_PITCH + j) = ol;
                }
            }
        }
        __syncthreads();
        f32x4 acc[5];
#pragma unroll
        for (int nt = 0; nt < 5; ++nt) acc[nt] = (f32x4){0.f, 0.f, 0.f, 0.f};
#pragma unroll
        for (int ks = 0; ks < 4; ++ks) {
            const int k0 = wv * 128 + ks * 32 + g * 8;
            const bf16x8 ah = *(const bf16x8*)(thi + fr * RT_PITCH + k0), al = *(const bf16x8*)(tlo + fr * RT_PITCH + k0);
#pragma unroll
            for (int nt = 0; nt < 5; ++nt) {
                const bf16x8 blf = *(const bf16x8*)(wlo + (size_t)(nt * 16 + fr) * DM + k0);
                acc[nt] = __builtin_amdgcn_mfma_f32_16x16x32_bf16(ah, bh[ks][nt], acc[nt], 0, 0, 0);
                acc[nt] = __builtin_amdgcn_mfma_f32_16x16x32_bf16(al, bh[ks][nt], acc[nt], 0, 0, 0);
                acc[nt] = __builtin_amdgcn_mfma_f32_16x16x32_bf16(ah, blf, acc[nt], 0, 0, 0);
            }
        }
#pragma unroll
        for (int nt = 0; nt < 5; ++nt)
#pragma unroll
            for (int r = 0; r < 4; ++r) part[(wv * 16 + g * 4 + r) * 80 + nt * 16 + fr] = acc[nt][r];
        __syncthreads();
        for (int i = tid; i < 16 * 80; i += NT) { float a = 0.f;
#pragma unroll
            for (int w = 0; w < 8; ++w) a += part[w * 16 * 80 + i];
            lgs[i] = a; }
        __syncthreads();
        if (tid < 128) {
            const int lrw = tid >> 3, i = tid & 7, row = rb + lrw;
            const float* le = lgs + lrw * 80; const float* lg = le + 64;
            const float* bre = bias_s; const float* brg = bias_s + 64;
            const float lgi = lg[i];
            float bv = lgi + brg[i]; int bi = i; float mx = lgi;
#pragma unroll
            for (int o = 1; o < 8; o <<= 1) { const float ov = shx(bv, o); const int oi = shx(bi, o); if (ov > bv || (ov == bv && oi < bi)) { bv = ov; bi = oi; } mx = fmaxf(mx, shx(mx, o)); }
            const int gs = bi;
            float den = __expf(lgi - mx);
#pragma unroll
            for (int o = 1; o < 8; o <<= 1) den += shx(den, o);
            const float pg = __expf(lg[gs] - mx) / den;
            const float lei = le[gs * 8 + i];
            float k0v = lei + bre[gs * 8 + i]; int k0i = i;
            const float keyi = k0v;
#pragma unroll
            for (int o = 1; o < 8; o <<= 1) { const float ov = shx(k0v, o); const int oi = shx(k0i, o); if (ov > k0v || (ov == k0v && oi < k0i)) { k0v = ov; k0i = oi; } }
            const int i0 = k0i;
            float k1v = (i == i0) ? -INFINITY : keyi; int k1i = (i == i0) ? 8 : i;
#pragma unroll
            for (int o = 1; o < 8; o <<= 1) { const float ov = shx(k1v, o); const int oi = shx(k1i, o); if (ov > k1v || (ov == k1v && oi < k1i)) { k1v = ov; k1i = oi; } }
            const int i1 = k1i;
            if (i == 0) {
                const float w0 = 1.0f / (1.0f + __expf(le[gs * 8 + i1] - le[gs * 8 + i0])), w1 = 1.0f - w0;
                float* rc = recs + (nrec * 16 + lrw) * 4;
                rc[0] = __int_as_float((gs * 8 + i0) | ((gs * 8 + i1) << 8)); rc[1] = pg * w0; rc[2] = pg * w1; rc[3] = __int_as_float(row);
            }
        }
        ++nrec;
    }
    __syncthreads();
    for (int q = tid; q < nrec * 16; q += NT) {
        const float* rc = recs + q * 4;
        const int ee = __float_as_int(rc[0]), e0 = ee & 255, e1 = ee >> 8, row = __float_as_int(rc[3]);
        const int r0 = atomicAdd(p.cnt + (l * NE + e0) * 64, 1), r1 = atomicAdd(p.cnt + (l * NE + e1) * 64, 1);
        p.list[(size_t)e0 * CAP + r0] = row; p.wl[(size_t)e0 * CAP + r0] = rc[1];
        p.list[(size_t)e1 * CAP + r1] = row; p.wl[(size_t)e1 * CAP + r1] = rc[2];
        *(int4*)(p.asg + (size_t)row * 4) = make_int4(e0, r0, e1, r1);
    }
    __syncthreads();
}

typedef float v2f __attribute__((ext_vector_type(2)));
#define HD __device__ __forceinline__
HD v2f vfma(v2f a, v2f b, v2f c) { return __builtin_elementwise_fma(a, b, c); }
HD v2f twk(v2f w) { return w.yy * (v2f){-1.f, 1.f}; }
HD v2f cmulk(v2f a, v2f w, v2f wk) { return vfma(a.yx, wk, a * w.xx); }
HD v2f cmulck(v2f a, v2f w, v2f wk) { return vfma(a.yx, -wk, a * w.xx); }
HD v2f cmul(v2f a, v2f w) { return cmulk(a, w, twk(w)); }
HD v2f cmulc(v2f a, v2f w) { return cmulck(a, w, twk(w)); }
HD int fphys(int i) { return (i >> 8) * 272 + ((i >> 4) & 15) * 17 + (i & 15); }
constexpr int FBUF = 4352;
template <bool INV> HD void dft4(v2f& x0, v2f& x1, v2f& x2, v2f& x3) {
    const v2f s02 = x0 + x2, d02 = x0 - x2, s13 = x1 + x3, d13 = x1 - x3;
    const v2f kj = INV ? (v2f){-1.f, 1.f} : (v2f){1.f, -1.f};
    x0 = s02 + s13; x2 = s02 - s13; x1 = vfma(d13.yx, kj, d02); x3 = vfma(d13.yx, -kj, d02);
}
template <bool INV> HD void dft16(v2f (&v)[16]) {
#pragma unroll
    for (int b = 0; b < 4; ++b) dft4<INV>(v[b], v[4 + b], v[8 + b], v[12 + b]);
    float C1 = 0.92387953251128674f, S1 = 0.38268343236508977f, C2 = 0.70710678118654752f;
    asm volatile("" : "+v"(C1), "+v"(S1), "+v"(C2));
#define TW(idx, cr, ci) v[idx] = vfma(v[idx].yx, INV ? (v2f){(ci), -(ci)} : (v2f){-(ci), (ci)}, v[idx] * (v2f){(cr), (cr)})
    TW(4 * 1 + 1, C1, -S1);
    TW(4 * 1 + 2, C2, -C2);
    TW(4 * 1 + 3, S1, -C1);
    TW(4 * 2 + 1, C2, -C2);
    v[4 * 2 + 2] = v[4 * 2 + 2].yx * (INV ? (v2f){-1.f, 1.f} : (v2f){1.f, -1.f});
    TW(4 * 2 + 3, -C2, -C2);
    TW(4 * 3 + 1, S1, -C1);
    TW(4 * 3 + 2, -C2, -C2);
    TW(4 * 3 + 3, -C1, S1);
#undef TW
#pragma unroll
    for (int c = 0; c < 4; ++c) dft4<INV>(v[4 * c], v[4 * c + 1], v[4 * c + 2], v[4 * c + 3]);
#define SW(i, j) { const v2f t_ = v[i]; v[i] = v[j]; v[j] = t_; }
    SW(1, 4) SW(2, 8) SW(3, 12) SW(6, 9) SW(7, 13) SW(11, 14)
#undef SW
}
template <class BUF, class TW> HD void fwd_pass0(int u, v2f (&v)[16], BUF buf, TW W) {
    dft16<false>(v);
    const v2f w1 = W[u], w1k = twk(w1); v2f wr = w1;
    const int pb = fphys(u);
    buf[pb] = v[0];
#pragma unroll
    for (int r = 1; r < 16; ++r) { v[r] = cmul(v[r], wr); buf[pb + 272 * r] = v[r]; wr = cmulk(wr, w1, w1k); }
}
template <class BUF, class TW> HD void fwd_pass1(int u, v2f (&v)[16], BUF buf, TW W) {
    const int j = u & 15, pb = (u >> 4) * 272 + j;
#pragma unroll
    for (int q = 0; q < 16; ++q) v[q] = buf[pb + 17 * q];
    dft16<false>(v);
    const v2f w1 = W[16 * j], w1k = twk(w1); v2f wr = w1;
    buf[pb] = v[0];
#pragma unroll
    for (int r = 1; r < 16; ++r) { v[r] = cmul(v[r], wr); buf[pb + 17 * r] = v[r]; wr = cmulk(wr, w1, w1k); }
}
template <class BUF> HD void fwd_pass2(int u, v2f (&v)[16], BUF buf) {
    const int pb = (u >> 4) * 272 + (u & 15) * 17;
#pragma unroll
    for (int q = 0; q < 16; ++q) v[q] = buf[pb + q];
    dft16<false>(v);
}
template <class BUF> HD void inv_passA(int u, v2f (&v)[16], BUF buf) {
    dft16<true>(v);
    const int pb = (u >> 4) * 272 + (u & 15) * 17;
#pragma unroll
    for (int r = 0; r < 16; ++r) buf[pb + r] = v[r];
}
template <class BUF, class TW> HD void inv_passB(int u, v2f (&v)[16], BUF buf, TW W) {
    const int j = u & 15, pb = (u >> 4) * 272 + j;
    const v2f w1 = W[16 * j], w1k = twk(w1); v2f wr = w1;
    v[0] = buf[pb];
#pragma unroll
    for (int q = 1; q < 16; ++q) { v[q] = cmulc(buf[pb + 17 * q], wr); wr = cmulk(wr, w1, w1k); }
    dft16<true>(v);
#pragma unroll
    for (int r = 0; r < 16; ++r) buf[pb + 17 * r] = v[r];
}
template <class BUF, class TW> HD void inv_passC(int u, v2f (&v)[16], BUF buf, TW W) {
    const v2f w1 = W[u], w1k = twk(w1); v2f wr = w1;
    const int pb = fphys(u);
    v[0] = buf[pb];
#pragma unroll
    for (int q = 1; q < 16; ++q) { v[q] = cmulc(buf[pb + 272 * q], wr); wr = cmulk(wr, w1, w1k); }
    dft16<true>(v);
}
HD int digitrev(int i) { return ((i & 15) << 8) | (i & 0xF0) | (i >> 8); }

#undef HD
constexpr int FFT_LDS_W = 2 * FBUF * 8;
constexpr int FFT_LDS_STG = FFT_LDS_W + 4096 * 8;
constexpr int STG_ROW = SEQ + 16;
constexpr int FFT_LDS_W2 = FFT_LDS_STG + 2 * STG_ROW * 2;
constexpr int FFT_LDS_END = FFT_LDS_W2 + 4096 * 8;
__device__ __forceinline__ void fft_load_w(const P& p, char* smem) {
    float2* Wl = (float2*)(smem + FFT_LDS_W); float2* W2l = (float2*)(smem + FFT_LDS_W2);
    __syncthreads();
    { const int t_ = tid_opaque();
      float4 a_[4], b_[4];
#pragma unroll
      for (int k = 0; k < 4; ++k) { a_[k] = ((const float4*)p.Wtab)[t_ + NT * k]; b_[k] = ((const float4*)p.W2tab)[t_ + NT * k]; }
#pragma unroll
      for (int k = 0; k < 4; ++k) { ((float4*)Wl)[t_ + NT * k] = a_[k]; ((float4*)W2l)[t_ + NT * k] = b_[k]; } }
    __syncthreads();
}
__device__ __forceinline__ void ph_tables(const P& p) {
    for (int i = blockIdx.x * NT + tid_opaque(); i < 8192; i += gridDim.x * NT) {
        float sn, cs;
        if (i < 4096) { sincospif((float)i * (1.0f / 2048.0f), &sn, &cs); p.Wtab[i] = make_float2(cs, -sn); }
        else { sincospif((float)(i - 4096) * (1.0f / 4096.0f), &sn, &cs); p.W2tab[i - 4096] = make_float2(cs, -sn); }
    }
    for (int i = blockIdx.x * NT + tid_opaque(); i < DEPTH * 80 * DM; i += gridDim.x * NT) {
        const int l = i / (80 * DM), n = (i / DM) % 80, kk = i % DM;
        const float v = n < 64 ? p.w_re[((size_t)l * DM + kk) * NE + n] : (n < 72 ? p.w_rg[((size_t)l * DM + kk) * 8 + (n - 64)] : 0.f);
        const bf16_t h = f2bf(v);
        p.WrT[((size_t)(l * 2 + 0) * 80 + n) * DM + kk] = h; p.WrT[((size_t)(l * 2 + 1) * 80 + n) * DM + kk] = f2bf(v - bf2f(h));
    }
}
__device__ __forceinline__ void ph_spectra(const P& p, char* smem) {
    v2f* bufE = (v2f*)smem; v2f* bufO = bufE + FBUF; const v2f* Wl = (const v2f*)(smem + FFT_LDS_W); const v2f* W2l = (const v2f*)(smem + FFT_LDS_W2);
    const int tid = tid_opaque(), half = tid >> 8, u = tid & 255;
    v2f* buf = half ? bufO : bufE;
    fft_load_w(p, smem);
    for (int un = blockIdx.x; un < DEPTH * HYW; un += gridDim.x) {
        const int l = un / HYW, c = un % HYW;
        const float* hf0 = p.HT0 + ((size_t)l * 2048 + c) * SEQ;        const float s_f0 = p.SCL0[l * 2048 + c];
        const float* hb0 = p.HT0 + ((size_t)l * 2048 + 512 + c) * SEQ;  const float s_b0 = p.SCL0[l * 2048 + 512 + c];
        const float* hf1 = p.HT0 + ((size_t)l * 2048 + 1024 + c) * SEQ; const float s_f1 = p.SCL0[l * 2048 + 1024 + c];
        const float* hb1 = p.HT0 + ((size_t)l * 2048 + 1536 + c) * SEQ; const float s_b1 = p.SCL0[l * 2048 + 1536 + c];
        v2f v[16];
#pragma unroll
        for (int q = 0; q < 16; ++q) {
            const int j = 2 * (u + 256 * q) + half;
            float a, b;
            if (j < SEQ) { a = hf0[j] * s_f0; b = hf1[j] * s_f1; } else if (j == SEQ) { a = 0.f; b = 0.f; } else { a = hb0[2 * SEQ - j] * s_b0; b = hb1[2 * SEQ - j] * s_b1; }
            if (j == 0) { a += p.flt_bias[(l * 2 + 0) * HYW + c]; b += p.flt_bias[(l * 2 + 1) * HYW + c]; }
            v[q] = (v2f){a, b};
        }
        __syncthreads();
        fwd_pass0(u, v, buf, Wl); __syncthreads();
        fwd_pass1(u, v, buf, Wl); __syncthreads();
        fwd_pass2(u, v, buf);
#pragma unroll
        for (int r = 0; r < 16; ++r) buf[fphys(16 * u + r)] = v[r];
        __syncthreads();
        unsigned* out = (unsigned*)p.Hs + (size_t)(l * HYW + c) * 4 * 4096;
        for (int idx = tid; idx < 8192; idx += NT) {
            const int par = idx >> 12, pi = idx & 4095, kp = 2 * digitrev(pi) + par, kpp = (8192 - kp) & 8191;
            const int k1 = kp & 4095, k2 = kpp & 4095;
            v2f t1 = cmul(W2l[k1], bufO[fphys(digitrev(k1))]); if (kp >= 4096) t1 = -t1;
            v2f t2 = cmul(W2l[k2], bufO[fphys(digitrev(k2))]); if (kpp >= 4096) t2 = -t2;
            const v2f F = bufE[fphys(digitrev(k1))] + t1, Gq = bufE[fphys(digitrev(k2))] + t2;
            const float sc = 0.5f / 8192.0f;
            out[(0 * 2 + par) * 4096 + pi] = pack2((F.x + Gq.x) * sc, (F.y - Gq.y) * sc);
            out[(1 * 2 + par) * 4096 + pi] = pack2((F.y + Gq.y) * sc, -(F.x - Gq.x) * sc);
        }
    }
    __syncthreads();
}
__device__ __forceinline__ void fft_conv(int half, int u, v2f (&v)[16], const v2f* W2g, const unsigned* Hso, v2f* buf, const v2f* Wl) {
    u32x4 hreg[4];
    const u32x4* hp = (const u32x4*)(Hso + (size_t)half * 4096 + 16 * u);
#pragma unroll
    for (int r4 = 0; r4 < 4; ++r4) hreg[r4] = hp[r4];
    if (half) {
#pragma unroll
        for (int q = 0; q < 16; ++q) v[q] = cmul(v[q], W2g[u + 256 * q]);
    }
    fwd_pass0(u, v, buf, Wl); __syncthreads();
    fwd_pass1(u, v, buf, Wl); __syncthreads();
    fwd_pass2(u, v, buf);
#pragma unroll
    for (int r4 = 0; r4 < 4; ++r4) { const u32x4 h = hreg[r4];
#define HSV(w_) ((v2f){__uint_as_float((w_) << 16), __uint_as_float((w_) & 0xFFFF0000u)})
        v[4 * r4] = cmul(v[4 * r4], HSV(h.x)); v[4 * r4 + 1] = cmul(v[4 * r4 + 1], HSV(h.y)); v[4 * r4 + 2] = cmul(v[4 * r4 + 2], HSV(h.z)); v[4 * r4 + 3] = cmul(v[4 * r4 + 3], HSV(h.w));
#undef HSV
    }
    inv_passA(u, v, buf); __syncthreads();
    inv_passB(u, v, buf, Wl); __syncthreads();
    inv_passC(u, v, buf, Wl);
    if (half) {
#pragma unroll
        for (int r = 0; r < 16; ++r) v[r] = cmulc(v[r], W2g[u + 256 * r]);
    }
}

__device__ __forceinline__ void ph_hyena_fft(const P& p, int l, char* smem) {
    v2f* buf0 = (v2f*)smem; v2f* buf1 = buf0 + FBUF; const v2f* Wl = (const v2f*)(smem + FFT_LDS_W);
    bf16_t* stg = (bf16_t*)(smem + FFT_LDS_STG) + 8;
    const v2f* W2l = (const v2f*)(smem + FFT_LDS_W2);
    const int tid = tid_opaque(), half = tid >> 8, u = tid & 255;
    v2f* buf = half ? buf1 : buf0;
    const int pu = fphys(u);
    if (tid < 32) { const int rw = tid >> 4, k = tid & 15; (stg - 8 + rw * STG_ROW)[k < 8 ? k : SEQ + k] = 0; }
    fft_load_w(p, smem);
    for (int c = blockIdx.x; c < HYW; c += gridDim.x) {
        const unsigned* Hs0 = (const unsigned*)p.Hs + (size_t)(l * HYW + c) * 4 * 4096; const unsigned* Hs1 = Hs0 + 2 * 4096;
        float scw[3][4];
#pragma unroll
        for (int w = 0; w < 3; ++w) { const int col = w * HYW + c; scw[w][0] = p.sc_w[(size_t)(l * 3 + 0) * HYC + col]; scw[w][1] = p.sc_w[(size_t)(l * 3 + 1) * HYC + col]; scw[w][2] = p.sc_w[(size_t)(l * 3 + 2) * HYC + col]; scw[w][3] = p.sc_b[l * HYC + col]; }
#define HY_TAP(sb, k, w) (scw[w][3] + scw[w][0] * __uint_as_float((unsigned)(sb)[(k) - 1] << 16) + scw[w][1] * __uint_as_float((unsigned)(sb)[(k)] << 16) + scw[w][2] * __uint_as_float((unsigned)(sb)[(k) + 1] << 16))
        u32x4 ra, rb;
#define HY_LOAD(sel, pr_) do { const bf16_t* r0_ = p.PT + ((size_t)(2 * (pr_)) * HYC + (sel) * HYW + c) * SEQ + tid * 8; ra = *(const u32x4*)r0_; rb = *(const u32x4*)(r0_ + (size_t)HYC * SEQ); } while (0)
#define HY_STAGE() do { *(u32x4*)(stg + tid * 8) = ra; *(u32x4*)(stg + STG_ROW + tid * 8) = rb; } while (0)
        HY_LOAD(0, 0);
        for (int pr = 0; pr < 2; ++pr) {
            const LAS bf16_t* sbA = (const LAS bf16_t*)stg + u; asm volatile("" : "+v"(sbA));
            const LAS bf16_t* sbB = sbA + STG_ROW;
            __syncthreads();
            HY_STAGE();
            __syncthreads();
            v2f v[16];
#pragma unroll
            for (int q = 0; q < 16; ++q) v[q] = (v2f){HY_TAP(sbA, 256 * q, 0), HY_TAP(sbB, 256 * q, 0)};
            HY_LOAD(1, pr);
            fft_conv(half, u, v, W2l, Hs0, buf, Wl);
            if (half) {
#pragma unroll
                for (int r = 0; r < 16; ++r) buf1[pu + 272 * r] = v[r];
            }
            HY_STAGE();
            __syncthreads();
            if (!half) {
#pragma unroll
                for (int r = 0; r < 16; ++r) {
                    const v2f y = v[r] + buf1[pu + 272 * r];
                    const float xa = HY_TAP(sbA, 256 * r, 1), xb = HY_TAP(sbB, 256 * r, 1);
                    const v2f z1 = (v2f){xa, xb} * y;
                    v[r] = z1; buf1[pu + 272 * r] = z1;
                }
            }
            HY_LOAD(2, pr);
            __syncthreads();
            if (half) {
#pragma unroll
                for (int r = 0; r < 16; ++r) v[r] = buf1[pu + 272 * r];
            }
            fft_conv(half, u, v, W2l, Hs1, buf, Wl);
            if (half) {
#pragma unroll
                for (int r = 0; r < 16; ++r) buf1[pu + 272 * r] = v[r];
            }
            HY_STAGE();
            if (pr == 0) HY_LOAD(0, 1);
            __syncthreads();
            if (!half) {
                bf16_t* oA = p.Yhy + ((size_t)(c >> 3) * TT + (size_t)(2 * pr) * SEQ + u) * 8 + (c & 7); bf16_t* oB = oA + (size_t)SEQ * 8;
#pragma unroll
                for (int r = 0; r < 16; ++r) {
                    const v2f y = v[r] + buf1[pu + 272 * r];
                    const float xa = HY_TAP(sbA, 256 * r, 2), xb = HY_TAP(sbB, 256 * r, 2);
                    oA[(size_t)(256 * r) * 8] = f2bf(xa * y.x);
                    oB[(size_t)(256 * r) * 8] = f2bf(xb * y.y);
                }
            }
        }
#undef HY_LOAD
#undef HY_STAGE
#undef HY_TAP
    }
    __syncthreads();
}

__device__ __forceinline__ float4 moe_combine4(const P& p, int lc, int b, size_t s0, size_t s1, int j, float4 hv) {
    const u32x2 y0 = *(const u32x2*)(p.Y + s0 * DM + j), y1 = *(const u32x2*)(p.Y + s1 * DM + j);
    const float4 g = *(const float4*)(p.mod + ((size_t)lc * 5 + b) * NMOD + 5 * DM + j);
    hv.x += g.x * (__uint_as_float(y0.x << 16) + __uint_as_float(y1.x << 16));
    hv.y += g.y * (__uint_as_float(y0.x & 0xFFFF0000u) + __uint_as_float(y1.x & 0xFFFF0000u));
    hv.z += g.z * (__uint_as_float(y0.y << 16) + __uint_as_float(y1.y << 16));
    hv.w += g.w * (__uint_as_float(y0.y & 0xFFFF0000u) + __uint_as_float(y1.y & 0xFFFF0000u));
    return hv;
}
__device__ __forceinline__ void ph_norm1c(const P& p, int l, const int* offs) {
    const int tid = tid_opaque(), lane = tid & 63, wv = tid >> 6;
    const float* ng = p.norm1_g + l * DM;
    for (int rb = blockIdx.x * 16; rb < TT; rb += gridDim.x * 16) {
        const int row0 = rb + wv * 2;
        const int b = row0 < TL ? (row0 >> 12) : 4;
        bf16_t* hp = (bf16_t*)p.hx + (size_t)row0 * DM;
        const float* src = row0 < TL ? p.x + (size_t)row0 * DM : p.ctx + (size_t)(row0 - TL) * DM;
        const float* md = p.mod + ((size_t)l * 5 + b) * NMOD;
        float4 xv[2][4];
        u32x2 ya[2][4], yb[2][4];
        if (l > 0) {
            const int4 a0 = *(const int4*)(p.asg + (size_t)row0 * 4), a1 = *(const int4*)(p.asg + (size_t)(row0 + 1) * 4);
            const size_t s00 = (size_t)offs[a0.x] + a0.y, s01 = (size_t)offs[a0.z] + a0.w, s10 = (size_t)offs[a1.x] + a1.y, s11 = (size_t)offs[a1.z] + a1.w;
#pragma unroll
            for (int i = 0; i < 4; ++i) { const int j = i * 256 + lane * 4;
                ya[0][i] = *(const u32x2*)(p.Y + s00 * DM + j); yb[0][i] = *(const u32x2*)(p.Y + s01 * DM + j);
                ya[1][i] = *(const u32x2*)(p.Y + s10 * DM + j); yb[1][i] = *(const u32x2*)(p.Y + s11 * DM + j); }
        }
#pragma unroll
        for (int i = 0; i < 4; ++i) { const int j = i * 256 + lane * 4;
            if (l > 0) { xv[0][i] = ld_hx4(hp + j); xv[1][i] = ld_hx4(hp + DM + j); } else { xv[0][i] = *(const float4*)(src + j); xv[1][i] = *(const float4*)(src + DM + j); } }
        float ss[2] = {0.f, 0.f};
#pragma unroll
        for (int rr = 0; rr < 2; ++rr)
#pragma unroll
            for (int i = 0; i < 4; ++i) {
                const int j = i * 256 + lane * 4;
                if (l > 0) {
                    const float4 g = *(const float4*)(p.mod + ((size_t)(l - 1) * 5 + b) * NMOD + 5 * DM + j);
                    const u32x2 y0 = ya[rr][i], y1 = yb[rr][i];
                    xv[rr][i].x += g.x * (__uint_as_float(y0.x << 16) + __uint_as_float(y1.x << 16));
                    xv[rr][i].y += g.y * (__uint_as_float(y0.x & 0xFFFF0000u) + __uint_as_float(y1.x & 0xFFFF0000u));
                    xv[rr][i].z += g.z * (__uint_as_float(y0.y << 16) + __uint_as_float(y1.y << 16));
                    xv[rr][i].w += g.w * (__uint_as_float(y0.y & 0xFFFF0000u) + __uint_as_float(y1.y & 0xFFFF0000u));
                }
                st_hx4(hp + (size_t)rr * DM + j, xv[rr][i]);
                ss[rr] += xv[rr][i].x * xv[rr][i].x + xv[rr][i].y * xv[rr][i].y + xv[rr][i].z * xv[rr][i].z + xv[rr][i].w * xv[rr][i].w;
            }
        ss[0] = wave_sum(ss[0]); ss[1] = wave_sum(ss[1]);
        const float rs[2] = {rsqrtf(ss[0] * (1.0f / DM) + epsf()), rsqrtf(ss[1] * (1.0f / DM) + epsf())};
#pragma unroll
        for (int i = 0; i < 4; ++i) {
            const int j = i * 256 + lane * 4;
            const float4 g = *(const float4*)(ng + j), sh = *(const float4*)(md + j), sc = *(const float4*)(md + DM + j);
#pragma unroll
            for (int rr = 0; rr < 2; ++rr) {
                u32x2 o;
                o.x = pack2((xv[rr][i].x * rs[rr] * g.x) * (1.f + sc.x) + sh.x, (xv[rr][i].y * rs[rr] * g.y) * (1.f + sc.y) + sh.y);
                o.y = pack2((xv[rr][i].z * rs[rr] * g.z) * (1.f + sc.z) + sh.z, (xv[rr][i].w * rs[rr] * g.w) * (1.f + sc.w) + sh.w);
                *(u32x2*)(p.U + (size_t)(row0 + rr) * DM + j) = o;
            }
        }
    }
}
__device__ __forceinline__ void ph_final_c(const P& p, const int* offs) {
    const int tid = tid_opaque(), lane = tid & 63, wv = tid >> 6;
    for (int rb = blockIdx.x * 8; rb < TL; rb += gridDim.x * 8) {
        const int row = rb + wv, b = row >> 12;
        const bf16_t* hp = (const bf16_t*)p.hx + (size_t)row * DM;
        const int4 a = *(const int4*)(p.asg + (size_t)row * 4);
        const size_t s0 = (size_t)offs[a.x] + a.y, s1 = (size_t)offs[a.z] + a.w;
        float4 xv[4]; float ss = 0.f;
#pragma unroll
        for (int i = 0; i < 4; ++i) {
            const int j = i * 256 + lane * 4;
            xv[i] = moe_combine4(p, DEPTH - 1, b, s0, s1, j, ld_hx4(hp + j));
            ss += xv[i].x * xv[i].x + xv[i].y * xv[i].y + xv[i].z * xv[i].z + xv[i].w * xv[i].w;
        }
        ss = wave_sum(ss);
        const float rs = rsqrtf(ss * (1.0f / DM) + epsf());
#pragma unroll
        for (int i = 0; i < 4; ++i) {
            const int j = i * 256 + lane * 4;
            const float4 g = *(const float4*)(p.final_g + j);
            float4 y; y.x = xv[i].x * rs * g.x; y.y = xv[i].y * rs * g.y; y.z = xv[i].z * rs * g.z; y.w = xv[i].w * rs * g.w;
            *(float4*)(p.out + (size_t)row * DM + j) = y;
        }
    }
}


__device__ __forceinline__ void ph_hyena_ctx(const P& p, int l, char* smem) {
    constexpr int L = CTXL;
    const int tid = tid_opaque(), hf = tid >> 8, tl = tid & 255, b = tl >> 6, t0 = (tl & 63) * 4;
    float* kern0 = (float*)smem + hf * (8 * L);
    float* kern1 = kern0 + 2 * L;
    float* zb = kern1 + 2 * L;
    const float* HT = p.HT1 + (size_t)l * 2048 * L;
    const float* SCL = p.SCL1 + l * 2048;
    for (int cb = blockIdx.x; cb < HYW; cb += 2 * gridDim.x) {
        const int c = cb + hf * gridDim.x;
        const bool act = c < HYW;
        __syncthreads();
        float uv[3][4];
        if (act) {
            const float kb0 = tl > 0 ? HT[(size_t)(512 + c) * L + (L - tl)] * SCL[512 + c] : 0.f, kb1 = tl > 0 ? HT[(size_t)(1536 + c) * L + (L - tl)] * SCL[1536 + c] : 0.f;
            const float kf0 = HT[(size_t)c * L + tl] * SCL[c], kf1 = HT[(size_t)(1024 + c) * L + tl] * SCL[1024 + c];
            kern0[tl] = kb0; kern1[tl] = kb1; kern0[L + tl] = kf0; kern1[L + tl] = kf1;
#pragma unroll
            for (int w = 0; w < 3; ++w) {
                const int col = w * HYW + c;
                const bf16_t* pr = p.PTc + ((size_t)b * HYC + col) * L + t0;
                const float w0 = p.sc_w[(size_t)(l * 3 + 0) * HYC + col], w1 = p.sc_w[(size_t)(l * 3 + 1) * HYC + col], w2 = p.sc_w[(size_t)(l * 3 + 2) * HYC + col], bb = p.sc_b[l * HYC + col];
                const u32x2 mid = *(const u32x2*)pr;
                float e[6];
                e[0] = t0 > 0 ? bf2f(pr[-1]) : 0.f; e[5] = t0 + 4 < L ? bf2f(pr[4]) : 0.f;
                e[1] = __uint_as_float(mid.x << 16); e[2] = __uint_as_float(mid.x & 0xFFFF0000u); e[3] = __uint_as_float(mid.y << 16); e[4] = __uint_as_float(mid.y & 0xFFFF0000u);
#pragma unroll
                for (int j = 0; j < 4; ++j) uv[w][j] = bb + w0 * e[j] + w1 * e[j + 1] + w2 * e[j + 2];
            }
            *(float4*)(zb + b * L + t0) = make_float4(uv[0][0], uv[0][1], uv[0][2], uv[0][3]);
        }
        __syncthreads();
        const float* zr = zb + b * L;
        float a[4];
#define CTX_CONV(kern) do { a[0] = 0.f; a[1] = 0.f; a[2] = 0.f; a[3] = 0.f; \
            float4 khi = *(const float4*)((kern) + t0 + L); \
            _Pragma("unroll 4") for (int m = 0; m < L / 4; ++m) { \
                const float4 klo = *(const float4*)((kern) + t0 + L - 4 * m - 4); const float4 z = *(const float4*)(zr + 4 * m); \
                a[0] += z.x * khi.x; a[1] += z.x * khi.y; a[2] += z.x * khi.z; a[3] += z.x * khi.w; \
                a[0] += z.y * klo.w; a[1] += z.y * khi.x; a[2] += z.y * khi.y; a[3] += z.y * khi.z; \
                a[0] += z.z * klo.z; a[1] += z.z * klo.w; a[2] += z.z * khi.x; a[3] += z.z * khi.y; \
                a[0] += z.w * klo.y; a[1] += z.w * klo.z; a[2] += z.w * klo.w; a[3] += z.w * khi.x; \
                khi = klo; } } while (0)
        float z1[4];
        if (act) {
            CTX_CONV(kern0);
            const float bias0 = p.flt_bias[(l * 2 + 0) * HYW + c];
#pragma unroll
            for (int j = 0; j < 4; ++j) z1[j] = uv[1][j] * (a[j] + bias0 * uv[0][j]);
        }
        __syncthreads();
        if (act) *(float4*)(zb + b * L + t0) = make_float4(z1[0], z1[1], z1[2], z1[3]);
        __syncthreads();
        if (act) {
            CTX_CONV(kern1);
            const float bias1 = p.flt_bias[(l * 2 + 1) * HYW + c];
            bf16_t* o = p.Yhy + ((size_t)(c >> 3) * TT + (size_t)TL + b * CTXL + t0) * 8 + (c & 7);
#pragma unroll
            for (int j = 0; j < 4; ++j) o[j * 8] = f2bf(uv[2][j] * (a[j] + bias1 * z1[j]));
        }
#undef CTX_CONV
    }
    __syncthreads();
}

__device__ __forceinline__ void conv_tile(bf16_t* tile, const float* src, int ld, int c0, int ncols, int K, bf16_t* dst, int kt, int ntile, const float* kscale = nullptr) {
    const int tid = tid_opaque();
    const int k = tid >> 3, n8 = (tid & 7) * 8, nbase = ntile * 64;
    float4 x0 = make_float4(0.f, 0.f, 0.f, 0.f), x1 = x0;
    if (nbase + n8 < ncols) { const float* sp = src + (size_t)(kt * 64 + k) * ld + c0 + nbase + n8; x0 = *(const float4*)sp; x1 = *(const float4*)(sp + 4); }
    if (kscale) { const float ks = kscale[kt * 64 + k]; x0.x *= ks; x0.y *= ks; x0.z *= ks; x0.w *= ks; x1.x *= ks; x1.y *= ks; x1.z *= ks; x1.w *= ks; }
    __syncthreads();
    tile[(n8 + 0) * 72 + k] = f2bf(x0.x); tile[(n8 + 1) * 72 + k] = f2bf(x0.y); tile[(n8 + 2) * 72 + k] = f2bf(x0.z); tile[(n8 + 3) * 72 + k] = f2bf(x0.w);
    tile[(n8 + 4) * 72 + k] = f2bf(x1.x); tile[(n8 + 5) * 72 + k] = f2bf(x1.y); tile[(n8 + 6) * 72 + k] = f2bf(x1.z); tile[(n8 + 7) * 72 + k] = f2bf(x1.w);
    __syncthreads();
    const int n = tid >> 3, k8 = (tid & 7) * 8;
    if (nbase + n < ncols) *(u32x4*)(dst + (size_t)(nbase + n) * K + kt * 64 + k8) = *(const u32x4*)(tile + n * 72 + k8);
}
constexpr int DENSE_TILES = 1720;
__device__ __forceinline__ void ph_conv_dense(const P& p, char* smem) {
    bf16_t* tile = (bf16_t*)smem;
    for (int id = blockIdx.x; id < DEPTH * DENSE_TILES; id += gridDim.x) {
        const int l = id / DENSE_TILES; int r = id % DENSE_TILES;
        const float* win = p.w_in + (size_t)l * DM * INC;
        if (r < 384) conv_tile(tile, win, INC, 0, HYC, DM, p.WtHy + (size_t)l * HYC * DM, r / 24, r % 24);
        else if ((r -= 384) < 64) conv_tile(tile, win, INC, HYC + QL, KVL, DM, p.WtRest + (size_t)l * 2816 * DM, r / 4, r % 4);
        else if ((r -= 64) < 96) conv_tile(tile, win, INC, HYC, QL, DM, p.WtRest + ((size_t)l * 2816 + 256) * DM, r / 6, r % 6);
        else if ((r -= 96) < 16) conv_tile(tile, win, INC, HYC + QL + KVL, QKR, DM, p.WtRest + ((size_t)l * 2816 + 640) * DM, r, 0);
        else if ((r -= 16) < 512) conv_tile(tile, win, INC, MLA_END, 2048, DM, p.WtRest + ((size_t)l * 2816 + 768) * DM, r / 32, r % 32);
        else if ((r -= 512) < 72) conv_tile(tile, p.w_uq + (size_t)l * QL * 768, 768, 0, 768, QL, p.WtUq + (size_t)l * 768 * QL, r / 12, r % 12, p.q_norm_g + l * QL);
        else if ((r -= 72) < 64) conv_tile(tile, p.w_ukv + (size_t)l * KVL * 1024, 1024, 0, 1024, KVL, p.WtUkv + (size_t)l * 1024 * KVL, r / 16, r % 16, p.kv_norm_g + l * KVL);
        else if ((r -= 64) < 128) conv_tile(tile, p.w_hy_o + (size_t)l * HYW * DM, DM, 0, DM, HYW, p.WtHyo + (size_t)l * DM * HYW, r / 16, r % 16);
        else if ((r -= 128) < 128) conv_tile(tile, p.w_mla_o + (size_t)l * 512 * DM, DM, 0, DM, 512, p.WtMlao + (size_t)l * DM * 512, r / 16, r % 16);
        else { r -= 128; conv_tile(tile, p.w_out + (size_t)l * DM * DM, DM, 0, DM, DM, p.WtOut + (size_t)l * DM * DM, r / 16, r % 16); }
    }
    const int nz = DEPTH * 96 * DM / 8;
    for (int i = blockIdx.x * NT + threadIdx.x; i < nz + SEQ * 16; i += gridDim.x * NT) {
        if (i < nz) { const int l = i / (96 * DM / 8), o = i % (96 * DM / 8); *(u32x4*)(p.WtRest + ((size_t)l * 2816 + MLAW) * DM + (size_t)o * 8) = (u32x4){0u, 0u, 0u, 0u}; }
        else { const int k = i - nz, t = k >> 4, a = (k >> 3) & 1, ii = k & 7; const float ang = (float)(a == 0 ? (t >> 6) : (t & 63)) * powf(10000.0f, -(float)ii / 8.0f); p.rope[k] = make_float2(cosf(ang), sinf(ang)); }
    }
}
__device__ __forceinline__ void ph_conv_experts(const P& p, int l, char* smem, int t_begin, int t_end, int worker, int nworkers) {
    bf16_t* tile = (bf16_t*)smem;
    if (worker >= 0)
    for (int id = t_begin + worker; id < t_end; id += nworkers) {
        const int e = id / 192; int r = id % 192;
        const size_t le = (size_t)l * NE + e;
        if (r < 64) conv_tile(tile, p.w_gate + le * DM * DE, DE, 0, DE, DM, p.WtG + (size_t)e * DE * DM, r / 4, r % 4);
        else if (r < 128) { r -= 64; conv_tile(tile, p.w_up + le * DM * DE, DE, 0, DE, DM, p.WtU + (size_t)e * DE * DM, r / 4, r % 4); }
        else { r -= 128; conv_tile(tile, p.w_down + le * DE * DM, DM, 0, DM, DE, p.WtD + (size_t)e * DM * DE, r / 16, r % 16); }
    }
    __syncthreads();
}

constexpr int LDS_TAB = ge::STAGE_BYTES;
static_assert(FFT_LDS_END <= 160 * 1024 - 16, "FFT LDS image");
constexpr int LDS_TOTAL = 160 * 1024;
#define PH_P KArgP kp_ = (KArgP)__builtin_amdgcn_kernarg_segment_ptr(); asm volatile("" : "+s"(kp_)); const P p = make_p(kp_); int G = gridDim.x, c = blockIdx.x; asm volatile("" : "+s"(G), "+s"(c)); (void)G; (void)c;
#define GRID_BAR() do { XcdBarrier b_; b_.bar = (unsigned*)k.ws; b_.x = xb_xcc_id(); b_.st = xbw; xcd_barrier(b_); } while (0)
__global__ __launch_bounds__(NT, 2) void mega(PK k) {
    extern __shared__ __attribute__((aligned(16))) char smem[];
    LAS unsigned char* lds = (LAS unsigned char*)smem;
    volatile LAS unsigned* xbw = (volatile LAS unsigned*)(smem + LDS_TOTAL - 16);
    if (threadIdx.x == 0) { xbw[0] = 0u; xbw[1] = 0u; xbw[2] = 0u; xbw[3] = 0u; }
    __syncthreads();
    (void)xcd_barrier_post((unsigned*)k.ws, xbw);
#define PB(id) do { if (PROBE_ID == (id) && blockIdx.x == PROBE_BLK && threadIdx.x == 0) xbw[2] = (unsigned)wall_clock64(); } while (0)
#define PE(id) do { if (PROBE_ID == (id) && blockIdx.x == PROBE_BLK && threadIdx.x == 0) xbw[3] += (unsigned)wall_clock64() - xbw[2]; } while (0)
    int* offs = (int*)(smem + LDS_TAB); int* tpre = offs + 65; int* cntl = tpre + 65;
    const LAS int* offs_l = (const LAS int*)(lds + LDS_TAB); const LAS int* tpre_l = offs_l + 65; const LAS int* cntl_l = tpre_l + 65;
    PB(0);
    for (int rep = 0; rep < REP_PRO; ++rep) {
    PB(20);
    { PH_P ph_mod_partial(p, smem); ph_filter_a(p, smem); ph_conv_dense(p, smem); ph_tables(p); }
    GRID_BAR();
    PE(20); PB(21);
    { PH_P ph_filter_b2(p, smem); }
    GRID_BAR();
    PE(21); PB(22);
    { PH_P ph_finalize(p); }
    GRID_BAR();
    PE(22); PB(23);
    { PH_P ph_spectra(p, smem); }
    GRID_BAR();
    PE(23);
    }
    PE(0);
    for (int l = 0; l < DEPTH; ++l) {
        const bool last = (l == DEPTH - 1);
        PB(1);
        { PH_P ph_norm1c(p, l, offs); }
        GRID_BAR();
        PE(1); PB(2); PB(40);
#define CHAIN_IDS int cw_ = blockIdx.x; asm volatile("" : "+s"(cw_)); const bool kvc = cw_ < 68, qc = !kvc && cw_ < 136; const int pm = kvc ? cw_ : cw_ - 68; (void)qc; (void)pm;
#define CHAIN_SSQ LAS float* ssq = (LAS float*)(lds + LDS_SSQ); LAS float* rsl = ssq + 256 * 16; (void)rsl;
        { CHAIN_IDS
          if (kvc || qc) { PH_P CHAIN_SSQ
              SchedChainIn S{(const char*)p.U, (const char*)(p.WtRest + (size_t)l * 2816 * DM), pm, kvc ? 0 : 1, kvc ? 1 : 2};
              EpiInprojMLA E{p.PMLAb, p.K, p.rope, ssq};
              ge::gemm_engine<false>(lds, DM, DM, DM, S, E);
          } }
        { CHAIN_IDS
          if (kvc || qc) { CHAIN_SSQ
              asm volatile("s_waitcnt vmcnt(0)" ::: "memory"); __syncthreads(); __builtin_amdgcn_fence(__ATOMIC_ACQUIRE, "agent"); asm volatile("s_waitcnt vmcnt(0)" ::: "memory");
              const int t_ = tid_opaque();
              if (t_ < 256) { float a_ = 0.f; const int ns = kvc ? 8 : 12;
                  for (int q_ = 0; q_ < ns; ++q_) a_ += ssq[t_ * 16 + q_];
                  rsl[t_] = rsqrtf(a_ * (kvc ? 1.0f / KVL : 1.0f / QL) + epsf()); }
              __syncthreads();
          } }
        { CHAIN_IDS
          if (kvc || qc) { PH_P CHAIN_SSQ
              LAS float* rpl = rsl + 256;
              { const int t0 = (pm & 15) * 256;
                if (pm < 64) for (int t_ = tid_opaque(); t_ < 544; t_ += NT) {
                    const float2 e_ = t_ < 32 ? p.rope[(size_t)(t0 + (t_ >> 3) * 64) * 16 + (t_ & 7)] : p.rope[(size_t)(t0 + ((t_ - 32) >> 3)) * 16 + 8 + ((t_ - 32) & 7)];
                    rpl[2 * t_] = e_.x; rpl[2 * t_ + 1] = e_.y; }
                __syncthreads(); }
              SchedPanel S{(const char*)(p.PMLAb + (kvc ? 0 : 256)), kvc ? (const char*)(p.WtUkv + (size_t)l * 1024 * KVL) : (const char*)(p.WtUq + (size_t)l * 768 * QL),
                           (size_t)640 * 2, (size_t)(kvc ? KVL : QL) * 2, pm, kvc ? 4 : 3, kvc ? 1 : 0};
              EpiQKV E{EpiQ{p.Q, p.Qc, rpl, rsl}, EpiKV{p.K, p.V, rsl}};
              ge::gemm_engine<false>(lds, 640, kvc ? KVL : QL, kvc ? KVL : QL, S, E);
          } }
        { CHAIN_IDS PH_P
            SchedPool S{(const char*)(p.WtHy + (size_t)l * HYC * DM), (const char*)(p.WtRest + (size_t)l * 2816 * DM), (const char*)p.U,
                        kvc ? 680 + 3 * cw_ : (qc ? 884 + (cw_ - 68) : cw_ - 136), (kvc || qc) ? 1 : G - 136, kvc ? 3 : (qc ? 1 : (680 - (cw_ - 136) + (G - 136) - 1) / (G - 136))};
            EpiInproj E{p.PT, p.PTc, p.G};
            ge::gemm_engine<false>(lds, DM, DM, DM, S, E);
        }
#undef CHAIN_IDS
#undef CHAIN_SSQ
        PE(40);
        GRID_BAR();
        PE(2);
        PE(4); PB(5);
        for (int rep = 0; rep < REP_MIX; ++rep) {
        PB(31);
        { PH_P ph_attn2(p, smem, !last); }
        PE(31); PB(32);
        { PH_P ph_hyena_fft(p, l, smem); }
        PE(32); PB(33);
        if (!last) { PH_P ph_hyena_ctx(p, l, smem); }
        PE(33); }
        GRID_BAR();
        PE(5); PB(6); PB(41);
        for (int rep = 0; rep < REP_DENSE; ++rep) { PH_P
            SchedMerge S{(const char*)p.Yhy, (const char*)p.Yatt, (const char*)(p.WtHyo + (size_t)l * DM * HYW), (const char*)(p.WtMlao + (size_t)l * DM * 512), G, c, last ? 64 : 68};
            EpiMerge E{p.G, p.M1};
            ge::gemm_engine<false, TT>(lds, 512, 512, 512, S, E);
        }
        { PH_P ph_conv_experts(p, l, smem, 0, NE * 96, c - 16, G - 16); }
        PE(41);
        GRID_BAR();
        PE(6); PB(7); PB(42);
        { PH_P
            SchedDense S{(const char*)p.M1, (const char*)(p.WtOut + (size_t)l * DM * DM), (size_t)DM * 2, (size_t)DM * 2, last ? 64 : 68, 4, G, c};
            EpiOut E{(bf16_t*)p.hx, p.mod + (size_t)l * 5 * NMOD};
            ge::gemm_engine<false>(lds, DM, DM, DM, S, E);
        }
        { PH_P ph_conv_experts(p, l, smem, NE * 96, NE * 192, c - 16, G - 16); }
        PE(42);
        GRID_BAR();
        PE(7); PB(8);
        { PH_P ph_norm2_router(p, l, smem, last ? TL : TT); }
        GRID_BAR();
        PE(8); PB(9);
        for (int rep = 0; rep < REP_MOE; ++rep) { PH_P
            if (threadIdx.x < NE) cntl[threadIdx.x] = p.cnt[(l * NE + threadIdx.x) * 64];
            __syncthreads();
            if (threadIdx.x == 0) { int a = 0, t = 0; for (int e = 0; e < NE; ++e) { const int n = cntl[e]; offs[e] = a; tpre[e] = t; a += n; t += (n + 255) >> 8; } offs[64] = a; tpre[64] = t; }
            __syncthreads();
            SchedGU S{(const char*)p.U, (const char*)p.WtG, (const char*)p.WtU, p.list, tpre_l, cntl_l, G, c};
            EpiGU E{p.Hb, offs_l};
            ge::gemm_engine<true>(lds, DM, DM, DM, S, E);
        }
        GRID_BAR();
        PE(9); PB(10);
        for (int rep = 0; rep < REP_MOE; ++rep) { PH_P
            SchedDown S{(const char*)p.Hb, (const char*)p.WtD, tpre_l, cntl_l, offs_l, G, c};
            EpiDown E{p.Y, p.wl, offs_l};
            ge::gemm_engine<false>(lds, DE, DE, DE, S, E);
        }
        GRID_BAR();
        PE(10);
        if (PROBE_ID == 12) { PB(12); GRID_BAR(); PE(12); }
    }
    PB(11);
    { PH_P ph_final_c(p, offs); }
    PE(11);
    if (PROBE_ID >= 0 && blockIdx.x == PROBE_BLK && threadIdx.x == 0) { const unsigned long long t0 = wall_clock64(), wait = (unsigned long long)xbw[3] * PROBE_K; while (wall_clock64() - t0 < wait) __builtin_amdgcn_s_sleep(8); }
}

extern "C" void kernel_launch(void* const* d_in, const int* in_sizes, int n_in, void* d_out, int out_size, void* d_ws, size_t ws_size, hipStream_t stream) {
    (void)in_sizes; (void)out_size;
    if (n_in < 33 || WSO.total > ws_size) { fprintf(stderr, "kernel_launch: need 33 inputs and %zu bytes of workspace; got %d, %zu\n", (size_t)WSO.total, n_in, ws_size); return; }
    PK k{};
    for (int i = 0; i < 33; ++i) k.in[i] = (const float*)d_in[i];
    k.out = (float*)d_out; k.ws = (char*)d_ws;
    (void)hipMemsetAsync(d_ws, 0, WS_ZERO_BYTES, stream);
    static int grid = 0;
    if (!grid) {
        int dev = 0, cus = 0, per_cu = 0;
        (void)hipGetDevice(&dev);
        (void)hipDeviceGetAttribute(&cus, hipDeviceAttributeMultiprocessorCount, dev);
        (void)hipFuncSetAttribute((const void*)mega, hipFuncAttributeMaxDynamicSharedMemorySize, LDS_TOTAL);
        (void)hipOccupancyMaxActiveBlocksPerMultiprocessor(&per_cu, (const void*)mega, NT, LDS_TOTAL);
        if (per_cu < 1) fprintf(stderr, "kernel_launch: occupancy query reports %d blocks per CU\n", per_cu);
        grid = cus > 0 ? cus : 256;
    }
    hipLaunchKernelGGL(mega, dim3(grid), dim3(NT), LDS_TOTAL, stream, k);
}
```

```cpp
#include <hip/hip_runtime.h>
#include <stdint.h>
#include <stdio.h>

typedef unsigned short bf16_t;
typedef short bf16x8 __attribute__((ext_vector_type(8)));
typedef float f32x4 __attribute__((ext_vector_type(4)));
typedef unsigned u32x4 __attribute__((ext_vector_type(4)));
typedef unsigned u32x2 __attribute__((ext_vector_type(2)));

#define NT 512
#ifndef PROBE_BLK
#define PROBE_BLK 0
#endif
#ifndef PROBE_ID
#define PROBE_ID (-1)
#endif
#define PROBE_K 8
#ifndef REP_PRO
#define REP_PRO 1
#endif
#ifndef REP_DENSE
#define REP_DENSE 1
#endif
#ifndef REP_MOE
#define REP_MOE 1
#endif
#ifndef REP_MIX
#define REP_MIX 1
#endif
#ifndef REP_MISC
#define REP_MISC 1
#endif
constexpr int DM = 1024, NB = 4, SEQ = 4096, DEPTH = 4, CTXL = 256;
constexpr int TL = NB * SEQ, TC = NB * CTXL, TT = TL + TC;
constexpr int HYW = 512, HYC = 1536, QL = 384, KVL = 256, QKR = 32;
constexpr int MLAW = QL + KVL + QKR, MLA_END = HYC + MLAW, INC = MLA_END + 2 * DM;
constexpr int NH = 8, DQK = 96, DV = 64, NKEY = SEQ + CTXL;
constexpr int NE = 64, DE = 256, CAP = TT;
constexpr int NMOD = 6 * DM;
constexpr float EPSF = 1e-6f;
constexpr float QSCALE = 0.10206207261596577f * 1.4426950408889634f;

__device__ __forceinline__ bf16_t f2bf(float f) { unsigned u = __float_as_uint(f); u += 0x7FFFu + ((u >> 16) & 1u); return (bf16_t)(u >> 16); }
__device__ __forceinline__ float bf2f(bf16_t b) { return __uint_as_float(((unsigned)b) << 16); }
__device__ __forceinline__ unsigned pack2(float lo, float hi) { return (unsigned)f2bf(lo) | ((unsigned)f2bf(hi) << 16); }
__device__ __forceinline__ float epsf() { float e = EPSF; asm volatile("" : "+v"(e)); return e; }
__device__ __forceinline__ int tid_opaque() { int t = threadIdx.x; asm volatile("" : "+v"(t)); return t; }
__device__ __forceinline__ int shx_i(int v, int mask) {
    switch (mask) {
        case 1: return __builtin_amdgcn_ds_swizzle(v, (1 << 10) | 0x1F);
        case 2: return __builtin_amdgcn_ds_swizzle(v, (2 << 10) | 0x1F);
        case 4: return __builtin_amdgcn_ds_swizzle(v, (4 << 10) | 0x1F);
        case 8: return __builtin_amdgcn_ds_swizzle(v, (8 << 10) | 0x1F);
        case 16: return __builtin_amdgcn_ds_swizzle(v, (16 << 10) | 0x1F);
        default: {
            typedef unsigned u32x2s_t __attribute__((ext_vector_type(2)));
            const u32x2s_t r = __builtin_amdgcn_permlane32_swap((unsigned)v, (unsigned)v, false, false);
            return (int)(((threadIdx.x & 32u) == 0u) ? r.y : r.x); }
    }
}
__device__ __forceinline__ float shx(float v, int mask) { return __int_as_float(shx_i(__float_as_int(v), mask)); }
__device__ __forceinline__ int shx(int v, int mask) { return shx_i(v, mask); }
typedef unsigned u32x2_t __attribute__((ext_vector_type(2)));
__device__ __forceinline__ float rowmax4(float v) {
    u32x2_t r = __builtin_amdgcn_permlane16_swap(__float_as_uint(v), __float_as_uint(v), false, false);
    v = fmaxf(__uint_as_float(r.x), __uint_as_float(r.y));
    r = __builtin_amdgcn_permlane32_swap(__float_as_uint(v), __float_as_uint(v), false, false);
    return fmaxf(__uint_as_float(r.x), __uint_as_float(r.y));
}
__device__ __forceinline__ float rowsum4(float v) {
    u32x2_t r = __builtin_amdgcn_permlane16_swap(__float_as_uint(v), __float_as_uint(v), false, false);
    v = __uint_as_float(r.x) + __uint_as_float(r.y);
    r = __builtin_amdgcn_permlane32_swap(__float_as_uint(v), __float_as_uint(v), false, false);
    return __uint_as_float(r.x) + __uint_as_float(r.y);
}
__device__ __forceinline__ float wave_sum(float v) {
#pragma unroll
    for (int o = 32; o > 0; o >>= 1) v += shx(v, o);
    return v;
}


#define XB_TMO      128
#define XB_XCNT(j)  (256  + 64 * (j))
#define XB_XSUB(j)  (1280 + 64 * (j))
#define XB_XGEN(j)  (2304 + 64 * (j))
#define XB_TOP      3328
#define XB_TOPGEN   3392
#define XCD_BAR_WORDS 3456
#define XB_SPIN_CAP (1u << 22)
#define LAS __attribute__((address_space(3)))
__device__ __forceinline__ unsigned xb_ld(unsigned* p)              { return __hip_atomic_load(p, __ATOMIC_RELAXED, __HIP_MEMORY_SCOPE_AGENT); }
__device__ __forceinline__ unsigned xb_add(unsigned* p, unsigned v) { return __hip_atomic_fetch_add(p, v, __ATOMIC_RELAXED, __HIP_MEMORY_SCOPE_AGENT); }
__device__ __forceinline__ unsigned xb_xcc_id() { return (unsigned)__builtin_amdgcn_s_getreg((3 << 11) | 20) & 0xFu; }
#define XB_SPIN(cond, bar) do { unsigned _sp = 0; while (cond) { __builtin_amdgcn_s_sleep(1); \
    if ((++_sp & 255u) == 0u) { if (xb_ld(&(bar)[XB_TMO])) break; if (_sp > XB_SPIN_CAP) { atomicAdd(&(bar)[XB_TMO], 1u); break; } } } } while (0)
struct XcdBarrier { unsigned* bar; unsigned x; volatile LAS unsigned* st; };
__device__ __forceinline__ XcdBarrier xcd_barrier_post(unsigned* bar, volatile LAS unsigned* st) {
    XcdBarrier b; b.bar = bar; b.x = xb_xcc_id(); b.st = st;
    if (threadIdx.x == 0) (void)xb_add(&bar[XB_XCNT(b.x)], 1u);
    return b;
}
__device__ __forceinline__ void xcd_barrier_complete(unsigned* bar, unsigned x, unsigned& nloc, unsigned& nx) {
    const unsigned G = gridDim.x * gridDim.y * gridDim.z;
    unsigned sum, cnt, mine, sp = 0u;
    for (;;) {
        sum = 0u; cnt = 0u; mine = 0u;
#pragma unroll
        for (unsigned j = 0; j < 16; ++j) { const unsigned c = xb_ld(&bar[XB_XCNT(j)]); sum += c; cnt += (c > 0u) ? 1u : 0u; mine = (j == x) ? c : mine; }
        if (sum == G) break;
        __builtin_amdgcn_s_sleep(1);
        if ((++sp & 255u) == 0u) { if (xb_ld(&bar[XB_TMO])) break; if (sp > XB_SPIN_CAP) { atomicAdd(&bar[XB_TMO], 1u); break; } }
    }
    nloc = mine > 0u ? mine : 1u; nx = cnt > 0u ? cnt : 1u;
}
__device__ __forceinline__ void xcd_barrier(const XcdBarrier& b) {
    asm volatile("s_waitcnt vmcnt(0)" ::: "memory");
    __syncthreads();
    if (threadIdx.x == 0) {
        unsigned* bar = b.bar;
        __builtin_amdgcn_s_waitcnt(0);
        unsigned nloc = b.st[0], nx = b.st[1];
        if (nloc == 0u) { xcd_barrier_complete(bar, b.x, nloc, nx); b.st[0] = nloc; b.st[1] = nx; }
        const unsigned old = xb_add(&bar[XB_XSUB(b.x)], 1u);
        const unsigned gen = old / nloc;
        if (old + 1u == (gen + 1u) * nloc) {
            __builtin_amdgcn_fence(__ATOMIC_RELEASE, "agent");
            asm volatile("s_waitcnt vmcnt(0)" ::: "memory");
            const unsigned og = xb_add(&bar[XB_TOP], 1u);
            const unsigned tg = og / nx;
            if (og + 1u == (tg + 1u) * nx) xb_add(&bar[XB_TOPGEN], 1u);
            else XB_SPIN(xb_ld(&bar[XB_TOPGEN]) == tg, bar);
            __builtin_amdgcn_fence(__ATOMIC_ACQUIRE, "agent");
            xb_add(&bar[XB_XGEN(b.x)], 1u);
            asm volatile("s_waitcnt vmcnt(0)" ::: "memory");
        } else {
            XB_SPIN(xb_ld(&bar[XB_XGEN(b.x)]) == gen, bar);
            __builtin_amdgcn_fence(__ATOMIC_ACQUIRE, "agent");
            asm volatile("s_waitcnt vmcnt(0)" ::: "memory");
        }
    }
    __syncthreads();
}

#define WS_LIST(X) \
    X(unsigned, bar, XCD_BAR_WORDS * 4)                         \
    X(int, cnt, DEPTH * 64 * 256)                               \
    X(float, modp, (size_t)DEPTH * 32 * 5 * NMOD * 4)           \
    X(float, mod, (size_t)DEPTH * 5 * NMOD * 4)                 \
    X(float, H2a, (size_t)DEPTH * SEQ * 64 * 4) \
    X(float, H2b, (size_t)DEPTH * CTXL * 64 * 4) \
    X(float, HT1, (size_t)DEPTH * 2048 * CTXL * 4) \
    X(float, SSQ0, (size_t)DEPTH * 2048 * 128 * 4) \
    X(float, SSQ1, (size_t)DEPTH * 2048 * 8 * 4) \
    X(float, SCL0, (size_t)DEPTH * 2048 * 4) \
    X(float, SCL1, (size_t)DEPTH * 2048 * 4) \
    X(float, hx, (size_t)TT * DM * 4)                           \
    X(bf16_t, U, (size_t)TT * DM * 2)                           \
    X(bf16_t, PT, (size_t)NB * HYC * SEQ * 2)                   \
    X(bf16_t, PTc, (size_t)NB * HYC * CTXL * 2) \
    X(bf16_t, PMLAb, (size_t)TT * 640 * 2)                      \
    X(bf16_t, G, (size_t)TT * 2048 * 2)                         \
    X(bf16_t, Q, (size_t)NB * NH * SEQ * 128 * 2)               \
    X(bf16_t, Qc, (size_t)NB * NH * CTXL * 128 * 2) \
    X(bf16_t, K, (size_t)NB * NH * NKEY * DQK * 2)              \
    X(bf16_t, V, (size_t)NB * NH * NKEY * DV * 2)               \
    X(bf16_t, Yatt, (size_t)TT * 512 * 2) \
    X(bf16_t, Yhy, (size_t)TT * 512 * 2) \
    X(bf16_t, M1, (size_t)TT * DM * 2) \
    X(int, list, (size_t)NE * CAP * 4) \
    X(float, wl, (size_t)NE * CAP * 4) \
    X(int, asg, (size_t)TT * 4 * 4) \
    X(bf16_t, Hb, (size_t)(2 * TT + 256) * DE * 2) \
    X(bf16_t, Y, (size_t)2 * TT * DM * 2) \
    X(bf16_t, WtHy, (size_t)DEPTH * HYC * DM * 2)               \
    X(bf16_t, WtRest, (size_t)DEPTH * 2816 * DM * 2) \
    X(bf16_t, WtUq, (size_t)DEPTH * 768 * QL * 2) \
    X(bf16_t, WtUkv, (size_t)DEPTH * 1024 * KVL * 2) \
    X(bf16_t, WtHyo, (size_t)DEPTH * DM * HYW * 2) \
    X(bf16_t, WtMlao, (size_t)DEPTH * DM * 512 * 2) \
    X(bf16_t, WtOut, (size_t)DEPTH * DM * DM * 2) \
    X(bf16_t, WtG, (size_t)NE * DE * DM * 2)                    \
    X(bf16_t, WtU, (size_t)NE * DE * DM * 2) \
    X(bf16_t, WtD, (size_t)NE * DM * DE * 2) \
    X(float2, rope, (size_t)SEQ * 16 * 8)                       \
    X(float2, Hs, (size_t)DEPTH * HYW * 4 * 4096 * 8)           \
    X(float2, Wtab, 4096 * 8) \
    X(bf16_t, WrT, (size_t)DEPTH * 2 * 80 * DM * 2)             \
    X(float2, W2tab, 4096 * 8)
struct WsOff {
#define X(t, n, b) size_t n;
    WS_LIST(X)
#undef X
    size_t total;
};
constexpr WsOff ws_layout() {
    WsOff o{}; size_t a = 0;
#define X(t, n, b) o.n = a; a += (((size_t)(b)) + 255) & ~(size_t)255;
    WS_LIST(X)
#undef X
    o.total = a; return o;
}
constexpr WsOff WSO = ws_layout();
constexpr size_t WS_ZERO_BYTES = WSO.modp;
static_assert(WSO.Yatt - WSO.G >= (size_t)DEPTH * 2048 * SEQ * 4, "HT0 alias region too small");

struct PK { const float* in[33]; float* out; char* ws; };
struct P {
    const float *x, *c, *ctx, *c_ctx, *w_ada, *b_ada, *norm1_g, *w_in, *q_norm_g, *kv_norm_g, *w_uq, *w_ukv, *sc_w, *sc_b;
    const float *flt_w1, *flt_b1, *flt_freq, *flt_w2, *flt_b2, *flt_w3, *flt_bias, *w_hy_o, *w_mla_o, *w_out, *norm2_g;
    const float *w_rg, *b_rg, *w_re, *b_re, *w_gate, *w_up, *w_down, *final_g;
    float* out;
#define X(t, n, b) t* n;
    WS_LIST(X)
#undef X
    float* HT0;
};
typedef const __attribute__((address_space(4))) PK* KArgP;
__device__ __forceinline__ P make_p(KArgP kp) {
    P p; const KArgP& kk = kp; char* ws = kk->ws;
    p.x = kk->in[0]; p.c = kk->in[1]; p.ctx = kk->in[2]; p.c_ctx = kk->in[3]; p.w_ada = kk->in[4]; p.b_ada = kk->in[5]; p.norm1_g = kk->in[6]; p.w_in = kk->in[7];
    p.q_norm_g = kk->in[8]; p.kv_norm_g = kk->in[9]; p.w_uq = kk->in[10]; p.w_ukv = kk->in[11]; p.sc_w = kk->in[12]; p.sc_b = kk->in[13];
    p.flt_w1 = kk->in[14]; p.flt_b1 = kk->in[15]; p.flt_freq = kk->in[16]; p.flt_w2 = kk->in[17]; p.flt_b2 = kk->in[18]; p.flt_w3 = kk->in[19]; p.flt_bias = kk->in[20];
    p.w_hy_o = kk->in[21]; p.w_mla_o = kk->in[22]; p.w_out = kk->in[23]; p.norm2_g = kk->in[24]; p.w_rg = kk->in[25]; p.b_rg = kk->in[26]; p.w_re = kk->in[27]; p.b_re = kk->in[28];
    p.w_gate = kk->in[29]; p.w_up = kk->in[30]; p.w_down = kk->in[31]; p.final_g = kk->in[32];
    p.out = kk->out;
#define X(t, n, b) p.n = (t*)(ws + WSO.n);
    WS_LIST(X)
#undef X
    p.HT0 = (float*)(ws + WSO.G);
    return p;
}

constexpr int MODK = 32;
__device__ __forceinline__ void ph_mod_partial(const P& p, char* smem) {
    float* s = (float*)smem;
    const int tid = tid_opaque();
    for (int it = blockIdx.x; it < DEPTH * MODK * 3; it += gridDim.x) {
        const int l = it / (MODK * 3), kc = (it / 3) % MODK, jb = it % 3;
        __syncthreads();
        if (tid < 5 * 32) {
            const int r = tid / 32, kk = tid % 32, k = kc * 32 + kk;
            const float cv = (r < 4) ? p.c[r * DM + k] : p.c_ctx[k];
            s[tid] = cv / (1.0f + expf(-cv));
        }
        __syncthreads();
        const int j = jb * 2048 + tid * 4;
        f32x4 a0 = {0.f, 0.f, 0.f, 0.f}, a1 = a0, a2 = a0, a3 = a0, a4 = a0;
        const float* w = p.w_ada + ((size_t)l * DM + kc * 32) * NMOD + j;
#pragma unroll 8
        for (int kk = 0; kk < 32; ++kk) {
            const f32x4 wv = *(const f32x4*)(w + (size_t)kk * NMOD);
            a0 += wv * s[kk]; a1 += wv * s[32 + kk]; a2 += wv * s[64 + kk]; a3 += wv * s[96 + kk]; a4 += wv * s[128 + kk];
        }
        float* o = p.modp + ((size_t)(l * MODK + kc) * 5) * NMOD + j;
        *(f32x4*)o = a0; *(f32x4*)(o + NMOD) = a1; *(f32x4*)(o + 2 * NMOD) = a2; *(f32x4*)(o + 3 * NMOD) = a3; *(f32x4*)(o + 4 * NMOD) = a4;
    }
}

__device__ __forceinline__ void ph_filter_a(const P& p, char* smem) {
    float* zs = (float*)smem;
    float* h1s = zs + 8 * 36;
    const int tid = tid_opaque(), tt = tid >> 6, j = tid & 63;
    const int n0 = DEPTH * 512, n1 = DEPTH * 32;
    for (int it = blockIdx.x; it < n0 + n1; it += gridDim.x) {
        int l, ls, tg;
        if (it < n0) { ls = 0; l = it / 512; tg = it % 512; } else { ls = 1; l = (it - n0) / 32; tg = (it - n0) % 32; }
        const int L = ls ? CTXL : SEQ;
        const int t = tg * 8 + tt;
        __syncthreads();
        if (j < 33) {
            float f;
            if (j == 0) f = (float)t / (float)(L - 1);
            else {
                const int k = (j - 1) & 15;
                const float band = 1e-4f + (float)k * ((15.0f - 1e-4f) / 15.0f);
                const float w = 6.283185307179586f * (float)t / (float)L;
                const double ang = (double)band * (double)w;
                f = (j <= 16) ? (float)cos(ang) : (float)(-sin(ang));
            }
            zs[tt * 36 + j] = f;
        }
        __syncthreads();
        const float fr = p.flt_freq[l * 64 + j];
        float a = p.flt_b1[l * 64 + j];
        for (int i = 0; i < 33; ++i) a += zs[tt * 36 + i] * p.flt_w1[((size_t)l * 33 + i) * 64 + j];
        h1s[tt * 64 + j] = sinf(fr * a);
        __syncthreads();
        float a2 = p.flt_b2[l * 64 + j];
        for (int i = 0; i < 64; ++i) a2 += h1s[tt * 64 + i] * p.flt_w2[((size_t)l * 64 + i) * 64 + j];
        const float h2 = sinf(fr * a2);
        if (ls == 0) p.H2a[((size_t)l * SEQ + t) * 64 + j] = h2; else p.H2b[((size_t)l * CTXL + t) * 64 + j] = h2;
    }
}

typedef float f32x16 __attribute__((ext_vector_type(16)));
__device__ __forceinline__ void ph_filter_b2(const P& p, char* smem) {
    float* sA = (float*)smem;
    const int tid = tid_opaque(), lane = tid & 63, wv = tid >> 6, li = lane & 31, hf = lane >> 5;
    const int n0 = DEPTH * 128 * 8, n1 = DEPTH * 8 * 8;
    const float DA = -15.350567286626973f, DB = -3.0701134573253946f;
    for (int it = blockIdx.x; it < n0 + n1; it += gridDim.x) {
        int l, ls, tt, cg;
        if (it < n0) { ls = 0; l = it / 1024; tt = (it / 8) % 128; cg = it % 8; } else { const int i2 = it - n0; ls = 1; l = i2 / 64; tt = (i2 / 8) % 8; cg = i2 % 8; }
        const int L = ls ? CTXL : SEQ, t0 = tt * 32;
        const float* h2 = ls ? p.H2b + ((size_t)l * CTXL + t0) * 64 : p.H2a + ((size_t)l * SEQ + t0) * 64;
        const int col = cg * 256 + wv * 32 + li;
        const float* wp = p.flt_w3 + (size_t)l * 64 * 2048 + col;
        float wv_[32];
#pragma unroll
        for (int s2 = 0; s2 < 32; ++s2) wv_[s2] = wp[(size_t)(2 * s2 + hf) * 2048];
        { const int r = tid >> 4, k4 = (tid & 15) * 4; const float4 v = *(const float4*)(h2 + r * 64 + k4);
          __syncthreads();
          float* d = sA + r * 65 + k4; d[0] = v.x; d[1] = v.y; d[2] = v.z; d[3] = v.w; }
        __syncthreads();
        f32x16 acc;
#pragma unroll
        for (int i = 0; i < 16; ++i) acc[i] = 0.f;
#pragma unroll
        for (int s2 = 0; s2 < 32; ++s2) {
            const int k = 2 * s2 + hf;
            acc = __builtin_amdgcn_mfma_f32_32x32x2f32(sA[li * 65 + k], wv_[s2], acc, 0, 0, 0);
        }
        const int ch = col & 511;
        const float delta = fabsf(DA + (float)ch * ((DB - DA) / 511.0f));
        float q = 0.f;
        float* dst = (ls ? p.HT1 + ((size_t)l * 2048 + col) * CTXL : p.HT0 + ((size_t)l * 2048 + col) * SEQ) + t0 + 4 * hf;
#pragma unroll
        for (int g4 = 0; g4 < 4; ++g4) {
            float4 o;
            float* op = &o.x;
#pragma unroll
            for (int e = 0; e < 4; ++e) { const int t = t0 + 8 * g4 + 4 * hf + e; const float v = acc[4 * g4 + e] * expf(-((float)t / (float)(L - 1)) * delta); op[e] = v; q += v * v; }
            *(float4*)(dst + 8 * g4) = o;
        }
        q += shx(q, 32);
        if (hf == 0) { if (ls == 0) p.SSQ0[((size_t)l * 2048 + col) * 128 + tt] = q; else p.SSQ1[((size_t)l * 2048 + col) * 8 + tt] = q; }
    }
    __syncthreads();
}

__device__ __forceinline__ void ph_finalize(const P& p) {
    const int n_mod = DEPTH * 5 * NMOD, n_s = DEPTH * 2048;
    for (int i = blockIdx.x * NT + threadIdx.x; i < n_mod + 2 * n_s; i += gridDim.x * NT) {
        if (i < n_mod) {
            const int l = i / (5 * NMOD), r = (i / NMOD) % 5, j = i % NMOD;
            float a = p.b_ada[l * NMOD + j];
            for (int kc = 0; kc < MODK; ++kc) a += p.modp[((size_t)(l * MODK + kc) * 5 + r) * NMOD + j];
            p.mod[i] = a;
        } else if (i < n_mod + n_s) {
            const int k = i - n_mod; float a = 0.f;
            for (int q = 0; q < 128; ++q) a += p.SSQ0[(size_t)k * 128 + q];
            p.SCL0[k] = rsqrtf(a + epsf());
        } else {
            const int k = i - n_mod - n_s; float a = 0.f;
            for (int q = 0; q < 8; ++q) a += p.SSQ1[(size_t)k * 8 + q];
            p.SCL1[k] = rsqrtf(a + epsf());
        }
    }
}

__device__ __forceinline__ float rope_apply(float self, float partner, int d, int t) {
    const int a = d >> 4, s = (d >> 3) & 1, i = d & 7;
    const float pos = (float)(a == 0 ? (t >> 6) : (t & 63));
    const float inv = powf(10000.0f, -(float)i / 8.0f);
    const float ang = pos * inv;
    const float cs = cosf(ang), sn = sinf(ang);
    return s == 0 ? self * cs - partner * sn : partner * sn + self * cs;
}

namespace ge {
constexpr int BM = 256, BK = 64, HALF = 128, HTB = HALF * BK * 2, STAGE_BYTES = 8 * HTB, NXCD = 8, WGM = 8;
__device__ __forceinline__ int lds_byte(int r, int c) { const int st = (r >> 4) * 2 + (c >> 5), rr = r & 15, cc = c & 31, ob = rr * 64 + cc * 2; return st * 1024 + (ob ^ (((ob >> 9) & 1) << 5)); }
__device__ __forceinline__ void stage_rc(int b, int& R, int& C) { const int st = b / 1024, sb = b % 1024, swz = sb ^ (((sb >> 9) & 1) << 5); R = (st >> 1) * 16 + swz / 64; C = (st & 1) * 32 + (swz % 64) / 2; }
__device__ __forceinline__ int perm32(int rho) { const int n = rho >> 4, i = rho & 15; return 8 * (i >> 2) + 4 * n + (i & 3); }
__device__ __forceinline__ void tile_order(int L, int nM, int nN, int& pm, int& pn) {
    const int nwg = nM * nN; int wgid = L;
    { const int q = nwg / NXCD, r = nwg % NXCD, xcd = wgid % NXCD, off = wgid / NXCD; wgid = (xcd < r ? xcd * (q + 1) : r * (q + 1) + (xcd - r) * q) + off; }
    const int nig = WGM * nN, gid = wgid / nig, fm = gid * WGM, gsz = (nM - fm) < WGM ? (nM - fm) : WGM;
    pm = fm + ((wgid % nig) % gsz); pn = (wgid % nig) / gsz;
}
struct Unit { const char* a; const char* b0; const char* b1; const int* rows; int nrows; int pm, pn, kind; };
typedef f32x4 Acc[2][2][4][2];

template <bool GATHER, int ABLK = 0, class Sched, class Epi>
__device__ __forceinline__ void gemm_engine(LAS unsigned char* lds, const int lda, const int ldb, const int K, const Sched& S, const Epi& E) {
    const int tid = tid_opaque(), wid = __builtin_amdgcn_readfirstlane(tid >> 6), lane = tid & 63, wr = wid >> 2, wc = wid & 3, fr = lane & 15, fq = lane >> 4;
    const int nt = K / BK;
    int sR[2], sC[2];
    unsigned voffA[2], voffB[2];
#pragma unroll
    for (int i = 0; i < 2; ++i) { stage_rc(tid * 16 + i * 8192, sR[i], sC[i]); const int Rb = (sR[i] & ~31) + perm32(sR[i] & 31);
        voffA[i] = ABLK ? (unsigned)((sC[i] >> 3) * ABLK + sR[i]) * 16u : (unsigned)(sR[i] * lda + sC[i]) * 2u; voffB[i] = (unsigned)(Rb * ldb + sC[i]) * 2u; }
    const size_t kstep = (size_t)(BK * 2);
    const size_t hstepA = ABLK ? (size_t)HALF * 16 : (size_t)HALF * lda * 2;
    const size_t kstepA = ABLK ? (size_t)(BK / 8) * ABLK * 16 : kstep;
    const unsigned ldsw = (unsigned)wid * 1024u;
    const int aoff = lds_byte(wr * 64 + fr, fq * 8), boff = lds_byte(wc * 32 + fr, fq * 8);
    unsigned gvc[2][2], gvn[2][2];
#define GE_SA(b, h) (((b) * 2 + (h)) * HTB)
#define GE_SB(b, h) ((4 + (b) * 2 + (h)) * HTB)
#define GE_GLDS(src, bufoff, i) __builtin_amdgcn_global_load_lds((const unsigned*)(src), (LAS unsigned*)(lds + (bufoff) + ldsw + (i) * 8192), 16, 0, 0)
#define GE_STAGE_B(bufoff, bp) do { _Pragma("unroll") for (int _i = 0; _i < 2; ++_i) GE_GLDS((bp) + voffB[_i], bufoff, _i); } while (0)
#define GE_STAGE_A(bufoff, ap, h, gv) do { _Pragma("unroll") for (int _i = 0; _i < 2; ++_i) { \
        if constexpr (GATHER) GE_GLDS((ap) + (gv)[h][_i], bufoff, _i); else GE_GLDS((ap) + (size_t)(h) * hstepA + voffA[_i], bufoff, _i); } } while (0)
#define GE_STAGE_A2(bufoff, ap, h) do { _Pragma("unroll") for (int _i = 0; _i < 2; ++_i) { \
        if constexpr (GATHER) GE_GLDS((ap) + (last ? gvn[h][_i] : gvc[h][_i]), bufoff, _i); else GE_GLDS((ap) + (size_t)(h) * hstepA + voffA[_i], bufoff, _i); } } while (0)
#define GE_LDA(dst, b, h) do { _Pragma("unroll") for (int m = 0; m < 4; ++m) _Pragma("unroll") for (int k = 0; k < 2; ++k) dst[m][k] = *(const LAS bf16x8*)(lds + GE_SA(b, h) + aoff + m * 2048 + k * 1024); } while (0)
#define GE_LDB(dst, b, h) do { _Pragma("unroll") for (int n = 0; n < 2; ++n) _Pragma("unroll") for (int k = 0; k < 2; ++k) dst[n][k] = *(const LAS bf16x8*)(lds + GE_SB(b, h) + boff + n * 2048 + k * 1024); } while (0)
#define GE_MMA(ai, bj, At, Bt) do { __builtin_amdgcn_s_setprio(1); _Pragma("unroll") for (int m = 0; m < 4; ++m) _Pragma("unroll") for (int n = 0; n < 2; ++n) _Pragma("unroll") for (int k = 0; k < 2; ++k) \
        acc[ai][bj][m][n] = __builtin_amdgcn_mfma_f32_16x16x32_bf16(Bt[n][k], At[m][k], acc[ai][bj][m][n], 0, 0, 0); __builtin_amdgcn_s_setprio(0); } while (0)
#define GE_WAIT_V(n) asm volatile("s_waitcnt vmcnt(" #n ")" ::: "memory")
#define GE_WAIT_L(n) asm volatile("s_waitcnt lgkmcnt(" #n ")" ::: "memory")
#define GE_BAR __builtin_amdgcn_s_barrier()
#define GE_SCHED __builtin_amdgcn_sched_barrier(0)
#define GE_GATHER_OFFS(gv, u) do { if constexpr (GATHER) { _Pragma("unroll") for (int _h = 0; _h < 2; ++_h) _Pragma("unroll") for (int _i = 0; _i < 2; ++_i) { \
        int _r = (u).pm * BM + _h * HALF + sR[_i]; _r = _r < (u).nrows ? _r : (u).nrows - 1; (gv)[_h][_i] = (unsigned)((u).rows[_r] * lda + sC[_i]) * 2u; } } } while (0)
    Unit cur, nxt; int ui = 0;
    if (!S.next(0, cur)) return;
    Acc acc;
#pragma unroll
    for (int a = 0; a < 2; ++a)
#pragma unroll
        for (int b = 0; b < 2; ++b)
#pragma unroll
            for (int m = 0; m < 4; ++m)
#pragma unroll
                for (int n = 0; n < 2; ++n) acc[a][b][m][n] = (f32x4){0.f, 0.f, 0.f, 0.f};
    bf16x8 At[4][2], B0[2][2], B1[2][2];
    GE_GATHER_OFFS(gvc, cur);
    GE_STAGE_B(GE_SB(0, 0), cur.b0); GE_STAGE_A(GE_SA(0, 0), cur.a, 0, gvc); GE_STAGE_B(GE_SB(0, 1), cur.b1); GE_STAGE_A(GE_SA(0, 1), cur.a, 1, gvc);
    if (wr == 1) GE_BAR;
    GE_WAIT_V(4); GE_BAR;
    GE_STAGE_B(GE_SB(1, 0), cur.b0 + kstep); GE_STAGE_A(GE_SA(1, 0), cur.a + kstepA, 0, gvc); GE_STAGE_B(GE_SB(1, 1), cur.b1 + kstep);
    GE_WAIT_V(6); GE_BAR;
    for (;;) {
        const bool has_next = S.next(ui + 1, nxt);
        if (!has_next) nxt = cur;
        if constexpr (GATHER) { if (has_next) { GE_GATHER_OFFS(gvn, nxt); } else {
#pragma unroll
            for (int h = 0; h < 2; ++h)
#pragma unroll
                for (int i = 0; i < 2; ++i) gvn[h][i] = gvc[h][i]; } }
#pragma unroll 1
        for (int t = 0; t < nt; t += 2) {
            const bool last = (t == nt - 2);
            const char* a1 = cur.a + (size_t)(t + 1) * kstepA;
            const char* a2 = last ? nxt.a : cur.a + (size_t)(t + 2) * kstepA;
            const char* b20 = last ? nxt.b0 : cur.b0 + (size_t)(t + 2) * kstep;
            const char* b21 = last ? nxt.b1 : cur.b1 + (size_t)(t + 2) * kstep;
            const char* a3 = a2 + kstepA; const char* b30 = b20 + kstep; const char* b31 = b21 + kstep;
            GE_LDB(B0, 0, 0); GE_SCHED; GE_LDA(At, 0, 0); GE_STAGE_A(GE_SA(1, 1), a1, 1, gvc);
            GE_WAIT_L(8); GE_BAR; GE_WAIT_L(0); GE_MMA(0, 0, At, B0); GE_BAR; GE_SCHED;
            GE_LDB(B1, 0, 1); GE_STAGE_B(GE_SB(0, 0), b20);
            GE_BAR; GE_WAIT_L(0); GE_MMA(0, 1, At, B1); GE_BAR;
            GE_LDA(At, 0, 1); GE_STAGE_A2(GE_SA(0, 0), a2, 0);
            GE_BAR; GE_WAIT_L(0); GE_MMA(1, 0, At, B0); GE_BAR; GE_SCHED;
            GE_STAGE_B(GE_SB(0, 1), b21);
            GE_WAIT_V(6); GE_BAR; GE_MMA(1, 1, At, B1); GE_BAR;
            GE_LDB(B0, 1, 0); GE_SCHED; GE_LDA(At, 1, 0); GE_STAGE_A2(GE_SA(0, 1), a2, 1);
            GE_WAIT_L(8); GE_BAR; GE_WAIT_L(0); GE_MMA(0, 0, At, B0); GE_BAR; GE_SCHED;
            GE_LDB(B1, 1, 1); GE_STAGE_B(GE_SB(1, 0), b30);
            GE_BAR; GE_WAIT_L(0); GE_MMA(0, 1, At, B1); GE_BAR;
            GE_LDA(At, 1, 1); GE_STAGE_A2(GE_SA(1, 0), a3, 0);
            GE_BAR; GE_WAIT_L(0); GE_MMA(1, 0, At, B0); GE_BAR; GE_SCHED;
            GE_STAGE_B(GE_SB(1, 1), b31);
            GE_WAIT_V(6); GE_BAR; GE_MMA(1, 1, At, B1); GE_BAR;
        }
        E(acc, cur, wr, wc, fr, fq);
        if (!has_next) break;
#pragma unroll
        for (int a = 0; a < 2; ++a)
#pragma unroll
            for (int b = 0; b < 2; ++b)
#pragma unroll
                for (int m = 0; m < 4; ++m)
#pragma unroll
                    for (int n = 0; n < 2; ++n) acc[a][b][m][n] = (f32x4){0.f, 0.f, 0.f, 0.f};
        cur = nxt; ++ui;
        if constexpr (GATHER) {
#pragma unroll
            for (int h = 0; h < 2; ++h)
#pragma unroll
                for (int i = 0; i < 2; ++i) gvc[h][i] = gvn[h][i]; }
    }
    GE_WAIT_V(0);
    if (wr == 0) GE_BAR;
    GE_BAR;
#undef GE_SA
#undef GE_SB
#undef GE_GLDS
#undef GE_STAGE_A
#undef GE_STAGE_A2
#undef GE_STAGE_B
#undef GE_LDA
#undef GE_LDB
#undef GE_MMA
#undef GE_WAIT_V
#undef GE_WAIT_L
#undef GE_BAR
#undef GE_SCHED
#undef GE_GATHER_OFFS
}
}
__device__ __forceinline__ unsigned cvt_pk_bf16(float lo, float hi) { unsigned r; asm volatile("v_cvt_pk_bf16_f32 %0, %1, %2" : "=v"(r) : "v"(lo), "v"(hi)); return r; }
__device__ __forceinline__ u32x4 pack8(const f32x4 a, const f32x4 b) { u32x4 w; w.x = cvt_pk_bf16(a[0], a[1]); w.y = cvt_pk_bf16(a[2], a[3]); w.z = cvt_pk_bf16(b[0], b[1]); w.w = cvt_pk_bf16(b[2], b[3]); return w; }
__device__ __forceinline__ void unpack8(const u32x4 w, f32x4& a, f32x4& b) {
    a[0] = __uint_as_float(w.x << 16); a[1] = __uint_as_float(w.x & 0xFFFF0000u); a[2] = __uint_as_float(w.y << 16); a[3] = __uint_as_float(w.y & 0xFFFF0000u);
    b[0] = __uint_as_float(w.z << 16); b[1] = __uint_as_float(w.z & 0xFFFF0000u); b[2] = __uint_as_float(w.w << 16); b[3] = __uint_as_float(w.w & 0xFFFF0000u); }
__device__ __forceinline__ float sigmoidf_fast(float v) { return 1.0f / (1.0f + __expf(-v)); }

struct SchedDense {
    const char* A; const char* B; size_t arb, brb; int nM, nN, G, c;
    __device__ __forceinline__ bool next(int i, ge::Unit& u) const {
        const int L = i * G + c; if (L >= nM * nN) return false;
        int pm, pn; ge::tile_order(L, nM, nN, pm, pn);
        u.pm = pm; u.pn = pn; u.kind = 0; u.rows = nullptr; u.nrows = 0;
        u.a = A + (size_t)pm * 256 * arb; u.b0 = B + (size_t)pn * 256 * brb; u.b1 = u.b0 + 128 * brb; return true;
    }
};
struct SchedInproj {
    const char* WtHy; const char* WtRest; const char* U; int G, c;
    __device__ __forceinline__ bool next(int i, ge::Unit& u) const {
        const int L = i * G + c; if (L >= 408 + 748) return false;
        int pm, pn; u.rows = nullptr; u.nrows = 0;
        if (L < 408) { ge::tile_order(L, 6, 68, pm, pn); u.kind = 0; u.a = WtHy + (size_t)pm * 256 * 2048; u.b0 = U + (size_t)pn * 256 * 2048; }
        else { ge::tile_order(L - 408, 68, 11, pm, pn); u.kind = 1; u.a = U + (size_t)pm * 256 * 2048; u.b0 = WtRest + (size_t)pn * 256 * 2048; }
        u.b1 = u.b0 + 128 * 2048; u.pm = pm; u.pn = pn; return true;
    }
};
struct EpiInproj {
    bf16_t* PT; bf16_t* PTc; bf16_t* G;
    __device__ __forceinline__ void operator()(const ge::Acc& acc, const ge::Unit& u, int wr, int wc, int fr, int fq) const {
#pragma unroll
        for (int ai = 0; ai < 2; ++ai)
#pragma unroll
            for (int m = 0; m < 4; ++m) {
                const int r = u.pm * 256 + ai * 128 + wr * 64 + m * 16 + fr;
#pragma unroll
                for (int bj = 0; bj < 2; ++bj) {
                    const int c0 = bj * 128 + wc * 32 + fq * 8;
                    if (u.kind == 0) {
                        bf16_t* dst = (u.pn < 64) ? PT + ((size_t)((u.pn >> 4) * HYC + r)) * SEQ + (u.pn & 15) * 256 + c0
                                                  : PTc + ((size_t)((u.pn - 64) * HYC + r)) * CTXL + c0;
                        *(u32x4*)dst = pack8(acc[ai][bj][m][0], acc[ai][bj][m][1]);
                    } else {
                        const int c = (u.pn - 3) * 256 + c0;
                        f32x4 a = acc[ai][bj][m][0], b = acc[ai][bj][m][1];
#pragma unroll
                        for (int j = 0; j < 4; ++j) { a[j] = sigmoidf_fast(a[j]); b[j] = sigmoidf_fast(b[j]); }
                        *(u32x4*)(G + (size_t)r * 2048 + c) = pack8(a, b);
                    }
                }
            }
    }
};
struct EpiQ {
    bf16_t* Q; bf16_t* Qc; const LAS float* rope;
    const LAS float* rs;
    __device__ __forceinline__ void operator()(const ge::Acc& acc, const ge::Unit& u, int wr, int wc, int fr, int fq) const {
#pragma unroll
        for (int ai = 0; ai < 2; ++ai)
#pragma unroll
            for (int m = 0; m < 4; ++m) {
                const int r = u.pm * 256 + ai * 128 + wr * 64 + m * 16 + fr;
                const bool lat = r < TL;
                const int t = lat ? (r & 4095) : ((r - TL) & 255);
                const int b = lat ? (r >> 12) : ((r - TL) >> 8);
#pragma unroll
                for (int bj = 0; bj < 2; ++bj) {
                    const int c = u.pn * 256 + bj * 128 + wc * 32 + fq * 8;
                    const int h = c / 96, dd = c - h * 96;
                    const float rsc = QSCALE * rs[ai * 128 + wr * 64 + m * 16 + fr];
                    f32x4 v0 = acc[ai][bj][m][0] * rsc, v1 = acc[ai][bj][m][1] * rsc;
                    f32x4 p0, p1;
#pragma unroll
                    for (int j = 0; j < 4; ++j) { p0[j] = shx(v0[j], 16); p1[j] = shx(v1[j], 16); }
                    bf16_t* qrow = lat ? Q + ((size_t)(b * NH + h) * SEQ + t) * 128 : Qc + ((size_t)(b * NH + h) * CTXL + t) * 128;
                    if (dd < 64) *(u32x4*)(qrow + dd) = pack8(v0, v1);
                    else {
                        const int d0 = dd - 64;
                        f32x4 o0 = v0, o1 = v1;
                        if (lat) {
                            const LAS float* rp = rope + 2 * ((d0 >> 4) ? 32 + (t & 63) * 8 : ((t >> 6) & 3) * 8);
                            const bool s1 = (d0 >> 3) & 1;
#pragma unroll
                            for (int j = 0; j < 4; ++j) {
                                const float cax = rp[2 * j], cay = rp[2 * j + 1], cbx = rp[8 + 2 * j], cby = rp[9 + 2 * j];
                                o0[j] = s1 ? p0[j] * cay + v0[j] * cax : v0[j] * cax - p0[j] * cay;
                                o1[j] = s1 ? p1[j] * cby + v1[j] * cbx : v1[j] * cbx - p1[j] * cby;
                            }
                        }
                        *(u32x4*)(qrow + 64 + d0) = pack8(o0, o1);
                        *(u32x4*)(qrow + 96 + d0) = pack8(v0, v1);
                    }
                }
            }
    }
};
struct EpiKV {
    bf16_t* K; bf16_t* V; const LAS float* rs;
    __device__ __forceinline__ void operator()(const ge::Acc& acc, const ge::Unit& u, int wr, int wc, int fr, int fq) const {
#pragma unroll
        for (int ai = 0; ai < 2; ++ai)
#pragma unroll
            for (int m = 0; m < 4; ++m) {
                const int r = u.pm * 256 + ai * 128 + wr * 64 + m * 16 + fr;
                int b, key;
                if (r < TL) { b = r >> 12; key = r & 4095; } else { b = (r - TL) >> 8; key = SEQ + ((r - TL) & 255); }
#pragma unroll
                for (int bj = 0; bj < 2; ++bj) {
                    const int c = u.pn * 256 + bj * 128 + wc * 32 + fq * 8;
                    const int h = c >> 7, d = c & 127;
                    const size_t kb = (size_t)(b * NH + h) * NKEY + key;
                    bf16_t* dst = (d < 64) ? K + kb * DQK + d : V + kb * DV + (d - 64);
                    const float rk = rs[ai * 128 + wr * 64 + m * 16 + fr]; *(u32x4*)dst = pack8(acc[ai][bj][m][0] * rk, acc[ai][bj][m][1] * rk);
                }
            }
    }
};

constexpr int LDS_SSQ = ge::STAGE_BYTES + 2048;
struct EpiInprojMLA {
    bf16_t* PMLAb; bf16_t* K; const float2* rope; LAS float* ssq;
    __device__ __forceinline__ void operator()(const ge::Acc& acc, const ge::Unit& u, int wr, int wc, int fr, int fq) const {
#pragma unroll
        for (int ai = 0; ai < 2; ++ai)
#pragma unroll
            for (int m = 0; m < 4; ++m) {
                const int rl = ai * 128 + wr * 64 + m * 16 + fr, r = u.pm * 256 + rl;
#pragma unroll
                for (int bj = 0; bj < 2; ++bj) {
                    const int c0 = bj * 128 + wc * 32 + fq * 8;
                    const f32x4 a = acc[ai][bj][m][0], b = acc[ai][bj][m][1];
                    const bool isval = (u.pn < 2) || (bj == 0);
                    const bool isrope = (u.pn == 2) && (bj == 1) && (wc == 0);
                    if (isval) {
                        const int col = (u.pn == 0 ? 0 : (u.pn == 1 ? 256 : 512)) + c0;
                        *(u32x4*)(PMLAb + (size_t)r * 640 + col) = pack8(a, b);
                        float sq = (a[0] * a[0] + a[1] * a[1]) + (a[2] * a[2] + a[3] * a[3]) + (b[0] * b[0] + b[1] * b[1]) + (b[2] * b[2] + b[3] * b[3]);
                        sq += shx(sq, 16); sq += shx(sq, 32);
                        if (fq == 0) ssq[rl * 16 + (u.pn == 2 ? 8 : 0) + bj * 4 + wc] = sq;
                    } else if (isrope) {
                        f32x4 pa, pb;
#pragma unroll
                        for (int j = 0; j < 4; ++j) { pa[j] = shx(a[j], 16); pb[j] = shx(b[j], 16); }
                        int bb, key; f32x4 oa = a, ob = b;
                        if (r < TL) {
                            bb = r >> 12; key = r & 4095;
                            const float2* rp = rope + (size_t)key * 16 + (fq >> 1) * 8;
#pragma unroll
                            for (int j = 0; j < 4; ++j) { const float2 ca = rp[j], cb = rp[4 + j];
                                oa[j] = (fq & 1) ? pa[j] * ca.y + a[j] * ca.x : a[j] * ca.x - pa[j] * ca.y;
                                ob[j] = (fq & 1) ? pb[j] * cb.y + b[j] * cb.x : b[j] * cb.x - pb[j] * cb.y; }
                        } else { bb = (r - TL) >> 8; key = SEQ + ((r - TL) & 255); }
                        const u32x4 w = pack8(oa, ob);
#pragma unroll
                        for (int h = 0; h < NH; ++h) *(u32x4*)(K + ((size_t)(bb * NH + h) * NKEY + key) * DQK + 64 + fq * 8) = w;
                    }
                }
            }
    }
};
struct SchedChainIn {
    const char* U; const char* WtRest; int pm, pn0, npn;
    __device__ __forceinline__ bool next(int i, ge::Unit& u) const {
        if (i >= npn) return false;
        u.pm = pm; u.pn = pn0 + i; u.kind = 1; u.rows = nullptr; u.nrows = 0;
        u.a = U + (size_t)pm * 256 * 2048; u.b0 = WtRest + (size_t)u.pn * 256 * 2048; u.b1 = u.b0 + 128 * 2048; return true;
    }
};
struct SchedPanel {
    const char* A; const char* B; size_t arb, brb; int pm, nN, kind;
    __device__ __forceinline__ bool next(int i, ge::Unit& u) const {
        if (i >= nN) return false;
        u.pm = pm; u.pn = i; u.kind = kind; u.rows = nullptr; u.nrows = 0;
        u.a = A + (size_t)pm * 256 * arb; u.b0 = B + (size_t)i * 256 * brb; u.b1 = u.b0 + 128 * brb; return true;
    }
};
struct SchedPool {
    const char* WtHy; const char* WtRest; const char* U; int first, step, n;
    __device__ __forceinline__ bool next(int i, ge::Unit& u) const {
        if (i >= n) return false;
        const int X = first + i * step; int pm, pn; u.rows = nullptr; u.nrows = 0;
        if (X < 408) { ge::tile_order(X, 6, 68, pm, pn); u.kind = 0; u.a = WtHy + (size_t)pm * 256 * 2048; u.b0 = U + (size_t)pn * 256 * 2048; }
        else { ge::tile_order(X - 408, 68, 8, pm, pn); pn += 3; u.kind = 1; u.a = U + (size_t)pm * 256 * 2048; u.b0 = WtRest + (size_t)pn * 256 * 2048; }
        u.b1 = u.b0 + 128 * 2048; u.pm = pm; u.pn = pn; return true;
    }
};
struct EpiQKV {
    EpiQ q; EpiKV kv;
    __device__ __forceinline__ void operator()(const ge::Acc& acc, const ge::Unit& u, int wr, int wc, int fr, int fq) const { if (u.kind == 0) q(acc, u, wr, wc, fr, fq); else kv(acc, u, wr, wc, fr, fq); }
};
struct SchedMerge {
    const char* Yhy; const char* Yatt; const char* Whyo; const char* Wmlao; int G, c, nM;
    __device__ __forceinline__ bool next(int i, ge::Unit& u) const {
        const int T = (i >> 1) * G + c; if (T >= nM * 4) return false;
        const int seg = i & 1; int pm, pn; ge::tile_order(T, nM, 4, pm, pn);
        u.pm = pm; u.pn = pn; u.kind = seg; u.rows = nullptr; u.nrows = 0;
        u.a = (seg ? Yatt : Yhy) + (size_t)pm * 256 * 16; u.b0 = (seg ? Wmlao : Whyo) + (size_t)pn * 256 * 1024; u.b1 = u.b0 + 128 * 1024; return true;
    }
};
struct EpiMerge {
    const bf16_t* G; bf16_t* M1;
    __device__ __forceinline__ void operator()(const ge::Acc& acc, const ge::Unit& u, int wr, int wc, int fr, int fq) const {
#pragma unroll
        for (int ai = 0; ai < 2; ++ai) {
            u32x4 gv[4][2], mv[4][2];
#pragma unroll
            for (int m = 0; m < 4; ++m) {
                const int r = u.pm * 256 + ai * 128 + wr * 64 + m * 16 + fr;
#pragma unroll
                for (int bj = 0; bj < 2; ++bj) {
                    const int c = u.pn * 256 + bj * 128 + wc * 32 + fq * 8;
                    gv[m][bj] = *(const u32x4*)(G + (size_t)r * 2048 + u.kind * DM + c);
                    if (u.kind) mv[m][bj] = *(const u32x4*)(M1 + (size_t)r * DM + c);
                }
            }
#pragma unroll
            for (int m = 0; m < 4; ++m) {
                const int r = u.pm * 256 + ai * 128 + wr * 64 + m * 16 + fr;
#pragma unroll
                for (int bj = 0; bj < 2; ++bj) {
                    const int c = u.pn * 256 + bj * 128 + wc * 32 + fq * 8;
                    f32x4 g0, g1; unpack8(gv[m][bj], g0, g1);
                    f32x4 o0 = g0 * acc[ai][bj][m][0], o1 = g1 * acc[ai][bj][m][1];
                    if (u.kind) { f32x4 q0, q1; unpack8(mv[m][bj], q0, q1); o0 += q0; o1 += q1; }
                    *(u32x4*)(M1 + (size_t)r * DM + c) = pack8(o0, o1);
                }
            }
        }
    }
};
__device__ __forceinline__ float4 ld_hx4(const bf16_t* q) { const u32x2 w = *(const u32x2*)q; return make_float4(__uint_as_float(w.x << 16), __uint_as_float(w.x & 0xFFFF0000u), __uint_as_float(w.y << 16), __uint_as_float(w.y & 0xFFFF0000u)); }
__device__ __forceinline__ void st_hx4(bf16_t* q, const float4 v) { u32x2 w; w.x = pack2(v.x, v.y); w.y = pack2(v.z, v.w); *(u32x2*)q = w; }
struct EpiOut {
    bf16_t* hx; const float* mod;
    __device__ __forceinline__ void operator()(const ge::Acc& acc, const ge::Unit& u, int wr, int wc, int fr, int fq) const {
        const int b = u.pm < 64 ? (u.pm >> 4) : 4;
        f32x4 gg[2][2];
#pragma unroll
        for (int bj = 0; bj < 2; ++bj) { const float* g = mod + (size_t)b * NMOD + 2 * DM + u.pn * 256 + bj * 128 + wc * 32 + fq * 8; gg[bj][0] = *(const f32x4*)g; gg[bj][1] = *(const f32x4*)(g + 4); }
#pragma unroll
        for (int ai = 0; ai < 2; ++ai) {
            u32x4 hv[4][2];
#pragma unroll
            for (int m = 0; m < 4; ++m) {
                const int r = u.pm * 256 + ai * 128 + wr * 64 + m * 16 + fr;
#pragma unroll
                for (int bj = 0; bj < 2; ++bj) hv[m][bj] = *(const u32x4*)(hx + (size_t)r * DM + u.pn * 256 + bj * 128 + wc * 32 + fq * 8);
            }
#pragma unroll
            for (int m = 0; m < 4; ++m) {
                const int r = u.pm * 256 + ai * 128 + wr * 64 + m * 16 + fr;
#pragma unroll
                for (int bj = 0; bj < 2; ++bj) {
                    f32x4 h0, h1; unpack8(hv[m][bj], h0, h1);
                    *(u32x4*)(hx + (size_t)r * DM + u.pn * 256 + bj * 128 + wc * 32 + fq * 8) = pack8(h0 + gg[bj][0] * acc[ai][bj][m][0], h1 + gg[bj][1] * acc[ai][bj][m][1]);
                }
            }
        }
    }
};
struct SchedGU {
    const char* U; const char* WtG; const char* WtU; const int* list; const LAS int* tpre; const LAS int* cntl; int G, c;
    __device__ __forceinline__ bool next(int i, ge::Unit& u) const {
        const int L = i * G + (((G & 7) || i) ? c : (c & 7) * (G >> 3) + (c >> 3)); if (L >= 2 * tpre[64]) return false;
        const int rt = L >> 1, half = L & 1; int e = 0;
#pragma unroll
        for (int st_ = 32; st_ > 0; st_ >>= 1) { if (tpre[e + st_] <= rt) e += st_; }
        u.kind = e; u.pm = rt - tpre[e]; u.pn = half; u.rows = list + (size_t)e * CAP; u.nrows = cntl[e];
        u.a = U; u.b0 = WtG + ((size_t)e * DE + half * 128) * 2048; u.b1 = WtU + ((size_t)e * DE + half * 128) * 2048; return true;
    }
};
struct EpiGU {
    bf16_t* H; const LAS int* offs;
    __device__ __forceinline__ void operator()(const ge::Acc& acc, const ge::Unit& u, int wr, int wc, int fr, int fq) const {
        const int o = offs[u.kind];
#pragma unroll
        for (int ai = 0; ai < 2; ++ai)
#pragma unroll
            for (int m = 0; m < 4; ++m) {
                const int r = u.pm * 256 + ai * 128 + wr * 64 + m * 16 + fr;
                if (r < u.nrows) {
                    const int c = u.pn * 128 + wc * 32 + fq * 8;
                    f32x4 g0 = acc[ai][0][m][0], g1 = acc[ai][0][m][1];
#pragma unroll
                    for (int j = 0; j < 4; ++j) { g0[j] = g0[j] * sigmoidf_fast(g0[j]) * acc[ai][1][m][0][j]; g1[j] = g1[j] * sigmoidf_fast(g1[j]) * acc[ai][1][m][1][j]; }
                    *(u32x4*)(H + (size_t)(o + r) * DE + c) = pack8(g0, g1);
                }
            }
    }
};
struct SchedDown {
    const char* H; const char* WtD; const LAS int* tpre; const LAS int* cntl; const LAS int* offs; int G, c;
    __device__ __forceinline__ bool next(int i, ge::Unit& u) const {
        const int L = i * G + (((G & 7) || i) ? c : (c & 7) * (G >> 3) + (c >> 3)); if (L >= 4 * tpre[64]) return false;
        const int rt = L >> 2, pn = L & 3; int e = 0;
#pragma unroll
        for (int st_ = 32; st_ > 0; st_ >>= 1) { if (tpre[e + st_] <= rt) e += st_; }
        u.kind = e; u.pm = rt - tpre[e]; u.pn = pn; u.rows = nullptr; u.nrows = cntl[e];
        u.a = H + ((size_t)offs[e] + (size_t)u.pm * 256) * 512; u.b0 = WtD + ((size_t)e * DM + pn * 256) * 512; u.b1 = u.b0 + 128 * 512; return true;
    }
};
struct EpiDown {
    bf16_t* Y; const float* wl; const LAS int* offs;
    __device__ __forceinline__ void operator()(const ge::Acc& acc, const ge::Unit& u, int wr, int wc, int fr, int fq) const {
        const int o = offs[u.kind];
        float w[2][4];
#pragma unroll
        for (int ai = 0; ai < 2; ++ai)
#pragma unroll
            for (int m = 0; m < 4; ++m) { const int r = u.pm * 256 + ai * 128 + wr * 64 + m * 16 + fr; w[ai][m] = wl[(size_t)u.kind * CAP + (r < u.nrows ? r : 0)]; }
#pragma unroll
        for (int ai = 0; ai < 2; ++ai)
#pragma unroll
            for (int m = 0; m < 4; ++m) {
                const int r = u.pm * 256 + ai * 128 + wr * 64 + m * 16 + fr;
                if (r < u.nrows) {
#pragma unroll
                    for (int bj = 0; bj < 2; ++bj) {
                        const int c = u.pn * 256 + bj * 128 + wc * 32 + fq * 8;
                        *(u32x4*)(Y + (size_t)(o + r) * DM + c) = pack8(acc[ai][bj][m][0] * w[ai][m], acc[ai][bj][m][1] * w[ai][m]);
                    }
                }
            }
    }
};


typedef short s16x4 __attribute__((ext_vector_type(4)));
#define AT_THR 8.0f
__device__ __forceinline__ void ph_attn2(const P& p, char* smem, bool with_ctx) {
    constexpr int KS = 112, VS = 80;
    constexpr int NSTG = NKEY / 128;
    bf16_t* sK = (bf16_t*)smem;
    bf16_t* sV = sK + 3 * 128 * KS;
    const int tid = tid_opaque(), lane = tid & 63, wv = tid >> 6, fr = lane & 15, g = lane >> 4;
    const int NUL = NB * NH * 16, NUC = with_ctx ? NB * NH : 0;
    const int kc0 = tid / 12, kp0 = tid % 12, kc1 = (512 + tid) / 12, kp1 = (512 + tid) % 12;
    const int vk = tid >> 3, vp = tid & 7;
#define AT_LOADK(st_, hs_) do { const bf16_t* kb_ = Kp + (size_t)((st_) * 128 + (hs_) * 64) * DQK; kr0 = *(const u32x4*)(kb_ + kc0 * DQK + kp0 * 8); if (tid < 256) kr1 = *(const u32x4*)(kb_ + kc1 * DQK + kp1 * 8); } while (0)
#define AT_LOADV(st_, hs_) do { vr0 = *(const u32x4*)(Vp + (size_t)((st_) * 128 + (hs_) * 64) * DV + vk * DV + vp * 8); } while (0)
#define AT_STOREK(buf_, hs_) do { bf16_t* d_ = sK + ((buf_) * 128 + (hs_) * 64) * KS; *(u32x4*)(d_ + kc0 * KS + kp0 * 8) = kr0; if (tid < 256) *(u32x4*)(d_ + kc1 * KS + kp1 * 8) = kr1; } while (0)
#define AT_STOREV(buf_, hs_) do { *(u32x4*)(sV + ((buf_) * 128 + (hs_) * 64) * VS + vk * VS + vp * 8) = vr0; } while (0)
#define AT_LDKF(dst, mk) do { _Pragma("unroll") for (int ks = 0; ks < 3; ++ks) dst[ks] = *(const bf16x8*)(sKn + (mk) * 16 * KS + ks * 32); } while (0)
#define AT_MMAS(src, mk) do { sN[mk][0] = (f32x4){0.f, 0.f, 0.f, 0.f}; sN[mk][1] = (f32x4){0.f, 0.f, 0.f, 0.f}; \
        _Pragma("unroll") for (int ks = 0; ks < 3; ++ks) _Pragma("unroll") for (int nq = 0; nq < 2; ++nq) { const bf16x8 bq_ = (ks < 2) ? qf[nq][ks] : (ctxn ? qf[nq][3] : qf[nq][2]); \
            sN[mk][nq] = __builtin_amdgcn_mfma_f32_16x16x32_bf16(src[ks], bq_, sN[mk][nq], 0, 0, 0); } } while (0)
#define AT_EXPS(nq) do { float r_ = (nq) ? rs[0] - rs[0] : 0.f; _Pragma("unroll") for (int mk = 0; mk < 4; ++mk) _Pragma("unroll") for (int r = 0; r < 4; ++r) { const float pv = __builtin_amdgcn_exp2f(sC[mk][nq][r] - mn[nq]); r_ += pv; sC[mk][nq][r] = pv; } rs[nq] = r_; } while (0)
#define AT_SUBTILE(sKn_, ctxn_, sVb_) do { \
        const bf16_t* sKn = (sKn_) + fr * KS + g * 8; const bool ctxn = (ctxn_); \
        bf16x8 kfA[3], kfB[3]; bf16x8 pf[2][2]; float mn[2], mxq[2], rs[2]; \
        AT_LDKF(kfA, 0); \
        AT_MMAS(kfA, 0); AT_LDKF(kfB, 1); \
        _Pragma("unroll") for (int nq = 0; nq < 2; ++nq) { float mx = sC[0][nq][0]; \
            _Pragma("unroll") for (int mk = 0; mk < 4; ++mk) _Pragma("unroll") for (int r = 0; r < 4; ++r) mx = fmaxf(mx, sC[mk][nq][r]); \
            mxq[nq] = rowmax4(mx); } \
          \
          \
        if (__any((mxq[0] - m[0] > AT_THR) || (mxq[1] - m[1] > AT_THR))) { \
            _Pragma("unroll") for (int nq = 0; nq < 2; ++nq) { const float mnew_ = fmaxf(m[nq], mxq[nq]); const float a_ = __builtin_amdgcn_exp2f(m[nq] - mnew_); m[nq] = mnew_; lsum[nq] *= a_; \
                _Pragma("unroll") for (int md = 0; md < 4; ++md) oT[md][nq] *= a_; } } \
        mn[0] = m[0]; mn[1] = m[1]; \
        __builtin_amdgcn_sched_barrier(0); \
        AT_MMAS(kfB, 1); AT_LDKF(kfA, 2); AT_EXPS(0); \
        __builtin_amdgcn_sched_barrier(0); \
        AT_MMAS(kfA, 2); AT_LDKF(kfB, 3); AT_EXPS(1); \
        __builtin_amdgcn_sched_barrier(0); \
        AT_MMAS(kfB, 3); \
        _Pragma("unroll") for (int nq = 0; nq < 2; ++nq) { lsum[nq] += rs[nq]; \
            _Pragma("unroll") for (int kp = 0; kp < 2; ++kp) { const u32x4 w_ = pack8(sC[2 * kp][nq], sC[2 * kp + 1][nq]); pf[kp][nq] = __builtin_bit_cast(bf16x8, w_); } } \
        __builtin_amdgcn_sched_barrier(0); \
        _Pragma("unroll") for (int kp = 0; kp < 2; ++kp) _Pragma("unroll") for (int md = 0; md < 4; ++md) { \
            const bf16_t* a0_ = (sVb_) + (32 * kp + 4 * g + (fr >> 2)) * VS + 16 * md + 4 * (fr & 3); \
            const s16x4 lo_ = __builtin_amdgcn_ds_read_tr16_b64_v4i16((LAS s16x4*)a0_); \
            const s16x4 hi_ = __builtin_amdgcn_ds_read_tr16_b64_v4i16((LAS s16x4*)(a0_ + 16 * VS)); \
            const bf16x8 vf_ = __builtin_shufflevector(lo_, hi_, 0, 1, 2, 3, 4, 5, 6, 7); \
            _Pragma("unroll") for (int nq = 0; nq < 2; ++nq) oT[md][nq] = __builtin_amdgcn_mfma_f32_16x16x32_bf16(vf_, pf[kp][nq], oT[md][nq], 0, 0, 0); } \
        _Pragma("unroll") for (int mk = 0; mk < 4; ++mk) { sC[mk][0] = sN[mk][0]; sC[mk][1] = sN[mk][1]; } \
    } while (0)
    for (int u = blockIdx.x; u < NUL + NUC; u += gridDim.x) {
        const bool isctx = u >= NUL;
        int b, h, q0;
        if (!isctx) {
            int bh, qb;
            if (gridDim.x == 256) { const int c = u & 255, r = u >> 8, x = c & 7, sl = c >> 3; bh = r * 16 + x * 2 + (sl >> 4); qb = sl & 15; } else { bh = u / 16; qb = u % 16; }
            b = bh / NH; h = bh % NH; q0 = qb * 256;
        } else { const int v = u - NUL; b = v / NH; h = v % NH; q0 = 0; }
        const bf16_t* Qp = (isctx ? p.Qc + ((size_t)(b * NH + h) * CTXL + q0) * 128 : p.Q + ((size_t)(b * NH + h) * SEQ + q0) * 128) + (size_t)(wv * 32) * 128;
        bf16x8 qf[2][4];
#pragma unroll
        for (int nq = 0; nq < 2; ++nq)
#pragma unroll
            for (int ks = 0; ks < 4; ++ks) qf[nq][ks] = *(const bf16x8*)(Qp + (size_t)(nq * 16 + fr) * 128 + ks * 32 + g * 8);
        const bf16_t* Kp = p.K + (size_t)(b * NH + h) * NKEY * DQK;
        const bf16_t* Vp = p.V + (size_t)(b * NH + h) * NKEY * DV;
        f32x4 oT[4][2]; float m[2], lsum[2];
#pragma unroll
        for (int nq = 0; nq < 2; ++nq) { m[nq] = -INFINITY; lsum[nq] = 0.f;
#pragma unroll
            for (int md = 0; md < 4; ++md) oT[md][nq] = (f32x4){0.f, 0.f, 0.f, 0.f}; }
        const int st0 = isctx ? 32 : 0;
        u32x4 kr0, kr1 = (u32x4){0u, 0u, 0u, 0u}, vr0;
        f32x4 sC[4][2], sN[4][2];
        __syncthreads();
        AT_LOADK(st0, 0); AT_LOADV(st0, 0); AT_STOREK(0, 0); AT_STOREV(0, 0);
        AT_LOADK(st0, 1); AT_LOADV(st0, 1); AT_STOREK(0, 1); AT_STOREV(0, 1);
        AT_LOADK(st0 + 1, 0); AT_STOREK(1, 0);
        AT_LOADK(st0 + 1, 1);
        __syncthreads();
        {
            const bf16_t* sKn = sK + fr * KS + g * 8; const bool ctxn = st0 >= 32;
            bf16x8 kfA[3];
#pragma unroll
            for (int mk = 0; mk < 4; ++mk) { AT_LDKF(kfA, mk); AT_MMAS(kfA, mk); }
#pragma unroll
            for (int mk = 0; mk < 4; ++mk) { sC[mk][0] = sN[mk][0]; sC[mk][1] = sN[mk][1]; }
        }
        AT_STOREK(1, 1);
        __syncthreads();
        int kb = 0;
        for (int st = st0; st < NSTG; ++st) {
            const int bufc = (st - st0) & 1;
            const int st1 = st + 1 < NSTG ? st + 1 : NSTG - 1, st2 = st + 2 < NSTG ? st + 2 : NSTG - 1;
            const int kb1 = kb == 2 ? 0 : kb + 1, kb2 = kb1 == 2 ? 0 : kb1 + 1;
            const bf16_t* sKc = sK + kb * 128 * KS; const bf16_t* sKx = sK + kb1 * 128 * KS; const bf16_t* sVc = sV + bufc * 128 * VS;
            AT_LOADK(st2, 0); AT_LOADV(st1, 0);
            AT_SUBTILE(sKc + 64 * KS, st >= 32, sVc);
            AT_STOREK(kb2, 0); AT_STOREV(bufc ^ 1, 0);
            AT_LOADK(st2, 1); AT_LOADV(st1, 1);
            AT_SUBTILE(sKx, st1 >= 32, sVc + 64 * VS);
            AT_STOREK(kb2, 1); AT_STOREV(bufc ^ 1, 1);
            __syncthreads();
            kb = kb1;
        }
        const size_t rbase = (isctx ? (size_t)TL + b * CTXL : (size_t)b * SEQ) + q0 + wv * 32;
#pragma unroll
        for (int nq = 0; nq < 2; ++nq) {
            const float l = rowsum4(lsum[nq]);
            const float inv = 1.0f / l;
#pragma unroll
            for (int md = 0; md < 4; ++md) {
                u32x2 o; o.x = cvt_pk_bf16(oT[md][nq][0] * inv, oT[md][nq][1] * inv); o.y = cvt_pk_bf16(oT[md][nq][2] * inv, oT[md][nq][3] * inv);
                *(u32x2*)(p.Yatt + ((size_t)(h * 8 + md * 2 + (g >> 1)) * TT + rbase + nq * 16 + fr) * 8 + 4 * (g & 1)) = o;
            }
        }
    }
#undef AT_LOADK
#undef AT_LOADV
#undef AT_STOREK
#undef AT_STOREV
#undef AT_LDKF
#undef AT_MMAS
#undef AT_EXPS
#undef AT_SUBTILE
}

constexpr int RT_PITCH = 1024 + 8;
__device__ __forceinline__ void ph_norm2_router(const P& p, int l, char* smem, int nrows_total) {
    bf16_t* thi = (bf16_t*)smem;
    bf16_t* tlo = thi + 16 * RT_PITCH;
    float* part = (float*)(tlo + 16 * RT_PITCH);
    float* lgs = part + 8 * 16 * 80;
    const int tid = tid_opaque(), lane = tid & 63, wv = tid >> 6, fr = lane & 15, g = lane >> 4;
    const float* ng = p.norm2_g + l * DM;
    const bf16_t* whi = p.WrT + (size_t)(l * 2 + 0) * 80 * DM; const bf16_t* wlo = p.WrT + (size_t)(l * 2 + 1) * 80 * DM;
    bf16x8 bh[4][5];
#pragma unroll
    for (int ks = 0; ks < 4; ++ks)
#pragma unroll
        for (int nt = 0; nt < 5; ++nt) { const size_t o = (size_t)(nt * 16 + fr) * DM + wv * 128 + ks * 32 + g * 8; bh[ks][nt] = *(const bf16x8*)(whi + o); }
    float* bias_s = lgs + 16 * 80;
    float* recs = bias_s + 80;
    int nrec = 0;
    if (tid < 72) bias_s[tid] = tid < 64 ? p.b_re[l * NE + tid] : p.b_rg[l * 8 + tid - 64];
    for (int rb = blockIdx.x * 16; rb < nrows_total; rb += gridDim.x * 16) {
        __syncthreads();
        {
            const int lr0 = wv * 2, row0 = rb + lr0;
            const int b = row0 < TL ? (row0 >> 12) : 4;
            const bf16_t* hp = (const bf16_t*)p.hx + (size_t)row0 * DM;
            const float* md = p.mod + ((size_t)l * 5 + b) * NMOD + 3 * DM;
            float4 xv[2][4], gg4[4], sh4[4], sc4[4];
#pragma unroll
            for (int i = 0; i < 4; ++i) { const int j = i * 256 + lane * 4; xv[0][i] = ld_hx4(hp + j); xv[1][i] = ld_hx4(hp + DM + j); gg4[i] = *(const float4*)(ng + j); sh4[i] = *(const float4*)(md + j); sc4[i] = *(const float4*)(md + DM + j); }
            float ss0 = 0.f, ss1 = 0.f;
#pragma unroll
            for (int i = 0; i < 4; ++i) { ss0 += xv[0][i].x * xv[0][i].x + xv[0][i].y * xv[0][i].y + xv[0][i].z * xv[0][i].z + xv[0][i].w * xv[0][i].w;
                                          ss1 += xv[1][i].x * xv[1][i].x + xv[1][i].y * xv[1][i].y + xv[1][i].z * xv[1][i].z + xv[1][i].w * xv[1][i].w; }
#pragma unroll
            for (int o = 32; o > 0; o >>= 1) { ss0 += shx(ss0, o); ss1 += shx(ss1, o); }
            const float rs2[2] = {rsqrtf(ss0 * (1.0f / DM) + epsf()), rsqrtf(ss1 * (1.0f / DM) + epsf())};
#pragma unroll
            for (int i = 0; i < 4; ++i) {
                const int j = i * 256 + lane * 4;
                const float4 gg = gg4[i], sh = sh4[i], sc = sc4[i];
#pragma unroll
                for (int rr = 0; rr < 2; ++rr) {
                    const int lr = lr0 + rr; const float rs = rs2[rr];
                    float y[4];
                    y[0] = (xv[rr][i].x * rs * gg.x) * (1.f + sc.x) + sh.x; y[1] = (xv[rr][i].y * rs * gg.y) * (1.f + sc.y) + sh.y;
                    y[2] = (xv[rr][i].z * rs * gg.z) * (1.f + sc.z) + sh.z; y[3] = (xv[rr][i].w * rs * gg.w) * (1.f + sc.w) + sh.w;
                    bf16_t h[4], lo[4];
#pragma unroll
                    for (int e = 0; e < 4; ++e) { h[e] = f2bf(y[e]); lo[e] = f2bf(y[e] - bf2f(h[e])); }
                    u32x2 oh; oh.x = (unsigned)h[0] | ((unsigned)h[1] << 16); oh.y = (unsigned)h[2] | ((unsigned)h[3] << 16);
                    u32x2 ol; ol.x = (unsigned)lo[0] | ((unsigned)lo[1] << 16); ol.y = (unsigned)lo[2] | ((unsigned)lo[3] << 16);
                    *(u32x2*)(p.U + (size_t)(row0 + rr) * DM + j) = oh;
                    *(u32x2*)(thi + lr * RT_PITCH + j) = oh; *(u32x2*)(tlo + lr * RT_PITCH + j) = ol;
                }
            }
        }
        __syncthreads();
        f32x4 acc[5];
#pragma unroll
        for (int nt = 0; nt < 5; ++nt) acc[nt] = (f32x4){0.f, 0.f, 0.f, 0.f};
#pragma unroll
        for (int ks = 0; ks < 4; ++ks) {
            const int k0 = wv * 128 + ks * 32 + g * 8;
            const bf16x8 ah = *(const bf16x8*)(thi + fr * RT_PITCH + k0), al = *(const bf16x8*)(tlo + fr * RT_PITCH + k0);
#pragma unroll
            for (int nt = 0; nt < 5; ++nt) {
                const bf16x8 blf = *(const bf16x8*)(wlo + (size_t)(nt * 16 + fr) * DM + k0);
                acc[nt] = __builtin_amdgcn_mfma_f32_16x16x32_bf16(ah, bh[ks][nt], acc[nt], 0, 0, 0);
                acc[nt] = __builtin_amdgcn_mfma_f32_16x16x32_bf16(al, bh[ks][nt], acc[nt], 0, 0, 0);
                acc[nt] = __builtin_amdgcn_mfma_f32_16x16x32_bf16(ah, blf, acc[nt], 0, 0, 0);
            }
        }
#pragma unroll
        for (int nt = 0; nt < 5; ++nt)
#pragma unroll
            for (int r = 0; r < 4; ++r) part[(wv * 16 + g * 4 + r) * 80 + nt * 16 + fr] = acc[nt][r];
        __syncthreads();
        for (int i = tid; i < 16 * 80; i += NT) { float a = 0.f;
#pragma unroll
            for (int w = 0; w < 8; ++w) a += part[w * 16 * 80 + i];
            lgs[i] = a; }
        __syncthreads();
        if (tid < 128) {
            const int lrw = tid >> 3, i = tid & 7, row = rb + lrw;
            const float* le = lgs + lrw * 80; const float* lg = le + 64;
            const float* bre = bias_s; const float* brg = bias_s + 64;
            const float lgi = lg[i];
            float bv = lgi + brg[i]; int bi = i; float mx = lgi;
#pragma unroll
            for (int o = 1; o < 8; o <<= 1) { const float ov = shx(bv, o); const int oi = shx(bi, o); if (ov > bv || (ov == bv && oi < bi)) { bv = ov; bi = oi; } mx = fmaxf(mx, shx(mx, o)); }
            const int gs = bi;
            float den = __expf(lgi - mx);
#pragma unroll
            for (int o = 1; o < 8; o <<= 1) den += shx(den, o);
            const float pg = __expf(lg[gs] - mx) / den;
            const float lei = le[gs * 8 + i];
            float k0v = lei + bre[gs * 8 + i]; int k0i = i;
            const float keyi = k0v;
#pragma unroll
            for (int o = 1; o < 8; o <<= 1) { const float ov = shx(k0v, o); const int oi = shx(k0i, o); if (ov > k0v || (ov == k0v && oi < k0i)) { k0v = ov; k0i = oi; } }
            const int i0 = k0i;
            float k1v = (i == i0) ? -INFINITY : keyi; int k1i = (i == i0) ? 8 : i;
#pragma unroll
            for (int o = 1; o < 8; o <<= 1) { const float ov = shx(k1v, o); const int oi = shx(k1i, o); if (ov > k1v || (ov == k1v && oi < k1i)) { k1v = ov; k1i = oi; } }
            const int i1 = k1i;
            if (i == 0) {
                const float w0 = 1.0f / (1.0f + __expf(le[gs * 8 + i1] - le[gs * 8 + i0])), w1 = 1.0f - w0;
                float* rc = recs + (nrec * 16 + lrw) * 4;
                rc[0] = __int_as_float((gs * 8 + i0) | ((gs * 8 + i1) << 8)); rc[1] = pg * w0; rc[2] = pg * w1; rc[3] = __int_as_float(row);
            }
        }
        ++nrec;
    }
    __syncthreads();
    for (int q = tid; q < nrec * 16; q += NT) {
        const float* rc = recs + q * 4;
        const int ee = __float_as_int(rc[0]), e0 = ee & 255, e1 = ee >> 8, row = __float_as_int(rc[3]);
        const int r0 = atomicAdd(p.cnt + (l * NE + e0) * 64, 1), r1 = atomicAdd(p.cnt + (l * NE + e1) * 64, 1);
        p.list[(size_t)e0 * CAP + r0] = row; p.wl[(size_t)e0 * CAP + r0] = rc[1];
        p.list[(size_t)e1 * CAP + r1] = row; p.wl[(size_t)e1 * CAP + r1] = rc[2];
        *(int4*)(p.asg + (size_t)row * 4) = make_int4(e0, r0, e1, r1);
    }
    __syncthreads();
}

typedef float v2f __attribute__((ext_vector_type(2)));
#define HD __device__ __forceinline__
HD v2f vfma(v2f a, v2f b, v2f c) { return __builtin_elementwise_fma(a, b, c); }
HD v2f twk(v2f w) { return w.yy * (v2f){-1.f, 1.f}; }
HD v2f cmulk(v2f a, v2f w, v2f wk) { return vfma(a.yx, wk, a * w.xx); }
HD v2f cmulck(v2f a, v2f w, v2f wk) { return vfma(a.yx, -wk, a * w.xx); }
HD v2f cmul(v2f a, v2f w) { return cmulk(a, w, twk(w)); }
HD v2f cmulc(v2f a, v2f w) { return cmulck(a, w, twk(w)); }
HD int fphys(int i) { return (i >> 8) * 272 + ((i >> 4) & 15) * 17 + (i & 15); }
constexpr int FBUF = 4352;
template <bool INV> HD void dft4(v2f& x0, v2f& x1, v2f& x2, v2f& x3) {
    const v2f s02 = x0 + x2, d02 = x0 - x2, s13 = x1 + x3, d13 = x1 - x3;
    const v2f kj = INV ? (v2f){-1.f, 1.f} : (v2f){1.f, -1.f};
    x0 = s02 + s13; x2 = s02 - s13; x1 = vfma(d13.yx, kj, d02); x3 = vfma(d13.yx, -kj, d02);
}
template <bool INV> HD void dft16(v2f (&v)[16]) {
#pragma unroll
    for (int b = 0; b < 4; ++b) dft4<INV>(v[b], v[4 + b], v[8 + b], v[12 + b]);
    float C1 = 0.92387953251128674f, S1 = 0.38268343236508977f, C2 = 0.70710678118654752f;
    asm volatile("" : "+v"(C1), "+v"(S1), "+v"(C2));
#define TW(idx, cr, ci) v[idx] = vfma(v[idx].yx, INV ? (v2f){(ci), -(ci)} : (v2f){-(ci), (ci)}, v[idx] * (v2f){(cr), (cr)})
    TW(4 * 1 + 1, C1, -S1);
    TW(4 * 1 + 2, C2, -C2);
    TW(4 * 1 + 3, S1, -C1);
    TW(4 * 2 + 1, C2, -C2);
    v[4 * 2 + 2] = v[4 * 2 + 2].yx * (INV ? (v2f){-1.f, 1.f} : (v2f){1.f, -1.f});
    TW(4 * 2 + 3, -C2, -C2);
    TW(4 * 3 + 1, S1, -C1);
    TW(4 * 3 + 2, -C2, -C2);
    TW(4 * 3 + 3, -C1, S1);
#undef TW
#pragma unroll
    for (int c = 0; c < 4; ++c) dft4<INV>(v[4 * c], v[4 * c + 1], v[4 * c + 2], v[4 * c + 3]);
#define SW(i, j) { const v2f t_ = v[i]; v[i] = v[j]; v[j] = t_; }
    SW(1, 4) SW(2, 8) SW(3, 12) SW(6, 9) SW(7, 13) SW(11, 14)
#undef SW
}
template <class BUF, class TW> HD void fwd_pass0(int u, v2f (&v)[16], BUF buf, TW W) {
    dft16<false>(v);
    const v2f w1 = W[u], w1k = twk(w1); v2f wr = w1;
    const int pb = fphys(u);
    buf[pb] = v[0];
#pragma unroll
    for (int r = 1; r < 16; ++r) { v[r] = cmul(v[r], wr); buf[pb + 272 * r] = v[r]; wr = cmulk(wr, w1, w1k); }
}
template <class BUF, class TW> HD void fwd_pass1(int u, v2f (&v)[16], BUF buf, TW W) {
    const int j = u & 15, pb = (u >> 4) * 272 + j;
#pragma unroll
    for (int q = 0; q < 16; ++q) v[q] = buf[pb + 17 * q];
    dft16<false>(v);
    const v2f w1 = W[16 * j], w1k = twk(w1); v2f wr = w1;
    buf[pb] = v[0];
#pragma unroll
    for (int r = 1; r < 16; ++r) { v[r] = cmul(v[r], wr); buf[pb + 17 * r] = v[r]; wr = cmulk(wr, w1, w1k); }
}
template <class BUF> HD void fwd_pass2(int u, v2f (&v)[16], BUF buf) {
    const int pb = (u >> 4) * 272 + (u & 15) * 17;
#pragma unroll
    for (int q = 0; q < 16; ++q) v[q] = buf[pb + q];
    dft16<false>(v);
}
template <class BUF> HD void inv_passA(int u, v2f (&v)[16], BUF buf) {
    dft16<true>(v);
    const int pb = (u >> 4) * 272 + (u & 15) * 17;
#pragma unroll
    for (int r = 0; r < 16; ++r) buf[pb + r] = v[r];
}
template <class BUF, class TW> HD void inv_passB(int u, v2f (&v)[16], BUF buf, TW W) {
    const int j = u & 15, pb = (u >> 4) * 272 + j;
    const v2f w1 = W[16 * j], w1k = twk(w1); v2f wr = w1;
    v[0] = buf[pb];
#pragma unroll
    for (int q = 1; q < 16; ++q) { v[q] = cmulc(buf[pb + 17 * q], wr); wr = cmulk(wr, w1, w1k); }
    dft16<true>(v);
#pragma unroll
    for (int r = 0; r < 16; ++r) buf[pb + 17 * r] = v[r];
}
template <class BUF, class TW> HD void inv_passC(int u, v2f (&v)[16], BUF buf, TW W) {
    const v2f w1 = W[u], w1k = twk(w1); v2f wr = w1;
    const int pb = fphys(u);
    v[0] = buf[pb];
#pragma unroll
    for (int q = 1; q < 16; ++q) { v[q] = cmulc(buf[pb + 272 * q], wr); wr = cmulk(wr, w1, w1k); }
    dft16<true>(v);
}
HD int digitrev(int i) { return ((i & 15) << 8) | (i & 0xF0) | (i >> 8); }

#undef HD
constexpr int FFT_LDS_W = 2 * FBUF * 8;
constexpr int FFT_LDS_STG = FFT_LDS_W + 4096 * 8;
constexpr int STG_ROW = SEQ + 16;
constexpr int FFT_LDS_W2 = FFT_LDS_STG + 2 * STG_ROW * 2;
constexpr int FFT_LDS_END = FFT_LDS_W2 + 4096 * 8;
__device__ __forceinline__ void fft_load_w(const P& p, char* smem) {
    float2* Wl = (float2*)(smem + FFT_LDS_W); float2* W2l = (float2*)(smem + FFT_LDS_W2);
    __syncthreads();
    { const int t_ = tid_opaque();
      float4 a_[4], b_[4];
#pragma unroll
      for (int k = 0; k < 4; ++k) { a_[k] = ((const float4*)p.Wtab)[t_ + NT * k]; b_[k] = ((const float4*)p.W2tab)[t_ + NT * k]; }
#pragma unroll
      for (int k = 0; k < 4; ++k) { ((float4*)Wl)[t_ + NT * k] = a_[k]; ((float4*)W2l)[t_ + NT * k] = b_[k]; } }
    __syncthreads();
}
__device__ __forceinline__ void ph_tables(const P& p) {
    for (int i = blockIdx.x * NT + tid_opaque(); i < 8192; i += gridDim.x * NT) {
        float sn, cs;
        if (i < 4096) { sincospif((float)i * (1.0f / 2048.0f), &sn, &cs); p.Wtab[i] = make_float2(cs, -sn); }
        else { sincospif((float)(i - 4096) * (1.0f / 4096.0f), &sn, &cs); p.W2tab[i - 4096] = make_float2(cs, -sn); }
    }
    for (int i = blockIdx.x * NT + tid_opaque(); i < DEPTH * 80 * DM; i += gridDim.x * NT) {
        const int l = i / (80 * DM), n = (i / DM) % 80, kk = i % DM;
        const float v = n < 64 ? p.w_re[((size_t)l * DM + kk) * NE + n] : (n < 72 ? p.w_rg[((size_t)l * DM + kk) * 8 + (n - 64)] : 0.f);
        const bf16_t h = f2bf(v);
        p.WrT[((size_t)(l * 2 + 0) * 80 + n) * DM + kk] = h; p.WrT[((size_t)(l * 2 + 1) * 80 + n) * DM + kk] = f2bf(v - bf2f(h));
    }
}
__device__ __forceinline__ void ph_spectra(const P& p, char* smem) {
    v2f* bufE = (v2f*)smem; v2f* bufO = bufE + FBUF; const v2f* Wl = (const v2f*)(smem + FFT_LDS_W); const v2f* W2l = (const v2f*)(smem + FFT_LDS_W2);
    const int tid = tid_opaque(), half = tid >> 8, u = tid & 255;
    v2f* buf = half ? bufO : bufE;
    fft_load_w(p, smem);
    for (int un = blockIdx.x; un < DEPTH * HYW; un += gridDim.x) {
        const int l = un / HYW, c = un % HYW;
        const float* hf0 = p.HT0 + ((size_t)l * 2048 + c) * SEQ;        const float s_f0 = p.SCL0[l * 2048 + c];
        const float* hb0 = p.HT0 + ((size_t)l * 2048 + 512 + c) * SEQ;  const float s_b0 = p.SCL0[l * 2048 + 512 + c];
        const float* hf1 = p.HT0 + ((size_t)l * 2048 + 1024 + c) * SEQ; const float s_f1 = p.SCL0[l * 2048 + 1024 + c];
        const float* hb1 = p.HT0 + ((size_t)l * 2048 + 1536 + c) * SEQ; const float s_b1 = p.SCL0[l * 2048 + 1536 + c];
        v2f v[16];
#pragma unroll
        for (int q = 0; q < 16; ++q) {
            const int j = 2 * (u + 256 * q) + half;
            float a, b;
            if (j < SEQ) { a = hf0[j] * s_f0; b = hf1[j] * s_f1; } else if (j == SEQ) { a = 0.f; b = 0.f; } else { a = hb0[2 * SEQ - j] * s_b0; b = hb1[2 * SEQ - j] * s_b1; }
            if (j == 0) { a += p.flt_bias[(l * 2 + 0) * HYW + c]; b += p.flt_bias[(l * 2 + 1) * HYW + c]; }
            v[q] = (v2f){a, b};
        }
        __syncthreads();
        fwd_pass0(u, v, buf, Wl); __syncthreads();
        fwd_pass1(u, v, buf, Wl); __syncthreads();
        fwd_pass2(u, v, buf);
#pragma unroll
        for (int r = 0; r < 16; ++r) buf[fphys(16 * u + r)] = v[r];
        __syncthreads();
        unsigned* out = (unsigned*)p.Hs + (size_t)(l * HYW + c) * 4 * 4096;
        for (int idx = tid; idx < 8192; idx += NT) {
            const int par = idx >> 12, pi = idx & 4095, kp = 2 * digitrev(pi) + par, kpp = (8192 - kp) & 8191;
            const int k1 = kp & 4095, k2 = kpp & 4095;
            v2f t1 = cmul(W2l[k1], bufO[fphys(digitrev(k1))]); if (kp >= 4096) t1 = -t1;
            v2f t2 = cmul(W2l[k2], bufO[fphys(digitrev(k2))]); if (kpp >= 4096) t2 = -t2;
            const v2f F = bufE[fphys(digitrev(k1))] + t1, Gq = bufE[fphys(digitrev(k2))] + t2;
            const float sc = 0.5f / 8192.0f;
            out[(0 * 2 + par) * 4096 + pi] = pack2((F.x + Gq.x) * sc, (F.y - Gq.y) * sc);
            out[(1 * 2 + par) * 4096 + pi] = pack2((F.y + Gq.y) * sc, -(F.x - Gq.x) * sc);
        }
    }
    __syncthreads();
}
__device__ __forceinline__ void fft_conv(int half, int u, v2f (&v)[16], const v2f* W2g, const unsigned* Hso, v2f* buf, const v2f* Wl) {
    u32x4 hreg[4];
    const u32x4* hp = (const u32x4*)(Hso + (size_t)half * 4096 + 16 * u);
#pragma unroll
    for (int r4 = 0; r4 < 4; ++r4) hreg[r4] = hp[r4];
    if (half) {
#pragma unroll
        for (int q = 0; q < 16; ++q) v[q] = cmul(v[q], W2g[u + 256 * q]);
    }
    fwd_pass0(u, v, buf, Wl); __syncthreads();
    fwd_pass1(u, v, buf, Wl); __syncthreads();
    fwd_pass2(u, v, buf);
#pragma unroll
    for (int r4 = 0; r4 < 4; ++r4) { const u32x4 h = hreg[r4];
#define HSV(w_) ((v2f){__uint_as_float((w_) << 16), __uint_as_float((w_) & 0xFFFF0000u)})
        v[4 * r4] = cmul(v[4 * r4], HSV(h.x)); v[4 * r4 + 1] = cmul(v[4 * r4 + 1], HSV(h.y)); v[4 * r4 + 2] = cmul(v[4 * r4 + 2], HSV(h.z)); v[4 * r4 + 3] = cmul(v[4 * r4 + 3], HSV(h.w));
#undef HSV
    }
    inv_passA(u, v, buf); __syncthreads();
    inv_passB(u, v, buf, Wl); __syncthreads();
    inv_passC(u, v, buf, Wl);
    if (half) {
#pragma unroll
        for (int r = 0; r < 16; ++r) v[r] = cmulc(v[r], W2g[u + 256 * r]);
    }
}

__device__ __forceinline__ void ph_hyena_fft(const P& p, int l, char* smem) {
    v2f* buf0 = (v2f*)smem; v2f* buf1 = buf0 + FBUF; const v2f* Wl = (const v2f*)(smem + FFT_LDS_W);
    bf16_t* stg = (bf16_t*)(smem + FFT_LDS_STG) + 8;
    const v2f* W2l = (const v2f*)(smem + FFT_LDS_W2);
    const int tid = tid_opaque(), half = tid >> 8, u = tid & 255;
    v2f* buf = half ? buf1 : buf0;
    const int pu = fphys(u);
    if (tid < 32) { const int rw = tid >> 4, k = tid & 15; (stg - 8 + rw * STG_ROW)[k < 8 ? k : SEQ + k] = 0; }
    fft_load_w(p, smem);
    for (int c = blockIdx.x; c < HYW; c += gridDim.x) {
        const unsigned* Hs0 = (const unsigned*)p.Hs + (size_t)(l * HYW + c) * 4 * 4096; const unsigned* Hs1 = Hs0 + 2 * 4096;
        float scw[3][4];
#pragma unroll
        for (int w = 0; w < 3; ++w) { const int col = w * HYW + c; scw[w][0] = p.sc_w[(size_t)(l * 3 + 0) * HYC + col]; scw[w][1] = p.sc_w[(size_t)(l * 3 + 1) * HYC + col]; scw[w][2] = p.sc_w[(size_t)(l * 3 + 2) * HYC + col]; scw[w][3] = p.sc_b[l * HYC + col]; }
#define HY_TAP(sb, k, w) (scw[w][3] + scw[w][0] * __uint_as_float((unsigned)(sb)[(k) - 1] << 16) + scw[w][1] * __uint_as_float((unsigned)(sb)[(k)] << 16) + scw[w][2] * __uint_as_float((unsigned)(sb)[(k) + 1] << 16))
        u32x4 ra, rb;
#define HY_LOAD(sel, pr_) do { const bf16_t* r0_ = p.PT + ((size_t)(2 * (pr_)) * HYC + (sel) * HYW + c) * SEQ + tid * 8; ra = *(const u32x4*)r0_; rb = *(const u32x4*)(r0_ + (size_t)HYC * SEQ); } while (0)
#define HY_STAGE() do { *(u32x4*)(stg + tid * 8) = ra; *(u32x4*)(stg + STG_ROW + tid * 8) = rb; } while (0)
        HY_LOAD(0, 0);
        for (int pr = 0; pr < 2; ++pr) {
            const LAS bf16_t* sbA = (const LAS bf16_t*)stg + u; asm volatile("" : "+v"(sbA));
            const LAS bf16_t* sbB = sbA + STG_ROW;
            __syncthreads();
            HY_STAGE();
            __syncthreads();
            v2f v[16];
#pragma unroll
            for (int q = 0; q < 16; ++q) v[q] = (v2f){HY_TAP(sbA, 256 * q, 0), HY_TAP(sbB, 256 * q, 0)};
            HY_LOAD(1, pr);
            fft_conv(half, u, v, W2l, Hs0, buf, Wl);
            if (half) {
#pragma unroll
                for (int r = 0; r < 16; ++r) buf1[pu + 272 * r] = v[r];
            }
            HY_STAGE();
            __syncthreads();
            if (!half) {
#pragma unroll
                for (int r = 0; r < 16; ++r) {
                    const v2f y = v[r] + buf1[pu + 272 * r];
                    const float xa = HY_TAP(sbA, 256 * r, 1), xb = HY_TAP(sbB, 256 * r, 1);
                    const v2f z1 = (v2f){xa, xb} * y;
                    v[r] = z1; buf1[pu + 272 * r] = z1;
                }
            }
            HY_LOAD(2, pr);
            __syncthreads();
            if (half) {
#pragma unroll
                for (int r = 0; r < 16; ++r) v[r] = buf1[pu + 272 * r];
            }
            fft_conv(half, u, v, W2l, Hs1, buf, Wl);
            if (half) {
#pragma unroll
                for (int r = 0; r < 16; ++r) buf1[pu + 272 * r] = v[r];
            }
            HY_STAGE();
            if (pr == 0) HY_LOAD(0, 1);
            __syncthreads();
            if (!half) {
                bf16_t* oA = p.Yhy + ((size_t)(c >> 3) * TT + (size_t)(2 * pr) * SEQ + u) * 8 + (c & 7); bf16_t* oB = oA + (size_t)SEQ * 8;
#pragma unroll
                for (int r = 0; r < 16; ++r) {
                    const v2f y = v[r] + buf1[pu + 272 * r];
                    const float xa = HY_TAP(sbA, 256 * r, 2), xb = HY_TAP(sbB, 256 * r, 2);
                    oA[(size_t)(256 * r) * 8] = f2bf(xa * y.x);
                    oB[(size_t)(256 * r) * 8] = f2bf(xb * y.y);
                }
            }
        }
#undef HY_LOAD
#undef HY_STAGE
#undef HY_TAP
    }
    __syncthreads();
}

__device__ __forceinline__ float4 moe_combine4(const P& p, int lc, int b, size_t s0, size_t s1, int j, float4 hv) {
    const u32x2 y0 = *(const u32x2*)(p.Y + s0 * DM + j), y1 = *(const u32x2*)(p.Y + s1 * DM + j);
    const float4 g = *(const float4*)(p.mod + ((size_t)lc * 5 + b) * NMOD + 5 * DM + j);
    hv.x += g.x * (__uint_as_float(y0.x << 16) + __uint_as_float(y1.x << 16));
    hv.y += g.y * (__uint_as_float(y0.x & 0xFFFF0000u) + __uint_as_float(y1.x & 0xFFFF0000u));
    hv.z += g.z * (__uint_as_float(y0.y << 16) + __uint_as_float(y1.y << 16));
    hv.w += g.w * (__uint_as_float(y0.y & 0xFFFF0000u) + __uint_as_float(y1.y & 0xFFFF0000u));
    return hv;
}
__device__ __forceinline__ void ph_norm1c(const P& p, int l, const int* offs) {
    const int tid = tid_opaque(), lane = tid & 63, wv = tid >> 6;
    const float* ng = p.norm1_g + l * DM;
    for (int rb = blockIdx.x * 16; rb < TT; rb += gridDim.x * 16) {
        const int row0 = rb + wv * 2;
        const int b = row0 < TL ? (row0 >> 12) : 4;
        bf16_t* hp = (bf16_t*)p.hx + (size_t)row0 * DM;
        const float* src = row0 < TL ? p.x + (size_t)row0 * DM : p.ctx + (size_t)(row0 - TL) * DM;
        const float* md = p.mod + ((size_t)l * 5 + b) * NMOD;
        float4 xv[2][4];
        u32x2 ya[2][4], yb[2][4];
        if (l > 0) {
            const int4 a0 = *(const int4*)(p.asg + (size_t)row0 * 4), a1 = *(const int4*)(p.asg + (size_t)(row0 + 1) * 4);
            const size_t s00 = (size_t)offs[a0.x] + a0.y, s01 = (size_t)offs[a0.z] + a0.w, s10 = (size_t)offs[a1.x] + a1.y, s11 = (size_t)offs[a1.z] + a1.w;
#pragma unroll
            for (int i = 0; i < 4; ++i) { const int j = i * 256 + lane * 4;
                ya[0][i] = *(const u32x2*)(p.Y + s00 * DM + j); yb[0][i] = *(const u32x2*)(p.Y + s01 * DM + j);
                ya[1][i] = *(const u32x2*)(p.Y + s10 * DM + j); yb[1][i] = *(const u32x2*)(p.Y + s11 * DM + j); }
        }
#pragma unroll
        for (int i = 0; i < 4; ++i) { const int j = i * 256 + lane * 4;
            if (l > 0) { xv[0][i] = ld_hx4(hp + j); xv[1][i] = ld_hx4(hp + DM + j); } else { xv[0][i] = *(const float4*)(src + j); xv[1][i] = *(const float4*)(src + DM + j); } }
        float ss[2] = {0.f, 0.f};
#pragma unroll
        for (int rr = 0; rr < 2; ++rr)
#pragma unroll
            for (int i = 0; i < 4; ++i) {
                const int j = i * 256 + lane * 4;
                if (l > 0) {
                    const float4 g = *(const float4*)(p.mod + ((size_t)(l - 1) * 5 + b) * NMOD + 5 * DM + j);
                    const u32x2 y0 = ya[rr][i], y1 = yb[rr][i];
                    xv[rr][i].x += g.x * (__uint_as_float(y0.x << 16) + __uint_as_float(y1.x << 16));
                    xv[rr][i].y += g.y * (__uint_as_float(y0.x & 0xFFFF0000u) + __uint_as_float(y1.x & 0xFFFF0000u));
                    xv[rr][i].z += g.z * (__uint_as_float(y0.y << 16) + __uint_as_float(y1.y << 16));
                    xv[rr][i].w += g.w * (__uint_as_float(y0.y & 0xFFFF0000u) + __uint_as_float(y1.y & 0xFFFF0000u));
                }
                st_hx4(hp + (size_t)rr * DM + j, xv[rr][i]);
                ss[rr] += xv[rr][i].x * xv[rr][i].x + xv[rr][i].y * xv[rr][i].y + xv[rr][i].z * xv[rr][i].z + xv[rr][i].w * xv[rr][i].w;
            }
        ss[0] = wave_sum(ss[0]); ss[1] = wave_sum(ss[1]);
        const float rs[2] = {rsqrtf(ss[0] * (1.0f / DM) + epsf()), rsqrtf(ss[1] * (1.0f / DM) + epsf())};
#pragma unroll
        for (int i = 0; i < 4; ++i) {
            const int j = i * 256 + lane * 4;
            const float4 g = *(const float4*)(ng + j), sh = *(const float4*)(md + j), sc = *(const float4*)(md + DM + j);
#pragma unroll
            for (int rr = 0; rr < 2; ++rr) {
                u32x2 o;
                o.x = pack2((xv[rr][i].x * rs[rr] * g.x) * (1.f + sc.x) + sh.x, (xv[rr][i].y * rs[rr] * g.y) * (1.f + sc.y) + sh.y);
                o.y = pack2((xv[rr][i].z * rs[rr] * g.z) * (1.f + sc.z) + sh.z, (xv[rr][i].w * rs[rr] * g.w) * (1.f + sc.w) + sh.w);
                *(u32x2*)(p.U + (size_t)(row0 + rr) * DM + j) = o;
            }
        }
    }
}
__device__ __forceinline__ void ph_final_c(const P& p, const int* offs) {
    const int tid = tid_opaque(), lane = tid & 63, wv = tid >> 6;
    for (int rb = blockIdx.x * 8; rb < TL; rb += gridDim.x * 8) {
        const int row = rb + wv, b = row >> 12;
        const bf16_t* hp = (const bf16_t*)p.hx + (size_t)row * DM;
        const int4 a = *(const int4*)(p.asg + (size_t)row * 4);
        const size_t s0 = (size_t)offs[a.x] + a.y, s1 = (size_t)offs[a.z] + a.w;
        float4 xv[4]; float ss = 0.f;
#pragma unroll
        for (int i = 0; i < 4; ++i) {
            const int j = i * 256 + lane * 4;
            xv[i] = moe_combine4(p, DEPTH - 1, b, s0, s1, j, ld_hx4(hp + j));
            ss += xv[i].x * xv[i].x + xv[i].y * xv[i].y + xv[i].z * xv[i].z + xv[i].w * xv[i].w;
        }
        ss = wave_sum(ss);
        const float rs = rsqrtf(ss * (1.0f / DM) + epsf());
#pragma unroll
        for (int i = 0; i < 4; ++i) {
            const int j = i * 256 + lane * 4;
            const float4 g = *(const float4*)(p.final_g + j);
            float4 y; y.x = xv[i].x * rs * g.x; y.y = xv[i].y * rs * g.y; y.z = xv[i].z * rs * g.z; y.w = xv[i].w * rs * g.w;
            *(float4*)(p.out + (size_t)row * DM + j) = y;
        }
    }
}


__device__ __forceinline__ void ph_hyena_ctx(const P& p, int l, char* smem) {
    constexpr int L = CTXL;
    const int tid = tid_opaque(), hf = tid >> 8, tl = tid & 255, b = tl >> 6, t0 = (tl & 63) * 4;
    float* kern0 = (float*)smem + hf * (8 * L);
    float* kern1 = kern0 + 2 * L;
    float* zb = kern1 + 2 * L;
    const float* HT = p.HT1 + (size_t)l * 2048 * L;
    const float* SCL = p.SCL1 + l * 2048;
    for (int cb = blockIdx.x; cb < HYW; cb += 2 * gridDim.x) {
        const int c = cb + hf * gridDim.x;
        const bool act = c < HYW;
        __syncthreads();
        float uv[3][4];
        if (act) {
            const float kb0 = tl > 0 ? HT[(size_t)(512 + c) * L + (L - tl)] * SCL[512 + c] : 0.f, kb1 = tl > 0 ? HT[(size_t)(1536 + c) * L + (L - tl)] * SCL[1536 + c] : 0.f;
            const float kf0 = HT[(size_t)c * L + tl] * SCL[c], kf1 = HT[(size_t)(1024 + c) * L + tl] * SCL[1024 + c];
            kern0[tl] = kb0; kern1[tl] = kb1; kern0[L + tl] = kf0; kern1[L + tl] = kf1;
#pragma unroll
            for (int w = 0; w < 3; ++w) {
                const int col = w * HYW + c;
                const bf16_t* pr = p.PTc + ((size_t)b * HYC + col) * L + t0;
                const float w0 = p.sc_w[(size_t)(l * 3 + 0) * HYC + col], w1 = p.sc_w[(size_t)(l * 3 + 1) * HYC + col], w2 = p.sc_w[(size_t)(l * 3 + 2) * HYC + col], bb = p.sc_b[l * HYC + col];
                const u32x2 mid = *(const u32x2*)pr;
                float e[6];
                e[0] = t0 > 0 ? bf2f(pr[-1]) : 0.f; e[5] = t0 + 4 < L ? bf2f(pr[4]) : 0.f;
                e[1] = __uint_as_float(mid.x << 16); e[2] = __uint_as_float(mid.x & 0xFFFF0000u); e[3] = __uint_as_float(mid.y << 16); e[4] = __uint_as_float(mid.y & 0xFFFF0000u);
#pragma unroll
                for (int j = 0; j < 4; ++j) uv[w][j] = bb + w0 * e[j] + w1 * e[j + 1] + w2 * e[j + 2];
            }
            *(float4*)(zb + b * L + t0) = make_float4(uv[0][0], uv[0][1], uv[0][2], uv[0][3]);
        }
        __syncthreads();
        const float* zr = zb + b * L;
        float a[4];
#define CTX_CONV(kern) do { a[0] = 0.f; a[1] = 0.f; a[2] = 0.f; a[3] = 0.f; \
            float4 khi = *(const float4*)((kern) + t0 + L); \
            _Pragma("unroll 4") for (int m = 0; m < L / 4; ++m) { \
                const float4 klo = *(const float4*)((kern) + t0 + L - 4 * m - 4); const float4 z = *(const float4*)(zr + 4 * m); \
                a[0] += z.x * khi.x; a[1] += z.x * khi.y; a[2] += z.x * khi.z; a[3] += z.x * khi.w; \
                a[0] += z.y * klo.w; a[1] += z.y * khi.x; a[2] += z.y * khi.y; a[3] += z.y * khi.z; \
                a[0] += z.z * klo.z; a[1] += z.z * klo.w; a[2] += z.z * khi.x; a[3] += z.z * khi.y; \
                a[0] += z.w * klo.y; a[1] += z.w * klo.z; a[2] += z.w * klo.w; a[3] += z.w * khi.x; \
                khi = klo; } } while (0)
        float z1[4];
        if (act) {
            CTX_CONV(kern0);
            const float bias0 = p.flt_bias[(l * 2 + 0) * HYW + c];
#pragma unroll
            for (int j = 0; j < 4; ++j) z1[j] = uv[1][j] * (a[j] + bias0 * uv[0][j]);
        }
        __syncthreads();
        if (act) *(float4*)(zb + b * L + t0) = make_float4(z1[0], z1[1], z1[2], z1[3]);
        __syncthreads();
        if (act) {
            CTX_CONV(kern1);
            const float bias1 = p.flt_bias[(l * 2 + 1) * HYW + c];
            bf16_t* o = p.Yhy + ((size_t)(c >> 3) * TT + (size_t)TL + b * CTXL + t0) * 8 + (c & 7);
#pragma unroll
            for (int j = 0; j < 4; ++j) o[j * 8] = f2bf(uv[2][j] * (a[j] + bias1 * z1[j]));
        }
#undef CTX_CONV
    }
    __syncthreads();
}

__device__ __forceinline__ void conv_tile(bf16_t* tile, const float* src, int ld, int c0, int ncols, int K, bf16_t* dst, int kt, int ntile, const float* kscale = nullptr) {
    const int tid = tid_opaque();
    const int k = tid >> 3, n8 = (tid & 7) * 8, nbase = ntile * 64;
    float4 x0 = make_float4(0.f, 0.f, 0.f, 0.f), x1 = x0;
    if (nbase + n8 < ncols) { const float* sp = src + (size_t)(kt * 64 + k) * ld + c0 + nbase + n8; x0 = *(const float4*)sp; x1 = *(const float4*)(sp + 4); }
    if (kscale) { const float ks = kscale[kt * 64 + k]; x0.x *= ks; x0.y *= ks; x0.z *= ks; x0.w *= ks; x1.x *= ks; x1.y *= ks; x1.z *= ks; x1.w *= ks; }
    __syncthreads();
    tile[(n8 + 0) * 72 + k] = f2bf(x0.x); tile[(n8 + 1) * 72 + k] = f2bf(x0.y); tile[(n8 + 2) * 72 + k] = f2bf(x0.z); tile[(n8 + 3) * 72 + k] = f2bf(x0.w);
    tile[(n8 + 4) * 72 + k] = f2bf(x1.x); tile[(n8 + 5) * 72 + k] = f2bf(x1.y); tile[(n8 + 6) * 72 + k] = f2bf(x1.z); tile[(n8 + 7) * 72 + k] = f2bf(x1.w);
    __syncthreads();
    const int n = tid >> 3, k8 = (tid & 7) * 8;
    if (nbase + n < ncols) *(u32x4*)(dst + (size_t)(nbase + n) * K + kt * 64 + k8) = *(const u32x4*)(tile + n * 72 + k8);
}
constexpr int DENSE_TILES = 1720;
__device__ __forceinline__ void ph_conv_dense(const P& p, char* smem) {
    bf16_t* tile = (bf16_t*)smem;
    for (int id = blockIdx.x; id < DEPTH * DENSE_TILES; id += gridDim.x) {
        const int l = id / DENSE_TILES; int r = id % DENSE_TILES;
        const float* win = p.w_in + (size_t)l * DM * INC;
        if (r < 384) conv_tile(tile, win, INC, 0, HYC, DM, p.WtHy + (size_t)l * HYC * DM, r / 24, r % 24);
        else if ((r -= 384) < 64) conv_tile(tile, win, INC, HYC + QL, KVL, DM, p.WtRest + (size_t)l * 2816 * DM, r / 4, r % 4);
        else if ((r -= 64) < 96) conv_tile(tile, win, INC, HYC, QL, DM, p.WtRest + ((size_t)l * 2816 + 256) * DM, r / 6, r % 6);
        else if ((r -= 96) < 16) conv_tile(tile, win, INC, HYC + QL + KVL, QKR, DM, p.WtRest + ((size_t)l * 2816 + 640) * DM, r, 0);
        else if ((r -= 16) < 512) conv_tile(tile, win, INC, MLA_END, 2048, DM, p.WtRest + ((size_t)l * 2816 + 768) * DM, r / 32, r % 32);
        else if ((r -= 512) < 72) conv_tile(tile, p.w_uq + (size_t)l * QL * 768, 768, 0, 768, QL, p.WtUq + (size_t)l * 768 * QL, r / 12, r % 12, p.q_norm_g + l * QL);
        else if ((r -= 72) < 64) conv_tile(tile, p.w_ukv + (size_t)l * KVL * 1024, 1024, 0, 1024, KVL, p.WtUkv + (size_t)l * 1024 * KVL, r / 16, r % 16, p.kv_norm_g + l * KVL);
        else if ((r -= 64) < 128) conv_tile(tile, p.w_hy_o + (size_t)l * HYW * DM, DM, 0, DM, HYW, p.WtHyo + (size_t)l * DM * HYW, r / 16, r % 16);
        else if ((r -= 128) < 128) conv_tile(tile, p.w_mla_o + (size_t)l * 512 * DM, DM, 0, DM, 512, p.WtMlao + (size_t)l * DM * 512, r / 16, r % 16);
        else { r -= 128; conv_tile(tile, p.w_out + (size_t)l * DM * DM, DM, 0, DM, DM, p.WtOut + (size_t)l * DM * DM, r / 16, r % 16); }
    }
    const int nz = DEPTH * 96 * DM / 8;
    for (int i = blockIdx.x * NT + threadIdx.x; i < nz + SEQ * 16; i += gridDim.x * NT) {
        if (i < nz) { const int l = i / (96 * DM / 8), o = i % (96 * DM / 8); *(u32x4*)(p.WtRest + ((size_t)l * 2816 + MLAW) * DM + (size_t)o * 8) = (u32x4){0u, 0u, 0u, 0u}; }
        else { const int k = i - nz, t = k >> 4, a = (k >> 3) & 1, ii = k & 7; const float ang = (float)(a == 0 ? (t >> 6) : (t & 63)) * powf(10000.0f, -(float)ii / 8.0f); p.rope[k] = make_float2(cosf(ang), sinf(ang)); }
    }
}
__device__ __forceinline__ void ph_conv_experts(const P& p, int l, char* smem, int t_begin, int t_end, int worker, int nworkers) {
    bf16_t* tile = (bf16_t*)smem;
    if (worker >= 0)
    for (int id = t_begin + worker; id < t_end; id += nworkers) {
        const int e = id / 192; int r = id % 192;
        const size_t le = (size_t)l * NE + e;
        if (r < 64) conv_tile(tile, p.w_gate + le * DM * DE, DE, 0, DE, DM, p.WtG + (size_t)e * DE * DM, r / 4, r % 4);
        else if (r < 128) { r -= 64; conv_tile(tile, p.w_up + le * DM * DE, DE, 0, DE, DM, p.WtU + (size_t)e * DE * DM, r / 4, r % 4); }
        else { r -= 128; conv_tile(tile, p.w_down + le * DE * DM, DM, 0, DM, DE, p.WtD + (size_t)e * DM * DE, r / 16, r % 16); }
    }
    __syncthreads();
}

constexpr int LDS_TAB = ge::STAGE_BYTES;
static_assert(FFT_LDS_END <= 160 * 1024 - 16, "FFT LDS image");
constexpr int LDS_TOTAL = 160 * 1024;
#define PH_P KArgP kp_ = (KArgP)__builtin_amdgcn_kernarg_segment_ptr(); asm volatile("" : "+s"(kp_)); const P p = make_p(kp_); int G = gridDim.x, c = blockIdx.x; asm volatile("" : "+s"(G), "+s"(c)); (void)G; (void)c;
#define GRID_BAR() do { XcdBarrier b_; b_.bar = (unsigned*)k.ws; b_.x = xb_xcc_id(); b_.st = xbw; xcd_barrier(b_); } while (0)
__global__ __launch_bounds__(NT, 2) void mega(PK k) {
    extern __shared__ __attribute__((aligned(16))) char smem[];
    LAS unsigned char* lds = (LAS unsigned char*)smem;
    volatile LAS unsigned* xbw = (volatile LAS unsigned*)(smem + LDS_TOTAL - 16);
    if (threadIdx.x == 0) { xbw[0] = 0u; xbw[1] = 0u; xbw[2] = 0u; xbw[3] = 0u; }
    __syncthreads();
    (void)xcd_barrier_post((unsigned*)k.ws, xbw);
#define PB(id) do { if (PROBE_ID == (id) && blockIdx.x == PROBE_BLK && threadIdx.x == 0) xbw[2] = (unsigned)wall_clock64(); } while (0)
#define PE(id) do { if (PROBE_ID == (id) && blockIdx.x == PROBE_BLK && threadIdx.x == 0) xbw[3] += (unsigned)wall_clock64() - xbw[2]; } while (0)
    int* offs = (int*)(smem + LDS_TAB); int* tpre = offs + 65; int* cntl = tpre + 65;
    const LAS int* offs_l = (const LAS int*)(lds + LDS_TAB); const LAS int* tpre_l = offs_l + 65; const LAS int* cntl_l = tpre_l + 65;
    PB(0);
    for (int rep = 0; rep < REP_PRO; ++rep) {
    PB(20);
    { PH_P ph_mod_partial(p, smem); ph_filter_a(p, smem); ph_conv_dense(p, smem); ph_tables(p); }
    GRID_BAR();
    PE(20); PB(21);
    { PH_P ph_filter_b2(p, smem); }
    GRID_BAR();
    PE(21); PB(22);
    { PH_P ph_finalize(p); }
    GRID_BAR();
    PE(22); PB(23);
    { PH_P ph_spectra(p, smem); }
    GRID_BAR();
    PE(23);
    }
    PE(0);
    for (int l = 0; l < DEPTH; ++l) {
        const bool last = (l == DEPTH - 1);
        PB(1);
        { PH_P ph_norm1c(p, l, offs); }
        GRID_BAR();
        PE(1); PB(2); PB(40);
#define CHAIN_IDS int cw_ = blockIdx.x; asm volatile("" : "+s"(cw_)); const bool kvc = cw_ < 68, qc = !kvc && cw_ < 136; const int pm = kvc ? cw_ : cw_ - 68; (void)qc; (void)pm;
#define CHAIN_SSQ LAS float* ssq = (LAS float*)(lds + LDS_SSQ); LAS float* rsl = ssq + 256 * 16; (void)rsl;
        { CHAIN_IDS
          if (kvc || qc) { PH_P CHAIN_SSQ
              SchedChainIn S{(const char*)p.U, (const char*)(p.WtRest + (size_t)l * 2816 * DM), pm, kvc ? 0 : 1, kvc ? 1 : 2};
              EpiInprojMLA E{p.PMLAb, p.K, p.rope, ssq};
              ge::gemm_engine<false>(lds, DM, DM, DM, S, E);
          } }
        { CHAIN_IDS
          if (kvc || qc) { CHAIN_SSQ
              asm volatile("s_waitcnt vmcnt(0)" ::: "memory"); __syncthreads(); __builtin_amdgcn_fence(__ATOMIC_ACQUIRE, "agent"); asm volatile("s_waitcnt vmcnt(0)" ::: "memory");
              const int t_ = tid_opaque();
              if (t_ < 256) { float a_ = 0.f; const int ns = kvc ? 8 : 12;
                  for (int q_ = 0; q_ < ns; ++q_) a_ += ssq[t_ * 16 + q_];
                  rsl[t_] = rsqrtf(a_ * (kvc ? 1.0f / KVL : 1.0f / QL) + epsf()); }
              __syncthreads();
          } }
        { CHAIN_IDS
          if (kvc || qc) { PH_P CHAIN_SSQ
              LAS float* rpl = rsl + 256;
              { const int t0 = (pm & 15) * 256;
                if (pm < 64) for (int t_ = tid_opaque(); t_ < 544; t_ += NT) {
                    const float2 e_ = t_ < 32 ? p.rope[(size_t)(t0 + (t_ >> 3) * 64) * 16 + (t_ & 7)] : p.rope[(size_t)(t0 + ((t_ - 32) >> 3)) * 16 + 8 + ((t_ - 32) & 7)];
                    rpl[2 * t_] = e_.x; rpl[2 * t_ + 1] = e_.y; }
                __syncthreads(); }
              SchedPanel S{(const char*)(p.PMLAb + (kvc ? 0 : 256)), kvc ? (const char*)(p.WtUkv + (size_t)l * 1024 * KVL) : (const char*)(p.WtUq + (size_t)l * 768 * QL),
                           (size_t)640 * 2, (size_t)(kvc ? KVL : QL) * 2, pm, kvc ? 4 : 3, kvc ? 1 : 0};
              EpiQKV E{EpiQ{p.Q, p.Qc, rpl, rsl}, EpiKV{p.K, p.V, rsl}};
              ge::gemm_engine<false>(lds, 640, kvc ? KVL : QL, kvc ? KVL : QL, S, E);
          } }
        { CHAIN_IDS PH_P
            SchedPool S{(const char*)(p.WtHy + (size_t)l * HYC * DM), (const char*)(p.WtRest + (size_t)l * 2816 * DM), (const char*)p.U,
                        kvc ? 680 + 3 * cw_ : (qc ? 884 + (cw_ - 68) : cw_ - 136), (kvc || qc) ? 1 : G - 136, kvc ? 3 : (qc ? 1 : (680 - (cw_ - 136) + (G - 136) - 1) / (G - 136))};
            EpiInproj E{p.PT, p.PTc, p.G};
            ge::gemm_engine<false>(lds, DM, DM, DM, S, E);
        }
#undef CHAIN_IDS
#undef CHAIN_SSQ
        PE(40);
        GRID_BAR();
        PE(2);
        PE(4); PB(5);
        for (int rep = 0; rep < REP_MIX; ++rep) {
        PB(31);
        { PH_P ph_attn2(p, smem, !last); }
        PE(31); PB(32);
        { PH_P ph_hyena_fft(p, l, smem); }
        PE(32); PB(33);
        if (!last) { PH_P ph_hyena_ctx(p, l, smem); }
        PE(33); }
        GRID_BAR();
        PE(5); PB(6); PB(41);
        for (int rep = 0; rep < REP_DENSE; ++rep) { PH_P
            SchedMerge S{(const char*)p.Yhy, (const char*)p.Yatt, (const char*)(p.WtHyo + (size_t)l * DM * HYW), (const char*)(p.WtMlao + (size_t)l * DM * 512), G, c, last ? 64 : 68};
            EpiMerge E{p.G, p.M1};
            ge::gemm_engine<false, TT>(lds, 512, 512, 512, S, E);
        }
        { PH_P ph_conv_experts(p, l, smem, 0, NE * 96, c - 16, G - 16); }
        PE(41);
        GRID_BAR();
        PE(6); PB(7); PB(42);
        { PH_P
            SchedDense S{(const char*)p.M1, (const char*)(p.WtOut + (size_t)l * DM * DM), (size_t)DM * 2, (size_t)DM * 2, last ? 64 : 68, 4, G, c};
            EpiOut E{(bf16_t*)p.hx, p.mod + (size_t)l * 5 * NMOD};
            ge::gemm_engine<false>(lds, DM, DM, DM, S, E);
        }
        { PH_P ph_conv_experts(p, l, smem, NE * 96, NE * 192, c - 16, G - 16); }
        PE(42);
        GRID_BAR();
        PE(7); PB(8);
        { PH_P ph_norm2_router(p, l, smem, last ? TL : TT); }
        GRID_BAR();
        PE(8); PB(9);
        for (int rep = 0; rep < REP_MOE; ++rep) { PH_P
            if (threadIdx.x < NE) cntl[threadIdx.x] = p.cnt[(l * NE + threadIdx.x) * 64];
            __syncthreads();
            if (threadIdx.x == 0) { int a = 0, t = 0; for (int e = 0; e < NE; ++e) { const int n = cntl[e]; offs[e] = a; tpre[e] = t; a += n; t += (n + 255) >> 8; } offs[64] = a; tpre[64] = t; }
            __syncthreads();
            SchedGU S{(const char*)p.U, (const char*)p.WtG, (const char*)p.WtU, p.list, tpre_l, cntl_l, G, c};
            EpiGU E{p.Hb, offs_l};
            ge::gemm_engine<true>(lds, DM, DM, DM, S, E);
        }
        GRID_BAR();
        PE(9); PB(10);
        for (int rep = 0; rep < REP_MOE; ++rep) { PH_P
            SchedDown S{(const char*)p.Hb, (const char*)p.WtD, tpre_l, cntl_l, offs_l, G, c};
            EpiDown E{p.Y, p.wl, offs_l};
            ge::gemm_engine<false>(lds, DE, DE, DE, S, E);
        }
        GRID_BAR();
        PE(10);
        if (PROBE_ID == 12) { PB(12); GRID_BAR(); PE(12); }
    }
    PB(11);
    { PH_P ph_final_c(p, offs); }
    PE(11);
    if (PROBE_ID >= 0 && blockIdx.x == PROBE_BLK && threadIdx.x == 0) { const unsigned long long t0 = wall_clock64(), wait = (unsigned long long)xbw[3] * PROBE_K; while (wall_clock64() - t0 < wait) __builtin_amdgcn_s_sleep(8); }
}

extern "C" void kernel_launch(void* const* d_in, const int* in_sizes, int n_in, void* d_out, int out_size, void* d_ws, size_t ws_size, hipStream_t stream) {
    (void)in_sizes; (void)out_size;
    if (n_in < 33 || WSO.total > ws_size) { fprintf(stderr, "kernel_launch: need 33 inputs and %zu bytes of workspace; got %d, %zu\n", (size_t)WSO.total, n_in, ws_size); return; }
    PK k{};
    for (int i = 0; i < 33; ++i) k.in[i] = (const float*)d_in[i];
    k.out = (float*)d_out; k.ws = (char*)d_ws;
    (void)hipMemsetAsync(d_ws, 0, WS_ZERO_BYTES, stream);
    static int grid = 0;
    if (!grid) {
        int dev = 0, cus = 0, per_cu = 0;
        (void)hipGetDevice(&dev);
        (void)hipDeviceGetAttribute(&cus, hipDeviceAttributeMultiprocessorCount, dev);
        (void)hipFuncSetAttribute((const void*)mega, hipFuncAttributeMaxDynamicSharedMemorySize, LDS_TOTAL);
        (void)hipOccupancyMaxActiveBlocksPerMultiprocessor(&per_cu, (const void*)mega, NT, LDS_TOTAL);
        if (per_cu < 1) fprintf(stderr, "kernel_launch: occupancy query reports %d blocks per CU\n", per_cu);
        grid = cus > 0 ? cus : 256;
    }
    hipLaunchKernelGGL(mega, dim3(grid), dim3(NT), LDS_TOTAL, stream, k);
}
```
